# Optimizing an MI355X kernel written in HIP

```python
import math
import jax, jax.numpy as jnp
from jax import lax
import numpy as np

D_MODEL = 1024
BATCH = 32
SEQ = 2048
DEPTH = 1

HEAD_DIM = 64
NSA_HEADS = D_MODEL // 2 // HEAD_DIM
NSA_KV_HEADS = 2
NSA_GROUP = NSA_HEADS // NSA_KV_HEADS
CMP_LEN = 32
CMP_STRIDE = 16
CMP_HIDDEN = 256
SLC_LEN = 64
SLC_TOPK = 6
SLC_Q_CHUNK = 32
WIN = 256
DIFF_QK_DIM = 32
DIFF_V_DIM = 64
DIFF_HEADS = D_MODEL // 2 // DIFF_V_DIM
ROPE_THETA = 500000.0
Q_BLOCK = 128
IN_COLS = (NSA_HEADS * HEAD_DIM + 6 * NSA_KV_HEADS * HEAD_DIM + 3 * NSA_HEADS
           + 4 * DIFF_HEADS * DIFF_QK_DIM + DIFF_HEADS * DIFF_V_DIM)
N_EXPERT_GROUPS = 4
EXPERTS_PER_GROUP = 8
N_EXPERTS = N_EXPERT_GROUPS * EXPERTS_PER_GROUP
EXPERT_TOPK = 2
EXPERT_HIDDEN = D_MODEL // 2
MOE_BLOCK = 512
EPS = 1e-6
NEG = -1e30
FORCE_BONUS = 1e4

kernel_name = "hymba_nsa_diffattn_hmoe_layer"


def rms_norm(x, g):
    x32 = x.astype(jnp.float32)
    y = x32 * lax.rsqrt(jnp.mean(x32 * x32, axis=-1, keepdims=True) + EPS)
    return (y * g.astype(jnp.float32)).astype(x.dtype)


def rope_tables(seq, rot_dim):
    inv = ROPE_THETA ** (-jnp.arange(0, rot_dim, 2, dtype=jnp.float32) / rot_dim)
    ang = jnp.arange(seq, dtype=jnp.float32)[:, None] * inv[None, :]
    return jnp.cos(ang), jnp.sin(ang)


def apply_rope(x, cos, sin):
    half = cos.shape[-1]
    x1, x2, xp = x[..., :half], x[..., half:2 * half], x[..., 2 * half:]
    c, s = cos.astype(x.dtype), sin.astype(x.dtype)
    return jnp.concatenate([x1 * c - x2 * s, x1 * s + x2 * c, xp], axis=-1)


def heads(t, n, d):
    b, s, _ = t.shape
    return t.reshape(b, s, n, d).transpose(0, 2, 1, 3)


def compress_blocks(t, pe, w1, w2):
    B, G, S, Dh = t.shape
    n_cmp = (S - CMP_LEN) // CMP_STRIDE + 1
    idx = jnp.arange(n_cmp)[:, None] * CMP_STRIDE + jnp.arange(CMP_LEN)[None, :]
    blocks = (t[:, :, idx, :] + pe).reshape(B, G, n_cmp, CMP_LEN * Dh)
    return jax.nn.gelu(blocks @ w1) @ w2


def selected_attention(q, k, v, sel, scale):
    B, G, NG, S, Dh = q.shape
    K = sel.shape[-1]
    n_chunk = S // SLC_Q_CHUNK
    kb = k.reshape(B, G, S // SLC_LEN, SLC_LEN, Dh)
    vb = v.reshape(B, G, S // SLC_LEN, SLC_LEN, Dh)
    gather = jax.vmap(jax.vmap(lambda blocks, idx: blocks[idx]))
    q_c = jnp.moveaxis(q.reshape(B, G, NG, n_chunk, SLC_Q_CHUNK, Dh), 3, 0)
    sel_c = jnp.moveaxis(sel.reshape(B, G, n_chunk, SLC_Q_CHUNK, K), 2, 0)
    t_c = jnp.arange(S).reshape(n_chunk, SLC_Q_CHUNK)
    offs = jnp.arange(SLC_LEN)

    def chunk(args):
        qc, ic, tc = args
        kg = gather(kb, ic).reshape(B, G, SLC_Q_CHUNK, K * SLC_LEN, Dh)
        vg = gather(vb, ic).reshape(B, G, SLC_Q_CHUNK, K * SLC_LEN, Dh)
        kpos = (ic[..., None] * SLC_LEN + offs).reshape(B, G, SLC_Q_CHUNK, K * SLC_LEN)
        mask = kpos <= tc[:, None]
        s = jnp.einsum('bgntd,bgtkd->bgntk', qc, kg).astype(jnp.float32) * scale
        p = jax.nn.softmax(jnp.where(mask[:, :, None], s, NEG), axis=-1)
        return jnp.einsum('bgntk,bgtkd->bgntd', p.astype(vg.dtype), vg)

    o = lax.map(chunk, (q_c, sel_c, t_c))
    return jnp.moveaxis(o, 0, 3).reshape(B, G, NG, S, Dh)


def window_attention(q, k, v, scale):
    B, G, NG, S, Dh = q.shape
    nq = S // Q_BLOCK
    nprev = WIN // Q_BLOCK
    pad = nprev * Q_BLOCK

    def band(t):
        tp = jnp.pad(t, ((0, 0), (0, 0), (pad, 0), (0, 0))).reshape(B, G, nq + nprev, Q_BLOCK, Dh)
        return jnp.concatenate([tp[:, :, i:i + nq] for i in range(nprev + 1)], axis=3)

    kb, vb = band(k), band(v)
    qb = q.reshape(B, G, NG, nq, Q_BLOCK, Dh)
    tq = jnp.arange(nq)[:, None] * Q_BLOCK + jnp.arange(Q_BLOCK)[None, :]
    tk = jnp.arange(nq)[:, None] * Q_BLOCK - pad + jnp.arange((nprev + 1) * Q_BLOCK)[None, :]
    tq3, tk3 = tq[:, :, None], tk[:, None, :]
    mask = (tk3 <= tq3) & (tk3 > tq3 - WIN) & (tk3 >= 0)
    s = jnp.einsum('bgnqid,bgqjd->bgnqij', qb, kb).astype(jnp.float32) * scale
    p = jax.nn.softmax(jnp.where(mask, s, NEG), axis=-1)
    o = jnp.einsum('bgnqij,bgqjd->bgnqid', p.astype(vb.dtype), vb)
    return o.reshape(B, G, NG, S, Dh)


def nsa_mixer(q, kv, gate_logits, pe_cmp, w_cmp1, w_cmp2, g_q, g_k, cos, sin):
    B, S, _ = q.shape
    dt = q.dtype
    scale = HEAD_DIM ** -0.5
    qh = rms_norm(heads(q, NSA_HEADS, HEAD_DIM), g_q)
    q_nope = qh.reshape(B, NSA_KV_HEADS, NSA_GROUP, S, HEAD_DIM)
    q_rope = apply_rope(qh, cos, sin).reshape(B, NSA_KV_HEADS, NSA_GROUP, S, HEAD_DIM)
    kc, vc, ks, vs, kw, vw = [heads(t, NSA_KV_HEADS, HEAD_DIM) for t in jnp.split(kv, 6, axis=-1)]
    t_pos = jnp.arange(S)

    k_cmp = rms_norm(compress_blocks(kc, pe_cmp[0], w_cmp1[0], w_cmp2[0]), g_k[0])
    v_cmp = compress_blocks(vc, pe_cmp[1], w_cmp1[1], w_cmp2[1])
    n_cmp = k_cmp.shape[2]
    cmp_end = jnp.arange(n_cmp) * CMP_STRIDE + CMP_LEN - 1
    cmp_mask = cmp_end[None, :] <= t_pos[:, None]
    cmp_any = jnp.any(cmp_mask, axis=-1)[:, None].astype(jnp.float32)
    s_cmp = jnp.einsum('bgnsd,bgcd->bgnsc', q_nope, k_cmp).astype(jnp.float32) * scale
    p_cmp = jax.nn.softmax(jnp.where(cmp_mask, s_cmp, NEG), axis=-1) * cmp_any
    o_cmp = jnp.einsum('bgnsc,bgcd->bgnsd', p_cmp.astype(dt), v_cmp)

    n_slc = S // SLC_LEN
    c_start = jnp.arange(n_cmp) * CMP_STRIDE
    s_start = jnp.arange(n_slc) * SLC_LEN
    overlap = jnp.clip(jnp.minimum(c_start[:, None] + CMP_LEN, s_start[None, :] + SLC_LEN)
                       - jnp.maximum(c_start[:, None], s_start[None, :]), 0, None).astype(jnp.float32) / CMP_LEN
    imp = jnp.einsum('bgnsc,cj->bgsj', p_cmp, overlap)
    blk = jnp.arange(n_slc)[None, :]
    cur = (t_pos // SLC_LEN)[:, None]
    valid = blk <= cur
    forced = (blk == 0) | (blk == cur) | (blk == cur - 1)
    score = jnp.where(valid, imp + jnp.where(forced, FORCE_BONUS, 0.0), NEG)
    _, sel = lax.top_k(score, min(SLC_TOPK, n_slc))
    k_s = apply_rope(rms_norm(ks, g_k[1]), cos, sin)
    o_slc = selected_attention(q_rope, k_s, vs, sel, scale)

    k_w = apply_rope(rms_norm(kw, g_k[2]), cos, sin)
    o_win = window_attention(q_rope, k_w, vw, scale)

    g = jax.nn.sigmoid(gate_logits.astype(jnp.float32)).astype(dt)
    g = g.reshape(B, S, NSA_HEADS, 3).transpose(0, 2, 1, 3).reshape(B, NSA_KV_HEADS, NSA_GROUP, S, 3)
    o = g[..., 0:1] * o_cmp + g[..., 1:2] * o_slc + g[..., 2:3] * o_win
    return o.reshape(B, NSA_HEADS, S, HEAD_DIM).transpose(0, 2, 1, 3).reshape(B, S, NSA_HEADS * HEAD_DIM)


def diff_mixer(q, k, v, lam_q1, lam_k1, lam_q2, lam_k2, g_q, g_k, g_o, lambda_init, cos, sin):
    B, S, _ = q.shape

    def qk_heads(t, g):
        t = t.reshape(B, S, DIFF_HEADS, 2, DIFF_QK_DIM).transpose(0, 2, 3, 1, 4)
        return apply_rope(rms_norm(t, g), cos, sin)

    qh, kh = qk_heads(q, g_q), qk_heads(k, g_k)
    vh = heads(v, DIFF_HEADS, DIFF_V_DIM)
    f32 = jnp.float32
    lam = (jnp.exp(jnp.sum(lam_q1.astype(f32) * lam_k1.astype(f32)))
           - jnp.exp(jnp.sum(lam_q2.astype(f32) * lam_k2.astype(f32))) + lambda_init)
    scale = DIFF_QK_DIM ** -0.5
    outs = []
    for i in range(S // Q_BLOCK):
        lo, hi = i * Q_BLOCK, (i + 1) * Q_BLOCK
        s = jnp.einsum('bhmqd,bhmkd->bhmqk', qh[:, :, :, lo:hi], kh[:, :, :, :hi]).astype(f32) * scale
        mask = jnp.arange(hi)[None, :] <= jnp.arange(lo, hi)[:, None]
        p = jax.nn.softmax(jnp.where(mask, s, NEG), axis=-1)
        a = p[:, :, 0] - lam * p[:, :, 1]
        outs.append(jnp.einsum('bhqk,bhkd->bhqd', a.astype(vh.dtype), vh[:, :, :hi]))
    o = jnp.concatenate(outs, axis=2)
    o = rms_norm(o, g_o) * (1.0 - lambda_init)
    return o.transpose(0, 2, 1, 3).reshape(B, S, DIFF_HEADS * DIFF_V_DIM)


def hier_moe(h, w_rg, b_rg, w_re, b_re, w_g, w_u, w_d):
    T, D = h.shape
    f32 = jnp.float32
    lg = (h @ w_rg).astype(f32) + b_rg.astype(f32)
    pg = jax.nn.softmax(lg, axis=-1)
    _, grp = lax.top_k(lg, 1)
    p_grp = jnp.take_along_axis(pg, grp, axis=-1)
    le = ((h @ w_re).astype(f32) + b_re.astype(f32)).reshape(T, N_EXPERT_GROUPS, EXPERTS_PER_GROUP)
    le_sel = jnp.take_along_axis(le, grp[:, :, None], axis=1)[:, 0]
    top_v, top_i = lax.top_k(le_sel, EXPERT_TOPK)
    weight = p_grp * jax.nn.softmax(top_v, axis=-1)
    expert = grp * EXPERTS_PER_GROUP + top_i

    e_flat = expert.reshape(-1)
    tok = jnp.repeat(jnp.arange(T), EXPERT_TOPK)
    w_flat = weight.reshape(-1)
    order = jnp.argsort(e_flat)
    e_s, tok_s, w_s = e_flat[order], tok[order], w_flat[order]
    counts = jnp.bincount(e_flat, length=N_EXPERTS)
    starts = jnp.cumsum(counts) - counts
    padded = (counts + MOE_BLOCK - 1) // MOE_BLOCK * MOE_BLOCK
    pend = jnp.cumsum(padded)
    pstarts = pend - padded
    dest = pstarts[e_s] + (jnp.arange(T * EXPERT_TOPK) - starts[e_s])
    n_blk = (T * EXPERT_TOPK + MOE_BLOCK - 1) // MOE_BLOCK + N_EXPERTS
    rows = n_blk * MOE_BLOCK
    buf = jnp.zeros((rows, D), h.dtype).at[dest].set(h[tok_s])
    blk_e = jnp.minimum(jnp.searchsorted(pend, jnp.arange(n_blk) * MOE_BLOCK, side='right'), N_EXPERTS - 1)

    def expert_block(args):
        xb, e = args
        return (jax.nn.silu(xb @ w_g[e]) * (xb @ w_u[e])) @ w_d[e]

    yb = lax.map(expert_block, (buf.reshape(n_blk, MOE_BLOCK, D), blk_e)).reshape(rows, D)
    return jnp.zeros((T, D), h.dtype).at[tok_s].add(yb[dest] * w_s[:, None].astype(h.dtype))


def setup_inputs(seed: int = 0) -> dict:
    key = jax.random.key(seed)
    ks = jax.random.split(key, 32)
    f32 = jnp.float32

    def nrm(k, shape, scale):
        return jax.random.normal(k, shape, f32) * scale

    D, L = D_MODEL, DEPTH
    return {
        'x': nrm(ks[0], (BATCH, SEQ, D), 1.0),
        'c': nrm(ks[1], (BATCH, D), 1.0),
        'w_ada': nrm(ks[2], (L, D, 6 * D), 0.3 * D ** -0.5),
        'b_ada': nrm(ks[3], (L, 6 * D), 0.01),
        'g_norm_mix': 1.0 + nrm(ks[4], (L, D), 0.05),
        'g_norm_ffn': 1.0 + nrm(ks[5], (L, D), 0.05),
        'w_in': nrm(ks[6], (L, D, IN_COLS), D ** -0.5),
        'g_nsa_q': 1.0 + nrm(ks[7], (L, HEAD_DIM), 0.05),
        'g_nsa_k': 1.0 + nrm(ks[8], (L, 3, HEAD_DIM), 0.05),
        'pe_cmp': nrm(ks[9], (L, 2, CMP_LEN, HEAD_DIM), 0.1),
        'w_cmp1': nrm(ks[10], (L, 2, CMP_LEN * HEAD_DIM, CMP_HIDDEN), (CMP_LEN * HEAD_DIM) ** -0.5),
        'w_cmp2': nrm(ks[11], (L, 2, CMP_HIDDEN, HEAD_DIM), CMP_HIDDEN ** -0.5),
        'g_diff_q': 1.0 + nrm(ks[12], (L, DIFF_QK_DIM), 0.05),
        'g_diff_k': 1.0 + nrm(ks[13], (L, DIFF_QK_DIM), 0.05),
        'lam_q1': nrm(ks[14], (L, DIFF_QK_DIM), 0.1),
        'lam_k1': nrm(ks[15], (L, DIFF_QK_DIM), 0.1),
        'lam_q2': nrm(ks[16], (L, DIFF_QK_DIM), 0.1),
        'lam_k2': nrm(ks[17], (L, DIFF_QK_DIM), 0.1),
        'g_diff_out': 1.0 + nrm(ks[18], (L, DIFF_V_DIM), 0.05),
        'w_out': nrm(ks[19], (L, D, D), D ** -0.5),
        'w_router_group': nrm(ks[20], (L, D, N_EXPERT_GROUPS), D ** -0.5),
        'b_router_group': nrm(ks[21], (L, N_EXPERT_GROUPS), 0.01),
        'w_router_expert': nrm(ks[22], (L, D, N_EXPERTS), D ** -0.5),
        'b_router_expert': nrm(ks[23], (L, N_EXPERTS), 0.01),
        'w_exp_gate': nrm(ks[24], (L, N_EXPERTS, D, EXPERT_HIDDEN), D ** -0.5),
        'w_exp_up': nrm(ks[25], (L, N_EXPERTS, D, EXPERT_HIDDEN), D ** -0.5),
        'w_exp_down': nrm(ks[26], (L, N_EXPERTS, EXPERT_HIDDEN, D), EXPERT_HIDDEN ** -0.5),
    }


def reference(x, c, w_ada, b_ada, g_norm_mix, g_norm_ffn, w_in, g_nsa_q, g_nsa_k, pe_cmp,
              w_cmp1, w_cmp2, g_diff_q, g_diff_k, lam_q1, lam_k1, lam_q2, lam_k2, g_diff_out,
              w_out, w_router_group, b_router_group, w_router_expert, b_router_expert,
              w_exp_gate, w_exp_up, w_exp_down):
    B, S, D = x.shape
    cos_n, sin_n = rope_tables(S, HEAD_DIM // 4)
    cos_d, sin_d = rope_tables(S, DIFF_QK_DIM // 4)
    sizes = (NSA_HEADS * HEAD_DIM, 6 * NSA_KV_HEADS * HEAD_DIM, 3 * NSA_HEADS,
             2 * DIFF_HEADS * DIFF_QK_DIM, 2 * DIFF_HEADS * DIFF_QK_DIM, DIFF_HEADS * DIFF_V_DIM)
    cuts = [int(v) for v in np.cumsum(sizes)[:-1]]
    for l in range(DEPTH):
        lambda_init = 0.8 - 0.6 * math.exp(-0.3 * l)
        mod = (c @ w_ada[l] + b_ada[l])[:, None, :]
        shift1, scale1, gate1, shift2, scale2, gate2 = jnp.split(mod, 6, axis=-1)

        h = rms_norm(x, g_norm_mix[l]) * (1.0 + scale1) + shift1
        proj = h @ w_in[l]
        q_n, kv_n, gate_n, q_d, k_d, v_d = jnp.split(proj, cuts, axis=-1)
        o_nsa = nsa_mixer(q_n, kv_n, gate_n, pe_cmp[l], w_cmp1[l], w_cmp2[l],
                          g_nsa_q[l], g_nsa_k[l], cos_n, sin_n)
        o_diff = diff_mixer(q_d, k_d, v_d, lam_q1[l], lam_k1[l], lam_q2[l], lam_k2[l],
                            g_diff_q[l], g_diff_k[l], g_diff_out[l], lambda_init, cos_d, sin_d)
        x = x + gate1 * (jnp.concatenate([o_nsa, o_diff], axis=-1) @ w_out[l])

        h = rms_norm(x, g_norm_ffn[l]) * (1.0 + scale2) + shift2
        y = hier_moe(h.reshape(B * S, D), w_router_group[l], b_router_group[l],
                     w_router_expert[l], b_router_expert[l],
                     w_exp_gate[l], w_exp_up[l], w_exp_down[l])
        x = x + gate2 * y.reshape(B, S, D)
    return x
```

```cpp
#include <hip/hip_runtime.h>
#include <hip/hip_cooperative_groups.h>
#include <cstdint>
#include <cstdio>
namespace cg = cooperative_groups;

#define LAS __attribute__((address_space(3)))
#define DI __device__ __forceinline__
typedef unsigned short bf16_t;
typedef short bf16x8 __attribute__((ext_vector_type(8)));
typedef short s16x4 __attribute__((ext_vector_type(4)));
typedef float f32x2 __attribute__((ext_vector_type(2)));
typedef float f32x4 __attribute__((ext_vector_type(4)));
typedef float f32x16 __attribute__((ext_vector_type(16)));
typedef unsigned u32x2 __attribute__((ext_vector_type(2)));
typedef unsigned u32x4 __attribute__((ext_vector_type(4)));

constexpr int BATCH = 32, SEQ = 2048, DM = 1024, TOK = BATCH * SEQ;
constexpr int NPROJ = 3072;
constexpr int INCOLS = 2840;
constexpr int NEXP = 32, EHID = 512, ECAP = 65536;
constexpr float EPS = 1e-6f;
constexpr int NWAVES = 8, NTHREADS = 512;

constexpr size_t MiB = 1u << 20;
constexpr size_t WS_CTL = 0;
constexpr size_t WS_MOD = 1 * MiB;
constexpr size_t WS_ROPE = 2 * MiB;
constexpr size_t WS_WR = 3 * MiB;
constexpr size_t WS_WIN = 4 * MiB;
constexpr size_t WS_WOUT = 10 * MiB;
constexpr size_t WS_WC1 = 12 * MiB;
constexpr size_t WS_WGU = 16 * MiB;
constexpr size_t WS_WD = 80 * MiB;
constexpr size_t WS_LIST = 112 * MiB;
constexpr size_t WS_TIPOS = 120 * MiB;
constexpr size_t WS_TIE = WS_TIPOS + 512 * 1024;
constexpr size_t WS_TIW = WS_TIE + 256 * 1024;
constexpr size_t WS_ROWSS = 122 * MiB;
constexpr size_t WS_GATES = 126 * MiB;
constexpr size_t WS_KCMP = 132 * MiB;
constexpr size_t WS_VCMP = 133 * MiB;
constexpr size_t WS_UL = 134 * MiB;
constexpr size_t WS_A = 160 * MiB;
constexpr size_t WS_B = 288 * MiB;
constexpr size_t WS_C = 672 * MiB;
constexpr size_t WS_H1 = WS_A, WS_QN = WS_A, WS_QR = WS_A + 64 * MiB, WS_H2 = WS_A;
constexpr size_t WS_PROJ = WS_B, WS_AO = WS_B, WS_HH = WS_B, WS_Y = WS_B + 136 * MiB;
constexpr size_t WS_KC = WS_C, WS_VC = WS_C + 16 * MiB, WS_PE = WS_C + 32 * MiB, WS_KS = WS_C + 33 * MiB, WS_VS = WS_C + 49 * MiB,
                 WS_KW = WS_C + 65 * MiB, WS_VW = WS_C + 81 * MiB, WS_DQ = WS_C + 97 * MiB, WS_DK = WS_C + 161 * MiB, WS_DV = WS_C + 225 * MiB;
constexpr size_t WS_END = WS_C + 289 * MiB;
constexpr int CW_CNT = 0;
constexpr int CW_QDIFF = 64, CW_QNSA = 128;

constexpr int RING_BYTES = 131072;
constexpr int LDS_MISC = RING_BYTES;
constexpr int LDS_BYTES = 147456;

DI unsigned pk2(float lo, float hi) { typedef __bf16 b2 __attribute__((ext_vector_type(2))); f32x2 v = {lo, hi}; b2 b = __builtin_convertvector(v, b2); return __builtin_bit_cast(unsigned, b); }
DI unsigned short f2bf(float f) { return (unsigned short)(pk2(f, 0.f) & 0xffffu); }
DI float bf2f(unsigned short h) { return __uint_as_float((unsigned)h << 16); }
DI float bflo(unsigned w) { return __uint_as_float(w << 16); }
DI float bfhi(unsigned w) { return __uint_as_float(w & 0xffff0000u); }
DI float wave_sum(float v) {
#pragma unroll
    for (int o = 1; o < 64; o <<= 1) v += __shfl_xor(v, o);
    return v;
}
DI float fast_exp2(float x) { return __builtin_amdgcn_exp2f(x); }
DI float fast_rcp(float x) { return __builtin_amdgcn_rcpf(x); }
#define MFMA32(a, b, c) __builtin_amdgcn_mfma_f32_32x32x16_bf16((a), (b), (c), 0, 0, 0)
#define MFMA16(a, b, c) __builtin_amdgcn_mfma_f32_16x16x32_bf16((a), (b), (c), 0, 0, 0)
DI int crow(int r, int hi) { return (r & 3) + 8 * (r >> 2) + 4 * hi; }

struct Params { const float* in[27]; float* out; unsigned char* ws; int ph_lo, ph_hi; };

namespace pg8 {
constexpr int BM = 256, BK = 64, HALF = 128, HTB = HALF * BK * 2, STAGE_BYTES = 8 * HTB, NXCD = 8, WGM = 8;
DI int lds_byte(int r, int c) { const int st = (r >> 4) * 2 + (c >> 5), rr = r & 15, cc = c & 31, ob = rr * 64 + cc * 2; return st * 1024 + (ob ^ (((ob >> 9) & 1) << 5)); }
DI void stage_rc(int b, int& R, int& C) { const int st = b / 1024, sb = b % 1024, swz = sb ^ (((sb >> 9) & 1) << 5); R = (st >> 1) * 16 + swz / 64; C = (st & 1) * 32 + (swz % 64) / 2; }
DI int perm32(int rho) { const int n = rho >> 4, i = rho & 15; return 8 * (i >> 2) + 4 * n + (i & 3); }

struct Unit { int pm, pn, aux; const char* Ab; const char* Bb; const int* tok; };

template <class Epi, class Sched, bool GATHER>
DI void gemm_phase(LAS unsigned char* lds, LAS unsigned* tokl, const int K, const Sched& S, const Epi& E) {
    const int tid = threadIdx.x, wid = __builtin_amdgcn_readfirstlane(tid >> 6), lane = tid & 63, wr = wid >> 2, wc = wid & 3, fr = lane & 15, fq = lane >> 4;
    const int nt = K / BK;
    unsigned voffA[2], voffB[2]; int RA[2], CA[2];
#pragma unroll
    for (int i = 0; i < 2; ++i) { int R, C; stage_rc(tid * 16 + i * 8192, R, C); const int Rb = Epi::PERM ? ((R & ~31) + perm32(R & 31)) : R;
        voffA[i] = (unsigned)(R * K + C) * 2u; voffB[i] = (unsigned)(Rb * K + C) * 2u; RA[i] = R; CA[i] = C; }
    const size_t kstep = (size_t)(BK * 2);
    const size_t hstep = (size_t)HALF * K * 2;
    const unsigned ldsw = (unsigned)wid * 1024u;
    const int aoff = lds_byte(wr * 64 + fr, fq * 8), boff = lds_byte(wc * 32 + fr, fq * 8);
#define PG8_SA(b, h) (((b) * 2 + (h)) * HTB)
#define PG8_SB(b, h) ((4 + (b) * 2 + (h)) * HTB)
#define PG8_STG(bufoff, gbase, voff) do { _Pragma("unroll") for (int _i = 0; _i < 2; ++_i) \
        __builtin_amdgcn_global_load_lds((const unsigned*)((const char*)(gbase) + (voff)[_i]), (LAS unsigned*)(lds + (bufoff) + ldsw + _i * 8192), 16, 0, 0); } while (0)
#define PG8_STA(bufoff, gbase, h, vv) do { if constexpr (GATHER) { PG8_STG(bufoff, gbase, vv[h]); } else { PG8_STG(bufoff, (gbase) + (h) * hstep, voffA); } } while (0)
#define PG8_LDA(dst, b, h) do { _Pragma("unroll") for (int m = 0; m < 4; ++m) _Pragma("unroll") for (int k = 0; k < 2; ++k) dst[m][k] = *(const LAS bf16x8*)(lds + PG8_SA(b, h) + aoff + m * 2048 + k * 1024); } while (0)
#define PG8_LDB(dst, b, h) do { _Pragma("unroll") for (int n = 0; n < 2; ++n) _Pragma("unroll") for (int k = 0; k < 2; ++k) dst[n][k] = *(const LAS bf16x8*)(lds + PG8_SB(b, h) + boff + n * 2048 + k * 1024); } while (0)
#define PG8_MMA(ai, bj, At, Bt) do { __builtin_amdgcn_s_setprio(1); _Pragma("unroll") for (int m = 0; m < 4; ++m) _Pragma("unroll") for (int n = 0; n < 2; ++n) _Pragma("unroll") for (int k = 0; k < 2; ++k) \
        acc[ai][bj][m][n] = __builtin_amdgcn_mfma_f32_16x16x32_bf16(Bt[n][k], At[m][k], acc[ai][bj][m][n], 0, 0, 0); __builtin_amdgcn_s_setprio(0); } while (0)
#define PG8_WAIT_V(n) asm volatile("s_waitcnt vmcnt(" #n ")" ::: "memory")
#define PG8_WAIT_L(n) asm volatile("s_waitcnt lgkmcnt(" #n ")" ::: "memory")
#define PG8_BAR __builtin_amdgcn_s_barrier()
#define PG8_SCHED __builtin_amdgcn_sched_barrier(0)
    Unit cur, nxt; int ui = 0;
    if (!S.next(0, cur)) return;
    f32x4 acc[2][2][4][2];
#pragma unroll
    for (int a = 0; a < 2; ++a)
#pragma unroll
        for (int b = 0; b < 2; ++b)
#pragma unroll
            for (int m = 0; m < 4; ++m)
#pragma unroll
                for (int n = 0; n < 2; ++n) acc[a][b][m][n] = (f32x4){0.f, 0.f, 0.f, 0.f};
    bf16x8 At[4][2], B0[2][2], B1[2][2];
    const char* cA = cur.Ab; const char* cB = cur.Bb;
    unsigned cvo[2][2] = {{0u, 0u}, {0u, 0u}}, nvo[2][2] = {{0u, 0u}, {0u, 0u}};
    if constexpr (GATHER) {
        if (wid < 4) __builtin_amdgcn_global_load_lds((const unsigned*)(cur.tok + wid * 64 + lane), (LAS unsigned*)(tokl + wid * 64), 4, 0, 0);
        PG8_WAIT_V(0); PG8_BAR;
#pragma unroll
        for (int h = 0; h < 2; ++h)
#pragma unroll
            for (int i = 0; i < 2; ++i) cvo[h][i] = tokl[h * 128 + RA[i]] * (unsigned)(K * 2) + (unsigned)(CA[i] * 2);
        PG8_WAIT_L(0);
    }
    PG8_STG(PG8_SB(0, 0), cB, voffB); PG8_STG(PG8_SB(0, 1), cB + hstep, voffB); PG8_STA(PG8_SA(0, 0), cA, 0, cvo); PG8_STA(PG8_SA(0, 1), cA, 1, cvo);
    if (wr == 1) PG8_BAR;
    PG8_WAIT_V(2); PG8_BAR;
    PG8_STG(PG8_SB(1, 0), cB + kstep, voffB); PG8_STA(PG8_SA(1, 0), cA + kstep, 0, cvo); PG8_STG(PG8_SB(1, 1), cB + hstep + kstep, voffB);
    PG8_WAIT_V(6); PG8_BAR;
    for (;;) {
        const bool has_next = S.next(ui + 1, nxt);
        const char* nA = has_next ? nxt.Ab : cA; const char* nB = has_next ? nxt.Bb : cB;
        if constexpr (GATHER) {
            if (has_next && wid < 4) __builtin_amdgcn_global_load_lds((const unsigned*)(nxt.tok + wid * 64 + lane), (LAS unsigned*)(tokl + ((ui + 1) & 1) * 256 + wid * 64), 4, 0, 0);
        }
        for (int t = 0; t < nt; t += 2) {
            const bool last = (t == nt - 2);
            const char* a1 = cA + (size_t)(t + 1) * kstep;
            const char* a2 = last ? nA : cA + (size_t)(t + 2) * kstep; const char* b2 = last ? nB : cB + (size_t)(t + 2) * kstep;
            const char* a3 = a2 + kstep; const char* b3 = b2 + kstep;
            unsigned v2[2][2];
            if constexpr (GATHER) {
                if (last) {
                    if (has_next) {
#pragma unroll
                        for (int h = 0; h < 2; ++h)
#pragma unroll
                            for (int i = 0; i < 2; ++i) nvo[h][i] = tokl[((ui + 1) & 1) * 256 + h * 128 + RA[i]] * (unsigned)(K * 2) + (unsigned)(CA[i] * 2);
                    } else {
#pragma unroll
                        for (int h = 0; h < 2; ++h)
#pragma unroll
                            for (int i = 0; i < 2; ++i) nvo[h][i] = cvo[h][i];
                    }
                }
#pragma unroll
                for (int h = 0; h < 2; ++h)
#pragma unroll
                    for (int i = 0; i < 2; ++i) v2[h][i] = last ? nvo[h][i] : cvo[h][i];
            } else {
#pragma unroll
                for (int h = 0; h < 2; ++h)
#pragma unroll
                    for (int i = 0; i < 2; ++i) v2[h][i] = 0u;
            }
            PG8_LDB(B0, 0, 0); PG8_LDB(B1, 0, 1); PG8_SCHED; PG8_LDA(At, 0, 0); PG8_STA(PG8_SA(1, 1), a1, 1, cvo);
            PG8_WAIT_V(8); PG8_WAIT_L(0); PG8_BAR; PG8_MMA(0, 0, At, B0); PG8_MMA(0, 1, At, B1); PG8_BAR; PG8_SCHED;
            PG8_LDA(At, 0, 1); PG8_STG(PG8_SB(0, 0), b2, voffB); PG8_STG(PG8_SB(0, 1), b2 + hstep, voffB); PG8_STA(PG8_SA(0, 0), a2, 0, v2);
            PG8_WAIT_V(8); PG8_WAIT_L(0); PG8_BAR; PG8_MMA(1, 0, At, B0); PG8_MMA(1, 1, At, B1); PG8_BAR; PG8_SCHED;
            PG8_LDB(B0, 1, 0); PG8_LDB(B1, 1, 1); PG8_SCHED; PG8_LDA(At, 1, 0); PG8_STA(PG8_SA(0, 1), a2, 1, v2);
            PG8_WAIT_V(8); PG8_WAIT_L(0); PG8_BAR; PG8_MMA(0, 0, At, B0); PG8_MMA(0, 1, At, B1); PG8_BAR; PG8_SCHED;
            PG8_LDA(At, 1, 1); PG8_STG(PG8_SB(1, 0), b3, voffB); PG8_STG(PG8_SB(1, 1), b3 + hstep, voffB); PG8_STA(PG8_SA(1, 0), a3, 0, v2);
            PG8_WAIT_V(8); PG8_WAIT_L(0); PG8_BAR; PG8_MMA(1, 0, At, B0); PG8_MMA(1, 1, At, B1); PG8_BAR; PG8_SCHED;
        }
        if (wr == 0) PG8_BAR;
        E(acc, cur, wr, wc, fr, fq);
        if (!has_next) break;
#pragma unroll
        for (int a = 0; a < 2; ++a)
#pragma unroll
            for (int b = 0; b < 2; ++b)
#pragma unroll
                for (int m = 0; m < 4; ++m)
#pragma unroll
                    for (int n = 0; n < 2; ++n) acc[a][b][m][n] = (f32x4){0.f, 0.f, 0.f, 0.f};
        cur = nxt; cA = nA; cB = nB; ++ui;
        if constexpr (GATHER) {
#pragma unroll
            for (int h = 0; h < 2; ++h)
#pragma unroll
                for (int i = 0; i < 2; ++i) cvo[h][i] = nvo[h][i];
        }
        if (wr == 1) PG8_BAR;
    }
    PG8_WAIT_V(0);
    PG8_BAR;
#undef PG8_SA
#undef PG8_SB
#undef PG8_STG
#undef PG8_STA
#undef PG8_LDA
#undef PG8_LDB
#undef PG8_MMA
#undef PG8_WAIT_V
#undef PG8_WAIT_L
#undef PG8_BAR
#undef PG8_SCHED
}

struct StaticOrder {
    int nM, nN, nwg, G, c; const char* A; const char* Bt; size_t tstep;
    DI void init(int M, int N, int K, int G_, int c_, const void* A_, const void* Bt_) { nM = M / BM; nN = N / BM; nwg = nM * nN; G = G_; c = c_; A = (const char*)A_; Bt = (const char*)Bt_; tstep = (size_t)BM * K * 2; }
    DI bool next(int i, Unit& u) const {
        const long L = (long)i * G + c; if (L >= nwg) return false;
        int wgid = (int)L; { const int q = nwg / NXCD, r = nwg % NXCD, xcd = wgid % NXCD, off = wgid / NXCD; wgid = (xcd < r ? xcd * (q + 1) : r * (q + 1) + (xcd - r) * q) + off; }
        const int nig = WGM * nN, gid = wgid / nig, fm = gid * WGM, gsz = (nM - fm) < WGM ? (nM - fm) : WGM;
        u.pm = fm + ((wgid % nig) % gsz); u.pn = (wgid % nig) / gsz; u.aux = 0; u.Ab = A + (size_t)u.pm * tstep; u.Bb = Bt + (size_t)u.pn * tstep; u.tok = nullptr; return true;
    }
};
struct CompressOrder {
    int G, c; const char* KC; const char* PE; const char* W;
    DI bool next(int i, Unit& u) const {
        const int L = i * G + c; if (L >= 132) return false;
        u.pm = L >> 1; u.pn = L & 1; const int kv = u.pm < 32 ? 0 : (u.pm < 64 ? 1 : u.pm - 64); u.aux = kv;
        u.Ab = u.pm < 64 ? KC + (size_t)u.pm * (256 * 1024 * 2) : PE; u.Bb = W + (size_t)kv * (512 * 1024 * 2) + (size_t)u.pn * (256 * 1024 * 2); u.tok = nullptr; return true;
    }
};
struct MoeOrder {
    int G, c, mode; const LAS int* tb; const char* A; const char* W; const int* lists;
    DI bool next(int i, Unit& u) const {
        const int L = i * G + c; const int mt = L >> 2; if (mt >= tb[32]) return false;
        int e = 0;
#pragma unroll 1
        for (int j = 1; j < 32; ++j) e += (tb[j] <= mt) ? 1 : 0;
        u.pm = mt; u.pn = L & 3; u.aux = e;
        if (mode == 0) { u.Ab = A; u.Bb = W + (size_t)e * (1024 * 1024 * 2) + (size_t)u.pn * (256 * 1024 * 2); u.tok = lists + (size_t)e * ECAP + (size_t)(mt - tb[e]) * 256; }
        else { u.Ab = A + (size_t)mt * (256 * 512 * 2); u.Bb = W + (size_t)e * (1024 * 512 * 2) + (size_t)u.pn * (256 * 512 * 2); u.tok = nullptr; }
        return true;
    }
};

struct EpiBf16 {
    static constexpr bool PERM = true;
    bf16_t* O; int ldc;
    DI void operator()(const f32x4 (&acc)[2][2][4][2], const Unit& u, int wr, int wc, int fr, int fq) const {
        const int row0 = u.pm * BM + wr * 64 + fr; const int col0 = u.pn * BM + wc * 32 + 8 * fq;
#pragma unroll
        for (int ai = 0; ai < 2; ++ai)
#pragma unroll
            for (int m = 0; m < 4; ++m) { bf16_t* rowp = O + (size_t)(row0 + ai * HALF + m * 16) * ldc + col0;
#pragma unroll
                for (int bj = 0; bj < 2; ++bj) { const f32x4 v0 = acc[ai][bj][m][0], v1 = acc[ai][bj][m][1];
                    u32x4 w; w.x = pk2(v0[0], v0[1]); w.y = pk2(v0[2], v0[3]); w.z = pk2(v1[0], v1[1]); w.w = pk2(v1[2], v1[3]);
                    *(u32x4*)(rowp + bj * HALF) = w; } }
    }
};
struct EpiSwiglu {
    static constexpr bool PERM = true;
    bf16_t* O;
    DI void operator()(const f32x4 (&acc)[2][2][4][2], const Unit& u, int wr, int wc, int fr, int fq) const {
        const int row0 = u.pm * BM + wr * 64 + fr; const int col0 = u.pn * 128 + wc * 16 + 4 * fq;
#pragma unroll
        for (int ai = 0; ai < 2; ++ai)
#pragma unroll
            for (int m = 0; m < 4; ++m) { bf16_t* rowp = O + (size_t)(row0 + ai * HALF + m * 16) * EHID + col0;
#pragma unroll
                for (int bj = 0; bj < 2; ++bj) { const f32x4 g = acc[ai][bj][m][0], up = acc[ai][bj][m][1]; float h[4];
#pragma unroll
                    for (int i = 0; i < 4; ++i) { const float s = fast_rcp(1.f + __expf(-g[i])); h[i] = g[i] * s * up[i]; }
                    u32x2 w; w.x = pk2(h[0], h[1]); w.y = pk2(h[2], h[3]);
                    *(u32x2*)(rowp + bj * 64) = w; } }
    }
};
struct EpiOutProj {
    static constexpr bool PERM = false;
    const float* x; float* out; const float* mod; float* rowss;
    DI void operator()(const f32x4 (&acc)[2][2][4][2], const Unit& u, int wr, int wc, int fr, int fq) const {
        const int col0 = u.pn * BM + wc * 32 + 4 * fq; const int b = (u.pm * BM) / SEQ;
        const float* g1 = mod + (size_t)b * 6144 + 2048 + col0;
        f32x4 gv[2][2];
#pragma unroll
        for (int bj = 0; bj < 2; ++bj)
#pragma unroll
            for (int n = 0; n < 2; ++n) gv[bj][n] = *(const f32x4*)(g1 + bj * HALF + n * 16);
#pragma unroll
        for (int ai = 0; ai < 2; ++ai)
#pragma unroll
            for (int m = 0; m < 4; ++m) { const int r = u.pm * BM + ai * HALF + wr * 64 + m * 16 + fr; const size_t off = (size_t)r * DM + col0; float ss = 0.f;
#pragma unroll
                for (int bj = 0; bj < 2; ++bj)
#pragma unroll
                    for (int n = 0; n < 2; ++n) { const f32x4 xv = *(const f32x4*)(x + off + bj * HALF + n * 16); const f32x4 o = xv + gv[bj][n] * acc[ai][bj][m][n];
                        ss += (o[0] * o[0] + o[1] * o[1]) + (o[2] * o[2] + o[3] * o[3]); *(f32x4*)(out + off + bj * HALF + n * 16) = o; }
                ss += __shfl_xor(ss, 16); ss += __shfl_xor(ss, 32);
                if (fq == 0) rowss[(size_t)r * 16 + u.pn * 4 + wc] = ss; }
    }
};
}

struct Frame {
    LAS unsigned char* lds; unsigned char* ws; const float* const* in; float* out;
    int tid, lane, wave, bid, G, gw, NGW;
};

DI int origcol(int n) { return n < 1280 ? n : (n < 2816 ? n + 24 : (n < 2840 ? n - 2816 + 1280 : -1)); }

template <class DRow>
DI void tr_item(const float* src, int src_ld, int sc  , bf16_t* dst, int dst_ld, int k0, LAS float* scr, int lane, DRow drow) {
#pragma unroll 8
    for (int i = 0; i < 32; ++i) { const int kk = 2 * i + (lane >> 5); scr[kk * 33 + (lane & 31)] = sc >= 0 ? src[(size_t)(k0 + kk) * src_ld + sc] : 0.f; }
    asm volatile("s_waitcnt lgkmcnt(0)" ::: "memory");
    const int c = lane & 7;
#pragma unroll
    for (int j = 0; j < 4; ++j) { const int n = (lane >> 3) + 8 * j; const LAS float* s = scr + (8 * c) * 33 + n;
        u32x4 o; o.x = pk2(s[0 * 33], s[1 * 33]); o.y = pk2(s[2 * 33], s[3 * 33]); o.z = pk2(s[4 * 33], s[5 * 33]); o.w = pk2(s[6 * 33], s[7 * 33]);
        *(u32x4*)(dst + (size_t)drow(n) * dst_ld + k0 + 8 * c) = o; }
    asm volatile("s_waitcnt lgkmcnt(0)" ::: "memory");
}

DI void phase0(Frame& F) {
    const float* c_in = F.in[1]; const float* w_ada = F.in[2]; const float* b_ada = F.in[3];
    float* mod = (float*)(F.ws + WS_MOD);
    for (int it = F.bid; it < 96; it += F.G) {
        LAS float* cs = (LAS float*)F.lds;
        for (int idx = F.tid; idx < 32 * 1024; idx += NTHREADS) { const int b = idx >> 10, k = idx & 1023; cs[k * 32 + b] = c_in[idx]; }
        __syncthreads();
        float acc[32];
#pragma unroll
        for (int b = 0; b < 32; ++b) acc[b] = 0.f;
        const int j = it * 64 + F.lane;
        for (int kk = 0; kk < 128; ++kk) { const int k = F.wave * 128 + kk; const float w = w_ada[(size_t)k * 6144 + j];
#pragma unroll
            for (int b4 = 0; b4 < 8; ++b4) { const f32x4 cv = *(const LAS f32x4*)(cs + k * 32 + b4 * 4); acc[b4 * 4 + 0] += cv[0] * w; acc[b4 * 4 + 1] += cv[1] * w; acc[b4 * 4 + 2] += cv[2] * w; acc[b4 * 4 + 3] += cv[3] * w; } }
        __syncthreads();
        LAS float* red = (LAS float*)F.lds;
#pragma unroll
        for (int b = 0; b < 32; ++b) red[(F.wave * 32 + b) * 64 + F.lane] = acc[b];
        __syncthreads();
        for (int o = F.tid; o < 2048; o += NTHREADS) { const int b = o >> 6, l = o & 63; float s = b_ada[it * 64 + l];
#pragma unroll
            for (int w = 0; w < 8; ++w) s += red[(w * 32 + b) * 64 + l];
            mod[(size_t)b * 6144 + it * 64 + l] = s; }
        __syncthreads();
    }
    LAS float* scr = (LAS float*)(F.lds + F.wave * 16384);
    const int lane = F.lane;
    constexpr int I_IN = 16 * 96, I_OUT = 16 * 32, I_G = 32 * 16 * 16, I_D = 32 * 8 * 32, I_C = 4 * 16 * 8;
    constexpr int NITEMS = I_IN + I_OUT + 2 * I_G + I_D + I_C;
    for (int it = F.gw; it < NITEMS; it += F.NGW) {
        int r = it;
        if (r < I_IN) { const int kb = r / 96, nb = r % 96, n0 = nb * 32; const int sc = origcol(n0 + (lane & 31));
            tr_item(F.in[6], INCOLS, sc, (bf16_t*)(F.ws + WS_WIN), 1024, kb * 64, scr, lane, [=](int n) { return n0 + n; }); continue; }
        r -= I_IN;
        if (r < I_OUT) { const int kb = r / 32, nb = r % 32, n0 = nb * 32;
            tr_item(F.in[19], 1024, n0 + (lane & 31), (bf16_t*)(F.ws + WS_WOUT), 1024, kb * 64, scr, lane, [=](int n) { return n0 + n; }); continue; }
        r -= I_OUT;
        if (r < 2 * I_G) { const int up = r / I_G; r -= up * I_G; const int e = r / 256, q = r % 256, kb = q / 16, nb = q % 16, n0 = nb * 32;
            const float* src = F.in[24 + up] + (size_t)e * 1024 * 512;
            tr_item(src, 512, n0 + (lane & 31), (bf16_t*)(F.ws + WS_WGU) + (size_t)e * 1024 * 1024, 1024, kb * 64, scr, lane, [=](int n) { const int j = n0 + n; return 8 * (j >> 2) + (j & 3) + 4 * up; }); continue; }
        r -= 2 * I_G;
        if (r < I_D) { const int e = r / 256, q = r % 256, kb = q / 32, nb = q % 32, n0 = nb * 32;
            const float* src = F.in[26] + (size_t)e * 512 * 1024;
            tr_item(src, 1024, n0 + (lane & 31), (bf16_t*)(F.ws + WS_WD) + (size_t)e * 1024 * 512, 512, kb * 64, scr, lane, [=](int n) { return n0 + n; }); continue; }
        r -= I_D;
        { const int kvh = r / 128, q = r % 128, kb = q / 8, nb = q % 8, n0 = nb * 32; const int kv = kvh >> 1, half = kvh & 1;
            const float* src = F.in[10] + (size_t)kv * 2048 * 256 + (size_t)half * 1024 * 256;
            tr_item(src, 256, n0 + (lane & 31), (bf16_t*)(F.ws + WS_WC1) + (size_t)kv * 512 * 1024, 1024, kb * 64, scr, lane, [=](int n) { return half * 256 + n0 + n; }); }
    }
    const int gt = F.bid * NTHREADS + F.tid, NGT = F.G * NTHREADS;
    { float* ropeN = (float*)(F.ws + WS_ROPE); float* ropeD = ropeN + 2048 * 16;
      for (int i = gt; i < 2048 * 12; i += NGT) { const int t = i / 12, j = i % 12; const bool isn = j < 8; const int ii = isn ? j : j - 8;
          const float ex = isn ? (float)(2 * ii) / 16.f : (float)(2 * ii) / 8.f;
          const float inv = exp2f(-ex * 18.931568569324174f);
          const float ang = (float)t * inv;
          const double rev = (double)ang * 0.15915494309189535; const double fr = rev - __builtin_rint(rev); const float rr = (float)(fr * 6.283185307179586);
          const float cs = __cosf(rr), sn = __sinf(rr);
          if (isn) { ropeN[(t * 8 + ii) * 2] = cs; ropeN[(t * 8 + ii) * 2 + 1] = sn; } else { ropeD[(t * 4 + ii) * 2] = cs; ropeD[(t * 4 + ii) * 2 + 1] = sn; } } }
    { bf16_t* whi = (bf16_t*)(F.ws + WS_WR); bf16_t* wlo = whi + 48 * 1024;
      for (int i = gt; i < 48 * 1024; i += NGT) { const int c = i >> 10, k = i & 1023; float w = 0.f;
          if (c < 4) w = F.in[20][k * 4 + c]; else if (c < 36) w = F.in[22][k * 32 + (c - 4)];
          const unsigned short h = f2bf(w); whi[i] = h; wlo[i] = f2bf(w - bf2f(h)); } }
    { bf16_t* pe = (bf16_t*)(F.ws + WS_PE);
      for (int i = gt; i < 256 * 1024; i += NGT) { const int r = i >> 10, k = i & 1023; float v = 0.f; if (r < 4) v = F.in[9][(r >> 1) * 2048 + (r & 1) * 1024 + k]; pe[i] = f2bf(v); } }
    { u32x4* l4 = (u32x4*)(F.ws + WS_LIST); for (int i = gt; i < (int)(NEXP * ECAP / 4); i += NGT) l4[i] = (u32x4){0u, 0u, 0u, 0u};
      unsigned* ctl = (unsigned*)(F.ws + WS_CTL); for (int i = gt; i < 1024; i += NGT) ctl[i] = 0u; }
}

DI void phase1(Frame& F) {
    const float* x = F.in[0]; const float* g = F.in[4]; const float* mod = (const float*)(F.ws + WS_MOD); bf16_t* h1 = (bf16_t*)(F.ws + WS_H1);
    for (int m = F.gw; m < TOK; m += F.NGW) {
        const int b = m >> 11; const f32x4* xr = (const f32x4*)(x + (size_t)m * DM) + F.lane;
        f32x4 v[4]; float s = 0.f;
#pragma unroll
        for (int j = 0; j < 4; ++j) { v[j] = xr[64 * j]; s += (v[j][0] * v[j][0] + v[j][1] * v[j][1]) + (v[j][2] * v[j][2] + v[j][3] * v[j][3]); }
        const float rstd = rsqrtf(wave_sum(s) * (1.f / DM) + EPS);
        const float* sh = mod + (size_t)b * 6144; const float* sc = sh + 1024;
        u32x2* o8 = (u32x2*)(h1 + (size_t)m * DM) + F.lane;
#pragma unroll
        for (int j = 0; j < 4; ++j) { const int col = 4 * F.lane + 256 * j; const f32x4 gv = *(const f32x4*)(g + col), sv = *(const f32x4*)(sc + col), hv = *(const f32x4*)(sh + col);
            f32x4 y = v[j] * rstd * gv * (sv + 1.f) + hv; u32x2 w; w.x = pk2(y[0], y[1]); w.y = pk2(y[2], y[3]); o8[64 * j] = w; }
    }
}

DI void phase3(Frame& F) {
    const bf16_t* proj = (const bf16_t*)(F.ws + WS_PROJ);
    const float* ropeN = (const float*)(F.ws + WS_ROPE); const float* ropeD = ropeN + 2048 * 16;
    const float* g_nq = F.in[7]; const float* g_nk = F.in[8]; const float* g_dq = F.in[12]; const float* g_dk = F.in[13];
    const int lane = F.lane;
    for (int it = F.gw; it < TOK * 6; it += F.NGW) {
        const int m = it / 6, part = it % 6; const int b = m >> 11, t = m & 2047;
        const int c0 = part * 512 + lane * 8;
        const u32x4 raw = *(const u32x4*)(proj + (size_t)m * NPROJ + c0);
        float v[8]; v[0] = bflo(raw.x); v[1] = bfhi(raw.x); v[2] = bflo(raw.y); v[3] = bfhi(raw.y); v[4] = bflo(raw.z); v[5] = bfhi(raw.z); v[6] = bflo(raw.w); v[7] = bfhi(raw.w);
        float ss = 0.f;
#pragma unroll
        for (int i = 0; i < 8; ++i) ss += v[i] * v[i];
        ss += __shfl_xor(ss, 1); ss += __shfl_xor(ss, 2); const float ss32 = ss; ss += __shfl_xor(ss, 4); const float ss64 = ss;
        float pv[8];
#pragma unroll
        for (int i = 0; i < 8; ++i) pv[i] = __shfl_xor(v[i], 1);
        if (c0 < 1280) {
            const bool isq = c0 < 512; int six = 0, gsel = 0, d0;
            if (isq) { d0 = c0 & 63; } else { const int cc = c0 - 512; six = cc >> 7; gsel = (cc >> 6) & 1; d0 = cc & 63; }
            const bool donorm = isq || six == 2 || six == 4;
            float y[8];
            if (donorm) { const float* gg = isq ? g_nq : (g_nk + (six == 2 ? 64 : 128)); const float rstd = rsqrtf(ss64 * (1.f / 64.f) + EPS);
#pragma unroll
                for (int i = 0; i < 8; ++i) { y[i] = v[i] * rstd * gg[d0 + i]; pv[i] = pv[i] * rstd * gg[(d0 ^ 8) + i]; } }
            else {
#pragma unroll
                for (int i = 0; i < 8; ++i) y[i] = v[i]; }
            float yr[8];
#pragma unroll
            for (int i = 0; i < 8; ++i) yr[i] = y[i];
            if (donorm && d0 < 16) {
#pragma unroll
                for (int i = 0; i < 8; ++i) { const float cs = ropeN[(t * 8 + i) * 2], sn = ropeN[(t * 8 + i) * 2 + 1];
                    yr[i] = d0 == 0 ? (y[i] * cs - pv[i] * sn) : (pv[i] * sn + y[i] * cs); }
            }
            u32x4 w0, w1; w0.x = pk2(y[0], y[1]); w0.y = pk2(y[2], y[3]); w0.z = pk2(y[4], y[5]); w0.w = pk2(y[6], y[7]);
            w1.x = pk2(yr[0], yr[1]); w1.y = pk2(yr[2], yr[3]); w1.z = pk2(yr[4], yr[5]); w1.w = pk2(yr[6], yr[7]);
            if (isq) { const int hd = c0 >> 6; const size_t off = (((size_t)b * 8 + hd) * SEQ + t) * 64 + d0;
                *(u32x4*)((bf16_t*)(F.ws + WS_QN) + off) = w0; *(u32x4*)((bf16_t*)(F.ws + WS_QR) + off) = w1; }
            else { const size_t base = six == 0 ? WS_KC : six == 1 ? WS_VC : six == 2 ? WS_KS : six == 3 ? WS_VS : six == 4 ? WS_KW : WS_VW;
                const size_t off = (((size_t)b * 2 + gsel) * SEQ + t) * 64 + d0;
                *(u32x4*)((bf16_t*)(F.ws + base) + off) = donorm ? w1 : w0; }
        } else if (c0 < 2304) {
            const bool isq = c0 < 1792; const int cc = c0 - (isq ? 1280 : 1792); const int hd = cc >> 6, dd = cc & 63, d0 = dd & 31;
            const float* gg = isq ? g_dq : g_dk; const float rstd = rsqrtf(ss32 * (1.f / 32.f) + EPS);
            float y[8];
#pragma unroll
            for (int i = 0; i < 8; ++i) y[i] = v[i] * rstd * gg[d0 + i];
            if (d0 == 0) {
#pragma unroll
                for (int i = 0; i < 4; ++i) { const float cs = ropeD[(t * 4 + i) * 2], sn = ropeD[(t * 4 + i) * 2 + 1]; const float a = y[i], bb = y[i + 4]; y[i] = a * cs - bb * sn; y[i + 4] = a * sn + bb * cs; }
            }
            u32x4 w; w.x = pk2(y[0], y[1]); w.y = pk2(y[2], y[3]); w.z = pk2(y[4], y[5]); w.w = pk2(y[6], y[7]);
            const size_t off = (((size_t)b * 8 + hd) * SEQ + t) * 64 + dd;
            *(u32x4*)((bf16_t*)(F.ws + (isq ? WS_DQ : WS_DK)) + off) = w;
        } else if (c0 < 2816) {
            const int cc = c0 - 2304; const int hd = cc >> 6, dd = cc & 63; const size_t off = (((size_t)b * 8 + hd) * SEQ + t) * 64 + dd;
            *(u32x4*)((bf16_t*)(F.ws + WS_DV) + off) = raw;
        } else if (c0 < 2840) {
            float* gt = (float*)(F.ws + WS_GATES) + (size_t)m * 24 + (c0 - 2816);
#pragma unroll
            for (int i = 0; i < 8; ++i) gt[i] = 1.f / (1.f + __expf(-v[i]));
        }
    }
}

DI int kswz(int row, int ch) { return row * 128 + ((ch ^ (row & 7)) << 4); }
DI s16x4 vtr(const LAS char* p) { typedef short v4i16 __attribute__((ext_vector_type(4))); return __builtin_bit_cast(s16x4, __builtin_amdgcn_ds_read_tr16_b64_v4i16((LAS v4i16*)p)); }
DI bf16x8 vfrag(const LAS char* Vt, int db, int kb, int s, int lane) {
    const int g = lane >> 4, hh = g >> 1, i = lane & 15; const int k0 = 32 * kb + 16 * s + 4 * hh + (i >> 2), d0 = 32 * db + 16 * (g & 1) + 4 * (i & 3);
    const s16x4 lo = vtr(Vt + k0 * 128 + d0 * 2), hi = vtr(Vt + (k0 + 8) * 128 + d0 * 2);
    return __builtin_shufflevector(lo, hi, 0, 1, 2, 3, 4, 5, 6, 7);
}
DI bf16x8 pfrag(const f32x16& p, int s) { u32x4 w; w.x = pk2(p[8 * s + 0], p[8 * s + 1]); w.y = pk2(p[8 * s + 2], p[8 * s + 3]); w.z = pk2(p[8 * s + 4], p[8 * s + 5]); w.w = pk2(p[8 * s + 6], p[8 * s + 7]); return __builtin_bit_cast(bf16x8, w); }
DI u32x4 tile_ld(const bf16_t* g, int tid) { return *(const u32x4*)(g + tid * 8); }
DI void tile_st_k(LAS char* Kt, u32x4 v, int tid) { *(LAS u32x4*)(Kt + kswz(tid >> 3, tid & 7)) = v; }
DI void tile_st_v(LAS char* Vt, u32x4 v, int tid) { *(LAS u32x4*)(Vt + tid * 16) = v; }

template <class MaskF>
DI void attn_tile64(const LAS char* Kt, const LAS char* Vt, const bf16x8 (&qf)[4], f32x16 (&O)[2], float& lsum, float c2, float mc, int lane, MaskF mask, f32x16 (&P)[2]) {
    const int r = lane & 31, hh = lane >> 5;
#pragma unroll
    for (int kb = 0; kb < 2; ++kb) {
        f32x16 acc = {0.f, 0.f, 0.f, 0.f, 0.f, 0.f, 0.f, 0.f, 0.f, 0.f, 0.f, 0.f, 0.f, 0.f, 0.f, 0.f};
#pragma unroll
        for (int ks = 0; ks < 4; ++ks) { const bf16x8 kf = *(const LAS bf16x8*)(Kt + kswz(32 * kb + r, 2 * ks + hh)); acc = MFMA32(kf, qf[ks], acc); }
#pragma unroll
        for (int i = 0; i < 16; ++i) { const float p = mask(kb, i) ? fast_exp2(acc[i] * c2 - mc) : 0.f; acc[i] = p; lsum += p; }
        P[kb] = acc;
    }
#pragma unroll
    for (int kb = 0; kb < 2; ++kb)
#pragma unroll
        for (int s = 0; s < 2; ++s) { const bf16x8 pf = pfrag(P[kb], s);
#pragma unroll
            for (int db = 0; db < 2; ++db) O[db] = MFMA32(vfrag(Vt, db, kb, s, lane), pf, O[db]); }
}

DI void diff_unit(Frame& F, int b, int hd, int qb, float c2, float mc, float lam) {
    const int tid = F.tid, lane = F.lane, wid = F.wave, r = lane & 31, hh = lane >> 5;
    const bf16_t* Q = (const bf16_t*)(F.ws + WS_DQ) + ((size_t)b * 8 + hd) * SEQ * 64;
    const bf16_t* Kg = (const bf16_t*)(F.ws + WS_DK) + ((size_t)b * 8 + hd) * SEQ * 64;
    const bf16_t* Vg = (const bf16_t*)(F.ws + WS_DV) + ((size_t)b * 8 + hd) * SEQ * 64;
    LAS char* lds = (LAS char*)F.lds;
    const int q0w = qb * 256 + wid * 32; const int qq = q0w + r;
    bf16x8 qf[2][2];
#pragma unroll
    for (int m = 0; m < 2; ++m)
#pragma unroll
        for (int ks = 0; ks < 2; ++ks) qf[m][ks] = *(const bf16x8*)(Q + (size_t)qq * 64 + m * 32 + ks * 16 + hh * 8);
    f32x16 O0[2], O1[2];
#pragma unroll
    for (int db = 0; db < 2; ++db)
#pragma unroll
        for (int i = 0; i < 16; ++i) { O0[db][i] = 0.f; O1[db][i] = 0.f; }
    float l0 = 0.f, l1 = 0.f;
    const int ntile = 4 * qb + 4; const int jmax = 4 * qb + (wid >> 1);
    u32x4 kreg = tile_ld(Kg, tid), vreg = tile_ld(Vg, tid);
    tile_st_k(lds, kreg, tid); tile_st_v(lds + 8192, vreg, tid);
    __syncthreads();
    for (int j = 0; j < ntile; ++j) {
        const int cur = j & 1; LAS char* Kt = lds + cur * 16384; LAS char* Vt = Kt + 8192;
        if (j + 1 < ntile) { kreg = tile_ld(Kg + (size_t)(j + 1) * 4096, tid); vreg = tile_ld(Vg + (size_t)(j + 1) * 4096, tid); }
        if (j <= jmax) {
            const bool diag = (j == jmax);
            f32x16 P0[2], P1[2];
#pragma unroll
            for (int kb = 0; kb < 2; ++kb) {
                f32x16 a0 = {0.f, 0.f, 0.f, 0.f, 0.f, 0.f, 0.f, 0.f, 0.f, 0.f, 0.f, 0.f, 0.f, 0.f, 0.f, 0.f}, a1 = a0;
#pragma unroll
                for (int ks = 0; ks < 2; ++ks) {
                    const bf16x8 k0 = *(const LAS bf16x8*)(Kt + kswz(32 * kb + r, 2 * ks + hh));
                    const bf16x8 k1 = *(const LAS bf16x8*)(Kt + kswz(32 * kb + r, 4 + 2 * ks + hh));
                    a0 = MFMA32(k0, qf[0][ks], a0); a1 = MFMA32(k1, qf[1][ks], a1); }
#pragma unroll
                for (int i = 0; i < 16; ++i) { const int key = 64 * j + 32 * kb + crow(i, hh); const bool ok = !diag || key <= qq;
                    const float p0 = ok ? fast_exp2(a0[i] * c2 - mc) : 0.f, p1 = ok ? fast_exp2(a1[i] * c2 - mc) : 0.f; a0[i] = p0; a1[i] = p1; l0 += p0; l1 += p1; }
                P0[kb] = a0; P1[kb] = a1;
            }
#pragma unroll
            for (int kb = 0; kb < 2; ++kb)
#pragma unroll
                for (int s = 0; s < 2; ++s) { const bf16x8 pf0 = pfrag(P0[kb], s), pf1 = pfrag(P1[kb], s);
#pragma unroll
                    for (int db = 0; db < 2; ++db) { const bf16x8 vf = vfrag(Vt, db, kb, s, lane); O0[db] = MFMA32(vf, pf0, O0[db]); O1[db] = MFMA32(vf, pf1, O1[db]); } }
        }
        if (j + 1 < ntile) { LAS char* Kn = lds + (cur ^ 1) * 16384; tile_st_k(Kn, kreg, tid); tile_st_v(Kn + 8192, vreg, tid); }
        __syncthreads();
    }
    l0 += __shfl_xor(l0, 32); l1 += __shfl_xor(l1, 32);
    const float i0 = 1.f / l0, i1 = lam / l1;
    float ss = 0.f;
#pragma unroll
    for (int db = 0; db < 2; ++db)
#pragma unroll
        for (int i = 0; i < 16; ++i) { const float o = O0[db][i] * i0 - O1[db][i] * i1; O0[db][i] = o; ss += o * o; }
    ss += __shfl_xor(ss, 32);
    const float rstd = rsqrtf(ss * (1.f / 64.f) + EPS) * 0.8f;
    const float* go = F.in[18];
    bf16_t* orow = (bf16_t*)(F.ws + WS_AO) + ((size_t)b * SEQ + qq) * DM + 512 + hd * 64;
#pragma unroll
    for (int db = 0; db < 2; ++db)
#pragma unroll
        for (int g4 = 0; g4 < 4; ++g4) { const int d = 32 * db + 8 * g4 + 4 * hh; const f32x4 gv = *(const f32x4*)(go + d);
            u32x2 w; w.x = pk2(O0[db][4 * g4] * rstd * gv[0], O0[db][4 * g4 + 1] * rstd * gv[1]); w.y = pk2(O0[db][4 * g4 + 2] * rstd * gv[2], O0[db][4 * g4 + 3] * rstd * gv[3]);
            *(u32x2*)(orow + d) = w; }
}

template <class MaskF>
DI void nsa_tiles(LAS char* lds, const bf16_t* Kg, const bf16_t* Vg, unsigned tiles, const bf16x8 (&qf)[4], f32x16 (&O)[2], float& lsum, float c2, float mc, int tid, int lane, MaskF maskf) {
    if (tiles == 0u) return;
    int j = __builtin_ctz(tiles); tiles &= tiles - 1u; int cur = 0;
    u32x4 kreg = tile_ld(Kg + (size_t)j * 4096, tid), vreg = tile_ld(Vg + (size_t)j * 4096, tid);
    tile_st_k(lds, kreg, tid); tile_st_v(lds + 8192, vreg, tid);
    __syncthreads();
    for (;;) {
        const int jn = tiles ? __builtin_ctz(tiles) : -1; tiles &= tiles - 1u;
        if (jn >= 0) { kreg = tile_ld(Kg + (size_t)jn * 4096, tid); vreg = tile_ld(Vg + (size_t)jn * 4096, tid); }
        LAS char* Kt = lds + cur * 16384;
        bool any = false;
#pragma unroll
        for (int kb = 0; kb < 2; ++kb)
#pragma unroll
            for (int i = 0; i < 16; ++i) any |= maskf(j, kb, i);
        if (__ballot(any) != 0ull) { f32x16 P[2]; attn_tile64(Kt, Kt + 8192, qf, O, lsum, c2, mc, lane, [&](int kb, int i) { return maskf(j, kb, i); }, P); }
        if (jn < 0) break;
        { LAS char* Kn = lds + (cur ^ 1) * 16384; tile_st_k(Kn, kreg, tid); tile_st_v(Kn + 8192, vreg, tid); }
        __syncthreads();
        j = jn; cur ^= 1;
    }
    __syncthreads();
}

DI void nsa_unit(Frame& F, int b, int g, int qb, float c2, float mc) {
    const int tid = F.tid, lane = F.lane, wid = F.wave, r = lane & 31, hh = lane >> 5;
    const int hd = 4 * g + (wid >> 1); const int tl = 32 * (wid & 1) + r; const int t = 64 * qb + tl;
    LAS char* lds = (LAS char*)F.lds;
    LAS float* impP = (LAS float*)(lds + 65536);
    LAS unsigned* selm = (LAS unsigned*)(lds + 65536 + 32768);
    const size_t bg = (size_t)b * 2 + g;
    const bf16_t* QN = (const bf16_t*)(F.ws + WS_QN) + (((size_t)b * 8 + hd) * SEQ + t) * 64;
    const bf16_t* QR = (const bf16_t*)(F.ws + WS_QR) + (((size_t)b * 8 + hd) * SEQ + t) * 64;
    const float* gates = (const float*)(F.ws + WS_GATES) + ((size_t)b * SEQ + t) * 24 + hd * 3;
    const float g0 = gates[0], g1 = gates[1], g2 = gates[2];
    bf16x8 qf[4];
    f32x16 OT[2], O[2];
#pragma unroll
    for (int db = 0; db < 2; ++db)
#pragma unroll
        for (int i = 0; i < 16; ++i) { OT[db][i] = 0.f; O[db][i] = 0.f; }
    {
        const bf16_t* Kc = (const bf16_t*)(F.ws + WS_KCMP) + bg * 128 * 64; const bf16_t* Vc = (const bf16_t*)(F.ws + WS_VCMP) + bg * 128 * 64;
        const u32x4 k0 = tile_ld(Kc, tid), k1 = tile_ld(Kc + 4096, tid), v0 = tile_ld(Vc, tid), v1 = tile_ld(Vc + 4096, tid);
        tile_st_k(lds, k0, tid); tile_st_v(lds + 8192, v0, tid); tile_st_k(lds + 16384, k1, tid); tile_st_v(lds + 24576, v1, tid);
#pragma unroll
        for (int ks = 0; ks < 4; ++ks) qf[ks] = *(const bf16x8*)(QN + ks * 16 + hh * 8);
        __syncthreads();
        const int nvalid = t >= 31 ? ((t - 31) >> 4) + 1 : 0;
        float lsum = 0.f; float av[16], cb[16];
#pragma unroll
        for (int tile = 0; tile < 2; ++tile) {
            f32x16 P[2];
            attn_tile64(lds + tile * 16384, lds + tile * 16384 + 8192, qf, O, lsum, c2, mc, lane, [&](int kb, int i) { return 64 * tile + 32 * kb + crow(i, hh) < nvalid; }, P);
#pragma unroll
            for (int kb = 0; kb < 2; ++kb)
#pragma unroll
                for (int gq = 0; gq < 4; ++gq) { const int f = 8 * tile + 4 * kb + gq; const float p3 = 0.5f * P[kb][4 * gq + 3]; av[f] = P[kb][4 * gq] + P[kb][4 * gq + 1] + P[kb][4 * gq + 2] + p3; cb[f] = p3; }
        }
        lsum += __shfl_xor(lsum, 32);
        const float inv = lsum > 0.f ? 1.f / lsum : 0.f;
        float rc[16];
#pragma unroll
        for (int f = 0; f < 16; ++f) rc[f] = __shfl_xor(cb[f], 32);
        LAS float* ip = impP + ((wid >> 1) * 64 + tl) * 32;
#pragma unroll
        for (int f = 0; f < 16; ++f) { const float carry = hh == 1 ? rc[f] : (f > 0 ? rc[f > 0 ? f - 1 : 0] : 0.f); ip[2 * f + hh] = (av[f] + carry) * inv; }
        const float s0 = g0 * inv;
#pragma unroll
        for (int db = 0; db < 2; ++db)
#pragma unroll
            for (int i = 0; i < 16; ++i) { OT[db][i] = O[db][i] * s0; O[db][i] = 0.f; }
    }
    __syncthreads();
    if (wid == 0) {
        unsigned m;
        if (qb <= 5) m = (1u << (qb + 1)) - 1u;
        else {
            m = 1u | (1u << qb) | (1u << (qb - 1));
            float best[3] = {-1.f, -1.f, -1.f}; int bi[3] = {0, 0, 0};
            for (int j = 1; j <= qb - 2; ++j) {
                const float v = (impP[(0 * 64 + lane) * 32 + j] + impP[(1 * 64 + lane) * 32 + j]) + (impP[(2 * 64 + lane) * 32 + j] + impP[(3 * 64 + lane) * 32 + j]);
                if (v > best[0]) { best[2] = best[1]; bi[2] = bi[1]; best[1] = best[0]; bi[1] = bi[0]; best[0] = v; bi[0] = j; }
                else if (v > best[1]) { best[2] = best[1]; bi[2] = bi[1]; best[1] = v; bi[1] = j; }
                else if (v > best[2]) { best[2] = v; bi[2] = j; }
            }
            m |= (1u << bi[0]) | (1u << bi[1]) | (1u << bi[2]);
        }
        selm[lane] = m;
        unsigned u = m;
#pragma unroll
        for (int o = 1; o < 64; o <<= 1) u |= (unsigned)__shfl_xor((int)u, o);
        if (lane == 0) selm[64] = u;
    }
    __syncthreads();
    const unsigned mym = selm[tl]; const unsigned uni = selm[64];
#pragma unroll
    for (int ks = 0; ks < 4; ++ks) qf[ks] = *(const bf16x8*)(QR + ks * 16 + hh * 8);
    {
        float lsum = 0.f;
        nsa_tiles(lds, (const bf16_t*)(F.ws + WS_KS) + bg * SEQ * 64, (const bf16_t*)(F.ws + WS_VS) + bg * SEQ * 64, uni, qf, O, lsum, c2, mc, tid, lane,
                  [&](int j, int kb, int i) { return ((mym >> j) & 1u) != 0u && (j < qb || 32 * kb + crow(i, hh) <= tl); });
        lsum += __shfl_xor(lsum, 32);
        const float s1 = g1 / lsum;
#pragma unroll
        for (int db = 0; db < 2; ++db)
#pragma unroll
            for (int i = 0; i < 16; ++i) { OT[db][i] += O[db][i] * s1; O[db][i] = 0.f; }
    }
    {
        float lsum = 0.f; const int jlo = qb >= 4 ? qb - 4 : 0; const unsigned wt = ((qb == 31 ? 0xffffffffu : ((1u << (qb + 1)) - 1u))) & ~((1u << jlo) - 1u);
        nsa_tiles(lds, (const bf16_t*)(F.ws + WS_KW) + bg * SEQ * 64, (const bf16_t*)(F.ws + WS_VW) + bg * SEQ * 64, wt, qf, O, lsum, c2, mc, tid, lane,
                  [&](int j, int kb, int i) { const int kl = 32 * kb + crow(i, hh); return j == qb ? kl <= tl : (j == qb - 4 ? kl > tl : true); });
        lsum += __shfl_xor(lsum, 32);
        const float s2 = g2 / lsum;
#pragma unroll
        for (int db = 0; db < 2; ++db)
#pragma unroll
            for (int i = 0; i < 16; ++i) OT[db][i] += O[db][i] * s2;
    }
    bf16_t* orow = (bf16_t*)(F.ws + WS_AO) + ((size_t)b * SEQ + t) * DM + hd * 64;
#pragma unroll
    for (int db = 0; db < 2; ++db)
#pragma unroll
        for (int g4 = 0; g4 < 4; ++g4) { const int d = 32 * db + 8 * g4 + 4 * hh;
            u32x2 w; w.x = pk2(OT[db][4 * g4], OT[db][4 * g4 + 1]); w.y = pk2(OT[db][4 * g4 + 2], OT[db][4 * g4 + 3]);
            *(u32x2*)(orow + d) = w; }
}

DI float gmax(const float* g, int n, int lane) { float v = lane < n ? fabsf(g[lane]) : 0.f;
#pragma unroll
    for (int o = 1; o < 64; o <<= 1) v = fmaxf(v, __shfl_xor(v, o));
    return v; }

DI int queue_next(Frame& F, unsigned* ctr) {
    LAS int* slot = (LAS int*)(F.lds + LDS_MISC + 4096);
    __syncthreads();
    if (F.tid == 0) *slot = (int)atomicAdd(ctr, 1u);
    __syncthreads();
    return *slot;
}

DI float gelu_tanh(float x) { const float u = 0.7978845608028654f * (x + 0.044715f * x * x * x); const float e = __expf(2.f * u); const float th = 1.f - 2.f / (e + 1.f); return 0.5f * x * (1.f + th); }
DI void phase5(Frame& F) {
    const bf16_t* UL = (const bf16_t*)(F.ws + WS_UL); const float* w2 = F.in[11]; const float* gk0 = F.in[8];
    LAS float* hid = (LAS float*)(F.lds + F.wave * 1024);
    const int lane = F.lane;
    for (int it = F.gw; it < 2 * 64 * 128; it += F.NGW) {
        const int kv = it >> 13, rem = it & 8191, bgi = rem >> 7, c = rem & 127;
        bf16_t* dst = (bf16_t*)(F.ws + (kv ? WS_VCMP : WS_KCMP)) + ((size_t)bgi * 128 + c) * 64;
        if (c == 127) { dst[lane] = 0; continue; }
        const size_t row = (size_t)kv * 8192 + (size_t)bgi * 128 + c;
        const size_t perow = 16384 + (size_t)kv * 256 + (size_t)kv * 2;
        const u32x2 u4 = *(const u32x2*)(UL + row * 512 + 4 * lane), l4 = *(const u32x2*)(UL + (row + 1) * 512 + 256 + 4 * lane);
        const u32x2 pu = *(const u32x2*)(UL + perow * 512 + 4 * lane), pl = *(const u32x2*)(UL + (perow + 1) * 512 + 256 + 4 * lane);
        float h[4];
        h[0] = bflo(u4.x) + bflo(l4.x) + bflo(pu.x) + bflo(pl.x); h[1] = bfhi(u4.x) + bfhi(l4.x) + bfhi(pu.x) + bfhi(pl.x);
        h[2] = bflo(u4.y) + bflo(l4.y) + bflo(pu.y) + bflo(pl.y); h[3] = bfhi(u4.y) + bfhi(l4.y) + bfhi(pu.y) + bfhi(pl.y);
#pragma unroll
        for (int i = 0; i < 4; ++i) hid[4 * lane + i] = gelu_tanh(h[i]);
        asm volatile("s_waitcnt lgkmcnt(0)" ::: "memory");
        const float* w = w2 + (size_t)kv * 256 * 64 + lane; float acc = 0.f;
#pragma unroll 8
        for (int k = 0; k < 256; ++k) acc += hid[k] * w[(size_t)k * 64];
        if (kv == 0) { const float ss = wave_sum(acc * acc); acc = acc * rsqrtf(ss * (1.f / 64.f) + EPS) * gk0[lane]; }
        dst[lane] = f2bf(acc);
        asm volatile("s_waitcnt lgkmcnt(0)" ::: "memory");
    }
}

DI void phase8(Frame& F) {
    const float* x1 = F.out; const float* gf = F.in[5]; const float* mod = (const float*)(F.ws + WS_MOD); const float* rowss = (const float*)(F.ws + WS_ROWSS);
    const bf16_t* whi = (const bf16_t*)(F.ws + WS_WR); const bf16_t* wlo = whi + 48 * 1024;
    bf16_t* h2 = (bf16_t*)(F.ws + WS_H2);
    unsigned* cnt = (unsigned*)(F.ws + WS_CTL) + CW_CNT; int* lists = (int*)(F.ws + WS_LIST);
    int* tipos = (int*)(F.ws + WS_TIPOS); int* tie = (int*)(F.ws + WS_TIE); float* tiw = (float*)(F.ws + WS_TIW);
    const float* brg = F.in[21]; const float* bre = F.in[23];
    const int lane = F.lane, wid = F.wave, row = lane & 15, kq = lane >> 4;
    LAS float* lg = (LAS float*)(F.lds + wid * 3072);
    LAS unsigned* hist = (LAS unsigned*)(F.lds + 32768);
    const int nbatch = TOK / 128;
    for (int bt = F.bid; bt < nbatch; bt += F.G) {
        if (F.tid < 64) hist[F.tid] = 0u;
        __syncthreads();
        const int m0 = bt * 128 + wid * 16; const int m = m0 + row; const int b = m0 >> 11;
        float rs = 0.f; { const f32x4* rp = (const f32x4*)(rowss + (size_t)m * 16);
#pragma unroll
            for (int q = 0; q < 4; ++q) { const f32x4 v = rp[q]; rs += (v[0] + v[1]) + (v[2] + v[3]); } }
        const float rstd = rsqrtf(rs * (1.f / DM) + EPS);
        const float* sh = mod + (size_t)b * 6144 + 3072; const float* sc = sh + 1024;
        f32x4 acc[3] = {{0.f, 0.f, 0.f, 0.f}, {0.f, 0.f, 0.f, 0.f}, {0.f, 0.f, 0.f, 0.f}};
#pragma unroll 2
        for (int ks = 0; ks < 32; ++ks) {
            const int k0 = 32 * ks + 8 * kq;
            const f32x4 xa = *(const f32x4*)(x1 + (size_t)m * DM + k0), xb = *(const f32x4*)(x1 + (size_t)m * DM + k0 + 4);
            const f32x4 ga = *(const f32x4*)(gf + k0), gb = *(const f32x4*)(gf + k0 + 4), sa = *(const f32x4*)(sc + k0), sb = *(const f32x4*)(sc + k0 + 4), ha = *(const f32x4*)(sh + k0), hb = *(const f32x4*)(sh + k0 + 4);
            const f32x4 ya = xa * rstd * ga * (sa + 1.f) + ha, yb = xb * rstd * gb * (sb + 1.f) + hb;
            u32x4 hi; hi.x = pk2(ya[0], ya[1]); hi.y = pk2(ya[2], ya[3]); hi.z = pk2(yb[0], yb[1]); hi.w = pk2(yb[2], yb[3]);
            *(u32x4*)(h2 + (size_t)m * DM + k0) = hi;
            u32x4 lo; lo.x = pk2(ya[0] - bflo(hi.x), ya[1] - bfhi(hi.x)); lo.y = pk2(ya[2] - bflo(hi.y), ya[3] - bfhi(hi.y)); lo.z = pk2(yb[0] - bflo(hi.z), yb[1] - bfhi(hi.z)); lo.w = pk2(yb[2] - bflo(hi.w), yb[3] - bfhi(hi.w));
            const bf16x8 ahi = __builtin_bit_cast(bf16x8, hi), alo = __builtin_bit_cast(bf16x8, lo);
#pragma unroll
            for (int ct = 0; ct < 3; ++ct) { const bf16x8 bh = *(const bf16x8*)(whi + (size_t)(16 * ct + row) * 1024 + k0), bl = *(const bf16x8*)(wlo + (size_t)(16 * ct + row) * 1024 + k0);
                acc[ct] = MFMA16(ahi, bh, acc[ct]); acc[ct] = MFMA16(alo, bh, acc[ct]); acc[ct] = MFMA16(ahi, bl, acc[ct]); }
        }
#pragma unroll
        for (int ct = 0; ct < 3; ++ct)
#pragma unroll
            for (int i = 0; i < 4; ++i) lg[(kq * 4 + i) * 48 + 16 * ct + row] = acc[ct][i];
        asm volatile("s_waitcnt lgkmcnt(0)" ::: "memory");
        int e0 = 0, e1 = 0; float w0 = 0.f, w1 = 0.f; unsigned lp0 = 0u, lp1 = 0u;
        if (lane < 16) {
            const LAS float* lr = lg + lane * 48;
            float g4[4]; int grp = 0; float gm = -3.0e38f;
#pragma unroll
            for (int i = 0; i < 4; ++i) { g4[i] = lr[i] + brg[i]; if (g4[i] > gm) { gm = g4[i]; grp = i; } }
            float den = 0.f;
#pragma unroll
            for (int i = 0; i < 4; ++i) den += __expf(g4[i] - gm);
            const float pg = 1.f / den;
            float v0 = -3.0e38f, v1 = -3.0e38f; int i0 = 0, i1 = 0;
            for (int i = 0; i < 8; ++i) { const float v = lr[4 + grp * 8 + i] + bre[grp * 8 + i];
                if (v > v0) { v1 = v0; i1 = i0; v0 = v; i0 = i; } else if (v > v1) { v1 = v; i1 = i; } }
            const float ex = __expf(v1 - v0); w0 = pg / (1.f + ex); w1 = pg * ex / (1.f + ex);
            e0 = grp * 8 + i0; e1 = grp * 8 + i1;
            lp0 = atomicAdd((unsigned*)&hist[e0], 1u); lp1 = atomicAdd((unsigned*)&hist[e1], 1u);
        }
        __syncthreads();
        if (F.tid < 32) { const unsigned n = hist[F.tid]; hist[32 + F.tid] = n ? atomicAdd(cnt + F.tid, n) : 0u; }
        __syncthreads();
        if (lane < 16) {
            const int tok = m0 + lane; const int p0 = (int)(hist[32 + e0] + lp0), p1 = (int)(hist[32 + e1] + lp1);
            lists[(size_t)e0 * ECAP + p0] = tok; lists[(size_t)e1 * ECAP + p1] = tok;
            tipos[2 * tok] = p0; tipos[2 * tok + 1] = p1; tie[tok] = e0 | (e1 << 8); tiw[2 * tok] = w0; tiw[2 * tok + 1] = w1;
        }
        __syncthreads();
    }
}

DI LAS int* moe_prefix(Frame& F) {
    LAS int* tb = (LAS int*)(F.lds + LDS_MISC);
    __syncthreads();
    if (F.tid == 0) { const unsigned* cnt = (const unsigned*)(F.ws + WS_CTL) + CW_CNT; int s = 0; for (int e = 0; e < 32; ++e) { tb[e] = s; s += (int)((__hip_atomic_load(cnt + e, __ATOMIC_RELAXED, __HIP_MEMORY_SCOPE_AGENT) + 255u) >> 8); } tb[32] = s; }
    __syncthreads();
    return tb;
}

DI void phase11(Frame& F) {
    LAS int* tb = moe_prefix(F);
    const bf16_t* Y = (const bf16_t*)(F.ws + WS_Y); const float* mod = (const float*)(F.ws + WS_MOD);
    const int* tipos = (const int*)(F.ws + WS_TIPOS); const int* tie = (const int*)(F.ws + WS_TIE); const float* tiw = (const float*)(F.ws + WS_TIW);
    const int lane = F.lane;
    for (int m = F.gw; m < TOK; m += F.NGW) {
        const int b = m >> 11; const int ee = tie[m]; const int e0 = ee & 255, e1 = ee >> 8;
        const size_t r0 = (size_t)tb[e0] * 256 + tipos[2 * m], r1 = (size_t)tb[e1] * 256 + tipos[2 * m + 1];
        const float w0 = tiw[2 * m], w1 = tiw[2 * m + 1];
        const float* g2 = mod + (size_t)b * 6144 + 5120;
        float* orow = F.out + (size_t)m * DM;
#pragma unroll
        for (int j = 0; j < 2; ++j) { const int col = 8 * lane + 512 * j;
            const u32x4 ya = *(const u32x4*)(Y + r0 * DM + col), yb = *(const u32x4*)(Y + r1 * DM + col);
            const f32x4 ga = *(const f32x4*)(g2 + col), gb = *(const f32x4*)(g2 + col + 4);
            f32x4 xa = *(const f32x4*)(orow + col), xb = *(const f32x4*)(orow + col + 4);
            xa[0] += ga[0] * (w0 * bflo(ya.x) + w1 * bflo(yb.x)); xa[1] += ga[1] * (w0 * bfhi(ya.x) + w1 * bfhi(yb.x));
            xa[2] += ga[2] * (w0 * bflo(ya.y) + w1 * bflo(yb.y)); xa[3] += ga[3] * (w0 * bfhi(ya.y) + w1 * bfhi(yb.y));
            xb[0] += gb[0] * (w0 * bflo(ya.z) + w1 * bflo(yb.z)); xb[1] += gb[1] * (w0 * bfhi(ya.z) + w1 * bfhi(yb.z));
            xb[2] += gb[2] * (w0 * bflo(ya.w) + w1 * bflo(yb.w)); xb[3] += gb[3] * (w0 * bfhi(ya.w) + w1 * bfhi(yb.w));
            *(f32x4*)(orow + col) = xa; *(f32x4*)(orow + col + 4) = xb; }
    }
}

constexpr int NPHASE = 12;
__global__ void __launch_bounds__(NTHREADS, 2) hymba_fwd(Params p) {
    extern __shared__ __attribute__((aligned(16))) unsigned char lds_raw[];
    cg::grid_group grid = cg::this_grid();
    Frame F;
    F.lds = (LAS unsigned char*)lds_raw; F.ws = p.ws; F.in = p.in; F.out = p.out;
    F.tid = threadIdx.x; F.lane = F.tid & 63; F.wave = __builtin_amdgcn_readfirstlane(F.tid >> 6); F.bid = blockIdx.x; F.G = gridDim.x;
    F.gw = F.bid * NWAVES + F.wave; F.NGW = F.G * NWAVES;
    const int lo = p.ph_lo, hi = p.ph_hi;
#define IN(k) (lo <= (k) && (k) < hi)
#define SEAM(k) do { if (IN(k) && IN((k) + 1)) grid.sync(); } while (0)
    LAS unsigned char* ring = F.lds; LAS unsigned* tokl = (LAS unsigned*)(F.lds + LDS_MISC + 256);

    if (IN(0)) phase0(F);
    SEAM(0);
    if (IN(1)) phase1(F);
    SEAM(1);
    if (IN(2)) {
        pg8::StaticOrder S; S.init(TOK, NPROJ, DM, F.G, F.bid, F.ws + WS_H1, F.ws + WS_WIN);
        pg8::EpiBf16 E{(bf16_t*)(F.ws + WS_PROJ), NPROJ};
        pg8::gemm_phase<pg8::EpiBf16, pg8::StaticOrder, false>(ring, tokl, DM, S, E);
    }
    SEAM(2);
    if (IN(3)) phase3(F);
    SEAM(3);
    if (IN(4)) {
        { pg8::CompressOrder S{F.G, F.bid, (const char*)(F.ws + WS_KC), (const char*)(F.ws + WS_PE), (const char*)(F.ws + WS_WC1)};
          pg8::EpiBf16 E{(bf16_t*)(F.ws + WS_UL), 512};
          pg8::gemm_phase<pg8::EpiBf16, pg8::CompressOrder, false>(ring, tokl, 1024, S, E); }
        const float mq = gmax(F.in[12], 32, F.lane), mk = gmax(F.in[13], 32, F.lane);
        const float bound = 5.656854249f * mq * mk * 1.02f; const float c2 = 0.17677669529663687f * 1.4426950408889634f; const float mc = bound * 1.4426950408889634f;
        float s1 = F.lane < 32 ? F.in[14][F.lane] * F.in[15][F.lane] : 0.f, s2 = F.lane < 32 ? F.in[16][F.lane] * F.in[17][F.lane] : 0.f;
        s1 = wave_sum(s1); s2 = wave_sum(s2);
        const float lam = __expf(s1) - __expf(s2) + 0.2f;
        unsigned* ctr = (unsigned*)(F.ws + WS_CTL) + CW_QDIFF;
        for (;;) { const int it = queue_next(F, ctr); if (it >= 2048) break; const int qb = 7 - (it >> 8), bh = it & 255; diff_unit(F, bh >> 3, bh & 7, qb, c2, mc, lam); }
    }
    SEAM(4);
    if (IN(5)) phase5(F);
    SEAM(5);
    if (IN(6)) {
        const float mq = gmax(F.in[7], 64, F.lane); const float mk = fmaxf(gmax(F.in[8], 64, F.lane), fmaxf(gmax(F.in[8] + 64, 64, F.lane), gmax(F.in[8] + 128, 64, F.lane)));
        const float bound = 8.f * mq * mk * 1.02f; const float c2 = 0.125f * 1.4426950408889634f; const float mc = bound * 1.4426950408889634f;
        unsigned* ctr = (unsigned*)(F.ws + WS_CTL) + CW_QNSA;
        for (;;) { const int it = queue_next(F, ctr); if (it >= 2048) break; const int qb = 31 - (it >> 6), bg = it & 63; nsa_unit(F, bg >> 1, bg & 1, qb, c2, mc); }
    }
    SEAM(6);
    if (IN(7)) {
        pg8::StaticOrder S; S.init(TOK, DM, DM, F.G, F.bid, F.ws + WS_AO, F.ws + WS_WOUT);
        pg8::EpiOutProj E{F.in[0], F.out, (const float*)(F.ws + WS_MOD), (float*)(F.ws + WS_ROWSS)};
        pg8::gemm_phase<pg8::EpiOutProj, pg8::StaticOrder, false>(ring, tokl, DM, S, E);
    }
    SEAM(7);
    if (IN(8)) phase8(F);
    SEAM(8);
    if (IN(9)) {
        LAS int* tb = moe_prefix(F);
        pg8::MoeOrder S{F.G, F.bid, 0, tb, (const char*)(F.ws + WS_H2), (const char*)(F.ws + WS_WGU), (const int*)(F.ws + WS_LIST)};
        pg8::EpiSwiglu E{(bf16_t*)(F.ws + WS_HH)};
        pg8::gemm_phase<pg8::EpiSwiglu, pg8::MoeOrder, true>(ring, tokl, DM, S, E);
    }
    SEAM(9);
    if (IN(10)) {
        LAS int* tb = moe_prefix(F);
        pg8::MoeOrder S{F.G, F.bid, 1, tb, (const char*)(F.ws + WS_HH), (const char*)(F.ws + WS_WD), nullptr};
        pg8::EpiBf16 E{(bf16_t*)(F.ws + WS_Y), DM};
        pg8::gemm_phase<pg8::EpiBf16, pg8::MoeOrder, false>(ring, tokl, EHID, S, E);
    }
    SEAM(10);
    if (IN(11)) phase11(F);
#undef IN
#undef SEAM
}

#ifndef MK_LAUNCHES
#define MK_LAUNCHES 1
#endif
extern "C" void kernel_launch(void* const* d_in, const int* in_sizes, int n_in, void* d_out, int out_size, void* d_ws, size_t ws_size, hipStream_t stream) {
    static int grid = 0;
    if (grid == 0) {
        if (n_in != 27 || ws_size < WS_END) { fprintf(stderr, "kernel_launch: unexpected inputs (n_in %d, ws %zu)\n", n_in, ws_size); grid = -1; return; }
        int dev = 0, cus = 0, per_cu = 0;
        hipGetDevice(&dev); hipDeviceGetAttribute(&cus, hipDeviceAttributeMultiprocessorCount, dev);
        hipFuncSetAttribute((const void*)hymba_fwd, hipFuncAttributeMaxDynamicSharedMemorySize, LDS_BYTES);
        hipOccupancyMaxActiveBlocksPerMultiprocessor(&per_cu, (const void*)hymba_fwd, NTHREADS, LDS_BYTES);
        if (per_cu < 1) { fprintf(stderr, "kernel_launch: occupancy query says %d blocks per CU\n", per_cu); per_cu = 1; }
        if (per_cu > 1) per_cu = 1;
        grid = cus * per_cu;
    }
    if (grid < 0) return;
    Params p{};
    for (int i = 0; i < 27; ++i) p.in[i] = (const float*)d_in[i];
    p.out = (float*)d_out; p.ws = (unsigned char*)d_ws;
    const int cuts[13] = {0, 1, 2, 3, 4, 5, 6, 7, 8, 9, 10, 11, 12};
    const int nl = MK_LAUNCHES == 1 ? 1 : NPHASE;
    for (int li = 0; li < nl; ++li) {
        p.ph_lo = nl == 1 ? 0 : cuts[li]; p.ph_hi = nl == 1 ? NPHASE : cuts[li + 1];
        void* args[] = {&p};
        hipError_t e = hipLaunchCooperativeKernel((const void*)hymba_fwd, dim3(grid), dim3(NTHREADS), args, LDS_BYTES, stream);
        if (e != hipSuccess) { fprintf(stderr, "cooperative launch failed: %s (grid %d)\n", hipGetErrorString(e), grid); break; }
    }
}
```

```cpp
#include <hip/hip_runtime.h>
#include <hip/hip_cooperative_groups.h>
#include <cstdint>
#include <cstdio>
namespace cg = cooperative_groups;

#define LAS __attribute__((address_space(3)))
#define DI __device__ __forceinline__
typedef unsigned short bf16_t;
typedef short bf16x8 __attribute__((ext_vector_type(8)));
typedef short s16x4 __attribute__((ext_vector_type(4)));
typedef float f32x2 __attribute__((ext_vector_type(2)));
typedef float f32x4 __attribute__((ext_vector_type(4)));
typedef float f32x16 __attribute__((ext_vector_type(16)));
typedef unsigned u32x2 __attribute__((ext_vector_type(2)));
typedef unsigned u32x4 __attribute__((ext_vector_type(4)));

constexpr int BATCH = 32, SEQ = 2048, DM = 1024, TOK = BATCH * SEQ;
constexpr int NPROJ = 3072;
constexpr int INCOLS = 2840;
constexpr int NEXP = 32, EHID = 512, ECAP = 65536;
constexpr float EPS = 1e-6f;
constexpr int NWAVES = 8, NTHREADS = 512;

constexpr size_t MiB = 1u << 20;
constexpr size_t WS_CTL = 0;
constexpr size_t WS_MOD = 1 * MiB;
constexpr size_t WS_ROPE = 2 * MiB;
constexpr size_t WS_WR = 3 * MiB;
constexpr size_t WS_WIN = 4 * MiB;
constexpr size_t WS_WOUT = 10 * MiB;
constexpr size_t WS_WC1 = 12 * MiB;
constexpr size_t WS_WGU = 16 * MiB;
constexpr size_t WS_WD = 80 * MiB;
constexpr size_t WS_LIST = 112 * MiB;
constexpr size_t WS_TIPOS = 120 * MiB;
constexpr size_t WS_TIE = WS_TIPOS + 512 * 1024;
constexpr size_t WS_TIW = WS_TIE + 256 * 1024;
constexpr size_t WS_ROWSS = 122 * MiB;
constexpr size_t WS_GATES = 126 * MiB;
constexpr size_t WS_KCMP = 132 * MiB;
constexpr size_t WS_VCMP = 133 * MiB;
constexpr size_t WS_UL = 134 * MiB;
constexpr size_t WS_A = 160 * MiB;
constexpr size_t WS_B = 288 * MiB;
constexpr size_t WS_C = 672 * MiB;
constexpr size_t WS_H1 = WS_A, WS_QN = WS_B + 128 * MiB, WS_QR = WS_B + 192 * MiB, WS_H2 = WS_A;
constexpr size_t WS_PROJ = WS_B, WS_AO = WS_B, WS_HH = WS_B, WS_Y = WS_B + 136 * MiB;
constexpr size_t WS_KC = WS_C, WS_VC = WS_C + 16 * MiB, WS_PE = WS_C + 32 * MiB, WS_KS = WS_C + 33 * MiB, WS_VS = WS_C + 49 * MiB,
                 WS_KW = WS_C + 65 * MiB, WS_VW = WS_C + 81 * MiB, WS_DQ = WS_C + 97 * MiB, WS_DK = WS_C + 161 * MiB, WS_DV = WS_C + 225 * MiB;
constexpr size_t WS_END = WS_C + 289 * MiB;
constexpr int CW_CNT = 0;
constexpr int CW_QDIFF = 64, CW_QNSA = 128;

constexpr int RING_BYTES = 131072;
constexpr int LDS_MISC = RING_BYTES;
constexpr int LDS_BYTES = 147456;

DI unsigned pk2(float lo, float hi) { typedef __bf16 b2 __attribute__((ext_vector_type(2))); f32x2 v = {lo, hi}; b2 b = __builtin_convertvector(v, b2); return __builtin_bit_cast(unsigned, b); }
DI unsigned short f2bf(float f) { return (unsigned short)(pk2(f, 0.f) & 0xffffu); }
DI float bf2f(unsigned short h) { return __uint_as_float((unsigned)h << 16); }
DI float bflo(unsigned w) { return __uint_as_float(w << 16); }
DI float bfhi(unsigned w) { return __uint_as_float(w & 0xffff0000u); }
DI float wave_sum(float v) {
#pragma unroll
    for (int o = 1; o < 64; o <<= 1) v += __shfl_xor(v, o);
    return v;
}
DI float fast_exp2(float x) { return __builtin_amdgcn_exp2f(x); }
DI float fast_rcp(float x) { return __builtin_amdgcn_rcpf(x); }
#define MFMA32(a, b, c) __builtin_amdgcn_mfma_f32_32x32x16_bf16((a), (b), (c), 0, 0, 0)
#define MFMA16(a, b, c) __builtin_amdgcn_mfma_f32_16x16x32_bf16((a), (b), (c), 0, 0, 0)
DI int crow(int r, int hi) { return (r & 3) + 8 * (r >> 2) + 4 * hi; }

struct Params { const float* in[27]; float* out; unsigned char* ws; int ph_lo, ph_hi; };

namespace pg8 {
constexpr int BM = 256, BK = 64, HALF = 128, HTB = HALF * BK * 2, STAGE_BYTES = 8 * HTB, NXCD = 8, WGM = 8;
DI int lds_byte(int r, int c) { const int st = (r >> 4) * 2 + (c >> 5), rr = r & 15, cc = c & 31, ob = rr * 64 + cc * 2; return st * 1024 + (ob ^ (((ob >> 9) & 1) << 5)); }
DI void stage_rc(int b, int& R, int& C) { const int st = b / 1024, sb = b % 1024, swz = sb ^ (((sb >> 9) & 1) << 5); R = (st >> 1) * 16 + swz / 64; C = (st & 1) * 32 + (swz % 64) / 2; }
DI int perm32(int rho) { const int n = rho >> 4, i = rho & 15; return 8 * (i >> 2) + 4 * n + (i & 3); }

struct Unit { int pm, pn, aux; const char* Ab; const char* Bb; const int* tok; };

template <class Epi, class Sched, bool GATHER>
DI void gemm_phase(LAS unsigned char* lds, LAS unsigned* tokl, const int K, const Sched& S, const Epi& E) {
    const int tid = threadIdx.x, wid = __builtin_amdgcn_readfirstlane(tid >> 6), lane = tid & 63, wr = wid >> 2, wc = wid & 3, fr = lane & 15, fq = lane >> 4;
    const int nt = K / BK;
    unsigned voffA[2], voffB[2]; int RA[2], CA[2];
#pragma unroll
    for (int i = 0; i < 2; ++i) { int R, C; stage_rc(tid * 16 + i * 8192, R, C); const int Rb = Epi::PERM ? ((R & ~31) + perm32(R & 31)) : R;
        voffA[i] = (unsigned)(R * K + C) * 2u; voffB[i] = (unsigned)(Rb * K + C) * 2u; RA[i] = R; CA[i] = C; }
    const size_t kstep = (size_t)(BK * 2);
    const size_t hstep = (size_t)HALF * K * 2;
    const unsigned ldsw = (unsigned)wid * 1024u;
    const int aoff = lds_byte(wr * 64 + fr, fq * 8), boff = lds_byte(wc * 32 + fr, fq * 8);
#define PG8_SA(b, h) (((b) * 2 + (h)) * HTB)
#define PG8_SB(b, h) ((4 + (b) * 2 + (h)) * HTB)
#define PG8_STG(bufoff, gbase, voff) do { _Pragma("unroll") for (int _i = 0; _i < 2; ++_i) \
        __builtin_amdgcn_global_load_lds((const unsigned*)((const char*)(gbase) + (voff)[_i]), (LAS unsigned*)(lds + (bufoff) + ldsw + _i * 8192), 16, 0, 0); } while (0)
#define PG8_STA(bufoff, gbase, h, vv) do { if constexpr (GATHER) { PG8_STG(bufoff, gbase, vv[h]); } else { PG8_STG(bufoff, (gbase) + (h) * hstep, voffA); } } while (0)
#define PG8_LDA(dst, b, h) do { _Pragma("unroll") for (int m = 0; m < 4; ++m) _Pragma("unroll") for (int k = 0; k < 2; ++k) dst[m][k] = *(const LAS bf16x8*)(lds + PG8_SA(b, h) + aoff + m * 2048 + k * 1024); } while (0)
#define PG8_LDB(dst, b, h) do { _Pragma("unroll") for (int n = 0; n < 2; ++n) _Pragma("unroll") for (int k = 0; k < 2; ++k) dst[n][k] = *(const LAS bf16x8*)(lds + PG8_SB(b, h) + boff + n * 2048 + k * 1024); } while (0)
#define PG8_MMA(ai, bj, At, Bt) do { __builtin_amdgcn_s_setprio(1); _Pragma("unroll") for (int m = 0; m < 4; ++m) _Pragma("unroll") for (int n = 0; n < 2; ++n) _Pragma("unroll") for (int k = 0; k < 2; ++k) \
        acc[ai][bj][m][n] = __builtin_amdgcn_mfma_f32_16x16x32_bf16(Bt[n][k], At[m][k], acc[ai][bj][m][n], 0, 0, 0); __builtin_amdgcn_s_setprio(0); } while (0)
#define PG8_WAIT_V(n) asm volatile("s_waitcnt vmcnt(" #n ")" ::: "memory")
#define PG8_WAIT_L(n) asm volatile("s_waitcnt lgkmcnt(" #n ")" ::: "memory")
#define PG8_BAR __builtin_amdgcn_s_barrier()
#define PG8_SCHED __builtin_amdgcn_sched_barrier(0)
    Unit cur, nxt; int ui = 0;
    if (!S.next(0, cur)) return;
    f32x4 acc[2][2][4][2];
#pragma unroll
    for (int a = 0; a < 2; ++a)
#pragma unroll
        for (int b = 0; b < 2; ++b)
#pragma unroll
            for (int m = 0; m < 4; ++m)
#pragma unroll
                for (int n = 0; n < 2; ++n) acc[a][b][m][n] = (f32x4){0.f, 0.f, 0.f, 0.f};
    bf16x8 At[4][2], B0[2][2], B1[2][2];
    const char* cA = cur.Ab; const char* cB = cur.Bb;
    unsigned cvo[2][2] = {{0u, 0u}, {0u, 0u}}, nvo[2][2] = {{0u, 0u}, {0u, 0u}};
    if constexpr (GATHER) {
        if (wid < 4) __builtin_amdgcn_global_load_lds((const unsigned*)(cur.tok + wid * 64 + lane), (LAS unsigned*)(tokl + wid * 64), 4, 0, 0);
        PG8_WAIT_V(0); PG8_BAR;
#pragma unroll
        for (int h = 0; h < 2; ++h)
#pragma unroll
            for (int i = 0; i < 2; ++i) cvo[h][i] = tokl[h * 128 + RA[i]] * (unsigned)(K * 2) + (unsigned)(CA[i] * 2);
        PG8_WAIT_L(0);
    }
    PG8_STG(PG8_SB(0, 0), cB, voffB); PG8_STG(PG8_SB(0, 1), cB + hstep, voffB); PG8_STA(PG8_SA(0, 0), cA, 0, cvo); PG8_STA(PG8_SA(0, 1), cA, 1, cvo);
    if (wr == 1) PG8_BAR;
    PG8_WAIT_V(2); PG8_BAR;
    PG8_STG(PG8_SB(1, 0), cB + kstep, voffB); PG8_STA(PG8_SA(1, 0), cA + kstep, 0, cvo); PG8_STG(PG8_SB(1, 1), cB + hstep + kstep, voffB);
    PG8_WAIT_V(6); PG8_BAR;
    for (;;) {
        const bool has_next = S.next(ui + 1, nxt);
        const char* nA = has_next ? nxt.Ab : cA; const char* nB = has_next ? nxt.Bb : cB;
        if constexpr (GATHER) {
            if (has_next && wid < 4) __builtin_amdgcn_global_load_lds((const unsigned*)(nxt.tok + wid * 64 + lane), (LAS unsigned*)(tokl + ((ui + 1) & 1) * 256 + wid * 64), 4, 0, 0);
        }
        for (int t = 0; t < nt; t += 2) {
            const bool last = (t == nt - 2);
            const char* a1 = cA + (size_t)(t + 1) * kstep;
            const char* a2 = last ? nA : cA + (size_t)(t + 2) * kstep; const char* b2 = last ? nB : cB + (size_t)(t + 2) * kstep;
            const char* a3 = a2 + kstep; const char* b3 = b2 + kstep;
            unsigned v2[2][2];
            if constexpr (GATHER) {
                if (last) {
                    if (has_next) {
#pragma unroll
                        for (int h = 0; h < 2; ++h)
#pragma unroll
                            for (int i = 0; i < 2; ++i) nvo[h][i] = tokl[((ui + 1) & 1) * 256 + h * 128 + RA[i]] * (unsigned)(K * 2) + (unsigned)(CA[i] * 2);
                    } else {
#pragma unroll
                        for (int h = 0; h < 2; ++h)
#pragma unroll
                            for (int i = 0; i < 2; ++i) nvo[h][i] = cvo[h][i];
                    }
                }
#pragma unroll
                for (int h = 0; h < 2; ++h)
#pragma unroll
                    for (int i = 0; i < 2; ++i) v2[h][i] = last ? nvo[h][i] : cvo[h][i];
            } else {
#pragma unroll
                for (int h = 0; h < 2; ++h)
#pragma unroll
                    for (int i = 0; i < 2; ++i) v2[h][i] = 0u;
            }
            PG8_LDB(B0, 0, 0); PG8_LDB(B1, 0, 1); PG8_SCHED; PG8_LDA(At, 0, 0); PG8_STA(PG8_SA(1, 1), a1, 1, cvo);
            PG8_WAIT_V(8); PG8_WAIT_L(0); PG8_BAR; PG8_MMA(0, 0, At, B0); PG8_MMA(0, 1, At, B1); PG8_BAR; PG8_SCHED;
            PG8_LDA(At, 0, 1); PG8_STG(PG8_SB(0, 0), b2, voffB); PG8_STG(PG8_SB(0, 1), b2 + hstep, voffB); PG8_STA(PG8_SA(0, 0), a2, 0, v2);
            PG8_WAIT_V(8); PG8_WAIT_L(0); PG8_BAR; PG8_MMA(1, 0, At, B0); PG8_MMA(1, 1, At, B1); PG8_BAR; PG8_SCHED;
            PG8_LDB(B0, 1, 0); PG8_LDB(B1, 1, 1); PG8_SCHED; PG8_LDA(At, 1, 0); PG8_STA(PG8_SA(0, 1), a2, 1, v2);
            PG8_WAIT_V(8); PG8_WAIT_L(0); PG8_BAR; PG8_MMA(0, 0, At, B0); PG8_MMA(0, 1, At, B1); PG8_BAR; PG8_SCHED;
            PG8_LDA(At, 1, 1); PG8_STG(PG8_SB(1, 0), b3, voffB); PG8_STG(PG8_SB(1, 1), b3 + hstep, voffB); PG8_STA(PG8_SA(1, 0), a3, 0, v2);
            PG8_WAIT_V(8); PG8_WAIT_L(0); PG8_BAR; PG8_MMA(1, 0, At, B0); PG8_MMA(1, 1, At, B1); PG8_BAR; PG8_SCHED;
        }
        if (wr == 0) PG8_BAR;
        E(acc, cur, wr, wc, fr, fq);
        if (!has_next) break;
#pragma unroll
        for (int a = 0; a < 2; ++a)
#pragma unroll
            for (int b = 0; b < 2; ++b)
#pragma unroll
                for (int m = 0; m < 4; ++m)
#pragma unroll
                    for (int n = 0; n < 2; ++n) acc[a][b][m][n] = (f32x4){0.f, 0.f, 0.f, 0.f};
        cur = nxt; cA = nA; cB = nB; ++ui;
        if constexpr (GATHER) {
#pragma unroll
            for (int h = 0; h < 2; ++h)
#pragma unroll
                for (int i = 0; i < 2; ++i) cvo[h][i] = nvo[h][i];
        }
        if (wr == 1) PG8_BAR;
    }
    PG8_WAIT_V(0);
    PG8_BAR;
#undef PG8_SA
#undef PG8_SB
#undef PG8_STG
#undef PG8_STA
#undef PG8_LDA
#undef PG8_LDB
#undef PG8_MMA
#undef PG8_WAIT_V
#undef PG8_WAIT_L
#undef PG8_BAR
#undef PG8_SCHED
}

struct StaticOrder {
    int nM, nN, nwg, G, c; const char* A; const char* Bt; size_t tstep;
    DI void init(int M, int N, int K, int G_, int c_, const void* A_, const void* Bt_) { nM = M / BM; nN = N / BM; nwg = nM * nN; G = G_; c = c_; A = (const char*)A_; Bt = (const char*)Bt_; tstep = (size_t)BM * K * 2; }
    DI bool next(int i, Unit& u) const {
        const long L = (long)i * G + c; if (L >= nwg) return false;
        int wgid = (int)L; { const int q = nwg / NXCD, r = nwg % NXCD, xcd = wgid % NXCD, off = wgid / NXCD; wgid = (xcd < r ? xcd * (q + 1) : r * (q + 1) + (xcd - r) * q) + off; }
        const int nig = WGM * nN, gid = wgid / nig, fm = gid * WGM, gsz = (nM - fm) < WGM ? (nM - fm) : WGM;
        u.pm = fm + ((wgid % nig) % gsz); u.pn = (wgid % nig) / gsz; u.aux = 0; u.Ab = A + (size_t)u.pm * tstep; u.Bb = Bt + (size_t)u.pn * tstep; u.tok = nullptr; return true;
    }
};
struct CompressOrder {
    int G, c; const char* KC; const char* PE; const char* W;
    DI bool next(int i, Unit& u) const {
        const int L = i * G + c; if (L >= 132) return false;
        u.pm = L >> 1; u.pn = L & 1; const int kv = u.pm < 32 ? 0 : (u.pm < 64 ? 1 : u.pm - 64); u.aux = kv;
        u.Ab = u.pm < 64 ? KC + (size_t)u.pm * (256 * 1024 * 2) : PE; u.Bb = W + (size_t)kv * (512 * 1024 * 2) + (size_t)u.pn * (256 * 1024 * 2); u.tok = nullptr; return true;
    }
};
struct MoeOrder {
    int G, c, mode; const LAS int* tb; const char* A; const char* W; const int* lists;
    DI bool next(int i, Unit& u) const {
        const int L = i * G + c; const int mt = L >> 2; if (mt >= tb[32]) return false;
        int e = 0;
#pragma unroll 1
        for (int j = 1; j < 32; ++j) e += (tb[j] <= mt) ? 1 : 0;
        u.pm = mt; u.pn = L & 3; u.aux = e;
        if (mode == 0) { u.Ab = A; u.Bb = W + (size_t)e * (1024 * 1024 * 2) + (size_t)u.pn * (256 * 1024 * 2); u.tok = lists + (size_t)e * ECAP + (size_t)(mt - tb[e]) * 256; }
        else { u.Ab = A + (size_t)mt * (256 * 512 * 2); u.Bb = W + (size_t)e * (1024 * 512 * 2) + (size_t)u.pn * (256 * 512 * 2); u.tok = nullptr; }
        return true;
    }
};

struct EpiBf16 {
    static constexpr bool PERM = true;
    bf16_t* O; int ldc;
    DI void operator()(const f32x4 (&acc)[2][2][4][2], const Unit& u, int wr, int wc, int fr, int fq) const {
        const int row0 = u.pm * BM + wr * 64 + fr; const int col0 = u.pn * BM + wc * 32 + 8 * fq;
#pragma unroll
        for (int ai = 0; ai < 2; ++ai)
#pragma unroll
            for (int m = 0; m < 4; ++m) { bf16_t* rowp = O + (size_t)(row0 + ai * HALF + m * 16) * ldc + col0;
#pragma unroll
                for (int bj = 0; bj < 2; ++bj) { const f32x4 v0 = acc[ai][bj][m][0], v1 = acc[ai][bj][m][1];
                    u32x4 w; w.x = pk2(v0[0], v0[1]); w.y = pk2(v0[2], v0[3]); w.z = pk2(v1[0], v1[1]); w.w = pk2(v1[2], v1[3]);
                    *(u32x4*)(rowp + bj * HALF) = w; } }
    }
};
struct EpiInProj {
    static constexpr bool PERM = true;
    unsigned char* ws; const float* g_nq; const float* g_nk; const float* g_dq; const float* g_dk; LAS float* xch;
    DI void operator()(const f32x4 (&acc)[2][2][4][2], const Unit& u, int wr, int wc, int fr, int fq) const {
        const int pn = u.pn, wid = wr * 4 + wc; const int tok0 = u.pm * BM; const int b = tok0 >> 11; int t0 = (tok0 & 2047) + wr * 64 + fr;
        int xo_i = wid * 256 + fr, xp_i = (wid ^ 1) * 256 + fr;
        asm volatile("" : "+v"(t0), "+v"(xo_i), "+v"(xp_i));
        LAS float* xo = xch + xo_i; LAS float* xp = xch + xp_i;
        const float* ropeN = (const float*)(ws + WS_ROPE); const float* ropeD = ropeN + 2048 * 16;
        const int d0 = 32 * (wc & 1) + 8 * fq;
        if (pn <= 4) {
            const bool nrm0 = (pn != 2), nrm1 = (pn < 2);
            if (pn != 2) {
#pragma unroll
                for (int ai = 0; ai < 2; ++ai)
#pragma unroll
                    for (int m = 0; m < 4; ++m)
#pragma unroll
                        for (int bj = 0; bj < 2; ++bj) { const f32x4 a = acc[ai][bj][m][0], c = acc[ai][bj][m][1];
                            float ss = (a[0] * a[0] + a[1] * a[1]) + (a[2] * a[2] + a[3] * a[3]) + (c[0] * c[0] + c[1] * c[1]) + (c[2] * c[2] + c[3] * c[3]);
                            ss += __shfl_xor(ss, 16); ss += __shfl_xor(ss, 32);
                            if (fq == 0) xo[((ai * 4 + m) * 2 + bj) * 16] = ss; }
                asm volatile("s_waitcnt lgkmcnt(0)" ::: "memory"); __builtin_amdgcn_s_barrier(); asm volatile("" ::: "memory");
            }
            const float* gg = pn < 2 ? g_nq : (g_nk + (pn == 3 ? 64 : 128));
            f32x4 g0 = {1.f, 1.f, 1.f, 1.f}, g1 = g0;
            if (pn != 2) { g0 = *(const f32x4*)(gg + d0); g1 = *(const f32x4*)(gg + d0 + 4); }
            const bool ropew = (wc & 1) == 0;
#pragma unroll
            for (int ai = 0; ai < 2; ++ai)
#pragma unroll
                for (int m = 0; m < 4; ++m) {
                    const int t = t0 + ai * HALF + m * 16;
                    f32x4 cs0 = {1.f, 0.f, 1.f, 0.f}, cs1 = cs0, cs2 = cs0, cs3 = cs0;
                    if (pn != 2 && ropew && fq < 2) { const f32x4* rp = (const f32x4*)(ropeN + t * 16); cs0 = rp[0]; cs1 = rp[1]; cs2 = rp[2]; cs3 = rp[3]; }
#pragma unroll
                    for (int bj = 0; bj < 2; ++bj) {
                        const bool donorm = bj == 0 ? nrm0 : nrm1;
                        f32x4 ya = acc[ai][bj][m][0], yb = acc[ai][bj][m][1];
                        u32x4 w0, w1;
                        if (donorm) {
                            const float rstd = rsqrtf((xo[((ai * 4 + m) * 2 + bj) * 16] + xp[((ai * 4 + m) * 2 + bj) * 16]) * (1.f / 64.f) + EPS);
                            ya = ya * rstd * g0; yb = yb * rstd * g1;
                            w0.x = pk2(ya[0], ya[1]); w0.y = pk2(ya[2], ya[3]); w0.z = pk2(yb[0], yb[1]); w0.w = pk2(yb[2], yb[3]);
                            f32x4 ra = ya, rb = yb;
                            if (ropew) {
                                f32x4 pa, pb;
#pragma unroll
                                for (int i = 0; i < 4; ++i) { pa[i] = __shfl_xor(ya[i], 16); pb[i] = __shfl_xor(yb[i], 16); }
                                if (fq == 0) { ra[0] = ya[0] * cs0[0] - pa[0] * cs0[1]; ra[1] = ya[1] * cs0[2] - pa[1] * cs0[3]; ra[2] = ya[2] * cs1[0] - pa[2] * cs1[1]; ra[3] = ya[3] * cs1[2] - pa[3] * cs1[3];
                                               rb[0] = yb[0] * cs2[0] - pb[0] * cs2[1]; rb[1] = yb[1] * cs2[2] - pb[1] * cs2[3]; rb[2] = yb[2] * cs3[0] - pb[2] * cs3[1]; rb[3] = yb[3] * cs3[2] - pb[3] * cs3[3]; }
                                else if (fq == 1) { ra[0] = pa[0] * cs0[1] + ya[0] * cs0[0]; ra[1] = pa[1] * cs0[3] + ya[1] * cs0[2]; ra[2] = pa[2] * cs1[1] + ya[2] * cs1[0]; ra[3] = pa[3] * cs1[3] + ya[3] * cs1[2];
                                                    rb[0] = pb[0] * cs2[1] + yb[0] * cs2[0]; rb[1] = pb[1] * cs2[3] + yb[1] * cs2[2]; rb[2] = pb[2] * cs3[1] + yb[2] * cs3[0]; rb[3] = pb[3] * cs3[3] + yb[3] * cs3[2]; }
                            }
                            w1.x = pk2(ra[0], ra[1]); w1.y = pk2(ra[2], ra[3]); w1.z = pk2(rb[0], rb[1]); w1.w = pk2(rb[2], rb[3]);
                        } else { w0.x = pk2(ya[0], ya[1]); w0.y = pk2(ya[2], ya[3]); w0.z = pk2(yb[0], yb[1]); w0.w = pk2(yb[2], yb[3]); w1 = w0; }
                        const int hq = 2 * bj + (wc >> 1);
                        if (pn < 2) { const size_t off = (((size_t)b * 8 + 4 * pn + hq) * SEQ + t) * 64 + d0;
                            *(u32x4*)((bf16_t*)(ws + WS_QN) + off) = w0; *(u32x4*)((bf16_t*)(ws + WS_QR) + off) = w1; }
                        else { const int six = 2 * (pn - 2) + bj; const size_t base = six == 0 ? WS_KC : six == 1 ? WS_VC : six == 2 ? WS_KS : six == 3 ? WS_VS : six == 4 ? WS_KW : WS_VW;
                            const size_t off = (((size_t)b * 2 + (wc >> 1)) * SEQ + t) * 64 + d0;
                            *(u32x4*)((bf16_t*)(ws + base) + off) = w1; }
                    }
                    asm volatile("" ::: "memory");
                }
        } else if (pn <= 8) {
            const bool isq = pn <= 6; const float* gg = isq ? g_dq : g_dk; bf16_t* dst = (bf16_t*)(ws + (isq ? WS_DQ : WS_DK));
            const f32x4 g0 = *(const f32x4*)(gg + 8 * fq), g1 = *(const f32x4*)(gg + 8 * fq + 4);
#pragma unroll
            for (int ai = 0; ai < 2; ++ai)
#pragma unroll
                for (int m = 0; m < 4; ++m) {
                    const int t = t0 + ai * HALF + m * 16;
                    f32x4 c0 = {1.f, 0.f, 1.f, 0.f}, c1 = c0;
                    if (fq == 0) { const f32x4* rp = (const f32x4*)(ropeD + t * 8); c0 = rp[0]; c1 = rp[1]; }
#pragma unroll
                    for (int bj = 0; bj < 2; ++bj) {
                        f32x4 ya = acc[ai][bj][m][0], yb = acc[ai][bj][m][1];
                        float ss = (ya[0] * ya[0] + ya[1] * ya[1]) + (ya[2] * ya[2] + ya[3] * ya[3]) + (yb[0] * yb[0] + yb[1] * yb[1]) + (yb[2] * yb[2] + yb[3] * yb[3]);
                        ss += __shfl_xor(ss, 16); ss += __shfl_xor(ss, 32);
                        const float rstd = rsqrtf(ss * (1.f / 32.f) + EPS);
                        ya = ya * rstd * g0; yb = yb * rstd * g1;
                        if (fq == 0) { const f32x4 a = ya, bb = yb;
                            ya[0] = a[0] * c0[0] - bb[0] * c0[1]; yb[0] = a[0] * c0[1] + bb[0] * c0[0]; ya[1] = a[1] * c0[2] - bb[1] * c0[3]; yb[1] = a[1] * c0[3] + bb[1] * c0[2];
                            ya[2] = a[2] * c1[0] - bb[2] * c1[1]; yb[2] = a[2] * c1[1] + bb[2] * c1[0]; ya[3] = a[3] * c1[2] - bb[3] * c1[3]; yb[3] = a[3] * c1[3] + bb[3] * c1[2]; }
                        u32x4 w; w.x = pk2(ya[0], ya[1]); w.y = pk2(ya[2], ya[3]); w.z = pk2(yb[0], yb[1]); w.w = pk2(yb[2], yb[3]);
                        const int hd = 4 * ((pn - 5) & 1) + 2 * bj + (wc >> 1);
                        *(u32x4*)(dst + (((size_t)b * 8 + hd) * SEQ + t) * 64 + d0) = w;
                    }
                    asm volatile("" ::: "memory");
                }
        } else if (pn <= 10) {
            bf16_t* dst = (bf16_t*)(ws + WS_DV);
#pragma unroll
            for (int ai = 0; ai < 2; ++ai)
#pragma unroll
                for (int m = 0; m < 4; ++m) { const int t = t0 + ai * HALF + m * 16;
#pragma unroll
                    for (int bj = 0; bj < 2; ++bj) { const f32x4 ya = acc[ai][bj][m][0], yb = acc[ai][bj][m][1];
                        u32x4 w; w.x = pk2(ya[0], ya[1]); w.y = pk2(ya[2], ya[3]); w.z = pk2(yb[0], yb[1]); w.w = pk2(yb[2], yb[3]);
                        const int hd = 4 * (pn - 9) + 2 * bj + (wc >> 1);
                        *(u32x4*)(dst + (((size_t)b * 8 + hd) * SEQ + t) * 64 + d0) = w; }
                    asm volatile("" ::: "memory"); }
        } else {
            if (wc == 0 && fq < 3) {
                float* gt = (float*)(ws + WS_GATES);
#pragma unroll
                for (int ai = 0; ai < 2; ++ai)
#pragma unroll
                    for (int m = 0; m < 4; ++m) { const size_t tok = (size_t)tok0 + wr * 64 + fr + ai * HALF + m * 16; const f32x4 ya = acc[ai][0][m][0], yb = acc[ai][0][m][1]; f32x4 sa, sb;
#pragma unroll
                        for (int i = 0; i < 4; ++i) { sa[i] = 1.f / (1.f + __expf(-ya[i])); sb[i] = 1.f / (1.f + __expf(-yb[i])); }
                        *(f32x4*)(gt + tok * 24 + 8 * fq) = sa; *(f32x4*)(gt + tok * 24 + 8 * fq + 4) = sb; }
            }
        }
    }
};
struct EpiSwiglu {
    static constexpr bool PERM = true;
    bf16_t* O;
    DI void operator()(const f32x4 (&acc)[2][2][4][2], const Unit& u, int wr, int wc, int fr, int fq) const {
        const int row0 = u.pm * BM + wr * 64 + fr; const int col0 = u.pn * 128 + wc * 16 + 4 * fq;
#pragma unroll
        for (int ai = 0; ai < 2; ++ai)
#pragma unroll
            for (int m = 0; m < 4; ++m) { bf16_t* rowp = O + (size_t)(row0 + ai * HALF + m * 16) * EHID + col0;
#pragma unroll
                for (int bj = 0; bj < 2; ++bj) { const f32x4 g = acc[ai][bj][m][0], up = acc[ai][bj][m][1]; float h[4];
#pragma unroll
                    for (int i = 0; i < 4; ++i) { const float s = fast_rcp(1.f + __expf(-g[i])); h[i] = g[i] * s * up[i]; }
                    u32x2 w; w.x = pk2(h[0], h[1]); w.y = pk2(h[2], h[3]);
                    *(u32x2*)(rowp + bj * 64) = w; } }
    }
};
struct EpiOutProj {
    static constexpr bool PERM = false;
    const float* x; float* out; const float* mod; float* rowss;
    DI void operator()(const f32x4 (&acc)[2][2][4][2], const Unit& u, int wr, int wc, int fr, int fq) const {
        const int col0 = u.pn * BM + wc * 32 + 4 * fq; const int b = (u.pm * BM) / SEQ;
        const float* g1 = mod + (size_t)b * 6144 + 2048 + col0;
        f32x4 gv[2][2];
#pragma unroll
        for (int bj = 0; bj < 2; ++bj)
#pragma unroll
            for (int n = 0; n < 2; ++n) gv[bj][n] = *(const f32x4*)(g1 + bj * HALF + n * 16);
#pragma unroll
        for (int ai = 0; ai < 2; ++ai)
#pragma unroll
            for (int m = 0; m < 4; ++m) { const int r = u.pm * BM + ai * HALF + wr * 64 + m * 16 + fr; const size_t off = (size_t)r * DM + col0; float ss = 0.f;
#pragma unroll
                for (int bj = 0; bj < 2; ++bj)
#pragma unroll
                    for (int n = 0; n < 2; ++n) { const f32x4 xv = *(const f32x4*)(x + off + bj * HALF + n * 16); const f32x4 o = xv + gv[bj][n] * acc[ai][bj][m][n];
                        ss += (o[0] * o[0] + o[1] * o[1]) + (o[2] * o[2] + o[3] * o[3]); *(f32x4*)(out + off + bj * HALF + n * 16) = o; }
                ss += __shfl_xor(ss, 16); ss += __shfl_xor(ss, 32);
                if (fq == 0) rowss[(size_t)r * 16 + u.pn * 4 + wc] = ss; }
    }
};
}

struct Frame {
    LAS unsigned char* lds; unsigned char* ws; const float* const* in; float* out;
    int tid, lane, wave, bid, G, gw, NGW;
};

DI int origcol(int n) { return n < 1280 ? n : (n < 2816 ? n + 24 : (n < 2840 ? n - 2816 + 1280 : -1)); }

template <class DRow>
DI void tr_item(const float* src, int src_ld, int sc  , bf16_t* dst, int dst_ld, int k0, LAS float* scr, int lane, DRow drow) {
#pragma unroll 8
    for (int i = 0; i < 32; ++i) { const int kk = 2 * i + (lane >> 5); scr[kk * 33 + (lane & 31)] = sc >= 0 ? src[(size_t)(k0 + kk) * src_ld + sc] : 0.f; }
    asm volatile("s_waitcnt lgkmcnt(0)" ::: "memory");
    const int c = lane & 7;
#pragma unroll
    for (int j = 0; j < 4; ++j) { const int n = (lane >> 3) + 8 * j; const LAS float* s = scr + (8 * c) * 33 + n;
        u32x4 o; o.x = pk2(s[0 * 33], s[1 * 33]); o.y = pk2(s[2 * 33], s[3 * 33]); o.z = pk2(s[4 * 33], s[5 * 33]); o.w = pk2(s[6 * 33], s[7 * 33]);
        *(u32x4*)(dst + (size_t)drow(n) * dst_ld + k0 + 8 * c) = o; }
    asm volatile("s_waitcnt lgkmcnt(0)" ::: "memory");
}

DI void phase0(Frame& F) {
    const float* c_in = F.in[1]; const float* w_ada = F.in[2]; const float* b_ada = F.in[3];
    float* mod = (float*)(F.ws + WS_MOD);
    for (int it = F.bid; it < 96; it += F.G) {
        LAS float* cs = (LAS float*)F.lds;
        for (int idx = F.tid; idx < 32 * 1024; idx += NTHREADS) { const int b = idx >> 10, k = idx & 1023; cs[k * 32 + b] = c_in[idx]; }
        __syncthreads();
        float acc[32];
#pragma unroll
        for (int b = 0; b < 32; ++b) acc[b] = 0.f;
        const int j = it * 64 + F.lane;
        for (int kk = 0; kk < 128; ++kk) { const int k = F.wave * 128 + kk; const float w = w_ada[(size_t)k * 6144 + j];
#pragma unroll
            for (int b4 = 0; b4 < 8; ++b4) { const f32x4 cv = *(const LAS f32x4*)(cs + k * 32 + b4 * 4); acc[b4 * 4 + 0] += cv[0] * w; acc[b4 * 4 + 1] += cv[1] * w; acc[b4 * 4 + 2] += cv[2] * w; acc[b4 * 4 + 3] += cv[3] * w; } }
        __syncthreads();
        LAS float* red = (LAS float*)F.lds;
#pragma unroll
        for (int b = 0; b < 32; ++b) red[(F.wave * 32 + b) * 64 + F.lane] = acc[b];
        __syncthreads();
        for (int o = F.tid; o < 2048; o += NTHREADS) { const int b = o >> 6, l = o & 63; float s = b_ada[it * 64 + l];
#pragma unroll
            for (int w = 0; w < 8; ++w) s += red[(w * 32 + b) * 64 + l];
            mod[(size_t)b * 6144 + it * 64 + l] = s; }
        __syncthreads();
    }
    const int gt = F.bid * NTHREADS + F.tid, NGT = F.G * NTHREADS;
    { float* ropeN = (float*)(F.ws + WS_ROPE); float* ropeD = ropeN + 2048 * 16;
      for (int i = gt; i < 2048 * 12; i += NGT) { const int t = i / 12, j = i % 12; const bool isn = j < 8; const int ii = isn ? j : j - 8;
          const float ex = isn ? (float)(2 * ii) / 16.f : (float)(2 * ii) / 8.f;
          const float inv = exp2f(-ex * 18.931568569324174f);
          const float ang = (float)t * inv;
          const double rev = (double)ang * 0.15915494309189535; const double fr = rev - __builtin_rint(rev); const float rr = (float)(fr * 6.283185307179586);
          const float cs = __cosf(rr), sn = __sinf(rr);
          if (isn) { ropeN[(t * 8 + ii) * 2] = cs; ropeN[(t * 8 + ii) * 2 + 1] = sn; } else { ropeD[(t * 4 + ii) * 2] = cs; ropeD[(t * 4 + ii) * 2 + 1] = sn; } } }
    { bf16_t* whi = (bf16_t*)(F.ws + WS_WR); bf16_t* wlo = whi + 48 * 1024;
      for (int i = gt; i < 48 * 1024; i += NGT) { const int c = i >> 10, k = i & 1023; float w = 0.f;
          if (c < 4) w = F.in[20][k * 4 + c]; else if (c < 36) w = F.in[22][k * 32 + (c - 4)];
          const unsigned short h = f2bf(w); whi[i] = h; wlo[i] = f2bf(w - bf2f(h)); } }
    { bf16_t* pe = (bf16_t*)(F.ws + WS_PE);
      for (int i = gt; i < 256 * 1024; i += NGT) { const int r = i >> 10, k = i & 1023; float v = 0.f; if (r < 4) v = F.in[9][(r >> 1) * 2048 + (r & 1) * 1024 + k]; pe[i] = f2bf(v); } }
    { u32x4* l4 = (u32x4*)(F.ws + WS_LIST); for (int i = gt; i < (int)(NEXP * ECAP / 4); i += NGT) l4[i] = (u32x4){0u, 0u, 0u, 0u};
      unsigned* ctl = (unsigned*)(F.ws + WS_CTL); for (int i = gt; i < 8192; i += NGT) ctl[i] = 0u; }
}

DI void phase0_weights(Frame& F) {
    LAS float* scr = (LAS float*)(F.lds + F.wave * 16384);
    const int lane = F.lane;
    constexpr int I_IN = 16 * 96, I_OUT = 16 * 32, I_G = 32 * 16 * 16, I_D = 32 * 8 * 32, I_C = 4 * 16 * 8;
    constexpr int NITEMS = I_IN + I_OUT + 2 * I_G + I_D + I_C;
    for (int it = F.gw; it < NITEMS; it += F.NGW) {
        int r = it;
        if (r < I_IN) { const int kb = r / 96, nb = r % 96, n0 = nb * 32; const int sc = origcol(n0 + (lane & 31));
            tr_item(F.in[6], INCOLS, sc, (bf16_t*)(F.ws + WS_WIN), 1024, kb * 64, scr, lane, [=](int n) { return n0 + n; }); continue; }
        r -= I_IN;
        if (r < I_OUT) { const int kb = r / 32, nb = r % 32, n0 = nb * 32;
            tr_item(F.in[19], 1024, n0 + (lane & 31), (bf16_t*)(F.ws + WS_WOUT), 1024, kb * 64, scr, lane, [=](int n) { return n0 + n; }); continue; }
        r -= I_OUT;
        if (r < 2 * I_G) { const int up = r / I_G; r -= up * I_G; const int e = r / 256, q = r % 256, kb = q / 16, nb = q % 16, n0 = nb * 32;
            const float* src = F.in[24 + up] + (size_t)e * 1024 * 512;
            tr_item(src, 512, n0 + (lane & 31), (bf16_t*)(F.ws + WS_WGU) + (size_t)e * 1024 * 1024, 1024, kb * 64, scr, lane, [=](int n) { const int j = n0 + n; return 8 * (j >> 2) + (j & 3) + 4 * up; }); continue; }
        r -= 2 * I_G;
        if (r < I_D) { const int e = r / 256, q = r % 256, kb = q / 32, nb = q % 32, n0 = nb * 32;
            const float* src = F.in[26] + (size_t)e * 512 * 1024;
            tr_item(src, 1024, n0 + (lane & 31), (bf16_t*)(F.ws + WS_WD) + (size_t)e * 1024 * 512, 512, kb * 64, scr, lane, [=](int n) { return n0 + n; }); continue; }
        r -= I_D;
        { const int kvh = r / 128, q = r % 128, kb = q / 8, nb = q % 8, n0 = nb * 32; const int kv = kvh >> 1, half = kvh & 1;
            const float* src = F.in[10] + (size_t)kv * 2048 * 256 + (size_t)half * 1024 * 256;
            tr_item(src, 256, n0 + (lane & 31), (bf16_t*)(F.ws + WS_WC1) + (size_t)kv * 512 * 1024, 1024, kb * 64, scr, lane, [=](int n) { return half * 256 + n0 + n; }); }
    }
}

DI void phase1(Frame& F) {
    const float* x = F.in[0]; const float* g = F.in[4]; const float* mod = (const float*)(F.ws + WS_MOD); bf16_t* h1 = (bf16_t*)(F.ws + WS_H1);
    const int lane = F.lane;
    for (int m0 = F.gw * 32; m0 < TOK; m0 += F.NGW * 32) {
        const int b = m0 >> 11; const float* sh = mod + (size_t)b * 6144; const float* sc = sh + 1024;
        f32x4 A[4], Bv[4];
#pragma unroll
        for (int j = 0; j < 4; ++j) { const int col = 4 * lane + 256 * j; A[j] = *(const f32x4*)(g + col) * (*(const f32x4*)(sc + col) + 1.f); Bv[j] = *(const f32x4*)(sh + col); }
        const f32x4* xr = (const f32x4*)(x + (size_t)m0 * DM) + lane; u32x2* o8 = (u32x2*)(h1 + (size_t)m0 * DM) + lane;
        f32x4 v0[4], v1[4];
#pragma unroll
        for (int j = 0; j < 4; ++j) { v0[j] = xr[64 * j]; v1[j] = xr[256 + 64 * j]; }
        for (int i = 0; i < 32; i += 2) {
            f32x4 n0[4], n1[4];
            if (i + 2 < 32) {
#pragma unroll
                for (int j = 0; j < 4; ++j) { n0[j] = xr[(size_t)(i + 2) * 256 + 64 * j]; n1[j] = xr[(size_t)(i + 3) * 256 + 64 * j]; }
            }
            float s0 = 0.f, s1 = 0.f;
#pragma unroll
            for (int j = 0; j < 4; ++j) { s0 += (v0[j][0] * v0[j][0] + v0[j][1] * v0[j][1]) + (v0[j][2] * v0[j][2] + v0[j][3] * v0[j][3]); s1 += (v1[j][0] * v1[j][0] + v1[j][1] * v1[j][1]) + (v1[j][2] * v1[j][2] + v1[j][3] * v1[j][3]); }
#pragma unroll
            for (int o = 1; o < 64; o <<= 1) { s0 += __shfl_xor(s0, o); s1 += __shfl_xor(s1, o); }
            const float r0 = rsqrtf(s0 * (1.f / DM) + EPS), r1 = rsqrtf(s1 * (1.f / DM) + EPS);
#pragma unroll
            for (int j = 0; j < 4; ++j) { const f32x4 y0 = v0[j] * r0 * A[j] + Bv[j], y1 = v1[j] * r1 * A[j] + Bv[j];
                u32x2 w0, w1; w0.x = pk2(y0[0], y0[1]); w0.y = pk2(y0[2], y0[3]); w1.x = pk2(y1[0], y1[1]); w1.y = pk2(y1[2], y1[3]);
                o8[(size_t)i * 256 + 64 * j] = w0; o8[(size_t)(i + 1) * 256 + 64 * j] = w1; }
#pragma unroll
            for (int j = 0; j < 4; ++j) { v0[j] = n0[j]; v1[j] = n1[j]; }
        }
    }
}

DI void phase3(Frame& F) {
    const bf16_t* proj = (const bf16_t*)(F.ws + WS_PROJ);
    const float* ropeN = (const float*)(F.ws + WS_ROPE); const float* ropeD = ropeN + 2048 * 16;
    const float* g_nq = F.in[7]; const float* g_nk = F.in[8]; const float* g_dq = F.in[12]; const float* g_dk = F.in[13];
    const int lane = F.lane;
    for (int it = F.gw; it < TOK * 6; it += F.NGW) {
        const int m = it / 6, part = it % 6; const int b = m >> 11, t = m & 2047;
        const int c0 = part * 512 + lane * 8;
        const u32x4 raw = *(const u32x4*)(proj + (size_t)m * NPROJ + c0);
        float v[8]; v[0] = bflo(raw.x); v[1] = bfhi(raw.x); v[2] = bflo(raw.y); v[3] = bfhi(raw.y); v[4] = bflo(raw.z); v[5] = bfhi(raw.z); v[6] = bflo(raw.w); v[7] = bfhi(raw.w);
        float ss = 0.f;
#pragma unroll
        for (int i = 0; i < 8; ++i) ss += v[i] * v[i];
        ss += __shfl_xor(ss, 1); ss += __shfl_xor(ss, 2); const float ss32 = ss; ss += __shfl_xor(ss, 4); const float ss64 = ss;
        float pv[8];
#pragma unroll
        for (int i = 0; i < 8; ++i) pv[i] = __shfl_xor(v[i], 1);
        if (c0 < 1280) {
            const bool isq = c0 < 512; int six = 0, gsel = 0, d0;
            if (isq) { d0 = c0 & 63; } else { const int cc = c0 - 512; six = cc >> 7; gsel = (cc >> 6) & 1; d0 = cc & 63; }
            const bool donorm = isq || six == 2 || six == 4;
            float y[8];
            if (donorm) { const float* gg = isq ? g_nq : (g_nk + (six == 2 ? 64 : 128)); const float rstd = rsqrtf(ss64 * (1.f / 64.f) + EPS);
#pragma unroll
                for (int i = 0; i < 8; ++i) { y[i] = v[i] * rstd * gg[d0 + i]; pv[i] = pv[i] * rstd * gg[(d0 ^ 8) + i]; } }
            else {
#pragma unroll
                for (int i = 0; i < 8; ++i) y[i] = v[i]; }
            float yr[8];
#pragma unroll
            for (int i = 0; i < 8; ++i) yr[i] = y[i];
            if (donorm && d0 < 16) {
#pragma unroll
                for (int i = 0; i < 8; ++i) { const float cs = ropeN[(t * 8 + i) * 2], sn = ropeN[(t * 8 + i) * 2 + 1];
                    yr[i] = d0 == 0 ? (y[i] * cs - pv[i] * sn) : (pv[i] * sn + y[i] * cs); }
            }
            u32x4 w0, w1; w0.x = pk2(y[0], y[1]); w0.y = pk2(y[2], y[3]); w0.z = pk2(y[4], y[5]); w0.w = pk2(y[6], y[7]);
            w1.x = pk2(yr[0], yr[1]); w1.y = pk2(yr[2], yr[3]); w1.z = pk2(yr[4], yr[5]); w1.w = pk2(yr[6], yr[7]);
            if (isq) { const int hd = c0 >> 6; const size_t off = (((size_t)b * 8 + hd) * SEQ + t) * 64 + d0;
                *(u32x4*)((bf16_t*)(F.ws + WS_QN) + off) = w0; *(u32x4*)((bf16_t*)(F.ws + WS_QR) + off) = w1; }
            else { const size_t base = six == 0 ? WS_KC : six == 1 ? WS_VC : six == 2 ? WS_KS : six == 3 ? WS_VS : six == 4 ? WS_KW : WS_VW;
                const size_t off = (((size_t)b * 2 + gsel) * SEQ + t) * 64 + d0;
                *(u32x4*)((bf16_t*)(F.ws + base) + off) = donorm ? w1 : w0; }
        } else if (c0 < 2304) {
            const bool isq = c0 < 1792; const int cc = c0 - (isq ? 1280 : 1792); const int hd = cc >> 6, dd = cc & 63, d0 = dd & 31;
            const float* gg = isq ? g_dq : g_dk; const float rstd = rsqrtf(ss32 * (1.f / 32.f) + EPS);
            float y[8];
#pragma unroll
            for (int i = 0; i < 8; ++i) y[i] = v[i] * rstd * gg[d0 + i];
            if (d0 == 0) {
#pragma unroll
                for (int i = 0; i < 4; ++i) { const float cs = ropeD[(t * 4 + i) * 2], sn = ropeD[(t * 4 + i) * 2 + 1]; const float a = y[i], bb = y[i + 4]; y[i] = a * cs - bb * sn; y[i + 4] = a * sn + bb * cs; }
            }
            u32x4 w; w.x = pk2(y[0], y[1]); w.y = pk2(y[2], y[3]); w.z = pk2(y[4], y[5]); w.w = pk2(y[6], y[7]);
            const size_t off = (((size_t)b * 8 + hd) * SEQ + t) * 64 + dd;
            *(u32x4*)((bf16_t*)(F.ws + (isq ? WS_DQ : WS_DK)) + off) = w;
        } else if (c0 < 2816) {
            const int cc = c0 - 2304; const int hd = cc >> 6, dd = cc & 63; const size_t off = (((size_t)b * 8 + hd) * SEQ + t) * 64 + dd;
            *(u32x4*)((bf16_t*)(F.ws + WS_DV) + off) = raw;
        } else if (c0 < 2840) {
            float* gt = (float*)(F.ws + WS_GATES) + (size_t)m * 24 + (c0 - 2816);
#pragma unroll
            for (int i = 0; i < 8; ++i) gt[i] = 1.f / (1.f + __expf(-v[i]));
        }
    }
}

struct ALane { int k0; int v0; DI int ko(int ks) const { return k0 ^ (ks << 5); } DI int vo(int db) const { return v0 ^ (db << 6); } };
DI ALane alane_init(int lane) {
    ALane L; const int r = lane & 31, hh = lane >> 5, g = lane >> 4, i = lane & 15;
    L.k0 = r * 128 + ((hh ^ ((r >> 1) & 7)) << 4);
    const int rl = 4 * hh + (i >> 2); const int ch = 2 * (g & 1) + ((i & 3) >> 1);
    L.v0 = rl * 128 + ((ch ^ (((rl >> 1) & 1) << 2)) << 4) + 8 * (i & 1);
    return L;
}
DI s16x4 vtr(const LAS char* p) { typedef short v4i16 __attribute__((ext_vector_type(4))); return __builtin_bit_cast(s16x4, __builtin_amdgcn_ds_read_tr16_b64_v4i16((LAS v4i16*)p)); }
DI bf16x8 vfrag(const LAS char* Vt, const ALane& L, int db, int kb, int s) {
    const LAS char* p = Vt + L.vo(db) + (32 * kb + 16 * s) * 128;
    const s16x4 lo = vtr(p), hi = vtr(p + 8 * 128);
    return __builtin_shufflevector(lo, hi, 0, 1, 2, 3, 4, 5, 6, 7);
}
DI bf16x8 pfrag(const f32x16& p, int s) { u32x4 w; w.x = pk2(p[8 * s + 0], p[8 * s + 1]); w.y = pk2(p[8 * s + 2], p[8 * s + 3]); w.z = pk2(p[8 * s + 4], p[8 * s + 5]); w.w = pk2(p[8 * s + 6], p[8 * s + 7]); return __builtin_bit_cast(bf16x8, w); }
DI u32x4 tile_ld(const bf16_t* g, int tid) { return *(const u32x4*)(g + tid * 8); }
DI void tile_st_k(LAS char* Kt, u32x4 v, int tid) { const int row = tid >> 3, ch = tid & 7; *(LAS u32x4*)(Kt + row * 128 + ((ch ^ ((row >> 1) & 7)) << 4)) = v; }
DI void tile_st_v(LAS char* Vt, u32x4 v, int tid) { const int row = tid >> 3, ch = tid & 7; *(LAS u32x4*)(Vt + row * 128 + ((ch ^ (((row >> 1) & 1) << 2)) << 4)) = v; }

constexpr int MK_NONE = 0, MK_LE = 1, MK_GT = 2;
template <int MASK>
DI void sm16(f32x16& a, float c2, float mcl, int kb, int hh, int th) {
    if constexpr (MASK != MK_NONE) asm volatile("" : "+v"(th));
#pragma unroll
    for (int i = 0; i < 16; ++i) {
        float x = __builtin_fmaf(a[i], c2, -mcl);
        if constexpr (MASK != MK_NONE) { const int kl = 32 * kb + crow(i, hh); const bool ok = MASK == MK_LE ? (kl <= th) : (kl > th); x = ok ? x : -1.0e30f; }
        a[i] = fast_exp2(x);
    }
}
DI float sum16(const f32x16& a) { return ((a[0] + a[1]) + (a[2] + a[3])) + ((a[4] + a[5]) + (a[6] + a[7])) + ((a[8] + a[9]) + (a[10] + a[11])) + ((a[12] + a[13]) + (a[14] + a[15])); }
template <int MASK, bool KEEPP>
DI void attn_tile64(const LAS char* Kt, const LAS char* Vt, const ALane& L, const bf16x8 (&qf)[4], f32x16 (&O)[2], float& lsum, float c2, float mcl, int th, int hh, f32x16 (&P)[2]) {
    bf16x8 pf[2][2];
#pragma unroll
    for (int kb = 0; kb < 2; ++kb) {
        f32x16 acc = {0.f, 0.f, 0.f, 0.f, 0.f, 0.f, 0.f, 0.f, 0.f, 0.f, 0.f, 0.f, 0.f, 0.f, 0.f, 0.f};
#pragma unroll
        for (int ks = 0; ks < 4; ++ks) { const bf16x8 kf = *(const LAS bf16x8*)(Kt + L.ko(ks) + kb * 4096); acc = MFMA32(kf, qf[ks], acc); }
        sm16<MASK>(acc, c2, mcl, kb, hh, th);
        lsum += sum16(acc); pf[kb][0] = pfrag(acc, 0); pf[kb][1] = pfrag(acc, 1);
        if constexpr (KEEPP) P[kb] = acc;
    }
#pragma unroll
    for (int kb = 0; kb < 2; ++kb)
#pragma unroll
        for (int s = 0; s < 2; ++s)
#pragma unroll
            for (int db = 0; db < 2; ++db) O[db] = MFMA32(vfrag(Vt, L, db, kb, s), pf[kb][s], O[db]);
}
template <int MASK>
DI void attn_tile_dm(const LAS char* Kt, const LAS char* Vt, const ALane& L, int ko0, int ko1, const bf16x8 (&qf)[2], f32x16 (&O)[2], float& lsum, float c2, float mc, int th, int hh) {
    bf16x8 pf[2][2];
#pragma unroll
    for (int kb = 0; kb < 2; ++kb) {
        f32x16 acc = {0.f, 0.f, 0.f, 0.f, 0.f, 0.f, 0.f, 0.f, 0.f, 0.f, 0.f, 0.f, 0.f, 0.f, 0.f, 0.f};
        const bf16x8 k0 = *(const LAS bf16x8*)(Kt + ko0 + kb * 4096), k1 = *(const LAS bf16x8*)(Kt + ko1 + kb * 4096);
        acc = MFMA32(k0, qf[0], acc); acc = MFMA32(k1, qf[1], acc);
        sm16<MASK>(acc, c2, mc, kb, hh, th);
        lsum += sum16(acc); pf[kb][0] = pfrag(acc, 0); pf[kb][1] = pfrag(acc, 1);
    }
#pragma unroll
    for (int kb = 0; kb < 2; ++kb)
#pragma unroll
        for (int s = 0; s < 2; ++s)
#pragma unroll
            for (int db = 0; db < 2; ++db) O[db] = MFMA32(vfrag(Vt, L, db, kb, s), pf[kb][s], O[db]);
}
#define RING_WAIT(n) asm volatile("s_waitcnt vmcnt(" #n ")" ::: "memory")
template <class CompF>
DI void attn_ring(LAS char* lds, const bf16_t* Kg, const bf16_t* Vg, unsigned tiles, int wid, int lane, CompF comp) {
    if (tiles == 0u) return;
    const int p = wid * 64 + lane, row = p >> 3, c = p & 7;
    const unsigned ksrc = (unsigned)(row * 128 + ((c ^ ((row >> 1) & 7)) << 4)), vsrc = (unsigned)(row * 128 + ((c ^ (((row >> 1) & 1) << 2)) << 4));
    LAS char* wb = lds + wid * 1024;
#define RING_ISSUE(j, slot) do { \
        __builtin_amdgcn_global_load_lds((const unsigned*)((const char*)(Kg) + (size_t)(j) * 8192 + ksrc), (LAS unsigned*)(wb + (slot) * 16384), 16, 0, 0); \
        __builtin_amdgcn_global_load_lds((const unsigned*)((const char*)(Vg) + (size_t)(j) * 8192 + vsrc), (LAS unsigned*)(wb + (slot) * 16384 + 8192), 16, 0, 0); } while (0)
    int q0 = __builtin_ctz(tiles); tiles &= tiles - 1u;
    int q1 = -1, q2 = -1;
    if (tiles) { q1 = __builtin_ctz(tiles); tiles &= tiles - 1u; }
    if (tiles) { q2 = __builtin_ctz(tiles); tiles &= tiles - 1u; }
    RING_ISSUE(q0, 0);
    if (q1 >= 0) RING_ISSUE(q1, 1);
    if (q2 >= 0) RING_ISSUE(q2, 2);
    int i = 0;
    for (;;) {
        if (q2 >= 0) RING_WAIT(4); else if (q1 >= 0) RING_WAIT(2); else RING_WAIT(0);
        __builtin_amdgcn_s_barrier();
        int q3 = -1;
        if (tiles) { q3 = __builtin_ctz(tiles); tiles &= tiles - 1u; RING_ISSUE(q3, (i + 3) & 3); }
        LAS char* st = lds + (i & 3) * 16384;
        comp(q0, st, st + 8192);
        if (q1 < 0) break;
        q0 = q1; q1 = q2; q2 = q3; ++i;
    }
    asm volatile("s_waitcnt lgkmcnt(0)" ::: "memory");
    __builtin_amdgcn_s_barrier();
#undef RING_ISSUE
}

DI void diff_unit(Frame& F, int b, int hd, int qb, float c2, float mc, float lam) {
    const int tid = F.tid, lane = F.lane, wid = F.wave, r = lane & 31, hh = lane >> 5;
    const int rb = wid >> 1, mp = wid & 1;
    const bf16_t* Q = (const bf16_t*)(F.ws + WS_DQ) + ((size_t)b * 8 + hd) * SEQ * 64;
    const bf16_t* Kg = (const bf16_t*)(F.ws + WS_DK) + ((size_t)b * 8 + hd) * SEQ * 64;
    const bf16_t* Vg = (const bf16_t*)(F.ws + WS_DV) + ((size_t)b * 8 + hd) * SEQ * 64;
    LAS char* lds = (LAS char*)F.lds;
    const ALane L = alane_init(lane);
    const int ko0 = L.ko(2 * mp), ko1 = L.ko(2 * mp + 1);
    const int q0w = qb * 128 + rb * 32; const int qq = q0w + r;
    bf16x8 qf[2];
#pragma unroll
    for (int ks = 0; ks < 2; ++ks) qf[ks] = *(const bf16x8*)(Q + (size_t)qq * 64 + mp * 32 + ks * 16 + hh * 8);
    f32x16 O[2]; float lsum = 0.f;
#pragma unroll
    for (int i = 0; i < 16; ++i) { O[0][i] = 0.f; O[1][i] = 0.f; }
    const int ntile = 2 * qb + 2; const int jmax = 2 * qb + (rb >> 1);
    const unsigned tiles = ntile == 32 ? 0xffffffffu : ((1u << ntile) - 1u);
    attn_ring(lds, Kg, Vg, tiles, wid, lane, [&](int j, const LAS char* Kt, const LAS char* Vt) __attribute__((always_inline)) {
        if (j < jmax) attn_tile_dm<MK_NONE>(Kt, Vt, L, ko0, ko1, qf, O, lsum, c2, mc, 0, hh);
        else if (j == jmax) attn_tile_dm<MK_LE>(Kt, Vt, L, ko0, ko1, qf, O, lsum, c2, mc, qq - 64 * j, hh);
    });
    lsum += __shfl_xor(lsum, 32);
    LAS float* xo = (LAS float*)(lds + 65536 + rb * 8192) + lane;
    if (mp == 1) { const float s1 = lam / lsum;
#pragma unroll
        for (int db = 0; db < 2; ++db)
#pragma unroll
            for (int i = 0; i < 16; ++i) xo[(db * 16 + i) * 64] = O[db][i] * s1; }
    __syncthreads();
    if (mp == 0) {
        const float i0 = 1.f / lsum; float ss = 0.f;
#pragma unroll
        for (int db = 0; db < 2; ++db)
#pragma unroll
            for (int i = 0; i < 16; ++i) { const float o = O[db][i] * i0 - xo[(db * 16 + i) * 64]; O[db][i] = o; ss += o * o; }
        ss += __shfl_xor(ss, 32);
        const float rstd = rsqrtf(ss * (1.f / 64.f) + EPS) * 0.8f;
        const float* go = F.in[18];
        bf16_t* orow = (bf16_t*)(F.ws + WS_AO) + ((size_t)b * SEQ + qq) * DM + 512 + hd * 64;
#pragma unroll
        for (int db = 0; db < 2; ++db)
#pragma unroll
            for (int g4 = 0; g4 < 4; ++g4) { const int d = 32 * db + 8 * g4 + 4 * hh; const f32x4 gv = *(const f32x4*)(go + d);
                u32x2 w; w.x = pk2(O[db][4 * g4] * rstd * gv[0], O[db][4 * g4 + 1] * rstd * gv[1]); w.y = pk2(O[db][4 * g4 + 2] * rstd * gv[2], O[db][4 * g4 + 3] * rstd * gv[3]);
                *(u32x2*)(orow + d) = w; }
    }
}

DI void nsa_unit(Frame& F, int b, int g, int qb, float c2, float mc) {
    const int tid = F.tid, lane = F.lane, wid = F.wave, r = lane & 31, hh = lane >> 5;
    const int hd = 4 * g + (wid >> 1); const int tl = 32 * (wid & 1) + r; const int t = 64 * qb + tl;
    LAS char* lds = (LAS char*)F.lds;
    LAS float* impP = (LAS float*)(lds + 65536);
    LAS unsigned* selm = (LAS unsigned*)(lds + LDS_MISC + 5120);
    LAS float* otp = (LAS float*)(lds + 65536 + wid * 8192) + lane;
    const ALane L = alane_init(lane);
    const size_t bg = (size_t)b * 2 + g;
    const bf16_t* QN = (const bf16_t*)(F.ws + WS_QN) + (((size_t)b * 8 + hd) * SEQ + t) * 64;
    const bf16_t* QR = (const bf16_t*)(F.ws + WS_QR) + (((size_t)b * 8 + hd) * SEQ + t) * 64;
    const float* gates = (const float*)(F.ws + WS_GATES) + ((size_t)b * SEQ + t) * 24 + hd * 3;
    LAS float* gpark = (LAS float*)(lds + LDS_MISC + 8192 + wid * 768) + lane;
    { const float g0_ = gates[0], g1_ = gates[1], g2_ = gates[2]; gpark[0] = g0_; gpark[64] = g1_; gpark[128] = g2_; }
    bf16x8 qf[4];
    f32x16 O[2]; float lv = 0.f; float s0 = 0.f;
#pragma unroll
    for (int i = 0; i < 16; ++i) { O[0][i] = 0.f; O[1][i] = 0.f; }
    LAS float* invs = (LAS float*)(selm + 128);
    {
        const bf16_t* Kc = (const bf16_t*)(F.ws + WS_KCMP) + bg * 128 * 64; const bf16_t* Vc = (const bf16_t*)(F.ws + WS_VCMP) + bg * 128 * 64;
        const u32x4 k0 = tile_ld(Kc, tid), k1 = tile_ld(Kc + 4096, tid), v0 = tile_ld(Vc, tid), v1 = tile_ld(Vc + 4096, tid);
        tile_st_k(lds, k0, tid); tile_st_v(lds + 8192, v0, tid); tile_st_k(lds + 16384, k1, tid); tile_st_v(lds + 24576, v1, tid);
#pragma unroll
        for (int ks = 0; ks < 4; ++ks) qf[ks] = *(const bf16x8*)(QN + ks * 16 + hh * 8);
        __syncthreads();
        const int nvalid = t >= 31 ? ((t - 31) >> 4) + 1 : 0;
        LAS float* ip = impP + ((wid >> 1) * 64 + tl) * 33;
        float carry_in = 0.f;
#pragma unroll 1
        for (int tile = 0; tile < 2; ++tile) {
            f32x16 P[2];
            attn_tile64<MK_LE, true>(lds + tile * 16384, lds + tile * 16384 + 8192, L, qf, O, lv, c2, mc, nvalid - 1 - 64 * tile, hh, P);
            float av[8], rc[8];
#pragma unroll
            for (int kb = 0; kb < 2; ++kb)
#pragma unroll
                for (int gq = 0; gq < 4; ++gq) { const int f = 4 * kb + gq; const float p3 = 0.5f * P[kb][4 * gq + 3]; av[f] = P[kb][4 * gq] + P[kb][4 * gq + 1] + P[kb][4 * gq + 2] + p3; rc[f] = __shfl_xor(p3, 32); }
#pragma unroll
            for (int f = 0; f < 8; ++f) { const float carry = hh == 1 ? rc[f] : (f > 0 ? rc[f > 0 ? f - 1 : 0] : carry_in); ip[2 * (8 * tile + f) + hh] = av[f] + carry; }
            carry_in = rc[7];
        }
        float lsum = lv; lsum += __shfl_xor(lsum, 32);
        const float inv = lsum > 0.f ? 1.f / lsum : 0.f;
        if (hh == 0) invs[(wid >> 1) * 64 + tl] = inv;
        s0 = gpark[0] * inv;
        lv = 0.f;
    }
#pragma unroll
    for (int ks = 0; ks < 4; ++ks) qf[ks] = *(const bf16x8*)(QR + ks * 16 + hh * 8);
    __syncthreads();
    if (wid == 0) {
        unsigned m;
        if (qb <= 5) m = (1u << (qb + 1)) - 1u;
        else {
            m = 1u | (1u << qb) | (1u << (qb - 1));
            float best[3] = {-1.f, -1.f, -1.f}; int bi[3] = {0, 0, 0}; const float iv0 = invs[lane], iv1 = invs[64 + lane], iv2 = invs[128 + lane], iv3 = invs[192 + lane];
            for (int j = 1; j <= qb - 2; ++j) {
                const float v = (impP[(0 * 64 + lane) * 33 + j] * iv0 + impP[(1 * 64 + lane) * 33 + j] * iv1) + (impP[(2 * 64 + lane) * 33 + j] * iv2 + impP[(3 * 64 + lane) * 33 + j] * iv3);
                if (v > best[0]) { best[2] = best[1]; bi[2] = bi[1]; best[1] = best[0]; bi[1] = bi[0]; best[0] = v; bi[0] = j; }
                else if (v > best[1]) { best[2] = best[1]; bi[2] = bi[1]; best[1] = v; bi[1] = j; }
                else if (v > best[2]) { best[2] = v; bi[2] = j; }
            }
            m |= (1u << bi[0]) | (1u << bi[1]) | (1u << bi[2]);
        }
        selm[lane] = m;
        unsigned u = m;
#pragma unroll
        for (int o = 1; o < 64; o <<= 1) u |= (unsigned)__shfl_xor((int)u, o);
        if (lane == 0) selm[64] = u;
    }
    __syncthreads();
    const unsigned mym = selm[tl]; const unsigned uni = selm[64];
#pragma unroll
    for (int db = 0; db < 2; ++db)
#pragma unroll
        for (int i = 0; i < 16; ++i) { otp[(db * 16 + i) * 64] = O[db][i] * s0; O[db][i] = 0.f; }
    {
        attn_ring(lds, (const bf16_t*)(F.ws + WS_KS) + bg * SEQ * 64, (const bf16_t*)(F.ws + WS_VS) + bg * SEQ * 64, uni, wid, lane, [&](int j, const LAS char* Kt, const LAS char* Vt) __attribute__((always_inline)) {
            const bool act = ((mym >> j) & 1u) != 0u;
            if (__ballot(act) == 0ull) return;
            const float mcl = act ? mc : 1.0e30f; f32x16 P[2];
            if (j < qb) attn_tile64<MK_NONE, false>(Kt, Vt, L, qf, O, lv, c2, mcl, 0, hh, P); else attn_tile64<MK_LE, false>(Kt, Vt, L, qf, O, lv, c2, mcl, tl, hh, P);
        });
        float lsum = lv; lsum += __shfl_xor(lsum, 32);
        const float s1 = gpark[64] / lsum;
#pragma unroll
        for (int db = 0; db < 2; ++db)
#pragma unroll
            for (int i = 0; i < 16; ++i) { otp[(db * 16 + i) * 64] += O[db][i] * s1; O[db][i] = 0.f; }
        lv = 0.f;
    }
    {
        const int jlo = qb >= 4 ? qb - 4 : 0; const unsigned wt = ((qb == 31 ? 0xffffffffu : ((1u << (qb + 1)) - 1u))) & ~((1u << jlo) - 1u);
        attn_ring(lds, (const bf16_t*)(F.ws + WS_KW) + bg * SEQ * 64, (const bf16_t*)(F.ws + WS_VW) + bg * SEQ * 64, wt, wid, lane, [&](int j, const LAS char* Kt, const LAS char* Vt) __attribute__((always_inline)) {
            f32x16 P[2];
            if (j == qb) attn_tile64<MK_LE, false>(Kt, Vt, L, qf, O, lv, c2, mc, tl, hh, P);
            else if (j == qb - 4) attn_tile64<MK_GT, false>(Kt, Vt, L, qf, O, lv, c2, mc, tl, hh, P);
            else attn_tile64<MK_NONE, false>(Kt, Vt, L, qf, O, lv, c2, mc, 0, hh, P);
        });
        float lsum = lv; lsum += __shfl_xor(lsum, 32);
        const float s2 = gpark[128] / lsum;
#pragma unroll
        for (int db = 0; db < 2; ++db)
#pragma unroll
            for (int i = 0; i < 16; ++i) O[db][i] = otp[(db * 16 + i) * 64] + O[db][i] * s2;
    }
    bf16_t* orow = (bf16_t*)(F.ws + WS_AO) + ((size_t)b * SEQ + t) * DM + hd * 64;
#pragma unroll
    for (int db = 0; db < 2; ++db)
#pragma unroll
        for (int g4 = 0; g4 < 4; ++g4) { const int d = 32 * db + 8 * g4 + 4 * hh;
            u32x2 w; w.x = pk2(O[db][4 * g4], O[db][4 * g4 + 1]); w.y = pk2(O[db][4 * g4 + 2], O[db][4 * g4 + 3]);
            *(u32x2*)(orow + d) = w; }
}

DI float gmax(const float* g, int n, int lane) { float v = lane < n ? fabsf(g[lane]) : 0.f;
#pragma unroll
    for (int o = 1; o < 64; o <<= 1) v = fmaxf(v, __shfl_xor(v, o));
    return v; }

DI int queue_next(Frame& F, unsigned* ctr) {
    LAS int* slot = (LAS int*)(F.lds + LDS_MISC + 4096);
    __syncthreads();
    if (F.tid == 0) *slot = (int)atomicAdd(ctr, 1u);
    __syncthreads();
    return *slot;
}

DI int queue_pass(Frame& F, unsigned nx) {
    LAS int* slot = (LAS int*)(F.lds + LDS_MISC + 4096);
    __syncthreads();
    if (F.tid == 0) *slot = (int)nx;
    __syncthreads();
    return *slot;
}

DI float gelu_tanh(float x) { const float u = 0.7978845608028654f * (x + 0.044715f * x * x * x); const float e = __expf(2.f * u); const float th = 1.f - 2.f / (e + 1.f); return 0.5f * x * (1.f + th); }
DI void phase5(Frame& F) {
    const bf16_t* UL = (const bf16_t*)(F.ws + WS_UL); const float* w2 = F.in[11]; const float* gk0 = F.in[8];
    LAS float* w2s = (LAS float*)F.lds;
    LAS float* hid = (LAS float*)(F.lds + LDS_MISC + 8192 + F.wave * 1024);
    for (int i = F.tid; i < 2 * 256 * 64 / 4; i += NTHREADS) ((LAS f32x4*)w2s)[i] = ((const f32x4*)w2)[i];
    __syncthreads();
    const int lane = F.lane;
    for (int it = F.gw; it < 2 * 64 * 128; it += F.NGW) {
        const int kv = it >> 13, rem = it & 8191, bgi = rem >> 7, c = rem & 127;
        bf16_t* dst = (bf16_t*)(F.ws + (kv ? WS_VCMP : WS_KCMP)) + ((size_t)bgi * 128 + c) * 64;
        if (c == 127) { dst[lane] = 0; continue; }
        const size_t row = (size_t)kv * 8192 + (size_t)bgi * 128 + c;
        const size_t perow = 16384 + (size_t)kv * 256 + (size_t)kv * 2;
        const u32x2 u4 = *(const u32x2*)(UL + row * 512 + 4 * lane), l4 = *(const u32x2*)(UL + (row + 1) * 512 + 256 + 4 * lane);
        const u32x2 pu = *(const u32x2*)(UL + perow * 512 + 4 * lane), pl = *(const u32x2*)(UL + (perow + 1) * 512 + 256 + 4 * lane);
        float h[4];
        h[0] = bflo(u4.x) + bflo(l4.x) + bflo(pu.x) + bflo(pl.x); h[1] = bfhi(u4.x) + bfhi(l4.x) + bfhi(pu.x) + bfhi(pl.x);
        h[2] = bflo(u4.y) + bflo(l4.y) + bflo(pu.y) + bflo(pl.y); h[3] = bfhi(u4.y) + bfhi(l4.y) + bfhi(pu.y) + bfhi(pl.y);
        f32x4 hv;
#pragma unroll
        for (int i = 0; i < 4; ++i) hv[i] = gelu_tanh(h[i]);
        *(LAS f32x4*)(hid + 4 * lane) = hv;
        asm volatile("s_waitcnt lgkmcnt(0)" ::: "memory");
        const LAS float* w = w2s + kv * 256 * 64 + lane; float acc0 = 0.f, acc1 = 0.f;
#pragma unroll 8
        for (int k = 0; k < 256; k += 4) { const f32x4 hh4 = *(const LAS f32x4*)(hid + k);
            acc0 += hh4[0] * w[(k + 0) * 64]; acc1 += hh4[1] * w[(k + 1) * 64]; acc0 += hh4[2] * w[(k + 2) * 64]; acc1 += hh4[3] * w[(k + 3) * 64]; }
        float acc = acc0 + acc1;
        if (kv == 0) { const float ss = wave_sum(acc * acc); acc = acc * rsqrtf(ss * (1.f / 64.f) + EPS) * gk0[lane]; }
        dst[lane] = f2bf(acc);
        asm volatile("s_waitcnt lgkmcnt(0)" ::: "memory");
    }
    __syncthreads();
}

DI void phase8(Frame& F) {
    const float* x1 = F.out; const float* gf = F.in[5]; const float* mod = (const float*)(F.ws + WS_MOD); const float* rowss = (const float*)(F.ws + WS_ROWSS);
    const bf16_t* whi = (const bf16_t*)(F.ws + WS_WR); const bf16_t* wlo = whi + 48 * 1024;
    bf16_t* h2 = (bf16_t*)(F.ws + WS_H2);
    unsigned* cnt = (unsigned*)(F.ws + WS_CTL) + CW_CNT; int* lists = (int*)(F.ws + WS_LIST);
    int* tipos = (int*)(F.ws + WS_TIPOS); int* tie = (int*)(F.ws + WS_TIE); float* tiw = (float*)(F.ws + WS_TIW);
    const float* brg = F.in[21]; const float* bre = F.in[23];
    const int lane = F.lane, wid = F.wave, row = lane & 15, kq = lane >> 4;
    LAS float* lg = (LAS float*)(F.lds + wid * 3072);
    LAS unsigned* hist = (LAS unsigned*)(F.lds + 32768);
    LAS float* A2 = (LAS float*)(F.lds + 36864);
    LAS float* B2 = A2 + 1024;
    const int nbatch = TOK / 128;
    for (int bt = F.bid; bt < nbatch; bt += F.G) {
        const int m0 = bt * 128 + wid * 16; const int m = m0 + row; const int b = m0 >> 11;
        { const float* sh = mod + (size_t)b * 6144 + 3072; const float* sc = sh + 1024;
          for (int k = F.tid; k < 1024; k += NTHREADS) { A2[k] = gf[k] * (sc[k] + 1.f); B2[k] = sh[k]; } }
        if (F.tid < 64) hist[F.tid] = 0u;
        float rs = 0.f; { const f32x4* rp = (const f32x4*)(rowss + (size_t)m * 16);
#pragma unroll
            for (int q = 0; q < 4; ++q) { const f32x4 v = rp[q]; rs += (v[0] + v[1]) + (v[2] + v[3]); } }
        const float rstd = rsqrtf(rs * (1.f / DM) + EPS);
        const float* xrow = x1 + (size_t)m * DM + 8 * kq; bf16_t* hrow = h2 + (size_t)m * DM + 8 * kq;
        f32x4 xa[4], xb[4];
#pragma unroll
        for (int u = 0; u < 4; ++u) { xa[u] = *(const f32x4*)(xrow + 32 * u); xb[u] = *(const f32x4*)(xrow + 32 * u + 4); }
        __syncthreads();
        f32x4 acc[3] = {{0.f, 0.f, 0.f, 0.f}, {0.f, 0.f, 0.f, 0.f}, {0.f, 0.f, 0.f, 0.f}};
        for (int g4 = 0; g4 < 8; ++g4) {
            f32x4 na[4], nb[4];
            if (g4 + 1 < 8) {
#pragma unroll
                for (int u = 0; u < 4; ++u) { na[u] = *(const f32x4*)(xrow + 128 * (g4 + 1) + 32 * u); nb[u] = *(const f32x4*)(xrow + 128 * (g4 + 1) + 32 * u + 4); }
            }
#pragma unroll
            for (int u = 0; u < 4; ++u) {
                const int k0 = 128 * g4 + 32 * u + 8 * kq;
                const f32x4 a0 = *(const LAS f32x4*)(A2 + k0), a1 = *(const LAS f32x4*)(A2 + k0 + 4), b0 = *(const LAS f32x4*)(B2 + k0), b1 = *(const LAS f32x4*)(B2 + k0 + 4);
                const f32x4 ya = xa[u] * rstd * a0 + b0, yb = xb[u] * rstd * a1 + b1;
                u32x4 hi; hi.x = pk2(ya[0], ya[1]); hi.y = pk2(ya[2], ya[3]); hi.z = pk2(yb[0], yb[1]); hi.w = pk2(yb[2], yb[3]);
                *(u32x4*)(hrow + 128 * g4 + 32 * u) = hi;
                u32x4 lo; lo.x = pk2(ya[0] - bflo(hi.x), ya[1] - bfhi(hi.x)); lo.y = pk2(ya[2] - bflo(hi.y), ya[3] - bfhi(hi.y)); lo.z = pk2(yb[0] - bflo(hi.z), yb[1] - bfhi(hi.z)); lo.w = pk2(yb[2] - bflo(hi.w), yb[3] - bfhi(hi.w));
                const bf16x8 ahi = __builtin_bit_cast(bf16x8, hi), alo = __builtin_bit_cast(bf16x8, lo);
#pragma unroll
                for (int ct = 0; ct < 3; ++ct) { const bf16x8 bh = *(const bf16x8*)(whi + (size_t)(16 * ct + row) * 1024 + k0), bl = *(const bf16x8*)(wlo + (size_t)(16 * ct + row) * 1024 + k0);
                    acc[ct] = MFMA16(ahi, bh, acc[ct]); acc[ct] = MFMA16(alo, bh, acc[ct]); acc[ct] = MFMA16(ahi, bl, acc[ct]); }
            }
#pragma unroll
            for (int u = 0; u < 4; ++u) { xa[u] = na[u]; xb[u] = nb[u]; }
        }
#pragma unroll
        for (int ct = 0; ct < 3; ++ct)
#pragma unroll
            for (int i = 0; i < 4; ++i) lg[(kq * 4 + i) * 48 + 16 * ct + row] = acc[ct][i];
        asm volatile("s_waitcnt lgkmcnt(0)" ::: "memory");
        int e0 = 0, e1 = 0; float w0 = 0.f, w1 = 0.f; unsigned lp0 = 0u, lp1 = 0u;
        if (lane < 16) {
            const LAS float* lr = lg + lane * 48;
            float g4v[4]; int grp = 0; float gm = -3.0e38f;
#pragma unroll
            for (int i = 0; i < 4; ++i) { g4v[i] = lr[i] + brg[i]; if (g4v[i] > gm) { gm = g4v[i]; grp = i; } }
            float den = 0.f;
#pragma unroll
            for (int i = 0; i < 4; ++i) den += __expf(g4v[i] - gm);
            const float pg = 1.f / den;
            float v0 = -3.0e38f, v1 = -3.0e38f; int i0 = 0, i1 = 0;
            for (int i = 0; i < 8; ++i) { const float v = lr[4 + grp * 8 + i] + bre[grp * 8 + i];
                if (v > v0) { v1 = v0; i1 = i0; v0 = v; i0 = i; } else if (v > v1) { v1 = v; i1 = i; } }
            const float ex = __expf(v1 - v0); w0 = pg / (1.f + ex); w1 = pg * ex / (1.f + ex);
            e0 = grp * 8 + i0; e1 = grp * 8 + i1;
            lp0 = atomicAdd((unsigned*)&hist[e0], 1u); lp1 = atomicAdd((unsigned*)&hist[e1], 1u);
        }
        __syncthreads();
        if (F.tid < 32) { const unsigned n = hist[F.tid]; hist[32 + F.tid] = n ? atomicAdd(cnt + F.tid, n) : 0u; }
        __syncthreads();
        if (lane < 16) {
            const int tok = m0 + lane; const int p0 = (int)(hist[32 + e0] + lp0), p1 = (int)(hist[32 + e1] + lp1);
            lists[(size_t)e0 * ECAP + p0] = tok; lists[(size_t)e1 * ECAP + p1] = tok;
            tipos[2 * tok] = p0; tipos[2 * tok + 1] = p1; tie[tok] = e0 | (e1 << 8); tiw[2 * tok] = w0; tiw[2 * tok + 1] = w1;
        }
        __syncthreads();
    }
}

DI LAS int* moe_prefix(Frame& F) {
    LAS int* tb = (LAS int*)(F.lds + LDS_MISC);
    __syncthreads();
    if (F.tid == 0) { const unsigned* cnt = (const unsigned*)(F.ws + WS_CTL) + CW_CNT; int s = 0; for (int e = 0; e < 32; ++e) { tb[e] = s; s += (int)((__hip_atomic_load(cnt + e, __ATOMIC_RELAXED, __HIP_MEMORY_SCOPE_AGENT) + 255u) >> 8); } tb[32] = s; }
    __syncthreads();
    return tb;
}

DI void phase11(Frame& F) {
    LAS int* tb = moe_prefix(F);
    const bf16_t* Y = (const bf16_t*)(F.ws + WS_Y); const float* mod = (const float*)(F.ws + WS_MOD);
    const int* tipos = (const int*)(F.ws + WS_TIPOS); const int* tie = (const int*)(F.ws + WS_TIE); const float* tiw = (const float*)(F.ws + WS_TIW);
    const int lane = F.lane;
    for (int m0 = F.gw * 32; m0 < TOK; m0 += F.NGW * 32) {
        const int b = m0 >> 11; const float* g2 = mod + (size_t)b * 6144 + 5120;
        f32x4 ga[2], gb[2];
#pragma unroll
        for (int j = 0; j < 2; ++j) { ga[j] = *(const f32x4*)(g2 + 8 * lane + 512 * j); gb[j] = *(const f32x4*)(g2 + 8 * lane + 512 * j + 4); }
        int mr0 = 0, mr1 = 0; float mw0 = 0.f, mw1 = 0.f;
        { const int mm = m0 + (lane & 31); const int ee = tie[mm]; mr0 = tb[ee & 255] * 256 + tipos[2 * mm]; mr1 = tb[ee >> 8] * 256 + tipos[2 * mm + 1]; mw0 = tiw[2 * mm]; mw1 = tiw[2 * mm + 1]; }
        float* obase = F.out + (size_t)m0 * DM + 8 * lane;
#define P11_LOAD(i, ya, yb, xa, xb) do { const size_t r0_ = (size_t)__shfl(mr0, (i)), r1_ = (size_t)__shfl(mr1, (i)); \
            _Pragma("unroll") for (int j = 0; j < 2; ++j) { ya[j] = *(const u32x4*)(Y + r0_ * DM + 8 * lane + 512 * j); yb[j] = *(const u32x4*)(Y + r1_ * DM + 8 * lane + 512 * j); \
                xa[j] = *(const f32x4*)(obase + (size_t)(i) * DM + 512 * j); xb[j] = *(const f32x4*)(obase + (size_t)(i) * DM + 512 * j + 4); } } while (0)
        u32x4 ya0[2], yb0[2], ya1[2], yb1[2]; f32x4 xa0[2], xb0[2], xa1[2], xb1[2];
        P11_LOAD(0, ya0, yb0, xa0, xb0); P11_LOAD(1, ya1, yb1, xa1, xb1);
        for (int i = 0; i < 32; i += 2) {
            u32x4 nya0[2], nyb0[2], nya1[2], nyb1[2]; f32x4 nxa0[2], nxb0[2], nxa1[2], nxb1[2];
            if (i + 2 < 32) { P11_LOAD(i + 2, nya0, nyb0, nxa0, nxb0); P11_LOAD(i + 3, nya1, nyb1, nxa1, nxb1); }
#define P11_ROW(i, ya, yb, xa, xb) do { const float w0 = __shfl(mw0, (i)), w1 = __shfl(mw1, (i)); \
            _Pragma("unroll") for (int j = 0; j < 2; ++j) { f32x4 oa = xa[j], ob = xb[j]; \
                oa[0] += ga[j][0] * (w0 * bflo(ya[j].x) + w1 * bflo(yb[j].x)); oa[1] += ga[j][1] * (w0 * bfhi(ya[j].x) + w1 * bfhi(yb[j].x)); \
                oa[2] += ga[j][2] * (w0 * bflo(ya[j].y) + w1 * bflo(yb[j].y)); oa[3] += ga[j][3] * (w0 * bfhi(ya[j].y) + w1 * bfhi(yb[j].y)); \
                ob[0] += gb[j][0] * (w0 * bflo(ya[j].z) + w1 * bflo(yb[j].z)); ob[1] += gb[j][1] * (w0 * bfhi(ya[j].z) + w1 * bfhi(yb[j].z)); \
                ob[2] += gb[j][2] * (w0 * bflo(ya[j].w) + w1 * bflo(yb[j].w)); ob[3] += gb[j][3] * (w0 * bfhi(ya[j].w) + w1 * bfhi(yb[j].w)); \
                *(f32x4*)(obase + (size_t)(i) * DM + 512 * j) = oa; *(f32x4*)(obase + (size_t)(i) * DM + 512 * j + 4) = ob; } } while (0)
            P11_ROW(i, ya0, yb0, xa0, xb0); P11_ROW(i + 1, ya1, yb1, xa1, xb1);
#pragma unroll
            for (int j = 0; j < 2; ++j) { ya0[j] = nya0[j]; yb0[j] = nyb0[j]; xa0[j] = nxa0[j]; xb0[j] = nxb0[j]; ya1[j] = nya1[j]; yb1[j] = nyb1[j]; xa1[j] = nxa1[j]; xb1[j] = nxb1[j]; }
        }
#undef P11_LOAD
#undef P11_ROW
    }
}

constexpr int CW_BAR = 4096;
#define XB_TMO      128
#define XB_XCNT(j)  (256  + 64 * (j))
#define XB_XSUB(j)  (1280 + 64 * (j))
#define XB_XGEN(j)  (2304 + 64 * (j))
#define XB_TOP      3328
#define XB_TOPGEN   3392
#define XB_SPIN_CAP (1u << 22)
DI unsigned xb_ld(unsigned* p)              { return __hip_atomic_load(p, __ATOMIC_RELAXED, __HIP_MEMORY_SCOPE_AGENT); }
DI unsigned xb_add(unsigned* p, unsigned v) { return __hip_atomic_fetch_add(p, v, __ATOMIC_RELAXED, __HIP_MEMORY_SCOPE_AGENT); }
DI unsigned xb_xcc_id() { return (unsigned)__builtin_amdgcn_s_getreg((3 << 11) | 20) & 0xFu; }
#define XB_SPIN(cond, bar) do { unsigned _sp = 0; while (cond) { __builtin_amdgcn_s_sleep(1); \
    if ((++_sp & 255u) == 0u) { if (xb_ld(&(bar)[XB_TMO])) break; if (_sp > XB_SPIN_CAP) { atomicAdd(&(bar)[XB_TMO], 1u); break; } } } } while (0)
struct XcdBarrier { unsigned* bar; unsigned x; volatile LAS unsigned* st; };
DI XcdBarrier xcd_barrier_post(unsigned* bar, volatile LAS unsigned* st) {
    XcdBarrier b; b.bar = bar; b.x = xb_xcc_id(); b.st = st;
    if (threadIdx.x == 0) (void)xb_add(&bar[XB_XCNT(b.x)], 1u);
    return b;
}
DI void xcd_barrier_complete(unsigned* bar, unsigned x, unsigned& nloc, unsigned& nx) {
    const unsigned G = gridDim.x;
    unsigned sum, cnt, mine, sp = 0u;
    for (;;) {
        sum = 0u; cnt = 0u; mine = 0u;
#pragma unroll
        for (unsigned j = 0; j < 16; ++j) { const unsigned c = xb_ld(&bar[XB_XCNT(j)]); sum += c; cnt += (c > 0u) ? 1u : 0u; mine = (j == x) ? c : mine; }
        if (sum == G) break;
        __builtin_amdgcn_s_sleep(1);
        if ((++sp & 255u) == 0u) { if (xb_ld(&bar[XB_TMO])) break; if (sp > XB_SPIN_CAP) { atomicAdd(&bar[XB_TMO], 1u); break; } }
    }
    nloc = mine > 0u ? mine : 1u; nx = cnt > 0u ? cnt : 1u;
}
DI void xcd_barrier(const XcdBarrier& b) {
    asm volatile("s_waitcnt vmcnt(0)" ::: "memory");
    __syncthreads();
    if (threadIdx.x == 0) {
        unsigned* bar = b.bar;
        __builtin_amdgcn_s_waitcnt(0);
        unsigned nloc = b.st[0], nx = b.st[1];
        if (nloc == 0u) { xcd_barrier_complete(bar, b.x, nloc, nx); b.st[0] = nloc; b.st[1] = nx; }
        const unsigned old = xb_add(&bar[XB_XSUB(b.x)], 1u);
        const unsigned gen = old / nloc;
        if (old + 1u == (gen + 1u) * nloc) {
            __builtin_amdgcn_fence(__ATOMIC_RELEASE, "agent");
            asm volatile("s_waitcnt vmcnt(0)" ::: "memory");
            const unsigned og = xb_add(&bar[XB_TOP], 1u);
            const unsigned tg = og / nx;
            if (og + 1u == (tg + 1u) * nx) xb_add(&bar[XB_TOPGEN], 1u);
            else XB_SPIN(xb_ld(&bar[XB_TOPGEN]) == tg, bar);
            __builtin_amdgcn_fence(__ATOMIC_ACQUIRE, "agent");
            xb_add(&bar[XB_XGEN(b.x)], 1u);
            asm volatile("s_waitcnt vmcnt(0)" ::: "memory");
        } else {
            XB_SPIN(xb_ld(&bar[XB_XGEN(b.x)]) == gen, bar);
            __builtin_amdgcn_fence(__ATOMIC_ACQUIRE, "agent");
            asm volatile("s_waitcnt vmcnt(0)" ::: "memory");
        }
    }
    __syncthreads();
}

constexpr int NPHASE = 12;
__global__ void __launch_bounds__(NTHREADS, 2) hymba_fwd(Params p) {
    extern __shared__ __attribute__((aligned(16))) unsigned char lds_raw[];
    __builtin_assume(__builtin_amdgcn_workitem_id_y() == 0); __builtin_assume(__builtin_amdgcn_workitem_id_z() == 0);
    cg::grid_group grid = cg::this_grid();
    Frame F;
    F.lds = (LAS unsigned char*)lds_raw; F.ws = p.ws; F.in = p.in; F.out = p.out;
    F.tid = threadIdx.x; F.lane = F.tid & 63; F.wave = __builtin_amdgcn_readfirstlane(F.tid >> 6); F.bid = blockIdx.x; F.G = gridDim.x;
    F.gw = F.bid * NWAVES + F.wave; F.NGW = F.G * NWAVES;
    const int lo = p.ph_lo, hi = p.ph_hi;
#define IN(k) (lo <= (k) && (k) < hi)
#ifdef PROBE_A
    LAS unsigned long long* ts_ = (LAS unsigned long long*)(F.lds + LDS_MISC + 7168);
#define STAMP(k) do { if (F.bid == 0 && F.tid == 0) ts_[k] = __builtin_amdgcn_s_memrealtime(); } while (0)
#else
#define STAMP(k) do { } while (0)
#endif
    STAMP(0);
    volatile LAS unsigned* xst = (volatile LAS unsigned*)(F.lds + LDS_MISC + 4112);
    if (F.tid == 0) { xst[0] = 0u; xst[1] = 0u; }
    __syncthreads();
    XcdBarrier xbar; xbar.bar = (unsigned*)(F.ws + WS_CTL) + CW_BAR; xbar.x = 0; xbar.st = xst;
#define SEAM(k) do { if (IN(k) && IN((k) + 1)) { if ((k) == 0) { grid.sync(); xbar = xcd_barrier_post((unsigned*)(F.ws + WS_CTL) + CW_BAR, xst); } else xcd_barrier(xbar); } STAMP((k) + 1); } while (0)
    LAS unsigned char* ring = F.lds; LAS unsigned* tokl = (LAS unsigned*)(F.lds + LDS_MISC + 256);
#ifdef DOUBLE_PHASE
#define NREP(k) ((k) == DOUBLE_PHASE ? 2 : 1)
#define REPSYNC(k, rep) do { if ((k) == DOUBLE_PHASE && (rep) == 0) grid.sync(); } while (0)
#else
#define NREP(k) 1
#define REPSYNC(k, rep) do { } while (0)
#endif

    if (IN(0)) for (int rep = 0; rep < NREP(0); ++rep) { phase0(F); REPSYNC(0, rep); }
    SEAM(0);
    if (IN(1)) for (int rep = 0; rep < NREP(1); ++rep) { phase1(F); phase0_weights(F); REPSYNC(1, rep); }
    SEAM(1);
    if (IN(2)) for (int rep = 0; rep < NREP(2); ++rep) {
        pg8::StaticOrder S; S.init(TOK, NPROJ, DM, F.G, F.bid, F.ws + WS_H1, F.ws + WS_WIN);
        pg8::EpiInProj E{F.ws, F.in[7], F.in[8], F.in[12], F.in[13], (LAS float*)(F.lds + LDS_MISC + 8192)};
        pg8::gemm_phase<pg8::EpiInProj, pg8::StaticOrder, false>(ring, tokl, DM, S, E);
        REPSYNC(2, rep);
    }
    SEAM(2); STAMP(4);
    if (IN(4)) for (int rep = 0; rep < NREP(4); ++rep) {
        { pg8::CompressOrder S{F.G, F.bid, (const char*)(F.ws + WS_KC), (const char*)(F.ws + WS_PE), (const char*)(F.ws + WS_WC1)};
          pg8::EpiBf16 E{(bf16_t*)(F.ws + WS_UL), 512};
          pg8::gemm_phase<pg8::EpiBf16, pg8::CompressOrder, false>(ring, tokl, 1024, S, E); }
        const float mq = gmax(F.in[12], 32, F.lane), mk = gmax(F.in[13], 32, F.lane);
        const float bound = 5.656854249f * mq * mk * 1.02f; const float c2 = 0.17677669529663687f * 1.4426950408889634f; const float mc = bound * 1.4426950408889634f;
        float s1 = F.lane < 32 ? F.in[14][F.lane] * F.in[15][F.lane] : 0.f, s2 = F.lane < 32 ? F.in[16][F.lane] * F.in[17][F.lane] : 0.f;
        s1 = wave_sum(s1); s2 = wave_sum(s2);
        const float lam = __expf(s1) - __expf(s2) + 0.2f;
        unsigned* ctr = (unsigned*)(F.ws + WS_CTL) + CW_QDIFF + 32 * rep;
        for (int it = queue_next(F, ctr); it < 4096;) { unsigned nx = 0u; if (F.tid == 0) nx = atomicAdd(ctr, 1u);
            const int qb = 15 - (it >> 8), bh = it & 255; diff_unit(F, bh >> 3, bh & 7, qb, c2, mc, lam); it = queue_pass(F, nx); }
        REPSYNC(4, rep);
    }
    SEAM(4);
    if (IN(5)) for (int rep = 0; rep < NREP(5); ++rep) { phase5(F); REPSYNC(5, rep); }
    SEAM(5);
    if (IN(6)) for (int rep = 0; rep < NREP(6); ++rep) {
        const float mq = gmax(F.in[7], 64, F.lane); const float mk = fmaxf(gmax(F.in[8], 64, F.lane), fmaxf(gmax(F.in[8] + 64, 64, F.lane), gmax(F.in[8] + 128, 64, F.lane)));
        const float bound = 8.f * mq * mk * 1.02f; const float c2 = 0.125f * 1.4426950408889634f; const float mc = bound * 1.4426950408889634f;
        unsigned* ctr = (unsigned*)(F.ws + WS_CTL) + CW_QNSA + 32 * rep;
        for (int it = queue_next(F, ctr); it < 2048;) { unsigned nx = 0u; if (F.tid == 0) nx = atomicAdd(ctr, 1u);
            const int qb = 31 - (it >> 6), bg = it & 63; nsa_unit(F, bg >> 1, bg & 1, qb, c2, mc); it = queue_pass(F, nx); }
        REPSYNC(6, rep);
    }
    SEAM(6);
    if (IN(7)) for (int rep = 0; rep < NREP(7); ++rep) {
        pg8::StaticOrder S; S.init(TOK, DM, DM, F.G, F.bid, F.ws + WS_AO, F.ws + WS_WOUT);
        pg8::EpiOutProj E{F.in[0], F.out, (const float*)(F.ws + WS_MOD), (float*)(F.ws + WS_ROWSS)};
        pg8::gemm_phase<pg8::EpiOutProj, pg8::StaticOrder, false>(ring, tokl, DM, S, E);
        REPSYNC(7, rep);
    }
    SEAM(7);
    if (IN(8)) phase8(F);
    SEAM(8);
    if (IN(9)) for (int rep = 0; rep < NREP(9); ++rep) {
        LAS int* tb = moe_prefix(F);
        pg8::MoeOrder S{F.G, F.bid, 0, tb, (const char*)(F.ws + WS_H2), (const char*)(F.ws + WS_WGU), (const int*)(F.ws + WS_LIST)};
        pg8::EpiSwiglu E{(bf16_t*)(F.ws + WS_HH)};
        pg8::gemm_phase<pg8::EpiSwiglu, pg8::MoeOrder, true>(ring, tokl, DM, S, E);
        REPSYNC(9, rep);
    }
    SEAM(9);
    if (IN(10)) for (int rep = 0; rep < NREP(10); ++rep) {
        LAS int* tb = moe_prefix(F);
        pg8::MoeOrder S{F.G, F.bid, 1, tb, (const char*)(F.ws + WS_HH), (const char*)(F.ws + WS_WD), nullptr};
        pg8::EpiBf16 E{(bf16_t*)(F.ws + WS_Y), DM};
        pg8::gemm_phase<pg8::EpiBf16, pg8::MoeOrder, false>(ring, tokl, EHID, S, E);
        REPSYNC(10, rep);
    }
    SEAM(10);
    if (IN(11)) phase11(F);
    grid.sync(); grid.sync(); grid.sync(); grid.sync(); grid.sync(); grid.sync(); grid.sync(); grid.sync();
#ifdef PROBE_A
    grid.sync(); STAMP(12);
    if (F.bid == 0 && F.tid == 0) {
        unsigned long long da = (ts_[PROBE_A + 1] - ts_[PROBE_A]) / 100ull, db = (ts_[PROBE_B + 1] - ts_[PROBE_B]) / 100ull;
        unsigned long long qa = (da + 5ull) / 10ull, qb2 = (db + 5ull) / 10ull; if (qa > 63ull) qa = 63ull; if (qb2 > 63ull) qb2 = 63ull;
        const unsigned long long target = ts_[0] + (6000ull + 16ull + 32ull * qa + 2048ull * qb2) * 100ull;
        while (__builtin_amdgcn_s_memrealtime() < target) __builtin_amdgcn_s_sleep(32);
    }
#endif
#undef IN
#undef SEAM
}

#ifndef MK_LAUNCHES
#define MK_LAUNCHES 1
#endif
extern "C" void kernel_launch(void* const* d_in, const int* in_sizes, int n_in, void* d_out, int out_size, void* d_ws, size_t ws_size, hipStream_t stream) {
    static int grid = 0;
    if (grid == 0) {
        if (n_in != 27 || ws_size < WS_END) { fprintf(stderr, "kernel_launch: unexpected inputs (n_in %d, ws %zu)\n", n_in, ws_size); grid = -1; return; }
        int dev = 0, cus = 0, per_cu = 0;
        hipGetDevice(&dev); hipDeviceGetAttribute(&cus, hipDeviceAttributeMultiprocessorCount, dev);
        hipFuncSetAttribute((const void*)hymba_fwd, hipFuncAttributeMaxDynamicSharedMemorySize, LDS_BYTES);
        hipOccupancyMaxActiveBlocksPerMultiprocessor(&per_cu, (const void*)hymba_fwd, NTHREADS, LDS_BYTES);
        if (per_cu < 1) { fprintf(stderr, "kernel_launch: occupancy query says %d blocks per CU\n", per_cu); per_cu = 1; }
        if (per_cu > 1) per_cu = 1;
        grid = cus * per_cu;
    }
    if (grid < 0) return;
    Params p{};
    for (int i = 0; i < 27; ++i) p.in[i] = (const float*)d_in[i];
    p.out = (float*)d_out; p.ws = (unsigned char*)d_ws;
    const int cuts[13] = {0, 1, 2, 3, 4, 5, 6, 7, 8, 9, 10, 11, 12};
    const int nl = MK_LAUNCHES == 1 ? 1 : NPHASE;
    for (int li = 0; li < nl; ++li) {
        p.ph_lo = nl == 1 ? 0 : cuts[li]; p.ph_hi = nl == 1 ? NPHASE : cuts[li + 1];
        void* args[] = {&p};
        hipError_t e = hipLaunchCooperativeKernel((const void*)hymba_fwd, dim3(grid), dim3(NTHREADS), args, LDS_BYTES, stream);
        if (e != hipSuccess) { fprintf(stderr, "cooperative launch failed: %s (grid %d)\n", hipGetErrorString(e), grid); break; }
    }
}
```

```cpp
#include <hip/hip_runtime.h>
#include <hip/hip_cooperative_groups.h>
#include <cstdint>
#include <cstdio>
namespace cg = cooperative_groups;

#define LAS __attribute__((address_space(3)))
#define DI __device__ __forceinline__
typedef unsigned short bf16_t;
typedef short bf16x8 __attribute__((ext_vector_type(8)));
typedef short s16x4 __attribute__((ext_vector_type(4)));
typedef float f32x2 __attribute__((ext_vector_type(2)));
typedef float f32x4 __attribute__((ext_vector_type(4)));
typedef float f32x16 __attribute__((ext_vector_type(16)));
typedef unsigned u32x2 __attribute__((ext_vector_type(2)));
typedef unsigned u32x4 __attribute__((ext_vector_type(4)));

constexpr int BATCH = 32, SEQ = 2048, DM = 1024, TOK = BATCH * SEQ;
constexpr int NPROJ = 3072;
constexpr int INCOLS = 2840;
constexpr int NEXP = 32, EHID = 512, ECAP = 65536;
constexpr float EPS = 1e-6f;
constexpr int NWAVES = 8, NTHREADS = 512;

constexpr size_t MiB = 1u << 20;
constexpr size_t WS_CTL = 0;
constexpr size_t WS_MOD = 1 * MiB;
constexpr size_t WS_ROPE = 2 * MiB;
constexpr size_t WS_WR = 3 * MiB;
constexpr size_t WS_WIN = 4 * MiB;
constexpr size_t WS_WOUT = 10 * MiB;
constexpr size_t WS_WC1 = 12 * MiB;
constexpr size_t WS_WGU = 16 * MiB;
constexpr size_t WS_WD = 80 * MiB;
constexpr size_t WS_LIST = 112 * MiB;
constexpr size_t WS_TIPOS = 120 * MiB;
constexpr size_t WS_TIE = WS_TIPOS + 512 * 1024;
constexpr size_t WS_TIW = WS_TIE + 256 * 1024;
constexpr size_t WS_ROWSS = 122 * MiB;
constexpr size_t WS_GATES = 126 * MiB;
constexpr size_t WS_KCMP = 132 * MiB;
constexpr size_t WS_VCMP = 133 * MiB;
constexpr size_t WS_UL = 134 * MiB;
constexpr size_t WS_A = 160 * MiB;
constexpr size_t WS_B = 288 * MiB;
constexpr size_t WS_C = 672 * MiB;
constexpr size_t WS_H1 = WS_A, WS_QN = WS_B + 128 * MiB, WS_QR = WS_B + 192 * MiB, WS_H2 = WS_A;
constexpr size_t WS_PROJ = WS_B, WS_AO = WS_B, WS_HH = WS_B, WS_Y = WS_B + 136 * MiB;
constexpr size_t WS_KC = WS_C, WS_VC = WS_C + 16 * MiB, WS_PE = WS_C + 32 * MiB, WS_KS = WS_C + 33 * MiB, WS_VS = WS_C + 49 * MiB,
                 WS_KW = WS_C + 65 * MiB, WS_VW = WS_C + 81 * MiB, WS_DQ = WS_C + 97 * MiB, WS_DK = WS_C + 161 * MiB, WS_DV = WS_C + 225 * MiB;
constexpr size_t WS_X1B = WS_C + 32 * MiB;
constexpr size_t WS_END = WS_C + 289 * MiB;
constexpr int CW_CNT = 0;
constexpr int CW_QDIFF = 64, CW_QNSA = 128;

constexpr int RING_BYTES = 131072;
constexpr int LDS_MISC = RING_BYTES;
constexpr int LDS_BYTES = 147456;

DI unsigned pk2(float lo, float hi) { typedef __bf16 b2 __attribute__((ext_vector_type(2))); f32x2 v = {lo, hi}; b2 b = __builtin_convertvector(v, b2); return __builtin_bit_cast(unsigned, b); }
DI unsigned short f2bf(float f) { return (unsigned short)(pk2(f, 0.f) & 0xffffu); }
DI float bf2f(unsigned short h) { return __uint_as_float((unsigned)h << 16); }
DI float bflo(unsigned w) { return __uint_as_float(w << 16); }
DI float bfhi(unsigned w) { return __uint_as_float(w & 0xffff0000u); }
DI float wave_sum(float v) {
#pragma unroll
    for (int o = 1; o < 64; o <<= 1) v += __shfl_xor(v, o);
    return v;
}
DI float fast_exp2(float x) { return __builtin_amdgcn_exp2f(x); }
DI float fast_rcp(float x) { return __builtin_amdgcn_rcpf(x); }
#define MFMA32(a, b, c) __builtin_amdgcn_mfma_f32_32x32x16_bf16((a), (b), (c), 0, 0, 0)
#define MFMA16(a, b, c) __builtin_amdgcn_mfma_f32_16x16x32_bf16((a), (b), (c), 0, 0, 0)
DI int crow(int r, int hi) { return (r & 3) + 8 * (r >> 2) + 4 * hi; }

DI int lane_id_fresh() { int l; asm volatile("v_mbcnt_lo_u32_b32 %0, -1, 0\n\tv_mbcnt_hi_u32_b32 %0, -1, %0" : "=v"(l)); return l; }
struct Params { const float* in[27]; float* out; unsigned char* ws; int ph_lo, ph_hi; };

namespace pg8 {
constexpr int BM = 256, BK = 64, HALF = 128, HTB = HALF * BK * 2, STAGE_BYTES = 8 * HTB, NXCD = 8, WGM = 8;
DI int lds_byte(int r, int c) { const int st = (r >> 4) * 2 + (c >> 5), rr = r & 15, cc = c & 31, ob = rr * 64 + cc * 2; return st * 1024 + (ob ^ (((ob >> 9) & 1) << 5)); }
DI void stage_rc(int b, int& R, int& C) { const int st = b / 1024, sb = b % 1024, swz = sb ^ (((sb >> 9) & 1) << 5); R = (st >> 1) * 16 + swz / 64; C = (st & 1) * 32 + (swz % 64) / 2; }
DI int perm32(int rho) { const int n = rho >> 4, i = rho & 15; return 8 * (i >> 2) + 4 * n + (i & 3); }

struct Unit { int pm, pn, aux; const char* Ab; const char* Bb; const int* tok; };

template <class Epi, class Sched, bool GATHER>
DI void gemm_phase(LAS unsigned char* lds, LAS unsigned* tokl, const int K, const Sched& S, const Epi& E, const int wid, const int lane) {
    const int tid = wid * 64 + lane, wr = wid >> 2, wc = wid & 3, fr = lane & 15, fq = lane >> 4;
    const int nt = K / BK;
    unsigned voffA[2], voffB[2]; int RA[2], CA[2];
#pragma unroll
    for (int i = 0; i < 2; ++i) { int R, C; stage_rc(tid * 16 + i * 8192, R, C); const int Rb = Epi::PERM ? ((R & ~31) + perm32(R & 31)) : R;
        voffA[i] = (unsigned)(R * K + C) * 2u; voffB[i] = (unsigned)(Rb * K + C) * 2u; RA[i] = R; CA[i] = C; }
    const size_t kstep = (size_t)(BK * 2);
    const size_t hstep = (size_t)HALF * K * 2;
    const unsigned ldsw = (unsigned)wid * 1024u;
    const int aoff = lds_byte(wr * 64 + fr, fq * 8), boff = lds_byte(wc * 32 + fr, fq * 8);
#define PG8_SA(b, h) (((b) * 2 + (h)) * HTB)
#define PG8_SB(b, h) ((4 + (b) * 2 + (h)) * HTB)
#define PG8_STG(bufoff, gbase, voff) do { _Pragma("unroll") for (int _i = 0; _i < 2; ++_i) \
        __builtin_amdgcn_global_load_lds((const unsigned*)((const char*)(gbase) + (voff)[_i]), (LAS unsigned*)(lds + (bufoff) + ldsw + _i * 8192), 16, 0, 0); } while (0)
#define PG8_STA(bufoff, gbase, h, vv) do { if constexpr (GATHER) { PG8_STG(bufoff, gbase, vv[h]); } else { PG8_STG(bufoff, (gbase) + (h) * hstep, voffA); } } while (0)
#define PG8_LDA(dst, b, h) do { _Pragma("unroll") for (int m = 0; m < 4; ++m) _Pragma("unroll") for (int k = 0; k < 2; ++k) dst[m][k] = *(const LAS bf16x8*)(lds + PG8_SA(b, h) + aoff + m * 2048 + k * 1024); } while (0)
#define PG8_LDB(dst, b, h) do { _Pragma("unroll") for (int n = 0; n < 2; ++n) _Pragma("unroll") for (int k = 0; k < 2; ++k) dst[n][k] = *(const LAS bf16x8*)(lds + PG8_SB(b, h) + boff + n * 2048 + k * 1024); } while (0)
#define PG8_MMA(ai, bj, At, Bt) do { __builtin_amdgcn_s_setprio(1); _Pragma("unroll") for (int m = 0; m < 4; ++m) _Pragma("unroll") for (int n = 0; n < 2; ++n) _Pragma("unroll") for (int k = 0; k < 2; ++k) \
        acc[ai][bj][m][n] = __builtin_amdgcn_mfma_f32_16x16x32_bf16(Bt[n][k], At[m][k], acc[ai][bj][m][n], 0, 0, 0); __builtin_amdgcn_s_setprio(0); } while (0)
#define PG8_WAIT_V(n) asm volatile("s_waitcnt vmcnt(" #n ")" ::: "memory")
#define PG8_WAIT_L(n) asm volatile("s_waitcnt lgkmcnt(" #n ")" ::: "memory")
#define PG8_BAR __builtin_amdgcn_s_barrier()
#define PG8_SCHED __builtin_amdgcn_sched_barrier(0)
    Unit cur, nxt; int ui = 0;
    if (!S.next(0, cur)) return;
    f32x4 acc[2][2][4][2];
#pragma unroll
    for (int a = 0; a < 2; ++a)
#pragma unroll
        for (int b = 0; b < 2; ++b)
#pragma unroll
            for (int m = 0; m < 4; ++m)
#pragma unroll
                for (int n = 0; n < 2; ++n) acc[a][b][m][n] = (f32x4){0.f, 0.f, 0.f, 0.f};
    bf16x8 At[4][2], B0[2][2], B1[2][2];
    const char* cA = cur.Ab; const char* cB = cur.Bb;
    unsigned cvo[2][2] = {{0u, 0u}, {0u, 0u}}, nvo[2][2] = {{0u, 0u}, {0u, 0u}};
    if constexpr (GATHER) {
        if (wid < 4) __builtin_amdgcn_global_load_lds((const unsigned*)(cur.tok + wid * 64 + lane), (LAS unsigned*)(tokl + wid * 64), 4, 0, 0);
        PG8_WAIT_V(0); PG8_BAR;
#pragma unroll
        for (int h = 0; h < 2; ++h)
#pragma unroll
            for (int i = 0; i < 2; ++i) cvo[h][i] = tokl[h * 128 + RA[i]] * (unsigned)(K * 2) + (unsigned)(CA[i] * 2);
        PG8_WAIT_L(0);
    }
    PG8_STG(PG8_SB(0, 0), cB, voffB); PG8_STG(PG8_SB(0, 1), cB + hstep, voffB); PG8_STA(PG8_SA(0, 0), cA, 0, cvo); PG8_STA(PG8_SA(0, 1), cA, 1, cvo);
    if (wr == 1) PG8_BAR;
    PG8_WAIT_V(2); PG8_BAR;
    PG8_STG(PG8_SB(1, 0), cB + kstep, voffB); PG8_STA(PG8_SA(1, 0), cA + kstep, 0, cvo); PG8_STG(PG8_SB(1, 1), cB + hstep + kstep, voffB);
    PG8_WAIT_V(6); PG8_BAR;
    for (;;) {
        const bool has_next = S.next(ui + 1, nxt);
        const char* nA = has_next ? nxt.Ab : cA; const char* nB = has_next ? nxt.Bb : cB;
        if constexpr (GATHER) {
            if (has_next && wid < 4) __builtin_amdgcn_global_load_lds((const unsigned*)(nxt.tok + wid * 64 + lane), (LAS unsigned*)(tokl + ((ui + 1) & 1) * 256 + wid * 64), 4, 0, 0);
        }
        for (int t = 0; t < nt; t += 2) {
            const bool last = (t == nt - 2);
            const char* a1 = cA + (size_t)(t + 1) * kstep;
            const char* a2 = last ? nA : cA + (size_t)(t + 2) * kstep; const char* b2 = last ? nB : cB + (size_t)(t + 2) * kstep;
            const char* a3 = a2 + kstep; const char* b3 = b2 + kstep;
            unsigned v2[2][2];
            if constexpr (GATHER) {
                if (last) {
                    if (has_next) {
#pragma unroll
                        for (int h = 0; h < 2; ++h)
#pragma unroll
                            for (int i = 0; i < 2; ++i) nvo[h][i] = tokl[((ui + 1) & 1) * 256 + h * 128 + RA[i]] * (unsigned)(K * 2) + (unsigned)(CA[i] * 2);
                    } else {
#pragma unroll
                        for (int h = 0; h < 2; ++h)
#pragma unroll
                            for (int i = 0; i < 2; ++i) nvo[h][i] = cvo[h][i];
                    }
                }
#pragma unroll
                for (int h = 0; h < 2; ++h)
#pragma unroll
                    for (int i = 0; i < 2; ++i) v2[h][i] = last ? nvo[h][i] : cvo[h][i];
            } else {
#pragma unroll
                for (int h = 0; h < 2; ++h)
#pragma unroll
                    for (int i = 0; i < 2; ++i) v2[h][i] = 0u;
            }
            PG8_LDB(B0, 0, 0); PG8_LDB(B1, 0, 1); PG8_SCHED; PG8_LDA(At, 0, 0); PG8_STA(PG8_SA(1, 1), a1, 1, cvo);
            PG8_WAIT_V(8); PG8_WAIT_L(0); PG8_BAR; PG8_MMA(0, 0, At, B0); PG8_MMA(0, 1, At, B1); PG8_BAR; PG8_SCHED;
            PG8_LDA(At, 0, 1); PG8_STG(PG8_SB(0, 0), b2, voffB); PG8_STG(PG8_SB(0, 1), b2 + hstep, voffB); PG8_STA(PG8_SA(0, 0), a2, 0, v2);
            PG8_WAIT_V(8); PG8_WAIT_L(0); PG8_BAR; PG8_MMA(1, 0, At, B0); PG8_MMA(1, 1, At, B1); PG8_BAR; PG8_SCHED;
            PG8_LDB(B0, 1, 0); PG8_LDB(B1, 1, 1); PG8_SCHED; PG8_LDA(At, 1, 0); PG8_STA(PG8_SA(0, 1), a2, 1, v2);
            PG8_WAIT_V(8); PG8_WAIT_L(0); PG8_BAR; PG8_MMA(0, 0, At, B0); PG8_MMA(0, 1, At, B1); PG8_BAR; PG8_SCHED;
            PG8_LDA(At, 1, 1); PG8_STG(PG8_SB(1, 0), b3, voffB); PG8_STG(PG8_SB(1, 1), b3 + hstep, voffB); PG8_STA(PG8_SA(1, 0), a3, 0, v2);
            PG8_WAIT_V(8); PG8_WAIT_L(0); PG8_BAR; PG8_MMA(1, 0, At, B0); PG8_MMA(1, 1, At, B1); PG8_BAR; PG8_SCHED;
        }
        if (wr == 0) PG8_BAR;
        E(acc, cur, wr, wc, fr, fq);
        if (!has_next) break;
#pragma unroll
        for (int a = 0; a < 2; ++a)
#pragma unroll
            for (int b = 0; b < 2; ++b)
#pragma unroll
                for (int m = 0; m < 4; ++m)
#pragma unroll
                    for (int n = 0; n < 2; ++n) acc[a][b][m][n] = (f32x4){0.f, 0.f, 0.f, 0.f};
        cur = nxt; cA = nA; cB = nB; ++ui;
        if constexpr (GATHER) {
#pragma unroll
            for (int h = 0; h < 2; ++h)
#pragma unroll
                for (int i = 0; i < 2; ++i) cvo[h][i] = nvo[h][i];
        }
        if (wr == 1) PG8_BAR;
    }
    PG8_WAIT_V(0);
    PG8_BAR;
#undef PG8_SA
#undef PG8_SB
#undef PG8_STG
#undef PG8_STA
#undef PG8_LDA
#undef PG8_LDB
#undef PG8_MMA
#undef PG8_WAIT_V
#undef PG8_WAIT_L
#undef PG8_BAR
#undef PG8_SCHED
}

struct StaticOrder {
    int nM, nN, nwg, G, c; const char* A; const char* Bt; size_t tstep;
    DI void init(int M, int N, int K, int G_, int c_, const void* A_, const void* Bt_) { nM = M / BM; nN = N / BM; nwg = nM * nN; G = G_; c = c_; A = (const char*)A_; Bt = (const char*)Bt_; tstep = (size_t)BM * K * 2; }
    DI bool next(int i, Unit& u) const {
        const long L = (long)i * G + c; if (L >= nwg) return false;
        int wgid = (int)L; { const int q = nwg / NXCD, r = nwg % NXCD, xcd = wgid % NXCD, off = wgid / NXCD; wgid = (xcd < r ? xcd * (q + 1) : r * (q + 1) + (xcd - r) * q) + off; }
        const int nig = WGM * nN, gid = wgid / nig, fm = gid * WGM, gsz = (nM - fm) < WGM ? (nM - fm) : WGM;
        u.pm = fm + ((wgid % nig) % gsz); u.pn = (wgid % nig) / gsz; u.aux = 0; u.Ab = A + (size_t)u.pm * tstep; u.Bb = Bt + (size_t)u.pn * tstep; u.tok = nullptr; return true;
    }
};
struct CompressOrder {
    int G, c; const char* KC; const char* PE; const char* W;
    DI bool next(int i, Unit& u) const {
        const int L = i * G + c; if (L >= 132) return false;
        u.pm = L >> 1; u.pn = L & 1; const int kv = u.pm < 32 ? 0 : (u.pm < 64 ? 1 : u.pm - 64); u.aux = kv;
        u.Ab = u.pm < 64 ? KC + (size_t)u.pm * (256 * 1024 * 2) : PE; u.Bb = W + (size_t)kv * (512 * 1024 * 2) + (size_t)u.pn * (256 * 1024 * 2); u.tok = nullptr; return true;
    }
};
struct MoeOrder {
    int G, c, mode; const LAS int* tb; const char* A; const char* W; const int* lists;
    DI bool next(int i, Unit& u) const {
        const int L = i * G + c; const int mt = L >> 2; if (mt >= tb[32]) return false;
        int e = 0;
#pragma unroll 1
        for (int j = 1; j < 32; ++j) e += (tb[j] <= mt) ? 1 : 0;
        u.pm = mt; u.pn = L & 3; u.aux = e;
        if (mode == 0) { u.Ab = A; u.Bb = W + (size_t)e * (1024 * 1024 * 2) + (size_t)u.pn * (256 * 1024 * 2); u.tok = lists + (size_t)e * ECAP + (size_t)(mt - tb[e]) * 256; }
        else { u.Ab = A + (size_t)mt * (256 * 512 * 2); u.Bb = W + (size_t)e * (1024 * 512 * 2) + (size_t)u.pn * (256 * 512 * 2); u.tok = nullptr; }
        return true;
    }
};

struct EpiBf16 {
    static constexpr bool PERM = true;
    bf16_t* O; int ldc;
    DI void operator()(const f32x4 (&acc)[2][2][4][2], const Unit& u, int wr, int wc, int fr, int fq) const {
        const int row0 = u.pm * BM + wr * 64 + fr; const int col0 = u.pn * BM + wc * 32 + 8 * fq;
#pragma unroll
        for (int ai = 0; ai < 2; ++ai)
#pragma unroll
            for (int m = 0; m < 4; ++m) { bf16_t* rowp = O + (size_t)(row0 + ai * HALF + m * 16) * ldc + col0;
#pragma unroll
                for (int bj = 0; bj < 2; ++bj) { const f32x4 v0 = acc[ai][bj][m][0], v1 = acc[ai][bj][m][1];
                    u32x4 w; w.x = pk2(v0[0], v0[1]); w.y = pk2(v0[2], v0[3]); w.z = pk2(v1[0], v1[1]); w.w = pk2(v1[2], v1[3]);
                    *(u32x4*)(rowp + bj * HALF) = w; } }
    }
};
struct EpiInProj {
    static constexpr bool PERM = true;
    unsigned char* ws; const float* g_nq; const float* g_nk; const float* g_dq; const float* g_dk; LAS float* xch;
    DI void operator()(const f32x4 (&acc)[2][2][4][2], const Unit& u, int wr, int wc, int fr, int fq) const {
        const int pn = u.pn, wid = wr * 4 + wc; const int tok0 = u.pm * BM; const int b = tok0 >> 11; int t0 = (tok0 & 2047) + wr * 64 + fr;
        int xo_i = wid * 256 + fr, xp_i = (wid ^ 1) * 256 + fr;
        asm volatile("" : "+v"(t0), "+v"(xo_i), "+v"(xp_i));
        LAS float* xo = xch + xo_i; LAS float* xp = xch + xp_i;
        const float* ropeN = (const float*)(ws + WS_ROPE); const float* ropeD = ropeN + 2048 * 16;
        const int d0 = 32 * (wc & 1) + 8 * fq;
        if (pn <= 4) {
            const bool nrm0 = (pn != 2), nrm1 = (pn < 2);
            if (pn != 2) {
#pragma unroll
                for (int ai = 0; ai < 2; ++ai)
#pragma unroll
                    for (int m = 0; m < 4; ++m)
#pragma unroll
                        for (int bj = 0; bj < 2; ++bj) { const f32x4 a = acc[ai][bj][m][0], c = acc[ai][bj][m][1];
                            float ss = (a[0] * a[0] + a[1] * a[1]) + (a[2] * a[2] + a[3] * a[3]) + (c[0] * c[0] + c[1] * c[1]) + (c[2] * c[2] + c[3] * c[3]);
                            ss += __shfl_xor(ss, 16); ss += __shfl_xor(ss, 32);
                            if (fq == 0) xo[((ai * 4 + m) * 2 + bj) * 16] = ss; }
                asm volatile("s_waitcnt lgkmcnt(0)" ::: "memory"); __builtin_amdgcn_s_barrier(); asm volatile("" ::: "memory");
            }
            const float* gg = pn < 2 ? g_nq : (g_nk + (pn == 3 ? 64 : 128));
            f32x4 g0 = {1.f, 1.f, 1.f, 1.f}, g1 = g0;
            if (pn != 2) { g0 = *(const f32x4*)(gg + d0); g1 = *(const f32x4*)(gg + d0 + 4); }
            const bool ropew = (wc & 1) == 0;
#pragma unroll
            for (int ai = 0; ai < 2; ++ai)
#pragma unroll
                for (int m = 0; m < 4; ++m) {
                    const int t = t0 + ai * HALF + m * 16;
                    f32x4 cs0 = {1.f, 0.f, 1.f, 0.f}, cs1 = cs0, cs2 = cs0, cs3 = cs0;
                    if (pn != 2 && ropew && fq < 2) { const f32x4* rp = (const f32x4*)(ropeN + t * 16); cs0 = rp[0]; cs1 = rp[1]; cs2 = rp[2]; cs3 = rp[3]; }
#pragma unroll
                    for (int bj = 0; bj < 2; ++bj) {
                        const bool donorm = bj == 0 ? nrm0 : nrm1;
                        f32x4 ya = acc[ai][bj][m][0], yb = acc[ai][bj][m][1];
                        u32x4 w0, w1;
                        if (donorm) {
                            const float rstd = rsqrtf((xo[((ai * 4 + m) * 2 + bj) * 16] + xp[((ai * 4 + m) * 2 + bj) * 16]) * (1.f / 64.f) + EPS);
                            ya = ya * rstd * g0; yb = yb * rstd * g1;
                            w0.x = pk2(ya[0], ya[1]); w0.y = pk2(ya[2], ya[3]); w0.z = pk2(yb[0], yb[1]); w0.w = pk2(yb[2], yb[3]);
                            f32x4 ra = ya, rb = yb;
                            if (ropew) {
                                f32x4 pa, pb;
#pragma unroll
                                for (int i = 0; i < 4; ++i) { pa[i] = __shfl_xor(ya[i], 16); pb[i] = __shfl_xor(yb[i], 16); }
                                if (fq == 0) { ra[0] = ya[0] * cs0[0] - pa[0] * cs0[1]; ra[1] = ya[1] * cs0[2] - pa[1] * cs0[3]; ra[2] = ya[2] * cs1[0] - pa[2] * cs1[1]; ra[3] = ya[3] * cs1[2] - pa[3] * cs1[3];
                                               rb[0] = yb[0] * cs2[0] - pb[0] * cs2[1]; rb[1] = yb[1] * cs2[2] - pb[1] * cs2[3]; rb[2] = yb[2] * cs3[0] - pb[2] * cs3[1]; rb[3] = yb[3] * cs3[2] - pb[3] * cs3[3]; }
                                else if (fq == 1) { ra[0] = pa[0] * cs0[1] + ya[0] * cs0[0]; ra[1] = pa[1] * cs0[3] + ya[1] * cs0[2]; ra[2] = pa[2] * cs1[1] + ya[2] * cs1[0]; ra[3] = pa[3] * cs1[3] + ya[3] * cs1[2];
                                                    rb[0] = pb[0] * cs2[1] + yb[0] * cs2[0]; rb[1] = pb[1] * cs2[3] + yb[1] * cs2[2]; rb[2] = pb[2] * cs3[1] + yb[2] * cs3[0]; rb[3] = pb[3] * cs3[3] + yb[3] * cs3[2]; }
                            }
                            w1.x = pk2(ra[0], ra[1]); w1.y = pk2(ra[2], ra[3]); w1.z = pk2(rb[0], rb[1]); w1.w = pk2(rb[2], rb[3]);
                        } else { w0.x = pk2(ya[0], ya[1]); w0.y = pk2(ya[2], ya[3]); w0.z = pk2(yb[0], yb[1]); w0.w = pk2(yb[2], yb[3]); w1 = w0; }
                        const int hq = 2 * bj + (wc >> 1);
                        if (pn < 2) { const size_t off = (((size_t)b * 8 + 4 * pn + hq) * SEQ + t) * 64 + d0;
                            *(u32x4*)((bf16_t*)(ws + WS_QN) + off) = w0; *(u32x4*)((bf16_t*)(ws + WS_QR) + off) = w1; }
                        else { const int six = 2 * (pn - 2) + bj; const size_t base = six == 0 ? WS_KC : six == 1 ? WS_VC : six == 2 ? WS_KS : six == 3 ? WS_VS : six == 4 ? WS_KW : WS_VW;
                            const size_t off = (((size_t)b * 2 + (wc >> 1)) * SEQ + t) * 64 + d0;
                            *(u32x4*)((bf16_t*)(ws + base) + off) = w1; }
                    }
                    asm volatile("" ::: "memory");
                }
        } else if (pn <= 8) {
            const bool isq = pn <= 6; const float* gg = isq ? g_dq : g_dk; bf16_t* dst = (bf16_t*)(ws + (isq ? WS_DQ : WS_DK));
            const f32x4 g0 = *(const f32x4*)(gg + 8 * fq), g1 = *(const f32x4*)(gg + 8 * fq + 4);
#pragma unroll
            for (int ai = 0; ai < 2; ++ai)
#pragma unroll
                for (int m = 0; m < 4; ++m) {
                    const int t = t0 + ai * HALF + m * 16;
                    f32x4 c0 = {1.f, 0.f, 1.f, 0.f}, c1 = c0;
                    if (fq == 0) { const f32x4* rp = (const f32x4*)(ropeD + t * 8); c0 = rp[0]; c1 = rp[1]; }
#pragma unroll
                    for (int bj = 0; bj < 2; ++bj) {
                        f32x4 ya = acc[ai][bj][m][0], yb = acc[ai][bj][m][1];
                        float ss = (ya[0] * ya[0] + ya[1] * ya[1]) + (ya[2] * ya[2] + ya[3] * ya[3]) + (yb[0] * yb[0] + yb[1] * yb[1]) + (yb[2] * yb[2] + yb[3] * yb[3]);
                        ss += __shfl_xor(ss, 16); ss += __shfl_xor(ss, 32);
                        const float rstd = rsqrtf(ss * (1.f / 32.f) + EPS);
                        ya = ya * rstd * g0; yb = yb * rstd * g1;
                        if (fq == 0) { const f32x4 a = ya, bb = yb;
                            ya[0] = a[0] * c0[0] - bb[0] * c0[1]; yb[0] = a[0] * c0[1] + bb[0] * c0[0]; ya[1] = a[1] * c0[2] - bb[1] * c0[3]; yb[1] = a[1] * c0[3] + bb[1] * c0[2];
                            ya[2] = a[2] * c1[0] - bb[2] * c1[1]; yb[2] = a[2] * c1[1] + bb[2] * c1[0]; ya[3] = a[3] * c1[2] - bb[3] * c1[3]; yb[3] = a[3] * c1[3] + bb[3] * c1[2]; }
                        u32x4 w; w.x = pk2(ya[0], ya[1]); w.y = pk2(ya[2], ya[3]); w.z = pk2(yb[0], yb[1]); w.w = pk2(yb[2], yb[3]);
                        const int hd = 4 * ((pn - 5) & 1) + 2 * bj + (wc >> 1);
                        *(u32x4*)(dst + (((size_t)b * 8 + hd) * SEQ + t) * 64 + d0) = w;
                    }
                    asm volatile("" ::: "memory");
                }
        } else if (pn <= 10) {
            bf16_t* dst = (bf16_t*)(ws + WS_DV);
#pragma unroll
            for (int ai = 0; ai < 2; ++ai)
#pragma unroll
                for (int m = 0; m < 4; ++m) { const int t = t0 + ai * HALF + m * 16;
#pragma unroll
                    for (int bj = 0; bj < 2; ++bj) { const f32x4 ya = acc[ai][bj][m][0], yb = acc[ai][bj][m][1];
                        u32x4 w; w.x = pk2(ya[0], ya[1]); w.y = pk2(ya[2], ya[3]); w.z = pk2(yb[0], yb[1]); w.w = pk2(yb[2], yb[3]);
                        const int hd = 4 * (pn - 9) + 2 * bj + (wc >> 1);
                        *(u32x4*)(dst + (((size_t)b * 8 + hd) * SEQ + t) * 64 + d0) = w; }
                    asm volatile("" ::: "memory"); }
        } else {
            if (wc == 0 && fq < 3) {
                float* gt = (float*)(ws + WS_GATES);
#pragma unroll
                for (int ai = 0; ai < 2; ++ai)
#pragma unroll
                    for (int m = 0; m < 4; ++m) { const size_t tok = (size_t)tok0 + wr * 64 + fr + ai * HALF + m * 16; const f32x4 ya = acc[ai][0][m][0], yb = acc[ai][0][m][1]; f32x4 sa, sb;
#pragma unroll
                        for (int i = 0; i < 4; ++i) { sa[i] = 1.f / (1.f + __expf(-ya[i])); sb[i] = 1.f / (1.f + __expf(-yb[i])); }
                        *(f32x4*)(gt + tok * 24 + 8 * fq) = sa; *(f32x4*)(gt + tok * 24 + 8 * fq + 4) = sb; }
            }
        }
    }
};
struct EpiSwiglu {
    static constexpr bool PERM = true;
    bf16_t* O;
    DI void operator()(const f32x4 (&acc)[2][2][4][2], const Unit& u, int wr, int wc, int fr, int fq) const {
        const int row0 = u.pm * BM + wr * 64 + fr; const int col0 = u.pn * 128 + wc * 16 + 4 * fq;
#pragma unroll
        for (int ai = 0; ai < 2; ++ai)
#pragma unroll
            for (int m = 0; m < 4; ++m) { bf16_t* rowp = O + (size_t)(row0 + ai * HALF + m * 16) * EHID + col0;
#pragma unroll
                for (int bj = 0; bj < 2; ++bj) { const f32x4 g = acc[ai][bj][m][0], up = acc[ai][bj][m][1]; float h[4];
#pragma unroll
                    for (int i = 0; i < 4; ++i) { const float s = fast_rcp(1.f + __expf(-g[i])); h[i] = g[i] * s * up[i]; }
                    u32x2 w; w.x = pk2(h[0], h[1]); w.y = pk2(h[2], h[3]);
                    *(u32x2*)(rowp + bj * 64) = w; } }
    }
};
struct EpiOutProj {
    static constexpr bool PERM = true;
    const float* x; bf16_t* x1b; const float* mod; float* rowss;
    DI void operator()(const f32x4 (&acc)[2][2][4][2], const Unit& u, int wr, int wc, int fr, int fq) const {
        const int col0 = u.pn * BM + wc * 32 + 8 * fq; const int b = (u.pm * BM) / SEQ;
        const float* g1 = mod + (size_t)b * 6144 + 2048 + col0;
        f32x4 gv[2][2];
#pragma unroll
        for (int bj = 0; bj < 2; ++bj)
#pragma unroll
            for (int n = 0; n < 2; ++n) gv[bj][n] = *(const f32x4*)(g1 + bj * HALF + n * 4);
#pragma unroll
        for (int ai = 0; ai < 2; ++ai)
#pragma unroll
            for (int m = 0; m < 4; ++m) { const int r = u.pm * BM + ai * HALF + wr * 64 + m * 16 + fr; const size_t off = (size_t)r * DM + col0; float ss = 0.f;
#pragma unroll
                for (int bj = 0; bj < 2; ++bj) { const f32x4 xa = *(const f32x4*)(x + off + bj * HALF), xb = *(const f32x4*)(x + off + bj * HALF + 4);
                    const f32x4 oa = xa + gv[bj][0] * acc[ai][bj][m][0], ob = xb + gv[bj][1] * acc[ai][bj][m][1];
                    ss += (oa[0] * oa[0] + oa[1] * oa[1]) + (oa[2] * oa[2] + oa[3] * oa[3]) + (ob[0] * ob[0] + ob[1] * ob[1]) + (ob[2] * ob[2] + ob[3] * ob[3]);
                    u32x4 w; w.x = pk2(oa[0], oa[1]); w.y = pk2(oa[2], oa[3]); w.z = pk2(ob[0], ob[1]); w.w = pk2(ob[2], ob[3]);
                    *(u32x4*)(x1b + off + bj * HALF) = w; }
                ss += __shfl_xor(ss, 16); ss += __shfl_xor(ss, 32);
                if (fq == 0) rowss[(size_t)r * 16 + u.pn * 4 + wc] = ss; }
    }
};
}

struct Frame {
    LAS unsigned char* lds; unsigned char* ws; const float* const* in; float* out;
    int tid, lane, wave, bid, G, gw, NGW;
};

DI int origcol(int n) { return n < 1280 ? n : (n < 2816 ? n + 24 : (n < 2840 ? n - 2816 + 1280 : -1)); }

template <class DRow>
DI void tr_item(const float* src, int src_ld, int sc  , bf16_t* dst, int dst_ld, int k0, LAS float* scr, int lane, DRow drow) {
#pragma unroll 8
    for (int i = 0; i < 32; ++i) { const int kk = 2 * i + (lane >> 5); scr[kk * 33 + (lane & 31)] = sc >= 0 ? src[(size_t)(k0 + kk) * src_ld + sc] : 0.f; }
    asm volatile("s_waitcnt lgkmcnt(0)" ::: "memory");
    const int c = lane & 7;
#pragma unroll
    for (int j = 0; j < 4; ++j) { const int n = (lane >> 3) + 8 * j; const LAS float* s = scr + (8 * c) * 33 + n;
        u32x4 o; o.x = pk2(s[0 * 33], s[1 * 33]); o.y = pk2(s[2 * 33], s[3 * 33]); o.z = pk2(s[4 * 33], s[5 * 33]); o.w = pk2(s[6 * 33], s[7 * 33]);
        *(u32x4*)(dst + (size_t)drow(n) * dst_ld + k0 + 8 * c) = o; }
    asm volatile("s_waitcnt lgkmcnt(0)" ::: "memory");
}

DI void phase0(Frame& F) {
    const float* c_in = F.in[1]; const float* w_ada = F.in[2]; const float* b_ada = F.in[3];
    float* mod = (float*)(F.ws + WS_MOD);
    for (int it = F.bid; it < 96; it += F.G) {
        LAS float* cs = (LAS float*)F.lds;
        for (int idx = F.tid; idx < 32 * 1024; idx += NTHREADS) { const int b = idx >> 10, k = idx & 1023; cs[k * 32 + b] = c_in[idx]; }
        __syncthreads();
        float acc[32];
#pragma unroll
        for (int b = 0; b < 32; ++b) acc[b] = 0.f;
        const int j = it * 64 + F.lane;
        for (int kk = 0; kk < 128; ++kk) { const int k = F.wave * 128 + kk; const float w = w_ada[(size_t)k * 6144 + j];
#pragma unroll
            for (int b4 = 0; b4 < 8; ++b4) { const f32x4 cv = *(const LAS f32x4*)(cs + k * 32 + b4 * 4); acc[b4 * 4 + 0] += cv[0] * w; acc[b4 * 4 + 1] += cv[1] * w; acc[b4 * 4 + 2] += cv[2] * w; acc[b4 * 4 + 3] += cv[3] * w; } }
        __syncthreads();
        LAS float* red = (LAS float*)F.lds;
#pragma unroll
        for (int b = 0; b < 32; ++b) red[(F.wave * 32 + b) * 64 + F.lane] = acc[b];
        __syncthreads();
        for (int o = F.tid; o < 2048; o += NTHREADS) { const int b = o >> 6, l = o & 63; float s = b_ada[it * 64 + l];
#pragma unroll
            for (int w = 0; w < 8; ++w) s += red[(w * 32 + b) * 64 + l];
            mod[(size_t)b * 6144 + it * 64 + l] = s; }
        __syncthreads();
    }
    const int gt = F.bid * NTHREADS + F.tid, NGT = F.G * NTHREADS;
    { float* ropeN = (float*)(F.ws + WS_ROPE); float* ropeD = ropeN + 2048 * 16;
      for (int i = gt; i < 2048 * 12; i += NGT) { const int t = i / 12, j = i % 12; const bool isn = j < 8; const int ii = isn ? j : j - 8;
          const float ex = isn ? (float)(2 * ii) / 16.f : (float)(2 * ii) / 8.f;
          const float inv = exp2f(-ex * 18.931568569324174f);
          const float ang = (float)t * inv;
          const double rev = (double)ang * 0.15915494309189535; const double fr = rev - __builtin_rint(rev); const float rr = (float)(fr * 6.283185307179586);
          const float cs = __cosf(rr), sn = __sinf(rr);
          if (isn) { ropeN[(t * 8 + ii) * 2] = cs; ropeN[(t * 8 + ii) * 2 + 1] = sn; } else { ropeD[(t * 4 + ii) * 2] = cs; ropeD[(t * 4 + ii) * 2 + 1] = sn; } } }
    { bf16_t* whi = (bf16_t*)(F.ws + WS_WR); bf16_t* wlo = whi + 48 * 1024;
      for (int i = gt; i < 48 * 1024; i += NGT) { const int c = i >> 10, k = i & 1023; float w = 0.f;
          if (c < 4) w = F.in[20][k * 4 + c]; else if (c < 36) w = F.in[22][k * 32 + (c - 4)];
          const unsigned short h = f2bf(w); whi[i] = h; wlo[i] = f2bf(w - bf2f(h)); } }
    { bf16_t* pe = (bf16_t*)(F.ws + WS_PE);
      for (int i = gt; i < 256 * 1024; i += NGT) { const int r = i >> 10, k = i & 1023; float v = 0.f; if (r < 4) v = F.in[9][(r >> 1) * 2048 + (r & 1) * 1024 + k]; pe[i] = f2bf(v); } }
    { u32x4* l4 = (u32x4*)(F.ws + WS_LIST); for (int i = gt; i < (int)(NEXP * ECAP / 4); i += NGT) l4[i] = (u32x4){0u, 0u, 0u, 0u};
      unsigned* ctl = (unsigned*)(F.ws + WS_CTL); for (int i = gt; i < 8192; i += NGT) ctl[i] = 0u; }
}

struct TrD { const float* src; int ld; int sc; bf16_t* dst; int dld; int k0; int mode; int n0; int aux; };
DI TrD tr_desc(Frame& F, int it, int lane) {
    constexpr int I_IN = 16 * 96, I_OUT = 16 * 32, I_G = 32 * 16 * 16, I_D = 32 * 8 * 32;
    TrD d; int r = it; const int nq = lane & 7;
    if (r < I_IN) { const int kb = r / 96, nb = r % 96; d.n0 = nb * 32; const int n = d.n0 + 4 * nq; d.src = F.in[6]; d.ld = INCOLS; d.sc = origcol(n); d.dst = (bf16_t*)(F.ws + WS_WIN); d.dld = 1024; d.k0 = kb * 64; d.mode = 0; d.aux = 0; return d; }
    r -= I_IN;
    if (r < I_OUT) { const int kb = r / 32, nb = r % 32; d.n0 = nb * 32; d.src = F.in[19]; d.ld = 1024; d.sc = d.n0 + 4 * nq; d.dst = (bf16_t*)(F.ws + WS_WOUT); d.dld = 1024; d.k0 = kb * 64; d.mode = 0; d.aux = 0; return d; }
    r -= I_OUT;
    if (r < 2 * I_G) { const int up = r / I_G; r -= up * I_G; const int e = r / 256, q = r % 256, kb = q / 16, nb = q % 16; d.n0 = nb * 32;
        d.src = F.in[24 + up] + (size_t)e * 1024 * 512; d.ld = 512; d.sc = d.n0 + 4 * nq; d.dst = (bf16_t*)(F.ws + WS_WGU) + (size_t)e * 1024 * 1024; d.dld = 1024; d.k0 = kb * 64; d.mode = 1; d.aux = up; return d; }
    r -= 2 * I_G;
    if (r < I_D) { const int e = r / 256, q = r % 256, kb = q / 32, nb = q % 32; d.n0 = nb * 32;
        d.src = F.in[26] + (size_t)e * 512 * 1024; d.ld = 1024; d.sc = d.n0 + 4 * nq; d.dst = (bf16_t*)(F.ws + WS_WD) + (size_t)e * 1024 * 512; d.dld = 512; d.k0 = kb * 64; d.mode = 0; d.aux = 0; return d; }
    r -= I_D;
    { const int kvh = r / 128, q = r % 128, kb = q / 8, nb = q % 8; d.n0 = nb * 32; const int kv = kvh >> 1, half = kvh & 1;
      d.src = F.in[10] + (size_t)kv * 2048 * 256 + (size_t)half * 1024 * 256; d.ld = 256; d.sc = d.n0 + 4 * nq; d.dst = (bf16_t*)(F.ws + WS_WC1) + (size_t)kv * 512 * 1024; d.dld = 1024; d.k0 = kb * 64; d.mode = 2; d.aux = half; return d; }
}
DI void tr_load(const TrD& d, f32x4 (&v)[8], int lane) {
    const int kk = lane >> 3;
#pragma unroll
    for (int i = 0; i < 8; ++i) v[i] = d.sc >= 0 ? *(const f32x4*)(d.src + (size_t)(d.k0 + kk + 8 * i) * d.ld + d.sc) : (f32x4){0.f, 0.f, 0.f, 0.f};
}
DI void tr_finish(const TrD& d, const f32x4 (&v)[8], LAS float* scr, int lane) {
    const int kk = lane >> 3, nq = lane & 7;
#pragma unroll
    for (int i = 0; i < 8; ++i) *(LAS f32x4*)(scr + (kk + 8 * i) * 36 + 4 * nq) = v[i];
    asm volatile("s_waitcnt lgkmcnt(0)" ::: "memory");
    const int c = lane & 7;
#pragma unroll
    for (int j = 0; j < 4; ++j) { const int n = (lane >> 3) + 8 * j; const LAS float* s = scr + (8 * c) * 36 + n;
        u32x4 o; o.x = pk2(s[0 * 36], s[1 * 36]); o.y = pk2(s[2 * 36], s[3 * 36]); o.z = pk2(s[4 * 36], s[5 * 36]); o.w = pk2(s[6 * 36], s[7 * 36]);
        const int jn = d.n0 + n; const int row = d.mode == 0 ? jn : (d.mode == 1 ? 8 * (jn >> 2) + (jn & 3) + 4 * d.aux : d.aux * 256 + jn);
        *(u32x4*)(d.dst + (size_t)row * d.dld + d.k0 + 8 * c) = o; }
    asm volatile("s_waitcnt lgkmcnt(0)" ::: "memory");
}
DI void phase0_weights(Frame& F) {
    LAS float* scr = (LAS float*)(F.lds + F.wave * 16384);
    const int lane = F.lane;
    constexpr int NITEMS = 16 * 96 + 16 * 32 + 2 * (32 * 16 * 16) + 32 * 8 * 32 + 4 * 16 * 8;
    int it = F.gw; if (it >= NITEMS) return;
    TrD cur = tr_desc(F, it, lane); f32x4 vc[8]; tr_load(cur, vc, lane);
    for (;;) {
        const int nit = it + F.NGW; const bool more = nit < NITEMS;
        TrD nxt = cur; f32x4 vn[8];
        if (more) { nxt = tr_desc(F, nit, lane); tr_load(nxt, vn, lane); }
        tr_finish(cur, vc, scr, lane);
        if (!more) break;
        cur = nxt; it = nit;
#pragma unroll
        for (int i = 0; i < 8; ++i) vc[i] = vn[i];
    }
}

DI void phase1(Frame& F) {
    const float* x = F.in[0]; const float* g = F.in[4]; const float* mod = (const float*)(F.ws + WS_MOD); bf16_t* h1 = (bf16_t*)(F.ws + WS_H1);
    const int lane = F.lane;
    for (int m0 = F.gw * 32; m0 < TOK; m0 += F.NGW * 32) {
        const int b = m0 >> 11; const float* sh = mod + (size_t)b * 6144; const float* sc = sh + 1024;
        f32x4 A[4], Bv[4];
#pragma unroll
        for (int j = 0; j < 4; ++j) { const int col = 4 * lane + 256 * j; A[j] = *(const f32x4*)(g + col) * (*(const f32x4*)(sc + col) + 1.f); Bv[j] = *(const f32x4*)(sh + col); }
        const f32x4* xr = (const f32x4*)(x + (size_t)m0 * DM) + lane; u32x2* o8 = (u32x2*)(h1 + (size_t)m0 * DM) + lane;
        f32x4 v0[4], v1[4];
#pragma unroll
        for (int j = 0; j < 4; ++j) { v0[j] = xr[64 * j]; v1[j] = xr[256 + 64 * j]; }
        for (int i = 0; i < 32; i += 2) {
            f32x4 n0[4], n1[4];
            if (i + 2 < 32) {
#pragma unroll
                for (int j = 0; j < 4; ++j) { n0[j] = xr[(size_t)(i + 2) * 256 + 64 * j]; n1[j] = xr[(size_t)(i + 3) * 256 + 64 * j]; }
            }
            float s0 = 0.f, s1 = 0.f;
#pragma unroll
            for (int j = 0; j < 4; ++j) { s0 += (v0[j][0] * v0[j][0] + v0[j][1] * v0[j][1]) + (v0[j][2] * v0[j][2] + v0[j][3] * v0[j][3]); s1 += (v1[j][0] * v1[j][0] + v1[j][1] * v1[j][1]) + (v1[j][2] * v1[j][2] + v1[j][3] * v1[j][3]); }
#pragma unroll
            for (int o = 1; o < 64; o <<= 1) { s0 += __shfl_xor(s0, o); s1 += __shfl_xor(s1, o); }
            const float r0 = rsqrtf(s0 * (1.f / DM) + EPS), r1 = rsqrtf(s1 * (1.f / DM) + EPS);
#pragma unroll
            for (int j = 0; j < 4; ++j) { const f32x4 y0 = v0[j] * r0 * A[j] + Bv[j], y1 = v1[j] * r1 * A[j] + Bv[j];
                u32x2 w0, w1; w0.x = pk2(y0[0], y0[1]); w0.y = pk2(y0[2], y0[3]); w1.x = pk2(y1[0], y1[1]); w1.y = pk2(y1[2], y1[3]);
                o8[(size_t)i * 256 + 64 * j] = w0; o8[(size_t)(i + 1) * 256 + 64 * j] = w1; }
#pragma unroll
            for (int j = 0; j < 4; ++j) { v0[j] = n0[j]; v1[j] = n1[j]; }
        }
    }
}

DI void phase3(Frame& F) {
    const bf16_t* proj = (const bf16_t*)(F.ws + WS_PROJ);
    const float* ropeN = (const float*)(F.ws + WS_ROPE); const float* ropeD = ropeN + 2048 * 16;
    const float* g_nq = F.in[7]; const float* g_nk = F.in[8]; const float* g_dq = F.in[12]; const float* g_dk = F.in[13];
    const int lane = F.lane;
    for (int it = F.gw; it < TOK * 6; it += F.NGW) {
        const int m = it / 6, part = it % 6; const int b = m >> 11, t = m & 2047;
        const int c0 = part * 512 + lane * 8;
        const u32x4 raw = *(const u32x4*)(proj + (size_t)m * NPROJ + c0);
        float v[8]; v[0] = bflo(raw.x); v[1] = bfhi(raw.x); v[2] = bflo(raw.y); v[3] = bfhi(raw.y); v[4] = bflo(raw.z); v[5] = bfhi(raw.z); v[6] = bflo(raw.w); v[7] = bfhi(raw.w);
        float ss = 0.f;
#pragma unroll
        for (int i = 0; i < 8; ++i) ss += v[i] * v[i];
        ss += __shfl_xor(ss, 1); ss += __shfl_xor(ss, 2); const float ss32 = ss; ss += __shfl_xor(ss, 4); const float ss64 = ss;
        float pv[8];
#pragma unroll
        for (int i = 0; i < 8; ++i) pv[i] = __shfl_xor(v[i], 1);
        if (c0 < 1280) {
            const bool isq = c0 < 512; int six = 0, gsel = 0, d0;
            if (isq) { d0 = c0 & 63; } else { const int cc = c0 - 512; six = cc >> 7; gsel = (cc >> 6) & 1; d0 = cc & 63; }
            const bool donorm = isq || six == 2 || six == 4;
            float y[8];
            if (donorm) { const float* gg = isq ? g_nq : (g_nk + (six == 2 ? 64 : 128)); const float rstd = rsqrtf(ss64 * (1.f / 64.f) + EPS);
#pragma unroll
                for (int i = 0; i < 8; ++i) { y[i] = v[i] * rstd * gg[d0 + i]; pv[i] = pv[i] * rstd * gg[(d0 ^ 8) + i]; } }
            else {
#pragma unroll
                for (int i = 0; i < 8; ++i) y[i] = v[i]; }
            float yr[8];
#pragma unroll
            for (int i = 0; i < 8; ++i) yr[i] = y[i];
            if (donorm && d0 < 16) {
#pragma unroll
                for (int i = 0; i < 8; ++i) { const float cs = ropeN[(t * 8 + i) * 2], sn = ropeN[(t * 8 + i) * 2 + 1];
                    yr[i] = d0 == 0 ? (y[i] * cs - pv[i] * sn) : (pv[i] * sn + y[i] * cs); }
            }
            u32x4 w0, w1; w0.x = pk2(y[0], y[1]); w0.y = pk2(y[2], y[3]); w0.z = pk2(y[4], y[5]); w0.w = pk2(y[6], y[7]);
            w1.x = pk2(yr[0], yr[1]); w1.y = pk2(yr[2], yr[3]); w1.z = pk2(yr[4], yr[5]); w1.w = pk2(yr[6], yr[7]);
            if (isq) { const int hd = c0 >> 6; const size_t off = (((size_t)b * 8 + hd) * SEQ + t) * 64 + d0;
                *(u32x4*)((bf16_t*)(F.ws + WS_QN) + off) = w0; *(u32x4*)((bf16_t*)(F.ws + WS_QR) + off) = w1; }
            else { const size_t base = six == 0 ? WS_KC : six == 1 ? WS_VC : six == 2 ? WS_KS : six == 3 ? WS_VS : six == 4 ? WS_KW : WS_VW;
                const size_t off = (((size_t)b * 2 + gsel) * SEQ + t) * 64 + d0;
                *(u32x4*)((bf16_t*)(F.ws + base) + off) = donorm ? w1 : w0; }
        } else if (c0 < 2304) {
            const bool isq = c0 < 1792; const int cc = c0 - (isq ? 1280 : 1792); const int hd = cc >> 6, dd = cc & 63, d0 = dd & 31;
            const float* gg = isq ? g_dq : g_dk; const float rstd = rsqrtf(ss32 * (1.f / 32.f) + EPS);
            float y[8];
#pragma unroll
            for (int i = 0; i < 8; ++i) y[i] = v[i] * rstd * gg[d0 + i];
            if (d0 == 0) {
#pragma unroll
                for (int i = 0; i < 4; ++i) { const float cs = ropeD[(t * 4 + i) * 2], sn = ropeD[(t * 4 + i) * 2 + 1]; const float a = y[i], bb = y[i + 4]; y[i] = a * cs - bb * sn; y[i + 4] = a * sn + bb * cs; }
            }
            u32x4 w; w.x = pk2(y[0], y[1]); w.y = pk2(y[2], y[3]); w.z = pk2(y[4], y[5]); w.w = pk2(y[6], y[7]);
            const size_t off = (((size_t)b * 8 + hd) * SEQ + t) * 64 + dd;
            *(u32x4*)((bf16_t*)(F.ws + (isq ? WS_DQ : WS_DK)) + off) = w;
        } else if (c0 < 2816) {
            const int cc = c0 - 2304; const int hd = cc >> 6, dd = cc & 63; const size_t off = (((size_t)b * 8 + hd) * SEQ + t) * 64 + dd;
            *(u32x4*)((bf16_t*)(F.ws + WS_DV) + off) = raw;
        } else if (c0 < 2840) {
            float* gt = (float*)(F.ws + WS_GATES) + (size_t)m * 24 + (c0 - 2816);
#pragma unroll
            for (int i = 0; i < 8; ++i) gt[i] = 1.f / (1.f + __expf(-v[i]));
        }
    }
}

DI void glds16(const void* gsrc, unsigned lds_dst) { unsigned keep;
    asm volatile("s_mov_b32 %0, m0\n\ts_mov_b32 m0, %2\n\ts_nop 0\n\tglobal_load_lds_dwordx4 %1, off\n\ts_mov_b32 m0, %0" : "=&s"(keep) : "v"(gsrc), "s"(lds_dst) : "memory"); }
DI unsigned lds_addr(const LAS void* p) { return (unsigned)(uintptr_t)p; }
struct ALane { int k0; int v0; DI int ko(int ks) const { return k0 ^ (ks << 5); } DI int vo(int db) const { return v0 ^ (db << 6); } };
DI ALane alane_init(int lane) {
    ALane L; const int r = lane & 31, hh = lane >> 5, g = lane >> 4, i = lane & 15;
    L.k0 = r * 128 + ((hh ^ ((r >> 1) & 7)) << 4);
    const int rl = 4 * hh + (i >> 2); const int ch = 2 * (g & 1) + ((i & 3) >> 1);
    L.v0 = rl * 128 + ((ch ^ (((rl >> 1) & 1) << 2)) << 4) + 8 * (i & 1);
    return L;
}
DI s16x4 vtr(const LAS char* p) { typedef short v4i16 __attribute__((ext_vector_type(4))); return __builtin_bit_cast(s16x4, __builtin_amdgcn_ds_read_tr16_b64_v4i16((LAS v4i16*)p)); }
DI bf16x8 vfrag(const LAS char* Vt, const ALane& L, int db, int kb, int s) {
    const LAS char* p = Vt + L.vo(db) + (32 * kb + 16 * s) * 128;
    const s16x4 lo = vtr(p), hi = vtr(p + 8 * 128);
    return __builtin_shufflevector(lo, hi, 0, 1, 2, 3, 4, 5, 6, 7);
}
DI bf16x8 pfrag(const f32x16& p, int s) { u32x4 w; w.x = pk2(p[8 * s + 0], p[8 * s + 1]); w.y = pk2(p[8 * s + 2], p[8 * s + 3]); w.z = pk2(p[8 * s + 4], p[8 * s + 5]); w.w = pk2(p[8 * s + 6], p[8 * s + 7]); return __builtin_bit_cast(bf16x8, w); }
DI u32x4 tile_ld(const bf16_t* g, int tid) { return *(const u32x4*)(g + tid * 8); }
DI void tile_st_k(LAS char* Kt, u32x4 v, int tid) { const int row = tid >> 3, ch = tid & 7; *(LAS u32x4*)(Kt + row * 128 + ((ch ^ ((row >> 1) & 7)) << 4)) = v; }
DI void tile_st_v(LAS char* Vt, u32x4 v, int tid) { const int row = tid >> 3, ch = tid & 7; *(LAS u32x4*)(Vt + row * 128 + ((ch ^ (((row >> 1) & 1) << 2)) << 4)) = v; }

constexpr int MK_NONE = 0, MK_LE = 1, MK_GT = 2;
template <int MASK>
DI void sm16(f32x16& a, float c2, float mcl, int kb, int hh, int th) {
    if constexpr (MASK != MK_NONE) asm volatile("" : "+v"(th));
#pragma unroll
    for (int i = 0; i < 16; ++i) {
        float x = __builtin_fmaf(a[i], c2, -mcl);
        if constexpr (MASK != MK_NONE) { const int kl = 32 * kb + crow(i, hh); const bool ok = MASK == MK_LE ? (kl <= th) : (kl > th); x = ok ? x : -1.0e30f; }
        a[i] = fast_exp2(x);
    }
}
DI float sum16(const f32x16& a) { return ((a[0] + a[1]) + (a[2] + a[3])) + ((a[4] + a[5]) + (a[6] + a[7])) + ((a[8] + a[9]) + (a[10] + a[11])) + ((a[12] + a[13]) + (a[14] + a[15])); }
#define SCHED_FENCE() do { } while (0)
template <int MASK, bool KEEPP>
DI void attn_tile64(const LAS char* Kt, const LAS char* Vt, const ALane& L, const bf16x8 (&qf)[4], f32x16 (&O)[2], float& lsum, float c2, float mcl, int th, int hh, f32x16 (&P)[2]) {
    bf16x8 kf[2][4];
#pragma unroll
    for (int kb = 0; kb < 2; ++kb)
#pragma unroll
        for (int ks = 0; ks < 4; ++ks) kf[kb][ks] = *(const LAS bf16x8*)(Kt + L.ko(ks) + kb * 4096);
    SCHED_FENCE();
    f32x16 a0 = {0.f, 0.f, 0.f, 0.f, 0.f, 0.f, 0.f, 0.f, 0.f, 0.f, 0.f, 0.f, 0.f, 0.f, 0.f, 0.f}, a1 = a0;
#pragma unroll
    for (int ks = 0; ks < 4; ++ks) a0 = MFMA32(kf[0][ks], qf[ks], a0);
#pragma unroll
    for (int ks = 0; ks < 4; ++ks) a1 = MFMA32(kf[1][ks], qf[ks], a1);
    bf16x8 v0[2][2], v1[2][2];
#pragma unroll
    for (int s = 0; s < 2; ++s)
#pragma unroll
        for (int db = 0; db < 2; ++db) v0[s][db] = vfrag(Vt, L, db, 0, s);
    SCHED_FENCE();
    bf16x8 pf[2][2];
    sm16<MASK>(a0, c2, mcl, 0, hh, th); lsum += sum16(a0); pf[0][0] = pfrag(a0, 0); pf[0][1] = pfrag(a0, 1);
    if constexpr (KEEPP) P[0] = a0;
#pragma unroll
    for (int s = 0; s < 2; ++s)
#pragma unroll
        for (int db = 0; db < 2; ++db) v1[s][db] = vfrag(Vt, L, db, 1, s);
    SCHED_FENCE();
    sm16<MASK>(a1, c2, mcl, 1, hh, th); lsum += sum16(a1); pf[1][0] = pfrag(a1, 0); pf[1][1] = pfrag(a1, 1);
    if constexpr (KEEPP) P[1] = a1;
    SCHED_FENCE();
#pragma unroll
    for (int s = 0; s < 2; ++s)
#pragma unroll
        for (int db = 0; db < 2; ++db) O[db] = MFMA32(v0[s][db], pf[0][s], O[db]);
#pragma unroll
    for (int s = 0; s < 2; ++s)
#pragma unroll
        for (int db = 0; db < 2; ++db) O[db] = MFMA32(v1[s][db], pf[1][s], O[db]);
    SCHED_FENCE();
}
template <int MASK>
DI void attn_tile_dm(const LAS char* Kt, const LAS char* Vt, const ALane& L, int ko0, int ko1, const bf16x8 (&qf)[2], f32x16 (&O)[2], float& lsum, float c2, float mc, int th, int hh) {
    const bf16x8 k00 = *(const LAS bf16x8*)(Kt + ko0), k01 = *(const LAS bf16x8*)(Kt + ko1), k10 = *(const LAS bf16x8*)(Kt + ko0 + 4096), k11 = *(const LAS bf16x8*)(Kt + ko1 + 4096);
    SCHED_FENCE();
    f32x16 a0 = {0.f, 0.f, 0.f, 0.f, 0.f, 0.f, 0.f, 0.f, 0.f, 0.f, 0.f, 0.f, 0.f, 0.f, 0.f, 0.f}, a1 = a0;
    a0 = MFMA32(k00, qf[0], a0); a0 = MFMA32(k01, qf[1], a0); a1 = MFMA32(k10, qf[0], a1); a1 = MFMA32(k11, qf[1], a1);
    bf16x8 vf[2][2][2];
#pragma unroll
    for (int kb = 0; kb < 2; ++kb)
#pragma unroll
        for (int s = 0; s < 2; ++s)
#pragma unroll
            for (int db = 0; db < 2; ++db) vf[kb][s][db] = vfrag(Vt, L, db, kb, s);
    SCHED_FENCE();
    bf16x8 pf[2][2];
    sm16<MASK>(a0, c2, mc, 0, hh, th); lsum += sum16(a0); pf[0][0] = pfrag(a0, 0); pf[0][1] = pfrag(a0, 1);
    sm16<MASK>(a1, c2, mc, 1, hh, th); lsum += sum16(a1); pf[1][0] = pfrag(a1, 0); pf[1][1] = pfrag(a1, 1);
    SCHED_FENCE();
#pragma unroll
    for (int kb = 0; kb < 2; ++kb)
#pragma unroll
        for (int s = 0; s < 2; ++s)
#pragma unroll
            for (int db = 0; db < 2; ++db) O[db] = MFMA32(vf[kb][s][db], pf[kb][s], O[db]);
    SCHED_FENCE();
}
#define RING_WAIT(n) asm volatile("s_waitcnt vmcnt(" #n ")" ::: "memory")
template <class PreF, class CompF>
DI void attn_ring(LAS char* lds, const bf16_t* Kg, const bf16_t* Vg, unsigned tiles, int wid, int lane, PreF pre, CompF comp) {
    if (tiles == 0u) return;
    const int p = wid * 64 + lane, row = p >> 3, c = p & 7;
    const unsigned ksrc = (unsigned)(row * 128 + ((c ^ ((row >> 1) & 7)) << 4)), vsrc = (unsigned)(row * 128 + ((c ^ (((row >> 1) & 1) << 2)) << 4));
    LAS char* wb = lds + wid * 1024;
#define RING_ISSUE(j, slot) do { \
        glds16((const char*)(Kg) + (size_t)(j) * 8192 + ksrc, (unsigned)__builtin_amdgcn_readfirstlane((int)(lds_addr(wb) + (unsigned)(slot) * 16384u))); \
        glds16((const char*)(Vg) + (size_t)(j) * 8192 + vsrc, (unsigned)__builtin_amdgcn_readfirstlane((int)(lds_addr(wb) + (unsigned)(slot) * 16384u + 8192u))); } while (0)
    int q0 = __builtin_ctz(tiles); tiles &= tiles - 1u;
    int q1 = -1, q2 = -1;
    if (tiles) { q1 = __builtin_ctz(tiles); tiles &= tiles - 1u; }
    if (tiles) { q2 = __builtin_ctz(tiles); tiles &= tiles - 1u; }
    RING_ISSUE(q0, 0);
    if (q1 >= 0) RING_ISSUE(q1, 1);
    if (q2 >= 0) RING_ISSUE(q2, 2);
    pre();
    int i = 0;
    for (;;) {
        if (q2 >= 0) RING_WAIT(4); else if (q1 >= 0) RING_WAIT(2); else RING_WAIT(0);
        __builtin_amdgcn_s_barrier();
        int q3 = -1;
        if (tiles) { q3 = __builtin_ctz(tiles); tiles &= tiles - 1u; RING_ISSUE(q3, (i + 3) & 3); }
        LAS char* st = lds + (i & 3) * 16384;
        comp(q0, st, st + 8192);
        if (q1 < 0) break;
        q0 = q1; q1 = q2; q2 = q3; ++i;
    }
    asm volatile("s_waitcnt lgkmcnt(0)" ::: "memory");
    __builtin_amdgcn_s_barrier();
#undef RING_ISSUE
}

DI void diff_unit(Frame& F, int b, int hd, int qb, float c2, float mc, float lam) {
    const int tid = F.tid, lane = F.lane, wid = F.wave, r = lane & 31, hh = lane >> 5;
    const int rb = wid >> 1, mp = wid & 1;
    const bf16_t* Q = (const bf16_t*)(F.ws + WS_DQ) + ((size_t)b * 8 + hd) * SEQ * 64;
    const bf16_t* Kg = (const bf16_t*)(F.ws + WS_DK) + ((size_t)b * 8 + hd) * SEQ * 64;
    const bf16_t* Vg = (const bf16_t*)(F.ws + WS_DV) + ((size_t)b * 8 + hd) * SEQ * 64;
    LAS char* lds = (LAS char*)F.lds;
    const ALane L = alane_init(lane);
    const int ko0 = L.ko(2 * mp), ko1 = L.ko(2 * mp + 1);
    const int q0w = qb * 128 + rb * 32; const int qq = q0w + r;
    bf16x8 qf[2];
#pragma unroll
    for (int ks = 0; ks < 2; ++ks) qf[ks] = *(const bf16x8*)(Q + (size_t)qq * 64 + mp * 32 + ks * 16 + hh * 8);
    f32x16 O[2]; float lsum = 0.f;
#pragma unroll
    for (int i = 0; i < 16; ++i) { O[0][i] = 0.f; O[1][i] = 0.f; }
    const int ntile = 2 * qb + 2; const int jmax = 2 * qb + (rb >> 1);
    const unsigned tiles = ntile == 32 ? 0xffffffffu : ((1u << ntile) - 1u);
    attn_ring(lds, Kg, Vg, tiles, wid, lane, [&]() __attribute__((always_inline)) { asm volatile("" : "+v"(qf[0]), "+v"(qf[1])); },
        [&](int j, const LAS char* Kt, const LAS char* Vt) __attribute__((always_inline)) {
        if (j < jmax) attn_tile_dm<MK_NONE>(Kt, Vt, L, ko0, ko1, qf, O, lsum, c2, mc, 0, hh);
        else if (j == jmax) attn_tile_dm<MK_LE>(Kt, Vt, L, ko0, ko1, qf, O, lsum, c2, mc, qq - 64 * j, hh);
    });
    lsum += __shfl_xor(lsum, 32);
    LAS float* xo = (LAS float*)(lds + 65536 + rb * 8192) + lane;
    if (mp == 1) { const float s1 = lam / lsum;
#pragma unroll
        for (int db = 0; db < 2; ++db)
#pragma unroll
            for (int i = 0; i < 16; ++i) xo[(db * 16 + i) * 64] = O[db][i] * s1; }
    __syncthreads();
    if (mp == 0) {
        const float i0 = 1.f / lsum; float ss = 0.f;
#pragma unroll
        for (int db = 0; db < 2; ++db)
#pragma unroll
            for (int i = 0; i < 16; ++i) { const float o = O[db][i] * i0 - xo[(db * 16 + i) * 64]; O[db][i] = o; ss += o * o; }
        ss += __shfl_xor(ss, 32);
        const float rstd = rsqrtf(ss * (1.f / 64.f) + EPS) * 0.8f;
        const float* go = F.in[18];
        bf16_t* orow = (bf16_t*)(F.ws + WS_AO) + ((size_t)b * SEQ + qq) * DM + 512 + hd * 64;
#pragma unroll
        for (int db = 0; db < 2; ++db)
#pragma unroll
            for (int g4 = 0; g4 < 4; ++g4) { const int d = 32 * db + 8 * g4 + 4 * hh; const f32x4 gv = *(const f32x4*)(go + d);
                u32x2 w; w.x = pk2(O[db][4 * g4] * rstd * gv[0], O[db][4 * g4 + 1] * rstd * gv[1]); w.y = pk2(O[db][4 * g4 + 2] * rstd * gv[2], O[db][4 * g4 + 3] * rstd * gv[3]);
                *(u32x2*)(orow + d) = w; }
    }
}

#define NSA_BAR() do { asm volatile("s_waitcnt lgkmcnt(0)" ::: "memory"); __builtin_amdgcn_s_barrier(); asm volatile("" ::: "memory"); } while (0)
DI void nsa_unit(Frame& F, int b, int g, int qb, float c2, float mc) {
    const int lane = F.lane, wid = F.wave, r = lane & 31, hh = lane >> 5;
    const int hd = 4 * g + (wid >> 1); const int tl = 32 * (wid & 1) + r; const int t = 64 * qb + tl;
    LAS char* lds = (LAS char*)F.lds;
    LAS float* impP = (LAS float*)(lds + 65536);
    LAS unsigned* selm = (LAS unsigned*)(lds + LDS_MISC + 5120);
    LAS float* invs = (LAS float*)(selm + 128);
    LAS float* otp = (LAS float*)(lds + 65536 + wid * 8192) + lane;
    LAS float* gpark = (LAS float*)(lds + LDS_MISC + 8192 + wid * 768) + lane;
    const ALane L = alane_init(lane);
    const size_t bg = (size_t)b * 2 + g;
    bf16x8 qf[4];
    { const bf16_t* QN = (const bf16_t*)(F.ws + WS_QN) + (((size_t)b * 8 + hd) * SEQ + t) * 64;
#pragma unroll
      for (int ks = 0; ks < 4; ++ks) qf[ks] = *(const bf16x8*)(QN + ks * 16 + hh * 8);
      const float* gates = (const float*)(F.ws + WS_GATES) + ((size_t)b * SEQ + t) * 24 + hd * 3;
      const float g0_ = gates[0], g1_ = gates[1], g2_ = gates[2]; gpark[0] = g0_; gpark[64] = g1_; gpark[128] = g2_; }
    const char* KcB = (const char*)(F.ws + WS_KCMP) + bg * 16384; const char* VcB = (const char*)(F.ws + WS_VCMP) + bg * 16384;
    const char* KsB = (const char*)(F.ws + WS_KS) + bg * (SEQ * 128); const char* VsB = (const char*)(F.ws + WS_VS) + bg * (SEQ * 128);
    const char* KwB = (const char*)(F.ws + WS_KW) + bg * (SEQ * 128); const char* VwB = (const char*)(F.ws + WS_VW) + bg * (SEQ * 128);
    const int nf = qb == 0 ? 1 : (qb == 1 ? 2 : 3); const int f1 = qb == 1 ? 1 : qb - 1, f2 = qb;
    const unsigned fmask = 1u | (qb >= 1 ? (1u << qb) : 0u) | (qb >= 2 ? (1u << (qb - 1)) : 0u);
    const unsigned allb = qb == 31 ? 0xffffffffu : ((1u << (qb + 1)) - 1u);
    unsigned grest = qb <= 5 ? (allb & ~fmask) : 0u;
    const int jlo = qb >= 4 ? qb - 4 : 0;
    int gph = 0, gi = 0;
    const int p_ = wid * 64 + lane, prow = p_ >> 3, pc = p_ & 7;
    const unsigned ksrc = (unsigned)(prow * 128 + ((pc ^ ((prow >> 1) & 7)) << 4)), vsrc = (unsigned)(prow * 128 + ((pc ^ (((prow >> 1) & 1) << 2)) << 4));
    const unsigned wbase = lds_addr(lds) + (unsigned)wid * 1024u;
#define NSA_GEN(ty, jj) do { ty = -1; jj = 0; \
        if (gph == 0) { ty = 0; jj = gi; if (++gi == 2) { gph = 1; gi = 0; } } \
        else if (gph == 1) { ty = 1; jj = gi == 0 ? 0 : (gi == 1 ? f1 : f2); if (++gi == nf) gph = 2; } \
        else { if (gph == 2) { if (grest) { ty = 1; jj = __builtin_ctz(grest); grest &= grest - 1u; } else { gph = 3; gi = jlo; } } \
               if (gph == 3) { if (gi <= qb) { ty = 2; jj = gi++; } else gph = 4; } } } while (0)
#define NSA_ISSUE(ty, jj, slot) do { const char* kp_ = ty == 0 ? KcB : (ty == 1 ? KsB : KwB); const char* vp_ = ty == 0 ? VcB : (ty == 1 ? VsB : VwB); \
        glds16(kp_ + (size_t)(jj) * 8192 + ksrc, (unsigned)__builtin_amdgcn_readfirstlane((int)(wbase + (unsigned)(slot) * 16384u))); \
        glds16(vp_ + (size_t)(jj) * 8192 + vsrc, (unsigned)__builtin_amdgcn_readfirstlane((int)(wbase + (unsigned)(slot) * 16384u + 8192u))); } while (0)
    int t0, j0, t1, j1, t2, j2;
    NSA_GEN(t0, j0); NSA_GEN(t1, j1); NSA_GEN(t2, j2);
    NSA_ISSUE(t0, j0, 0); NSA_ISSUE(t1, j1, 1); if (t2 >= 0) NSA_ISSUE(t2, j2, 2);
#pragma unroll
    for (int ks = 0; ks < 4; ++ks) asm volatile("" : "+v"(qf[ks]));
    f32x16 O[2]; float lv = 0.f; float carry_in = 0.f; unsigned mym = 0u; bool inB = false;
#pragma unroll
    for (int i = 0; i < 16; ++i) { O[0][i] = 0.f; O[1][i] = 0.f; }
    const int nvalid = t >= 31 ? ((t - 31) >> 4) + 1 : 0;
    for (int n = 0;; ++n) {
        if (t2 >= 0) RING_WAIT(4); else if (t1 >= 0) RING_WAIT(2); else RING_WAIT(0);
        __builtin_amdgcn_s_barrier();
        int t3, j3;
        NSA_GEN(t3, j3);
        if (t3 >= 0) NSA_ISSUE(t3, j3, (n + 3) & 3);
        const LAS char* Kt = lds + (n & 3) * 16384; const LAS char* Vt = Kt + 8192;
        int mode = MK_LE, th = tl; float mcl = mc;
        if (t0 == 0) { th = nvalid - 1 - 64 * j0; }
        else if (t0 == 1) { mcl = ((mym >> j0) & 1u) ? mc : 1.0e30f; mode = j0 < qb ? MK_NONE : MK_LE; }
        else {
            if (inB) {
                float lsum = lv; lsum += __shfl_xor(lsum, 32); const float s1 = gpark[64] / lsum;
#pragma unroll
                for (int db = 0; db < 2; ++db)
#pragma unroll
                    for (int i = 0; i < 16; ++i) { otp[(db * 16 + i) * 64] += O[db][i] * s1; O[db][i] = 0.f; }
                lv = 0.f; inB = false;
            }
            mode = j0 == qb ? MK_LE : (j0 == qb - 4 ? MK_GT : MK_NONE);
        }
        if (t0 != 0) {
            f32x16 Pd[2];
            if (mode == MK_NONE) attn_tile64<MK_NONE, false>(Kt, Vt, L, qf, O, lv, c2, mcl, 0, hh, Pd);
            else if (mode == MK_LE) attn_tile64<MK_LE, false>(Kt, Vt, L, qf, O, lv, c2, mcl, th, hh, Pd);
            else attn_tile64<MK_GT, false>(Kt, Vt, L, qf, O, lv, c2, mcl, th, hh, Pd);
        } else {
            f32x16 P[2];
            attn_tile64<MK_LE, true>(Kt, Vt, L, qf, O, lv, c2, mcl, th, hh, P);
            LAS float* ip = impP + ((wid >> 1) * 64 + tl) * 33;
            float av[8], rc[8];
#pragma unroll
            for (int kb = 0; kb < 2; ++kb)
#pragma unroll
                for (int gq = 0; gq < 4; ++gq) { const int f = 4 * kb + gq; const float p3 = 0.5f * P[kb][4 * gq + 3]; av[f] = P[kb][4 * gq] + P[kb][4 * gq + 1] + P[kb][4 * gq + 2] + p3; rc[f] = __shfl_xor(p3, 32); }
#pragma unroll
            for (int f = 0; f < 8; ++f) { const float carry = hh == 1 ? rc[f] : (f > 0 ? rc[f > 0 ? f - 1 : 0] : carry_in); ip[2 * (8 * j0 + f) + hh] = av[f] + carry; }
            carry_in = rc[7];
            if (j0 == 1) {
                {
                    const bf16_t* QR = (const bf16_t*)(F.ws + WS_QR) + (((size_t)b * 8 + hd) * SEQ + t) * 64;
#pragma unroll
                    for (int ks = 0; ks < 4; ++ks) qf[ks] = *(const bf16x8*)(QR + ks * 16 + hh * 8); }
                float lsum = lv; lsum += __shfl_xor(lsum, 32);
                const float inv = lsum > 0.f ? 1.f / lsum : 0.f;
                if (hh == 0) invs[(wid >> 1) * 64 + tl] = inv;
                const float s0 = gpark[0] * inv;
                lv = 0.f;
                NSA_BAR();
                if (wid == 0) {
                    unsigned m;
                    if (qb <= 5) m = allb;
                    else {
                        m = fmask;
                        float best[3] = {-1.f, -1.f, -1.f}; int bi[3] = {0, 0, 0}; const float iv0 = invs[lane], iv1 = invs[64 + lane], iv2 = invs[128 + lane], iv3 = invs[192 + lane];
                        for (int j = 1; j <= qb - 2; ++j) {
                            const float v = (impP[(0 * 64 + lane) * 33 + j] * iv0 + impP[(1 * 64 + lane) * 33 + j] * iv1) + (impP[(2 * 64 + lane) * 33 + j] * iv2 + impP[(3 * 64 + lane) * 33 + j] * iv3);
                            if (v > best[0]) { best[2] = best[1]; bi[2] = bi[1]; best[1] = best[0]; bi[1] = bi[0]; best[0] = v; bi[0] = j; }
                            else if (v > best[1]) { best[2] = best[1]; bi[2] = bi[1]; best[1] = v; bi[1] = j; }
                            else if (v > best[2]) { best[2] = v; bi[2] = j; }
                        }
                        m |= (1u << bi[0]) | (1u << bi[1]) | (1u << bi[2]);
                    }
                    selm[lane] = m;
                    unsigned u = m;
#pragma unroll
                    for (int o = 1; o < 64; o <<= 1) u |= (unsigned)__shfl_xor((int)u, o);
                    if (lane == 0) selm[64] = u;
                }
                NSA_BAR();
                mym = selm[tl];
                if (qb > 5) grest = (unsigned)__builtin_amdgcn_readfirstlane((int)selm[64]) & ~fmask;
#pragma unroll
                for (int db = 0; db < 2; ++db)
#pragma unroll
                    for (int i = 0; i < 16; ++i) { otp[(db * 16 + i) * 64] = O[db][i] * s0; O[db][i] = 0.f; }
                inB = true;
#pragma unroll
                for (int ks = 0; ks < 4; ++ks) asm volatile("" : "+v"(qf[ks]));
            }
        }
        if (t1 < 0) break;
        t0 = t1; j0 = j1; t1 = t2; j1 = j2; t2 = t3; j2 = j3;
    }
    {
        float lsum = lv; lsum += __shfl_xor(lsum, 32); const float s2 = gpark[128] / lsum;
#pragma unroll
        for (int db = 0; db < 2; ++db)
#pragma unroll
            for (int i = 0; i < 16; ++i) O[db][i] = otp[(db * 16 + i) * 64] + O[db][i] * s2;
    }
    bf16_t* orow = (bf16_t*)(F.ws + WS_AO) + ((size_t)b * SEQ + t) * DM + hd * 64;
#pragma unroll
    for (int db = 0; db < 2; ++db)
#pragma unroll
        for (int g4 = 0; g4 < 4; ++g4) { const int d = 32 * db + 8 * g4 + 4 * hh;
            u32x2 w; w.x = pk2(O[db][4 * g4], O[db][4 * g4 + 1]); w.y = pk2(O[db][4 * g4 + 2], O[db][4 * g4 + 3]);
            *(u32x2*)(orow + d) = w; }
    NSA_BAR();
#undef NSA_GEN
#undef NSA_ISSUE
}

DI float gmax(const float* g, int n, int lane) { float v = lane < n ? fabsf(g[lane]) : 0.f;
#pragma unroll
    for (int o = 1; o < 64; o <<= 1) v = fmaxf(v, __shfl_xor(v, o));
    return v; }

DI int queue_next(Frame& F, unsigned* ctr) {
    LAS int* slot = (LAS int*)(F.lds + LDS_MISC + 4096);
    __syncthreads();
    if (F.tid == 0) *slot = (int)atomicAdd(ctr, 1u);
    __syncthreads();
    return *slot;
}

DI int queue_pass(Frame& F, unsigned nx) {
    LAS int* slot = (LAS int*)(F.lds + LDS_MISC + 4096);
    __syncthreads();
    if (F.tid == 0) *slot = (int)nx;
    __syncthreads();
    return *slot;
}

DI float gelu_tanh(float x) { const float u = 0.7978845608028654f * (x + 0.044715f * x * x * x); const float e = __expf(2.f * u); const float th = 1.f - 2.f / (e + 1.f); return 0.5f * x * (1.f + th); }
DI void phase5(Frame& F) {
    const bf16_t* UL = (const bf16_t*)(F.ws + WS_UL); const float* w2 = F.in[11]; const float* gk0 = F.in[8];
    LAS float* w2s = (LAS float*)F.lds;
    LAS float* hid = (LAS float*)(F.lds + LDS_MISC + 8192 + F.wave * 1024);
    for (int i = F.tid; i < 2 * 256 * 64 / 4; i += NTHREADS) ((LAS f32x4*)w2s)[i] = ((const f32x4*)w2)[i];
    __syncthreads();
    const int lane = F.lane;
    for (int it = F.gw; it < 2 * 64 * 128; it += F.NGW) {
        const int kv = it >> 13, rem = it & 8191, bgi = rem >> 7, c = rem & 127;
        bf16_t* dst = (bf16_t*)(F.ws + (kv ? WS_VCMP : WS_KCMP)) + ((size_t)bgi * 128 + c) * 64;
        if (c == 127) { dst[lane] = 0; continue; }
        const size_t row = (size_t)kv * 8192 + (size_t)bgi * 128 + c;
        const size_t perow = 16384 + (size_t)kv * 256 + (size_t)kv * 2;
        const u32x2 u4 = *(const u32x2*)(UL + row * 512 + 4 * lane), l4 = *(const u32x2*)(UL + (row + 1) * 512 + 256 + 4 * lane);
        const u32x2 pu = *(const u32x2*)(UL + perow * 512 + 4 * lane), pl = *(const u32x2*)(UL + (perow + 1) * 512 + 256 + 4 * lane);
        float h[4];
        h[0] = bflo(u4.x) + bflo(l4.x) + bflo(pu.x) + bflo(pl.x); h[1] = bfhi(u4.x) + bfhi(l4.x) + bfhi(pu.x) + bfhi(pl.x);
        h[2] = bflo(u4.y) + bflo(l4.y) + bflo(pu.y) + bflo(pl.y); h[3] = bfhi(u4.y) + bfhi(l4.y) + bfhi(pu.y) + bfhi(pl.y);
        f32x4 hv;
#pragma unroll
        for (int i = 0; i < 4; ++i) hv[i] = gelu_tanh(h[i]);
        *(LAS f32x4*)(hid + 4 * lane) = hv;
        asm volatile("s_waitcnt lgkmcnt(0)" ::: "memory");
        const LAS float* w = w2s + kv * 256 * 64 + lane; float acc0 = 0.f, acc1 = 0.f;
#pragma unroll 8
        for (int k = 0; k < 256; k += 4) { const f32x4 hh4 = *(const LAS f32x4*)(hid + k);
            acc0 += hh4[0] * w[(k + 0) * 64]; acc1 += hh4[1] * w[(k + 1) * 64]; acc0 += hh4[2] * w[(k + 2) * 64]; acc1 += hh4[3] * w[(k + 3) * 64]; }
        float acc = acc0 + acc1;
        if (kv == 0) { const float ss = wave_sum(acc * acc); acc = acc * rsqrtf(ss * (1.f / 64.f) + EPS) * gk0[lane]; }
        dst[lane] = f2bf(acc);
        asm volatile("s_waitcnt lgkmcnt(0)" ::: "memory");
    }
    __syncthreads();
}

DI void phase8(Frame& F) {
    const bf16_t* x1 = (const bf16_t*)(F.ws + WS_X1B); const float* gf = F.in[5]; const float* mod = (const float*)(F.ws + WS_MOD); const float* rowss = (const float*)(F.ws + WS_ROWSS);
    const char* wsrc = (const char*)(F.ws + WS_WR);
    bf16_t* h2 = (bf16_t*)(F.ws + WS_H2);
    unsigned* cnt = (unsigned*)(F.ws + WS_CTL) + CW_CNT; int* lists = (int*)(F.ws + WS_LIST);
    int* tipos = (int*)(F.ws + WS_TIPOS); int* tie = (int*)(F.ws + WS_TIE); float* tiw = (float*)(F.ws + WS_TIW);
    const float* brg = F.in[21]; const float* bre = F.in[23];
    const int lane = F.lane, wid = F.wave, row = lane & 15, kq = lane >> 4;
    LAS char* wl = (LAS char*)F.lds;
    LAS float* lg = (LAS float*)(F.lds + 98304 + wid * 3072);
    LAS float* A2 = (LAS float*)(F.lds + 122880);
    LAS float* B2 = A2 + 1024;
    LAS unsigned* hist = (LAS unsigned*)(F.lds + LDS_MISC + 8192);
    unsigned wso[6];
#pragma unroll
    for (int i = 0; i < 6; ++i) { const int s = i * 512 + F.tid, part = s / 1536, r = (s >> 5) % 48, cs = s & 31; wso[i] = (unsigned)(part * 98304 + r * 2048 + ((cs ^ (r & 15)) << 4)); }
#define P8_ISSUE(kc, buf) do { _Pragma("unroll") for (int i_ = 0; i_ < 6; ++i_) \
        __builtin_amdgcn_global_load_lds((const unsigned*)(wsrc + (size_t)(kc) * 512 + wso[i_]), (LAS unsigned*)(wl + (buf) * 49152 + i_ * 8192 + wid * 1024), 16, 0, 0); } while (0)
    const int nbatch = TOK / 128;
    for (int bt = F.bid; bt < nbatch; bt += F.G) {
        const int m0 = bt * 128 + wid * 16; const int m = m0 + row; const int b = m0 >> 11;
        P8_ISSUE(0, 0);
        { const float* sh = mod + (size_t)b * 6144 + 3072; const float* sc = sh + 1024;
          for (int k = F.tid; k < 1024; k += NTHREADS) { A2[k] = gf[k] * (sc[k] + 1.f); B2[k] = sh[k]; } }
        if (F.tid < 64) hist[F.tid] = 0u;
        float rs = 0.f; { const f32x4* rp = (const f32x4*)(rowss + (size_t)m * 16);
#pragma unroll
            for (int q = 0; q < 4; ++q) { const f32x4 v = rp[q]; rs += (v[0] + v[1]) + (v[2] + v[3]); } }
        const float rstd = rsqrtf(rs * (1.f / DM) + EPS);
        const bf16_t* xrow = x1 + (size_t)m * DM + 8 * kq; bf16_t* hrow = h2 + (size_t)m * DM + 8 * kq;
        u32x4 xw[4];
#pragma unroll
        for (int u = 0; u < 4; ++u) xw[u] = *(const u32x4*)(xrow + 32 * u);
        f32x4 acc[3] = {{0.f, 0.f, 0.f, 0.f}, {0.f, 0.f, 0.f, 0.f}, {0.f, 0.f, 0.f, 0.f}};
        for (int kc = 0; kc < 4; ++kc) {
            asm volatile("s_waitcnt vmcnt(0)" ::: "memory");
            __syncthreads();
            if (kc + 1 < 4) P8_ISSUE(kc + 1, (kc + 1) & 1);
            const LAS char* wb = wl + (kc & 1) * 49152;
#pragma unroll 1
            for (int g4 = 0; g4 < 2; ++g4) {
                const int gg = kc * 2 + g4;
                u32x4 nw[4];
                if (gg + 1 < 8) {
#pragma unroll
                    for (int u = 0; u < 4; ++u) nw[u] = *(const u32x4*)(xrow + 128 * (gg + 1) + 32 * u);
                }
#pragma unroll
                for (int u = 0; u < 4; ++u) {
                    const int k0 = 128 * gg + 32 * u + 8 * kq;
                    const f32x4 a0 = *(const LAS f32x4*)(A2 + k0), a1 = *(const LAS f32x4*)(A2 + k0 + 4), b0 = *(const LAS f32x4*)(B2 + k0), b1 = *(const LAS f32x4*)(B2 + k0 + 4);
                    const f32x4 xa_ = {bflo(xw[u].x), bfhi(xw[u].x), bflo(xw[u].y), bfhi(xw[u].y)}, xb_ = {bflo(xw[u].z), bfhi(xw[u].z), bflo(xw[u].w), bfhi(xw[u].w)};
                    const f32x4 ya = xa_ * rstd * a0 + b0, yb = xb_ * rstd * a1 + b1;
                    u32x4 hi; hi.x = pk2(ya[0], ya[1]); hi.y = pk2(ya[2], ya[3]); hi.z = pk2(yb[0], yb[1]); hi.w = pk2(yb[2], yb[3]);
                    *(u32x4*)(hrow + 128 * gg + 32 * u) = hi;
                    u32x4 lo; lo.x = pk2(ya[0] - bflo(hi.x), ya[1] - bfhi(hi.x)); lo.y = pk2(ya[2] - bflo(hi.y), ya[3] - bfhi(hi.y)); lo.z = pk2(yb[0] - bflo(hi.z), yb[1] - bfhi(hi.z)); lo.w = pk2(yb[2] - bflo(hi.w), yb[3] - bfhi(hi.w));
                    const bf16x8 ahi = __builtin_bit_cast(bf16x8, hi), alo = __builtin_bit_cast(bf16x8, lo);
                    const int ch = (g4 * 4 + u) * 4 + kq;
#pragma unroll
                    for (int ct = 0; ct < 3; ++ct) { const int r = 16 * ct + row; const int off = r * 512 + ((ch ^ row) << 4);
                        const bf16x8 bh = *(const LAS bf16x8*)(wb + off), bl = *(const LAS bf16x8*)(wb + 24576 + off);
                        acc[ct] = MFMA16(ahi, bh, acc[ct]); acc[ct] = MFMA16(alo, bh, acc[ct]); acc[ct] = MFMA16(ahi, bl, acc[ct]); }
                }
#pragma unroll
                for (int u = 0; u < 4; ++u) xw[u] = nw[u];
            }
        }
#pragma unroll
        for (int ct = 0; ct < 3; ++ct)
#pragma unroll
            for (int i = 0; i < 4; ++i) lg[(kq * 4 + i) * 48 + 16 * ct + row] = acc[ct][i];
        asm volatile("s_waitcnt lgkmcnt(0)" ::: "memory");
        int e0 = 0, e1 = 0; float w0 = 0.f, w1 = 0.f; unsigned lp0 = 0u, lp1 = 0u;
        if (lane < 16) {
            const LAS float* lr = lg + lane * 48;
            float g4v[4]; int grp = 0; float gm = -3.0e38f;
#pragma unroll
            for (int i = 0; i < 4; ++i) { g4v[i] = lr[i] + brg[i]; if (g4v[i] > gm) { gm = g4v[i]; grp = i; } }
            float den = 0.f;
#pragma unroll
            for (int i = 0; i < 4; ++i) den += __expf(g4v[i] - gm);
            const float pg = 1.f / den;
            float v0 = -3.0e38f, v1 = -3.0e38f; int i0 = 0, i1 = 0;
            for (int i = 0; i < 8; ++i) { const float v = lr[4 + grp * 8 + i] + bre[grp * 8 + i];
                if (v > v0) { v1 = v0; i1 = i0; v0 = v; i0 = i; } else if (v > v1) { v1 = v; i1 = i; } }
            const float ex = __expf(v1 - v0); w0 = pg / (1.f + ex); w1 = pg * ex / (1.f + ex);
            e0 = grp * 8 + i0; e1 = grp * 8 + i1;
            lp0 = atomicAdd((unsigned*)&hist[e0], 1u); lp1 = atomicAdd((unsigned*)&hist[e1], 1u);
        }
        __syncthreads();
        if (F.tid < 32) { const unsigned n = hist[F.tid]; hist[32 + F.tid] = n ? atomicAdd(cnt + F.tid, n) : 0u; }
        __syncthreads();
        if (lane < 16) {
            const int tok = m0 + lane; const int p0 = (int)(hist[32 + e0] + lp0), p1 = (int)(hist[32 + e1] + lp1);
            lists[(size_t)e0 * ECAP + p0] = tok; lists[(size_t)e1 * ECAP + p1] = tok;
            tipos[2 * tok] = p0; tipos[2 * tok + 1] = p1; tie[tok] = e0 | (e1 << 8); tiw[2 * tok] = w0; tiw[2 * tok + 1] = w1;
        }
        __syncthreads();
    }
#undef P8_ISSUE
}

DI LAS int* moe_prefix(Frame& F) {
    LAS int* tb = (LAS int*)(F.lds + LDS_MISC);
    __syncthreads();
    if (F.wave == 0) {
        const unsigned* cnt = (const unsigned*)(F.ws + WS_CTL) + CW_CNT; const int l = F.lane;
        int v = l < 32 ? (int)((__hip_atomic_load(cnt + l, __ATOMIC_RELAXED, __HIP_MEMORY_SCOPE_AGENT) + 255u) >> 8) : 0;
#pragma unroll
        for (int o = 1; o < 32; o <<= 1) { const int u = __shfl_up(v, o); if (l >= o) v += u; }
        if (l < 32) tb[l + 1] = v;
        if (l == 0) tb[0] = 0;
    }
    __syncthreads();
    return tb;
}

DI void phase11(Frame& F) {
    LAS int* tb = moe_prefix(F);
    const bf16_t* Y = (const bf16_t*)(F.ws + WS_Y); const float* mod = (const float*)(F.ws + WS_MOD);
    const int* tipos = (const int*)(F.ws + WS_TIPOS); const int* tie = (const int*)(F.ws + WS_TIE); const float* tiw = (const float*)(F.ws + WS_TIW);
    const int lane = F.lane;
    for (int m0 = F.gw * 32; m0 < TOK; m0 += F.NGW * 32) {
        const int b = m0 >> 11; const float* g2 = mod + (size_t)b * 6144 + 5120;
        f32x4 ga[2], gb[2];
#pragma unroll
        for (int j = 0; j < 2; ++j) { ga[j] = *(const f32x4*)(g2 + 8 * lane + 512 * j); gb[j] = *(const f32x4*)(g2 + 8 * lane + 512 * j + 4); }
        int mr0 = 0, mr1 = 0; float mw0 = 0.f, mw1 = 0.f;
        { const int mm = m0 + (lane & 31); const int ee = tie[mm]; mr0 = tb[ee & 255] * 256 + tipos[2 * mm]; mr1 = tb[ee >> 8] * 256 + tipos[2 * mm + 1]; mw0 = tiw[2 * mm]; mw1 = tiw[2 * mm + 1]; }
        float* obase = F.out + (size_t)m0 * DM + 8 * lane; const bf16_t* xbase = (const bf16_t*)(F.ws + WS_X1B) + (size_t)m0 * DM + 8 * lane;
#define P11_LOAD(i, ya, yb, xa, xb) do { const size_t r0_ = (size_t)__shfl(mr0, (i)), r1_ = (size_t)__shfl(mr1, (i)); \
            _Pragma("unroll") for (int j = 0; j < 2; ++j) { ya[j] = *(const u32x4*)(Y + r0_ * DM + 8 * lane + 512 * j); yb[j] = *(const u32x4*)(Y + r1_ * DM + 8 * lane + 512 * j); \
                const u32x4 xw_ = *(const u32x4*)(xbase + (size_t)(i) * DM + 512 * j); xa[j] = (f32x4){bflo(xw_.x), bfhi(xw_.x), bflo(xw_.y), bfhi(xw_.y)}; xb[j] = (f32x4){bflo(xw_.z), bfhi(xw_.z), bflo(xw_.w), bfhi(xw_.w)}; } } while (0)
        u32x4 ya0[2], yb0[2], ya1[2], yb1[2]; f32x4 xa0[2], xb0[2], xa1[2], xb1[2];
        P11_LOAD(0, ya0, yb0, xa0, xb0); P11_LOAD(1, ya1, yb1, xa1, xb1);
        for (int i = 0; i < 32; i += 2) {
            u32x4 nya0[2], nyb0[2], nya1[2], nyb1[2]; f32x4 nxa0[2], nxb0[2], nxa1[2], nxb1[2];
            if (i + 2 < 32) { P11_LOAD(i + 2, nya0, nyb0, nxa0, nxb0); P11_LOAD(i + 3, nya1, nyb1, nxa1, nxb1); }
#define P11_ROW(i, ya, yb, xa, xb) do { const float w0 = __shfl(mw0, (i)), w1 = __shfl(mw1, (i)); \
            _Pragma("unroll") for (int j = 0; j < 2; ++j) { f32x4 oa = xa[j], ob = xb[j]; \
                oa[0] += ga[j][0] * (w0 * bflo(ya[j].x) + w1 * bflo(yb[j].x)); oa[1] += ga[j][1] * (w0 * bfhi(ya[j].x) + w1 * bfhi(yb[j].x)); \
                oa[2] += ga[j][2] * (w0 * bflo(ya[j].y) + w1 * bflo(yb[j].y)); oa[3] += ga[j][3] * (w0 * bfhi(ya[j].y) + w1 * bfhi(yb[j].y)); \
                ob[0] += gb[j][0] * (w0 * bflo(ya[j].z) + w1 * bflo(yb[j].z)); ob[1] += gb[j][1] * (w0 * bfhi(ya[j].z) + w1 * bfhi(yb[j].z)); \
                ob[2] += gb[j][2] * (w0 * bflo(ya[j].w) + w1 * bflo(yb[j].w)); ob[3] += gb[j][3] * (w0 * bfhi(ya[j].w) + w1 * bfhi(yb[j].w)); \
                *(f32x4*)(obase + (size_t)(i) * DM + 512 * j) = oa; *(f32x4*)(obase + (size_t)(i) * DM + 512 * j + 4) = ob; } } while (0)
            P11_ROW(i, ya0, yb0, xa0, xb0); P11_ROW(i + 1, ya1, yb1, xa1, xb1);
#pragma unroll
            for (int j = 0; j < 2; ++j) { ya0[j] = nya0[j]; yb0[j] = nyb0[j]; xa0[j] = nxa0[j]; xb0[j] = nxb0[j]; ya1[j] = nya1[j]; yb1[j] = nyb1[j]; xa1[j] = nxa1[j]; xb1[j] = nxb1[j]; }
        }
#undef P11_LOAD
#undef P11_ROW
    }
}

constexpr int CW_BAR = 4096;
#define XB_TMO      128
#define XB_XCNT(j)  (256  + 64 * (j))
#define XB_XSUB(j)  (1280 + 64 * (j))
#define XB_XGEN(j)  (2304 + 64 * (j))
#define XB_TOP      3328
#define XB_TOPGEN   3392
#define XB_SPIN_CAP (1u << 22)
DI unsigned xb_ld(unsigned* p)              { return __hip_atomic_load(p, __ATOMIC_RELAXED, __HIP_MEMORY_SCOPE_AGENT); }
DI unsigned xb_add(unsigned* p, unsigned v) { return __hip_atomic_fetch_add(p, v, __ATOMIC_RELAXED, __HIP_MEMORY_SCOPE_AGENT); }
DI unsigned xb_xcc_id() { return (unsigned)__builtin_amdgcn_s_getreg((3 << 11) | 20) & 0xFu; }
#define XB_SPIN(cond, bar) do { unsigned _sp = 0; while (cond) { __builtin_amdgcn_s_sleep(1); \
    if ((++_sp & 255u) == 0u) { if (xb_ld(&(bar)[XB_TMO])) break; if (_sp > XB_SPIN_CAP) { atomicAdd(&(bar)[XB_TMO], 1u); break; } } } } while (0)
struct XcdBarrier { unsigned* bar; unsigned x; volatile LAS unsigned* st; };
DI XcdBarrier xcd_barrier_post(unsigned* bar, volatile LAS unsigned* st, bool leader) {
    XcdBarrier b; b.bar = bar; b.x = xb_xcc_id(); b.st = st;
    if (leader) (void)xb_add(&bar[XB_XCNT(b.x)], 1u);
    return b;
}
DI void xcd_barrier_complete(unsigned* bar, unsigned x, unsigned& nloc, unsigned& nx) {
    const unsigned G = gridDim.x;
    unsigned sum, cnt, mine, sp = 0u;
    for (;;) {
        sum = 0u; cnt = 0u; mine = 0u;
#pragma unroll
        for (unsigned j = 0; j < 16; ++j) { const unsigned c = xb_ld(&bar[XB_XCNT(j)]); sum += c; cnt += (c > 0u) ? 1u : 0u; mine = (j == x) ? c : mine; }
        if (sum == G) break;
        __builtin_amdgcn_s_sleep(1);
        if ((++sp & 255u) == 0u) { if (xb_ld(&bar[XB_TMO])) break; if (sp > XB_SPIN_CAP) { atomicAdd(&bar[XB_TMO], 1u); break; } }
    }
    nloc = mine > 0u ? mine : 1u; nx = cnt > 0u ? cnt : 1u;
}
DI void xcd_barrier(const XcdBarrier& b, bool leader) {
    asm volatile("s_waitcnt vmcnt(0)" ::: "memory");
    __syncthreads();
    if (leader) {
        unsigned* bar = b.bar;
        __builtin_amdgcn_s_waitcnt(0);
        unsigned nloc = b.st[0], nx = b.st[1];
        if (nloc == 0u) { xcd_barrier_complete(bar, b.x, nloc, nx); b.st[0] = nloc; b.st[1] = nx; }
        const unsigned old = xb_add(&bar[XB_XSUB(b.x)], 1u);
        const unsigned gen = old / nloc;
        if (old + 1u == (gen + 1u) * nloc) {
            __builtin_amdgcn_fence(__ATOMIC_RELEASE, "agent");
            asm volatile("s_waitcnt vmcnt(0)" ::: "memory");
            const unsigned og = xb_add(&bar[XB_TOP], 1u);
            const unsigned tg = og / nx;
            if (og + 1u == (tg + 1u) * nx) xb_add(&bar[XB_TOPGEN], 1u);
            else XB_SPIN(xb_ld(&bar[XB_TOPGEN]) == tg, bar);
            __builtin_amdgcn_fence(__ATOMIC_ACQUIRE, "agent");
            xb_add(&bar[XB_XGEN(b.x)], 1u);
            asm volatile("s_waitcnt vmcnt(0)" ::: "memory");
        } else {
            XB_SPIN(xb_ld(&bar[XB_XGEN(b.x)]) == gen, bar);
            __builtin_amdgcn_fence(__ATOMIC_ACQUIRE, "agent");
            asm volatile("s_waitcnt vmcnt(0)" ::: "memory");
        }
    }
    __syncthreads();
}

constexpr int NPHASE = 12;
__global__ void __launch_bounds__(NTHREADS, 2) hymba_fwd(Params p) {
    extern __shared__ __attribute__((aligned(16))) unsigned char lds_raw[];
    __builtin_assume(__builtin_amdgcn_workitem_id_y() == 0); __builtin_assume(__builtin_amdgcn_workitem_id_z() == 0);
    cg::grid_group grid = cg::this_grid();
    Frame F;
    F.lds = (LAS unsigned char*)lds_raw; F.ws = p.ws; F.in = p.in; F.out = p.out;
    F.wave = __builtin_amdgcn_readfirstlane(threadIdx.x >> 6); F.lane = lane_id_fresh(); F.tid = F.wave * 64 + F.lane; F.bid = blockIdx.x; F.G = gridDim.x;
    F.gw = F.bid * NWAVES + F.wave; F.NGW = F.G * NWAVES;
    const int lo = p.ph_lo, hi = p.ph_hi;
#define IN(k) (lo <= (k) && (k) < hi)
#ifdef PROBE_A
    LAS unsigned long long* ts_ = (LAS unsigned long long*)(F.lds + LDS_MISC + 7168);
#define STAMP(k) do { if (F.bid == 0 && F.tid == 0) ts_[k] = __builtin_amdgcn_s_memrealtime(); } while (0)
#else
#define STAMP(k) do { } while (0)
#endif
    STAMP(0);
    volatile LAS unsigned* xst = (volatile LAS unsigned*)(F.lds + LDS_MISC + 4112);
    if (F.tid == 0) { xst[0] = 0u; xst[1] = 0u; }
    __syncthreads();
    XcdBarrier xbar; xbar.bar = (unsigned*)(F.ws + WS_CTL) + CW_BAR; xbar.x = 0; xbar.st = xst;
#define SEAM(k) do { if (IN(k) && IN((k) + 1)) { if ((k) == 0) { grid.sync(); xbar = xcd_barrier_post((unsigned*)(F.ws + WS_CTL) + CW_BAR, xst, F.tid == 0); } else xcd_barrier(xbar, F.tid == 0); } F.lane = lane_id_fresh(); F.tid = F.wave * 64 + F.lane; STAMP((k) + 1); } while (0)
    LAS unsigned char* ring = F.lds; LAS unsigned* tokl = (LAS unsigned*)(F.lds + LDS_MISC + 256);
#ifdef DOUBLE_PHASE
#define NREP(k) ((k) == DOUBLE_PHASE ? 2 : 1)
#define REPSYNC(k, rep) do { if ((k) == DOUBLE_PHASE && (rep) == 0) grid.sync(); } while (0)
#else
#define NREP(k) 1
#define REPSYNC(k, rep) do { } while (0)
#endif

    if (IN(0)) for (int rep = 0; rep < NREP(0); ++rep) { phase0(F); REPSYNC(0, rep); }
    SEAM(0);
    if (IN(1)) for (int rep = 0; rep < NREP(1); ++rep) { phase1(F); phase0_weights(F); REPSYNC(1, rep); }
    SEAM(1);
    if (IN(2)) for (int rep = 0; rep < NREP(2); ++rep) {
        pg8::StaticOrder S; S.init(TOK, NPROJ, DM, F.G, F.bid, F.ws + WS_H1, F.ws + WS_WIN);
        pg8::EpiInProj E{F.ws, F.in[7], F.in[8], F.in[12], F.in[13], (LAS float*)(F.lds + LDS_MISC + 8192)};
        pg8::gemm_phase<pg8::EpiInProj, pg8::StaticOrder, false>(ring, tokl, DM, S, E, F.wave, F.lane);
        REPSYNC(2, rep);
    }
    SEAM(2); STAMP(4);
    if (IN(4)) for (int rep = 0; rep < NREP(4); ++rep) {
        { pg8::CompressOrder S{F.G, F.bid, (const char*)(F.ws + WS_KC), (const char*)(F.ws + WS_PE), (const char*)(F.ws + WS_WC1)};
          pg8::EpiBf16 E{(bf16_t*)(F.ws + WS_UL), 512};
          pg8::gemm_phase<pg8::EpiBf16, pg8::CompressOrder, false>(ring, tokl, 1024, S, E, F.wave, F.lane); }
        const float mq = gmax(F.in[12], 32, F.lane), mk = gmax(F.in[13], 32, F.lane);
        const float bound = 5.656854249f * mq * mk * 1.02f; const float c2 = 0.17677669529663687f * 1.4426950408889634f; const float mc = bound * 1.4426950408889634f;
        float s1 = F.lane < 32 ? F.in[14][F.lane] * F.in[15][F.lane] : 0.f, s2 = F.lane < 32 ? F.in[16][F.lane] * F.in[17][F.lane] : 0.f;
        s1 = wave_sum(s1); s2 = wave_sum(s2);
        const float lam = __expf(s1) - __expf(s2) + 0.2f;
        unsigned* ctr = (unsigned*)(F.ws + WS_CTL) + CW_QDIFF + 32 * rep;
        for (int it = queue_next(F, ctr); it < 4096;) { unsigned nx = 0u; if (F.tid == 0) nx = atomicAdd(ctr, 1u);
            const int qb = 15 - (it >> 8), bh = it & 255; diff_unit(F, bh >> 3, bh & 7, qb, c2, mc, lam); it = queue_pass(F, nx); }
        REPSYNC(4, rep);
    }
    SEAM(4);
    if (IN(5)) for (int rep = 0; rep < NREP(5); ++rep) { phase5(F); REPSYNC(5, rep); }
    SEAM(5);
    if (IN(6)) for (int rep = 0; rep < NREP(6); ++rep) {
        const float mq = gmax(F.in[7], 64, F.lane); const float mk = fmaxf(gmax(F.in[8], 64, F.lane), fmaxf(gmax(F.in[8] + 64, 64, F.lane), gmax(F.in[8] + 128, 64, F.lane)));
        const float bound = 8.f * mq * mk * 1.02f; const float c2 = 0.125f * 1.4426950408889634f; const float mc = bound * 1.4426950408889634f;
        unsigned* ctr = (unsigned*)(F.ws + WS_CTL) + CW_QNSA + 32 * rep;
        for (int it = queue_next(F, ctr); it < 2048;) { unsigned nx = 0u; if (F.tid == 0) nx = atomicAdd(ctr, 1u);
            const int qb = 31 - (it >> 6), bg = it & 63; nsa_unit(F, bg >> 1, bg & 1, qb, c2, mc); it = queue_pass(F, nx); }
        REPSYNC(6, rep);
    }
    SEAM(6);
    if (IN(7)) for (int rep = 0; rep < NREP(7); ++rep) {
        pg8::StaticOrder S; S.init(TOK, DM, DM, F.G, F.bid, F.ws + WS_AO, F.ws + WS_WOUT);
        pg8::EpiOutProj E{F.in[0], (bf16_t*)(F.ws + WS_X1B), (const float*)(F.ws + WS_MOD), (float*)(F.ws + WS_ROWSS)};
        pg8::gemm_phase<pg8::EpiOutProj, pg8::StaticOrder, false>(ring, tokl, DM, S, E, F.wave, F.lane);
        REPSYNC(7, rep);
    }
    SEAM(7);
    if (IN(8)) phase8(F);
    SEAM(8);
    if (IN(9)) for (int rep = 0; rep < NREP(9); ++rep) {
        LAS int* tb = moe_prefix(F);
        pg8::MoeOrder S{F.G, F.bid, 0, tb, (const char*)(F.ws + WS_H2), (const char*)(F.ws + WS_WGU), (const int*)(F.ws + WS_LIST)};
        pg8::EpiSwiglu E{(bf16_t*)(F.ws + WS_HH)};
        pg8::gemm_phase<pg8::EpiSwiglu, pg8::MoeOrder, true>(ring, tokl, DM, S, E, F.wave, F.lane);
        REPSYNC(9, rep);
    }
    SEAM(9);
    if (IN(10)) for (int rep = 0; rep < NREP(10); ++rep) {
        LAS int* tb = moe_prefix(F);
        pg8::MoeOrder S{F.G, F.bid, 1, tb, (const char*)(F.ws + WS_HH), (const char*)(F.ws + WS_WD), nullptr};
        pg8::EpiBf16 E{(bf16_t*)(F.ws + WS_Y), DM};
        pg8::gemm_phase<pg8::EpiBf16, pg8::MoeOrder, false>(ring, tokl, EHID, S, E, F.wave, F.lane);
        REPSYNC(10, rep);
    }
    SEAM(10);
    if (IN(11)) phase11(F);
    grid.sync(); grid.sync(); grid.sync(); grid.sync(); grid.sync(); grid.sync(); grid.sync(); grid.sync();
#ifdef PROBE_A
    grid.sync(); STAMP(12);
    if (F.bid == 0 && F.tid == 0) {
        unsigned long long da = (ts_[PROBE_A + 1] - ts_[PROBE_A]) / 100ull, db = (ts_[PROBE_B + 1] - ts_[PROBE_B]) / 100ull;
        unsigned long long qa = (da + 5ull) / 10ull, qb2 = (db + 5ull) / 10ull; if (qa > 63ull) qa = 63ull; if (qb2 > 63ull) qb2 = 63ull;
        const unsigned long long target = ts_[0] + (6000ull + 16ull + 32ull * qa + 2048ull * qb2) * 100ull;
        while (__builtin_amdgcn_s_memrealtime() < target) __builtin_amdgcn_s_sleep(32);
    }
#endif
#undef IN
#undef SEAM
}

#ifndef MK_LAUNCHES
#define MK_LAUNCHES 1
#endif
extern "C" void kernel_launch(void* const* d_in, const int* in_sizes, int n_in, void* d_out, int out_size, void* d_ws, size_t ws_size, hipStream_t stream) {
    static int grid = 0;
    if (grid == 0) {
        if (n_in != 27 || ws_size < WS_END) { fprintf(stderr, "kernel_launch: unexpected inputs (n_in %d, ws %zu)\n", n_in, ws_size); grid = -1; return; }
        int dev = 0, cus = 0, per_cu = 0;
        hipGetDevice(&dev); hipDeviceGetAttribute(&cus, hipDeviceAttributeMultiprocessorCount, dev);
        hipFuncSetAttribute((const void*)hymba_fwd, hipFuncAttributeMaxDynamicSharedMemorySize, LDS_BYTES);
        hipOccupancyMaxActiveBlocksPerMultiprocessor(&per_cu, (const void*)hymba_fwd, NTHREADS, LDS_BYTES);
        if (per_cu < 1) { fprintf(stderr, "kernel_launch: occupancy query says %d blocks per CU\n", per_cu); per_cu = 1; }
        if (per_cu > 1) per_cu = 1;
        grid = cus * per_cu;
    }
    if (grid < 0) return;
    Params p{};
    for (int i = 0; i < 27; ++i) p.in[i] = (const float*)d_in[i];
    p.out = (float*)d_out; p.ws = (unsigned char*)d_ws;
    const int cuts[13] = {0, 1, 2, 3, 4, 5, 6, 7, 8, 9, 10, 11, 12};
    const int nl = MK_LAUNCHES == 1 ? 1 : NPHASE;
    for (int li = 0; li < nl; ++li) {
        p.ph_lo = nl == 1 ? 0 : cuts[li]; p.ph_hi = nl == 1 ? NPHASE : cuts[li + 1];
        void* args[] = {&p};
        hipError_t e = hipLaunchCooperativeKernel((const void*)hymba_fwd, dim3(grid), dim3(NTHREADS), args, LDS_BYTES, stream);
        if (e != hipSuccess) { fprintf(stderr, "cooperative launch failed: %s (grid %d)\n", hipGetErrorString(e), grid); break; }
    }
}
```

```cpp
#include <hip/hip_runtime.h>
#include <hip/hip_cooperative_groups.h>
#include <cstdint>
#include <cstdio>
namespace cg = cooperative_groups;

#define LAS __attribute__((address_space(3)))
#define DI __device__ __forceinline__
typedef unsigned short bf16_t;
typedef short bf16x8 __attribute__((ext_vector_type(8)));
typedef short s16x4 __attribute__((ext_vector_type(4)));
typedef float f32x2 __attribute__((ext_vector_type(2)));
typedef float f32x4 __attribute__((ext_vector_type(4)));
typedef float f32x16 __attribute__((ext_vector_type(16)));
typedef unsigned u32x2 __attribute__((ext_vector_type(2)));
typedef unsigned u32x4 __attribute__((ext_vector_type(4)));

constexpr int BATCH = 32, SEQ = 2048, DM = 1024, TOK = BATCH * SEQ;
constexpr int NPROJ = 3072;
constexpr int INCOLS = 2840;
constexpr int NEXP = 32, EHID = 512, ECAP = 65536;
constexpr float EPS = 1e-6f;
constexpr int NWAVES = 8, NTHREADS = 512;

constexpr size_t MiB = 1u << 20;
constexpr size_t WS_CTL = 0;
constexpr size_t WS_MOD = 1 * MiB;
constexpr size_t WS_ROPE = 2 * MiB;
constexpr size_t WS_WR = 3 * MiB;
constexpr size_t WS_WIN = 4 * MiB;
constexpr size_t WS_WOUT = 10 * MiB;
constexpr size_t WS_WC1 = 12 * MiB;
constexpr size_t WS_WGU = 16 * MiB;
constexpr size_t WS_WD = 80 * MiB;
constexpr size_t WS_LIST = 112 * MiB;
constexpr size_t WS_TIPOS = 120 * MiB;
constexpr size_t WS_TIE = WS_TIPOS + 512 * 1024;
constexpr size_t WS_TIW = WS_TIE + 256 * 1024;
constexpr size_t WS_ROWSS = 122 * MiB;
constexpr size_t WS_GATES = 126 * MiB;
constexpr size_t WS_KCMP = 132 * MiB;
constexpr size_t WS_VCMP = 133 * MiB;
constexpr size_t WS_UL = 134 * MiB;
constexpr size_t WS_A = 160 * MiB;
constexpr size_t WS_B = 288 * MiB;
constexpr size_t WS_C = 672 * MiB;
constexpr size_t WS_H1 = WS_A, WS_QN = WS_B + 128 * MiB, WS_QR = WS_B + 192 * MiB, WS_H2 = WS_A;
constexpr size_t WS_PROJ = WS_B, WS_AO = WS_B, WS_HH = WS_B, WS_Y = WS_B + 136 * MiB;
constexpr size_t WS_KC = WS_C, WS_VC = WS_C + 16 * MiB, WS_PE = WS_C + 32 * MiB, WS_KS = WS_C + 33 * MiB, WS_VS = WS_C + 49 * MiB,
                 WS_KW = WS_C + 65 * MiB, WS_VW = WS_C + 81 * MiB, WS_DQ = WS_C + 97 * MiB, WS_DK = WS_C + 161 * MiB, WS_DV = WS_C + 225 * MiB;
constexpr size_t WS_X1B = WS_C + 32 * MiB;
constexpr size_t WS_END = WS_C + 289 * MiB;
constexpr int CW_CNT = 0;
constexpr int CW_QDIFF = 64, CW_QNSA = 128;

constexpr int RING_BYTES = 131072;
constexpr int LDS_MISC = RING_BYTES;
constexpr int LDS_BYTES = 147456;

DI unsigned pk2(float lo, float hi) { typedef __bf16 b2 __attribute__((ext_vector_type(2))); f32x2 v = {lo, hi}; b2 b = __builtin_convertvector(v, b2); return __builtin_bit_cast(unsigned, b); }
DI unsigned short f2bf(float f) { return (unsigned short)(pk2(f, 0.f) & 0xffffu); }
DI float bf2f(unsigned short h) { return __uint_as_float((unsigned)h << 16); }
DI float bflo(unsigned w) { return __uint_as_float(w << 16); }
DI float bfhi(unsigned w) { return __uint_as_float(w & 0xffff0000u); }
DI float wave_sum(float v) {
#pragma unroll
    for (int o = 1; o < 64; o <<= 1) v += __shfl_xor(v, o);
    return v;
}
DI float fast_exp2(float x) { return __builtin_amdgcn_exp2f(x); }
DI float fast_rcp(float x) { return __builtin_amdgcn_rcpf(x); }
#define MFMA32(a, b, c) __builtin_amdgcn_mfma_f32_32x32x16_bf16((a), (b), (c), 0, 0, 0)
#define MFMA16(a, b, c) __builtin_amdgcn_mfma_f32_16x16x32_bf16((a), (b), (c), 0, 0, 0)
DI int crow(int r, int hi) { return (r & 3) + 8 * (r >> 2) + 4 * hi; }

DI int lane_id_fresh() { int l; asm volatile("v_mbcnt_lo_u32_b32 %0, -1, 0\n\tv_mbcnt_hi_u32_b32 %0, -1, %0" : "=v"(l)); return l; }
struct Params { const float* in[27]; float* out; unsigned char* ws; int ph_lo, ph_hi; };

namespace pg8 {
constexpr int BM = 256, BK = 64, HALF = 128, HTB = HALF * BK * 2, STAGE_BYTES = 8 * HTB, NXCD = 8, WGM = 8;
DI int lds_byte(int r, int c) { const int st = (r >> 4) * 2 + (c >> 5), rr = r & 15, cc = c & 31, ob = rr * 64 + cc * 2; return st * 1024 + (ob ^ (((ob >> 9) & 1) << 5)); }
DI void stage_rc(int b, int& R, int& C) { const int st = b / 1024, sb = b % 1024, swz = sb ^ (((sb >> 9) & 1) << 5); R = (st >> 1) * 16 + swz / 64; C = (st & 1) * 32 + (swz % 64) / 2; }
DI int perm32(int rho) { const int n = rho >> 4, i = rho & 15; return 8 * (i >> 2) + 4 * n + (i & 3); }

struct Unit { int pm, pn, aux; const char* Ab; const char* Bb; const int* tok; };

template <class Epi, class Sched, bool GATHER>
DI void gemm_phase(LAS unsigned char* lds, LAS unsigned* tokl, const int K, const Sched& S, const Epi& E, const int wid, const int lane) {
    const int tid = wid * 64 + lane, wr = wid >> 2, wc = wid & 3, fr = lane & 15, fq = lane >> 4;
    const int nt = K / BK;
    unsigned voffA[2], voffB[2]; int RA[2], CA[2];
#pragma unroll
    for (int i = 0; i < 2; ++i) { int R, C; stage_rc(tid * 16 + i * 8192, R, C); const int Rb = Epi::PERM ? ((R & ~31) + perm32(R & 31)) : R;
        voffA[i] = (unsigned)(R * K + C) * 2u; voffB[i] = (unsigned)(Rb * K + C) * 2u; RA[i] = R; CA[i] = C; }
    const size_t kstep = (size_t)(BK * 2);
    const size_t hstep = (size_t)HALF * K * 2;
    const unsigned ldsw = (unsigned)wid * 1024u;
    const int aoff = lds_byte(wr * 64 + fr, fq * 8), boff = lds_byte(wc * 32 + fr, fq * 8);
#define PG8_SA(b, h) (((b) * 2 + (h)) * HTB)
#define PG8_SB(b, h) ((4 + (b) * 2 + (h)) * HTB)
#define PG8_STG(bufoff, gbase, voff) do { _Pragma("unroll") for (int _i = 0; _i < 2; ++_i) \
        __builtin_amdgcn_global_load_lds((const unsigned*)((const char*)(gbase) + (voff)[_i]), (LAS unsigned*)(lds + (bufoff) + ldsw + _i * 8192), 16, 0, 0); } while (0)
#define PG8_STA(bufoff, gbase, h, vv) do { if constexpr (GATHER) { PG8_STG(bufoff, gbase, vv[h]); } else { PG8_STG(bufoff, (gbase) + (h) * hstep, voffA); } } while (0)
#define PG8_LDA(dst, b, h) do { _Pragma("unroll") for (int m = 0; m < 4; ++m) _Pragma("unroll") for (int k = 0; k < 2; ++k) dst[m][k] = *(const LAS bf16x8*)(lds + PG8_SA(b, h) + aoff + m * 2048 + k * 1024); } while (0)
#define PG8_LDB(dst, b, h) do { _Pragma("unroll") for (int n = 0; n < 2; ++n) _Pragma("unroll") for (int k = 0; k < 2; ++k) dst[n][k] = *(const LAS bf16x8*)(lds + PG8_SB(b, h) + boff + n * 2048 + k * 1024); } while (0)
#define PG8_MMA(ai, bj, At, Bt) do { __builtin_amdgcn_s_setprio(1); _Pragma("unroll") for (int m = 0; m < 4; ++m) _Pragma("unroll") for (int n = 0; n < 2; ++n) _Pragma("unroll") for (int k = 0; k < 2; ++k) \
        acc[ai][bj][m][n] = __builtin_amdgcn_mfma_f32_16x16x32_bf16(Bt[n][k], At[m][k], acc[ai][bj][m][n], 0, 0, 0); __builtin_amdgcn_s_setprio(0); } while (0)
#define PG8_WAIT_V(n) asm volatile("s_waitcnt vmcnt(" #n ")" ::: "memory")
#define PG8_WAIT_L(n) asm volatile("s_waitcnt lgkmcnt(" #n ")" ::: "memory")
#define PG8_BAR __builtin_amdgcn_s_barrier()
#define PG8_SCHED __builtin_amdgcn_sched_barrier(0)
    Unit cur, nxt; int ui = 0;
    if (!S.next(0, cur)) return;
    f32x4 acc[2][2][4][2];
#pragma unroll
    for (int a = 0; a < 2; ++a)
#pragma unroll
        for (int b = 0; b < 2; ++b)
#pragma unroll
            for (int m = 0; m < 4; ++m)
#pragma unroll
                for (int n = 0; n < 2; ++n) acc[a][b][m][n] = (f32x4){0.f, 0.f, 0.f, 0.f};
    bf16x8 At[4][2], B0[2][2], B1[2][2];
    const char* cA = cur.Ab; const char* cB = cur.Bb;
    unsigned cvo[2][2] = {{0u, 0u}, {0u, 0u}}, nvo[2][2] = {{0u, 0u}, {0u, 0u}};
    if constexpr (GATHER) {
        if (wid < 4) __builtin_amdgcn_global_load_lds((const unsigned*)(cur.tok + wid * 64 + lane), (LAS unsigned*)(tokl + wid * 64), 4, 0, 0);
        PG8_WAIT_V(0); PG8_BAR;
#pragma unroll
        for (int h = 0; h < 2; ++h)
#pragma unroll
            for (int i = 0; i < 2; ++i) cvo[h][i] = tokl[h * 128 + RA[i]] * (unsigned)(K * 2) + (unsigned)(CA[i] * 2);
        PG8_WAIT_L(0);
    }
    PG8_STG(PG8_SB(0, 0), cB, voffB); PG8_STG(PG8_SB(0, 1), cB + hstep, voffB); PG8_STA(PG8_SA(0, 0), cA, 0, cvo); PG8_STA(PG8_SA(0, 1), cA, 1, cvo);
    if (wr == 1) PG8_BAR;
    PG8_WAIT_V(2); PG8_BAR;
    PG8_STG(PG8_SB(1, 0), cB + kstep, voffB); PG8_STA(PG8_SA(1, 0), cA + kstep, 0, cvo); PG8_STG(PG8_SB(1, 1), cB + hstep + kstep, voffB);
    PG8_WAIT_V(6); PG8_BAR;
    for (;;) {
        const bool has_next = S.next(ui + 1, nxt);
        const char* nA = has_next ? nxt.Ab : cA; const char* nB = has_next ? nxt.Bb : cB;
        if constexpr (GATHER) {
            if (has_next && wid < 4) __builtin_amdgcn_global_load_lds((const unsigned*)(nxt.tok + wid * 64 + lane), (LAS unsigned*)(tokl + ((ui + 1) & 1) * 256 + wid * 64), 4, 0, 0);
        }
        for (int t = 0; t < nt; t += 2) {
            const bool last = (t == nt - 2);
            const char* a1 = cA + (size_t)(t + 1) * kstep;
            const char* a2 = last ? nA : cA + (size_t)(t + 2) * kstep; const char* b2 = last ? nB : cB + (size_t)(t + 2) * kstep;
            const char* a3 = a2 + kstep; const char* b3 = b2 + kstep;
            unsigned v2[2][2];
            if constexpr (GATHER) {
                if (last) {
                    if (has_next) {
#pragma unroll
                        for (int h = 0; h < 2; ++h)
#pragma unroll
                            for (int i = 0; i < 2; ++i) nvo[h][i] = tokl[((ui + 1) & 1) * 256 + h * 128 + RA[i]] * (unsigned)(K * 2) + (unsigned)(CA[i] * 2);
                    } else {
#pragma unroll
                        for (int h = 0; h < 2; ++h)
#pragma unroll
                            for (int i = 0; i < 2; ++i) nvo[h][i] = cvo[h][i];
                    }
                }
#pragma unroll
                for (int h = 0; h < 2; ++h)
#pragma unroll
                    for (int i = 0; i < 2; ++i) v2[h][i] = last ? nvo[h][i] : cvo[h][i];
            } else {
#pragma unroll
                for (int h = 0; h < 2; ++h)
#pragma unroll
                    for (int i = 0; i < 2; ++i) v2[h][i] = 0u;
            }
            PG8_LDB(B0, 0, 0); PG8_LDB(B1, 0, 1); PG8_SCHED; PG8_LDA(At, 0, 0); PG8_STA(PG8_SA(1, 1), a1, 1, cvo);
            PG8_WAIT_V(8); PG8_WAIT_L(0); PG8_BAR; PG8_MMA(0, 0, At, B0); PG8_MMA(0, 1, At, B1); PG8_BAR; PG8_SCHED;
            PG8_LDA(At, 0, 1); PG8_STG(PG8_SB(0, 0), b2, voffB); PG8_STG(PG8_SB(0, 1), b2 + hstep, voffB); PG8_STA(PG8_SA(0, 0), a2, 0, v2);
            PG8_WAIT_V(8); PG8_WAIT_L(0); PG8_BAR; PG8_MMA(1, 0, At, B0); PG8_MMA(1, 1, At, B1); PG8_BAR; PG8_SCHED;
            PG8_LDB(B0, 1, 0); PG8_LDB(B1, 1, 1); PG8_SCHED; PG8_LDA(At, 1, 0); PG8_STA(PG8_SA(0, 1), a2, 1, v2);
            PG8_WAIT_V(8); PG8_WAIT_L(0); PG8_BAR; PG8_MMA(0, 0, At, B0); PG8_MMA(0, 1, At, B1); PG8_BAR; PG8_SCHED;
            PG8_LDA(At, 1, 1); PG8_STG(PG8_SB(1, 0), b3, voffB); PG8_STG(PG8_SB(1, 1), b3 + hstep, voffB); PG8_STA(PG8_SA(1, 0), a3, 0, v2);
            PG8_WAIT_V(8); PG8_WAIT_L(0); PG8_BAR; PG8_MMA(1, 0, At, B0); PG8_MMA(1, 1, At, B1); PG8_BAR; PG8_SCHED;
        }
        if (wr == 0) PG8_BAR;
        E(acc, cur, wr, wc, fr, fq);
        if (!has_next) break;
#pragma unroll
        for (int a = 0; a < 2; ++a)
#pragma unroll
            for (int b = 0; b < 2; ++b)
#pragma unroll
                for (int m = 0; m < 4; ++m)
#pragma unroll
                    for (int n = 0; n < 2; ++n) acc[a][b][m][n] = (f32x4){0.f, 0.f, 0.f, 0.f};
        cur = nxt; cA = nA; cB = nB; ++ui;
        if constexpr (GATHER) {
#pragma unroll
            for (int h = 0; h < 2; ++h)
#pragma unroll
                for (int i = 0; i < 2; ++i) cvo[h][i] = nvo[h][i];
        }
        if (wr == 1) PG8_BAR;
    }
    PG8_WAIT_V(0);
    PG8_BAR;
#undef PG8_SA
#undef PG8_SB
#undef PG8_STG
#undef PG8_STA
#undef PG8_LDA
#undef PG8_LDB
#undef PG8_MMA
#undef PG8_WAIT_V
#undef PG8_WAIT_L
#undef PG8_BAR
#undef PG8_SCHED
}

struct StaticOrder {
    int nM, nN, nwg, G, c; const char* A; const char* Bt; size_t tstep;
    DI void init(int M, int N, int K, int G_, int c_, const void* A_, const void* Bt_) { nM = M / BM; nN = N / BM; nwg = nM * nN; G = G_; c = c_; A = (const char*)A_; Bt = (const char*)Bt_; tstep = (size_t)BM * K * 2; }
    DI bool next(int i, Unit& u) const {
        const long L = (long)i * G + c; if (L >= nwg) return false;
        int wgid = (int)L; { const int q = nwg / NXCD, r = nwg % NXCD, xcd = wgid % NXCD, off = wgid / NXCD; wgid = (xcd < r ? xcd * (q + 1) : r * (q + 1) + (xcd - r) * q) + off; }
        const int nig = WGM * nN, gid = wgid / nig, fm = gid * WGM, gsz = (nM - fm) < WGM ? (nM - fm) : WGM;
        u.pm = fm + ((wgid % nig) % gsz); u.pn = (wgid % nig) / gsz; u.aux = 0; u.Ab = A + (size_t)u.pm * tstep; u.Bb = Bt + (size_t)u.pn * tstep; u.tok = nullptr; return true;
    }
};
struct CompressOrder {
    int G, c; const char* KC; const char* PE; const char* W;
    DI bool next(int i, Unit& u) const {
        const int L = i * G + c; if (L >= 132) return false;
        u.pm = L >> 1; u.pn = L & 1; const int kv = u.pm < 32 ? 0 : (u.pm < 64 ? 1 : u.pm - 64); u.aux = kv;
        u.Ab = u.pm < 64 ? KC + (size_t)u.pm * (256 * 1024 * 2) : PE; u.Bb = W + (size_t)kv * (512 * 1024 * 2) + (size_t)u.pn * (256 * 1024 * 2); u.tok = nullptr; return true;
    }
};
struct MoeOrder {
    int G, c, mode; const LAS int* tb; const char* A; const char* W; const int* lists;
    DI bool next(int i, Unit& u) const {
        const int L = i * G + c; const int mt = L >> 2; if (mt >= tb[32]) return false;
        int e = 0;
#pragma unroll 1
        for (int j = 1; j < 32; ++j) e += (tb[j] <= mt) ? 1 : 0;
        u.pm = mt; u.pn = L & 3; u.aux = e;
        if (mode == 0) { u.Ab = A; u.Bb = W + (size_t)e * (1024 * 1024 * 2) + (size_t)u.pn * (256 * 1024 * 2); u.tok = lists + (size_t)e * ECAP + (size_t)(mt - tb[e]) * 256; }
        else { u.Ab = A + (size_t)mt * (256 * 512 * 2); u.Bb = W + (size_t)e * (1024 * 512 * 2) + (size_t)u.pn * (256 * 512 * 2); u.tok = nullptr; }
        return true;
    }
};

struct EpiBf16 {
    static constexpr bool PERM = true;
    bf16_t* O; int ldc;
    DI void operator()(const f32x4 (&acc)[2][2][4][2], const Unit& u, int wr, int wc, int fr, int fq) const {
        const int row0 = u.pm * BM + wr * 64 + fr; const int col0 = u.pn * BM + wc * 32 + 8 * fq;
#pragma unroll
        for (int ai = 0; ai < 2; ++ai)
#pragma unroll
            for (int m = 0; m < 4; ++m) { bf16_t* rowp = O + (size_t)(row0 + ai * HALF + m * 16) * ldc + col0;
#pragma unroll
                for (int bj = 0; bj < 2; ++bj) { const f32x4 v0 = acc[ai][bj][m][0], v1 = acc[ai][bj][m][1];
                    u32x4 w; w.x = pk2(v0[0], v0[1]); w.y = pk2(v0[2], v0[3]); w.z = pk2(v1[0], v1[1]); w.w = pk2(v1[2], v1[3]);
                    *(u32x4*)(rowp + bj * HALF) = w; } }
    }
};
struct EpiInProj {
    static constexpr bool PERM = true;
    unsigned char* ws; const float* g_nq; const float* g_nk; const float* g_dq; const float* g_dk; LAS float* xch;
    DI void operator()(const f32x4 (&acc)[2][2][4][2], const Unit& u, int wr, int wc, int fr, int fq) const {
        const int pn = u.pn, wid = wr * 4 + wc; const int tok0 = u.pm * BM; const int b = tok0 >> 11; int t0 = (tok0 & 2047) + wr * 64 + fr;
        int xo_i = wid * 256 + fr, xp_i = (wid ^ 1) * 256 + fr;
        asm volatile("" : "+v"(t0), "+v"(xo_i), "+v"(xp_i));
        LAS float* xo = xch + xo_i; LAS float* xp = xch + xp_i;
        const float* ropeN = (const float*)(ws + WS_ROPE); const float* ropeD = ropeN + 2048 * 16;
        const int d0 = 32 * (wc & 1) + 8 * fq;
        if (pn <= 4) {
            const bool nrm0 = (pn != 2), nrm1 = (pn < 2);
            if (pn != 2) {
#pragma unroll
                for (int ai = 0; ai < 2; ++ai)
#pragma unroll
                    for (int m = 0; m < 4; ++m)
#pragma unroll
                        for (int bj = 0; bj < 2; ++bj) { const f32x4 a = acc[ai][bj][m][0], c = acc[ai][bj][m][1];
                            float ss = (a[0] * a[0] + a[1] * a[1]) + (a[2] * a[2] + a[3] * a[3]) + (c[0] * c[0] + c[1] * c[1]) + (c[2] * c[2] + c[3] * c[3]);
                            ss += __shfl_xor(ss, 16); ss += __shfl_xor(ss, 32);
                            if (fq == 0) xo[((ai * 4 + m) * 2 + bj) * 16] = ss; }
                asm volatile("s_waitcnt lgkmcnt(0)" ::: "memory"); __builtin_amdgcn_s_barrier(); asm volatile("" ::: "memory");
            }
            const float* gg = pn < 2 ? g_nq : (g_nk + (pn == 3 ? 64 : 128));
            f32x4 g0 = {1.f, 1.f, 1.f, 1.f}, g1 = g0;
            if (pn != 2) { g0 = *(const f32x4*)(gg + d0); g1 = *(const f32x4*)(gg + d0 + 4); }
            const bool ropew = (wc & 1) == 0;
#pragma unroll
            for (int ai = 0; ai < 2; ++ai)
#pragma unroll
                for (int m = 0; m < 4; ++m) {
                    const int t = t0 + ai * HALF + m * 16;
                    f32x4 cs0 = {1.f, 0.f, 1.f, 0.f}, cs1 = cs0, cs2 = cs0, cs3 = cs0;
                    if (pn != 2 && ropew && fq < 2) { const f32x4* rp = (const f32x4*)(ropeN + t * 16); cs0 = rp[0]; cs1 = rp[1]; cs2 = rp[2]; cs3 = rp[3]; }
#pragma unroll
                    for (int bj = 0; bj < 2; ++bj) {
                        const bool donorm = bj == 0 ? nrm0 : nrm1;
                        f32x4 ya = acc[ai][bj][m][0], yb = acc[ai][bj][m][1];
                        u32x4 w0, w1;
                        if (donorm) {
                            const float rstd = rsqrtf((xo[((ai * 4 + m) * 2 + bj) * 16] + xp[((ai * 4 + m) * 2 + bj) * 16]) * (1.f / 64.f) + EPS);
                            ya = ya * rstd * g0; yb = yb * rstd * g1;
                            w0.x = pk2(ya[0], ya[1]); w0.y = pk2(ya[2], ya[3]); w0.z = pk2(yb[0], yb[1]); w0.w = pk2(yb[2], yb[3]);
                            f32x4 ra = ya, rb = yb;
                            if (ropew) {
                                f32x4 pa, pb;
#pragma unroll
                                for (int i = 0; i < 4; ++i) { pa[i] = __shfl_xor(ya[i], 16); pb[i] = __shfl_xor(yb[i], 16); }
                                if (fq == 0) { ra[0] = ya[0] * cs0[0] - pa[0] * cs0[1]; ra[1] = ya[1] * cs0[2] - pa[1] * cs0[3]; ra[2] = ya[2] * cs1[0] - pa[2] * cs1[1]; ra[3] = ya[3] * cs1[2] - pa[3] * cs1[3];
                                               rb[0] = yb[0] * cs2[0] - pb[0] * cs2[1]; rb[1] = yb[1] * cs2[2] - pb[1] * cs2[3]; rb[2] = yb[2] * cs3[0] - pb[2] * cs3[1]; rb[3] = yb[3] * cs3[2] - pb[3] * cs3[3]; }
                                else if (fq == 1) { ra[0] = pa[0] * cs0[1] + ya[0] * cs0[0]; ra[1] = pa[1] * cs0[3] + ya[1] * cs0[2]; ra[2] = pa[2] * cs1[1] + ya[2] * cs1[0]; ra[3] = pa[3] * cs1[3] + ya[3] * cs1[2];
                                                    rb[0] = pb[0] * cs2[1] + yb[0] * cs2[0]; rb[1] = pb[1] * cs2[3] + yb[1] * cs2[2]; rb[2] = pb[2] * cs3[1] + yb[2] * cs3[0]; rb[3] = pb[3] * cs3[3] + yb[3] * cs3[2]; }
                            }
                            w1.x = pk2(ra[0], ra[1]); w1.y = pk2(ra[2], ra[3]); w1.z = pk2(rb[0], rb[1]); w1.w = pk2(rb[2], rb[3]);
                        } else { w0.x = pk2(ya[0], ya[1]); w0.y = pk2(ya[2], ya[3]); w0.z = pk2(yb[0], yb[1]); w0.w = pk2(yb[2], yb[3]); w1 = w0; }
                        const int hq = 2 * bj + (wc >> 1);
                        if (pn < 2) { const size_t off = (((size_t)b * 8 + 4 * pn + hq) * SEQ + t) * 64 + d0;
                            *(u32x4*)((bf16_t*)(ws + WS_QN) + off) = w0; *(u32x4*)((bf16_t*)(ws + WS_QR) + off) = w1; }
                        else { const int six = 2 * (pn - 2) + bj; const size_t base = six == 0 ? WS_KC : six == 1 ? WS_VC : six == 2 ? WS_KS : six == 3 ? WS_VS : six == 4 ? WS_KW : WS_VW;
                            const size_t off = (((size_t)b * 2 + (wc >> 1)) * SEQ + t) * 64 + d0;
                            *(u32x4*)((bf16_t*)(ws + base) + off) = w1; }
                    }
                    asm volatile("" ::: "memory");
                }
        } else if (pn <= 8) {
            const bool isq = pn <= 6; const float* gg = isq ? g_dq : g_dk; bf16_t* dst = (bf16_t*)(ws + (isq ? WS_DQ : WS_DK));
            const f32x4 g0 = *(const f32x4*)(gg + 8 * fq), g1 = *(const f32x4*)(gg + 8 * fq + 4);
#pragma unroll
            for (int ai = 0; ai < 2; ++ai)
#pragma unroll
                for (int m = 0; m < 4; ++m) {
                    const int t = t0 + ai * HALF + m * 16;
                    f32x4 c0 = {1.f, 0.f, 1.f, 0.f}, c1 = c0;
                    if (fq == 0) { const f32x4* rp = (const f32x4*)(ropeD + t * 8); c0 = rp[0]; c1 = rp[1]; }
#pragma unroll
                    for (int bj = 0; bj < 2; ++bj) {
                        f32x4 ya = acc[ai][bj][m][0], yb = acc[ai][bj][m][1];
                        float ss = (ya[0] * ya[0] + ya[1] * ya[1]) + (ya[2] * ya[2] + ya[3] * ya[3]) + (yb[0] * yb[0] + yb[1] * yb[1]) + (yb[2] * yb[2] + yb[3] * yb[3]);
                        ss += __shfl_xor(ss, 16); ss += __shfl_xor(ss, 32);
                        const float rstd = rsqrtf(ss * (1.f / 32.f) + EPS);
                        ya = ya * rstd * g0; yb = yb * rstd * g1;
                        if (fq == 0) { const f32x4 a = ya, bb = yb;
                            ya[0] = a[0] * c0[0] - bb[0] * c0[1]; yb[0] = a[0] * c0[1] + bb[0] * c0[0]; ya[1] = a[1] * c0[2] - bb[1] * c0[3]; yb[1] = a[1] * c0[3] + bb[1] * c0[2];
                            ya[2] = a[2] * c1[0] - bb[2] * c1[1]; yb[2] = a[2] * c1[1] + bb[2] * c1[0]; ya[3] = a[3] * c1[2] - bb[3] * c1[3]; yb[3] = a[3] * c1[3] + bb[3] * c1[2]; }
                        u32x4 w; w.x = pk2(ya[0], ya[1]); w.y = pk2(ya[2], ya[3]); w.z = pk2(yb[0], yb[1]); w.w = pk2(yb[2], yb[3]);
                        const int hd = 4 * ((pn - 5) & 1) + 2 * bj + (wc >> 1);
                        *(u32x4*)(dst + (((size_t)b * 8 + hd) * SEQ + t) * 64 + d0) = w;
                    }
                    asm volatile("" ::: "memory");
                }
        } else if (pn <= 10) {
            bf16_t* dst = (bf16_t*)(ws + WS_DV);
#pragma unroll
            for (int ai = 0; ai < 2; ++ai)
#pragma unroll
                for (int m = 0; m < 4; ++m) { const int t = t0 + ai * HALF + m * 16;
#pragma unroll
                    for (int bj = 0; bj < 2; ++bj) { const f32x4 ya = acc[ai][bj][m][0], yb = acc[ai][bj][m][1];
                        u32x4 w; w.x = pk2(ya[0], ya[1]); w.y = pk2(ya[2], ya[3]); w.z = pk2(yb[0], yb[1]); w.w = pk2(yb[2], yb[3]);
                        const int hd = 4 * (pn - 9) + 2 * bj + (wc >> 1);
                        *(u32x4*)(dst + (((size_t)b * 8 + hd) * SEQ + t) * 64 + d0) = w; }
                    asm volatile("" ::: "memory"); }
        } else {
            if (wc == 0 && fq < 3) {
                float* gt = (float*)(ws + WS_GATES);
#pragma unroll
                for (int ai = 0; ai < 2; ++ai)
#pragma unroll
                    for (int m = 0; m < 4; ++m) { const size_t tok = (size_t)tok0 + wr * 64 + fr + ai * HALF + m * 16; const f32x4 ya = acc[ai][0][m][0], yb = acc[ai][0][m][1]; f32x4 sa, sb;
#pragma unroll
                        for (int i = 0; i < 4; ++i) { sa[i] = 1.f / (1.f + __expf(-ya[i])); sb[i] = 1.f / (1.f + __expf(-yb[i])); }
                        *(f32x4*)(gt + tok * 24 + 8 * fq) = sa; *(f32x4*)(gt + tok * 24 + 8 * fq + 4) = sb; }
            }
        }
    }
};
struct EpiSwiglu {
    static constexpr bool PERM = true;
    bf16_t* O;
    DI void operator()(const f32x4 (&acc)[2][2][4][2], const Unit& u, int wr, int wc, int fr, int fq) const {
        const int row0 = u.pm * BM + wr * 64 + fr; const int col0 = u.pn * 128 + wc * 16 + 4 * fq;
#pragma unroll
        for (int ai = 0; ai < 2; ++ai)
#pragma unroll
            for (int m = 0; m < 4; ++m) { bf16_t* rowp = O + (size_t)(row0 + ai * HALF + m * 16) * EHID + col0;
#pragma unroll
                for (int bj = 0; bj < 2; ++bj) { const f32x4 g = acc[ai][bj][m][0], up = acc[ai][bj][m][1]; float h[4];
#pragma unroll
                    for (int i = 0; i < 4; ++i) { const float s = fast_rcp(1.f + __expf(-g[i])); h[i] = g[i] * s * up[i]; }
                    u32x2 w; w.x = pk2(h[0], h[1]); w.y = pk2(h[2], h[3]);
                    *(u32x2*)(rowp + bj * 64) = w; } }
    }
};
struct EpiOutProj {
    static constexpr bool PERM = true;
    const float* x; bf16_t* x1b; const float* mod; float* rowss;
    DI void operator()(const f32x4 (&acc)[2][2][4][2], const Unit& u, int wr, int wc, int fr, int fq) const {
        const int col0 = u.pn * BM + wc * 32 + 8 * fq; const int b = (u.pm * BM) / SEQ;
        const float* g1 = mod + (size_t)b * 6144 + 2048 + col0;
        f32x4 gv[2][2];
#pragma unroll
        for (int bj = 0; bj < 2; ++bj)
#pragma unroll
            for (int n = 0; n < 2; ++n) gv[bj][n] = *(const f32x4*)(g1 + bj * HALF + n * 4);
#pragma unroll
        for (int ai = 0; ai < 2; ++ai)
#pragma unroll
            for (int m = 0; m < 4; ++m) { const int r = u.pm * BM + ai * HALF + wr * 64 + m * 16 + fr; const size_t off = (size_t)r * DM + col0; float ss = 0.f;
#pragma unroll
                for (int bj = 0; bj < 2; ++bj) { const f32x4 xa = *(const f32x4*)(x + off + bj * HALF), xb = *(const f32x4*)(x + off + bj * HALF + 4);
                    const f32x4 oa = xa + gv[bj][0] * acc[ai][bj][m][0], ob = xb + gv[bj][1] * acc[ai][bj][m][1];
                    ss += (oa[0] * oa[0] + oa[1] * oa[1]) + (oa[2] * oa[2] + oa[3] * oa[3]) + (ob[0] * ob[0] + ob[1] * ob[1]) + (ob[2] * ob[2] + ob[3] * ob[3]);
                    u32x4 w; w.x = pk2(oa[0], oa[1]); w.y = pk2(oa[2], oa[3]); w.z = pk2(ob[0], ob[1]); w.w = pk2(ob[2], ob[3]);
                    *(u32x4*)(x1b + off + bj * HALF) = w; }
                ss += __shfl_xor(ss, 16); ss += __shfl_xor(ss, 32);
                if (fq == 0) rowss[(size_t)r * 16 + u.pn * 4 + wc] = ss; }
    }
};
}

struct Frame {
    LAS unsigned char* lds; unsigned char* ws; const float* const* in; float* out;
    int tid, lane, wave, bid, G, gw, NGW;
};

DI int origcol(int n) { return n < 1280 ? n : (n < 2816 ? n + 24 : (n < 2840 ? n - 2816 + 1280 : -1)); }

template <class DRow>
DI void tr_item(const float* src, int src_ld, int sc  , bf16_t* dst, int dst_ld, int k0, LAS float* scr, int lane, DRow drow) {
#pragma unroll 8
    for (int i = 0; i < 32; ++i) { const int kk = 2 * i + (lane >> 5); scr[kk * 33 + (lane & 31)] = sc >= 0 ? src[(size_t)(k0 + kk) * src_ld + sc] : 0.f; }
    asm volatile("s_waitcnt lgkmcnt(0)" ::: "memory");
    const int c = lane & 7;
#pragma unroll
    for (int j = 0; j < 4; ++j) { const int n = (lane >> 3) + 8 * j; const LAS float* s = scr + (8 * c) * 33 + n;
        u32x4 o; o.x = pk2(s[0 * 33], s[1 * 33]); o.y = pk2(s[2 * 33], s[3 * 33]); o.z = pk2(s[4 * 33], s[5 * 33]); o.w = pk2(s[6 * 33], s[7 * 33]);
        *(u32x4*)(dst + (size_t)drow(n) * dst_ld + k0 + 8 * c) = o; }
    asm volatile("s_waitcnt lgkmcnt(0)" ::: "memory");
}

DI void phase0(Frame& F) {
    const float* c_in = F.in[1]; const float* w_ada = F.in[2]; const float* b_ada = F.in[3];
    float* mod = (float*)(F.ws + WS_MOD);
    for (int it = F.bid; it < 96; it += F.G) {
        LAS float* cs = (LAS float*)F.lds;
        for (int idx = F.tid; idx < 32 * 1024; idx += NTHREADS) { const int b = idx >> 10, k = idx & 1023; cs[k * 32 + b] = c_in[idx]; }
        __syncthreads();
        float acc[32];
#pragma unroll
        for (int b = 0; b < 32; ++b) acc[b] = 0.f;
        const int j = it * 64 + F.lane;
#pragma unroll 1
        for (int kg = 0; kg < 4; ++kg) {
            float wv[32];
#pragma unroll
            for (int q = 0; q < 32; ++q) wv[q] = w_ada[(size_t)(F.wave * 128 + kg * 32 + q) * 6144 + j];
#pragma unroll
            for (int q = 0; q < 32; ++q) { const int k = F.wave * 128 + kg * 32 + q; const float w = wv[q];
#pragma unroll
                for (int b4 = 0; b4 < 8; ++b4) { const f32x4 cv = *(const LAS f32x4*)(cs + k * 32 + b4 * 4); acc[b4 * 4 + 0] += cv[0] * w; acc[b4 * 4 + 1] += cv[1] * w; acc[b4 * 4 + 2] += cv[2] * w; acc[b4 * 4 + 3] += cv[3] * w; } }
        }
        __syncthreads();
        LAS float* red = (LAS float*)F.lds;
#pragma unroll
        for (int b = 0; b < 32; ++b) red[(F.wave * 32 + b) * 64 + F.lane] = acc[b];
        __syncthreads();
        for (int o = F.tid; o < 2048; o += NTHREADS) { const int b = o >> 6, l = o & 63; float s = b_ada[it * 64 + l];
#pragma unroll
            for (int w = 0; w < 8; ++w) s += red[(w * 32 + b) * 64 + l];
            mod[(size_t)b * 6144 + it * 64 + l] = s; }
        __syncthreads();
    }
    const int gt = F.bid * NTHREADS + F.tid, NGT = F.G * NTHREADS;
    { float* ropeN = (float*)(F.ws + WS_ROPE); float* ropeD = ropeN + 2048 * 16;
      for (int i = gt; i < 2048 * 12; i += NGT) { const int t = i / 12, j = i % 12; const bool isn = j < 8; const int ii = isn ? j : j - 8;
          const float ex = isn ? (float)(2 * ii) / 16.f : (float)(2 * ii) / 8.f;
          const float inv = exp2f(-ex * 18.931568569324174f);
          const float ang = (float)t * inv;
          const double rev = (double)ang * 0.15915494309189535; const double fr = rev - __builtin_rint(rev); const float rr = (float)(fr * 6.283185307179586);
          const float cs = __cosf(rr), sn = __sinf(rr);
          if (isn) { ropeN[(t * 8 + ii) * 2] = cs; ropeN[(t * 8 + ii) * 2 + 1] = sn; } else { ropeD[(t * 4 + ii) * 2] = cs; ropeD[(t * 4 + ii) * 2 + 1] = sn; } } }
    { bf16_t* whi = (bf16_t*)(F.ws + WS_WR); bf16_t* wlo = whi + 48 * 1024;
      for (int i = gt; i < 48 * 1024; i += NGT) { const int c = i >> 10, k = i & 1023; float w = 0.f;
          if (c < 4) w = F.in[20][k * 4 + c]; else if (c < 36) w = F.in[22][k * 32 + (c - 4)];
          const unsigned short h = f2bf(w); whi[i] = h; wlo[i] = f2bf(w - bf2f(h)); } }
    { bf16_t* pe = (bf16_t*)(F.ws + WS_PE);
      for (int i = gt; i < 256 * 1024; i += NGT) { const int r = i >> 10, k = i & 1023; float v = 0.f; if (r < 4) v = F.in[9][(r >> 1) * 2048 + (r & 1) * 1024 + k]; pe[i] = f2bf(v); } }
    { u32x4* l4 = (u32x4*)(F.ws + WS_LIST); for (int i = gt; i < (int)(NEXP * ECAP / 4); i += NGT) l4[i] = (u32x4){0u, 0u, 0u, 0u};
      unsigned* ctl = (unsigned*)(F.ws + WS_CTL); for (int i = gt; i < 8192; i += NGT) ctl[i] = 0u; }
}

struct TrD { const float* src; int ld; int sc; bf16_t* dst; int dld; int k0; int mode; int n0; int aux; };
DI TrD tr_desc(Frame& F, int it, int lane) {
    constexpr int I_IN = 16 * 96, I_OUT = 16 * 32, I_G = 32 * 16 * 16, I_D = 32 * 8 * 32;
    TrD d; int r = it; const int nq = lane & 7;
    if (r < I_IN) { const int kb = r / 96, nb = r % 96; d.n0 = nb * 32; const int n = d.n0 + 4 * nq; d.src = F.in[6]; d.ld = INCOLS; d.sc = origcol(n); d.dst = (bf16_t*)(F.ws + WS_WIN); d.dld = 1024; d.k0 = kb * 64; d.mode = 0; d.aux = 0; return d; }
    r -= I_IN;
    if (r < I_OUT) { const int kb = r / 32, nb = r % 32; d.n0 = nb * 32; d.src = F.in[19]; d.ld = 1024; d.sc = d.n0 + 4 * nq; d.dst = (bf16_t*)(F.ws + WS_WOUT); d.dld = 1024; d.k0 = kb * 64; d.mode = 0; d.aux = 0; return d; }
    r -= I_OUT;
    if (r < 2 * I_G) { const int up = r / I_G; r -= up * I_G; const int e = r / 256, q = r % 256, kb = q / 16, nb = q % 16; d.n0 = nb * 32;
        d.src = F.in[24 + up] + (size_t)e * 1024 * 512; d.ld = 512; d.sc = d.n0 + 4 * nq; d.dst = (bf16_t*)(F.ws + WS_WGU) + (size_t)e * 1024 * 1024; d.dld = 1024; d.k0 = kb * 64; d.mode = 1; d.aux = up; return d; }
    r -= 2 * I_G;
    if (r < I_D) { const int e = r / 256, q = r % 256, kb = q / 32, nb = q % 32; d.n0 = nb * 32;
        d.src = F.in[26] + (size_t)e * 512 * 1024; d.ld = 1024; d.sc = d.n0 + 4 * nq; d.dst = (bf16_t*)(F.ws + WS_WD) + (size_t)e * 1024 * 512; d.dld = 512; d.k0 = kb * 64; d.mode = 0; d.aux = 0; return d; }
    r -= I_D;
    { const int kvh = r / 128, q = r % 128, kb = q / 8, nb = q % 8; d.n0 = nb * 32; const int kv = kvh >> 1, half = kvh & 1;
      d.src = F.in[10] + (size_t)kv * 2048 * 256 + (size_t)half * 1024 * 256; d.ld = 256; d.sc = d.n0 + 4 * nq; d.dst = (bf16_t*)(F.ws + WS_WC1) + (size_t)kv * 512 * 1024; d.dld = 1024; d.k0 = kb * 64; d.mode = 2; d.aux = half; return d; }
}
DI void tr_load(const TrD& d, f32x4 (&v)[8], int lane) {
    const int kk = lane >> 3;
#pragma unroll
    for (int i = 0; i < 8; ++i) v[i] = d.sc >= 0 ? *(const f32x4*)(d.src + (size_t)(d.k0 + kk + 8 * i) * d.ld + d.sc) : (f32x4){0.f, 0.f, 0.f, 0.f};
}
DI void tr_finish(const TrD& d, const f32x4 (&v)[8], LAS float* scr, int lane) {
    const int kk = lane >> 3, nq = lane & 7;
#pragma unroll
    for (int i = 0; i < 8; ++i) *(LAS f32x4*)(scr + (kk + 8 * i) * 36 + 4 * nq) = v[i];
    asm volatile("s_waitcnt lgkmcnt(0)" ::: "memory");
    const int c = lane & 7;
#pragma unroll
    for (int j = 0; j < 4; ++j) { const int n = (lane >> 3) + 8 * j; const LAS float* s = scr + (8 * c) * 36 + n;
        u32x4 o; o.x = pk2(s[0 * 36], s[1 * 36]); o.y = pk2(s[2 * 36], s[3 * 36]); o.z = pk2(s[4 * 36], s[5 * 36]); o.w = pk2(s[6 * 36], s[7 * 36]);
        const int jn = d.n0 + n; const int row = d.mode == 0 ? jn : (d.mode == 1 ? 8 * (jn >> 2) + (jn & 3) + 4 * d.aux : d.aux * 256 + jn);
        *(u32x4*)(d.dst + (size_t)row * d.dld + d.k0 + 8 * c) = o; }
    asm volatile("s_waitcnt lgkmcnt(0)" ::: "memory");
}
DI void phase0_weights(Frame& F) {
    LAS float* scr = (LAS float*)(F.lds + F.wave * 16384);
    const int lane = F.lane;
    constexpr int NITEMS = 16 * 96 + 16 * 32 + 2 * (32 * 16 * 16) + 32 * 8 * 32 + 4 * 16 * 8;
    int it = F.gw; if (it >= NITEMS) return;
    TrD cur = tr_desc(F, it, lane); f32x4 vc[8]; tr_load(cur, vc, lane);
    for (;;) {
        const int nit = it + F.NGW; const bool more = nit < NITEMS;
        TrD nxt = cur; f32x4 vn[8];
        if (more) { nxt = tr_desc(F, nit, lane); tr_load(nxt, vn, lane); }
        tr_finish(cur, vc, scr, lane);
        if (!more) break;
        cur = nxt; it = nit;
#pragma unroll
        for (int i = 0; i < 8; ++i) vc[i] = vn[i];
    }
}

DI void phase1(Frame& F) {
    const float* x = F.in[0]; const float* g = F.in[4]; const float* mod = (const float*)(F.ws + WS_MOD); bf16_t* h1 = (bf16_t*)(F.ws + WS_H1);
    const int lane = F.lane;
    for (int m0 = F.gw * 32; m0 < TOK; m0 += F.NGW * 32) {
        const int b = m0 >> 11; const float* sh = mod + (size_t)b * 6144; const float* sc = sh + 1024;
        f32x4 A[4], Bv[4];
#pragma unroll
        for (int j = 0; j < 4; ++j) { const int col = 4 * lane + 256 * j; A[j] = *(const f32x4*)(g + col) * (*(const f32x4*)(sc + col) + 1.f); Bv[j] = *(const f32x4*)(sh + col); }
        const f32x4* xr = (const f32x4*)(x + (size_t)m0 * DM) + lane; u32x2* o8 = (u32x2*)(h1 + (size_t)m0 * DM) + lane;
        f32x4 v0[4], v1[4];
#pragma unroll
        for (int j = 0; j < 4; ++j) { v0[j] = xr[64 * j]; v1[j] = xr[256 + 64 * j]; }
        for (int i = 0; i < 32; i += 2) {
            f32x4 n0[4], n1[4];
            if (i + 2 < 32) {
#pragma unroll
                for (int j = 0; j < 4; ++j) { n0[j] = xr[(size_t)(i + 2) * 256 + 64 * j]; n1[j] = xr[(size_t)(i + 3) * 256 + 64 * j]; }
            }
            float s0 = 0.f, s1 = 0.f;
#pragma unroll
            for (int j = 0; j < 4; ++j) { s0 += (v0[j][0] * v0[j][0] + v0[j][1] * v0[j][1]) + (v0[j][2] * v0[j][2] + v0[j][3] * v0[j][3]); s1 += (v1[j][0] * v1[j][0] + v1[j][1] * v1[j][1]) + (v1[j][2] * v1[j][2] + v1[j][3] * v1[j][3]); }
#pragma unroll
            for (int o = 1; o < 64; o <<= 1) { s0 += __shfl_xor(s0, o); s1 += __shfl_xor(s1, o); }
            const float r0 = rsqrtf(s0 * (1.f / DM) + EPS), r1 = rsqrtf(s1 * (1.f / DM) + EPS);
#pragma unroll
            for (int j = 0; j < 4; ++j) { const f32x4 y0 = v0[j] * r0 * A[j] + Bv[j], y1 = v1[j] * r1 * A[j] + Bv[j];
                u32x2 w0, w1; w0.x = pk2(y0[0], y0[1]); w0.y = pk2(y0[2], y0[3]); w1.x = pk2(y1[0], y1[1]); w1.y = pk2(y1[2], y1[3]);
                o8[(size_t)i * 256 + 64 * j] = w0; o8[(size_t)(i + 1) * 256 + 64 * j] = w1; }
#pragma unroll
            for (int j = 0; j < 4; ++j) { v0[j] = n0[j]; v1[j] = n1[j]; }
        }
    }
}

DI void phase3(Frame& F) {
    const bf16_t* proj = (const bf16_t*)(F.ws + WS_PROJ);
    const float* ropeN = (const float*)(F.ws + WS_ROPE); const float* ropeD = ropeN + 2048 * 16;
    const float* g_nq = F.in[7]; const float* g_nk = F.in[8]; const float* g_dq = F.in[12]; const float* g_dk = F.in[13];
    const int lane = F.lane;
    for (int it = F.gw; it < TOK * 6; it += F.NGW) {
        const int m = it / 6, part = it % 6; const int b = m >> 11, t = m & 2047;
        const int c0 = part * 512 + lane * 8;
        const u32x4 raw = *(const u32x4*)(proj + (size_t)m * NPROJ + c0);
        float v[8]; v[0] = bflo(raw.x); v[1] = bfhi(raw.x); v[2] = bflo(raw.y); v[3] = bfhi(raw.y); v[4] = bflo(raw.z); v[5] = bfhi(raw.z); v[6] = bflo(raw.w); v[7] = bfhi(raw.w);
        float ss = 0.f;
#pragma unroll
        for (int i = 0; i < 8; ++i) ss += v[i] * v[i];
        ss += __shfl_xor(ss, 1); ss += __shfl_xor(ss, 2); const float ss32 = ss; ss += __shfl_xor(ss, 4); const float ss64 = ss;
        float pv[8];
#pragma unroll
        for (int i = 0; i < 8; ++i) pv[i] = __shfl_xor(v[i], 1);
        if (c0 < 1280) {
            const bool isq = c0 < 512; int six = 0, gsel = 0, d0;
            if (isq) { d0 = c0 & 63; } else { const int cc = c0 - 512; six = cc >> 7; gsel = (cc >> 6) & 1; d0 = cc & 63; }
            const bool donorm = isq || six == 2 || six == 4;
            float y[8];
            if (donorm) { const float* gg = isq ? g_nq : (g_nk + (six == 2 ? 64 : 128)); const float rstd = rsqrtf(ss64 * (1.f / 64.f) + EPS);
#pragma unroll
                for (int i = 0; i < 8; ++i) { y[i] = v[i] * rstd * gg[d0 + i]; pv[i] = pv[i] * rstd * gg[(d0 ^ 8) + i]; } }
            else {
#pragma unroll
                for (int i = 0; i < 8; ++i) y[i] = v[i]; }
            float yr[8];
#pragma unroll
            for (int i = 0; i < 8; ++i) yr[i] = y[i];
            if (donorm && d0 < 16) {
#pragma unroll
                for (int i = 0; i < 8; ++i) { const float cs = ropeN[(t * 8 + i) * 2], sn = ropeN[(t * 8 + i) * 2 + 1];
                    yr[i] = d0 == 0 ? (y[i] * cs - pv[i] * sn) : (pv[i] * sn + y[i] * cs); }
            }
            u32x4 w0, w1; w0.x = pk2(y[0], y[1]); w0.y = pk2(y[2], y[3]); w0.z = pk2(y[4], y[5]); w0.w = pk2(y[6], y[7]);
            w1.x = pk2(yr[0], yr[1]); w1.y = pk2(yr[2], yr[3]); w1.z = pk2(yr[4], yr[5]); w1.w = pk2(yr[6], yr[7]);
            if (isq) { const int hd = c0 >> 6; const size_t off = (((size_t)b * 8 + hd) * SEQ + t) * 64 + d0;
                *(u32x4*)((bf16_t*)(F.ws + WS_QN) + off) = w0; *(u32x4*)((bf16_t*)(F.ws + WS_QR) + off) = w1; }
            else { const size_t base = six == 0 ? WS_KC : six == 1 ? WS_VC : six == 2 ? WS_KS : six == 3 ? WS_VS : six == 4 ? WS_KW : WS_VW;
                const size_t off = (((size_t)b * 2 + gsel) * SEQ + t) * 64 + d0;
                *(u32x4*)((bf16_t*)(F.ws + base) + off) = donorm ? w1 : w0; }
        } else if (c0 < 2304) {
            const bool isq = c0 < 1792; const int cc = c0 - (isq ? 1280 : 1792); const int hd = cc >> 6, dd = cc & 63, d0 = dd & 31;
            const float* gg = isq ? g_dq : g_dk; const float rstd = rsqrtf(ss32 * (1.f / 32.f) + EPS);
            float y[8];
#pragma unroll
            for (int i = 0; i < 8; ++i) y[i] = v[i] * rstd * gg[d0 + i];
            if (d0 == 0) {
#pragma unroll
                for (int i = 0; i < 4; ++i) { const float cs = ropeD[(t * 4 + i) * 2], sn = ropeD[(t * 4 + i) * 2 + 1]; const float a = y[i], bb = y[i + 4]; y[i] = a * cs - bb * sn; y[i + 4] = a * sn + bb * cs; }
            }
            u32x4 w; w.x = pk2(y[0], y[1]); w.y = pk2(y[2], y[3]); w.z = pk2(y[4], y[5]); w.w = pk2(y[6], y[7]);
            const size_t off = (((size_t)b * 8 + hd) * SEQ + t) * 64 + dd;
            *(u32x4*)((bf16_t*)(F.ws + (isq ? WS_DQ : WS_DK)) + off) = w;
        } else if (c0 < 2816) {
            const int cc = c0 - 2304; const int hd = cc >> 6, dd = cc & 63; const size_t off = (((size_t)b * 8 + hd) * SEQ + t) * 64 + dd;
            *(u32x4*)((bf16_t*)(F.ws + WS_DV) + off) = raw;
        } else if (c0 < 2840) {
            float* gt = (float*)(F.ws + WS_GATES) + (size_t)m * 24 + (c0 - 2816);
#pragma unroll
            for (int i = 0; i < 8; ++i) gt[i] = 1.f / (1.f + __expf(-v[i]));
        }
    }
}

DI void glds16(const void* gsrc, unsigned lds_dst) { unsigned keep;
    asm volatile("s_mov_b32 %0, m0\n\ts_mov_b32 m0, %2\n\ts_nop 0\n\tglobal_load_lds_dwordx4 %1, off\n\ts_mov_b32 m0, %0" : "=&s"(keep) : "v"(gsrc), "s"(lds_dst) : "memory"); }
DI unsigned lds_addr(const LAS void* p) { return (unsigned)(uintptr_t)p; }
struct ALane { int k0; int v0; DI int ko(int ks) const { return k0 ^ (ks << 5); } DI int vo(int db) const { return v0 ^ (db << 6); } };
DI ALane alane_init(int lane) {
    ALane L; const int r = lane & 31, hh = lane >> 5, g = lane >> 4, i = lane & 15;
    L.k0 = r * 128 + ((hh ^ ((r >> 1) & 7)) << 4);
    const int rl = 4 * hh + (i >> 2); const int ch = 2 * (g & 1) + ((i & 3) >> 1);
    L.v0 = rl * 128 + ((ch ^ (((rl >> 1) & 1) << 2)) << 4) + 8 * (i & 1);
    return L;
}
DI s16x4 vtr(const LAS char* p) { typedef short v4i16 __attribute__((ext_vector_type(4))); return __builtin_bit_cast(s16x4, __builtin_amdgcn_ds_read_tr16_b64_v4i16((LAS v4i16*)p)); }
DI bf16x8 vfrag(const LAS char* Vt, const ALane& L, int db, int kb, int s) {
    const LAS char* p = Vt + L.vo(db) + (32 * kb + 16 * s) * 128;
    const s16x4 lo = vtr(p), hi = vtr(p + 8 * 128);
    return __builtin_shufflevector(lo, hi, 0, 1, 2, 3, 4, 5, 6, 7);
}
DI bf16x8 pfrag(const f32x16& p, int s) { u32x4 w; w.x = pk2(p[8 * s + 0], p[8 * s + 1]); w.y = pk2(p[8 * s + 2], p[8 * s + 3]); w.z = pk2(p[8 * s + 4], p[8 * s + 5]); w.w = pk2(p[8 * s + 6], p[8 * s + 7]); return __builtin_bit_cast(bf16x8, w); }
DI u32x4 tile_ld(const bf16_t* g, int tid) { return *(const u32x4*)(g + tid * 8); }
DI void tile_st_k(LAS char* Kt, u32x4 v, int tid) { const int row = tid >> 3, ch = tid & 7; *(LAS u32x4*)(Kt + row * 128 + ((ch ^ ((row >> 1) & 7)) << 4)) = v; }
DI void tile_st_v(LAS char* Vt, u32x4 v, int tid) { const int row = tid >> 3, ch = tid & 7; *(LAS u32x4*)(Vt + row * 128 + ((ch ^ (((row >> 1) & 1) << 2)) << 4)) = v; }

constexpr int MK_NONE = 0, MK_LE = 1, MK_GT = 2;
template <int MASK>
DI void sm16(f32x16& a, float c2, float mcl, int kb, int hh, int th) {
    if constexpr (MASK != MK_NONE) asm volatile("" : "+v"(th));
#pragma unroll
    for (int i = 0; i < 16; ++i) {
        float x = __builtin_fmaf(a[i], c2, -mcl);
        if constexpr (MASK != MK_NONE) { const int kl = 32 * kb + crow(i, hh); const bool ok = MASK == MK_LE ? (kl <= th) : (kl > th); x = ok ? x : -1.0e30f; }
        a[i] = fast_exp2(x);
    }
}
DI float sum16(const f32x16& a) { return ((a[0] + a[1]) + (a[2] + a[3])) + ((a[4] + a[5]) + (a[6] + a[7])) + ((a[8] + a[9]) + (a[10] + a[11])) + ((a[12] + a[13]) + (a[14] + a[15])); }
#define SCHED_FENCE() do { } while (0)
template <int MASK, bool KEEPP>
DI void attn_tile64(const LAS char* Kt, const LAS char* Vt, const ALane& L, const bf16x8 (&qf)[4], f32x16 (&O)[2], float& lsum, float c2, float mcl, int th, int hh, f32x16 (&P)[2]) {
    bf16x8 kf[2][4];
#pragma unroll
    for (int kb = 0; kb < 2; ++kb)
#pragma unroll
        for (int ks = 0; ks < 4; ++ks) kf[kb][ks] = *(const LAS bf16x8*)(Kt + L.ko(ks) + kb * 4096);
    SCHED_FENCE();
    f32x16 a0 = {0.f, 0.f, 0.f, 0.f, 0.f, 0.f, 0.f, 0.f, 0.f, 0.f, 0.f, 0.f, 0.f, 0.f, 0.f, 0.f}, a1 = a0;
#pragma unroll
    for (int ks = 0; ks < 4; ++ks) a0 = MFMA32(kf[0][ks], qf[ks], a0);
#pragma unroll
    for (int ks = 0; ks < 4; ++ks) a1 = MFMA32(kf[1][ks], qf[ks], a1);
    bf16x8 v0[2][2], v1[2][2];
#pragma unroll
    for (int s = 0; s < 2; ++s)
#pragma unroll
        for (int db = 0; db < 2; ++db) v0[s][db] = vfrag(Vt, L, db, 0, s);
    SCHED_FENCE();
    bf16x8 pf[2][2];
    sm16<MASK>(a0, c2, mcl, 0, hh, th); lsum += sum16(a0); pf[0][0] = pfrag(a0, 0); pf[0][1] = pfrag(a0, 1);
    if constexpr (KEEPP) P[0] = a0;
#pragma unroll
    for (int s = 0; s < 2; ++s)
#pragma unroll
        for (int db = 0; db < 2; ++db) v1[s][db] = vfrag(Vt, L, db, 1, s);
    SCHED_FENCE();
    sm16<MASK>(a1, c2, mcl, 1, hh, th); lsum += sum16(a1); pf[1][0] = pfrag(a1, 0); pf[1][1] = pfrag(a1, 1);
    if constexpr (KEEPP) P[1] = a1;
    SCHED_FENCE();
#pragma unroll
    for (int s = 0; s < 2; ++s)
#pragma unroll
        for (int db = 0; db < 2; ++db) O[db] = MFMA32(v0[s][db], pf[0][s], O[db]);
#pragma unroll
    for (int s = 0; s < 2; ++s)
#pragma unroll
        for (int db = 0; db < 2; ++db) O[db] = MFMA32(v1[s][db], pf[1][s], O[db]);
    SCHED_FENCE();
}
template <int MASK>
DI void attn_tile_dm(const LAS char* Kt, const LAS char* Vt, const ALane& L, int ko0, int ko1, const bf16x8 (&qf)[2], f32x16 (&O)[2], float& lsum, float c2, float mc, int th, int hh) {
    const bf16x8 k00 = *(const LAS bf16x8*)(Kt + ko0), k01 = *(const LAS bf16x8*)(Kt + ko1), k10 = *(const LAS bf16x8*)(Kt + ko0 + 4096), k11 = *(const LAS bf16x8*)(Kt + ko1 + 4096);
    SCHED_FENCE();
    f32x16 a0 = {0.f, 0.f, 0.f, 0.f, 0.f, 0.f, 0.f, 0.f, 0.f, 0.f, 0.f, 0.f, 0.f, 0.f, 0.f, 0.f}, a1 = a0;
    a0 = MFMA32(k00, qf[0], a0); a0 = MFMA32(k01, qf[1], a0); a1 = MFMA32(k10, qf[0], a1); a1 = MFMA32(k11, qf[1], a1);
    bf16x8 vf[2][2][2];
#pragma unroll
    for (int kb = 0; kb < 2; ++kb)
#pragma unroll
        for (int s = 0; s < 2; ++s)
#pragma unroll
            for (int db = 0; db < 2; ++db) vf[kb][s][db] = vfrag(Vt, L, db, kb, s);
    SCHED_FENCE();
    bf16x8 pf[2][2];
    sm16<MASK>(a0, c2, mc, 0, hh, th); lsum += sum16(a0); pf[0][0] = pfrag(a0, 0); pf[0][1] = pfrag(a0, 1);
    sm16<MASK>(a1, c2, mc, 1, hh, th); lsum += sum16(a1); pf[1][0] = pfrag(a1, 0); pf[1][1] = pfrag(a1, 1);
    SCHED_FENCE();
#pragma unroll
    for (int kb = 0; kb < 2; ++kb)
#pragma unroll
        for (int s = 0; s < 2; ++s)
#pragma unroll
            for (int db = 0; db < 2; ++db) O[db] = MFMA32(vf[kb][s][db], pf[kb][s], O[db]);
    SCHED_FENCE();
}
#define RING_WAIT(n) asm volatile("s_waitcnt vmcnt(" #n ")" ::: "memory")
template <class PreF, class CompF>
DI void attn_ring(LAS char* lds, const bf16_t* Kg, const bf16_t* Vg, unsigned tiles, int wid, int lane, PreF pre, CompF comp) {
    if (tiles == 0u) return;
    const int p = wid * 64 + lane, row = p >> 3, c = p & 7;
    const unsigned ksrc = (unsigned)(row * 128 + ((c ^ ((row >> 1) & 7)) << 4)), vsrc = (unsigned)(row * 128 + ((c ^ (((row >> 1) & 1) << 2)) << 4));
    LAS char* wb = lds + wid * 1024;
#define RING_ISSUE(j, slot) do { \
        glds16((const char*)(Kg) + (size_t)(j) * 8192 + ksrc, (unsigned)__builtin_amdgcn_readfirstlane((int)(lds_addr(wb) + (unsigned)(slot) * 16384u))); \
        glds16((const char*)(Vg) + (size_t)(j) * 8192 + vsrc, (unsigned)__builtin_amdgcn_readfirstlane((int)(lds_addr(wb) + (unsigned)(slot) * 16384u + 8192u))); } while (0)
    int q0 = __builtin_ctz(tiles); tiles &= tiles - 1u;
    int q1 = -1, q2 = -1;
    if (tiles) { q1 = __builtin_ctz(tiles); tiles &= tiles - 1u; }
    if (tiles) { q2 = __builtin_ctz(tiles); tiles &= tiles - 1u; }
    RING_ISSUE(q0, 0);
    if (q1 >= 0) RING_ISSUE(q1, 1);
    if (q2 >= 0) RING_ISSUE(q2, 2);
    pre();
    int i = 0;
    for (;;) {
        if (q2 >= 0) RING_WAIT(4); else if (q1 >= 0) RING_WAIT(2); else RING_WAIT(0);
        __builtin_amdgcn_s_barrier();
        int q3 = -1;
        if (tiles) { q3 = __builtin_ctz(tiles); tiles &= tiles - 1u; RING_ISSUE(q3, (i + 3) & 3); }
        LAS char* st = lds + (i & 3) * 16384;
        comp(q0, st, st + 8192);
        if (q1 < 0) break;
        q0 = q1; q1 = q2; q2 = q3; ++i;
    }
    asm volatile("s_waitcnt lgkmcnt(0)" ::: "memory");
    __builtin_amdgcn_s_barrier();
#undef RING_ISSUE
}

DI void diff_unit(Frame& F, int b, int hd, int qb, float c2, float mc, float lam) {
    const int tid = F.tid, lane = F.lane, wid = F.wave, r = lane & 31, hh = lane >> 5;
    const int rb = wid >> 1, mp = wid & 1;
    const bf16_t* Q = (const bf16_t*)(F.ws + WS_DQ) + ((size_t)b * 8 + hd) * SEQ * 64;
    const bf16_t* Kg = (const bf16_t*)(F.ws + WS_DK) + ((size_t)b * 8 + hd) * SEQ * 64;
    const bf16_t* Vg = (const bf16_t*)(F.ws + WS_DV) + ((size_t)b * 8 + hd) * SEQ * 64;
    LAS char* lds = (LAS char*)F.lds;
    const ALane L = alane_init(lane);
    const int ko0 = L.ko(2 * mp), ko1 = L.ko(2 * mp + 1);
    const int q0w = qb * 128 + rb * 32; const int qq = q0w + r;
    bf16x8 qf[2];
#pragma unroll
    for (int ks = 0; ks < 2; ++ks) qf[ks] = *(const bf16x8*)(Q + (size_t)qq * 64 + mp * 32 + ks * 16 + hh * 8);
    f32x16 O[2]; float lsum = 0.f;
#pragma unroll
    for (int i = 0; i < 16; ++i) { O[0][i] = 0.f; O[1][i] = 0.f; }
    const int ntile = 2 * qb + 2; const int jmax = 2 * qb + (rb >> 1);
    const unsigned tiles = ntile == 32 ? 0xffffffffu : ((1u << ntile) - 1u);
    attn_ring(lds, Kg, Vg, tiles, wid, lane, [&]() __attribute__((always_inline)) { asm volatile("" : "+v"(qf[0]), "+v"(qf[1])); },
        [&](int j, const LAS char* Kt, const LAS char* Vt) __attribute__((always_inline)) {
        if (j < jmax) attn_tile_dm<MK_NONE>(Kt, Vt, L, ko0, ko1, qf, O, lsum, c2, mc, 0, hh);
        else if (j == jmax) attn_tile_dm<MK_LE>(Kt, Vt, L, ko0, ko1, qf, O, lsum, c2, mc, qq - 64 * j, hh);
    });
    lsum += __shfl_xor(lsum, 32);
    LAS float* xo = (LAS float*)(lds + 65536 + rb * 8192) + lane;
    if (mp == 1) { const float s1 = lam / lsum;
#pragma unroll
        for (int db = 0; db < 2; ++db)
#pragma unroll
            for (int i = 0; i < 16; ++i) xo[(db * 16 + i) * 64] = O[db][i] * s1; }
    __syncthreads();
    if (mp == 0) {
        const float i0 = 1.f / lsum; float ss = 0.f;
#pragma unroll
        for (int db = 0; db < 2; ++db)
#pragma unroll
            for (int i = 0; i < 16; ++i) { const float o = O[db][i] * i0 - xo[(db * 16 + i) * 64]; O[db][i] = o; ss += o * o; }
        ss += __shfl_xor(ss, 32);
        const float rstd = rsqrtf(ss * (1.f / 64.f) + EPS) * 0.8f;
        const float* go = F.in[18];
        bf16_t* orow = (bf16_t*)(F.ws + WS_AO) + ((size_t)b * SEQ + qq) * DM + 512 + hd * 64;
#pragma unroll
        for (int db = 0; db < 2; ++db)
#pragma unroll
            for (int g4 = 0; g4 < 4; ++g4) { const int d = 32 * db + 8 * g4 + 4 * hh; const f32x4 gv = *(const f32x4*)(go + d);
                u32x2 w; w.x = pk2(O[db][4 * g4] * rstd * gv[0], O[db][4 * g4 + 1] * rstd * gv[1]); w.y = pk2(O[db][4 * g4 + 2] * rstd * gv[2], O[db][4 * g4 + 3] * rstd * gv[3]);
                *(u32x2*)(orow + d) = w; }
    }
}

#define NSA_BAR() do { asm volatile("s_waitcnt lgkmcnt(0)" ::: "memory"); __builtin_amdgcn_s_barrier(); asm volatile("" ::: "memory"); } while (0)
DI void nsa_unit(Frame& F, int b, int g, int qb, float c2, float mc) {
    const int lane = F.lane, wid = F.wave, r = lane & 31, hh = lane >> 5;
    const int hd = 4 * g + (wid >> 1); const int tl = 32 * (wid & 1) + r; const int t = 64 * qb + tl;
    LAS char* lds = (LAS char*)F.lds;
    LAS float* impP = (LAS float*)(lds + 65536);
    LAS unsigned* selm = (LAS unsigned*)(lds + LDS_MISC + 5120);
    LAS float* invs = (LAS float*)(selm + 128);
    LAS float* otp = (LAS float*)(lds + 65536 + wid * 8192) + lane;
    LAS float* gpark = (LAS float*)(lds + LDS_MISC + 8192 + wid * 768) + lane;
    const ALane L = alane_init(lane);
    const size_t bg = (size_t)b * 2 + g;
    bf16x8 qf[4];
    { const bf16_t* QN = (const bf16_t*)(F.ws + WS_QN) + (((size_t)b * 8 + hd) * SEQ + t) * 64;
#pragma unroll
      for (int ks = 0; ks < 4; ++ks) qf[ks] = *(const bf16x8*)(QN + ks * 16 + hh * 8);
      const float* gates = (const float*)(F.ws + WS_GATES) + ((size_t)b * SEQ + t) * 24 + hd * 3;
      const float g0_ = gates[0], g1_ = gates[1], g2_ = gates[2]; gpark[0] = g0_; gpark[64] = g1_; gpark[128] = g2_; }
    const char* KcB = (const char*)(F.ws + WS_KCMP) + bg * 16384; const char* VcB = (const char*)(F.ws + WS_VCMP) + bg * 16384;
    const char* KsB = (const char*)(F.ws + WS_KS) + bg * (SEQ * 128); const char* VsB = (const char*)(F.ws + WS_VS) + bg * (SEQ * 128);
    const char* KwB = (const char*)(F.ws + WS_KW) + bg * (SEQ * 128); const char* VwB = (const char*)(F.ws + WS_VW) + bg * (SEQ * 128);
    const int nf = qb == 0 ? 1 : (qb == 1 ? 2 : 3); const int f1 = qb == 1 ? 1 : qb - 1, f2 = qb;
    const unsigned fmask = 1u | (qb >= 1 ? (1u << qb) : 0u) | (qb >= 2 ? (1u << (qb - 1)) : 0u);
    const unsigned allb = qb == 31 ? 0xffffffffu : ((1u << (qb + 1)) - 1u);
    unsigned grest = qb <= 5 ? (allb & ~fmask) : 0u;
    const int jlo = qb >= 4 ? qb - 4 : 0;
    int gph = 0, gi = 0;
    const int p_ = wid * 64 + lane, prow = p_ >> 3, pc = p_ & 7;
    const unsigned ksrc = (unsigned)(prow * 128 + ((pc ^ ((prow >> 1) & 7)) << 4)), vsrc = (unsigned)(prow * 128 + ((pc ^ (((prow >> 1) & 1) << 2)) << 4));
    const unsigned wbase = lds_addr(lds) + (unsigned)wid * 1024u;
#define NSA_GEN(ty, jj) do { ty = -1; jj = 0; \
        if (gph == 0) { ty = 0; jj = gi; if (++gi == 2) { gph = 1; gi = 0; } } \
        else if (gph == 1) { ty = 1; jj = gi == 0 ? 0 : (gi == 1 ? f1 : f2); if (++gi == nf) gph = 2; } \
        else { if (gph == 2) { if (grest) { ty = 1; jj = __builtin_ctz(grest); grest &= grest - 1u; } else { gph = 3; gi = jlo; } } \
               if (gph == 3) { if (gi <= qb) { ty = 2; jj = gi++; } else gph = 4; } } } while (0)
#define NSA_ISSUE(ty, jj, slot) do { const char* kp_ = ty == 0 ? KcB : (ty == 1 ? KsB : KwB); const char* vp_ = ty == 0 ? VcB : (ty == 1 ? VsB : VwB); \
        glds16(kp_ + (size_t)(jj) * 8192 + ksrc, (unsigned)__builtin_amdgcn_readfirstlane((int)(wbase + (unsigned)(slot) * 16384u))); \
        glds16(vp_ + (size_t)(jj) * 8192 + vsrc, (unsigned)__builtin_amdgcn_readfirstlane((int)(wbase + (unsigned)(slot) * 16384u + 8192u))); } while (0)
    int t0, j0, t1, j1, t2, j2;
    NSA_GEN(t0, j0); NSA_GEN(t1, j1); NSA_GEN(t2, j2);
    NSA_ISSUE(t0, j0, 0); NSA_ISSUE(t1, j1, 1); if (t2 >= 0) NSA_ISSUE(t2, j2, 2);
#pragma unroll
    for (int ks = 0; ks < 4; ++ks) asm volatile("" : "+v"(qf[ks]));
    f32x16 O[2]; float lv = 0.f; float carry_in = 0.f; unsigned mym = 0u; bool inB = false;
#pragma unroll
    for (int i = 0; i < 16; ++i) { O[0][i] = 0.f; O[1][i] = 0.f; }
    const int nvalid = t >= 31 ? ((t - 31) >> 4) + 1 : 0;
    for (int n = 0;; ++n) {
        if (t2 >= 0) RING_WAIT(4); else if (t1 >= 0) RING_WAIT(2); else RING_WAIT(0);
        __builtin_amdgcn_s_barrier();
        int t3, j3;
        NSA_GEN(t3, j3);
        if (t3 >= 0) NSA_ISSUE(t3, j3, (n + 3) & 3);
        const LAS char* Kt = lds + (n & 3) * 16384; const LAS char* Vt = Kt + 8192;
        int mode = MK_LE, th = tl; float mcl = mc;
        if (t0 == 0) { th = nvalid - 1 - 64 * j0; }
        else if (t0 == 1) { mcl = ((mym >> j0) & 1u) ? mc : 1.0e30f; mode = j0 < qb ? MK_NONE : MK_LE; }
        else {
            if (inB) {
                float lsum = lv; lsum += __shfl_xor(lsum, 32); const float s1 = gpark[64] / lsum;
#pragma unroll
                for (int db = 0; db < 2; ++db)
#pragma unroll
                    for (int i = 0; i < 16; ++i) { otp[(db * 16 + i) * 64] += O[db][i] * s1; O[db][i] = 0.f; }
                lv = 0.f; inB = false;
            }
            mode = j0 == qb ? MK_LE : (j0 == qb - 4 ? MK_GT : MK_NONE);
        }
        if (t0 != 0) {
            f32x16 Pd[2];
            if (mode == MK_NONE) attn_tile64<MK_NONE, false>(Kt, Vt, L, qf, O, lv, c2, mcl, 0, hh, Pd);
            else if (mode == MK_LE) attn_tile64<MK_LE, false>(Kt, Vt, L, qf, O, lv, c2, mcl, th, hh, Pd);
            else attn_tile64<MK_GT, false>(Kt, Vt, L, qf, O, lv, c2, mcl, th, hh, Pd);
        } else {
            f32x16 P[2];
            attn_tile64<MK_LE, true>(Kt, Vt, L, qf, O, lv, c2, mcl, th, hh, P);
            LAS float* ip = impP + ((wid >> 1) * 64 + tl) * 33;
            float av[8], rc[8];
#pragma unroll
            for (int kb = 0; kb < 2; ++kb)
#pragma unroll
                for (int gq = 0; gq < 4; ++gq) { const int f = 4 * kb + gq; const float p3 = 0.5f * P[kb][4 * gq + 3]; av[f] = P[kb][4 * gq] + P[kb][4 * gq + 1] + P[kb][4 * gq + 2] + p3; rc[f] = __shfl_xor(p3, 32); }
#pragma unroll
            for (int f = 0; f < 8; ++f) { const float carry = hh == 1 ? rc[f] : (f > 0 ? rc[f > 0 ? f - 1 : 0] : carry_in); ip[2 * (8 * j0 + f) + hh] = av[f] + carry; }
            carry_in = rc[7];
            if (j0 == 1) {
                {
                    const bf16_t* QR = (const bf16_t*)(F.ws + WS_QR) + (((size_t)b * 8 + hd) * SEQ + t) * 64;
#pragma unroll
                    for (int ks = 0; ks < 4; ++ks) qf[ks] = *(const bf16x8*)(QR + ks * 16 + hh * 8); }
                float lsum = lv; lsum += __shfl_xor(lsum, 32);
                const float inv = lsum > 0.f ? 1.f / lsum : 0.f;
                if (hh == 0) invs[(wid >> 1) * 64 + tl] = inv;
                const float s0 = gpark[0] * inv;
                lv = 0.f;
                NSA_BAR();
                if (wid == 0) {
                    unsigned m;
                    if (qb <= 5) m = allb;
                    else {
                        m = fmask;
                        float best[3] = {-1.f, -1.f, -1.f}; int bi[3] = {0, 0, 0}; const float iv0 = invs[lane], iv1 = invs[64 + lane], iv2 = invs[128 + lane], iv3 = invs[192 + lane];
                        for (int j = 1; j <= qb - 2; ++j) {
                            const float v = (impP[(0 * 64 + lane) * 33 + j] * iv0 + impP[(1 * 64 + lane) * 33 + j] * iv1) + (impP[(2 * 64 + lane) * 33 + j] * iv2 + impP[(3 * 64 + lane) * 33 + j] * iv3);
                            if (v > best[0]) { best[2] = best[1]; bi[2] = bi[1]; best[1] = best[0]; bi[1] = bi[0]; best[0] = v; bi[0] = j; }
                            else if (v > best[1]) { best[2] = best[1]; bi[2] = bi[1]; best[1] = v; bi[1] = j; }
                            else if (v > best[2]) { best[2] = v; bi[2] = j; }
                        }
                        m |= (1u << bi[0]) | (1u << bi[1]) | (1u << bi[2]);
                    }
                    selm[lane] = m;
                    unsigned u = m;
#pragma unroll
                    for (int o = 1; o < 64; o <<= 1) u |= (unsigned)__shfl_xor((int)u, o);
                    if (lane == 0) selm[64] = u;
                }
                NSA_BAR();
                mym = selm[tl];
                if (qb > 5) grest = (unsigned)__builtin_amdgcn_readfirstlane((int)selm[64]) & ~fmask;
#pragma unroll
                for (int db = 0; db < 2; ++db)
#pragma unroll
                    for (int i = 0; i < 16; ++i) { otp[(db * 16 + i) * 64] = O[db][i] * s0; O[db][i] = 0.f; }
                inB = true;
#pragma unroll
                for (int ks = 0; ks < 4; ++ks) asm volatile("" : "+v"(qf[ks]));
            }
        }
        if (t1 < 0) break;
        t0 = t1; j0 = j1; t1 = t2; j1 = j2; t2 = t3; j2 = j3;
    }
    {
        float lsum = lv; lsum += __shfl_xor(lsum, 32); const float s2 = gpark[128] / lsum;
#pragma unroll
        for (int db = 0; db < 2; ++db)
#pragma unroll
            for (int i = 0; i < 16; ++i) O[db][i] = otp[(db * 16 + i) * 64] + O[db][i] * s2;
    }
    bf16_t* orow = (bf16_t*)(F.ws + WS_AO) + ((size_t)b * SEQ + t) * DM + hd * 64;
#pragma unroll
    for (int db = 0; db < 2; ++db)
#pragma unroll
        for (int g4 = 0; g4 < 4; ++g4) { const int d = 32 * db + 8 * g4 + 4 * hh;
            u32x2 w; w.x = pk2(O[db][4 * g4], O[db][4 * g4 + 1]); w.y = pk2(O[db][4 * g4 + 2], O[db][4 * g4 + 3]);
            *(u32x2*)(orow + d) = w; }
    NSA_BAR();
#undef NSA_GEN
#undef NSA_ISSUE
}

DI float gmax(const float* g, int n, int lane) { float v = lane < n ? fabsf(g[lane]) : 0.f;
#pragma unroll
    for (int o = 1; o < 64; o <<= 1) v = fmaxf(v, __shfl_xor(v, o));
    return v; }

DI int queue_next(Frame& F, unsigned* ctr) {
    LAS int* slot = (LAS int*)(F.lds + LDS_MISC + 4096);
    __syncthreads();
    if (F.tid == 0) *slot = (int)atomicAdd(ctr, 1u);
    __syncthreads();
    return *slot;
}

DI int queue_pass(Frame& F, unsigned nx) {
    LAS int* slot = (LAS int*)(F.lds + LDS_MISC + 4096);
    __syncthreads();
    if (F.tid == 0) *slot = (int)nx;
    __syncthreads();
    return *slot;
}

DI float gelu_tanh(float x) { const float u = 0.7978845608028654f * (x + 0.044715f * x * x * x); const float e = __expf(2.f * u); const float th = 1.f - 2.f / (e + 1.f); return 0.5f * x * (1.f + th); }
DI void phase5(Frame& F) {
    const bf16_t* UL = (const bf16_t*)(F.ws + WS_UL); const float* w2 = F.in[11]; const float* gk0 = F.in[8];
    LAS float* w2s = (LAS float*)F.lds;
    LAS float* hid = (LAS float*)(F.lds + LDS_MISC + 8192 + F.wave * 1024);
    for (int i = F.tid; i < 2 * 256 * 64 / 4; i += NTHREADS) ((LAS f32x4*)w2s)[i] = ((const f32x4*)w2)[i];
    __syncthreads();
    const int lane = F.lane;
    for (int it = F.gw; it < 2 * 64 * 128; it += F.NGW) {
        const int kv = it >> 13, rem = it & 8191, bgi = rem >> 7, c = rem & 127;
        bf16_t* dst = (bf16_t*)(F.ws + (kv ? WS_VCMP : WS_KCMP)) + ((size_t)bgi * 128 + c) * 64;
        if (c == 127) { dst[lane] = 0; continue; }
        const size_t row = (size_t)kv * 8192 + (size_t)bgi * 128 + c;
        const size_t perow = 16384 + (size_t)kv * 256 + (size_t)kv * 2;
        const u32x2 u4 = *(const u32x2*)(UL + row * 512 + 4 * lane), l4 = *(const u32x2*)(UL + (row + 1) * 512 + 256 + 4 * lane);
        const u32x2 pu = *(const u32x2*)(UL + perow * 512 + 4 * lane), pl = *(const u32x2*)(UL + (perow + 1) * 512 + 256 + 4 * lane);
        float h[4];
        h[0] = bflo(u4.x) + bflo(l4.x) + bflo(pu.x) + bflo(pl.x); h[1] = bfhi(u4.x) + bfhi(l4.x) + bfhi(pu.x) + bfhi(pl.x);
        h[2] = bflo(u4.y) + bflo(l4.y) + bflo(pu.y) + bflo(pl.y); h[3] = bfhi(u4.y) + bfhi(l4.y) + bfhi(pu.y) + bfhi(pl.y);
        f32x4 hv;
#pragma unroll
        for (int i = 0; i < 4; ++i) hv[i] = gelu_tanh(h[i]);
        *(LAS f32x4*)(hid + 4 * lane) = hv;
        asm volatile("s_waitcnt lgkmcnt(0)" ::: "memory");
        const LAS float* w = w2s + kv * 256 * 64 + lane; float acc0 = 0.f, acc1 = 0.f;
#pragma unroll 8
        for (int k = 0; k < 256; k += 4) { const f32x4 hh4 = *(const LAS f32x4*)(hid + k);
            acc0 += hh4[0] * w[(k + 0) * 64]; acc1 += hh4[1] * w[(k + 1) * 64]; acc0 += hh4[2] * w[(k + 2) * 64]; acc1 += hh4[3] * w[(k + 3) * 64]; }
        float acc = acc0 + acc1;
        if (kv == 0) { const float ss = wave_sum(acc * acc); acc = acc * rsqrtf(ss * (1.f / 64.f) + EPS) * gk0[lane]; }
        dst[lane] = f2bf(acc);
        asm volatile("s_waitcnt lgkmcnt(0)" ::: "memory");
    }
    __syncthreads();
}

DI void phase8(Frame& F) {
    const bf16_t* x1 = (const bf16_t*)(F.ws + WS_X1B); const float* gf = F.in[5]; const float* mod = (const float*)(F.ws + WS_MOD); const float* rowss = (const float*)(F.ws + WS_ROWSS);
    const char* wsrc = (const char*)(F.ws + WS_WR);
    bf16_t* h2 = (bf16_t*)(F.ws + WS_H2);
    unsigned* cnt = (unsigned*)(F.ws + WS_CTL) + CW_CNT; int* lists = (int*)(F.ws + WS_LIST);
    int* tipos = (int*)(F.ws + WS_TIPOS); int* tie = (int*)(F.ws + WS_TIE); float* tiw = (float*)(F.ws + WS_TIW);
    const float* brg = F.in[21]; const float* bre = F.in[23];
    const int lane = F.lane, wid = F.wave, row = lane & 15, kq = lane >> 4;
    LAS char* wl = (LAS char*)F.lds;
    LAS float* lg = (LAS float*)(F.lds + 98304 + wid * 3072);
    LAS float* A2 = (LAS float*)(F.lds + 122880);
    LAS float* B2 = A2 + 1024;
    LAS unsigned* hist = (LAS unsigned*)(F.lds + LDS_MISC + 8192);
    unsigned wso[6];
#pragma unroll
    for (int i = 0; i < 6; ++i) { const int s = i * 512 + F.tid, part = s / 1536, r = (s >> 5) % 48, cs = s & 31; wso[i] = (unsigned)(part * 98304 + r * 2048 + ((cs ^ (r & 15)) << 4)); }
#define P8_ISSUE(kc, buf) do { _Pragma("unroll") for (int i_ = 0; i_ < 6; ++i_) \
        __builtin_amdgcn_global_load_lds((const unsigned*)(wsrc + (size_t)(kc) * 512 + wso[i_]), (LAS unsigned*)(wl + (buf) * 49152 + i_ * 8192 + wid * 1024), 16, 0, 0); } while (0)
    const int nbatch = TOK / 128;
    for (int bt = F.bid; bt < nbatch; bt += F.G) {
        const int m0 = bt * 128 + wid * 16; const int m = m0 + row; const int b = m0 >> 11;
        P8_ISSUE(0, 0);
        { const float* sh = mod + (size_t)b * 6144 + 3072; const float* sc = sh + 1024;
          for (int k = F.tid; k < 1024; k += NTHREADS) { A2[k] = gf[k] * (sc[k] + 1.f); B2[k] = sh[k]; } }
        if (F.tid < 64) hist[F.tid] = 0u;
        float rs = 0.f; { const f32x4* rp = (const f32x4*)(rowss + (size_t)m * 16);
#pragma unroll
            for (int q = 0; q < 4; ++q) { const f32x4 v = rp[q]; rs += (v[0] + v[1]) + (v[2] + v[3]); } }
        const float rstd = rsqrtf(rs * (1.f / DM) + EPS);
        const bf16_t* xrow = x1 + (size_t)m * DM + 8 * kq; bf16_t* hrow = h2 + (size_t)m * DM + 8 * kq;
        u32x4 xw[4];
#pragma unroll
        for (int u = 0; u < 4; ++u) xw[u] = *(const u32x4*)(xrow + 32 * u);
        f32x4 acc[3] = {{0.f, 0.f, 0.f, 0.f}, {0.f, 0.f, 0.f, 0.f}, {0.f, 0.f, 0.f, 0.f}};
        for (int kc = 0; kc < 4; ++kc) {
            asm volatile("s_waitcnt vmcnt(0)" ::: "memory");
            __syncthreads();
            if (kc + 1 < 4) P8_ISSUE(kc + 1, (kc + 1) & 1);
            const LAS char* wb = wl + (kc & 1) * 49152;
#pragma unroll 1
            for (int g4 = 0; g4 < 2; ++g4) {
                const int gg = kc * 2 + g4;
                u32x4 nw[4];
                if (gg + 1 < 8) {
#pragma unroll
                    for (int u = 0; u < 4; ++u) nw[u] = *(const u32x4*)(xrow + 128 * (gg + 1) + 32 * u);
                }
#pragma unroll
                for (int u = 0; u < 4; ++u) {
                    const int k0 = 128 * gg + 32 * u + 8 * kq;
                    const f32x4 a0 = *(const LAS f32x4*)(A2 + k0), a1 = *(const LAS f32x4*)(A2 + k0 + 4), b0 = *(const LAS f32x4*)(B2 + k0), b1 = *(const LAS f32x4*)(B2 + k0 + 4);
                    const f32x4 xa_ = {bflo(xw[u].x), bfhi(xw[u].x), bflo(xw[u].y), bfhi(xw[u].y)}, xb_ = {bflo(xw[u].z), bfhi(xw[u].z), bflo(xw[u].w), bfhi(xw[u].w)};
                    const f32x4 ya = xa_ * rstd * a0 + b0, yb = xb_ * rstd * a1 + b1;
                    u32x4 hi; hi.x = pk2(ya[0], ya[1]); hi.y = pk2(ya[2], ya[3]); hi.z = pk2(yb[0], yb[1]); hi.w = pk2(yb[2], yb[3]);
                    *(u32x4*)(hrow + 128 * gg + 32 * u) = hi;
                    u32x4 lo; lo.x = pk2(ya[0] - bflo(hi.x), ya[1] - bfhi(hi.x)); lo.y = pk2(ya[2] - bflo(hi.y), ya[3] - bfhi(hi.y)); lo.z = pk2(yb[0] - bflo(hi.z), yb[1] - bfhi(hi.z)); lo.w = pk2(yb[2] - bflo(hi.w), yb[3] - bfhi(hi.w));
                    const bf16x8 ahi = __builtin_bit_cast(bf16x8, hi), alo = __builtin_bit_cast(bf16x8, lo);
                    const int ch = (g4 * 4 + u) * 4 + kq;
#pragma unroll
                    for (int ct = 0; ct < 3; ++ct) { const int r = 16 * ct + row; const int off = r * 512 + ((ch ^ row) << 4);
                        const bf16x8 bh = *(const LAS bf16x8*)(wb + off), bl = *(const LAS bf16x8*)(wb + 24576 + off);
                        acc[ct] = MFMA16(ahi, bh, acc[ct]); acc[ct] = MFMA16(alo, bh, acc[ct]); acc[ct] = MFMA16(ahi, bl, acc[ct]); }
                }
#pragma unroll
                for (int u = 0; u < 4; ++u) xw[u] = nw[u];
            }
        }
#pragma unroll
        for (int ct = 0; ct < 3; ++ct)
#pragma unroll
            for (int i = 0; i < 4; ++i) lg[(kq * 4 + i) * 48 + 16 * ct + row] = acc[ct][i];
        asm volatile("s_waitcnt lgkmcnt(0)" ::: "memory");
        int e0 = 0, e1 = 0; float w0 = 0.f, w1 = 0.f; unsigned lp0 = 0u, lp1 = 0u;
        if (lane < 16) {
            const LAS float* lr = lg + lane * 48;
            float g4v[4]; int grp = 0; float gm = -3.0e38f;
#pragma unroll
            for (int i = 0; i < 4; ++i) { g4v[i] = lr[i] + brg[i]; if (g4v[i] > gm) { gm = g4v[i]; grp = i; } }
            float den = 0.f;
#pragma unroll
            for (int i = 0; i < 4; ++i) den += __expf(g4v[i] - gm);
            const float pg = 1.f / den;
            float v0 = -3.0e38f, v1 = -3.0e38f; int i0 = 0, i1 = 0;
            for (int i = 0; i < 8; ++i) { const float v = lr[4 + grp * 8 + i] + bre[grp * 8 + i];
                if (v > v0) { v1 = v0; i1 = i0; v0 = v; i0 = i; } else if (v > v1) { v1 = v; i1 = i; } }
            const float ex = __expf(v1 - v0); w0 = pg / (1.f + ex); w1 = pg * ex / (1.f + ex);
            e0 = grp * 8 + i0; e1 = grp * 8 + i1;
            lp0 = atomicAdd((unsigned*)&hist[e0], 1u); lp1 = atomicAdd((unsigned*)&hist[e1], 1u);
        }
        __syncthreads();
        if (F.tid < 32) { const unsigned n = hist[F.tid]; hist[32 + F.tid] = n ? atomicAdd(cnt + F.tid, n) : 0u; }
        __syncthreads();
        if (lane < 16) {
            const int tok = m0 + lane; const int p0 = (int)(hist[32 + e0] + lp0), p1 = (int)(hist[32 + e1] + lp1);
            lists[(size_t)e0 * ECAP + p0] = tok; lists[(size_t)e1 * ECAP + p1] = tok;
            tipos[2 * tok] = p0; tipos[2 * tok + 1] = p1; tie[tok] = e0 | (e1 << 8); tiw[2 * tok] = w0; tiw[2 * tok + 1] = w1;
        }
        __syncthreads();
    }
#undef P8_ISSUE
}

DI LAS int* moe_prefix(Frame& F) {
    LAS int* tb = (LAS int*)(F.lds + LDS_MISC);
    __syncthreads();
    if (F.wave == 0) {
        const unsigned* cnt = (const unsigned*)(F.ws + WS_CTL) + CW_CNT; const int l = F.lane;
        int v = l < 32 ? (int)((__hip_atomic_load(cnt + l, __ATOMIC_RELAXED, __HIP_MEMORY_SCOPE_AGENT) + 255u) >> 8) : 0;
#pragma unroll
        for (int o = 1; o < 32; o <<= 1) { const int u = __shfl_up(v, o); if (l >= o) v += u; }
        if (l < 32) tb[l + 1] = v;
        if (l == 0) tb[0] = 0;
    }
    __syncthreads();
    return tb;
}

DI void phase11(Frame& F) {
    LAS int* tb = moe_prefix(F);
    const bf16_t* Y = (const bf16_t*)(F.ws + WS_Y); const float* mod = (const float*)(F.ws + WS_MOD);
    const int* tipos = (const int*)(F.ws + WS_TIPOS); const int* tie = (const int*)(F.ws + WS_TIE); const float* tiw = (const float*)(F.ws + WS_TIW);
    const int lane = F.lane;
    for (int m0 = F.gw * 32; m0 < TOK; m0 += F.NGW * 32) {
        const int b = m0 >> 11; const float* g2 = mod + (size_t)b * 6144 + 5120;
        f32x4 ga[2], gb[2];
#pragma unroll
        for (int j = 0; j < 2; ++j) { ga[j] = *(const f32x4*)(g2 + 8 * lane + 512 * j); gb[j] = *(const f32x4*)(g2 + 8 * lane + 512 * j + 4); }
        int mr0 = 0, mr1 = 0; float mw0 = 0.f, mw1 = 0.f;
        { const int mm = m0 + (lane & 31); const int ee = tie[mm]; mr0 = tb[ee & 255] * 256 + tipos[2 * mm]; mr1 = tb[ee >> 8] * 256 + tipos[2 * mm + 1]; mw0 = tiw[2 * mm]; mw1 = tiw[2 * mm + 1]; }
        float* obase = F.out + (size_t)m0 * DM + 8 * lane; const bf16_t* xbase = (const bf16_t*)(F.ws + WS_X1B) + (size_t)m0 * DM + 8 * lane;
#define P11_LOAD(i, ya, yb, xa, xb) do { const size_t r0_ = (size_t)__shfl(mr0, (i)), r1_ = (size_t)__shfl(mr1, (i)); \
            _Pragma("unroll") for (int j = 0; j < 2; ++j) { ya[j] = *(const u32x4*)(Y + r0_ * DM + 8 * lane + 512 * j); yb[j] = *(const u32x4*)(Y + r1_ * DM + 8 * lane + 512 * j); \
                const u32x4 xw_ = *(const u32x4*)(xbase + (size_t)(i) * DM + 512 * j); xa[j] = (f32x4){bflo(xw_.x), bfhi(xw_.x), bflo(xw_.y), bfhi(xw_.y)}; xb[j] = (f32x4){bflo(xw_.z), bfhi(xw_.z), bflo(xw_.w), bfhi(xw_.w)}; } } while (0)
        u32x4 ya0[2], yb0[2], ya1[2], yb1[2]; f32x4 xa0[2], xb0[2], xa1[2], xb1[2];
        P11_LOAD(0, ya0, yb0, xa0, xb0); P11_LOAD(1, ya1, yb1, xa1, xb1);
        for (int i = 0; i < 32; i += 2) {
            u32x4 nya0[2], nyb0[2], nya1[2], nyb1[2]; f32x4 nxa0[2], nxb0[2], nxa1[2], nxb1[2];
            if (i + 2 < 32) { P11_LOAD(i + 2, nya0, nyb0, nxa0, nxb0); P11_LOAD(i + 3, nya1, nyb1, nxa1, nxb1); }
#define P11_ROW(i, ya, yb, xa, xb) do { const float w0 = __shfl(mw0, (i)), w1 = __shfl(mw1, (i)); \
            _Pragma("unroll") for (int j = 0; j < 2; ++j) { f32x4 oa = xa[j], ob = xb[j]; \
                oa[0] += ga[j][0] * (w0 * bflo(ya[j].x) + w1 * bflo(yb[j].x)); oa[1] += ga[j][1] * (w0 * bfhi(ya[j].x) + w1 * bfhi(yb[j].x)); \
                oa[2] += ga[j][2] * (w0 * bflo(ya[j].y) + w1 * bflo(yb[j].y)); oa[3] += ga[j][3] * (w0 * bfhi(ya[j].y) + w1 * bfhi(yb[j].y)); \
                ob[0] += gb[j][0] * (w0 * bflo(ya[j].z) + w1 * bflo(yb[j].z)); ob[1] += gb[j][1] * (w0 * bfhi(ya[j].z) + w1 * bfhi(yb[j].z)); \
                ob[2] += gb[j][2] * (w0 * bflo(ya[j].w) + w1 * bflo(yb[j].w)); ob[3] += gb[j][3] * (w0 * bfhi(ya[j].w) + w1 * bfhi(yb[j].w)); \
                *(f32x4*)(obase + (size_t)(i) * DM + 512 * j) = oa; *(f32x4*)(obase + (size_t)(i) * DM + 512 * j + 4) = ob; } } while (0)
            P11_ROW(i, ya0, yb0, xa0, xb0); P11_ROW(i + 1, ya1, yb1, xa1, xb1);
#pragma unroll
            for (int j = 0; j < 2; ++j) { ya0[j] = nya0[j]; yb0[j] = nyb0[j]; xa0[j] = nxa0[j]; xb0[j] = nxb0[j]; ya1[j] = nya1[j]; yb1[j] = nyb1[j]; xa1[j] = nxa1[j]; xb1[j] = nxb1[j]; }
        }
#undef P11_LOAD
#undef P11_ROW
    }
}

constexpr int CW_BAR = 4096;
#define XB_TMO      128
#define XB_XCNT(j)  (256  + 64 * (j))
#define XB_XSUB(j)  (1280 + 64 * (j))
#define XB_XGEN(j)  (2304 + 64 * (j))
#define XB_TOP      3328
#define XB_TOPGEN   3392
#define XB_SPIN_CAP (1u << 22)
DI unsigned xb_ld(unsigned* p)              { return __hip_atomic_load(p, __ATOMIC_RELAXED, __HIP_MEMORY_SCOPE_AGENT); }
DI unsigned xb_add(unsigned* p, unsigned v) { return __hip_atomic_fetch_add(p, v, __ATOMIC_RELAXED, __HIP_MEMORY_SCOPE_AGENT); }
DI unsigned xb_xcc_id() { return (unsigned)__builtin_amdgcn_s_getreg((3 << 11) | 20) & 0xFu; }
#define XB_SPIN(cond, bar) do { unsigned _sp = 0; while (cond) { __builtin_amdgcn_s_sleep(1); \
    if ((++_sp & 255u) == 0u) { if (xb_ld(&(bar)[XB_TMO])) break; if (_sp > XB_SPIN_CAP) { atomicAdd(&(bar)[XB_TMO], 1u); break; } } } } while (0)
struct XcdBarrier { unsigned* bar; unsigned x; volatile LAS unsigned* st; };
DI XcdBarrier xcd_barrier_post(unsigned* bar, volatile LAS unsigned* st, bool leader) {
    XcdBarrier b; b.bar = bar; b.x = xb_xcc_id(); b.st = st;
    if (leader) (void)xb_add(&bar[XB_XCNT(b.x)], 1u);
    return b;
}
DI void xcd_barrier_complete(unsigned* bar, unsigned x, unsigned& nloc, unsigned& nx) {
    const unsigned G = gridDim.x;
    unsigned sum, cnt, mine, sp = 0u;
    for (;;) {
        sum = 0u; cnt = 0u; mine = 0u;
#pragma unroll
        for (unsigned j = 0; j < 16; ++j) { const unsigned c = xb_ld(&bar[XB_XCNT(j)]); sum += c; cnt += (c > 0u) ? 1u : 0u; mine = (j == x) ? c : mine; }
        if (sum == G) break;
        __builtin_amdgcn_s_sleep(1);
        if ((++sp & 255u) == 0u) { if (xb_ld(&bar[XB_TMO])) break; if (sp > XB_SPIN_CAP) { atomicAdd(&bar[XB_TMO], 1u); break; } }
    }
    nloc = mine > 0u ? mine : 1u; nx = cnt > 0u ? cnt : 1u;
}
DI void xcd_barrier(const XcdBarrier& b, bool leader) {
    asm volatile("s_waitcnt vmcnt(0)" ::: "memory");
    __syncthreads();
    if (leader) {
        unsigned* bar = b.bar;
        __builtin_amdgcn_s_waitcnt(0);
        unsigned nloc = b.st[0], nx = b.st[1];
        if (nloc == 0u) { xcd_barrier_complete(bar, b.x, nloc, nx); b.st[0] = nloc; b.st[1] = nx; }
        const unsigned old = xb_add(&bar[XB_XSUB(b.x)], 1u);
        const unsigned gen = old / nloc;
        if (old + 1u == (gen + 1u) * nloc) {
            __builtin_amdgcn_fence(__ATOMIC_RELEASE, "agent");
            asm volatile("s_waitcnt vmcnt(0)" ::: "memory");
            const unsigned og = xb_add(&bar[XB_TOP], 1u);
            const unsigned tg = og / nx;
            if (og + 1u == (tg + 1u) * nx) xb_add(&bar[XB_TOPGEN], 1u);
            else XB_SPIN(xb_ld(&bar[XB_TOPGEN]) == tg, bar);
            __builtin_amdgcn_fence(__ATOMIC_ACQUIRE, "agent");
            xb_add(&bar[XB_XGEN(b.x)], 1u);
            asm volatile("s_waitcnt vmcnt(0)" ::: "memory");
        } else {
            XB_SPIN(xb_ld(&bar[XB_XGEN(b.x)]) == gen, bar);
            __builtin_amdgcn_fence(__ATOMIC_ACQUIRE, "agent");
            asm volatile("s_waitcnt vmcnt(0)" ::: "memory");
        }
    }
    __syncthreads();
}

constexpr int NPHASE = 12;
__global__ void __launch_bounds__(NTHREADS, 2) hymba_fwd(Params p) {
    extern __shared__ __attribute__((aligned(16))) unsigned char lds_raw[];
    __builtin_assume(__builtin_amdgcn_workitem_id_y() == 0); __builtin_assume(__builtin_amdgcn_workitem_id_z() == 0);
    cg::grid_group grid = cg::this_grid();
    Frame F;
    F.lds = (LAS unsigned char*)lds_raw; F.ws = p.ws; F.in = p.in; F.out = p.out;
    F.wave = __builtin_amdgcn_readfirstlane(threadIdx.x >> 6); F.lane = lane_id_fresh(); F.tid = F.wave * 64 + F.lane; F.bid = blockIdx.x; F.G = gridDim.x;
    F.gw = F.bid * NWAVES + F.wave; F.NGW = F.G * NWAVES;
    const int lo = p.ph_lo, hi = p.ph_hi;
#define IN(k) (lo <= (k) && (k) < hi)
#ifdef PROBE_A
    LAS unsigned long long* ts_ = (LAS unsigned long long*)(F.lds + LDS_MISC + 7168);
#define STAMP(k) do { if (F.bid == 0 && F.tid == 0) ts_[k] = __builtin_amdgcn_s_memrealtime(); } while (0)
#else
#define STAMP(k) do { } while (0)
#endif
    STAMP(0);
    volatile LAS unsigned* xst = (volatile LAS unsigned*)(F.lds + LDS_MISC + 4112);
    if (F.tid == 0) { xst[0] = 0u; xst[1] = 0u; }
    __syncthreads();
    XcdBarrier xbar; xbar.bar = (unsigned*)(F.ws + WS_CTL) + CW_BAR; xbar.x = 0; xbar.st = xst;
#define SEAM(k) do { if (IN(k) && IN((k) + 1)) { if ((k) == 0) { grid.sync(); xbar = xcd_barrier_post((unsigned*)(F.ws + WS_CTL) + CW_BAR, xst, F.tid == 0); } else xcd_barrier(xbar, F.tid == 0); } F.lane = lane_id_fresh(); F.tid = F.wave * 64 + F.lane; STAMP((k) + 1); } while (0)
    LAS unsigned char* ring = F.lds; LAS unsigned* tokl = (LAS unsigned*)(F.lds + LDS_MISC + 256);
#ifdef DOUBLE_PHASE
#define NREP(k) ((k) == DOUBLE_PHASE ? 2 : 1)
#define REPSYNC(k, rep) do { if ((k) == DOUBLE_PHASE && (rep) == 0) grid.sync(); } while (0)
#else
#define NREP(k) 1
#define REPSYNC(k, rep) do { } while (0)
#endif

    if (IN(0)) for (int rep = 0; rep < NREP(0); ++rep) { phase0(F); REPSYNC(0, rep); }
    SEAM(0);
    if (IN(1)) for (int rep = 0; rep < NREP(1); ++rep) { phase1(F); phase0_weights(F); REPSYNC(1, rep); }
    SEAM(1);
    if (IN(2)) for (int rep = 0; rep < NREP(2); ++rep) {
        pg8::StaticOrder S; S.init(TOK, NPROJ, DM, F.G, F.bid, F.ws + WS_H1, F.ws + WS_WIN);
        pg8::EpiInProj E{F.ws, F.in[7], F.in[8], F.in[12], F.in[13], (LAS float*)(F.lds + LDS_MISC + 8192)};
        pg8::gemm_phase<pg8::EpiInProj, pg8::StaticOrder, false>(ring, tokl, DM, S, E, F.wave, F.lane);
        REPSYNC(2, rep);
    }
    SEAM(2); STAMP(4);
    if (IN(4)) for (int rep = 0; rep < NREP(4); ++rep) {
        { pg8::CompressOrder S{F.G, F.bid, (const char*)(F.ws + WS_KC), (const char*)(F.ws + WS_PE), (const char*)(F.ws + WS_WC1)};
          pg8::EpiBf16 E{(bf16_t*)(F.ws + WS_UL), 512};
          pg8::gemm_phase<pg8::EpiBf16, pg8::CompressOrder, false>(ring, tokl, 1024, S, E, F.wave, F.lane); }
        const float mq = gmax(F.in[12], 32, F.lane), mk = gmax(F.in[13], 32, F.lane);
        const float bound = 5.656854249f * mq * mk * 1.02f; const float c2 = 0.17677669529663687f * 1.4426950408889634f; const float mc = bound * 1.4426950408889634f;
        float s1 = F.lane < 32 ? F.in[14][F.lane] * F.in[15][F.lane] : 0.f, s2 = F.lane < 32 ? F.in[16][F.lane] * F.in[17][F.lane] : 0.f;
        s1 = wave_sum(s1); s2 = wave_sum(s2);
        const float lam = __expf(s1) - __expf(s2) + 0.2f;
        unsigned* ctr = (unsigned*)(F.ws + WS_CTL) + CW_QDIFF + 32 * rep;
        for (int it = queue_next(F, ctr); it < 4096;) { unsigned nx = 0u; if (F.tid == 0) nx = atomicAdd(ctr, 1u);
            const int qb = 15 - (it >> 8), bh = it & 255; diff_unit(F, bh >> 3, bh & 7, qb, c2, mc, lam); it = queue_pass(F, nx); }
        REPSYNC(4, rep);
    }
    SEAM(4);
    if (IN(5)) for (int rep = 0; rep < NREP(5); ++rep) { phase5(F); REPSYNC(5, rep); }
    SEAM(5);
    if (IN(6)) for (int rep = 0; rep < NREP(6); ++rep) {
        const float mq = gmax(F.in[7], 64, F.lane); const float mk = fmaxf(gmax(F.in[8], 64, F.lane), fmaxf(gmax(F.in[8] + 64, 64, F.lane), gmax(F.in[8] + 128, 64, F.lane)));
        const float bound = 8.f * mq * mk * 1.02f; const float c2 = 0.125f * 1.4426950408889634f; const float mc = bound * 1.4426950408889634f;
        unsigned* ctr = (unsigned*)(F.ws + WS_CTL) + CW_QNSA + 32 * rep;
        for (int it = queue_next(F, ctr); it < 2048;) { unsigned nx = 0u; if (F.tid == 0) nx = atomicAdd(ctr, 1u);
            const int qb = 31 - (it >> 6), bg = it & 63; nsa_unit(F, bg >> 1, bg & 1, qb, c2, mc); it = queue_pass(F, nx); }
        REPSYNC(6, rep);
    }
    SEAM(6);
    if (IN(7)) for (int rep = 0; rep < NREP(7); ++rep) {
        pg8::StaticOrder S; S.init(TOK, DM, DM, F.G, F.bid, F.ws + WS_AO, F.ws + WS_WOUT);
        pg8::EpiOutProj E{F.in[0], (bf16_t*)(F.ws + WS_X1B), (const float*)(F.ws + WS_MOD), (float*)(F.ws + WS_ROWSS)};
        pg8::gemm_phase<pg8::EpiOutProj, pg8::StaticOrder, false>(ring, tokl, DM, S, E, F.wave, F.lane);
        REPSYNC(7, rep);
    }
    SEAM(7);
    if (IN(8)) phase8(F);
    SEAM(8);
    if (IN(9)) for (int rep = 0; rep < NREP(9); ++rep) {
        LAS int* tb = moe_prefix(F);
        pg8::MoeOrder S{F.G, F.bid, 0, tb, (const char*)(F.ws + WS_H2), (const char*)(F.ws + WS_WGU), (const int*)(F.ws + WS_LIST)};
        pg8::EpiSwiglu E{(bf16_t*)(F.ws + WS_HH)};
        pg8::gemm_phase<pg8::EpiSwiglu, pg8::MoeOrder, true>(ring, tokl, DM, S, E, F.wave, F.lane);
        REPSYNC(9, rep);
    }
    SEAM(9);
    if (IN(10)) for (int rep = 0; rep < NREP(10); ++rep) {
        LAS int* tb = moe_prefix(F);
        pg8::MoeOrder S{F.G, F.bid, 1, tb, (const char*)(F.ws + WS_HH), (const char*)(F.ws + WS_WD), nullptr};
        pg8::EpiBf16 E{(bf16_t*)(F.ws + WS_Y), DM};
        pg8::gemm_phase<pg8::EpiBf16, pg8::MoeOrder, false>(ring, tokl, EHID, S, E, F.wave, F.lane);
        REPSYNC(10, rep);
    }
    SEAM(10);
    if (IN(11)) phase11(F);
    grid.sync(); grid.sync(); grid.sync(); grid.sync(); grid.sync(); grid.sync(); grid.sync(); grid.sync();
#ifdef PROBE_A
    grid.sync(); STAMP(12);
    if (F.bid == 0 && F.tid == 0) {
        unsigned long long da = (ts_[PROBE_A + 1] - ts_[PROBE_A]) / 100ull, db = (ts_[PROBE_B + 1] - ts_[PROBE_B]) / 100ull;
        unsigned long long qa = (da + 5ull) / 10ull, qb2 = (db + 5ull) / 10ull; if (qa > 63ull) qa = 63ull; if (qb2 > 63ull) qb2 = 63ull;
        const unsigned long long target = ts_[0] + (6000ull + 16ull + 32ull * qa + 2048ull * qb2) * 100ull;
        while (__builtin_amdgcn_s_memrealtime() < target) __builtin_amdgcn_s_sleep(32);
    }
#endif
#undef IN
#undef SEAM
}

#ifndef MK_LAUNCHES
#define MK_LAUNCHES 1
#endif
extern "C" void kernel_launch(void* const* d_in, const int* in_sizes, int n_in, void* d_out, int out_size, void* d_ws, size_t ws_size, hipStream_t stream) {
    static int grid = 0;
    if (grid == 0) {
        if (n_in != 27 || ws_size < WS_END) { fprintf(stderr, "kernel_launch: unexpected inputs (n_in %d, ws %zu)\n", n_in, ws_size); grid = -1; return; }
        int dev = 0, cus = 0, per_cu = 0;
        hipGetDevice(&dev); hipDeviceGetAttribute(&cus, hipDeviceAttributeMultiprocessorCount, dev);
        hipFuncSetAttribute((const void*)hymba_fwd, hipFuncAttributeMaxDynamicSharedMemorySize, LDS_BYTES);
        hipOccupancyMaxActiveBlocksPerMultiprocessor(&per_cu, (const void*)hymba_fwd, NTHREADS, LDS_BYTES);
        if (per_cu < 1) { fprintf(stderr, "kernel_launch: occupancy query says %d blocks per CU\n", per_cu); per_cu = 1; }
        if (per_cu > 1) per_cu = 1;
        grid = cus * per_cu;
    }
    if (grid < 0) return;
    Params p{};
    for (int i = 0; i < 27; ++i) p.in[i] = (const float*)d_in[i];
    p.out = (float*)d_out; p.ws = (unsigned char*)d_ws;
    const int cuts[13] = {0, 1, 2, 3, 4, 5, 6, 7, 8, 9, 10, 11, 12};
    const int nl = MK_LAUNCHES == 1 ? 1 : NPHASE;
    for (int li = 0; li < nl; ++li) {
        p.ph_lo = nl == 1 ? 0 : cuts[li]; p.ph_hi = nl == 1 ? NPHASE : cuts[li + 1];
        void* args[] = {&p};
        hipError_t e = hipLaunchCooperativeKernel((const void*)hymba_fwd, dim3(grid), dim3(NTHREADS), args, LDS_BYTES, stream);
        if (e != hipSuccess) { fprintf(stderr, "cooperative launch failed: %s (grid %d)\n", hipGetErrorString(e), grid); break; }
    }
}
```

```cpp
#include <hip/hip_runtime.h>
#include <hip/hip_cooperative_groups.h>
#include <cstdint>
#include <cstdio>
namespace cg = cooperative_groups;

#define LAS __attribute__((address_space(3)))
#define DI __device__ __forceinline__
typedef unsigned short bf16_t;
typedef short bf16x8 __attribute__((ext_vector_type(8)));
typedef short s16x4 __attribute__((ext_vector_type(4)));
typedef float f32x2 __attribute__((ext_vector_type(2)));
typedef float f32x4 __attribute__((ext_vector_type(4)));
typedef float f32x16 __attribute__((ext_vector_type(16)));
typedef unsigned u32x2 __attribute__((ext_vector_type(2)));
typedef unsigned u32x4 __attribute__((ext_vector_type(4)));

constexpr int BATCH = 32, SEQ = 2048, DM = 1024, TOK = BATCH * SEQ;
constexpr int NPROJ = 3072;
constexpr int INCOLS = 2840;
constexpr int NEXP = 32, EHID = 512, ECAP = 65536;
constexpr float EPS = 1e-6f;
constexpr int NWAVES = 8, NTHREADS = 512;

constexpr size_t MiB = 1u << 20;
constexpr size_t WS_CTL = 0;
constexpr size_t WS_MOD = 1 * MiB;
constexpr size_t WS_ROPE = 2 * MiB;
constexpr size_t WS_WR = 3 * MiB;
constexpr size_t WS_WIN = 4 * MiB;
constexpr size_t WS_WOUT = 10 * MiB;
constexpr size_t WS_WC1 = 12 * MiB;
constexpr size_t WS_WGU = 16 * MiB;
constexpr size_t WS_WD = 80 * MiB;
constexpr size_t WS_LIST = 112 * MiB;
constexpr size_t WS_TIPOS = 120 * MiB;
constexpr size_t WS_TIE = WS_TIPOS + 512 * 1024;
constexpr size_t WS_TIW = WS_TIE + 256 * 1024;
constexpr size_t WS_ROWSS = 122 * MiB;
constexpr size_t WS_GATES = 126 * MiB;
constexpr size_t WS_KCMP = 132 * MiB;
constexpr size_t WS_VCMP = 133 * MiB;
constexpr size_t WS_UL = 134 * MiB;
constexpr size_t WS_A = 160 * MiB;
constexpr size_t WS_B = 288 * MiB;
constexpr size_t WS_C = 672 * MiB;
constexpr size_t WS_H1 = WS_A, WS_QN = WS_B + 128 * MiB, WS_QR = WS_B + 192 * MiB, WS_H2 = WS_A;
constexpr size_t WS_PROJ = WS_B, WS_AO = WS_B, WS_HH = WS_B, WS_Y = WS_B + 136 * MiB;
constexpr size_t WS_KC = WS_C, WS_VC = WS_C + 16 * MiB, WS_PE = WS_C + 32 * MiB, WS_KS = WS_C + 33 * MiB, WS_VS = WS_C + 49 * MiB,
                 WS_KW = WS_C + 65 * MiB, WS_VW = WS_C + 81 * MiB, WS_DQ = WS_C + 97 * MiB, WS_DK = WS_C + 161 * MiB, WS_DV = WS_C + 225 * MiB;
constexpr size_t WS_X1B = WS_C + 32 * MiB;
constexpr size_t WS_END = WS_C + 289 * MiB;
constexpr int CW_CNT = 0;
constexpr int CW_QDIFF = 64, CW_QNSA = 128;

constexpr int RING_BYTES = 131072;
constexpr int LDS_MISC = RING_BYTES;
constexpr int LDS_BYTES = 147456;

DI unsigned pk2(float lo, float hi) { typedef __bf16 b2 __attribute__((ext_vector_type(2))); f32x2 v = {lo, hi}; b2 b = __builtin_convertvector(v, b2); return __builtin_bit_cast(unsigned, b); }
DI unsigned short f2bf(float f) { return (unsigned short)(pk2(f, 0.f) & 0xffffu); }
DI float bf2f(unsigned short h) { return __uint_as_float((unsigned)h << 16); }
DI float bflo(unsigned w) { return __uint_as_float(w << 16); }
DI float bfhi(unsigned w) { return __uint_as_float(w & 0xffff0000u); }
DI float wave_sum(float v) {
#pragma unroll
    for (int o = 1; o < 64; o <<= 1) v += __shfl_xor(v, o);
    return v;
}
DI float fast_exp2(float x) { return __builtin_amdgcn_exp2f(x); }
DI float fast_rcp(float x) { return __builtin_amdgcn_rcpf(x); }
#define MFMA32(a, b, c) __builtin_amdgcn_mfma_f32_32x32x16_bf16((a), (b), (c), 0, 0, 0)
#define MFMA16(a, b, c) __builtin_amdgcn_mfma_f32_16x16x32_bf16((a), (b), (c), 0, 0, 0)
typedef int v8i32 __attribute__((ext_vector_type(8)));
DI unsigned pk4_fp8(float a, float b, float c, float d) { int w = 0; w = __builtin_amdgcn_cvt_pk_fp8_f32(a, b, w, false); w = __builtin_amdgcn_cvt_pk_fp8_f32(c, d, w, true); return (unsigned)w; }
DI int crow(int r, int hi) { return (r & 3) + 8 * (r >> 2) + 4 * hi; }

DI int lane_id_fresh() { int l; asm volatile("v_mbcnt_lo_u32_b32 %0, -1, 0\n\tv_mbcnt_hi_u32_b32 %0, -1, %0" : "=v"(l)); return l; }
DI void glds16s(const void* sbase, unsigned voff, unsigned lds_dst) { unsigned keep;
    asm volatile("s_mov_b32 %0, m0\n\ts_mov_b32 m0, %3\n\ts_nop 0\n\tglobal_load_lds_dwordx4 %1, %2\n\ts_mov_b32 m0, %0" : "=&s"(keep) : "v"(voff), "s"(sbase), "s"(lds_dst) : "memory"); }
struct Params { const float* in[27]; float* out; unsigned char* ws; int ph_lo, ph_hi; };

namespace pg8 {
constexpr int BM = 256, BK = 64, HALF = 128, HTB = HALF * BK * 2, STAGE_BYTES = 8 * HTB, NXCD = 8, WGM = 8;
DI int lds_byte(int r, int c) { const int st = (r >> 4) * 2 + (c >> 5), rr = r & 15, cc = c & 31, ob = rr * 64 + cc * 2; return st * 1024 + (ob ^ (((ob >> 9) & 1) << 5)); }
DI void stage_rc(int b, int& R, int& C) { const int st = b / 1024, sb = b % 1024, swz = sb ^ (((sb >> 9) & 1) << 5); R = (st >> 1) * 16 + swz / 64; C = (st & 1) * 32 + (swz % 64) / 2; }
DI int perm32(int rho) { const int n = rho >> 4, i = rho & 15; return 8 * (i >> 2) + 4 * n + (i & 3); }

struct Unit { int pm, pn, aux; const char* Ab; const char* Bb; const int* tok; };

template <class Epi, class Sched, bool GATHER, bool FP8 = false>
DI void gemm_phase(LAS unsigned char* lds, LAS unsigned* tokl, const int K, const Sched& S, const Epi& E, const int wid, const int lane) {
    const int tid = wid * 64 + lane, wr = wid >> 2, wc = wid & 3, fr = lane & 15, fq = lane >> 4;
    const int nt = K / BK;
    unsigned voffA[2], voffB[2]; int RA[2], CA[2];
#pragma unroll
    for (int i = 0; i < 2; ++i) { int R, C; stage_rc(tid * 16 + i * 8192, R, C); const int Rb = Epi::PERM ? ((R & ~31) + perm32(R & 31)) : R;
        voffA[i] = (unsigned)(R * K + C) * 2u; voffB[i] = (unsigned)(Rb * K + C) * 2u; RA[i] = R; CA[i] = C; }
    const size_t kstep = (size_t)(BK * 2);
    const size_t hstep = (size_t)HALF * K * 2;
    const unsigned ldsw = (unsigned)wid * 1024u; const unsigned ldsb = (unsigned)(uintptr_t)lds;
    const int aoff = lds_byte(wr * 64 + fr, fq * 8), boff = lds_byte(wc * 32 + fr, fq * 8);
#define PG8_SA(b, h) (((b) * 2 + (h)) * HTB)
#define PG8_SB(b, h) ((4 + (b) * 2 + (h)) * HTB)
#define PG8_STG(bufoff, gbase, voff) do { _Pragma("unroll") for (int _i = 0; _i < 2; ++_i) \
        glds16s((const void*)(gbase), (voff)[_i], (unsigned)__builtin_amdgcn_readfirstlane((int)(ldsb + (unsigned)(bufoff) + ldsw + (unsigned)_i * 8192u))); } while (0)
#define PG8_STA(bufoff, gbase, h, bsel) do { if constexpr (GATHER) { unsigned vv_[2];   \
            _Pragma("unroll") for (int _j = 0; _j < 2; ++_j) vv_[_j] = tokl[(bsel) * 256 + (h) * 128 + RA[_j]] * (unsigned)(K * 2) + (unsigned)(CA[_j] * 2); \
            PG8_STG(bufoff, gbase, vv_); } else { PG8_STG(bufoff, (gbase) + (h) * hstep, voffA); } } while (0)
#define PG8_LD8(p_) ({ const u32x4 lo_ = *(const LAS u32x4*)(p_), hi_ = *(const LAS u32x4*)((p_) + 1024); (v8i32){(int)lo_.x, (int)lo_.y, (int)lo_.z, (int)lo_.w, (int)hi_.x, (int)hi_.y, (int)hi_.z, (int)hi_.w}; })
#define PG8_LDA(dst, b, h) do { if constexpr (FP8) { _Pragma("unroll") for (int m = 0; m < 4; ++m) dst##8[m] = PG8_LD8(lds + PG8_SA(b, h) + aoff + m * 2048); } \
        else { _Pragma("unroll") for (int m = 0; m < 4; ++m) _Pragma("unroll") for (int k = 0; k < 2; ++k) dst[m][k] = *(const LAS bf16x8*)(lds + PG8_SA(b, h) + aoff + m * 2048 + k * 1024); } } while (0)
#define PG8_LDB(dst, b, h) do { if constexpr (FP8) { _Pragma("unroll") for (int n = 0; n < 2; ++n) dst##8[n] = PG8_LD8(lds + PG8_SB(b, h) + boff + n * 2048); } \
        else { _Pragma("unroll") for (int n = 0; n < 2; ++n) _Pragma("unroll") for (int k = 0; k < 2; ++k) dst[n][k] = *(const LAS bf16x8*)(lds + PG8_SB(b, h) + boff + n * 2048 + k * 1024); } } while (0)
#define PG8_MMA(ai, bj, At, Bt) do { __builtin_amdgcn_s_setprio(1); _Pragma("unroll") for (int m = 0; m < 4; ++m) _Pragma("unroll") for (int n = 0; n < 2; ++n) { \
        if constexpr (FP8) {   \
            asm volatile("v_mfma_scale_f32_16x16x128_f8f6f4 %0, %1, %2, %0, %3, %4 op_sel_hi:[0,0,0]" : "+v"(acc[ai][bj][m][n]) : "v"(Bt##8[n]), "v"(At##8[m]), "v"(sclB_), "v"(sclA_)); \
        } else { _Pragma("unroll") for (int k = 0; k < 2; ++k) acc[ai][bj][m][n] = __builtin_amdgcn_mfma_f32_16x16x32_bf16(Bt[n][k], At[m][k], acc[ai][bj][m][n], 0, 0, 0); } } \
        __builtin_amdgcn_s_setprio(0); } while (0)
#define PG8_WAIT_V(n) asm volatile("s_waitcnt vmcnt(" #n ")" ::: "memory")
#define PG8_WAIT_L(n) asm volatile("s_waitcnt lgkmcnt(" #n ")" ::: "memory")
#define PG8_BAR __builtin_amdgcn_s_barrier()
#define PG8_SCHED __builtin_amdgcn_sched_barrier(0)
    Unit cur, nxt; int ui = 0;
    if (!S.next(0, cur)) return;
    f32x4 acc[2][2][4][2];
#pragma unroll
    for (int a = 0; a < 2; ++a)
#pragma unroll
        for (int b = 0; b < 2; ++b)
#pragma unroll
            for (int m = 0; m < 4; ++m)
#pragma unroll
                for (int n = 0; n < 2; ++n) acc[a][b][m][n] = (f32x4){0.f, 0.f, 0.f, 0.f};
    bf16x8 At[4][2], B0[2][2], B1[2][2];
    v8i32 At8[4], B08[2], B18[2];
    int sclB_ = 0x77777777, sclA_ = 0x7f7f7f7f; asm volatile("" : "+v"(sclB_), "+v"(sclA_));
    const char* cA = cur.Ab; const char* cB = cur.Bb;
    if constexpr (GATHER) {
        if (wid < 4) __builtin_amdgcn_global_load_lds((const unsigned*)(cur.tok + wid * 64 + lane), (LAS unsigned*)(tokl + wid * 64), 4, 0, 0);
        PG8_WAIT_V(0); PG8_BAR;
    }
    PG8_STG(PG8_SB(0, 0), cB, voffB); PG8_STG(PG8_SB(0, 1), cB + hstep, voffB); PG8_STA(PG8_SA(0, 0), cA, 0, 0); PG8_STA(PG8_SA(0, 1), cA, 1, 0);
    if (wr == 1) PG8_BAR;
    PG8_WAIT_V(2); PG8_BAR;
    PG8_STG(PG8_SB(1, 0), cB + kstep, voffB); PG8_STA(PG8_SA(1, 0), cA + kstep, 0, 0); PG8_STG(PG8_SB(1, 1), cB + hstep + kstep, voffB);
    PG8_WAIT_V(6); PG8_BAR;
    for (;;) {
        const bool has_next = S.next(ui + 1, nxt);
        const char* nA = has_next ? nxt.Ab : cA; const char* nB = has_next ? nxt.Bb : cB;
        if constexpr (GATHER) {
            if (has_next && wid < 4) __builtin_amdgcn_global_load_lds((const unsigned*)(nxt.tok + wid * 64 + lane), (LAS unsigned*)(tokl + ((ui + 1) & 1) * 256 + wid * 64), 4, 0, 0);
        }
#pragma unroll 1
        for (int t = 0; t < nt; t += 2) {
            const bool last = (t == nt - 2);
            const char* a1 = cA + (size_t)(t + 1) * kstep;
            const char* a2 = last ? nA : cA + (size_t)(t + 2) * kstep; const char* b2 = last ? nB : cB + (size_t)(t + 2) * kstep;
            const char* a3 = a2 + kstep; const char* b3 = b2 + kstep;
            const int bc_ = ui & 1, bn_ = (last && has_next) ? ((ui + 1) & 1) : (ui & 1);
            PG8_LDB(B0, 0, 0); PG8_LDB(B1, 0, 1); PG8_SCHED; PG8_LDA(At, 0, 0); PG8_STA(PG8_SA(1, 1), a1, 1, bc_);
            PG8_WAIT_V(8); PG8_WAIT_L(0); PG8_BAR; PG8_MMA(0, 0, At, B0); PG8_MMA(0, 1, At, B1); PG8_BAR; PG8_SCHED;
            PG8_LDA(At, 0, 1); PG8_STG(PG8_SB(0, 0), b2, voffB); PG8_STG(PG8_SB(0, 1), b2 + hstep, voffB); PG8_STA(PG8_SA(0, 0), a2, 0, bn_);
            PG8_WAIT_V(8); PG8_WAIT_L(0); PG8_BAR; PG8_MMA(1, 0, At, B0); PG8_MMA(1, 1, At, B1); PG8_BAR; PG8_SCHED;
            PG8_LDB(B0, 1, 0); PG8_LDB(B1, 1, 1); PG8_SCHED; PG8_LDA(At, 1, 0); PG8_STA(PG8_SA(0, 1), a2, 1, bn_);
            PG8_WAIT_V(8); PG8_WAIT_L(0); PG8_BAR; PG8_MMA(0, 0, At, B0); PG8_MMA(0, 1, At, B1); PG8_BAR; PG8_SCHED;
            PG8_LDA(At, 1, 1); PG8_STG(PG8_SB(1, 0), b3, voffB); PG8_STG(PG8_SB(1, 1), b3 + hstep, voffB); PG8_STA(PG8_SA(1, 0), a3, 0, bn_);
            PG8_WAIT_V(8); PG8_WAIT_L(0); PG8_BAR; PG8_MMA(1, 0, At, B0); PG8_MMA(1, 1, At, B1); PG8_BAR; PG8_SCHED;
        }
        if (wr == 0) PG8_BAR;
        if constexpr (FP8) asm volatile("s_nop 15\n\ts_nop 15" ::: "memory");
        E(acc, cur, wr, wc, fr, fq);
        if (!has_next) break;
#pragma unroll
        for (int a = 0; a < 2; ++a)
#pragma unroll
            for (int b = 0; b < 2; ++b)
#pragma unroll
                for (int m = 0; m < 4; ++m)
#pragma unroll
                    for (int n = 0; n < 2; ++n) acc[a][b][m][n] = (f32x4){0.f, 0.f, 0.f, 0.f};
        cur = nxt; cA = nA; cB = nB; ++ui;
        if (wr == 1) PG8_BAR;
    }
    PG8_WAIT_V(0);
    PG8_BAR;
#undef PG8_SA
#undef PG8_SB
#undef PG8_STG
#undef PG8_STA
#undef PG8_LDA
#undef PG8_LDB
#undef PG8_MMA
#undef PG8_WAIT_V
#undef PG8_WAIT_L
#undef PG8_BAR
#undef PG8_SCHED
}

struct StaticOrder {
    int nM, nN, nwg, G, c; const char* A; const char* Bt; size_t tstep;
    DI void init(int M, int N, int K, int G_, int c_, const void* A_, const void* Bt_) { nM = M / BM; nN = N / BM; nwg = nM * nN; G = G_; c = c_; A = (const char*)A_; Bt = (const char*)Bt_; tstep = (size_t)BM * K * 2; }
    DI bool next(int i, Unit& u) const {
        const long L = (long)i * G + c; if (L >= nwg) return false;
        int wgid = (int)L; { const int q = nwg / NXCD, r = nwg % NXCD, xcd = wgid % NXCD, off = wgid / NXCD; wgid = (xcd < r ? xcd * (q + 1) : r * (q + 1) + (xcd - r) * q) + off; }
        const int nig = WGM * nN, gid = wgid / nig, fm = gid * WGM, gsz = (nM - fm) < WGM ? (nM - fm) : WGM;
        u.pm = fm + ((wgid % nig) % gsz); u.pn = (wgid % nig) / gsz; u.aux = 0; u.Ab = A + (size_t)u.pm * tstep; u.Bb = Bt + (size_t)u.pn * tstep; u.tok = nullptr; return true;
    }
};
struct CompressOrder {
    int G, c; const char* KC; const char* PE; const char* W;
    DI bool next(int i, Unit& u) const {
        const int L = i * G + c; if (L >= 132) return false;
        u.pm = L >> 1; u.pn = L & 1; const int kv = u.pm < 32 ? 0 : (u.pm < 64 ? 1 : u.pm - 64); u.aux = kv;
        u.Ab = u.pm < 64 ? KC + (size_t)u.pm * (256 * 1024 * 2) : PE; u.Bb = W + (size_t)kv * (512 * 1024 * 2) + (size_t)u.pn * (256 * 1024 * 2); u.tok = nullptr; return true;
    }
};
struct MoeOrder {
    int G, c, mode; const LAS int* tb; const char* A; const char* W; const int* lists;
    DI bool next(int i, Unit& u) const {
        const int L = i * G + c; const int mt = L >> 2; if (mt >= tb[32]) return false;
        int e = 0;
#pragma unroll 1
        for (int j = 1; j < 32; ++j) e += (tb[j] <= mt) ? 1 : 0;
        u.pm = mt; u.pn = L & 3; u.aux = e;
        if (mode == 0) { u.Ab = A; u.Bb = W + (size_t)e * (1024 * 1024) + (size_t)u.pn * (256 * 1024); u.tok = lists + (size_t)e * ECAP + (size_t)(mt - tb[e]) * 256; }
        else { u.Ab = A + (size_t)mt * (256 * 512); u.Bb = W + (size_t)e * (1024 * 512) + (size_t)u.pn * (256 * 512); u.tok = nullptr; }
        return true;
    }
};

struct EpiBf16 {
    static constexpr bool PERM = true;
    bf16_t* O; int ldc;
    DI void operator()(const f32x4 (&acc)[2][2][4][2], const Unit& u, int wr, int wc, int fr, int fq) const {
        asm volatile("" : "+v"(fr), "+v"(fq));
        const int row0 = u.pm * BM + wr * 64 + fr; const int col0 = u.pn * BM + wc * 32 + 8 * fq;
#pragma unroll
        for (int ai = 0; ai < 2; ++ai)
#pragma unroll
            for (int m = 0; m < 4; ++m) { bf16_t* rowp = O + (size_t)(row0 + ai * HALF + m * 16) * ldc + col0;
#pragma unroll
                for (int bj = 0; bj < 2; ++bj) { const f32x4 v0 = acc[ai][bj][m][0], v1 = acc[ai][bj][m][1];
                    u32x4 w; w.x = pk2(v0[0], v0[1]); w.y = pk2(v0[2], v0[3]); w.z = pk2(v1[0], v1[1]); w.w = pk2(v1[2], v1[3]);
                    *(u32x4*)(rowp + bj * HALF) = w; } }
    }
};
struct EpiInProj {
    static constexpr bool PERM = true;
    unsigned char* ws; const float* g_nq; const float* g_nk; const float* g_dq; const float* g_dk; LAS float* xch;
    DI void operator()(const f32x4 (&acc)[2][2][4][2], const Unit& u, int wr, int wc, int fr, int fq) const {
        const int pn = u.pn, wid = wr * 4 + wc; const int tok0 = u.pm * BM; const int b = tok0 >> 11; int t0 = (tok0 & 2047) + wr * 64 + fr;
        int xo_i = wid * 256 + fr, xp_i = (wid ^ 1) * 256 + fr;
        asm volatile("" : "+v"(t0), "+v"(xo_i), "+v"(xp_i));
        LAS float* xo = xch + xo_i; LAS float* xp = xch + xp_i;
        const float* ropeN = (const float*)(ws + WS_ROPE); const float* ropeD = ropeN + 2048 * 16;
        const int d0 = 32 * (wc & 1) + 8 * fq;
        if (pn <= 4) {
            const bool nrm0 = (pn != 2), nrm1 = (pn < 2);
            if (pn != 2) {
#pragma unroll
                for (int ai = 0; ai < 2; ++ai)
#pragma unroll
                    for (int m = 0; m < 4; ++m)
#pragma unroll
                        for (int bj = 0; bj < 2; ++bj) { const f32x4 a = acc[ai][bj][m][0], c = acc[ai][bj][m][1];
                            float ss = (a[0] * a[0] + a[1] * a[1]) + (a[2] * a[2] + a[3] * a[3]) + (c[0] * c[0] + c[1] * c[1]) + (c[2] * c[2] + c[3] * c[3]);
                            ss += __shfl_xor(ss, 16); ss += __shfl_xor(ss, 32);
                            if (fq == 0) xo[((ai * 4 + m) * 2 + bj) * 16] = ss; }
                asm volatile("s_waitcnt lgkmcnt(0)" ::: "memory"); __builtin_amdgcn_s_barrier(); asm volatile("" ::: "memory");
            }
            const float* gg = pn < 2 ? g_nq : (g_nk + (pn == 3 ? 64 : 128));
            f32x4 g0 = {1.f, 1.f, 1.f, 1.f}, g1 = g0;
            if (pn != 2) { g0 = *(const f32x4*)(gg + d0); g1 = *(const f32x4*)(gg + d0 + 4); }
            const bool ropew = (wc & 1) == 0;
#pragma unroll
            for (int ai = 0; ai < 2; ++ai)
#pragma unroll
                for (int m = 0; m < 4; ++m) {
                    const int t = t0 + ai * HALF + m * 16;
                    f32x4 cs0 = {1.f, 0.f, 1.f, 0.f}, cs1 = cs0, cs2 = cs0, cs3 = cs0;
                    if (pn != 2 && ropew && fq < 2) { const f32x4* rp = (const f32x4*)(ropeN + t * 16); cs0 = rp[0]; cs1 = rp[1]; cs2 = rp[2]; cs3 = rp[3]; }
#pragma unroll
                    for (int bj = 0; bj < 2; ++bj) {
                        const bool donorm = bj == 0 ? nrm0 : nrm1;
                        f32x4 ya = acc[ai][bj][m][0], yb = acc[ai][bj][m][1];
                        u32x4 w0, w1;
                        if (donorm) {
                            const float rstd = rsqrtf((xo[((ai * 4 + m) * 2 + bj) * 16] + xp[((ai * 4 + m) * 2 + bj) * 16]) * (1.f / 64.f) + EPS);
                            ya = ya * rstd * g0; yb = yb * rstd * g1;
                            w0.x = pk2(ya[0], ya[1]); w0.y = pk2(ya[2], ya[3]); w0.z = pk2(yb[0], yb[1]); w0.w = pk2(yb[2], yb[3]);
                            f32x4 ra = ya, rb = yb;
                            if (ropew) {
                                f32x4 pa, pb;
#pragma unroll
                                for (int i = 0; i < 4; ++i) { pa[i] = __shfl_xor(ya[i], 16); pb[i] = __shfl_xor(yb[i], 16); }
                                if (fq == 0) { ra[0] = ya[0] * cs0[0] - pa[0] * cs0[1]; ra[1] = ya[1] * cs0[2] - pa[1] * cs0[3]; ra[2] = ya[2] * cs1[0] - pa[2] * cs1[1]; ra[3] = ya[3] * cs1[2] - pa[3] * cs1[3];
                                               rb[0] = yb[0] * cs2[0] - pb[0] * cs2[1]; rb[1] = yb[1] * cs2[2] - pb[1] * cs2[3]; rb[2] = yb[2] * cs3[0] - pb[2] * cs3[1]; rb[3] = yb[3] * cs3[2] - pb[3] * cs3[3]; }
                                else if (fq == 1) { ra[0] = pa[0] * cs0[1] + ya[0] * cs0[0]; ra[1] = pa[1] * cs0[3] + ya[1] * cs0[2]; ra[2] = pa[2] * cs1[1] + ya[2] * cs1[0]; ra[3] = pa[3] * cs1[3] + ya[3] * cs1[2];
                                                    rb[0] = pb[0] * cs2[1] + yb[0] * cs2[0]; rb[1] = pb[1] * cs2[3] + yb[1] * cs2[2]; rb[2] = pb[2] * cs3[1] + yb[2] * cs3[0]; rb[3] = pb[3] * cs3[3] + yb[3] * cs3[2]; }
                            }
                            w1.x = pk2(ra[0], ra[1]); w1.y = pk2(ra[2], ra[3]); w1.z = pk2(rb[0], rb[1]); w1.w = pk2(rb[2], rb[3]);
                        } else { w0.x = pk2(ya[0], ya[1]); w0.y = pk2(ya[2], ya[3]); w0.z = pk2(yb[0], yb[1]); w0.w = pk2(yb[2], yb[3]); w1 = w0; }
                        const int hq = 2 * bj + (wc >> 1);
                        if (pn < 2) { const size_t off = (((size_t)b * 8 + 4 * pn + hq) * SEQ + t) * 64 + d0;
                            *(u32x4*)((bf16_t*)(ws + WS_QN) + off) = w0; *(u32x4*)((bf16_t*)(ws + WS_QR) + off) = w1; }
                        else { const int six = 2 * (pn - 2) + bj; const size_t base = six == 0 ? WS_KC : six == 1 ? WS_VC : six == 2 ? WS_KS : six == 3 ? WS_VS : six == 4 ? WS_KW : WS_VW;
                            const size_t off = (((size_t)b * 2 + (wc >> 1)) * SEQ + t) * 64 + d0;
                            *(u32x4*)((bf16_t*)(ws + base) + off) = w1; }
                    }
                    asm volatile("" ::: "memory");
                }
        } else if (pn <= 8) {
            const bool isq = pn <= 6; const float* gg = isq ? g_dq : g_dk; bf16_t* dst = (bf16_t*)(ws + (isq ? WS_DQ : WS_DK));
            const f32x4 g0 = *(const f32x4*)(gg + 8 * fq), g1 = *(const f32x4*)(gg + 8 * fq + 4);
#pragma unroll
            for (int ai = 0; ai < 2; ++ai)
#pragma unroll
                for (int m = 0; m < 4; ++m) {
                    const int t = t0 + ai * HALF + m * 16;
                    f32x4 c0 = {1.f, 0.f, 1.f, 0.f}, c1 = c0;
                    if (fq == 0) { const f32x4* rp = (const f32x4*)(ropeD + t * 8); c0 = rp[0]; c1 = rp[1]; }
#pragma unroll
                    for (int bj = 0; bj < 2; ++bj) {
                        f32x4 ya = acc[ai][bj][m][0], yb = acc[ai][bj][m][1];
                        float ss = (ya[0] * ya[0] + ya[1] * ya[1]) + (ya[2] * ya[2] + ya[3] * ya[3]) + (yb[0] * yb[0] + yb[1] * yb[1]) + (yb[2] * yb[2] + yb[3] * yb[3]);
                        ss += __shfl_xor(ss, 16); ss += __shfl_xor(ss, 32);
                        const float rstd = rsqrtf(ss * (1.f / 32.f) + EPS);
                        ya = ya * rstd * g0; yb = yb * rstd * g1;
                        if (fq == 0) { const f32x4 a = ya, bb = yb;
                            ya[0] = a[0] * c0[0] - bb[0] * c0[1]; yb[0] = a[0] * c0[1] + bb[0] * c0[0]; ya[1] = a[1] * c0[2] - bb[1] * c0[3]; yb[1] = a[1] * c0[3] + bb[1] * c0[2];
                            ya[2] = a[2] * c1[0] - bb[2] * c1[1]; yb[2] = a[2] * c1[1] + bb[2] * c1[0]; ya[3] = a[3] * c1[2] - bb[3] * c1[3]; yb[3] = a[3] * c1[3] + bb[3] * c1[2]; }
                        u32x4 w; w.x = pk2(ya[0], ya[1]); w.y = pk2(ya[2], ya[3]); w.z = pk2(yb[0], yb[1]); w.w = pk2(yb[2], yb[3]);
                        const int hd = 4 * ((pn - 5) & 1) + 2 * bj + (wc >> 1);
                        *(u32x4*)(dst + (((size_t)b * 8 + hd) * SEQ + t) * 64 + d0) = w;
                    }
                    asm volatile("" ::: "memory");
                }
        } else if (pn <= 10) {
            bf16_t* dst = (bf16_t*)(ws + WS_DV);
#pragma unroll
            for (int ai = 0; ai < 2; ++ai)
#pragma unroll
                for (int m = 0; m < 4; ++m) { const int t = t0 + ai * HALF + m * 16;
#pragma unroll
                    for (int bj = 0; bj < 2; ++bj) { const f32x4 ya = acc[ai][bj][m][0], yb = acc[ai][bj][m][1];
                        u32x4 w; w.x = pk2(ya[0], ya[1]); w.y = pk2(ya[2], ya[3]); w.z = pk2(yb[0], yb[1]); w.w = pk2(yb[2], yb[3]);
                        const int hd = 4 * (pn - 9) + 2 * bj + (wc >> 1);
                        *(u32x4*)(dst + (((size_t)b * 8 + hd) * SEQ + t) * 64 + d0) = w; }
                    asm volatile("" ::: "memory"); }
        } else {
            if (wc == 0 && fq < 3) {
                float* gt = (float*)(ws + WS_GATES);
#pragma unroll
                for (int ai = 0; ai < 2; ++ai)
#pragma unroll
                    for (int m = 0; m < 4; ++m) { const size_t tok = (size_t)tok0 + wr * 64 + fr + ai * HALF + m * 16; const f32x4 ya = acc[ai][0][m][0], yb = acc[ai][0][m][1]; f32x4 sa, sb;
#pragma unroll
                        for (int i = 0; i < 4; ++i) { sa[i] = 1.f / (1.f + __expf(-ya[i])); sb[i] = 1.f / (1.f + __expf(-yb[i])); }
                        *(f32x4*)(gt + tok * 24 + 8 * fq) = sa; *(f32x4*)(gt + tok * 24 + 8 * fq + 4) = sb; }
            }
        }
    }
};
struct EpiSwiglu {
    static constexpr bool PERM = true;
    unsigned char* O;
    DI void operator()(const f32x4 (&acc)[2][2][4][2], const Unit& u, int wr, int wc, int fr, int fq) const {
        asm volatile("" : "+v"(fr), "+v"(fq));
        const int row0 = u.pm * BM + wr * 64 + fr; const int col0 = u.pn * 128 + wc * 16 + 4 * fq;
#pragma unroll
        for (int ai = 0; ai < 2; ++ai)
#pragma unroll
            for (int m = 0; m < 4; ++m) { unsigned char* rowp = O + (size_t)(row0 + ai * HALF + m * 16) * EHID + col0;
#pragma unroll
                for (int bj = 0; bj < 2; ++bj) { const f32x4 g = acc[ai][bj][m][0], up = acc[ai][bj][m][1]; float h[4];
#pragma unroll
                    for (int i = 0; i < 4; ++i) { const float s = fast_rcp(1.f + __expf(-g[i])); h[i] = g[i] * s * up[i]; }
                    *(unsigned*)(rowp + bj * 64) = pk4_fp8(h[0], h[1], h[2], h[3]); } }
    }
};
struct EpiOutProj {
    static constexpr bool PERM = true;
    const float* x; bf16_t* x1b; const float* mod; float* rowss;
    DI void operator()(const f32x4 (&acc)[2][2][4][2], const Unit& u, int wr, int wc, int fr, int fq) const {
        const int col0 = u.pn * BM + wc * 32 + 8 * fq; const int b = (u.pm * BM) / SEQ;
        const float* g1 = mod + (size_t)b * 6144 + 2048 + col0;
        f32x4 gv[2][2];
#pragma unroll
        for (int bj = 0; bj < 2; ++bj)
#pragma unroll
            for (int n = 0; n < 2; ++n) gv[bj][n] = *(const f32x4*)(g1 + bj * HALF + n * 4);
#pragma unroll
        for (int ai = 0; ai < 2; ++ai)
#pragma unroll
            for (int m = 0; m < 4; ++m) { const int r = u.pm * BM + ai * HALF + wr * 64 + m * 16 + fr; const size_t off = (size_t)r * DM + col0; float ss = 0.f;
#pragma unroll
                for (int bj = 0; bj < 2; ++bj) { const f32x4 xa = *(const f32x4*)(x + off + bj * HALF), xb = *(const f32x4*)(x + off + bj * HALF + 4);
                    const f32x4 oa = xa + gv[bj][0] * acc[ai][bj][m][0], ob = xb + gv[bj][1] * acc[ai][bj][m][1];
                    ss += (oa[0] * oa[0] + oa[1] * oa[1]) + (oa[2] * oa[2] + oa[3] * oa[3]) + (ob[0] * ob[0] + ob[1] * ob[1]) + (ob[2] * ob[2] + ob[3] * ob[3]);
                    u32x4 w; w.x = pk2(oa[0], oa[1]); w.y = pk2(oa[2], oa[3]); w.z = pk2(ob[0], ob[1]); w.w = pk2(ob[2], ob[3]);
                    *(u32x4*)(x1b + off + bj * HALF) = w; }
                ss += __shfl_xor(ss, 16); ss += __shfl_xor(ss, 32);
                if (fq == 0) rowss[(size_t)r * 16 + u.pn * 4 + wc] = ss; }
    }
};
}

struct Frame {
    LAS unsigned char* lds; unsigned char* ws; const float* const* in; float* out;
    int tid, lane, wave, bid, G, gw, NGW;
};

DI int origcol(int n) { return n < 1280 ? n : (n < 2816 ? n + 24 : (n < 2840 ? n - 2816 + 1280 : -1)); }

template <class DRow>
DI void tr_item(const float* src, int src_ld, int sc  , bf16_t* dst, int dst_ld, int k0, LAS float* scr, int lane, DRow drow) {
#pragma unroll 8
    for (int i = 0; i < 32; ++i) { const int kk = 2 * i + (lane >> 5); scr[kk * 33 + (lane & 31)] = sc >= 0 ? src[(size_t)(k0 + kk) * src_ld + sc] : 0.f; }
    asm volatile("s_waitcnt lgkmcnt(0)" ::: "memory");
    const int c = lane & 7;
#pragma unroll
    for (int j = 0; j < 4; ++j) { const int n = (lane >> 3) + 8 * j; const LAS float* s = scr + (8 * c) * 33 + n;
        u32x4 o; o.x = pk2(s[0 * 33], s[1 * 33]); o.y = pk2(s[2 * 33], s[3 * 33]); o.z = pk2(s[4 * 33], s[5 * 33]); o.w = pk2(s[6 * 33], s[7 * 33]);
        *(u32x4*)(dst + (size_t)drow(n) * dst_ld + k0 + 8 * c) = o; }
    asm volatile("s_waitcnt lgkmcnt(0)" ::: "memory");
}

DI void phase0(Frame& F) {
    const float* c_in = F.in[1]; const float* w_ada = F.in[2]; const float* b_ada = F.in[3];
    float* mod = (float*)(F.ws + WS_MOD);
    for (int it = F.bid; it < 96; it += F.G) {
        LAS float* cs = (LAS float*)F.lds;
        for (int idx = F.tid; idx < 32 * 1024; idx += NTHREADS) { const int b = idx >> 10, k = idx & 1023; cs[k * 32 + b] = c_in[idx]; }
        __syncthreads();
        float acc[32];
#pragma unroll
        for (int b = 0; b < 32; ++b) acc[b] = 0.f;
        const int j = it * 64 + F.lane;
#pragma unroll 1
        for (int kg = 0; kg < 4; ++kg) {
            float wv[32];
#pragma unroll
            for (int q = 0; q < 32; ++q) wv[q] = w_ada[(size_t)(F.wave * 128 + kg * 32 + q) * 6144 + j];
#pragma unroll
            for (int q = 0; q < 32; ++q) { const int k = F.wave * 128 + kg * 32 + q; const float w = wv[q];
#pragma unroll
                for (int b4 = 0; b4 < 8; ++b4) { const f32x4 cv = *(const LAS f32x4*)(cs + k * 32 + b4 * 4); acc[b4 * 4 + 0] += cv[0] * w; acc[b4 * 4 + 1] += cv[1] * w; acc[b4 * 4 + 2] += cv[2] * w; acc[b4 * 4 + 3] += cv[3] * w; } }
        }
        __syncthreads();
        LAS float* red = (LAS float*)F.lds;
#pragma unroll
        for (int b = 0; b < 32; ++b) red[(F.wave * 32 + b) * 64 + F.lane] = acc[b];
        __syncthreads();
        for (int o = F.tid; o < 2048; o += NTHREADS) { const int b = o >> 6, l = o & 63; float s = b_ada[it * 64 + l];
#pragma unroll
            for (int w = 0; w < 8; ++w) s += red[(w * 32 + b) * 64 + l];
            mod[(size_t)b * 6144 + it * 64 + l] = s; }
        __syncthreads();
    }
    const int gt = F.bid * NTHREADS + F.tid, NGT = F.G * NTHREADS;
    { float* ropeN = (float*)(F.ws + WS_ROPE); float* ropeD = ropeN + 2048 * 16;
      for (int i = gt; i < 2048 * 12; i += NGT) { const int t = i / 12, j = i % 12; const bool isn = j < 8; const int ii = isn ? j : j - 8;
          const float ex = isn ? (float)(2 * ii) / 16.f : (float)(2 * ii) / 8.f;
          const float inv = exp2f(-ex * 18.931568569324174f);
          const float ang = (float)t * inv;
          const double rev = (double)ang * 0.15915494309189535; const double fr = rev - __builtin_rint(rev); const float rr = (float)(fr * 6.283185307179586);
          const float cs = __cosf(rr), sn = __sinf(rr);
          if (isn) { ropeN[(t * 8 + ii) * 2] = cs; ropeN[(t * 8 + ii) * 2 + 1] = sn; } else { ropeD[(t * 4 + ii) * 2] = cs; ropeD[(t * 4 + ii) * 2 + 1] = sn; } } }
    { bf16_t* whi = (bf16_t*)(F.ws + WS_WR); bf16_t* wlo = whi + 48 * 1024;
      for (int i = gt; i < 48 * 1024; i += NGT) { const int c = i >> 10, k = i & 1023; float w = 0.f;
          if (c < 4) w = F.in[20][k * 4 + c]; else if (c < 36) w = F.in[22][k * 32 + (c - 4)];
          const unsigned short h = f2bf(w); whi[i] = h; wlo[i] = f2bf(w - bf2f(h)); } }
    { bf16_t* pe = (bf16_t*)(F.ws + WS_PE);
      for (int i = gt; i < 256 * 1024; i += NGT) { const int r = i >> 10, k = i & 1023; float v = 0.f; if (r < 4) v = F.in[9][(r >> 1) * 2048 + (r & 1) * 1024 + k]; pe[i] = f2bf(v); } }
    { u32x4* l4 = (u32x4*)(F.ws + WS_LIST); for (int i = gt; i < (int)(NEXP * ECAP / 4); i += NGT) l4[i] = (u32x4){0u, 0u, 0u, 0u};
      unsigned* ctl = (unsigned*)(F.ws + WS_CTL); for (int i = gt; i < 8192; i += NGT) ctl[i] = 0u; }
}

struct TrD { const float* src; int ld; int sc; bf16_t* dst; int dld; int k0; int mode; int n0; int aux; int fp8; };
DI TrD tr_desc(Frame& F, int it, int lane) {
    constexpr int I_IN = 16 * 96, I_OUT = 16 * 32, I_G = 32 * 16 * 16, I_D = 32 * 8 * 32;
    TrD d; int r = it; const int nq = lane & 7;
    if (r < I_IN) { const int kb = r / 96, nb = r % 96; d.n0 = nb * 32; const int n = d.n0 + 4 * nq; d.src = F.in[6]; d.ld = INCOLS; d.sc = origcol(n); d.dst = (bf16_t*)(F.ws + WS_WIN); d.dld = 1024; d.k0 = kb * 64; d.mode = 0; d.aux = 0; d.fp8 = 0; return d; }
    r -= I_IN;
    if (r < I_OUT) { const int kb = r / 32, nb = r % 32; d.n0 = nb * 32; d.src = F.in[19]; d.ld = 1024; d.sc = d.n0 + 4 * nq; d.dst = (bf16_t*)(F.ws + WS_WOUT); d.dld = 1024; d.k0 = kb * 64; d.mode = 0; d.aux = 0; d.fp8 = 0; return d; }
    r -= I_OUT;
    if (r < 2 * I_G) { const int up = r / I_G; r -= up * I_G; const int e = r / 256, q = r % 256, kb = q / 16, nb = q % 16; d.n0 = nb * 32;
        d.src = F.in[24 + up] + (size_t)e * 1024 * 512; d.ld = 512; d.sc = d.n0 + 4 * nq; d.dst = (bf16_t*)(F.ws + WS_WGU + (size_t)e * 1024 * 1024); d.dld = 1024; d.k0 = kb * 64; d.mode = 1; d.aux = up; d.fp8 = 1; return d; }
    r -= 2 * I_G;
    if (r < I_D) { const int e = r / 256, q = r % 256, kb = q / 32, nb = q % 32; d.n0 = nb * 32;
        d.src = F.in[26] + (size_t)e * 512 * 1024; d.ld = 1024; d.sc = d.n0 + 4 * nq; d.dst = (bf16_t*)(F.ws + WS_WD + (size_t)e * 1024 * 512); d.dld = 512; d.k0 = kb * 64; d.mode = 0; d.aux = 0; d.fp8 = 1; return d; }
    r -= I_D;
    { const int kvh = r / 128, q = r % 128, kb = q / 8, nb = q % 8; d.n0 = nb * 32; const int kv = kvh >> 1, half = kvh & 1;
      d.src = F.in[10] + (size_t)kv * 2048 * 256 + (size_t)half * 1024 * 256; d.ld = 256; d.sc = d.n0 + 4 * nq; d.dst = (bf16_t*)(F.ws + WS_WC1) + (size_t)kv * 512 * 1024; d.dld = 1024; d.k0 = kb * 64; d.mode = 2; d.aux = half; d.fp8 = 0; return d; }
}
DI void tr_load(const TrD& d, f32x4 (&v)[8], int lane) {
    const int kk = lane >> 3;
#pragma unroll
    for (int i = 0; i < 8; ++i) v[i] = d.sc >= 0 ? *(const f32x4*)(d.src + (size_t)(d.k0 + kk + 8 * i) * d.ld + d.sc) : (f32x4){0.f, 0.f, 0.f, 0.f};
}
DI void tr_finish(const TrD& d, const f32x4 (&v)[8], LAS float* scr, int lane) {
    const int kk = lane >> 3, nq = lane & 7;
#pragma unroll
    for (int i = 0; i < 8; ++i) *(LAS f32x4*)(scr + (kk + 8 * i) * 36 + 4 * nq) = v[i];
    asm volatile("s_waitcnt lgkmcnt(0)" ::: "memory");
    const int c = lane & 7;
#pragma unroll
    for (int j = 0; j < 4; ++j) { const int n = (lane >> 3) + 8 * j; const LAS float* s = scr + (8 * c) * 36 + n;
        const int jn = d.n0 + n; const int row = d.mode == 0 ? jn : (d.mode == 1 ? 8 * (jn >> 2) + (jn & 3) + 4 * d.aux : d.aux * 256 + jn);
        if (d.fp8) { u32x2 o8; o8.x = pk4_fp8(s[0 * 36] * 256.f, s[1 * 36] * 256.f, s[2 * 36] * 256.f, s[3 * 36] * 256.f); o8.y = pk4_fp8(s[4 * 36] * 256.f, s[5 * 36] * 256.f, s[6 * 36] * 256.f, s[7 * 36] * 256.f);
            *(u32x2*)((unsigned char*)d.dst + (size_t)row * d.dld + d.k0 + 8 * c) = o8; }
        else { u32x4 o; o.x = pk2(s[0 * 36], s[1 * 36]); o.y = pk2(s[2 * 36], s[3 * 36]); o.z = pk2(s[4 * 36], s[5 * 36]); o.w = pk2(s[6 * 36], s[7 * 36]);
            *(u32x4*)(d.dst + (size_t)row * d.dld + d.k0 + 8 * c) = o; } }
    asm volatile("s_waitcnt lgkmcnt(0)" ::: "memory");
}
DI void phase0_weights(Frame& F) {
    LAS float* scr = (LAS float*)(F.lds + F.wave * 16384);
    const int lane = F.lane;
    constexpr int NITEMS = 16 * 96 + 16 * 32 + 2 * (32 * 16 * 16) + 32 * 8 * 32 + 4 * 16 * 8;
    int it = F.gw; if (it >= NITEMS) return;
    TrD cur = tr_desc(F, it, lane); f32x4 vc[8]; tr_load(cur, vc, lane);
    for (;;) {
        const int nit = it + F.NGW; const bool more = nit < NITEMS;
        TrD nxt = cur; f32x4 vn[8];
        if (more) { nxt = tr_desc(F, nit, lane); tr_load(nxt, vn, lane); }
        tr_finish(cur, vc, scr, lane);
        if (!more) break;
        cur = nxt; it = nit;
#pragma unroll
        for (int i = 0; i < 8; ++i) vc[i] = vn[i];
    }
}

DI void phase1(Frame& F) {
    const float* x = F.in[0]; const float* g = F.in[4]; const float* mod = (const float*)(F.ws + WS_MOD); bf16_t* h1 = (bf16_t*)(F.ws + WS_H1);
    const int lane = F.lane;
    for (int m0 = F.gw * 32; m0 < TOK; m0 += F.NGW * 32) {
        const int b = m0 >> 11; const float* sh = mod + (size_t)b * 6144; const float* sc = sh + 1024;
        f32x4 A[4], Bv[4];
#pragma unroll
        for (int j = 0; j < 4; ++j) { const int col = 4 * lane + 256 * j; A[j] = *(const f32x4*)(g + col) * (*(const f32x4*)(sc + col) + 1.f); Bv[j] = *(const f32x4*)(sh + col); }
        const f32x4* xr = (const f32x4*)(x + (size_t)m0 * DM) + lane; u32x2* o8 = (u32x2*)(h1 + (size_t)m0 * DM) + lane;
        f32x4 v0[4], v1[4];
#pragma unroll
        for (int j = 0; j < 4; ++j) { v0[j] = xr[64 * j]; v1[j] = xr[256 + 64 * j]; }
        for (int i = 0; i < 32; i += 2) {
            f32x4 n0[4], n1[4];
            if (i + 2 < 32) {
#pragma unroll
                for (int j = 0; j < 4; ++j) { n0[j] = xr[(size_t)(i + 2) * 256 + 64 * j]; n1[j] = xr[(size_t)(i + 3) * 256 + 64 * j]; }
            }
            float s0 = 0.f, s1 = 0.f;
#pragma unroll
            for (int j = 0; j < 4; ++j) { s0 += (v0[j][0] * v0[j][0] + v0[j][1] * v0[j][1]) + (v0[j][2] * v0[j][2] + v0[j][3] * v0[j][3]); s1 += (v1[j][0] * v1[j][0] + v1[j][1] * v1[j][1]) + (v1[j][2] * v1[j][2] + v1[j][3] * v1[j][3]); }
#pragma unroll
            for (int o = 1; o < 64; o <<= 1) { s0 += __shfl_xor(s0, o); s1 += __shfl_xor(s1, o); }
            const float r0 = rsqrtf(s0 * (1.f / DM) + EPS), r1 = rsqrtf(s1 * (1.f / DM) + EPS);
#pragma unroll
            for (int j = 0; j < 4; ++j) { const f32x4 y0 = v0[j] * r0 * A[j] + Bv[j], y1 = v1[j] * r1 * A[j] + Bv[j];
                u32x2 w0, w1; w0.x = pk2(y0[0], y0[1]); w0.y = pk2(y0[2], y0[3]); w1.x = pk2(y1[0], y1[1]); w1.y = pk2(y1[2], y1[3]);
                o8[(size_t)i * 256 + 64 * j] = w0; o8[(size_t)(i + 1) * 256 + 64 * j] = w1; }
#pragma unroll
            for (int j = 0; j < 4; ++j) { v0[j] = n0[j]; v1[j] = n1[j]; }
        }
    }
}

DI void phase3(Frame& F) {
    const bf16_t* proj = (const bf16_t*)(F.ws + WS_PROJ);
    const float* ropeN = (const float*)(F.ws + WS_ROPE); const float* ropeD = ropeN + 2048 * 16;
    const float* g_nq = F.in[7]; const float* g_nk = F.in[8]; const float* g_dq = F.in[12]; const float* g_dk = F.in[13];
    const int lane = F.lane;
    for (int it = F.gw; it < TOK * 6; it += F.NGW) {
        const int m = it / 6, part = it % 6; const int b = m >> 11, t = m & 2047;
        const int c0 = part * 512 + lane * 8;
        const u32x4 raw = *(const u32x4*)(proj + (size_t)m * NPROJ + c0);
        float v[8]; v[0] = bflo(raw.x); v[1] = bfhi(raw.x); v[2] = bflo(raw.y); v[3] = bfhi(raw.y); v[4] = bflo(raw.z); v[5] = bfhi(raw.z); v[6] = bflo(raw.w); v[7] = bfhi(raw.w);
        float ss = 0.f;
#pragma unroll
        for (int i = 0; i < 8; ++i) ss += v[i] * v[i];
        ss += __shfl_xor(ss, 1); ss += __shfl_xor(ss, 2); const float ss32 = ss; ss += __shfl_xor(ss, 4); const float ss64 = ss;
        float pv[8];
#pragma unroll
        for (int i = 0; i < 8; ++i) pv[i] = __shfl_xor(v[i], 1);
        if (c0 < 1280) {
            const bool isq = c0 < 512; int six = 0, gsel = 0, d0;
            if (isq) { d0 = c0 & 63; } else { const int cc = c0 - 512; six = cc >> 7; gsel = (cc >> 6) & 1; d0 = cc & 63; }
            const bool donorm = isq || six == 2 || six == 4;
            float y[8];
            if (donorm) { const float* gg = isq ? g_nq : (g_nk + (six == 2 ? 64 : 128)); const float rstd = rsqrtf(ss64 * (1.f / 64.f) + EPS);
#pragma unroll
                for (int i = 0; i < 8; ++i) { y[i] = v[i] * rstd * gg[d0 + i]; pv[i] = pv[i] * rstd * gg[(d0 ^ 8) + i]; } }
            else {
#pragma unroll
                for (int i = 0; i < 8; ++i) y[i] = v[i]; }
            float yr[8];
#pragma unroll
            for (int i = 0; i < 8; ++i) yr[i] = y[i];
            if (donorm && d0 < 16) {
#pragma unroll
                for (int i = 0; i < 8; ++i) { const float cs = ropeN[(t * 8 + i) * 2], sn = ropeN[(t * 8 + i) * 2 + 1];
                    yr[i] = d0 == 0 ? (y[i] * cs - pv[i] * sn) : (pv[i] * sn + y[i] * cs); }
            }
            u32x4 w0, w1; w0.x = pk2(y[0], y[1]); w0.y = pk2(y[2], y[3]); w0.z = pk2(y[4], y[5]); w0.w = pk2(y[6], y[7]);
            w1.x = pk2(yr[0], yr[1]); w1.y = pk2(yr[2], yr[3]); w1.z = pk2(yr[4], yr[5]); w1.w = pk2(yr[6], yr[7]);
            if (isq) { const int hd = c0 >> 6; const size_t off = (((size_t)b * 8 + hd) * SEQ + t) * 64 + d0;
                *(u32x4*)((bf16_t*)(F.ws + WS_QN) + off) = w0; *(u32x4*)((bf16_t*)(F.ws + WS_QR) + off) = w1; }
            else { const size_t base = six == 0 ? WS_KC : six == 1 ? WS_VC : six == 2 ? WS_KS : six == 3 ? WS_VS : six == 4 ? WS_KW : WS_VW;
                const size_t off = (((size_t)b * 2 + gsel) * SEQ + t) * 64 + d0;
                *(u32x4*)((bf16_t*)(F.ws + base) + off) = donorm ? w1 : w0; }
        } else if (c0 < 2304) {
            const bool isq = c0 < 1792; const int cc = c0 - (isq ? 1280 : 1792); const int hd = cc >> 6, dd = cc & 63, d0 = dd & 31;
            const float* gg = isq ? g_dq : g_dk; const float rstd = rsqrtf(ss32 * (1.f / 32.f) + EPS);
            float y[8];
#pragma unroll
            for (int i = 0; i < 8; ++i) y[i] = v[i] * rstd * gg[d0 + i];
            if (d0 == 0) {
#pragma unroll
                for (int i = 0; i < 4; ++i) { const float cs = ropeD[(t * 4 + i) * 2], sn = ropeD[(t * 4 + i) * 2 + 1]; const float a = y[i], bb = y[i + 4]; y[i] = a * cs - bb * sn; y[i + 4] = a * sn + bb * cs; }
            }
            u32x4 w; w.x = pk2(y[0], y[1]); w.y = pk2(y[2], y[3]); w.z = pk2(y[4], y[5]); w.w = pk2(y[6], y[7]);
            const size_t off = (((size_t)b * 8 + hd) * SEQ + t) * 64 + dd;
            *(u32x4*)((bf16_t*)(F.ws + (isq ? WS_DQ : WS_DK)) + off) = w;
        } else if (c0 < 2816) {
            const int cc = c0 - 2304; const int hd = cc >> 6, dd = cc & 63; const size_t off = (((size_t)b * 8 + hd) * SEQ + t) * 64 + dd;
            *(u32x4*)((bf16_t*)(F.ws + WS_DV) + off) = raw;
        } else if (c0 < 2840) {
            float* gt = (float*)(F.ws + WS_GATES) + (size_t)m * 24 + (c0 - 2816);
#pragma unroll
            for (int i = 0; i < 8; ++i) gt[i] = 1.f / (1.f + __expf(-v[i]));
        }
    }
}

DI void glds16(const void* gsrc, unsigned lds_dst) { unsigned keep;
    asm volatile("s_mov_b32 %0, m0\n\ts_mov_b32 m0, %2\n\ts_nop 0\n\tglobal_load_lds_dwordx4 %1, off\n\ts_mov_b32 m0, %0" : "=&s"(keep) : "v"(gsrc), "s"(lds_dst) : "memory"); }
DI unsigned lds_addr(const LAS void* p) { return (unsigned)(uintptr_t)p; }
struct ALane { int k0; int v0; DI int ko(int ks) const { return k0 ^ (ks << 5); } DI int vo(int db) const { return v0 ^ (db << 6); } };
DI ALane alane_init(int lane) {
    ALane L; const int r = lane & 31, hh = lane >> 5, g = lane >> 4, i = lane & 15;
    L.k0 = r * 128 + ((hh ^ ((r >> 1) & 7)) << 4);
    const int rl = 4 * hh + (i >> 2); const int ch = 2 * (g & 1) + ((i & 3) >> 1);
    L.v0 = rl * 128 + ((ch ^ (((rl >> 1) & 1) << 2)) << 4) + 8 * (i & 1);
    return L;
}
DI s16x4 vtr(const LAS char* p) { typedef short v4i16 __attribute__((ext_vector_type(4))); return __builtin_bit_cast(s16x4, __builtin_amdgcn_ds_read_tr16_b64_v4i16((LAS v4i16*)p)); }
DI bf16x8 vfrag(const LAS char* Vt, const ALane& L, int db, int kb, int s) {
    const LAS char* p = Vt + L.vo(db) + (32 * kb + 16 * s) * 128;
    const s16x4 lo = vtr(p), hi = vtr(p + 8 * 128);
    return __builtin_shufflevector(lo, hi, 0, 1, 2, 3, 4, 5, 6, 7);
}
DI bf16x8 pfrag(const f32x16& p, int s) { u32x4 w; w.x = pk2(p[8 * s + 0], p[8 * s + 1]); w.y = pk2(p[8 * s + 2], p[8 * s + 3]); w.z = pk2(p[8 * s + 4], p[8 * s + 5]); w.w = pk2(p[8 * s + 6], p[8 * s + 7]); return __builtin_bit_cast(bf16x8, w); }
DI u32x4 tile_ld(const bf16_t* g, int tid) { return *(const u32x4*)(g + tid * 8); }
DI void tile_st_k(LAS char* Kt, u32x4 v, int tid) { const int row = tid >> 3, ch = tid & 7; *(LAS u32x4*)(Kt + row * 128 + ((ch ^ ((row >> 1) & 7)) << 4)) = v; }
DI void tile_st_v(LAS char* Vt, u32x4 v, int tid) { const int row = tid >> 3, ch = tid & 7; *(LAS u32x4*)(Vt + row * 128 + ((ch ^ (((row >> 1) & 1) << 2)) << 4)) = v; }

constexpr int MK_NONE = 0, MK_LE = 1, MK_GT = 2;
template <int MASK>
DI void sm16(f32x16& a, float c2, float mcl, int kb, int hh, int th) {
    if constexpr (MASK != MK_NONE) asm volatile("" : "+v"(th));
#pragma unroll
    for (int i = 0; i < 16; ++i) {
        float x = __builtin_fmaf(a[i], c2, -mcl);
        if constexpr (MASK != MK_NONE) { const int kl = 32 * kb + crow(i, hh); const bool ok = MASK == MK_LE ? (kl <= th) : (kl > th); x = ok ? x : -1.0e30f; }
        a[i] = fast_exp2(x);
    }
}
DI float sum16(const f32x16& a) { return ((a[0] + a[1]) + (a[2] + a[3])) + ((a[4] + a[5]) + (a[6] + a[7])) + ((a[8] + a[9]) + (a[10] + a[11])) + ((a[12] + a[13]) + (a[14] + a[15])); }
#define SCHED_FENCE() do { } while (0)
template <int MASK, bool KEEPP>
DI void attn_tile64(const LAS char* Kt, const LAS char* Vt, const ALane& L, const bf16x8 (&qf)[4], f32x16 (&O)[2], float& lsum, float c2, float mcl, int th, int hh, f32x16 (&P)[2]) {
    bf16x8 kf[2][4];
#pragma unroll
    for (int kb = 0; kb < 2; ++kb)
#pragma unroll
        for (int ks = 0; ks < 4; ++ks) kf[kb][ks] = *(const LAS bf16x8*)(Kt + L.ko(ks) + kb * 4096);
    SCHED_FENCE();
    f32x16 a0 = {0.f, 0.f, 0.f, 0.f, 0.f, 0.f, 0.f, 0.f, 0.f, 0.f, 0.f, 0.f, 0.f, 0.f, 0.f, 0.f}, a1 = a0;
#pragma unroll
    for (int ks = 0; ks < 4; ++ks) a0 = MFMA32(kf[0][ks], qf[ks], a0);
#pragma unroll
    for (int ks = 0; ks < 4; ++ks) a1 = MFMA32(kf[1][ks], qf[ks], a1);
    bf16x8 v0[2][2], v1[2][2];
#pragma unroll
    for (int s = 0; s < 2; ++s)
#pragma unroll
        for (int db = 0; db < 2; ++db) v0[s][db] = vfrag(Vt, L, db, 0, s);
    SCHED_FENCE();
    bf16x8 pf[2][2];
    sm16<MASK>(a0, c2, mcl, 0, hh, th); lsum += sum16(a0); pf[0][0] = pfrag(a0, 0); pf[0][1] = pfrag(a0, 1);
    if constexpr (KEEPP) P[0] = a0;
#pragma unroll
    for (int s = 0; s < 2; ++s)
#pragma unroll
        for (int db = 0; db < 2; ++db) v1[s][db] = vfrag(Vt, L, db, 1, s);
    SCHED_FENCE();
    sm16<MASK>(a1, c2, mcl, 1, hh, th); lsum += sum16(a1); pf[1][0] = pfrag(a1, 0); pf[1][1] = pfrag(a1, 1);
    if constexpr (KEEPP) P[1] = a1;
    SCHED_FENCE();
#pragma unroll
    for (int s = 0; s < 2; ++s)
#pragma unroll
        for (int db = 0; db < 2; ++db) O[db] = MFMA32(v0[s][db], pf[0][s], O[db]);
#pragma unroll
    for (int s = 0; s < 2; ++s)
#pragma unroll
        for (int db = 0; db < 2; ++db) O[db] = MFMA32(v1[s][db], pf[1][s], O[db]);
    SCHED_FENCE();
}
template <int MASK>
DI void attn_tile_dm(const LAS char* Kt, const LAS char* Vt, const ALane& L, int ko0, int ko1, const bf16x8 (&qf)[2], f32x16 (&O)[2], float& lsum, float c2, float mc, int th, int hh) {
    const bf16x8 k00 = *(const LAS bf16x8*)(Kt + ko0), k01 = *(const LAS bf16x8*)(Kt + ko1), k10 = *(const LAS bf16x8*)(Kt + ko0 + 4096), k11 = *(const LAS bf16x8*)(Kt + ko1 + 4096);
    SCHED_FENCE();
    f32x16 a0 = {0.f, 0.f, 0.f, 0.f, 0.f, 0.f, 0.f, 0.f, 0.f, 0.f, 0.f, 0.f, 0.f, 0.f, 0.f, 0.f}, a1 = a0;
    a0 = MFMA32(k00, qf[0], a0); a0 = MFMA32(k01, qf[1], a0); a1 = MFMA32(k10, qf[0], a1); a1 = MFMA32(k11, qf[1], a1);
    bf16x8 vf[2][2][2];
#pragma unroll
    for (int kb = 0; kb < 2; ++kb)
#pragma unroll
        for (int s = 0; s < 2; ++s)
#pragma unroll
            for (int db = 0; db < 2; ++db) vf[kb][s][db] = vfrag(Vt, L, db, kb, s);
    SCHED_FENCE();
    bf16x8 pf[2][2];
    sm16<MASK>(a0, c2, mc, 0, hh, th); lsum += sum16(a0); pf[0][0] = pfrag(a0, 0); pf[0][1] = pfrag(a0, 1);
    sm16<MASK>(a1, c2, mc, 1, hh, th); lsum += sum16(a1); pf[1][0] = pfrag(a1, 0); pf[1][1] = pfrag(a1, 1);
    SCHED_FENCE();
#pragma unroll
    for (int kb = 0; kb < 2; ++kb)
#pragma unroll
        for (int s = 0; s < 2; ++s)
#pragma unroll
            for (int db = 0; db < 2; ++db) O[db] = MFMA32(vf[kb][s][db], pf[kb][s], O[db]);
    SCHED_FENCE();
}
#define RING_WAIT(n) asm volatile("s_waitcnt vmcnt(" #n ")" ::: "memory")
template <class PreF, class CompF>
DI void attn_ring(LAS char* lds, const bf16_t* Kg, const bf16_t* Vg, unsigned tiles, int wid, int lane, PreF pre, CompF comp) {
    if (tiles == 0u) return;
    const int p = wid * 64 + lane, row = p >> 3, c = p & 7;
    const unsigned ksrc = (unsigned)(row * 128 + ((c ^ ((row >> 1) & 7)) << 4)), vsrc = (unsigned)(row * 128 + ((c ^ (((row >> 1) & 1) << 2)) << 4));
    LAS char* wb = lds + wid * 1024;
#define RING_ISSUE(j, slot) do { \
        glds16((const char*)(Kg) + (size_t)(j) * 8192 + ksrc, (unsigned)__builtin_amdgcn_readfirstlane((int)(lds_addr(wb) + (unsigned)(slot) * 16384u))); \
        glds16((const char*)(Vg) + (size_t)(j) * 8192 + vsrc, (unsigned)__builtin_amdgcn_readfirstlane((int)(lds_addr(wb) + (unsigned)(slot) * 16384u + 8192u))); } while (0)
    int q0 = __builtin_ctz(tiles); tiles &= tiles - 1u;
    int q1 = -1, q2 = -1;
    if (tiles) { q1 = __builtin_ctz(tiles); tiles &= tiles - 1u; }
    if (tiles) { q2 = __builtin_ctz(tiles); tiles &= tiles - 1u; }
    RING_ISSUE(q0, 0);
    if (q1 >= 0) RING_ISSUE(q1, 1);
    if (q2 >= 0) RING_ISSUE(q2, 2);
    pre();
    int i = 0;
    for (;;) {
        if (q2 >= 0) RING_WAIT(4); else if (q1 >= 0) RING_WAIT(2); else RING_WAIT(0);
        __builtin_amdgcn_s_barrier();
        int q3 = -1;
        if (tiles) { q3 = __builtin_ctz(tiles); tiles &= tiles - 1u; RING_ISSUE(q3, (i + 3) & 3); }
        LAS char* st = lds + (i & 3) * 16384;
        comp(q0, st, st + 8192);
        if (q1 < 0) break;
        q0 = q1; q1 = q2; q2 = q3; ++i;
    }
    asm volatile("s_waitcnt lgkmcnt(0)" ::: "memory");
    __builtin_amdgcn_s_barrier();
#undef RING_ISSUE
}

DI void diff_unit(Frame& F, int b, int hd, int qb, float c2, float mc, float lam) {
    const int tid = F.tid, lane = F.lane, wid = F.wave, r = lane & 31, hh = lane >> 5;
    const int rb = wid >> 1, mp = wid & 1;
    const bf16_t* Q = (const bf16_t*)(F.ws + WS_DQ) + ((size_t)b * 8 + hd) * SEQ * 64;
    const bf16_t* Kg = (const bf16_t*)(F.ws + WS_DK) + ((size_t)b * 8 + hd) * SEQ * 64;
    const bf16_t* Vg = (const bf16_t*)(F.ws + WS_DV) + ((size_t)b * 8 + hd) * SEQ * 64;
    LAS char* lds = (LAS char*)F.lds;
    const ALane L = alane_init(lane);
    const int ko0 = L.ko(2 * mp), ko1 = L.ko(2 * mp + 1);
    const int q0w = qb * 128 + rb * 32; const int qq = q0w + r;
    bf16x8 qf[2];
#pragma unroll
    for (int ks = 0; ks < 2; ++ks) qf[ks] = *(const bf16x8*)(Q + (size_t)qq * 64 + mp * 32 + ks * 16 + hh * 8);
    f32x16 O[2]; float lsum = 0.f;
#pragma unroll
    for (int i = 0; i < 16; ++i) { O[0][i] = 0.f; O[1][i] = 0.f; }
    const int ntile = 2 * qb + 2; const int jmax = 2 * qb + (rb >> 1);
    const unsigned tiles = ntile == 32 ? 0xffffffffu : ((1u << ntile) - 1u);
    attn_ring(lds, Kg, Vg, tiles, wid, lane, [&]() __attribute__((always_inline)) { asm volatile("" : "+v"(qf[0]), "+v"(qf[1])); },
        [&](int j, const LAS char* Kt, const LAS char* Vt) __attribute__((always_inline)) {
        if (j < jmax) attn_tile_dm<MK_NONE>(Kt, Vt, L, ko0, ko1, qf, O, lsum, c2, mc, 0, hh);
        else if (j == jmax) attn_tile_dm<MK_LE>(Kt, Vt, L, ko0, ko1, qf, O, lsum, c2, mc, qq - 64 * j, hh);
    });
    lsum += __shfl_xor(lsum, 32);
    LAS float* xo = (LAS float*)(lds + 65536 + rb * 8192) + lane;
    if (mp == 1) { const float s1 = lam / lsum;
#pragma unroll
        for (int db = 0; db < 2; ++db)
#pragma unroll
            for (int i = 0; i < 16; ++i) xo[(db * 16 + i) * 64] = O[db][i] * s1; }
    __syncthreads();
    if (mp == 0) {
        const float i0 = 1.f / lsum; float ss = 0.f;
#pragma unroll
        for (int db = 0; db < 2; ++db)
#pragma unroll
            for (int i = 0; i < 16; ++i) { const float o = O[db][i] * i0 - xo[(db * 16 + i) * 64]; O[db][i] = o; ss += o * o; }
        ss += __shfl_xor(ss, 32);
        const float rstd = rsqrtf(ss * (1.f / 64.f) + EPS) * 0.8f;
        const float* go = F.in[18];
        bf16_t* orow = (bf16_t*)(F.ws + WS_AO) + ((size_t)b * SEQ + qq) * DM + 512 + hd * 64;
#pragma unroll
        for (int db = 0; db < 2; ++db)
#pragma unroll
            for (int g4 = 0; g4 < 4; ++g4) { const int d = 32 * db + 8 * g4 + 4 * hh; const f32x4 gv = *(const f32x4*)(go + d);
                u32x2 w; w.x = pk2(O[db][4 * g4] * rstd * gv[0], O[db][4 * g4 + 1] * rstd * gv[1]); w.y = pk2(O[db][4 * g4 + 2] * rstd * gv[2], O[db][4 * g4 + 3] * rstd * gv[3]);
                *(u32x2*)(orow + d) = w; }
    }
}

#define NSA_BAR() do { asm volatile("s_waitcnt lgkmcnt(0)" ::: "memory"); __builtin_amdgcn_s_barrier(); asm volatile("" ::: "memory"); } while (0)
DI void nsa_unit(Frame& F, int b, int g, int qb, float c2, float mc) {
    const int lane = F.lane, wid = F.wave, r = lane & 31, hh = lane >> 5;
    const int hd = 4 * g + (wid >> 1); const int tl = 32 * (wid & 1) + r; const int t = 64 * qb + tl;
    LAS char* lds = (LAS char*)F.lds;
    LAS float* impP = (LAS float*)(lds + 65536);
    LAS unsigned* selm = (LAS unsigned*)(lds + LDS_MISC + 5120);
    LAS float* invs = (LAS float*)(selm + 128);
    LAS float* otp = (LAS float*)(lds + 65536 + wid * 8192) + lane;
    LAS float* gpark = (LAS float*)(lds + LDS_MISC + 8192 + wid * 768) + lane;
    const ALane L = alane_init(lane);
    const size_t bg = (size_t)b * 2 + g;
    bf16x8 qf[4];
    { const bf16_t* QN = (const bf16_t*)(F.ws + WS_QN) + (((size_t)b * 8 + hd) * SEQ + t) * 64;
#pragma unroll
      for (int ks = 0; ks < 4; ++ks) qf[ks] = *(const bf16x8*)(QN + ks * 16 + hh * 8);
      const float* gates = (const float*)(F.ws + WS_GATES) + ((size_t)b * SEQ + t) * 24 + hd * 3;
      const float g0_ = gates[0], g1_ = gates[1], g2_ = gates[2]; gpark[0] = g0_; gpark[64] = g1_; gpark[128] = g2_; }
    const char* KcB = (const char*)(F.ws + WS_KCMP) + bg * 16384; const char* VcB = (const char*)(F.ws + WS_VCMP) + bg * 16384;
    const char* KsB = (const char*)(F.ws + WS_KS) + bg * (SEQ * 128); const char* VsB = (const char*)(F.ws + WS_VS) + bg * (SEQ * 128);
    const char* KwB = (const char*)(F.ws + WS_KW) + bg * (SEQ * 128); const char* VwB = (const char*)(F.ws + WS_VW) + bg * (SEQ * 128);
    const int nf = qb == 0 ? 1 : (qb == 1 ? 2 : 3); const int f1 = qb == 1 ? 1 : qb - 1, f2 = qb;
    const unsigned fmask = 1u | (qb >= 1 ? (1u << qb) : 0u) | (qb >= 2 ? (1u << (qb - 1)) : 0u);
    const unsigned allb = qb == 31 ? 0xffffffffu : ((1u << (qb + 1)) - 1u);
    unsigned grest = qb <= 5 ? (allb & ~fmask) : 0u;
    const int jlo = qb >= 4 ? qb - 4 : 0;
    int gph = 0, gi = 0;
    const int p_ = wid * 64 + lane, prow = p_ >> 3, pc = p_ & 7;
    const unsigned ksrc = (unsigned)(prow * 128 + ((pc ^ ((prow >> 1) & 7)) << 4)), vsrc = (unsigned)(prow * 128 + ((pc ^ (((prow >> 1) & 1) << 2)) << 4));
    const unsigned wbase = lds_addr(lds) + (unsigned)wid * 1024u;
#define NSA_GEN(ty, jj) do { ty = -1; jj = 0; \
        if (gph == 0) { ty = 0; jj = gi; if (++gi == 2) { gph = 1; gi = 0; } } \
        else if (gph == 1) { ty = 1; jj = gi == 0 ? 0 : (gi == 1 ? f1 : f2); if (++gi == nf) gph = 2; } \
        else { if (gph == 2) { if (grest) { ty = 1; jj = __builtin_ctz(grest); grest &= grest - 1u; } else { gph = 3; gi = jlo; } } \
               if (gph == 3) { if (gi <= qb) { ty = 2; jj = gi++; } else gph = 4; } } } while (0)
#define NSA_ISSUE(ty, jj, slot) do { const char* kp_ = ty == 0 ? KcB : (ty == 1 ? KsB : KwB); const char* vp_ = ty == 0 ? VcB : (ty == 1 ? VsB : VwB); \
        glds16(kp_ + (size_t)(jj) * 8192 + ksrc, (unsigned)__builtin_amdgcn_readfirstlane((int)(wbase + (unsigned)(slot) * 16384u))); \
        glds16(vp_ + (size_t)(jj) * 8192 + vsrc, (unsigned)__builtin_amdgcn_readfirstlane((int)(wbase + (unsigned)(slot) * 16384u + 8192u))); } while (0)
    int t0, j0, t1, j1, t2, j2;
    NSA_GEN(t0, j0); NSA_GEN(t1, j1); NSA_GEN(t2, j2);
    NSA_ISSUE(t0, j0, 0); NSA_ISSUE(t1, j1, 1); if (t2 >= 0) NSA_ISSUE(t2, j2, 2);
#pragma unroll
    for (int ks = 0; ks < 4; ++ks) asm volatile("" : "+v"(qf[ks]));
    f32x16 O[2]; float lv = 0.f; float carry_in = 0.f; unsigned mym = 0u; bool inB = false;
#pragma unroll
    for (int i = 0; i < 16; ++i) { O[0][i] = 0.f; O[1][i] = 0.f; }
    const int nvalid = t >= 31 ? ((t - 31) >> 4) + 1 : 0;
    for (int n = 0;; ++n) {
        if (t2 >= 0) RING_WAIT(4); else if (t1 >= 0) RING_WAIT(2); else RING_WAIT(0);
        __builtin_amdgcn_s_barrier();
        int t3, j3;
        NSA_GEN(t3, j3);
        if (t3 >= 0) NSA_ISSUE(t3, j3, (n + 3) & 3);
        const LAS char* Kt = lds + (n & 3) * 16384; const LAS char* Vt = Kt + 8192;
        int mode = MK_LE, th = tl; float mcl = mc;
        if (t0 == 0) { th = nvalid - 1 - 64 * j0; }
        else if (t0 == 1) { mcl = ((mym >> j0) & 1u) ? mc : 1.0e30f; mode = j0 < qb ? MK_NONE : MK_LE; }
        else {
            if (inB) {
                float lsum = lv; lsum += __shfl_xor(lsum, 32); const float s1 = gpark[64] / lsum;
#pragma unroll
                for (int db = 0; db < 2; ++db)
#pragma unroll
                    for (int i = 0; i < 16; ++i) { otp[(db * 16 + i) * 64] += O[db][i] * s1; O[db][i] = 0.f; }
                lv = 0.f; inB = false;
            }
            mode = j0 == qb ? MK_LE : (j0 == qb - 4 ? MK_GT : MK_NONE);
        }
        if (t0 != 0) {
            f32x16 Pd[2];
            if (mode == MK_NONE) attn_tile64<MK_NONE, false>(Kt, Vt, L, qf, O, lv, c2, mcl, 0, hh, Pd);
            else if (mode == MK_LE) attn_tile64<MK_LE, false>(Kt, Vt, L, qf, O, lv, c2, mcl, th, hh, Pd);
            else attn_tile64<MK_GT, false>(Kt, Vt, L, qf, O, lv, c2, mcl, th, hh, Pd);
        } else {
            f32x16 P[2];
            attn_tile64<MK_LE, true>(Kt, Vt, L, qf, O, lv, c2, mcl, th, hh, P);
            LAS float* ip = impP + ((wid >> 1) * 64 + tl) * 33;
            float av[8], rc[8];
#pragma unroll
            for (int kb = 0; kb < 2; ++kb)
#pragma unroll
                for (int gq = 0; gq < 4; ++gq) { const int f = 4 * kb + gq; const float p3 = 0.5f * P[kb][4 * gq + 3]; av[f] = P[kb][4 * gq] + P[kb][4 * gq + 1] + P[kb][4 * gq + 2] + p3; rc[f] = __shfl_xor(p3, 32); }
#pragma unroll
            for (int f = 0; f < 8; ++f) { const float carry = hh == 1 ? rc[f] : (f > 0 ? rc[f > 0 ? f - 1 : 0] : carry_in); ip[2 * (8 * j0 + f) + hh] = av[f] + carry; }
            carry_in = rc[7];
            if (j0 == 1) {
                {
                    const bf16_t* QR = (const bf16_t*)(F.ws + WS_QR) + (((size_t)b * 8 + hd) * SEQ + t) * 64;
#pragma unroll
                    for (int ks = 0; ks < 4; ++ks) qf[ks] = *(const bf16x8*)(QR + ks * 16 + hh * 8); }
                float lsum = lv; lsum += __shfl_xor(lsum, 32);
                const float inv = lsum > 0.f ? 1.f / lsum : 0.f;
                if (hh == 0) invs[(wid >> 1) * 64 + tl] = inv;
                const float s0 = gpark[0] * inv;
                lv = 0.f;
                NSA_BAR();
                if (wid == 0) {
                    unsigned m;
                    if (qb <= 5) m = allb;
                    else {
                        m = fmask;
                        float best[3] = {-1.f, -1.f, -1.f}; int bi[3] = {0, 0, 0}; const float iv0 = invs[lane], iv1 = invs[64 + lane], iv2 = invs[128 + lane], iv3 = invs[192 + lane];
                        for (int j = 1; j <= qb - 2; ++j) {
                            const float v = (impP[(0 * 64 + lane) * 33 + j] * iv0 + impP[(1 * 64 + lane) * 33 + j] * iv1) + (impP[(2 * 64 + lane) * 33 + j] * iv2 + impP[(3 * 64 + lane) * 33 + j] * iv3);
                            if (v > best[0]) { best[2] = best[1]; bi[2] = bi[1]; best[1] = best[0]; bi[1] = bi[0]; best[0] = v; bi[0] = j; }
                            else if (v > best[1]) { best[2] = best[1]; bi[2] = bi[1]; best[1] = v; bi[1] = j; }
                            else if (v > best[2]) { best[2] = v; bi[2] = j; }
                        }
                        m |= (1u << bi[0]) | (1u << bi[1]) | (1u << bi[2]);
                    }
                    selm[lane] = m;
                    unsigned u = m;
#pragma unroll
                    for (int o = 1; o < 64; o <<= 1) u |= (unsigned)__shfl_xor((int)u, o);
                    if (lane == 0) selm[64] = u;
                }
                NSA_BAR();
                mym = selm[tl];
                if (qb > 5) grest = (unsigned)__builtin_amdgcn_readfirstlane((int)selm[64]) & ~fmask;
#pragma unroll
                for (int db = 0; db < 2; ++db)
#pragma unroll
                    for (int i = 0; i < 16; ++i) { otp[(db * 16 + i) * 64] = O[db][i] * s0; O[db][i] = 0.f; }
                inB = true;
#pragma unroll
                for (int ks = 0; ks < 4; ++ks) asm volatile("" : "+v"(qf[ks]));
            }
        }
        if (t1 < 0) break;
        t0 = t1; j0 = j1; t1 = t2; j1 = j2; t2 = t3; j2 = j3;
    }
    {
        float lsum = lv; lsum += __shfl_xor(lsum, 32); const float s2 = gpark[128] / lsum;
#pragma unroll
        for (int db = 0; db < 2; ++db)
#pragma unroll
            for (int i = 0; i < 16; ++i) O[db][i] = otp[(db * 16 + i) * 64] + O[db][i] * s2;
    }
    bf16_t* orow = (bf16_t*)(F.ws + WS_AO) + ((size_t)b * SEQ + t) * DM + hd * 64;
#pragma unroll
    for (int db = 0; db < 2; ++db)
#pragma unroll
        for (int g4 = 0; g4 < 4; ++g4) { const int d = 32 * db + 8 * g4 + 4 * hh;
            u32x2 w; w.x = pk2(O[db][4 * g4], O[db][4 * g4 + 1]); w.y = pk2(O[db][4 * g4 + 2], O[db][4 * g4 + 3]);
            *(u32x2*)(orow + d) = w; }
    NSA_BAR();
#undef NSA_GEN
#undef NSA_ISSUE
}

DI float gmax(const float* g, int n, int lane) { float v = lane < n ? fabsf(g[lane]) : 0.f;
#pragma unroll
    for (int o = 1; o < 64; o <<= 1) v = fmaxf(v, __shfl_xor(v, o));
    return v; }

DI int queue_next(Frame& F, unsigned* ctr) {
    LAS int* slot = (LAS int*)(F.lds + LDS_MISC + 4096);
    __syncthreads();
    if (F.tid == 0) *slot = (int)atomicAdd(ctr, 1u);
    __syncthreads();
    return *slot;
}

DI int queue_pass(Frame& F, unsigned nx) {
    LAS int* slot = (LAS int*)(F.lds + LDS_MISC + 4096);
    __syncthreads();
    if (F.tid == 0) *slot = (int)nx;
    __syncthreads();
    return *slot;
}

DI float gelu_tanh(float x) { const float u = 0.7978845608028654f * (x + 0.044715f * x * x * x); const float e = __expf(2.f * u); const float th = 1.f - 2.f / (e + 1.f); return 0.5f * x * (1.f + th); }
DI void phase5(Frame& F) {
    const bf16_t* UL = (const bf16_t*)(F.ws + WS_UL); const float* w2 = F.in[11]; const float* gk0 = F.in[8];
    LAS float* w2s = (LAS float*)F.lds;
    LAS float* hid = (LAS float*)(F.lds + LDS_MISC + 8192 + F.wave * 1024);
    for (int i = F.tid; i < 2 * 256 * 64 / 4; i += NTHREADS) ((LAS f32x4*)w2s)[i] = ((const f32x4*)w2)[i];
    __syncthreads();
    const int lane = F.lane;
    for (int it = F.gw; it < 2 * 64 * 128; it += F.NGW) {
        const int kv = it >> 13, rem = it & 8191, bgi = rem >> 7, c = rem & 127;
        bf16_t* dst = (bf16_t*)(F.ws + (kv ? WS_VCMP : WS_KCMP)) + ((size_t)bgi * 128 + c) * 64;
        if (c == 127) { dst[lane] = 0; continue; }
        const size_t row = (size_t)kv * 8192 + (size_t)bgi * 128 + c;
        const size_t perow = 16384 + (size_t)kv * 256 + (size_t)kv * 2;
        const u32x2 u4 = *(const u32x2*)(UL + row * 512 + 4 * lane), l4 = *(const u32x2*)(UL + (row + 1) * 512 + 256 + 4 * lane);
        const u32x2 pu = *(const u32x2*)(UL + perow * 512 + 4 * lane), pl = *(const u32x2*)(UL + (perow + 1) * 512 + 256 + 4 * lane);
        float h[4];
        h[0] = bflo(u4.x) + bflo(l4.x) + bflo(pu.x) + bflo(pl.x); h[1] = bfhi(u4.x) + bfhi(l4.x) + bfhi(pu.x) + bfhi(pl.x);
        h[2] = bflo(u4.y) + bflo(l4.y) + bflo(pu.y) + bflo(pl.y); h[3] = bfhi(u4.y) + bfhi(l4.y) + bfhi(pu.y) + bfhi(pl.y);
        f32x4 hv;
#pragma unroll
        for (int i = 0; i < 4; ++i) hv[i] = gelu_tanh(h[i]);
        *(LAS f32x4*)(hid + 4 * lane) = hv;
        asm volatile("s_waitcnt lgkmcnt(0)" ::: "memory");
        const LAS float* w = w2s + kv * 256 * 64 + lane; float acc0 = 0.f, acc1 = 0.f;
#pragma unroll 8
        for (int k = 0; k < 256; k += 4) { const f32x4 hh4 = *(const LAS f32x4*)(hid + k);
            acc0 += hh4[0] * w[(k + 0) * 64]; acc1 += hh4[1] * w[(k + 1) * 64]; acc0 += hh4[2] * w[(k + 2) * 64]; acc1 += hh4[3] * w[(k + 3) * 64]; }
        float acc = acc0 + acc1;
        if (kv == 0) { const float ss = wave_sum(acc * acc); acc = acc * rsqrtf(ss * (1.f / 64.f) + EPS) * gk0[lane]; }
        dst[lane] = f2bf(acc);
        asm volatile("s_waitcnt lgkmcnt(0)" ::: "memory");
    }
    __syncthreads();
}

DI void phase8(Frame& F) {
    const bf16_t* x1 = (const bf16_t*)(F.ws + WS_X1B); const float* gf = F.in[5]; const float* mod = (const float*)(F.ws + WS_MOD); const float* rowss = (const float*)(F.ws + WS_ROWSS);
    const char* wsrc = (const char*)(F.ws + WS_WR);
    unsigned char* h2 = (unsigned char*)(F.ws + WS_H2);
    unsigned* cnt = (unsigned*)(F.ws + WS_CTL) + CW_CNT; int* lists = (int*)(F.ws + WS_LIST);
    int* tipos = (int*)(F.ws + WS_TIPOS); int* tie = (int*)(F.ws + WS_TIE); float* tiw = (float*)(F.ws + WS_TIW);
    const float* brg = F.in[21]; const float* bre = F.in[23];
    const int lane = F.lane, wid = F.wave, row = lane & 15, kq = lane >> 4;
    LAS char* wl = (LAS char*)F.lds;
    LAS float* lg = (LAS float*)(F.lds + 98304 + wid * 3072);
    LAS float* A2 = (LAS float*)(F.lds + 122880);
    LAS float* B2 = A2 + 1024;
    LAS unsigned* hist = (LAS unsigned*)(F.lds + LDS_MISC + 8192);
    unsigned wso[6];
#pragma unroll
    for (int i = 0; i < 6; ++i) { const int s = i * 512 + F.tid, part = s / 1536, r = (s >> 5) % 48, cs = s & 31; wso[i] = (unsigned)(part * 98304 + r * 2048 + ((cs ^ (r & 15)) << 4)); }
#define P8_ISSUE(kc, buf) do { _Pragma("unroll") for (int i_ = 0; i_ < 6; ++i_) \
        __builtin_amdgcn_global_load_lds((const unsigned*)(wsrc + (size_t)(kc) * 512 + wso[i_]), (LAS unsigned*)(wl + (buf) * 49152 + i_ * 8192 + wid * 1024), 16, 0, 0); } while (0)
    const int nbatch = TOK / 128;
    for (int bt = F.bid; bt < nbatch; bt += F.G) {
        const int m0 = bt * 128 + wid * 16; const int m = m0 + row; const int b = m0 >> 11;
        P8_ISSUE(0, 0);
        { const float* sh = mod + (size_t)b * 6144 + 3072; const float* sc = sh + 1024;
          for (int k = F.tid; k < 1024; k += NTHREADS) { A2[k] = gf[k] * (sc[k] + 1.f); B2[k] = sh[k]; } }
        if (F.tid < 64) hist[F.tid] = 0u;
        float rs = 0.f; { const f32x4* rp = (const f32x4*)(rowss + (size_t)m * 16);
#pragma unroll
            for (int q = 0; q < 4; ++q) { const f32x4 v = rp[q]; rs += (v[0] + v[1]) + (v[2] + v[3]); } }
        const float rstd = rsqrtf(rs * (1.f / DM) + EPS);
        const bf16_t* xrow = x1 + (size_t)m * DM + 8 * kq; unsigned char* hrow = h2 + (size_t)m * DM + 8 * kq;
        u32x4 xw[4];
#pragma unroll
        for (int u = 0; u < 4; ++u) xw[u] = *(const u32x4*)(xrow + 32 * u);
        f32x4 acc[3] = {{0.f, 0.f, 0.f, 0.f}, {0.f, 0.f, 0.f, 0.f}, {0.f, 0.f, 0.f, 0.f}};
        for (int kc = 0; kc < 4; ++kc) {
            asm volatile("s_waitcnt vmcnt(0)" ::: "memory");
            __syncthreads();
            if (kc + 1 < 4) P8_ISSUE(kc + 1, (kc + 1) & 1);
            const LAS char* wb = wl + (kc & 1) * 49152;
#pragma unroll 1
            for (int g4 = 0; g4 < 2; ++g4) {
                const int gg = kc * 2 + g4;
                u32x4 nw[4];
                if (gg + 1 < 8) {
#pragma unroll
                    for (int u = 0; u < 4; ++u) nw[u] = *(const u32x4*)(xrow + 128 * (gg + 1) + 32 * u);
                }
#pragma unroll
                for (int u = 0; u < 4; ++u) {
                    const int k0 = 128 * gg + 32 * u + 8 * kq;
                    const f32x4 a0 = *(const LAS f32x4*)(A2 + k0), a1 = *(const LAS f32x4*)(A2 + k0 + 4), b0 = *(const LAS f32x4*)(B2 + k0), b1 = *(const LAS f32x4*)(B2 + k0 + 4);
                    const f32x4 xa_ = {bflo(xw[u].x), bfhi(xw[u].x), bflo(xw[u].y), bfhi(xw[u].y)}, xb_ = {bflo(xw[u].z), bfhi(xw[u].z), bflo(xw[u].w), bfhi(xw[u].w)};
                    const f32x4 ya = xa_ * rstd * a0 + b0, yb = xb_ * rstd * a1 + b1;
                    u32x4 hi; hi.x = pk2(ya[0], ya[1]); hi.y = pk2(ya[2], ya[3]); hi.z = pk2(yb[0], yb[1]); hi.w = pk2(yb[2], yb[3]);
                    { u32x2 h8; h8.x = pk4_fp8(ya[0], ya[1], ya[2], ya[3]); h8.y = pk4_fp8(yb[0], yb[1], yb[2], yb[3]); *(u32x2*)(hrow + 128 * gg + 32 * u) = h8; }
                    u32x4 lo; lo.x = pk2(ya[0] - bflo(hi.x), ya[1] - bfhi(hi.x)); lo.y = pk2(ya[2] - bflo(hi.y), ya[3] - bfhi(hi.y)); lo.z = pk2(yb[0] - bflo(hi.z), yb[1] - bfhi(hi.z)); lo.w = pk2(yb[2] - bflo(hi.w), yb[3] - bfhi(hi.w));
                    const bf16x8 ahi = __builtin_bit_cast(bf16x8, hi), alo = __builtin_bit_cast(bf16x8, lo);
                    const int ch = (g4 * 4 + u) * 4 + kq;
#pragma unroll
                    for (int ct = 0; ct < 3; ++ct) { const int r = 16 * ct + row; const int off = r * 512 + ((ch ^ row) << 4);
                        const bf16x8 bh = *(const LAS bf16x8*)(wb + off), bl = *(const LAS bf16x8*)(wb + 24576 + off);
                        acc[ct] = MFMA16(ahi, bh, acc[ct]); acc[ct] = MFMA16(alo, bh, acc[ct]); acc[ct] = MFMA16(ahi, bl, acc[ct]); }
                }
#pragma unroll
                for (int u = 0; u < 4; ++u) xw[u] = nw[u];
            }
        }
#pragma unroll
        for (int ct = 0; ct < 3; ++ct)
#pragma unroll
            for (int i = 0; i < 4; ++i) lg[(kq * 4 + i) * 48 + 16 * ct + row] = acc[ct][i];
        asm volatile("s_waitcnt lgkmcnt(0)" ::: "memory");
        int e0 = 0, e1 = 0; float w0 = 0.f, w1 = 0.f; unsigned lp0 = 0u, lp1 = 0u;
        if (lane < 16) {
            const LAS float* lr = lg + lane * 48;
            float g4v[4]; int grp = 0; float gm = -3.0e38f;
#pragma unroll
            for (int i = 0; i < 4; ++i) { g4v[i] = lr[i] + brg[i]; if (g4v[i] > gm) { gm = g4v[i]; grp = i; } }
            float den = 0.f;
#pragma unroll
            for (int i = 0; i < 4; ++i) den += __expf(g4v[i] - gm);
            const float pg = 1.f / den;
            float v0 = -3.0e38f, v1 = -3.0e38f; int i0 = 0, i1 = 0;
            for (int i = 0; i < 8; ++i) { const float v = lr[4 + grp * 8 + i] + bre[grp * 8 + i];
                if (v > v0) { v1 = v0; i1 = i0; v0 = v; i0 = i; } else if (v > v1) { v1 = v; i1 = i; } }
            const float ex = __expf(v1 - v0); w0 = pg / (1.f + ex); w1 = pg * ex / (1.f + ex);
            e0 = grp * 8 + i0; e1 = grp * 8 + i1;
            lp0 = atomicAdd((unsigned*)&hist[e0], 1u); lp1 = atomicAdd((unsigned*)&hist[e1], 1u);
        }
        __syncthreads();
        if (F.tid < 32) { const unsigned n = hist[F.tid]; hist[32 + F.tid] = n ? atomicAdd(cnt + F.tid, n) : 0u; }
        __syncthreads();
        if (lane < 16) {
            const int tok = m0 + lane; const int p0 = (int)(hist[32 + e0] + lp0), p1 = (int)(hist[32 + e1] + lp1);
            lists[(size_t)e0 * ECAP + p0] = tok; lists[(size_t)e1 * ECAP + p1] = tok;
            tipos[2 * tok] = p0; tipos[2 * tok + 1] = p1; tie[tok] = e0 | (e1 << 8); tiw[2 * tok] = w0; tiw[2 * tok + 1] = w1;
        }
        __syncthreads();
    }
#undef P8_ISSUE
}

DI LAS int* moe_prefix(Frame& F) {
    LAS int* tb = (LAS int*)(F.lds + LDS_MISC);
    __syncthreads();
    if (F.wave == 0) {
        const unsigned* cnt = (const unsigned*)(F.ws + WS_CTL) + CW_CNT; const int l = F.lane;
        int v = l < 32 ? (int)((__hip_atomic_load(cnt + l, __ATOMIC_RELAXED, __HIP_MEMORY_SCOPE_AGENT) + 255u) >> 8) : 0;
#pragma unroll
        for (int o = 1; o < 32; o <<= 1) { const int u = __shfl_up(v, o); if (l >= o) v += u; }
        if (l < 32) tb[l + 1] = v;
        if (l == 0) tb[0] = 0;
    }
    __syncthreads();
    return tb;
}

DI void phase11(Frame& F) {
    LAS int* tb = moe_prefix(F);
    const bf16_t* Y = (const bf16_t*)(F.ws + WS_Y); const float* mod = (const float*)(F.ws + WS_MOD);
    const int* tipos = (const int*)(F.ws + WS_TIPOS); const int* tie = (const int*)(F.ws + WS_TIE); const float* tiw = (const float*)(F.ws + WS_TIW);
    const int lane = F.lane;
    for (int m0 = F.gw * 32; m0 < TOK; m0 += F.NGW * 32) {
        const int b = m0 >> 11; const float* g2 = mod + (size_t)b * 6144 + 5120;
        f32x4 ga[2], gb[2];
#pragma unroll
        for (int j = 0; j < 2; ++j) { ga[j] = *(const f32x4*)(g2 + 8 * lane + 512 * j); gb[j] = *(const f32x4*)(g2 + 8 * lane + 512 * j + 4); }
        int mr0 = 0, mr1 = 0; float mw0 = 0.f, mw1 = 0.f;
        { const int mm = m0 + (lane & 31); const int ee = tie[mm]; mr0 = tb[ee & 255] * 256 + tipos[2 * mm]; mr1 = tb[ee >> 8] * 256 + tipos[2 * mm + 1]; mw0 = tiw[2 * mm]; mw1 = tiw[2 * mm + 1]; }
        float* obase = F.out + (size_t)m0 * DM + 8 * lane; const bf16_t* xbase = (const bf16_t*)(F.ws + WS_X1B) + (size_t)m0 * DM + 8 * lane;
#define P11_LOAD(i, ya, yb, xa, xb) do { const size_t r0_ = (size_t)__shfl(mr0, (i)), r1_ = (size_t)__shfl(mr1, (i)); \
            _Pragma("unroll") for (int j = 0; j < 2; ++j) { ya[j] = *(const u32x4*)(Y + r0_ * DM + 8 * lane + 512 * j); yb[j] = *(const u32x4*)(Y + r1_ * DM + 8 * lane + 512 * j); \
                const u32x4 xw_ = *(const u32x4*)(xbase + (size_t)(i) * DM + 512 * j); xa[j] = (f32x4){bflo(xw_.x), bfhi(xw_.x), bflo(xw_.y), bfhi(xw_.y)}; xb[j] = (f32x4){bflo(xw_.z), bfhi(xw_.z), bflo(xw_.w), bfhi(xw_.w)}; } } while (0)
        u32x4 ya0[2], yb0[2], ya1[2], yb1[2]; f32x4 xa0[2], xb0[2], xa1[2], xb1[2];
        P11_LOAD(0, ya0, yb0, xa0, xb0); P11_LOAD(1, ya1, yb1, xa1, xb1);
        for (int i = 0; i < 32; i += 2) {
            u32x4 nya0[2], nyb0[2], nya1[2], nyb1[2]; f32x4 nxa0[2], nxb0[2], nxa1[2], nxb1[2];
            if (i + 2 < 32) { P11_LOAD(i + 2, nya0, nyb0, nxa0, nxb0); P11_LOAD(i + 3, nya1, nyb1, nxa1, nxb1); }
#define P11_ROW(i, ya, yb, xa, xb) do { const float w0 = __shfl(mw0, (i)), w1 = __shfl(mw1, (i)); \
            _Pragma("unroll") for (int j = 0; j < 2; ++j) { f32x4 oa = xa[j], ob = xb[j]; \
                oa[0] += ga[j][0] * (w0 * bflo(ya[j].x) + w1 * bflo(yb[j].x)); oa[1] += ga[j][1] * (w0 * bfhi(ya[j].x) + w1 * bfhi(yb[j].x)); \
                oa[2] += ga[j][2] * (w0 * bflo(ya[j].y) + w1 * bflo(yb[j].y)); oa[3] += ga[j][3] * (w0 * bfhi(ya[j].y) + w1 * bfhi(yb[j].y)); \
                ob[0] += gb[j][0] * (w0 * bflo(ya[j].z) + w1 * bflo(yb[j].z)); ob[1] += gb[j][1] * (w0 * bfhi(ya[j].z) + w1 * bfhi(yb[j].z)); \
                ob[2] += gb[j][2] * (w0 * bflo(ya[j].w) + w1 * bflo(yb[j].w)); ob[3] += gb[j][3] * (w0 * bfhi(ya[j].w) + w1 * bfhi(yb[j].w)); \
                *(f32x4*)(obase + (size_t)(i) * DM + 512 * j) = oa; *(f32x4*)(obase + (size_t)(i) * DM + 512 * j + 4) = ob; } } while (0)
            P11_ROW(i, ya0, yb0, xa0, xb0); P11_ROW(i + 1, ya1, yb1, xa1, xb1);
#pragma unroll
            for (int j = 0; j < 2; ++j) { ya0[j] = nya0[j]; yb0[j] = nyb0[j]; xa0[j] = nxa0[j]; xb0[j] = nxb0[j]; ya1[j] = nya1[j]; yb1[j] = nyb1[j]; xa1[j] = nxa1[j]; xb1[j] = nxb1[j]; }
        }
#undef P11_LOAD
#undef P11_ROW
    }
}

constexpr int CW_BAR = 4096;
#define XB_TMO      128
#define XB_XCNT(j)  (256  + 64 * (j))
#define XB_XSUB(j)  (1280 + 64 * (j))
#define XB_XGEN(j)  (2304 + 64 * (j))
#define XB_TOP      3328
#define XB_TOPGEN   3392
#define XB_SPIN_CAP (1u << 22)
DI unsigned xb_ld(unsigned* p)              { return __hip_atomic_load(p, __ATOMIC_RELAXED, __HIP_MEMORY_SCOPE_AGENT); }
DI unsigned xb_add(unsigned* p, unsigned v) { return __hip_atomic_fetch_add(p, v, __ATOMIC_RELAXED, __HIP_MEMORY_SCOPE_AGENT); }
DI unsigned xb_xcc_id() { return (unsigned)__builtin_amdgcn_s_getreg((3 << 11) | 20) & 0xFu; }
#define XB_SPIN(cond, bar) do { unsigned _sp = 0; while (cond) { __builtin_amdgcn_s_sleep(1); \
    if ((++_sp & 255u) == 0u) { if (xb_ld(&(bar)[XB_TMO])) break; if (_sp > XB_SPIN_CAP) { atomicAdd(&(bar)[XB_TMO], 1u); break; } } } } while (0)
struct XcdBarrier { unsigned* bar; unsigned x; volatile LAS unsigned* st; };
DI XcdBarrier xcd_barrier_post(unsigned* bar, volatile LAS unsigned* st, bool leader) {
    XcdBarrier b; b.bar = bar; b.x = xb_xcc_id(); b.st = st;
    if (leader) (void)xb_add(&bar[XB_XCNT(b.x)], 1u);
    return b;
}
DI void xcd_barrier_complete(unsigned* bar, unsigned x, unsigned& nloc, unsigned& nx) {
    const unsigned G = gridDim.x;
    unsigned sum, cnt, mine, sp = 0u;
    for (;;) {
        sum = 0u; cnt = 0u; mine = 0u;
#pragma unroll
        for (unsigned j = 0; j < 16; ++j) { const unsigned c = xb_ld(&bar[XB_XCNT(j)]); sum += c; cnt += (c > 0u) ? 1u : 0u; mine = (j == x) ? c : mine; }
        if (sum == G) break;
        __builtin_amdgcn_s_sleep(1);
        if ((++sp & 255u) == 0u) { if (xb_ld(&bar[XB_TMO])) break; if (sp > XB_SPIN_CAP) { atomicAdd(&bar[XB_TMO], 1u); break; } }
    }
    nloc = mine > 0u ? mine : 1u; nx = cnt > 0u ? cnt : 1u;
}
DI void xcd_barrier(const XcdBarrier& b, bool leader) {
    asm volatile("s_waitcnt vmcnt(0)" ::: "memory");
    __syncthreads();
    if (leader) {
        unsigned* bar = b.bar;
        __builtin_amdgcn_s_waitcnt(0);
        unsigned nloc = b.st[0], nx = b.st[1];
        if (nloc == 0u) { xcd_barrier_complete(bar, b.x, nloc, nx); b.st[0] = nloc; b.st[1] = nx; }
        const unsigned old = xb_add(&bar[XB_XSUB(b.x)], 1u);
        const unsigned gen = old / nloc;
        if (old + 1u == (gen + 1u) * nloc) {
            __builtin_amdgcn_fence(__ATOMIC_RELEASE, "agent");
            asm volatile("s_waitcnt vmcnt(0)" ::: "memory");
            const unsigned og = xb_add(&bar[XB_TOP], 1u);
            const unsigned tg = og / nx;
            if (og + 1u == (tg + 1u) * nx) xb_add(&bar[XB_TOPGEN], 1u);
            else XB_SPIN(xb_ld(&bar[XB_TOPGEN]) == tg, bar);
            __builtin_amdgcn_fence(__ATOMIC_ACQUIRE, "agent");
            xb_add(&bar[XB_XGEN(b.x)], 1u);
            asm volatile("s_waitcnt vmcnt(0)" ::: "memory");
        } else {
            XB_SPIN(xb_ld(&bar[XB_XGEN(b.x)]) == gen, bar);
            __builtin_amdgcn_fence(__ATOMIC_ACQUIRE, "agent");
            asm volatile("s_waitcnt vmcnt(0)" ::: "memory");
        }
    }
    __syncthreads();
}

constexpr int NPHASE = 12;
__global__ void __launch_bounds__(NTHREADS, 2) hymba_fwd(Params p) {
    extern __shared__ __attribute__((aligned(16))) unsigned char lds_raw[];
    __builtin_assume(__builtin_amdgcn_workitem_id_y() == 0); __builtin_assume(__builtin_amdgcn_workitem_id_z() == 0);
    cg::grid_group grid = cg::this_grid();
    Frame F;
    F.lds = (LAS unsigned char*)lds_raw; F.ws = p.ws; F.in = p.in; F.out = p.out;
    F.wave = __builtin_amdgcn_readfirstlane(threadIdx.x >> 6); F.lane = lane_id_fresh(); F.tid = F.wave * 64 + F.lane; F.bid = blockIdx.x; F.G = gridDim.x;
    F.gw = F.bid * NWAVES + F.wave; F.NGW = F.G * NWAVES;
    const int lo = p.ph_lo, hi = p.ph_hi;
#define IN(k) (lo <= (k) && (k) < hi)
#ifdef PROBE_A
    LAS unsigned long long* ts_ = (LAS unsigned long long*)(F.lds + LDS_MISC + 7168);
#define STAMP(k) do { if (F.bid == 0 && F.tid == 0) ts_[k] = __builtin_amdgcn_s_memrealtime(); } while (0)
#else
#define STAMP(k) do { } while (0)
#endif
    STAMP(0);
    volatile LAS unsigned* xst = (volatile LAS unsigned*)(F.lds + LDS_MISC + 4112);
    if (F.tid == 0) { xst[0] = 0u; xst[1] = 0u; }
    __syncthreads();
    XcdBarrier xbar; xbar.bar = (unsigned*)(F.ws + WS_CTL) + CW_BAR; xbar.x = 0; xbar.st = xst;
#define SEAM(k) do { if (IN(k) && IN((k) + 1)) { if ((k) == 0) { grid.sync(); xbar = xcd_barrier_post((unsigned*)(F.ws + WS_CTL) + CW_BAR, xst, F.tid == 0); } else xcd_barrier(xbar, F.tid == 0); } F.lane = lane_id_fresh(); F.tid = F.wave * 64 + F.lane; STAMP((k) + 1); } while (0)
    LAS unsigned char* ring = F.lds; LAS unsigned* tokl = (LAS unsigned*)(F.lds + LDS_MISC + 256);
#ifdef DOUBLE_PHASE
#define NREP(k) ((k) == DOUBLE_PHASE ? 2 : 1)
#define REPSYNC(k, rep) do { if ((k) == DOUBLE_PHASE && (rep) == 0) grid.sync(); } while (0)
#else
#define NREP(k) 1
#define REPSYNC(k, rep) do { } while (0)
#endif

    if (IN(0)) for (int rep = 0; rep < NREP(0); ++rep) { phase0(F); REPSYNC(0, rep); }
    SEAM(0);
    if (IN(1)) for (int rep = 0; rep < NREP(1); ++rep) { phase1(F); phase0_weights(F); REPSYNC(1, rep); }
    SEAM(1);
    if (IN(2)) for (int rep = 0; rep < NREP(2); ++rep) {
        pg8::StaticOrder S; S.init(TOK, NPROJ, DM, F.G, F.bid, F.ws + WS_H1, F.ws + WS_WIN);
        pg8::EpiInProj E{F.ws, F.in[7], F.in[8], F.in[12], F.in[13], (LAS float*)(F.lds + LDS_MISC + 8192)};
        pg8::gemm_phase<pg8::EpiInProj, pg8::StaticOrder, false>(ring, tokl, DM, S, E, F.wave, F.lane);
        REPSYNC(2, rep);
    }
    SEAM(2); STAMP(4);
    if (IN(4)) for (int rep = 0; rep < NREP(4); ++rep) {
        { pg8::CompressOrder S{F.G, F.bid, (const char*)(F.ws + WS_KC), (const char*)(F.ws + WS_PE), (const char*)(F.ws + WS_WC1)};
          pg8::EpiBf16 E{(bf16_t*)(F.ws + WS_UL), 512};
          pg8::gemm_phase<pg8::EpiBf16, pg8::CompressOrder, false>(ring, tokl, 1024, S, E, F.wave, F.lane); }
        const float mq = gmax(F.in[12], 32, F.lane), mk = gmax(F.in[13], 32, F.lane);
        const float bound = 5.656854249f * mq * mk * 1.02f; const float c2 = 0.17677669529663687f * 1.4426950408889634f; const float mc = bound * 1.4426950408889634f;
        float s1 = F.lane < 32 ? F.in[14][F.lane] * F.in[15][F.lane] : 0.f, s2 = F.lane < 32 ? F.in[16][F.lane] * F.in[17][F.lane] : 0.f;
        s1 = wave_sum(s1); s2 = wave_sum(s2);
        const float lam = __expf(s1) - __expf(s2) + 0.2f;
        unsigned* ctr = (unsigned*)(F.ws + WS_CTL) + CW_QDIFF + 32 * rep;
        for (int it = queue_next(F, ctr); it < 4096;) { unsigned nx = 0u; if (F.tid == 0) nx = atomicAdd(ctr, 1u);
            const int qb = 15 - (it >> 8), bh = it & 255; diff_unit(F, bh >> 3, bh & 7, qb, c2, mc, lam); it = queue_pass(F, nx); }
        REPSYNC(4, rep);
    }
    SEAM(4);
    if (IN(5)) for (int rep = 0; rep < NREP(5); ++rep) { phase5(F); REPSYNC(5, rep); }
    SEAM(5);
    if (IN(6)) for (int rep = 0; rep < NREP(6); ++rep) {
        const float mq = gmax(F.in[7], 64, F.lane); const float mk = fmaxf(gmax(F.in[8], 64, F.lane), fmaxf(gmax(F.in[8] + 64, 64, F.lane), gmax(F.in[8] + 128, 64, F.lane)));
        const float bound = 8.f * mq * mk * 1.02f; const float c2 = 0.125f * 1.4426950408889634f; const float mc = bound * 1.4426950408889634f;
        unsigned* ctr = (unsigned*)(F.ws + WS_CTL) + CW_QNSA + 32 * rep;
        for (int it = queue_next(F, ctr); it < 2048;) { unsigned nx = 0u; if (F.tid == 0) nx = atomicAdd(ctr, 1u);
            const int qb = 31 - (it >> 6), bg = it & 63; nsa_unit(F, bg >> 1, bg & 1, qb, c2, mc); it = queue_pass(F, nx); }
        REPSYNC(6, rep);
    }
    SEAM(6);
    if (IN(7)) for (int rep = 0; rep < NREP(7); ++rep) {
        pg8::StaticOrder S; S.init(TOK, DM, DM, F.G, F.bid, F.ws + WS_AO, F.ws + WS_WOUT);
        pg8::EpiOutProj E{F.in[0], (bf16_t*)(F.ws + WS_X1B), (const float*)(F.ws + WS_MOD), (float*)(F.ws + WS_ROWSS)};
        pg8::gemm_phase<pg8::EpiOutProj, pg8::StaticOrder, false>(ring, tokl, DM, S, E, F.wave, F.lane);
        REPSYNC(7, rep);
    }
    SEAM(7);
    if (IN(8)) phase8(F);
    SEAM(8);
    if (IN(9)) for (int rep = 0; rep < NREP(9); ++rep) {
        LAS int* tb = moe_prefix(F);
        pg8::MoeOrder S{F.G, F.bid, 0, tb, (const char*)(F.ws + WS_H2), (const char*)(F.ws + WS_WGU), (const int*)(F.ws + WS_LIST)};
        pg8::EpiSwiglu E{(unsigned char*)(F.ws + WS_HH)};
        pg8::gemm_phase<pg8::EpiSwiglu, pg8::MoeOrder, true, true>(ring, tokl, DM / 2, S, E, F.wave, F.lane);
        REPSYNC(9, rep);
    }
    SEAM(9);
    if (IN(10)) for (int rep = 0; rep < NREP(10); ++rep) {
        LAS int* tb = moe_prefix(F);
        pg8::MoeOrder S{F.G, F.bid, 1, tb, (const char*)(F.ws + WS_HH), (const char*)(F.ws + WS_WD), nullptr};
        pg8::EpiBf16 E{(bf16_t*)(F.ws + WS_Y), DM};
        pg8::gemm_phase<pg8::EpiBf16, pg8::MoeOrder, false, true>(ring, tokl, EHID / 2, S, E, F.wave, F.lane);
        REPSYNC(10, rep);
    }
    SEAM(10);
    if (IN(11)) phase11(F);
    grid.sync(); grid.sync(); grid.sync(); grid.sync(); grid.sync(); grid.sync(); grid.sync(); grid.sync();
#ifdef PROBE_A
    grid.sync(); STAMP(12);
    if (F.bid == 0 && F.tid == 0) {
        unsigned long long da = (ts_[PROBE_A + 1] - ts_[PROBE_A]) / 100ull, db = (ts_[PROBE_B + 1] - ts_[PROBE_B]) / 100ull;
        unsigned long long qa = (da + 5ull) / 10ull, qb2 = (db + 5ull) / 10ull; if (qa > 63ull) qa = 63ull; if (qb2 > 63ull) qb2 = 63ull;
        const unsigned long long target = ts_[0] + (6000ull + 16ull + 32ull * qa + 2048ull * qb2) * 100ull;
        while (__builtin_amdgcn_s_memrealtime() < target) __builtin_amdgcn_s_sleep(32);
    }
#endif
#undef IN
#undef SEAM
}

#ifndef MK_LAUNCHES
#define MK_LAUNCHES 1
#endif
extern "C" void kernel_launch(void* const* d_in, const int* in_sizes, int n_in, void* d_out, int out_size, void* d_ws, size_t ws_size, hipStream_t stream) {
    static int grid = 0;
    if (grid == 0) {
        if (n_in != 27 || ws_size < WS_END) { fprintf(stderr, "kernel_launch: unexpected inputs (n_in %d, ws %zu)\n", n_in, ws_size); grid = -1; return; }
        int dev = 0, cus = 0, per_cu = 0;
        hipGetDevice(&dev); hipDeviceGetAttribute(&cus, hipDeviceAttributeMultiprocessorCount, dev);
        hipFuncSetAttribute((const void*)hymba_fwd, hipFuncAttributeMaxDynamicSharedMemorySize, LDS_BYTES);
        hipOccupancyMaxActiveBlocksPerMultiprocessor(&per_cu, (const void*)hymba_fwd, NTHREADS, LDS_BYTES);
        if (per_cu < 1) { fprintf(stderr, "kernel_launch: occupancy query says %d blocks per CU\n", per_cu); per_cu = 1; }
        if (per_cu > 1) per_cu = 1;
        grid = cus * per_cu;
    }
    if (grid < 0) return;
    Params p{};
    for (int i = 0; i < 27; ++i) p.in[i] = (const float*)d_in[i];
    p.out = (float*)d_out; p.ws = (unsigned char*)d_ws;
    const int cuts[13] = {0, 1, 2, 3, 4, 5, 6, 7, 8, 9, 10, 11, 12};
    const int nl = MK_LAUNCHES == 1 ? 1 : NPHASE;
    for (int li = 0; li < nl; ++li) {
        p.ph_lo = nl == 1 ? 0 : cuts[li]; p.ph_hi = nl == 1 ? NPHASE : cuts[li + 1];
        void* args[] = {&p};
        hipError_t e = hipLaunchCooperativeKernel((const void*)hymba_fwd, dim3(grid), dim3(NTHREADS), args, LDS_BYTES, stream);
        if (e != hipSuccess) { fprintf(stderr, "cooperative launch failed: %s (grid %d)\n", hipGetErrorString(e), grid); break; }
    }
}
```

```cpp
#include <hip/hip_runtime.h>
#include <hip/hip_cooperative_groups.h>
#include <cstdint>
#include <cstdio>
namespace cg = cooperative_groups;

#define LAS __attribute__((address_space(3)))
#define DI __device__ __forceinline__
typedef unsigned short bf16_t;
typedef short bf16x8 __attribute__((ext_vector_type(8)));
typedef short s16x4 __attribute__((ext_vector_type(4)));
typedef float f32x2 __attribute__((ext_vector_type(2)));
typedef float f32x4 __attribute__((ext_vector_type(4)));
typedef float f32x16 __attribute__((ext_vector_type(16)));
typedef unsigned u32x2 __attribute__((ext_vector_type(2)));
typedef unsigned u32x4 __attribute__((ext_vector_type(4)));

constexpr int BATCH = 32, SEQ = 2048, DM = 1024, TOK = BATCH * SEQ;
constexpr int NPROJ = 3072;
constexpr int INCOLS = 2840;
constexpr int NEXP = 32, EHID = 512, ECAP = 65536;
constexpr float EPS = 1e-6f;
constexpr int NWAVES = 8, NTHREADS = 512;

constexpr size_t MiB = 1u << 20;
constexpr size_t WS_CTL = 0;
constexpr size_t WS_MOD = 1 * MiB;
constexpr size_t WS_ROPE = 2 * MiB;
constexpr size_t WS_WR = 3 * MiB;
constexpr size_t WS_WIN = 4 * MiB;
constexpr size_t WS_WOUT = 10 * MiB;
constexpr size_t WS_WC1 = 12 * MiB;
constexpr size_t WS_WGU = 16 * MiB;
constexpr size_t WS_WD = 80 * MiB;
constexpr size_t WS_LIST = 112 * MiB;
constexpr size_t WS_TIPOS = 120 * MiB;
constexpr size_t WS_TIE = WS_TIPOS + 512 * 1024;
constexpr size_t WS_TIW = WS_TIE + 256 * 1024;
constexpr size_t WS_ROWSS = 122 * MiB;
constexpr size_t WS_GATES = 126 * MiB;
constexpr size_t WS_KCMP = 132 * MiB;
constexpr size_t WS_VCMP = 133 * MiB;
constexpr size_t WS_UL = 134 * MiB;
constexpr size_t WS_A = 160 * MiB;
constexpr size_t WS_B = 288 * MiB;
constexpr size_t WS_C = 672 * MiB;
constexpr size_t WS_H1 = WS_A, WS_QN = WS_B + 128 * MiB, WS_QR = WS_B + 192 * MiB, WS_H2 = WS_A;
constexpr size_t WS_PROJ = WS_B, WS_AO = WS_B, WS_HH = WS_B, WS_Y = WS_B + 136 * MiB;
constexpr size_t WS_KC = WS_C, WS_VC = WS_C + 16 * MiB, WS_PE = WS_C + 32 * MiB, WS_KS = WS_C + 33 * MiB, WS_VS = WS_C + 49 * MiB,
                 WS_KW = WS_C + 65 * MiB, WS_VW = WS_C + 81 * MiB, WS_DQ = WS_C + 97 * MiB, WS_DK = WS_C + 161 * MiB, WS_DV = WS_C + 225 * MiB;
constexpr size_t WS_X1B = WS_C + 32 * MiB;
constexpr size_t WS_END = WS_C + 289 * MiB;
constexpr int CW_CNT = 0;
constexpr int CW_QDIFF = 64, CW_QNSA = 128;

constexpr int RING_BYTES = 131072;
constexpr int LDS_MISC = RING_BYTES;
constexpr int LDS_BYTES = 147456;

DI unsigned pk2(float lo, float hi) { typedef __bf16 b2 __attribute__((ext_vector_type(2))); f32x2 v = {lo, hi}; b2 b = __builtin_convertvector(v, b2); return __builtin_bit_cast(unsigned, b); }
DI unsigned short f2bf(float f) { return (unsigned short)(pk2(f, 0.f) & 0xffffu); }
DI float bf2f(unsigned short h) { return __uint_as_float((unsigned)h << 16); }
DI float bflo(unsigned w) { return __uint_as_float(w << 16); }
DI float bfhi(unsigned w) { return __uint_as_float(w & 0xffff0000u); }
DI float wave_sum(float v) {
#pragma unroll
    for (int o = 1; o < 64; o <<= 1) v += __shfl_xor(v, o);
    return v;
}
DI float fast_exp2(float x) { return __builtin_amdgcn_exp2f(x); }
DI float fast_rcp(float x) { return __builtin_amdgcn_rcpf(x); }
#define MFMA32(a, b, c) __builtin_amdgcn_mfma_f32_32x32x16_bf16((a), (b), (c), 0, 0, 0)
#define MFMA16(a, b, c) __builtin_amdgcn_mfma_f32_16x16x32_bf16((a), (b), (c), 0, 0, 0)
typedef int v8i32 __attribute__((ext_vector_type(8)));
DI unsigned pk4_fp8(float a, float b, float c, float d) { int w = 0; w = __builtin_amdgcn_cvt_pk_fp8_f32(a, b, w, false); w = __builtin_amdgcn_cvt_pk_fp8_f32(c, d, w, true); return (unsigned)w; }
DI f32x4 ldnt4(const float* p) { return __builtin_nontemporal_load((const f32x4*)p); }
DI u32x4 ldntu4(const void* p) { return __builtin_nontemporal_load((const u32x4*)p); }
DI void stnt4(float* p, f32x4 v) { __builtin_nontemporal_store(v, (f32x4*)p); }
DI int crow(int r, int hi) { return (r & 3) + 8 * (r >> 2) + 4 * hi; }

DI int lane_id_fresh() { int l; asm volatile("v_mbcnt_lo_u32_b32 %0, -1, 0\n\tv_mbcnt_hi_u32_b32 %0, -1, %0" : "=v"(l)); return l; }
DI void glds16s(const void* sbase, unsigned voff, unsigned lds_dst) { unsigned keep;
    asm volatile("s_mov_b32 %0, m0\n\ts_mov_b32 m0, %3\n\ts_nop 0\n\tglobal_load_lds_dwordx4 %1, %2\n\ts_mov_b32 m0, %0" : "=&s"(keep) : "v"(voff), "s"(sbase), "s"(lds_dst) : "memory"); }
struct Params { const float* in[27]; float* out; unsigned char* ws; int ph_lo, ph_hi; };

namespace pg8 {
constexpr int BM = 256, BK = 64, HALF = 128, HTB = HALF * BK * 2, STAGE_BYTES = 8 * HTB, NXCD = 8, WGM = 8;
DI int lds_byte(int r, int c) { const int st = (r >> 4) * 2 + (c >> 5), rr = r & 15, cc = c & 31, ob = rr * 64 + cc * 2; return st * 1024 + (ob ^ (((ob >> 9) & 1) << 5)); }
DI void stage_rc(int b, int& R, int& C) { const int st = b / 1024, sb = b % 1024, swz = sb ^ (((sb >> 9) & 1) << 5); R = (st >> 1) * 16 + swz / 64; C = (st & 1) * 32 + (swz % 64) / 2; }
DI int perm32(int rho) { const int n = rho >> 4, i = rho & 15; return 8 * (i >> 2) + 4 * n + (i & 3); }

struct Unit { int pm, pn, aux; const char* Ab; const char* Bb; const int* tok; };

template <class Epi, class Sched, bool GATHER, bool FP8 = false>
DI void gemm_phase(LAS unsigned char* lds, LAS unsigned* tokl, const int K, const Sched& S, const Epi& E, const int wid, const int lane) {
    const int tid = wid * 64 + lane, wr = wid >> 2, wc = wid & 3, fr = lane & 15, fq = lane >> 4;
    const int nt = K / BK;
    unsigned voffA[2], voffB[2]; int RA[2], CA[2];
#pragma unroll
    for (int i = 0; i < 2; ++i) { int R, C; stage_rc(tid * 16 + i * 8192, R, C); const int Rb = Epi::PERM ? ((R & ~31) + perm32(R & 31)) : R;
        voffA[i] = (unsigned)(R * K + C) * 2u; voffB[i] = (unsigned)(Rb * K + C) * 2u; RA[i] = R; CA[i] = C; }
    const size_t kstep = (size_t)(BK * 2);
    const size_t hstep = (size_t)HALF * K * 2;
    const unsigned ldsw = (unsigned)wid * 1024u; const unsigned ldsb = (unsigned)(uintptr_t)lds;
    const int aoff = lds_byte(wr * 64 + fr, fq * 8), boff = lds_byte(wc * 32 + fr, fq * 8);
#define PG8_SA(b, h) (((b) * 2 + (h)) * HTB)
#define PG8_SB(b, h) ((4 + (b) * 2 + (h)) * HTB)
#define PG8_STG(bufoff, gbase, voff) do { _Pragma("unroll") for (int _i = 0; _i < 2; ++_i) \
        glds16s((const void*)(gbase), (voff)[_i], (unsigned)__builtin_amdgcn_readfirstlane((int)(ldsb + (unsigned)(bufoff) + ldsw + (unsigned)_i * 8192u))); } while (0)
#define PG8_STA(bufoff, gbase, h, bsel) do { if constexpr (GATHER) { unsigned vv_[2];   \
            _Pragma("unroll") for (int _j = 0; _j < 2; ++_j) vv_[_j] = tokl[(bsel) * 256 + (h) * 128 + RA[_j]] * (unsigned)(K * 2) + (unsigned)(CA[_j] * 2); \
            PG8_STG(bufoff, gbase, vv_); } else { PG8_STG(bufoff, (gbase) + (h) * hstep, voffA); } } while (0)
#define PG8_LD8(p_) ({ const u32x4 lo_ = *(const LAS u32x4*)(p_), hi_ = *(const LAS u32x4*)((p_) + 1024); (v8i32){(int)lo_.x, (int)lo_.y, (int)lo_.z, (int)lo_.w, (int)hi_.x, (int)hi_.y, (int)hi_.z, (int)hi_.w}; })
#define PG8_LDA(dst, b, h) do { if constexpr (FP8) { _Pragma("unroll") for (int m = 0; m < 4; ++m) dst##8[m] = PG8_LD8(lds + PG8_SA(b, h) + aoff + m * 2048); } \
        else { _Pragma("unroll") for (int m = 0; m < 4; ++m) _Pragma("unroll") for (int k = 0; k < 2; ++k) dst[m][k] = *(const LAS bf16x8*)(lds + PG8_SA(b, h) + aoff + m * 2048 + k * 1024); } } while (0)
#define PG8_LDB(dst, b, h) do { if constexpr (FP8) { _Pragma("unroll") for (int n = 0; n < 2; ++n) dst##8[n] = PG8_LD8(lds + PG8_SB(b, h) + boff + n * 2048); } \
        else { _Pragma("unroll") for (int n = 0; n < 2; ++n) _Pragma("unroll") for (int k = 0; k < 2; ++k) dst[n][k] = *(const LAS bf16x8*)(lds + PG8_SB(b, h) + boff + n * 2048 + k * 1024); } } while (0)
#define PG8_MMA(ai, bj, At, Bt) do { __builtin_amdgcn_s_setprio(1); _Pragma("unroll") for (int m = 0; m < 4; ++m) _Pragma("unroll") for (int n = 0; n < 2; ++n) { \
        if constexpr (FP8) {   \
            asm volatile("v_mfma_scale_f32_16x16x128_f8f6f4 %0, %1, %2, %0, %3, %4 op_sel_hi:[0,0,0]" : "+v"(acc[ai][bj][m][n]) : "v"(Bt##8[n]), "v"(At##8[m]), "v"(sclB_), "v"(sclA_)); \
        } else { _Pragma("unroll") for (int k = 0; k < 2; ++k) acc[ai][bj][m][n] = __builtin_amdgcn_mfma_f32_16x16x32_bf16(Bt[n][k], At[m][k], acc[ai][bj][m][n], 0, 0, 0); } } \
        __builtin_amdgcn_s_setprio(0); } while (0)
#define PG8_WAIT_V(n) asm volatile("s_waitcnt vmcnt(" #n ")" ::: "memory")
#define PG8_WAIT_L(n) asm volatile("s_waitcnt lgkmcnt(" #n ")" ::: "memory")
#define PG8_BAR __builtin_amdgcn_s_barrier()
#define PG8_SCHED __builtin_amdgcn_sched_barrier(0)
    Unit cur, nxt; int ui = 0;
    if (!S.next(0, cur)) return;
    f32x4 acc[2][2][4][2];
#pragma unroll
    for (int a = 0; a < 2; ++a)
#pragma unroll
        for (int b = 0; b < 2; ++b)
#pragma unroll
            for (int m = 0; m < 4; ++m)
#pragma unroll
                for (int n = 0; n < 2; ++n) acc[a][b][m][n] = (f32x4){0.f, 0.f, 0.f, 0.f};
    bf16x8 At[4][2], B0[2][2], B1[2][2];
    v8i32 At8[4], B08[2], B18[2];
    int sclB_ = 0x77777777, sclA_ = 0x7f7f7f7f; asm volatile("" : "+v"(sclB_), "+v"(sclA_));
    const char* cA = cur.Ab; const char* cB = cur.Bb;
    if constexpr (GATHER) {
        if (wid < 4) __builtin_amdgcn_global_load_lds((const unsigned*)(cur.tok + wid * 64 + lane), (LAS unsigned*)(tokl + wid * 64), 4, 0, 0);
        PG8_WAIT_V(0); PG8_BAR;
    }
    PG8_STG(PG8_SB(0, 0), cB, voffB); PG8_STG(PG8_SB(0, 1), cB + hstep, voffB); PG8_STA(PG8_SA(0, 0), cA, 0, 0); PG8_STA(PG8_SA(0, 1), cA, 1, 0);
    if (wr == 1) PG8_BAR;
    PG8_WAIT_V(2); PG8_BAR;
    PG8_STG(PG8_SB(1, 0), cB + kstep, voffB); PG8_STA(PG8_SA(1, 0), cA + kstep, 0, 0); PG8_STG(PG8_SB(1, 1), cB + hstep + kstep, voffB);
    PG8_WAIT_V(6); PG8_BAR;
    for (;;) {
        const bool has_next = S.next(ui + 1, nxt);
        const char* nA = has_next ? nxt.Ab : cA; const char* nB = has_next ? nxt.Bb : cB;
        if constexpr (GATHER) {
            if (has_next && wid < 4) __builtin_amdgcn_global_load_lds((const unsigned*)(nxt.tok + wid * 64 + lane), (LAS unsigned*)(tokl + ((ui + 1) & 1) * 256 + wid * 64), 4, 0, 0);
        }
#pragma unroll 1
        for (int t = 0; t < nt; t += 2) {
            const bool last = (t == nt - 2);
            const char* a1 = cA + (size_t)(t + 1) * kstep;
            const char* a2 = last ? nA : cA + (size_t)(t + 2) * kstep; const char* b2 = last ? nB : cB + (size_t)(t + 2) * kstep;
            const char* a3 = a2 + kstep; const char* b3 = b2 + kstep;
            const int bc_ = ui & 1, bn_ = (last && has_next) ? ((ui + 1) & 1) : (ui & 1);
            PG8_LDB(B0, 0, 0); PG8_LDB(B1, 0, 1); PG8_SCHED; PG8_LDA(At, 0, 0); PG8_STA(PG8_SA(1, 1), a1, 1, bc_);
            PG8_WAIT_V(8); PG8_WAIT_L(0); PG8_BAR; PG8_MMA(0, 0, At, B0); PG8_MMA(0, 1, At, B1); PG8_BAR; PG8_SCHED;
            PG8_LDA(At, 0, 1); PG8_STG(PG8_SB(0, 0), b2, voffB); PG8_STG(PG8_SB(0, 1), b2 + hstep, voffB); PG8_STA(PG8_SA(0, 0), a2, 0, bn_);
            PG8_WAIT_V(8); PG8_WAIT_L(0); PG8_BAR; PG8_MMA(1, 0, At, B0); PG8_MMA(1, 1, At, B1); PG8_BAR; PG8_SCHED;
            PG8_LDB(B0, 1, 0); PG8_LDB(B1, 1, 1); PG8_SCHED; PG8_LDA(At, 1, 0); PG8_STA(PG8_SA(0, 1), a2, 1, bn_);
            PG8_WAIT_V(8); PG8_WAIT_L(0); PG8_BAR; PG8_MMA(0, 0, At, B0); PG8_MMA(0, 1, At, B1); PG8_BAR; PG8_SCHED;
            PG8_LDA(At, 1, 1); PG8_STG(PG8_SB(1, 0), b3, voffB); PG8_STG(PG8_SB(1, 1), b3 + hstep, voffB); PG8_STA(PG8_SA(1, 0), a3, 0, bn_);
            PG8_WAIT_V(8); PG8_WAIT_L(0); PG8_BAR; PG8_MMA(1, 0, At, B0); PG8_MMA(1, 1, At, B1); PG8_BAR; PG8_SCHED;
        }
        if (wr == 0) PG8_BAR;
        if constexpr (FP8) asm volatile("s_nop 15\n\ts_nop 15" ::: "memory");
        E(acc, cur, wr, wc, fr, fq);
        if (!has_next) break;
#pragma unroll
        for (int a = 0; a < 2; ++a)
#pragma unroll
            for (int b = 0; b < 2; ++b)
#pragma unroll
                for (int m = 0; m < 4; ++m)
#pragma unroll
                    for (int n = 0; n < 2; ++n) acc[a][b][m][n] = (f32x4){0.f, 0.f, 0.f, 0.f};
        cur = nxt; cA = nA; cB = nB; ++ui;
        if (wr == 1) PG8_BAR;
    }
    PG8_WAIT_V(0);
    PG8_BAR;
#undef PG8_SA
#undef PG8_SB
#undef PG8_STG
#undef PG8_STA
#undef PG8_LDA
#undef PG8_LDB
#undef PG8_MMA
#undef PG8_WAIT_V
#undef PG8_WAIT_L
#undef PG8_BAR
#undef PG8_SCHED
}

struct StaticOrder {
    int nM, nN, nwg, G, c; const char* A; const char* Bt; size_t tstep;
    DI void init(int M, int N, int K, int G_, int c_, const void* A_, const void* Bt_) { nM = M / BM; nN = N / BM; nwg = nM * nN; G = G_; c = c_; A = (const char*)A_; Bt = (const char*)Bt_; tstep = (size_t)BM * K * 2; }
    DI bool next(int i, Unit& u) const {
        const long L = (long)i * G + c; if (L >= nwg) return false;
        int wgid = (int)L; { const int q = nwg / NXCD, r = nwg % NXCD, xcd = wgid % NXCD, off = wgid / NXCD; wgid = (xcd < r ? xcd * (q + 1) : r * (q + 1) + (xcd - r) * q) + off; }
        const int nig = WGM * nN, gid = wgid / nig, fm = gid * WGM, gsz = (nM - fm) < WGM ? (nM - fm) : WGM;
        u.pm = fm + ((wgid % nig) % gsz); u.pn = (wgid % nig) / gsz; u.aux = 0; u.Ab = A + (size_t)u.pm * tstep; u.Bb = Bt + (size_t)u.pn * tstep; u.tok = nullptr; return true;
    }
};
struct CompressOrder {
    int G, c; const char* KC; const char* PE; const char* W;
    DI bool next(int i, Unit& u) const {
        const int L = i * G + c; if (L >= 132) return false;
        u.pm = L >> 1; u.pn = L & 1; const int kv = u.pm < 32 ? 0 : (u.pm < 64 ? 1 : u.pm - 64); u.aux = kv;
        u.Ab = u.pm < 64 ? KC + (size_t)u.pm * (256 * 1024 * 2) : PE; u.Bb = W + (size_t)kv * (512 * 1024 * 2) + (size_t)u.pn * (256 * 1024 * 2); u.tok = nullptr; return true;
    }
};
struct MoeOrder {
    int G, c, mode; const LAS int* tb; const char* A; const char* W; const int* lists;
    DI bool next(int i, Unit& u) const {
        const int L = i * G + c; const int mt = L >> 2; if (mt >= tb[32]) return false;
        int e = 0;
#pragma unroll 1
        for (int j = 1; j < 32; ++j) e += (tb[j] <= mt) ? 1 : 0;
        u.pm = mt; u.pn = L & 3; u.aux = e;
        if (mode == 0) { u.Ab = A; u.Bb = W + (size_t)e * (1024 * 1024) + (size_t)u.pn * (256 * 1024); u.tok = lists + (size_t)e * ECAP + (size_t)(mt - tb[e]) * 256; }
        else { u.Ab = A + (size_t)mt * (256 * 512); u.Bb = W + (size_t)e * (1024 * 512) + (size_t)u.pn * (256 * 512); u.tok = nullptr; }
        return true;
    }
};

struct EpiBf16 {
    static constexpr bool PERM = true;
    bf16_t* O; int ldc;
    DI void operator()(const f32x4 (&acc)[2][2][4][2], const Unit& u, int wr, int wc, int fr, int fq) const {
        asm volatile("" : "+v"(fr), "+v"(fq));
        const int row0 = u.pm * BM + wr * 64 + fr; const int col0 = u.pn * BM + wc * 32 + 8 * fq;
#pragma unroll
        for (int ai = 0; ai < 2; ++ai)
#pragma unroll
            for (int m = 0; m < 4; ++m) { bf16_t* rowp = O + (size_t)(row0 + ai * HALF + m * 16) * ldc + col0;
#pragma unroll
                for (int bj = 0; bj < 2; ++bj) { const f32x4 v0 = acc[ai][bj][m][0], v1 = acc[ai][bj][m][1];
                    u32x4 w; w.x = pk2(v0[0], v0[1]); w.y = pk2(v0[2], v0[3]); w.z = pk2(v1[0], v1[1]); w.w = pk2(v1[2], v1[3]);
                    *(u32x4*)(rowp + bj * HALF) = w; } }
    }
};
struct EpiInProj {
    static constexpr bool PERM = true;
    unsigned char* ws; const float* g_nq; const float* g_nk; const float* g_dq; const float* g_dk; LAS float* xch;
    DI void operator()(const f32x4 (&acc)[2][2][4][2], const Unit& u, int wr, int wc, int fr, int fq) const {
        const int pn = u.pn, wid = wr * 4 + wc; const int tok0 = u.pm * BM; const int b = tok0 >> 11; int t0 = (tok0 & 2047) + wr * 64 + fr;
        int xo_i = wid * 256 + fr, xp_i = (wid ^ 1) * 256 + fr;
        asm volatile("" : "+v"(t0), "+v"(xo_i), "+v"(xp_i));
        LAS float* xo = xch + xo_i; LAS float* xp = xch + xp_i;
        const float* ropeN = (const float*)(ws + WS_ROPE); const float* ropeD = ropeN + 2048 * 16;
        const int d0 = 32 * (wc & 1) + 8 * fq;
        if (pn <= 4) {
            const bool nrm0 = (pn != 2), nrm1 = (pn < 2);
            if (pn != 2) {
#pragma unroll
                for (int ai = 0; ai < 2; ++ai)
#pragma unroll
                    for (int m = 0; m < 4; ++m)
#pragma unroll
                        for (int bj = 0; bj < 2; ++bj) { const f32x4 a = acc[ai][bj][m][0], c = acc[ai][bj][m][1];
                            float ss = (a[0] * a[0] + a[1] * a[1]) + (a[2] * a[2] + a[3] * a[3]) + (c[0] * c[0] + c[1] * c[1]) + (c[2] * c[2] + c[3] * c[3]);
                            ss += __shfl_xor(ss, 16); ss += __shfl_xor(ss, 32);
                            if (fq == 0) xo[((ai * 4 + m) * 2 + bj) * 16] = ss; }
                asm volatile("s_waitcnt lgkmcnt(0)" ::: "memory"); __builtin_amdgcn_s_barrier(); asm volatile("" ::: "memory");
            }
            const float* gg = pn < 2 ? g_nq : (g_nk + (pn == 3 ? 64 : 128));
            f32x4 g0 = {1.f, 1.f, 1.f, 1.f}, g1 = g0;
            if (pn != 2) { g0 = *(const f32x4*)(gg + d0); g1 = *(const f32x4*)(gg + d0 + 4); }
            const bool ropew = (wc & 1) == 0;
#pragma unroll
            for (int ai = 0; ai < 2; ++ai)
#pragma unroll
                for (int m = 0; m < 4; ++m) {
                    const int t = t0 + ai * HALF + m * 16;
                    f32x4 cs0 = {1.f, 0.f, 1.f, 0.f}, cs1 = cs0, cs2 = cs0, cs3 = cs0;
                    if (pn != 2 && ropew && fq < 2) { const f32x4* rp = (const f32x4*)(ropeN + t * 16); cs0 = rp[0]; cs1 = rp[1]; cs2 = rp[2]; cs3 = rp[3]; }
#pragma unroll
                    for (int bj = 0; bj < 2; ++bj) {
                        const bool donorm = bj == 0 ? nrm0 : nrm1;
                        f32x4 ya = acc[ai][bj][m][0], yb = acc[ai][bj][m][1];
                        u32x4 w0, w1;
                        if (donorm) {
                            const float rstd = rsqrtf((xo[((ai * 4 + m) * 2 + bj) * 16] + xp[((ai * 4 + m) * 2 + bj) * 16]) * (1.f / 64.f) + EPS);
                            ya = ya * rstd * g0; yb = yb * rstd * g1;
                            w0.x = pk2(ya[0], ya[1]); w0.y = pk2(ya[2], ya[3]); w0.z = pk2(yb[0], yb[1]); w0.w = pk2(yb[2], yb[3]);
                            f32x4 ra = ya, rb = yb;
                            if (ropew) {
                                f32x4 pa, pb;
#pragma unroll
                                for (int i = 0; i < 4; ++i) { pa[i] = __shfl_xor(ya[i], 16); pb[i] = __shfl_xor(yb[i], 16); }
                                if (fq == 0) { ra[0] = ya[0] * cs0[0] - pa[0] * cs0[1]; ra[1] = ya[1] * cs0[2] - pa[1] * cs0[3]; ra[2] = ya[2] * cs1[0] - pa[2] * cs1[1]; ra[3] = ya[3] * cs1[2] - pa[3] * cs1[3];
                                               rb[0] = yb[0] * cs2[0] - pb[0] * cs2[1]; rb[1] = yb[1] * cs2[2] - pb[1] * cs2[3]; rb[2] = yb[2] * cs3[0] - pb[2] * cs3[1]; rb[3] = yb[3] * cs3[2] - pb[3] * cs3[3]; }
                                else if (fq == 1) { ra[0] = pa[0] * cs0[1] + ya[0] * cs0[0]; ra[1] = pa[1] * cs0[3] + ya[1] * cs0[2]; ra[2] = pa[2] * cs1[1] + ya[2] * cs1[0]; ra[3] = pa[3] * cs1[3] + ya[3] * cs1[2];
                                                    rb[0] = pb[0] * cs2[1] + yb[0] * cs2[0]; rb[1] = pb[1] * cs2[3] + yb[1] * cs2[2]; rb[2] = pb[2] * cs3[1] + yb[2] * cs3[0]; rb[3] = pb[3] * cs3[3] + yb[3] * cs3[2]; }
                            }
                            w1.x = pk2(ra[0], ra[1]); w1.y = pk2(ra[2], ra[3]); w1.z = pk2(rb[0], rb[1]); w1.w = pk2(rb[2], rb[3]);
                        } else { w0.x = pk2(ya[0], ya[1]); w0.y = pk2(ya[2], ya[3]); w0.z = pk2(yb[0], yb[1]); w0.w = pk2(yb[2], yb[3]); w1 = w0; }
                        const int hq = 2 * bj + (wc >> 1);
                        if (pn < 2) { const size_t off = (((size_t)b * 8 + 4 * pn + hq) * SEQ + t) * 64 + d0;
                            *(u32x4*)((bf16_t*)(ws + WS_QN) + off) = w0; *(u32x4*)((bf16_t*)(ws + WS_QR) + off) = w1; }
                        else { const int six = 2 * (pn - 2) + bj; const size_t base = six == 0 ? WS_KC : six == 1 ? WS_VC : six == 2 ? WS_KS : six == 3 ? WS_VS : six == 4 ? WS_KW : WS_VW;
                            const size_t off = (((size_t)b * 2 + (wc >> 1)) * SEQ + t) * 64 + d0;
                            *(u32x4*)((bf16_t*)(ws + base) + off) = w1; }
                    }
                    asm volatile("" ::: "memory");
                }
        } else if (pn <= 8) {
            const bool isq = pn <= 6; const float* gg = isq ? g_dq : g_dk; bf16_t* dst = (bf16_t*)(ws + (isq ? WS_DQ : WS_DK));
            const f32x4 g0 = *(const f32x4*)(gg + 8 * fq), g1 = *(const f32x4*)(gg + 8 * fq + 4);
#pragma unroll
            for (int ai = 0; ai < 2; ++ai)
#pragma unroll
                for (int m = 0; m < 4; ++m) {
                    const int t = t0 + ai * HALF + m * 16;
                    f32x4 c0 = {1.f, 0.f, 1.f, 0.f}, c1 = c0;
                    if (fq == 0) { const f32x4* rp = (const f32x4*)(ropeD + t * 8); c0 = rp[0]; c1 = rp[1]; }
#pragma unroll
                    for (int bj = 0; bj < 2; ++bj) {
                        f32x4 ya = acc[ai][bj][m][0], yb = acc[ai][bj][m][1];
                        float ss = (ya[0] * ya[0] + ya[1] * ya[1]) + (ya[2] * ya[2] + ya[3] * ya[3]) + (yb[0] * yb[0] + yb[1] * yb[1]) + (yb[2] * yb[2] + yb[3] * yb[3]);
                        ss += __shfl_xor(ss, 16); ss += __shfl_xor(ss, 32);
                        const float rstd = rsqrtf(ss * (1.f / 32.f) + EPS);
                        ya = ya * rstd * g0; yb = yb * rstd * g1;
                        if (fq == 0) { const f32x4 a = ya, bb = yb;
                            ya[0] = a[0] * c0[0] - bb[0] * c0[1]; yb[0] = a[0] * c0[1] + bb[0] * c0[0]; ya[1] = a[1] * c0[2] - bb[1] * c0[3]; yb[1] = a[1] * c0[3] + bb[1] * c0[2];
                            ya[2] = a[2] * c1[0] - bb[2] * c1[1]; yb[2] = a[2] * c1[1] + bb[2] * c1[0]; ya[3] = a[3] * c1[2] - bb[3] * c1[3]; yb[3] = a[3] * c1[3] + bb[3] * c1[2]; }
                        u32x4 w; w.x = pk2(ya[0], ya[1]); w.y = pk2(ya[2], ya[3]); w.z = pk2(yb[0], yb[1]); w.w = pk2(yb[2], yb[3]);
                        const int hd = 4 * ((pn - 5) & 1) + 2 * bj + (wc >> 1);
                        *(u32x4*)(dst + (((size_t)b * 8 + hd) * SEQ + t) * 64 + d0) = w;
                    }
                    asm volatile("" ::: "memory");
                }
        } else if (pn <= 10) {
            bf16_t* dst = (bf16_t*)(ws + WS_DV);
#pragma unroll
            for (int ai = 0; ai < 2; ++ai)
#pragma unroll
                for (int m = 0; m < 4; ++m) { const int t = t0 + ai * HALF + m * 16;
#pragma unroll
                    for (int bj = 0; bj < 2; ++bj) { const f32x4 ya = acc[ai][bj][m][0], yb = acc[ai][bj][m][1];
                        u32x4 w; w.x = pk2(ya[0], ya[1]); w.y = pk2(ya[2], ya[3]); w.z = pk2(yb[0], yb[1]); w.w = pk2(yb[2], yb[3]);
                        const int hd = 4 * (pn - 9) + 2 * bj + (wc >> 1);
                        *(u32x4*)(dst + (((size_t)b * 8 + hd) * SEQ + t) * 64 + d0) = w; }
                    asm volatile("" ::: "memory"); }
        } else {
            if (wc == 0 && fq < 3) {
                float* gt = (float*)(ws + WS_GATES);
#pragma unroll
                for (int ai = 0; ai < 2; ++ai)
#pragma unroll
                    for (int m = 0; m < 4; ++m) { const size_t tok = (size_t)tok0 + wr * 64 + fr + ai * HALF + m * 16; const f32x4 ya = acc[ai][0][m][0], yb = acc[ai][0][m][1]; f32x4 sa, sb;
#pragma unroll
                        for (int i = 0; i < 4; ++i) { sa[i] = 1.f / (1.f + __expf(-ya[i])); sb[i] = 1.f / (1.f + __expf(-yb[i])); }
                        *(f32x4*)(gt + tok * 24 + 8 * fq) = sa; *(f32x4*)(gt + tok * 24 + 8 * fq + 4) = sb; }
            }
        }
    }
};
struct EpiFp8 {
    static constexpr bool PERM = true;
    unsigned char* O; int ldc;
    DI void operator()(const f32x4 (&acc)[2][2][4][2], const Unit& u, int wr, int wc, int fr, int fq) const {
        asm volatile("" : "+v"(fr), "+v"(fq));
        const int row0 = u.pm * BM + wr * 64 + fr; const int col0 = u.pn * BM + wc * 32 + 8 * fq;
#pragma unroll
        for (int ai = 0; ai < 2; ++ai)
#pragma unroll
            for (int m = 0; m < 4; ++m) { unsigned char* rowp = O + (size_t)(row0 + ai * HALF + m * 16) * ldc + col0;
#pragma unroll
                for (int bj = 0; bj < 2; ++bj) { const f32x4 v0 = acc[ai][bj][m][0], v1 = acc[ai][bj][m][1];
                    u32x2 w; w.x = pk4_fp8(v0[0], v0[1], v0[2], v0[3]); w.y = pk4_fp8(v1[0], v1[1], v1[2], v1[3]);
                    *(u32x2*)(rowp + bj * HALF) = w; } }
    }
};
struct EpiSwiglu {
    static constexpr bool PERM = true;
    unsigned char* O;
    DI void operator()(const f32x4 (&acc)[2][2][4][2], const Unit& u, int wr, int wc, int fr, int fq) const {
        asm volatile("" : "+v"(fr), "+v"(fq));
        const int row0 = u.pm * BM + wr * 64 + fr; const int col0 = u.pn * 128 + wc * 16 + 4 * fq;
#pragma unroll
        for (int ai = 0; ai < 2; ++ai)
#pragma unroll
            for (int m = 0; m < 4; ++m) { unsigned char* rowp = O + (size_t)(row0 + ai * HALF + m * 16) * EHID + col0;
#pragma unroll
                for (int bj = 0; bj < 2; ++bj) { const f32x4 g = acc[ai][bj][m][0], up = acc[ai][bj][m][1]; float h[4];
#pragma unroll
                    for (int i = 0; i < 4; ++i) { const float s = fast_rcp(1.f + __expf(-g[i])); h[i] = g[i] * s * up[i]; }
                    *(unsigned*)(rowp + bj * 64) = pk4_fp8(h[0], h[1], h[2], h[3]); } }
    }
};
struct EpiOutProj {
    static constexpr bool PERM = true;
    const float* x; bf16_t* x1b; const float* mod; float* rowss;
    DI void operator()(const f32x4 (&acc)[2][2][4][2], const Unit& u, int wr, int wc, int fr, int fq) const {
        const int col0 = u.pn * BM + wc * 32 + 8 * fq; const int b = (u.pm * BM) / SEQ;
        const float* g1 = mod + (size_t)b * 6144 + 2048 + col0;
        f32x4 gv[2][2];
#pragma unroll
        for (int bj = 0; bj < 2; ++bj)
#pragma unroll
            for (int n = 0; n < 2; ++n) gv[bj][n] = *(const f32x4*)(g1 + bj * HALF + n * 4);
#pragma unroll
        for (int ai = 0; ai < 2; ++ai)
#pragma unroll
            for (int m = 0; m < 4; ++m) { const int r = u.pm * BM + ai * HALF + wr * 64 + m * 16 + fr; const size_t off = (size_t)r * DM + col0; float ss = 0.f;
#pragma unroll
                for (int bj = 0; bj < 2; ++bj) { const f32x4 xa = ldnt4(x + off + bj * HALF), xb = ldnt4(x + off + bj * HALF + 4);
                    const f32x4 oa = xa + gv[bj][0] * acc[ai][bj][m][0], ob = xb + gv[bj][1] * acc[ai][bj][m][1];
                    ss += (oa[0] * oa[0] + oa[1] * oa[1]) + (oa[2] * oa[2] + oa[3] * oa[3]) + (ob[0] * ob[0] + ob[1] * ob[1]) + (ob[2] * ob[2] + ob[3] * ob[3]);
                    u32x4 w; w.x = pk2(oa[0], oa[1]); w.y = pk2(oa[2], oa[3]); w.z = pk2(ob[0], ob[1]); w.w = pk2(ob[2], ob[3]);
                    *(u32x4*)(x1b + off + bj * HALF) = w; }
                ss += __shfl_xor(ss, 16); ss += __shfl_xor(ss, 32);
                if (fq == 0) rowss[(size_t)r * 16 + u.pn * 4 + wc] = ss; }
    }
};
}

struct Frame {
    LAS unsigned char* lds; unsigned char* ws; const float* const* in; float* out;
    int tid, lane, wave, bid, G, gw, NGW;
};

DI int origcol(int n) { return n < 1280 ? n : (n < 2816 ? n + 24 : (n < 2840 ? n - 2816 + 1280 : -1)); }

template <class DRow>
DI void tr_item(const float* src, int src_ld, int sc  , bf16_t* dst, int dst_ld, int k0, LAS float* scr, int lane, DRow drow) {
#pragma unroll 8
    for (int i = 0; i < 32; ++i) { const int kk = 2 * i + (lane >> 5); scr[kk * 33 + (lane & 31)] = sc >= 0 ? src[(size_t)(k0 + kk) * src_ld + sc] : 0.f; }
    asm volatile("s_waitcnt lgkmcnt(0)" ::: "memory");
    const int c = lane & 7;
#pragma unroll
    for (int j = 0; j < 4; ++j) { const int n = (lane >> 3) + 8 * j; const LAS float* s = scr + (8 * c) * 33 + n;
        u32x4 o; o.x = pk2(s[0 * 33], s[1 * 33]); o.y = pk2(s[2 * 33], s[3 * 33]); o.z = pk2(s[4 * 33], s[5 * 33]); o.w = pk2(s[6 * 33], s[7 * 33]);
        *(u32x4*)(dst + (size_t)drow(n) * dst_ld + k0 + 8 * c) = o; }
    asm volatile("s_waitcnt lgkmcnt(0)" ::: "memory");
}

DI void phase0(Frame& F) {
    const float* c_in = F.in[1]; const float* w_ada = F.in[2]; const float* b_ada = F.in[3];
    float* mod = (float*)(F.ws + WS_MOD);
    for (int it = F.bid; it < 96; it += F.G) {
        LAS float* cs = (LAS float*)F.lds;
        for (int idx = F.tid; idx < 32 * 1024; idx += NTHREADS) { const int b = idx >> 10, k = idx & 1023; cs[k * 32 + b] = c_in[idx]; }
        __syncthreads();
        float acc[32];
#pragma unroll
        for (int b = 0; b < 32; ++b) acc[b] = 0.f;
        const int j = it * 64 + F.lane;
#pragma unroll 1
        for (int kg = 0; kg < 4; ++kg) {
            float wv[32];
#pragma unroll
            for (int q = 0; q < 32; ++q) wv[q] = w_ada[(size_t)(F.wave * 128 + kg * 32 + q) * 6144 + j];
#pragma unroll
            for (int q = 0; q < 32; ++q) { const int k = F.wave * 128 + kg * 32 + q; const float w = wv[q];
#pragma unroll
                for (int b4 = 0; b4 < 8; ++b4) { const f32x4 cv = *(const LAS f32x4*)(cs + k * 32 + b4 * 4); acc[b4 * 4 + 0] += cv[0] * w; acc[b4 * 4 + 1] += cv[1] * w; acc[b4 * 4 + 2] += cv[2] * w; acc[b4 * 4 + 3] += cv[3] * w; } }
        }
        __syncthreads();
        LAS float* red = (LAS float*)F.lds;
#pragma unroll
        for (int b = 0; b < 32; ++b) red[(F.wave * 32 + b) * 64 + F.lane] = acc[b];
        __syncthreads();
        for (int o = F.tid; o < 2048; o += NTHREADS) { const int b = o >> 6, l = o & 63; float s = b_ada[it * 64 + l];
#pragma unroll
            for (int w = 0; w < 8; ++w) s += red[(w * 32 + b) * 64 + l];
            mod[(size_t)b * 6144 + it * 64 + l] = s; }
        __syncthreads();
    }
    const int gt = F.bid * NTHREADS + F.tid, NGT = F.G * NTHREADS;
    { float* ropeN = (float*)(F.ws + WS_ROPE); float* ropeD = ropeN + 2048 * 16;
      for (int i = gt; i < 2048 * 12; i += NGT) { const int t = i / 12, j = i % 12; const bool isn = j < 8; const int ii = isn ? j : j - 8;
          const float ex = isn ? (float)(2 * ii) / 16.f : (float)(2 * ii) / 8.f;
          const float inv = exp2f(-ex * 18.931568569324174f);
          const float ang = (float)t * inv;
          const double rev = (double)ang * 0.15915494309189535; const double fr = rev - __builtin_rint(rev); const float rr = (float)(fr * 6.283185307179586);
          const float cs = __cosf(rr), sn = __sinf(rr);
          if (isn) { ropeN[(t * 8 + ii) * 2] = cs; ropeN[(t * 8 + ii) * 2 + 1] = sn; } else { ropeD[(t * 4 + ii) * 2] = cs; ropeD[(t * 4 + ii) * 2 + 1] = sn; } } }
    { bf16_t* whi = (bf16_t*)(F.ws + WS_WR); bf16_t* wlo = whi + 48 * 1024;
      for (int i = gt; i < 48 * 1024; i += NGT) { const int c = i >> 10, k = i & 1023; float w = 0.f;
          if (c < 4) w = F.in[20][k * 4 + c]; else if (c < 36) w = F.in[22][k * 32 + (c - 4)];
          const unsigned short h = f2bf(w); whi[i] = h; wlo[i] = f2bf(w - bf2f(h)); } }
    { bf16_t* pe = (bf16_t*)(F.ws + WS_PE);
      for (int i = gt; i < 256 * 1024; i += NGT) { const int r = i >> 10, k = i & 1023; float v = 0.f; if (r < 4) v = F.in[9][(r >> 1) * 2048 + (r & 1) * 1024 + k]; pe[i] = f2bf(v); } }
    { u32x4* l4 = (u32x4*)(F.ws + WS_LIST); for (int i = gt; i < (int)(NEXP * ECAP / 4); i += NGT) l4[i] = (u32x4){0u, 0u, 0u, 0u};
      unsigned* ctl = (unsigned*)(F.ws + WS_CTL); for (int i = gt; i < 8192; i += NGT) ctl[i] = 0u; }
}

struct TrD { const float* src; int ld; int sc; bf16_t* dst; int dld; int k0; int mode; int n0; int aux; int fp8; };
DI TrD tr_desc(Frame& F, int it, int lane) {
    constexpr int I_IN = 16 * 96, I_OUT = 16 * 32, I_G = 32 * 16 * 16, I_D = 32 * 8 * 32;
    TrD d; int r = it; const int nq = lane & 7;
    if (r < I_IN) { const int kb = r / 96, nb = r % 96; d.n0 = nb * 32; const int n = d.n0 + 4 * nq; d.src = F.in[6]; d.ld = INCOLS; d.sc = origcol(n); d.dst = (bf16_t*)(F.ws + WS_WIN); d.dld = 1024; d.k0 = kb * 64; d.mode = 0; d.aux = 0; d.fp8 = 0; return d; }
    r -= I_IN;
    if (r < I_OUT) { const int kb = r / 32, nb = r % 32; d.n0 = nb * 32; d.src = F.in[19]; d.ld = 1024; d.sc = d.n0 + 4 * nq; d.dst = (bf16_t*)(F.ws + WS_WOUT); d.dld = 1024; d.k0 = kb * 64; d.mode = 0; d.aux = 0; d.fp8 = 0; return d; }
    r -= I_OUT;
    if (r < 2 * I_G) { const int up = r / I_G; r -= up * I_G; const int e = r / 256, q = r % 256, kb = q / 16, nb = q % 16; d.n0 = nb * 32;
        d.src = F.in[24 + up] + (size_t)e * 1024 * 512; d.ld = 512; d.sc = d.n0 + 4 * nq; d.dst = (bf16_t*)(F.ws + WS_WGU + (size_t)e * 1024 * 1024); d.dld = 1024; d.k0 = kb * 64; d.mode = 1; d.aux = up; d.fp8 = 1; return d; }
    r -= 2 * I_G;
    if (r < I_D) { const int e = r / 256, q = r % 256, kb = q / 32, nb = q % 32; d.n0 = nb * 32;
        d.src = F.in[26] + (size_t)e * 512 * 1024; d.ld = 1024; d.sc = d.n0 + 4 * nq; d.dst = (bf16_t*)(F.ws + WS_WD + (size_t)e * 1024 * 512); d.dld = 512; d.k0 = kb * 64; d.mode = 0; d.aux = 0; d.fp8 = 1; return d; }
    r -= I_D;
    { const int kvh = r / 128, q = r % 128, kb = q / 8, nb = q % 8; d.n0 = nb * 32; const int kv = kvh >> 1, half = kvh & 1;
      d.src = F.in[10] + (size_t)kv * 2048 * 256 + (size_t)half * 1024 * 256; d.ld = 256; d.sc = d.n0 + 4 * nq; d.dst = (bf16_t*)(F.ws + WS_WC1) + (size_t)kv * 512 * 1024; d.dld = 1024; d.k0 = kb * 64; d.mode = 2; d.aux = half; d.fp8 = 0; return d; }
}
DI void tr_load(const TrD& d, f32x4 (&v)[8], int lane) {
    const int kk = lane >> 3;
#pragma unroll
    for (int i = 0; i < 8; ++i) v[i] = d.sc >= 0 ? ldnt4(d.src + (size_t)(d.k0 + kk + 8 * i) * d.ld + d.sc) : (f32x4){0.f, 0.f, 0.f, 0.f};
}
DI void tr_finish(const TrD& d, const f32x4 (&v)[8], LAS float* scr, int lane) {
    const int kk = lane >> 3, nq = lane & 7;
#pragma unroll
    for (int i = 0; i < 8; ++i) *(LAS f32x4*)(scr + (kk + 8 * i) * 36 + 4 * nq) = v[i];
    asm volatile("s_waitcnt lgkmcnt(0)" ::: "memory");
    const int c = lane & 7;
#pragma unroll
    for (int j = 0; j < 4; ++j) { const int n = (lane >> 3) + 8 * j; const LAS float* s = scr + (8 * c) * 36 + n;
        const int jn = d.n0 + n; const int row = d.mode == 0 ? jn : (d.mode == 1 ? 8 * (jn >> 2) + (jn & 3) + 4 * d.aux : d.aux * 256 + jn);
        if (d.fp8) { u32x2 o8; o8.x = pk4_fp8(s[0 * 36] * 256.f, s[1 * 36] * 256.f, s[2 * 36] * 256.f, s[3 * 36] * 256.f); o8.y = pk4_fp8(s[4 * 36] * 256.f, s[5 * 36] * 256.f, s[6 * 36] * 256.f, s[7 * 36] * 256.f);
            *(u32x2*)((unsigned char*)d.dst + (size_t)row * d.dld + d.k0 + 8 * c) = o8; }
        else { u32x4 o; o.x = pk2(s[0 * 36], s[1 * 36]); o.y = pk2(s[2 * 36], s[3 * 36]); o.z = pk2(s[4 * 36], s[5 * 36]); o.w = pk2(s[6 * 36], s[7 * 36]);
            *(u32x4*)(d.dst + (size_t)row * d.dld + d.k0 + 8 * c) = o; } }
    asm volatile("s_waitcnt lgkmcnt(0)" ::: "memory");
}
DI void phase0_weights(Frame& F) {
    LAS float* scr = (LAS float*)(F.lds + F.wave * 16384);
    const int lane = F.lane;
    constexpr int NITEMS = 16 * 96 + 16 * 32 + 2 * (32 * 16 * 16) + 32 * 8 * 32 + 4 * 16 * 8;
    int it = F.gw; if (it >= NITEMS) return;
    TrD cur = tr_desc(F, it, lane); f32x4 vc[8]; tr_load(cur, vc, lane);
    for (;;) {
        const int nit = it + F.NGW; const bool more = nit < NITEMS;
        TrD nxt = cur; f32x4 vn[8];
        if (more) { nxt = tr_desc(F, nit, lane); tr_load(nxt, vn, lane); }
        tr_finish(cur, vc, scr, lane);
        if (!more) break;
        cur = nxt; it = nit;
#pragma unroll
        for (int i = 0; i < 8; ++i) vc[i] = vn[i];
    }
}

DI void phase1(Frame& F) {
    const float* x = F.in[0]; const float* g = F.in[4]; const float* mod = (const float*)(F.ws + WS_MOD); bf16_t* h1 = (bf16_t*)(F.ws + WS_H1);
    const int lane = F.lane;
    for (int m0 = F.gw * 32; m0 < TOK; m0 += F.NGW * 32) {
        const int b = m0 >> 11; const float* sh = mod + (size_t)b * 6144; const float* sc = sh + 1024;
        f32x4 A[4], Bv[4];
#pragma unroll
        for (int j = 0; j < 4; ++j) { const int col = 4 * lane + 256 * j; A[j] = *(const f32x4*)(g + col) * (*(const f32x4*)(sc + col) + 1.f); Bv[j] = *(const f32x4*)(sh + col); }
        const f32x4* xr = (const f32x4*)(x + (size_t)m0 * DM) + lane; u32x2* o8 = (u32x2*)(h1 + (size_t)m0 * DM) + lane;
        f32x4 v0[4], v1[4];
#pragma unroll
        for (int j = 0; j < 4; ++j) { v0[j] = __builtin_nontemporal_load(xr + 64 * j); v1[j] = __builtin_nontemporal_load(xr + 256 + 64 * j); }
        for (int i = 0; i < 32; i += 2) {
            f32x4 n0[4], n1[4];
            if (i + 2 < 32) {
#pragma unroll
                for (int j = 0; j < 4; ++j) { n0[j] = __builtin_nontemporal_load(xr + (size_t)(i + 2) * 256 + 64 * j); n1[j] = __builtin_nontemporal_load(xr + (size_t)(i + 3) * 256 + 64 * j); }
            }
            float s0 = 0.f, s1 = 0.f;
#pragma unroll
            for (int j = 0; j < 4; ++j) { s0 += (v0[j][0] * v0[j][0] + v0[j][1] * v0[j][1]) + (v0[j][2] * v0[j][2] + v0[j][3] * v0[j][3]); s1 += (v1[j][0] * v1[j][0] + v1[j][1] * v1[j][1]) + (v1[j][2] * v1[j][2] + v1[j][3] * v1[j][3]); }
#pragma unroll
            for (int o = 1; o < 64; o <<= 1) { s0 += __shfl_xor(s0, o); s1 += __shfl_xor(s1, o); }
            const float r0 = rsqrtf(s0 * (1.f / DM) + EPS), r1 = rsqrtf(s1 * (1.f / DM) + EPS);
#pragma unroll
            for (int j = 0; j < 4; ++j) { const f32x4 y0 = v0[j] * r0 * A[j] + Bv[j], y1 = v1[j] * r1 * A[j] + Bv[j];
                u32x2 w0, w1; w0.x = pk2(y0[0], y0[1]); w0.y = pk2(y0[2], y0[3]); w1.x = pk2(y1[0], y1[1]); w1.y = pk2(y1[2], y1[3]);
                o8[(size_t)i * 256 + 64 * j] = w0; o8[(size_t)(i + 1) * 256 + 64 * j] = w1; }
#pragma unroll
            for (int j = 0; j < 4; ++j) { v0[j] = n0[j]; v1[j] = n1[j]; }
        }
    }
}

DI void phase3(Frame& F) {
    const bf16_t* proj = (const bf16_t*)(F.ws + WS_PROJ);
    const float* ropeN = (const float*)(F.ws + WS_ROPE); const float* ropeD = ropeN + 2048 * 16;
    const float* g_nq = F.in[7]; const float* g_nk = F.in[8]; const float* g_dq = F.in[12]; const float* g_dk = F.in[13];
    const int lane = F.lane;
    for (int it = F.gw; it < TOK * 6; it += F.NGW) {
        const int m = it / 6, part = it % 6; const int b = m >> 11, t = m & 2047;
        const int c0 = part * 512 + lane * 8;
        const u32x4 raw = *(const u32x4*)(proj + (size_t)m * NPROJ + c0);
        float v[8]; v[0] = bflo(raw.x); v[1] = bfhi(raw.x); v[2] = bflo(raw.y); v[3] = bfhi(raw.y); v[4] = bflo(raw.z); v[5] = bfhi(raw.z); v[6] = bflo(raw.w); v[7] = bfhi(raw.w);
        float ss = 0.f;
#pragma unroll
        for (int i = 0; i < 8; ++i) ss += v[i] * v[i];
        ss += __shfl_xor(ss, 1); ss += __shfl_xor(ss, 2); const float ss32 = ss; ss += __shfl_xor(ss, 4); const float ss64 = ss;
        float pv[8];
#pragma unroll
        for (int i = 0; i < 8; ++i) pv[i] = __shfl_xor(v[i], 1);
        if (c0 < 1280) {
            const bool isq = c0 < 512; int six = 0, gsel = 0, d0;
            if (isq) { d0 = c0 & 63; } else { const int cc = c0 - 512; six = cc >> 7; gsel = (cc >> 6) & 1; d0 = cc & 63; }
            const bool donorm = isq || six == 2 || six == 4;
            float y[8];
            if (donorm) { const float* gg = isq ? g_nq : (g_nk + (six == 2 ? 64 : 128)); const float rstd = rsqrtf(ss64 * (1.f / 64.f) + EPS);
#pragma unroll
                for (int i = 0; i < 8; ++i) { y[i] = v[i] * rstd * gg[d0 + i]; pv[i] = pv[i] * rstd * gg[(d0 ^ 8) + i]; } }
            else {
#pragma unroll
                for (int i = 0; i < 8; ++i) y[i] = v[i]; }
            float yr[8];
#pragma unroll
            for (int i = 0; i < 8; ++i) yr[i] = y[i];
            if (donorm && d0 < 16) {
#pragma unroll
                for (int i = 0; i < 8; ++i) { const float cs = ropeN[(t * 8 + i) * 2], sn = ropeN[(t * 8 + i) * 2 + 1];
                    yr[i] = d0 == 0 ? (y[i] * cs - pv[i] * sn) : (pv[i] * sn + y[i] * cs); }
            }
            u32x4 w0, w1; w0.x = pk2(y[0], y[1]); w0.y = pk2(y[2], y[3]); w0.z = pk2(y[4], y[5]); w0.w = pk2(y[6], y[7]);
            w1.x = pk2(yr[0], yr[1]); w1.y = pk2(yr[2], yr[3]); w1.z = pk2(yr[4], yr[5]); w1.w = pk2(yr[6], yr[7]);
            if (isq) { const int hd = c0 >> 6; const size_t off = (((size_t)b * 8 + hd) * SEQ + t) * 64 + d0;
                *(u32x4*)((bf16_t*)(F.ws + WS_QN) + off) = w0; *(u32x4*)((bf16_t*)(F.ws + WS_QR) + off) = w1; }
            else { const size_t base = six == 0 ? WS_KC : six == 1 ? WS_VC : six == 2 ? WS_KS : six == 3 ? WS_VS : six == 4 ? WS_KW : WS_VW;
                const size_t off = (((size_t)b * 2 + gsel) * SEQ + t) * 64 + d0;
                *(u32x4*)((bf16_t*)(F.ws + base) + off) = donorm ? w1 : w0; }
        } else if (c0 < 2304) {
            const bool isq = c0 < 1792; const int cc = c0 - (isq ? 1280 : 1792); const int hd = cc >> 6, dd = cc & 63, d0 = dd & 31;
            const float* gg = isq ? g_dq : g_dk; const float rstd = rsqrtf(ss32 * (1.f / 32.f) + EPS);
            float y[8];
#pragma unroll
            for (int i = 0; i < 8; ++i) y[i] = v[i] * rstd * gg[d0 + i];
            if (d0 == 0) {
#pragma unroll
                for (int i = 0; i < 4; ++i) { const float cs = ropeD[(t * 4 + i) * 2], sn = ropeD[(t * 4 + i) * 2 + 1]; const float a = y[i], bb = y[i + 4]; y[i] = a * cs - bb * sn; y[i + 4] = a * sn + bb * cs; }
            }
            u32x4 w; w.x = pk2(y[0], y[1]); w.y = pk2(y[2], y[3]); w.z = pk2(y[4], y[5]); w.w = pk2(y[6], y[7]);
            const size_t off = (((size_t)b * 8 + hd) * SEQ + t) * 64 + dd;
            *(u32x4*)((bf16_t*)(F.ws + (isq ? WS_DQ : WS_DK)) + off) = w;
        } else if (c0 < 2816) {
            const int cc = c0 - 2304; const int hd = cc >> 6, dd = cc & 63; const size_t off = (((size_t)b * 8 + hd) * SEQ + t) * 64 + dd;
            *(u32x4*)((bf16_t*)(F.ws + WS_DV) + off) = raw;
        } else if (c0 < 2840) {
            float* gt = (float*)(F.ws + WS_GATES) + (size_t)m * 24 + (c0 - 2816);
#pragma unroll
            for (int i = 0; i < 8; ++i) gt[i] = 1.f / (1.f + __expf(-v[i]));
        }
    }
}

DI void glds16(const void* gsrc, unsigned lds_dst) { unsigned keep;
    asm volatile("s_mov_b32 %0, m0\n\ts_mov_b32 m0, %2\n\ts_nop 0\n\tglobal_load_lds_dwordx4 %1, off\n\ts_mov_b32 m0, %0" : "=&s"(keep) : "v"(gsrc), "s"(lds_dst) : "memory"); }
DI unsigned lds_addr(const LAS void* p) { return (unsigned)(uintptr_t)p; }
struct ALane { int k0; int v0; DI int ko(int ks) const { return k0 ^ (ks << 5); } DI int vo(int db) const { return v0 ^ (db << 6); } };
DI ALane alane_init(int lane) {
    ALane L; const int r = lane & 31, hh = lane >> 5, g = lane >> 4, i = lane & 15;
    L.k0 = r * 128 + ((hh ^ ((r >> 1) & 7)) << 4);
    const int rl = 4 * hh + (i >> 2); const int ch = 2 * (g & 1) + ((i & 3) >> 1);
    L.v0 = rl * 128 + ((ch ^ (((rl >> 1) & 1) << 2)) << 4) + 8 * (i & 1);
    return L;
}
DI s16x4 vtr(const LAS char* p) { typedef short v4i16 __attribute__((ext_vector_type(4))); return __builtin_bit_cast(s16x4, __builtin_amdgcn_ds_read_tr16_b64_v4i16((LAS v4i16*)p)); }
DI bf16x8 vfrag(const LAS char* Vt, const ALane& L, int db, int kb, int s) {
    const LAS char* p = Vt + L.vo(db) + (32 * kb + 16 * s) * 128;
    const s16x4 lo = vtr(p), hi = vtr(p + 8 * 128);
    return __builtin_shufflevector(lo, hi, 0, 1, 2, 3, 4, 5, 6, 7);
}
DI bf16x8 pfrag(const f32x16& p, int s) { u32x4 w; w.x = pk2(p[8 * s + 0], p[8 * s + 1]); w.y = pk2(p[8 * s + 2], p[8 * s + 3]); w.z = pk2(p[8 * s + 4], p[8 * s + 5]); w.w = pk2(p[8 * s + 6], p[8 * s + 7]); return __builtin_bit_cast(bf16x8, w); }
DI u32x4 tile_ld(const bf16_t* g, int tid) { return *(const u32x4*)(g + tid * 8); }
DI void tile_st_k(LAS char* Kt, u32x4 v, int tid) { const int row = tid >> 3, ch = tid & 7; *(LAS u32x4*)(Kt + row * 128 + ((ch ^ ((row >> 1) & 7)) << 4)) = v; }
DI void tile_st_v(LAS char* Vt, u32x4 v, int tid) { const int row = tid >> 3, ch = tid & 7; *(LAS u32x4*)(Vt + row * 128 + ((ch ^ (((row >> 1) & 1) << 2)) << 4)) = v; }

constexpr int MK_NONE = 0, MK_LE = 1, MK_GT = 2;
template <int MASK>
DI void sm16(f32x16& a, float c2, float mcl, int kb, int hh, int th) {
    if constexpr (MASK != MK_NONE) asm volatile("" : "+v"(th));
#pragma unroll
    for (int i = 0; i < 16; ++i) {
        float x = __builtin_fmaf(a[i], c2, -mcl);
        if constexpr (MASK != MK_NONE) { const int kl = 32 * kb + crow(i, hh); const bool ok = MASK == MK_LE ? (kl <= th) : (kl > th); x = ok ? x : -1.0e30f; }
        a[i] = fast_exp2(x);
    }
}
DI float sum16(const f32x16& a) { return ((a[0] + a[1]) + (a[2] + a[3])) + ((a[4] + a[5]) + (a[6] + a[7])) + ((a[8] + a[9]) + (a[10] + a[11])) + ((a[12] + a[13]) + (a[14] + a[15])); }
#define SCHED_FENCE() do { } while (0)
template <int MASK, bool KEEPP>
DI void attn_tile64(const LAS char* Kt, const LAS char* Vt, const ALane& L, const bf16x8 (&qf)[4], f32x16 (&O)[2], float& lsum, float c2, float mcl, int th, int hh, f32x16 (&P)[2]) {
    bf16x8 kf[2][4];
#pragma unroll
    for (int kb = 0; kb < 2; ++kb)
#pragma unroll
        for (int ks = 0; ks < 4; ++ks) kf[kb][ks] = *(const LAS bf16x8*)(Kt + L.ko(ks) + kb * 4096);
    SCHED_FENCE();
    f32x16 a0 = {0.f, 0.f, 0.f, 0.f, 0.f, 0.f, 0.f, 0.f, 0.f, 0.f, 0.f, 0.f, 0.f, 0.f, 0.f, 0.f}, a1 = a0;
#pragma unroll
    for (int ks = 0; ks < 4; ++ks) a0 = MFMA32(kf[0][ks], qf[ks], a0);
#pragma unroll
    for (int ks = 0; ks < 4; ++ks) a1 = MFMA32(kf[1][ks], qf[ks], a1);
    bf16x8 v0[2][2], v1[2][2];
#pragma unroll
    for (int s = 0; s < 2; ++s)
#pragma unroll
        for (int db = 0; db < 2; ++db) v0[s][db] = vfrag(Vt, L, db, 0, s);
    SCHED_FENCE();
    bf16x8 pf[2][2];
    sm16<MASK>(a0, c2, mcl, 0, hh, th); lsum += sum16(a0); pf[0][0] = pfrag(a0, 0); pf[0][1] = pfrag(a0, 1);
    if constexpr (KEEPP) P[0] = a0;
#pragma unroll
    for (int s = 0; s < 2; ++s)
#pragma unroll
        for (int db = 0; db < 2; ++db) v1[s][db] = vfrag(Vt, L, db, 1, s);
    SCHED_FENCE();
    sm16<MASK>(a1, c2, mcl, 1, hh, th); lsum += sum16(a1); pf[1][0] = pfrag(a1, 0); pf[1][1] = pfrag(a1, 1);
    if constexpr (KEEPP) P[1] = a1;
    SCHED_FENCE();
#pragma unroll
    for (int s = 0; s < 2; ++s)
#pragma unroll
        for (int db = 0; db < 2; ++db) O[db] = MFMA32(v0[s][db], pf[0][s], O[db]);
#pragma unroll
    for (int s = 0; s < 2; ++s)
#pragma unroll
        for (int db = 0; db < 2; ++db) O[db] = MFMA32(v1[s][db], pf[1][s], O[db]);
    SCHED_FENCE();
}
template <int MASK>
DI void attn_tile_dm(const LAS char* Kt, const LAS char* Vt, const ALane& L, int ko0, int ko1, const bf16x8 (&qf)[2], f32x16 (&O)[2], float& lsum, float c2, float mc, int th, int hh) {
    const bf16x8 k00 = *(const LAS bf16x8*)(Kt + ko0), k01 = *(const LAS bf16x8*)(Kt + ko1), k10 = *(const LAS bf16x8*)(Kt + ko0 + 4096), k11 = *(const LAS bf16x8*)(Kt + ko1 + 4096);
    SCHED_FENCE();
    f32x16 a0 = {0.f, 0.f, 0.f, 0.f, 0.f, 0.f, 0.f, 0.f, 0.f, 0.f, 0.f, 0.f, 0.f, 0.f, 0.f, 0.f}, a1 = a0;
    a0 = MFMA32(k00, qf[0], a0); a0 = MFMA32(k01, qf[1], a0); a1 = MFMA32(k10, qf[0], a1); a1 = MFMA32(k11, qf[1], a1);
    bf16x8 vf[2][2][2];
#pragma unroll
    for (int kb = 0; kb < 2; ++kb)
#pragma unroll
        for (int s = 0; s < 2; ++s)
#pragma unroll
            for (int db = 0; db < 2; ++db) vf[kb][s][db] = vfrag(Vt, L, db, kb, s);
    SCHED_FENCE();
    bf16x8 pf[2][2];
    sm16<MASK>(a0, c2, mc, 0, hh, th); lsum += sum16(a0); pf[0][0] = pfrag(a0, 0); pf[0][1] = pfrag(a0, 1);
    sm16<MASK>(a1, c2, mc, 1, hh, th); lsum += sum16(a1); pf[1][0] = pfrag(a1, 0); pf[1][1] = pfrag(a1, 1);
    SCHED_FENCE();
#pragma unroll
    for (int kb = 0; kb < 2; ++kb)
#pragma unroll
        for (int s = 0; s < 2; ++s)
#pragma unroll
            for (int db = 0; db < 2; ++db) O[db] = MFMA32(vf[kb][s][db], pf[kb][s], O[db]);
    SCHED_FENCE();
}
#define RING_WAIT(n) asm volatile("s_waitcnt vmcnt(" #n ")" ::: "memory")
template <class PreF, class CompF>
DI void attn_ring(LAS char* lds, const bf16_t* Kg, const bf16_t* Vg, unsigned tiles, int wid, int lane, PreF pre, CompF comp) {
    if (tiles == 0u) return;
    const int p = wid * 64 + lane, row = p >> 3, c = p & 7;
    const unsigned ksrc = (unsigned)(row * 128 + ((c ^ ((row >> 1) & 7)) << 4)), vsrc = (unsigned)(row * 128 + ((c ^ (((row >> 1) & 1) << 2)) << 4));
    LAS char* wb = lds + wid * 1024;
#define RING_ISSUE(j, slot) do { \
        glds16((const char*)(Kg) + (size_t)(j) * 8192 + ksrc, (unsigned)__builtin_amdgcn_readfirstlane((int)(lds_addr(wb) + (unsigned)(slot) * 16384u))); \
        glds16((const char*)(Vg) + (size_t)(j) * 8192 + vsrc, (unsigned)__builtin_amdgcn_readfirstlane((int)(lds_addr(wb) + (unsigned)(slot) * 16384u + 8192u))); } while (0)
    int q0 = __builtin_ctz(tiles); tiles &= tiles - 1u;
    int q1 = -1, q2 = -1;
    if (tiles) { q1 = __builtin_ctz(tiles); tiles &= tiles - 1u; }
    if (tiles) { q2 = __builtin_ctz(tiles); tiles &= tiles - 1u; }
    RING_ISSUE(q0, 0);
    if (q1 >= 0) RING_ISSUE(q1, 1);
    if (q2 >= 0) RING_ISSUE(q2, 2);
    pre();
    int i = 0;
    for (;;) {
        if (q2 >= 0) RING_WAIT(4); else if (q1 >= 0) RING_WAIT(2); else RING_WAIT(0);
        __builtin_amdgcn_s_barrier();
        int q3 = -1;
        if (tiles) { q3 = __builtin_ctz(tiles); tiles &= tiles - 1u; RING_ISSUE(q3, (i + 3) & 3); }
        LAS char* st = lds + (i & 3) * 16384;
        comp(q0, st, st + 8192);
        if (q1 < 0) break;
        q0 = q1; q1 = q2; q2 = q3; ++i;
    }
    asm volatile("s_waitcnt lgkmcnt(0)" ::: "memory");
    __builtin_amdgcn_s_barrier();
#undef RING_ISSUE
}

DI void diff_unit(Frame& F, int b, int hd, int qb, float c2, float mc, float lam) {
    const int tid = F.tid, lane = F.lane, wid = F.wave, r = lane & 31, hh = lane >> 5;
    const int rb = wid >> 1, mp = wid & 1;
    const bf16_t* Q = (const bf16_t*)(F.ws + WS_DQ) + ((size_t)b * 8 + hd) * SEQ * 64;
    const bf16_t* Kg = (const bf16_t*)(F.ws + WS_DK) + ((size_t)b * 8 + hd) * SEQ * 64;
    const bf16_t* Vg = (const bf16_t*)(F.ws + WS_DV) + ((size_t)b * 8 + hd) * SEQ * 64;
    LAS char* lds = (LAS char*)F.lds;
    const ALane L = alane_init(lane);
    const int ko0 = L.ko(2 * mp), ko1 = L.ko(2 * mp + 1);
    const int q0w = qb * 128 + rb * 32; const int qq = q0w + r;
    bf16x8 qf[2];
#pragma unroll
    for (int ks = 0; ks < 2; ++ks) qf[ks] = *(const bf16x8*)(Q + (size_t)qq * 64 + mp * 32 + ks * 16 + hh * 8);
    f32x16 O[2]; float lsum = 0.f;
#pragma unroll
    for (int i = 0; i < 16; ++i) { O[0][i] = 0.f; O[1][i] = 0.f; }
    const int ntile = 2 * qb + 2; const int jmax = 2 * qb + (rb >> 1);
    const unsigned tiles = ntile == 32 ? 0xffffffffu : ((1u << ntile) - 1u);
    attn_ring(lds, Kg, Vg, tiles, wid, lane, [&]() __attribute__((always_inline)) { asm volatile("" : "+v"(qf[0]), "+v"(qf[1])); },
        [&](int j, const LAS char* Kt, const LAS char* Vt) __attribute__((always_inline)) {
        if (j < jmax) attn_tile_dm<MK_NONE>(Kt, Vt, L, ko0, ko1, qf, O, lsum, c2, mc, 0, hh);
        else if (j == jmax) attn_tile_dm<MK_LE>(Kt, Vt, L, ko0, ko1, qf, O, lsum, c2, mc, qq - 64 * j, hh);
    });
    lsum += __shfl_xor(lsum, 32);
    LAS float* xo = (LAS float*)(lds + 65536 + rb * 8192) + lane;
    if (mp == 1) { const float s1 = lam / lsum;
#pragma unroll
        for (int db = 0; db < 2; ++db)
#pragma unroll
            for (int i = 0; i < 16; ++i) xo[(db * 16 + i) * 64] = O[db][i] * s1; }
    __syncthreads();
    if (mp == 0) {
        const float i0 = 1.f / lsum; float ss = 0.f;
#pragma unroll
        for (int db = 0; db < 2; ++db)
#pragma unroll
            for (int i = 0; i < 16; ++i) { const float o = O[db][i] * i0 - xo[(db * 16 + i) * 64]; O[db][i] = o; ss += o * o; }
        ss += __shfl_xor(ss, 32);
        const float rstd = rsqrtf(ss * (1.f / 64.f) + EPS) * 0.8f;
        const float* go = F.in[18];
        bf16_t* orow = (bf16_t*)(F.ws + WS_AO) + ((size_t)b * SEQ + qq) * DM + 512 + hd * 64;
#pragma unroll
        for (int db = 0; db < 2; ++db)
#pragma unroll
            for (int g4 = 0; g4 < 4; ++g4) { const int d = 32 * db + 8 * g4 + 4 * hh; const f32x4 gv = *(const f32x4*)(go + d);
                u32x2 w; w.x = pk2(O[db][4 * g4] * rstd * gv[0], O[db][4 * g4 + 1] * rstd * gv[1]); w.y = pk2(O[db][4 * g4 + 2] * rstd * gv[2], O[db][4 * g4 + 3] * rstd * gv[3]);
                *(u32x2*)(orow + d) = w; }
    }
}

#define NSA_BAR() do { asm volatile("s_waitcnt lgkmcnt(0)" ::: "memory"); __builtin_amdgcn_s_barrier(); asm volatile("" ::: "memory"); } while (0)
DI void nsa_unit(Frame& F, int b, int g, int qb, float c2, float mc) {
    const int lane = F.lane, wid = F.wave, r = lane & 31, hh = lane >> 5;
    const int hd = 4 * g + (wid >> 1); const int tl = 32 * (wid & 1) + r; const int t = 64 * qb + tl;
    LAS char* lds = (LAS char*)F.lds;
    LAS float* impP = (LAS float*)(lds + 65536);
    LAS unsigned* selm = (LAS unsigned*)(lds + LDS_MISC + 5120);
    LAS float* invs = (LAS float*)(selm + 128);
    LAS float* otp = (LAS float*)(lds + 65536 + wid * 8192) + lane;
    LAS float* gpark = (LAS float*)(lds + LDS_MISC + 8192 + wid * 768) + lane;
    const ALane L = alane_init(lane);
    const size_t bg = (size_t)b * 2 + g;
    bf16x8 qf[4];
    { const bf16_t* QN = (const bf16_t*)(F.ws + WS_QN) + (((size_t)b * 8 + hd) * SEQ + t) * 64;
#pragma unroll
      for (int ks = 0; ks < 4; ++ks) qf[ks] = *(const bf16x8*)(QN + ks * 16 + hh * 8);
      const float* gates = (const float*)(F.ws + WS_GATES) + ((size_t)b * SEQ + t) * 24 + hd * 3;
      const float g0_ = gates[0], g1_ = gates[1], g2_ = gates[2]; gpark[0] = g0_; gpark[64] = g1_; gpark[128] = g2_; }
    const char* KcB = (const char*)(F.ws + WS_KCMP) + bg * 16384; const char* VcB = (const char*)(F.ws + WS_VCMP) + bg * 16384;
    const char* KsB = (const char*)(F.ws + WS_KS) + bg * (SEQ * 128); const char* VsB = (const char*)(F.ws + WS_VS) + bg * (SEQ * 128);
    const char* KwB = (const char*)(F.ws + WS_KW) + bg * (SEQ * 128); const char* VwB = (const char*)(F.ws + WS_VW) + bg * (SEQ * 128);
    const int nf = qb == 0 ? 1 : (qb == 1 ? 2 : 3); const int f1 = qb == 1 ? 1 : qb - 1, f2 = qb;
    const unsigned fmask = 1u | (qb >= 1 ? (1u << qb) : 0u) | (qb >= 2 ? (1u << (qb - 1)) : 0u);
    const unsigned allb = qb == 31 ? 0xffffffffu : ((1u << (qb + 1)) - 1u);
    unsigned grest = qb <= 5 ? (allb & ~fmask) : 0u;
    const int jlo = qb >= 4 ? qb - 4 : 0;
    int gph = 0, gi = 0;
    const int p_ = wid * 64 + lane, prow = p_ >> 3, pc = p_ & 7;
    const unsigned ksrc = (unsigned)(prow * 128 + ((pc ^ ((prow >> 1) & 7)) << 4)), vsrc = (unsigned)(prow * 128 + ((pc ^ (((prow >> 1) & 1) << 2)) << 4));
    const unsigned wbase = lds_addr(lds) + (unsigned)wid * 1024u;
#define NSA_GEN(ty, jj) do { ty = -1; jj = 0; \
        if (gph == 0) { ty = 0; jj = gi; if (++gi == 2) { gph = 1; gi = 0; } } \
        else if (gph == 1) { ty = 1; jj = gi == 0 ? 0 : (gi == 1 ? f1 : f2); if (++gi == nf) gph = 2; } \
        else { if (gph == 2) { if (grest) { ty = 1; jj = __builtin_ctz(grest); grest &= grest - 1u; } else { gph = 3; gi = jlo; } } \
               if (gph == 3) { if (gi <= qb) { ty = 2; jj = gi++; } else gph = 4; } } } while (0)
#define NSA_ISSUE(ty, jj, slot) do { const char* kp_ = ty == 0 ? KcB : (ty == 1 ? KsB : KwB); const char* vp_ = ty == 0 ? VcB : (ty == 1 ? VsB : VwB); \
        glds16(kp_ + (size_t)(jj) * 8192 + ksrc, (unsigned)__builtin_amdgcn_readfirstlane((int)(wbase + (unsigned)(slot) * 16384u))); \
        glds16(vp_ + (size_t)(jj) * 8192 + vsrc, (unsigned)__builtin_amdgcn_readfirstlane((int)(wbase + (unsigned)(slot) * 16384u + 8192u))); } while (0)
    int t0, j0, t1, j1, t2, j2;
    NSA_GEN(t0, j0); NSA_GEN(t1, j1); NSA_GEN(t2, j2);
    NSA_ISSUE(t0, j0, 0); NSA_ISSUE(t1, j1, 1); if (t2 >= 0) NSA_ISSUE(t2, j2, 2);
#pragma unroll
    for (int ks = 0; ks < 4; ++ks) asm volatile("" : "+v"(qf[ks]));
    f32x16 O[2]; float lv = 0.f; float carry_in = 0.f; unsigned mym = 0u; bool inB = false;
#pragma unroll
    for (int i = 0; i < 16; ++i) { O[0][i] = 0.f; O[1][i] = 0.f; }
    const int nvalid = t >= 31 ? ((t - 31) >> 4) + 1 : 0;
    for (int n = 0;; ++n) {
        if (t2 >= 0) RING_WAIT(4); else if (t1 >= 0) RING_WAIT(2); else RING_WAIT(0);
        __builtin_amdgcn_s_barrier();
        int t3, j3;
        NSA_GEN(t3, j3);
        if (t3 >= 0) NSA_ISSUE(t3, j3, (n + 3) & 3);
        const LAS char* Kt = lds + (n & 3) * 16384; const LAS char* Vt = Kt + 8192;
        int mode = MK_LE, th = tl; float mcl = mc;
        if (t0 == 0) { th = nvalid - 1 - 64 * j0; }
        else if (t0 == 1) { mcl = ((mym >> j0) & 1u) ? mc : 1.0e30f; mode = j0 < qb ? MK_NONE : MK_LE; }
        else {
            if (inB) {
                float lsum = lv; lsum += __shfl_xor(lsum, 32); const float s1 = gpark[64] / lsum;
#pragma unroll
                for (int db = 0; db < 2; ++db)
#pragma unroll
                    for (int i = 0; i < 16; ++i) { otp[(db * 16 + i) * 64] += O[db][i] * s1; O[db][i] = 0.f; }
                lv = 0.f; inB = false;
            }
            mode = j0 == qb ? MK_LE : (j0 == qb - 4 ? MK_GT : MK_NONE);
        }
        if (t0 != 0) {
            f32x16 Pd[2];
            if (mode == MK_NONE) attn_tile64<MK_NONE, false>(Kt, Vt, L, qf, O, lv, c2, mcl, 0, hh, Pd);
            else if (mode == MK_LE) attn_tile64<MK_LE, false>(Kt, Vt, L, qf, O, lv, c2, mcl, th, hh, Pd);
            else attn_tile64<MK_GT, false>(Kt, Vt, L, qf, O, lv, c2, mcl, th, hh, Pd);
        } else {
            f32x16 P[2];
            attn_tile64<MK_LE, true>(Kt, Vt, L, qf, O, lv, c2, mcl, th, hh, P);
            LAS float* ip = impP + ((wid >> 1) * 64 + tl) * 33;
            float av[8], rc[8];
#pragma unroll
            for (int kb = 0; kb < 2; ++kb)
#pragma unroll
                for (int gq = 0; gq < 4; ++gq) { const int f = 4 * kb + gq; const float p3 = 0.5f * P[kb][4 * gq + 3]; av[f] = P[kb][4 * gq] + P[kb][4 * gq + 1] + P[kb][4 * gq + 2] + p3; rc[f] = __shfl_xor(p3, 32); }
#pragma unroll
            for (int f = 0; f < 8; ++f) { const float carry = hh == 1 ? rc[f] : (f > 0 ? rc[f > 0 ? f - 1 : 0] : carry_in); ip[2 * (8 * j0 + f) + hh] = av[f] + carry; }
            carry_in = rc[7];
            if (j0 == 1) {
                {
                    const bf16_t* QR = (const bf16_t*)(F.ws + WS_QR) + (((size_t)b * 8 + hd) * SEQ + t) * 64;
#pragma unroll
                    for (int ks = 0; ks < 4; ++ks) qf[ks] = *(const bf16x8*)(QR + ks * 16 + hh * 8); }
                float lsum = lv; lsum += __shfl_xor(lsum, 32);
                const float inv = lsum > 0.f ? 1.f / lsum : 0.f;
                if (hh == 0) invs[(wid >> 1) * 64 + tl] = inv;
                const float s0 = gpark[0] * inv;
                lv = 0.f;
                NSA_BAR();
                if (wid == 0) {
                    unsigned m;
                    if (qb <= 5) m = allb;
                    else {
                        m = fmask;
                        float best[3] = {-1.f, -1.f, -1.f}; int bi[3] = {0, 0, 0}; const float iv0 = invs[lane], iv1 = invs[64 + lane], iv2 = invs[128 + lane], iv3 = invs[192 + lane];
                        for (int j = 1; j <= qb - 2; ++j) {
                            const float v = (impP[(0 * 64 + lane) * 33 + j] * iv0 + impP[(1 * 64 + lane) * 33 + j] * iv1) + (impP[(2 * 64 + lane) * 33 + j] * iv2 + impP[(3 * 64 + lane) * 33 + j] * iv3);
                            if (v > best[0]) { best[2] = best[1]; bi[2] = bi[1]; best[1] = best[0]; bi[1] = bi[0]; best[0] = v; bi[0] = j; }
                            else if (v > best[1]) { best[2] = best[1]; bi[2] = bi[1]; best[1] = v; bi[1] = j; }
                            else if (v > best[2]) { best[2] = v; bi[2] = j; }
                        }
                        m |= (1u << bi[0]) | (1u << bi[1]) | (1u << bi[2]);
                    }
                    selm[lane] = m;
                    unsigned u = m;
#pragma unroll
                    for (int o = 1; o < 64; o <<= 1) u |= (unsigned)__shfl_xor((int)u, o);
                    if (lane == 0) selm[64] = u;
                }
                NSA_BAR();
                mym = selm[tl];
                if (qb > 5) grest = (unsigned)__builtin_amdgcn_readfirstlane((int)selm[64]) & ~fmask;
#pragma unroll
                for (int db = 0; db < 2; ++db)
#pragma unroll
                    for (int i = 0; i < 16; ++i) { otp[(db * 16 + i) * 64] = O[db][i] * s0; O[db][i] = 0.f; }
                inB = true;
#pragma unroll
                for (int ks = 0; ks < 4; ++ks) asm volatile("" : "+v"(qf[ks]));
            }
        }
        if (t1 < 0) break;
        t0 = t1; j0 = j1; t1 = t2; j1 = j2; t2 = t3; j2 = j3;
    }
    {
        float lsum = lv; lsum += __shfl_xor(lsum, 32); const float s2 = gpark[128] / lsum;
#pragma unroll
        for (int db = 0; db < 2; ++db)
#pragma unroll
            for (int i = 0; i < 16; ++i) O[db][i] = otp[(db * 16 + i) * 64] + O[db][i] * s2;
    }
    bf16_t* orow = (bf16_t*)(F.ws + WS_AO) + ((size_t)b * SEQ + t) * DM + hd * 64;
#pragma unroll
    for (int db = 0; db < 2; ++db)
#pragma unroll
        for (int g4 = 0; g4 < 4; ++g4) { const int d = 32 * db + 8 * g4 + 4 * hh;
            u32x2 w; w.x = pk2(O[db][4 * g4], O[db][4 * g4 + 1]); w.y = pk2(O[db][4 * g4 + 2], O[db][4 * g4 + 3]);
            *(u32x2*)(orow + d) = w; }
    NSA_BAR();
#undef NSA_GEN
#undef NSA_ISSUE
}

DI float gmax(const float* g, int n, int lane) { float v = lane < n ? fabsf(g[lane]) : 0.f;
#pragma unroll
    for (int o = 1; o < 64; o <<= 1) v = fmaxf(v, __shfl_xor(v, o));
    return v; }

DI int queue_next(Frame& F, unsigned* ctr) {
    LAS int* slot = (LAS int*)(F.lds + LDS_MISC + 4096);
    __syncthreads();
    if (F.tid == 0) *slot = (int)atomicAdd(ctr, 1u);
    __syncthreads();
    return *slot;
}

DI int queue_pass(Frame& F, unsigned nx) {
    LAS int* slot = (LAS int*)(F.lds + LDS_MISC + 4096);
    __syncthreads();
    if (F.tid == 0) *slot = (int)nx;
    __syncthreads();
    return *slot;
}

DI float gelu_tanh(float x) { const float u = 0.7978845608028654f * (x + 0.044715f * x * x * x); const float e = __expf(2.f * u); const float th = 1.f - 2.f / (e + 1.f); return 0.5f * x * (1.f + th); }
DI void phase5(Frame& F) {
    const bf16_t* UL = (const bf16_t*)(F.ws + WS_UL); const float* w2 = F.in[11]; const float* gk0 = F.in[8];
    LAS float* w2s = (LAS float*)F.lds;
    LAS float* hid = (LAS float*)(F.lds + LDS_MISC + 8192 + F.wave * 1024);
    for (int i = F.tid; i < 2 * 256 * 64 / 4; i += NTHREADS) ((LAS f32x4*)w2s)[i] = ((const f32x4*)w2)[i];
    __syncthreads();
    const int lane = F.lane;
    for (int it = F.gw; it < 2 * 64 * 128; it += F.NGW) {
        const int kv = it >> 13, rem = it & 8191, bgi = rem >> 7, c = rem & 127;
        bf16_t* dst = (bf16_t*)(F.ws + (kv ? WS_VCMP : WS_KCMP)) + ((size_t)bgi * 128 + c) * 64;
        if (c == 127) { dst[lane] = 0; continue; }
        const size_t row = (size_t)kv * 8192 + (size_t)bgi * 128 + c;
        const size_t perow = 16384 + (size_t)kv * 256 + (size_t)kv * 2;
        const u32x2 u4 = *(const u32x2*)(UL + row * 512 + 4 * lane), l4 = *(const u32x2*)(UL + (row + 1) * 512 + 256 + 4 * lane);
        const u32x2 pu = *(const u32x2*)(UL + perow * 512 + 4 * lane), pl = *(const u32x2*)(UL + (perow + 1) * 512 + 256 + 4 * lane);
        float h[4];
        h[0] = bflo(u4.x) + bflo(l4.x) + bflo(pu.x) + bflo(pl.x); h[1] = bfhi(u4.x) + bfhi(l4.x) + bfhi(pu.x) + bfhi(pl.x);
        h[2] = bflo(u4.y) + bflo(l4.y) + bflo(pu.y) + bflo(pl.y); h[3] = bfhi(u4.y) + bfhi(l4.y) + bfhi(pu.y) + bfhi(pl.y);
        f32x4 hv;
#pragma unroll
        for (int i = 0; i < 4; ++i) hv[i] = gelu_tanh(h[i]);
        *(LAS f32x4*)(hid + 4 * lane) = hv;
        asm volatile("s_waitcnt lgkmcnt(0)" ::: "memory");
        const LAS float* w = w2s + kv * 256 * 64 + lane; float acc0 = 0.f, acc1 = 0.f;
#pragma unroll 8
        for (int k = 0; k < 256; k += 4) { const f32x4 hh4 = *(const LAS f32x4*)(hid + k);
            acc0 += hh4[0] * w[(k + 0) * 64]; acc1 += hh4[1] * w[(k + 1) * 64]; acc0 += hh4[2] * w[(k + 2) * 64]; acc1 += hh4[3] * w[(k + 3) * 64]; }
        float acc = acc0 + acc1;
        if (kv == 0) { const float ss = wave_sum(acc * acc); acc = acc * rsqrtf(ss * (1.f / 64.f) + EPS) * gk0[lane]; }
        dst[lane] = f2bf(acc);
        asm volatile("s_waitcnt lgkmcnt(0)" ::: "memory");
    }
    __syncthreads();
}

DI void phase8(Frame& F) {
    const bf16_t* x1 = (const bf16_t*)(F.ws + WS_X1B); const float* gf = F.in[5]; const float* mod = (const float*)(F.ws + WS_MOD); const float* rowss = (const float*)(F.ws + WS_ROWSS);
    const char* wsrc = (const char*)(F.ws + WS_WR);
    unsigned char* h2 = (unsigned char*)(F.ws + WS_H2);
    unsigned* cnt = (unsigned*)(F.ws + WS_CTL) + CW_CNT; int* lists = (int*)(F.ws + WS_LIST);
    int* tipos = (int*)(F.ws + WS_TIPOS); int* tie = (int*)(F.ws + WS_TIE); float* tiw = (float*)(F.ws + WS_TIW);
    const float* brg = F.in[21]; const float* bre = F.in[23];
    const int lane = F.lane, wid = F.wave, row = lane & 15, kq = lane >> 4;
    LAS char* wl = (LAS char*)F.lds;
    LAS float* lg = (LAS float*)(F.lds + 98304 + wid * 3072);
    LAS float* A2 = (LAS float*)(F.lds + 122880);
    LAS float* B2 = A2 + 1024;
    LAS unsigned* hist = (LAS unsigned*)(F.lds + LDS_MISC + 8192);
    unsigned wso[6];
#pragma unroll
    for (int i = 0; i < 6; ++i) { const int s = i * 512 + F.tid, part = s / 1536, r = (s >> 5) % 48, cs = s & 31; wso[i] = (unsigned)(part * 98304 + r * 2048 + ((cs ^ (r & 15)) << 4)); }
#define P8_ISSUE(kc, buf) do { _Pragma("unroll") for (int i_ = 0; i_ < 6; ++i_) \
        __builtin_amdgcn_global_load_lds((const unsigned*)(wsrc + (size_t)(kc) * 512 + wso[i_]), (LAS unsigned*)(wl + (buf) * 49152 + i_ * 8192 + wid * 1024), 16, 0, 0); } while (0)
    const int nbatch = TOK / 128;
    for (int bt = F.bid; bt < nbatch; bt += F.G) {
        const int m0 = bt * 128 + wid * 16; const int m = m0 + row; const int b = m0 >> 11;
        P8_ISSUE(0, 0);
        { const float* sh = mod + (size_t)b * 6144 + 3072; const float* sc = sh + 1024;
          for (int k = F.tid; k < 1024; k += NTHREADS) { A2[k] = gf[k] * (sc[k] + 1.f); B2[k] = sh[k]; } }
        if (F.tid < 64) hist[F.tid] = 0u;
        float rs = 0.f; { const f32x4* rp = (const f32x4*)(rowss + (size_t)m * 16);
#pragma unroll
            for (int q = 0; q < 4; ++q) { const f32x4 v = rp[q]; rs += (v[0] + v[1]) + (v[2] + v[3]); } }
        const float rstd = rsqrtf(rs * (1.f / DM) + EPS);
        const bf16_t* xrow = x1 + (size_t)m * DM + 8 * kq; unsigned char* hrow = h2 + (size_t)m * DM + 8 * kq;
        u32x4 xw[4];
#pragma unroll
        for (int u = 0; u < 4; ++u) xw[u] = *(const u32x4*)(xrow + 32 * u);
        f32x4 acc[3] = {{0.f, 0.f, 0.f, 0.f}, {0.f, 0.f, 0.f, 0.f}, {0.f, 0.f, 0.f, 0.f}};
        for (int kc = 0; kc < 4; ++kc) {
            asm volatile("s_waitcnt vmcnt(0)" ::: "memory");
            __syncthreads();
            if (kc + 1 < 4) P8_ISSUE(kc + 1, (kc + 1) & 1);
            const LAS char* wb = wl + (kc & 1) * 49152;
#pragma unroll 1
            for (int g4 = 0; g4 < 2; ++g4) {
                const int gg = kc * 2 + g4;
                u32x4 nw[4];
                if (gg + 1 < 8) {
#pragma unroll
                    for (int u = 0; u < 4; ++u) nw[u] = *(const u32x4*)(xrow + 128 * (gg + 1) + 32 * u);
                }
#pragma unroll
                for (int u = 0; u < 4; ++u) {
                    const int k0 = 128 * gg + 32 * u + 8 * kq;
                    const f32x4 a0 = *(const LAS f32x4*)(A2 + k0), a1 = *(const LAS f32x4*)(A2 + k0 + 4), b0 = *(const LAS f32x4*)(B2 + k0), b1 = *(const LAS f32x4*)(B2 + k0 + 4);
                    const f32x4 xa_ = {bflo(xw[u].x), bfhi(xw[u].x), bflo(xw[u].y), bfhi(xw[u].y)}, xb_ = {bflo(xw[u].z), bfhi(xw[u].z), bflo(xw[u].w), bfhi(xw[u].w)};
                    const f32x4 ya = xa_ * rstd * a0 + b0, yb = xb_ * rstd * a1 + b1;
                    u32x4 hi; hi.x = pk2(ya[0], ya[1]); hi.y = pk2(ya[2], ya[3]); hi.z = pk2(yb[0], yb[1]); hi.w = pk2(yb[2], yb[3]);
                    { u32x2 h8; h8.x = pk4_fp8(ya[0], ya[1], ya[2], ya[3]); h8.y = pk4_fp8(yb[0], yb[1], yb[2], yb[3]); *(u32x2*)(hrow + 128 * gg + 32 * u) = h8; }
                    u32x4 lo; lo.x = pk2(ya[0] - bflo(hi.x), ya[1] - bfhi(hi.x)); lo.y = pk2(ya[2] - bflo(hi.y), ya[3] - bfhi(hi.y)); lo.z = pk2(yb[0] - bflo(hi.z), yb[1] - bfhi(hi.z)); lo.w = pk2(yb[2] - bflo(hi.w), yb[3] - bfhi(hi.w));
                    const bf16x8 ahi = __builtin_bit_cast(bf16x8, hi), alo = __builtin_bit_cast(bf16x8, lo);
                    const int ch = (g4 * 4 + u) * 4 + kq;
#pragma unroll
                    for (int ct = 0; ct < 3; ++ct) { const int r = 16 * ct + row; const int off = r * 512 + ((ch ^ row) << 4);
                        const bf16x8 bh = *(const LAS bf16x8*)(wb + off), bl = *(const LAS bf16x8*)(wb + 24576 + off);
                        acc[ct] = MFMA16(ahi, bh, acc[ct]); acc[ct] = MFMA16(alo, bh, acc[ct]); acc[ct] = MFMA16(ahi, bl, acc[ct]); }
                }
#pragma unroll
                for (int u = 0; u < 4; ++u) xw[u] = nw[u];
            }
        }
#pragma unroll
        for (int ct = 0; ct < 3; ++ct)
#pragma unroll
            for (int i = 0; i < 4; ++i) lg[(kq * 4 + i) * 48 + 16 * ct + row] = acc[ct][i];
        asm volatile("s_waitcnt lgkmcnt(0)" ::: "memory");
        int e0 = 0, e1 = 0; float w0 = 0.f, w1 = 0.f; unsigned lp0 = 0u, lp1 = 0u;
        if (lane < 16) {
            const LAS float* lr = lg + lane * 48;
            float g4v[4]; int grp = 0; float gm = -3.0e38f;
#pragma unroll
            for (int i = 0; i < 4; ++i) { g4v[i] = lr[i] + brg[i]; if (g4v[i] > gm) { gm = g4v[i]; grp = i; } }
            float den = 0.f;
#pragma unroll
            for (int i = 0; i < 4; ++i) den += __expf(g4v[i] - gm);
            const float pg = 1.f / den;
            float v0 = -3.0e38f, v1 = -3.0e38f; int i0 = 0, i1 = 0;
            for (int i = 0; i < 8; ++i) { const float v = lr[4 + grp * 8 + i] + bre[grp * 8 + i];
                if (v > v0) { v1 = v0; i1 = i0; v0 = v; i0 = i; } else if (v > v1) { v1 = v; i1 = i; } }
            const float ex = __expf(v1 - v0); w0 = pg / (1.f + ex); w1 = pg * ex / (1.f + ex);
            e0 = grp * 8 + i0; e1 = grp * 8 + i1;
            lp0 = atomicAdd((unsigned*)&hist[e0], 1u); lp1 = atomicAdd((unsigned*)&hist[e1], 1u);
        }
        __syncthreads();
        if (F.tid < 32) { const unsigned n = hist[F.tid]; hist[32 + F.tid] = n ? atomicAdd(cnt + F.tid, n) : 0u; }
        __syncthreads();
        if (lane < 16) {
            const int tok = m0 + lane; const int p0 = (int)(hist[32 + e0] + lp0), p1 = (int)(hist[32 + e1] + lp1);
            lists[(size_t)e0 * ECAP + p0] = tok; lists[(size_t)e1 * ECAP + p1] = tok;
            tipos[2 * tok] = p0; tipos[2 * tok + 1] = p1; tie[tok] = e0 | (e1 << 8); tiw[2 * tok] = w0; tiw[2 * tok + 1] = w1;
        }
        __syncthreads();
    }
#undef P8_ISSUE
}

DI LAS int* moe_prefix(Frame& F) {
    LAS int* tb = (LAS int*)(F.lds + LDS_MISC);
    __syncthreads();
    if (F.wave == 0) {
        const unsigned* cnt = (const unsigned*)(F.ws + WS_CTL) + CW_CNT; const int l = F.lane;
        int v = l < 32 ? (int)((__hip_atomic_load(cnt + l, __ATOMIC_RELAXED, __HIP_MEMORY_SCOPE_AGENT) + 255u) >> 8) : 0;
#pragma unroll
        for (int o = 1; o < 32; o <<= 1) { const int u = __shfl_up(v, o); if (l >= o) v += u; }
        if (l < 32) tb[l + 1] = v;
        if (l == 0) tb[0] = 0;
    }
    __syncthreads();
    return tb;
}

DI void phase11(Frame& F) {
    LAS int* tb = moe_prefix(F);
    const unsigned char* Y = (const unsigned char*)(F.ws + WS_Y); const float* mod = (const float*)(F.ws + WS_MOD);
    const int* tipos = (const int*)(F.ws + WS_TIPOS); const int* tie = (const int*)(F.ws + WS_TIE); const float* tiw = (const float*)(F.ws + WS_TIW);
    const int lane = F.lane;
    for (int m0 = F.gw * 32; m0 < TOK; m0 += F.NGW * 32) {
        const int b = m0 >> 11; const float* g2 = mod + (size_t)b * 6144 + 5120;
        f32x4 ga[2], gb[2];
#pragma unroll
        for (int j = 0; j < 2; ++j) { ga[j] = *(const f32x4*)(g2 + 8 * lane + 512 * j); gb[j] = *(const f32x4*)(g2 + 8 * lane + 512 * j + 4); }
        int mr0 = 0, mr1 = 0; float mw0 = 0.f, mw1 = 0.f;
        { const int mm = m0 + (lane & 31); const int ee = tie[mm]; mr0 = tb[ee & 255] * 256 + tipos[2 * mm]; mr1 = tb[ee >> 8] * 256 + tipos[2 * mm + 1]; mw0 = tiw[2 * mm]; mw1 = tiw[2 * mm + 1]; }
        float* obase = F.out + (size_t)m0 * DM + 8 * lane; const bf16_t* xbase = (const bf16_t*)(F.ws + WS_X1B) + (size_t)m0 * DM + 8 * lane;
#define P11_LOAD(i, ya, yb, xa, xb) do { const size_t r0_ = (size_t)__shfl(mr0, (i)), r1_ = (size_t)__shfl(mr1, (i)); \
            _Pragma("unroll") for (int j = 0; j < 2; ++j) { ya[j] = __builtin_nontemporal_load((const u32x2*)(Y + r0_ * DM + 8 * lane + 512 * j)); yb[j] = __builtin_nontemporal_load((const u32x2*)(Y + r1_ * DM + 8 * lane + 512 * j)); \
                const u32x4 xw_ = ldntu4(xbase + (size_t)(i) * DM + 512 * j); xa[j] = (f32x4){bflo(xw_.x), bfhi(xw_.x), bflo(xw_.y), bfhi(xw_.y)}; xb[j] = (f32x4){bflo(xw_.z), bfhi(xw_.z), bflo(xw_.w), bfhi(xw_.w)}; } } while (0)
        u32x2 ya0[2], yb0[2], ya1[2], yb1[2]; f32x4 xa0[2], xb0[2], xa1[2], xb1[2];
        P11_LOAD(0, ya0, yb0, xa0, xb0); P11_LOAD(1, ya1, yb1, xa1, xb1);
        for (int i = 0; i < 32; i += 2) {
            u32x2 nya0[2], nyb0[2], nya1[2], nyb1[2]; f32x4 nxa0[2], nxb0[2], nxa1[2], nxb1[2];
            if (i + 2 < 32) { P11_LOAD(i + 2, nya0, nyb0, nxa0, nxb0); P11_LOAD(i + 3, nya1, nyb1, nxa1, nxb1); }
#define P11_ROW(i, ya, yb, xa, xb) do { const float w0 = __shfl(mw0, (i)), w1 = __shfl(mw1, (i)); \
            _Pragma("unroll") for (int j = 0; j < 2; ++j) { f32x4 oa = xa[j], ob = xb[j]; \
                const f32x2 a01 = __builtin_amdgcn_cvt_pk_f32_fp8((int)ya[j].x, false), a23 = __builtin_amdgcn_cvt_pk_f32_fp8((int)ya[j].x, true), a45 = __builtin_amdgcn_cvt_pk_f32_fp8((int)ya[j].y, false), a67 = __builtin_amdgcn_cvt_pk_f32_fp8((int)ya[j].y, true); \
                const f32x2 b01 = __builtin_amdgcn_cvt_pk_f32_fp8((int)yb[j].x, false), b23 = __builtin_amdgcn_cvt_pk_f32_fp8((int)yb[j].x, true), b45 = __builtin_amdgcn_cvt_pk_f32_fp8((int)yb[j].y, false), b67 = __builtin_amdgcn_cvt_pk_f32_fp8((int)yb[j].y, true); \
                oa[0] += ga[j][0] * (w0 * a01[0] + w1 * b01[0]); oa[1] += ga[j][1] * (w0 * a01[1] + w1 * b01[1]); \
                oa[2] += ga[j][2] * (w0 * a23[0] + w1 * b23[0]); oa[3] += ga[j][3] * (w0 * a23[1] + w1 * b23[1]); \
                ob[0] += gb[j][0] * (w0 * a45[0] + w1 * b45[0]); ob[1] += gb[j][1] * (w0 * a45[1] + w1 * b45[1]); \
                ob[2] += gb[j][2] * (w0 * a67[0] + w1 * b67[0]); ob[3] += gb[j][3] * (w0 * a67[1] + w1 * b67[1]); \
                stnt4(obase + (size_t)(i) * DM + 512 * j, oa); stnt4(obase + (size_t)(i) * DM + 512 * j + 4, ob); } } while (0)
            P11_ROW(i, ya0, yb0, xa0, xb0); P11_ROW(i + 1, ya1, yb1, xa1, xb1);
#pragma unroll
            for (int j = 0; j < 2; ++j) { ya0[j] = nya0[j]; yb0[j] = nyb0[j]; xa0[j] = nxa0[j]; xb0[j] = nxb0[j]; ya1[j] = nya1[j]; yb1[j] = nyb1[j]; xa1[j] = nxa1[j]; xb1[j] = nxb1[j]; }
        }
#undef P11_LOAD
#undef P11_ROW
    }
}

constexpr int CW_BAR = 4096;
#define XB_TMO      128
#define XB_XCNT(j)  (256  + 64 * (j))
#define XB_XSUB(j)  (1280 + 64 * (j))
#define XB_XGEN(j)  (2304 + 64 * (j))
#define XB_TOP      3328
#define XB_TOPGEN   3392
#define XB_SPIN_CAP (1u << 22)
DI unsigned xb_ld(unsigned* p)              { return __hip_atomic_load(p, __ATOMIC_RELAXED, __HIP_MEMORY_SCOPE_AGENT); }
DI unsigned xb_add(unsigned* p, unsigned v) { return __hip_atomic_fetch_add(p, v, __ATOMIC_RELAXED, __HIP_MEMORY_SCOPE_AGENT); }
DI unsigned xb_xcc_id() { return (unsigned)__builtin_amdgcn_s_getreg((3 << 11) | 20) & 0xFu; }
#define XB_SPIN(cond, bar) do { unsigned _sp = 0; while (cond) { __builtin_amdgcn_s_sleep(1); \
    if ((++_sp & 255u) == 0u) { if (xb_ld(&(bar)[XB_TMO])) break; if (_sp > XB_SPIN_CAP) { atomicAdd(&(bar)[XB_TMO], 1u); break; } } } } while (0)
struct XcdBarrier { unsigned* bar; unsigned x; volatile LAS unsigned* st; };
DI XcdBarrier xcd_barrier_post(unsigned* bar, volatile LAS unsigned* st, bool leader) {
    XcdBarrier b; b.bar = bar; b.x = xb_xcc_id(); b.st = st;
    if (leader) (void)xb_add(&bar[XB_XCNT(b.x)], 1u);
    return b;
}
DI void xcd_barrier_complete(unsigned* bar, unsigned x, unsigned& nloc, unsigned& nx) {
    const unsigned G = gridDim.x;
    unsigned sum, cnt, mine, sp = 0u;
    for (;;) {
        sum = 0u; cnt = 0u; mine = 0u;
#pragma unroll
        for (unsigned j = 0; j < 16; ++j) { const unsigned c = xb_ld(&bar[XB_XCNT(j)]); sum += c; cnt += (c > 0u) ? 1u : 0u; mine = (j == x) ? c : mine; }
        if (sum == G) break;
        __builtin_amdgcn_s_sleep(1);
        if ((++sp & 255u) == 0u) { if (xb_ld(&bar[XB_TMO])) break; if (sp > XB_SPIN_CAP) { atomicAdd(&bar[XB_TMO], 1u); break; } }
    }
    nloc = mine > 0u ? mine : 1u; nx = cnt > 0u ? cnt : 1u;
}
DI void xcd_barrier(const XcdBarrier& b, bool leader) {
    asm volatile("s_waitcnt vmcnt(0)" ::: "memory");
    __syncthreads();
    if (leader) {
        unsigned* bar = b.bar;
        __builtin_amdgcn_s_waitcnt(0);
        unsigned nloc = b.st[0], nx = b.st[1];
        if (nloc == 0u) { xcd_barrier_complete(bar, b.x, nloc, nx); b.st[0] = nloc; b.st[1] = nx; }
        const unsigned old = xb_add(&bar[XB_XSUB(b.x)], 1u);
        const unsigned gen = old / nloc;
        if (old + 1u == (gen + 1u) * nloc) {
            __builtin_amdgcn_fence(__ATOMIC_RELEASE, "agent");
            asm volatile("s_waitcnt vmcnt(0)" ::: "memory");
            const unsigned og = xb_add(&bar[XB_TOP], 1u);
            const unsigned tg = og / nx;
            if (og + 1u == (tg + 1u) * nx) xb_add(&bar[XB_TOPGEN], 1u);
            else XB_SPIN(xb_ld(&bar[XB_TOPGEN]) == tg, bar);
            __builtin_amdgcn_fence(__ATOMIC_ACQUIRE, "agent");
            xb_add(&bar[XB_XGEN(b.x)], 1u);
            asm volatile("s_waitcnt vmcnt(0)" ::: "memory");
        } else {
            XB_SPIN(xb_ld(&bar[XB_XGEN(b.x)]) == gen, bar);
            __builtin_amdgcn_fence(__ATOMIC_ACQUIRE, "agent");
            asm volatile("s_waitcnt vmcnt(0)" ::: "memory");
        }
    }
    __syncthreads();
}

constexpr int NPHASE = 12;
__global__ void __launch_bounds__(NTHREADS, 2) hymba_fwd(Params p) {
    extern __shared__ __attribute__((aligned(16))) unsigned char lds_raw[];
    __builtin_assume(__builtin_amdgcn_workitem_id_y() == 0); __builtin_assume(__builtin_amdgcn_workitem_id_z() == 0);
    cg::grid_group grid = cg::this_grid();
    Frame F;
    F.lds = (LAS unsigned char*)lds_raw; F.ws = p.ws; F.in = p.in; F.out = p.out;
    F.wave = __builtin_amdgcn_readfirstlane(threadIdx.x >> 6); F.lane = lane_id_fresh(); F.tid = F.wave * 64 + F.lane; F.bid = blockIdx.x; F.G = gridDim.x;
    F.gw = F.bid * NWAVES + F.wave; F.NGW = F.G * NWAVES;
    const int lo = p.ph_lo, hi = p.ph_hi;
#define IN(k) (lo <= (k) && (k) < hi)
#ifdef PROBE_A
    LAS unsigned long long* ts_ = (LAS unsigned long long*)(F.lds + LDS_MISC + 7168);
#define STAMP(k) do { if (F.bid == 0 && F.tid == 0) ts_[k] = __builtin_amdgcn_s_memrealtime(); } while (0)
#else
#define STAMP(k) do { } while (0)
#endif
    STAMP(0);
    volatile LAS unsigned* xst = (volatile LAS unsigned*)(F.lds + LDS_MISC + 4112);
    if (F.tid == 0) { xst[0] = 0u; xst[1] = 0u; }
    __syncthreads();
    XcdBarrier xbar; xbar.bar = (unsigned*)(F.ws + WS_CTL) + CW_BAR; xbar.x = 0; xbar.st = xst;
#define SEAM(k) do { if (IN(k) && IN((k) + 1)) { if ((k) == 0) { grid.sync(); xbar = xcd_barrier_post((unsigned*)(F.ws + WS_CTL) + CW_BAR, xst, F.tid == 0); } else xcd_barrier(xbar, F.tid == 0); } F.lane = lane_id_fresh(); F.tid = F.wave * 64 + F.lane; STAMP((k) + 1); } while (0)
    LAS unsigned char* ring = F.lds; LAS unsigned* tokl = (LAS unsigned*)(F.lds + LDS_MISC + 256);
#ifdef DOUBLE_PHASE
#define NREP(k) ((k) == DOUBLE_PHASE ? 2 : 1)
#define REPSYNC(k, rep) do { if ((k) == DOUBLE_PHASE && (rep) == 0) grid.sync(); } while (0)
#else
#define NREP(k) 1
#define REPSYNC(k, rep) do { } while (0)
#endif

    if (IN(0)) for (int rep = 0; rep < NREP(0); ++rep) { phase0(F); REPSYNC(0, rep); }
    SEAM(0);
    if (IN(1)) for (int rep = 0; rep < NREP(1); ++rep) { phase1(F); phase0_weights(F); REPSYNC(1, rep); }
    SEAM(1);
    if (IN(2)) for (int rep = 0; rep < NREP(2); ++rep) {
        pg8::StaticOrder S; S.init(TOK, NPROJ, DM, F.G, F.bid, F.ws + WS_H1, F.ws + WS_WIN);
        pg8::EpiInProj E{F.ws, F.in[7], F.in[8], F.in[12], F.in[13], (LAS float*)(F.lds + LDS_MISC + 8192)};
        pg8::gemm_phase<pg8::EpiInProj, pg8::StaticOrder, false>(ring, tokl, DM, S, E, F.wave, F.lane);
        REPSYNC(2, rep);
    }
    SEAM(2); STAMP(4);
    if (IN(4)) for (int rep = 0; rep < NREP(4); ++rep) {
        { pg8::CompressOrder S{F.G, F.bid, (const char*)(F.ws + WS_KC), (const char*)(F.ws + WS_PE), (const char*)(F.ws + WS_WC1)};
          pg8::EpiBf16 E{(bf16_t*)(F.ws + WS_UL), 512};
          pg8::gemm_phase<pg8::EpiBf16, pg8::CompressOrder, false>(ring, tokl, 1024, S, E, F.wave, F.lane); }
        const float mq = gmax(F.in[12], 32, F.lane), mk = gmax(F.in[13], 32, F.lane);
        const float bound = 5.656854249f * mq * mk * 1.02f; const float c2 = 0.17677669529663687f * 1.4426950408889634f; const float mc = bound * 1.4426950408889634f;
        float s1 = F.lane < 32 ? F.in[14][F.lane] * F.in[15][F.lane] : 0.f, s2 = F.lane < 32 ? F.in[16][F.lane] * F.in[17][F.lane] : 0.f;
        s1 = wave_sum(s1); s2 = wave_sum(s2);
        const float lam = __expf(s1) - __expf(s2) + 0.2f;
        unsigned* ctr = (unsigned*)(F.ws + WS_CTL) + CW_QDIFF + 32 * rep;
        for (int it = queue_next(F, ctr); it < 4096;) { unsigned nx = 0u; if (F.tid == 0) nx = atomicAdd(ctr, 1u);
            const int qb = 15 - (it >> 8), bh = it & 255; diff_unit(F, bh >> 3, bh & 7, qb, c2, mc, lam); it = queue_pass(F, nx); }
        REPSYNC(4, rep);
    }
    SEAM(4);
    if (IN(5)) for (int rep = 0; rep < NREP(5); ++rep) { phase5(F); REPSYNC(5, rep); }
    SEAM(5);
    if (IN(6)) for (int rep = 0; rep < NREP(6); ++rep) {
        const float mq = gmax(F.in[7], 64, F.lane); const float mk = fmaxf(gmax(F.in[8], 64, F.lane), fmaxf(gmax(F.in[8] + 64, 64, F.lane), gmax(F.in[8] + 128, 64, F.lane)));
        const float bound = 8.f * mq * mk * 1.02f; const float c2 = 0.125f * 1.4426950408889634f; const float mc = bound * 1.4426950408889634f;
        unsigned* ctr = (unsigned*)(F.ws + WS_CTL) + CW_QNSA + 32 * rep;
        for (int it = queue_next(F, ctr); it < 2048;) { unsigned nx = 0u; if (F.tid == 0) nx = atomicAdd(ctr, 1u);
            const int qb = 31 - (it >> 6), bg = it & 63; nsa_unit(F, bg >> 1, bg & 1, qb, c2, mc); it = queue_pass(F, nx); }
        REPSYNC(6, rep);
    }
    SEAM(6);
    if (IN(7)) for (int rep = 0; rep < NREP(7); ++rep) {
        pg8::StaticOrder S; S.init(TOK, DM, DM, F.G, F.bid, F.ws + WS_AO, F.ws + WS_WOUT);
        pg8::EpiOutProj E{F.in[0], (bf16_t*)(F.ws + WS_X1B), (const float*)(F.ws + WS_MOD), (float*)(F.ws + WS_ROWSS)};
        pg8::gemm_phase<pg8::EpiOutProj, pg8::StaticOrder, false>(ring, tokl, DM, S, E, F.wave, F.lane);
        REPSYNC(7, rep);
    }
    SEAM(7);
    if (IN(8)) phase8(F);
    SEAM(8);
    if (IN(9)) for (int rep = 0; rep < NREP(9); ++rep) {
        LAS int* tb = moe_prefix(F);
        pg8::MoeOrder S{F.G, F.bid, 0, tb, (const char*)(F.ws + WS_H2), (const char*)(F.ws + WS_WGU), (const int*)(F.ws + WS_LIST)};
        pg8::EpiSwiglu E{(unsigned char*)(F.ws + WS_HH)};
        pg8::gemm_phase<pg8::EpiSwiglu, pg8::MoeOrder, true, true>(ring, tokl, DM / 2, S, E, F.wave, F.lane);
        REPSYNC(9, rep);
    }
    SEAM(9);
    if (IN(10)) for (int rep = 0; rep < NREP(10); ++rep) {
        LAS int* tb = moe_prefix(F);
        pg8::MoeOrder S{F.G, F.bid, 1, tb, (const char*)(F.ws + WS_HH), (const char*)(F.ws + WS_WD), nullptr};
        pg8::EpiFp8 E{(unsigned char*)(F.ws + WS_Y), DM};
        pg8::gemm_phase<pg8::EpiFp8, pg8::MoeOrder, false, true>(ring, tokl, EHID / 2, S, E, F.wave, F.lane);
        REPSYNC(10, rep);
    }
    SEAM(10);
    if (IN(11)) phase11(F);
    grid.sync(); grid.sync(); grid.sync(); grid.sync(); grid.sync(); grid.sync(); grid.sync(); grid.sync();
#ifdef PROBE_A
    grid.sync(); STAMP(12);
    if (F.bid == 0 && F.tid == 0) {
        unsigned long long da = (ts_[PROBE_A + 1] - ts_[PROBE_A]) / 100ull, db = (ts_[PROBE_B + 1] - ts_[PROBE_B]) / 100ull;
        unsigned long long qa = (da + 5ull) / 10ull, qb2 = (db + 5ull) / 10ull; if (qa > 63ull) qa = 63ull; if (qb2 > 63ull) qb2 = 63ull;
        const unsigned long long target = ts_[0] + (6000ull + 16ull + 32ull * qa + 2048ull * qb2) * 100ull;
        while (__builtin_amdgcn_s_memrealtime() < target) __builtin_amdgcn_s_sleep(32);
    }
#endif
#undef IN
#undef SEAM
}

#ifndef MK_LAUNCHES
#define MK_LAUNCHES 1
#endif
extern "C" void kernel_launch(void* const* d_in, const int* in_sizes, int n_in, void* d_out, int out_size, void* d_ws, size_t ws_size, hipStream_t stream) {
    static int grid = 0;
    if (grid == 0) {
        if (n_in != 27 || ws_size < WS_END) { fprintf(stderr, "kernel_launch: unexpected inputs (n_in %d, ws %zu)\n", n_in, ws_size); grid = -1; return; }
        int dev = 0, cus = 0, per_cu = 0;
        hipGetDevice(&dev); hipDeviceGetAttribute(&cus, hipDeviceAttributeMultiprocessorCount, dev);
        hipFuncSetAttribute((const void*)hymba_fwd, hipFuncAttributeMaxDynamicSharedMemorySize, LDS_BYTES);
        hipOccupancyMaxActiveBlocksPerMultiprocessor(&per_cu, (const void*)hymba_fwd, NTHREADS, LDS_BYTES);
        if (per_cu < 1) { fprintf(stderr, "kernel_launch: occupancy query says %d blocks per CU\n", per_cu); per_cu = 1; }
        if (per_cu > 1) per_cu = 1;
        grid = cus * per_cu;
    }
    if (grid < 0) return;
    Params p{};
    for (int i = 0; i < 27; ++i) p.in[i] = (const float*)d_in[i];
    p.out = (float*)d_out; p.ws = (unsigned char*)d_ws;
    const int cuts[13] = {0, 1, 2, 3, 4, 5, 6, 7, 8, 9, 10, 11, 12};
    const int nl = MK_LAUNCHES == 1 ? 1 : NPHASE;
    for (int li = 0; li < nl; ++li) {
        p.ph_lo = nl == 1 ? 0 : cuts[li]; p.ph_hi = nl == 1 ? NPHASE : cuts[li + 1];
        void* args[] = {&p};
        hipError_t e = hipLaunchCooperativeKernel((const void*)hymba_fwd, dim3(grid), dim3(NTHREADS), args, LDS_BYTES, stream);
        if (e != hipSuccess) { fprintf(stderr, "cooperative launch failed: %s (grid %d)\n", hipGetErrorString(e), grid); break; }
    }
}
```

```cpp
#include <hip/hip_runtime.h>
#include <hip/hip_cooperative_groups.h>
#include <cstdint>
#include <cstdio>
namespace cg = cooperative_groups;

#define LAS __attribute__((address_space(3)))
#define DI __device__ __forceinline__
typedef unsigned short bf16_t;
typedef short bf16x8 __attribute__((ext_vector_type(8)));
typedef short s16x4 __attribute__((ext_vector_type(4)));
typedef float f32x2 __attribute__((ext_vector_type(2)));
typedef float f32x4 __attribute__((ext_vector_type(4)));
typedef float f32x16 __attribute__((ext_vector_type(16)));
typedef unsigned u32x2 __attribute__((ext_vector_type(2)));
typedef unsigned u32x4 __attribute__((ext_vector_type(4)));

constexpr int BATCH = 32, SEQ = 2048, DM = 1024, TOK = BATCH * SEQ;
constexpr int NPROJ = 3072;
constexpr int INCOLS = 2840;
constexpr int NEXP = 32, EHID = 512, ECAP = 65536;
constexpr float EPS = 1e-6f;
constexpr int NWAVES = 8, NTHREADS = 512;

constexpr size_t MiB = 1u << 20;
constexpr size_t WS_CTL = 0;
constexpr size_t WS_MOD = 1 * MiB;
constexpr size_t WS_ROPE = 2 * MiB;
constexpr size_t WS_WR = 3 * MiB;
constexpr size_t WS_WIN = 4 * MiB;
constexpr size_t WS_WOUT = 10 * MiB;
constexpr size_t WS_WC1 = 12 * MiB;
constexpr size_t WS_WGU = 16 * MiB;
constexpr size_t WS_WD = 80 * MiB;
constexpr size_t WS_LIST = 112 * MiB;
constexpr size_t WS_TIPOS = 120 * MiB;
constexpr size_t WS_TIE = WS_TIPOS + 512 * 1024;
constexpr size_t WS_TIW = WS_TIE + 256 * 1024;
constexpr size_t WS_ROWSS = 122 * MiB;
constexpr size_t WS_GATES = 126 * MiB;
constexpr size_t WS_KCMP = 132 * MiB;
constexpr size_t WS_VCMP = 133 * MiB;
constexpr size_t WS_UL = 134 * MiB;
constexpr size_t WS_A = 160 * MiB;
constexpr size_t WS_B = 288 * MiB;
constexpr size_t WS_C = 672 * MiB;
constexpr size_t WS_H1 = WS_A, WS_QN = WS_B + 128 * MiB, WS_QR = WS_B + 192 * MiB, WS_H2 = WS_A;
constexpr size_t WS_PROJ = WS_B, WS_AO = WS_B, WS_HH = WS_B, WS_Y = WS_B + 136 * MiB;
constexpr size_t WS_KC = WS_C, WS_VC = WS_C + 16 * MiB, WS_PE = WS_C + 32 * MiB, WS_KS = WS_C + 33 * MiB, WS_VS = WS_C + 49 * MiB,
                 WS_KW = WS_C + 65 * MiB, WS_VW = WS_C + 81 * MiB, WS_DQ = WS_C + 97 * MiB, WS_DK = WS_C + 161 * MiB, WS_DV = WS_C + 225 * MiB;
constexpr size_t WS_X1B = WS_C + 32 * MiB;
constexpr size_t WS_END = WS_C + 289 * MiB;
constexpr int CW_CNT = 0;
constexpr int CW_QDIFF = 64, CW_QNSA = 128;

constexpr int RING_BYTES = 131072;
constexpr int LDS_MISC = RING_BYTES;
constexpr int LDS_BYTES = 147456;

DI unsigned pk2(float lo, float hi) { typedef __bf16 b2 __attribute__((ext_vector_type(2))); f32x2 v = {lo, hi}; b2 b = __builtin_convertvector(v, b2); return __builtin_bit_cast(unsigned, b); }
DI unsigned short f2bf(float f) { return (unsigned short)(pk2(f, 0.f) & 0xffffu); }
DI float bf2f(unsigned short h) { return __uint_as_float((unsigned)h << 16); }
DI float bflo(unsigned w) { return __uint_as_float(w << 16); }
DI float bfhi(unsigned w) { return __uint_as_float(w & 0xffff0000u); }
DI float wave_sum(float v) {
#pragma unroll
    for (int o = 1; o < 64; o <<= 1) v += __shfl_xor(v, o);
    return v;
}
DI float fast_exp2(float x) { return __builtin_amdgcn_exp2f(x); }
DI float fast_rcp(float x) { return __builtin_amdgcn_rcpf(x); }
#define MFMA32(a, b, c) __builtin_amdgcn_mfma_f32_32x32x16_bf16((a), (b), (c), 0, 0, 0)
#define MFMA16(a, b, c) __builtin_amdgcn_mfma_f32_16x16x32_bf16((a), (b), (c), 0, 0, 0)
typedef int v8i32 __attribute__((ext_vector_type(8)));
DI unsigned pk4_fp8(float a, float b, float c, float d) { int w = 0; w = __builtin_amdgcn_cvt_pk_fp8_f32(a, b, w, false); w = __builtin_amdgcn_cvt_pk_fp8_f32(c, d, w, true); return (unsigned)w; }
DI f32x4 ldnt4(const float* p) { return __builtin_nontemporal_load((const f32x4*)p); }
DI u32x4 ldntu4(const void* p) { return __builtin_nontemporal_load((const u32x4*)p); }
DI void stnt4(float* p, f32x4 v) { __builtin_nontemporal_store(v, (f32x4*)p); }
DI int crow(int r, int hi) { return (r & 3) + 8 * (r >> 2) + 4 * hi; }

DI int lane_id_fresh() { int l; asm volatile("v_mbcnt_lo_u32_b32 %0, -1, 0\n\tv_mbcnt_hi_u32_b32 %0, -1, %0" : "=v"(l)); return l; }
DI void glds16s(const void* sbase, unsigned voff, unsigned lds_dst) { unsigned keep;
    asm volatile("s_mov_b32 %0, m0\n\ts_mov_b32 m0, %3\n\ts_nop 0\n\tglobal_load_lds_dwordx4 %1, %2\n\ts_mov_b32 m0, %0" : "=&s"(keep) : "v"(voff), "s"(sbase), "s"(lds_dst) : "memory"); }
struct Params { const float* in[27]; float* out; unsigned char* ws; int ph_lo, ph_hi; };

namespace pg8 {
constexpr int BM = 256, BK = 64, HALF = 128, HTB = HALF * BK * 2, STAGE_BYTES = 8 * HTB, NXCD = 8, WGM = 8;
DI int lds_byte(int r, int c) { const int st = (r >> 4) * 2 + (c >> 5), rr = r & 15, cc = c & 31, ob = rr * 64 + cc * 2; return st * 1024 + (ob ^ (((ob >> 9) & 1) << 5)); }
DI void stage_rc(int b, int& R, int& C) { const int st = b / 1024, sb = b % 1024, swz = sb ^ (((sb >> 9) & 1) << 5); R = (st >> 1) * 16 + swz / 64; C = (st & 1) * 32 + (swz % 64) / 2; }
DI int perm32(int rho) { const int n = rho >> 4, i = rho & 15; return 8 * (i >> 2) + 4 * n + (i & 3); }

struct Unit { int pm, pn, aux; const char* Ab; const char* Bb; const int* tok; };

template <class Epi, class Sched, bool GATHER, bool FP8 = false>
DI void gemm_phase(LAS unsigned char* lds, LAS unsigned* tokl, const int K, const Sched& S, const Epi& E, const int wid, const int lane) {
    const int tid = wid * 64 + lane, wr = wid >> 2, wc = wid & 3, fr = lane & 15, fq = lane >> 4;
    const int nt = K / BK;
    unsigned voffA[2], voffB[2]; int RA[2], CA[2];
#pragma unroll
    for (int i = 0; i < 2; ++i) { int R, C; stage_rc(tid * 16 + i * 8192, R, C); const int Rb = Epi::PERM ? ((R & ~31) + perm32(R & 31)) : R;
        voffA[i] = (unsigned)(R * K + C) * 2u; voffB[i] = (unsigned)(Rb * K + C) * 2u; RA[i] = R; CA[i] = C; }
    const size_t kstep = (size_t)(BK * 2);
    const size_t hstep = (size_t)HALF * K * 2;
    const unsigned ldsw = (unsigned)wid * 1024u; const unsigned ldsb = (unsigned)(uintptr_t)lds;
    const int aoff = lds_byte(wr * 64 + fr, fq * 8), boff = lds_byte(wc * 32 + fr, fq * 8);
#define PG8_SA(b, h) (((b) * 2 + (h)) * HTB)
#define PG8_SB(b, h) ((4 + (b) * 2 + (h)) * HTB)
#define PG8_STG(bufoff, gbase, voff) do { _Pragma("unroll") for (int _i = 0; _i < 2; ++_i) \
        glds16s((const void*)(gbase), (voff)[_i], (unsigned)__builtin_amdgcn_readfirstlane((int)(ldsb + (unsigned)(bufoff) + ldsw + (unsigned)_i * 8192u))); } while (0)
#define PG8_STA(bufoff, gbase, h, bsel) do { if constexpr (GATHER) { unsigned vv_[2];   \
            _Pragma("unroll") for (int _j = 0; _j < 2; ++_j) vv_[_j] = tokl[(bsel) * 256 + (h) * 128 + RA[_j]] * (unsigned)(K * 2) + (unsigned)(CA[_j] * 2); \
            PG8_STG(bufoff, gbase, vv_); } else { PG8_STG(bufoff, (gbase) + (h) * hstep, voffA); } } while (0)
#define PG8_LD8(p_) ({ const u32x4 lo_ = *(const LAS u32x4*)(p_), hi_ = *(const LAS u32x4*)((p_) + 1024); (v8i32){(int)lo_.x, (int)lo_.y, (int)lo_.z, (int)lo_.w, (int)hi_.x, (int)hi_.y, (int)hi_.z, (int)hi_.w}; })
#define PG8_LDA(dst, b, h) do { if constexpr (FP8) { _Pragma("unroll") for (int m = 0; m < 4; ++m) dst##8[m] = PG8_LD8(lds + PG8_SA(b, h) + aoff + m * 2048); } \
        else { _Pragma("unroll") for (int m = 0; m < 4; ++m) _Pragma("unroll") for (int k = 0; k < 2; ++k) dst[m][k] = *(const LAS bf16x8*)(lds + PG8_SA(b, h) + aoff + m * 2048 + k * 1024); } } while (0)
#define PG8_LDB(dst, b, h) do { if constexpr (FP8) { _Pragma("unroll") for (int n = 0; n < 2; ++n) dst##8[n] = PG8_LD8(lds + PG8_SB(b, h) + boff + n * 2048); } \
        else { _Pragma("unroll") for (int n = 0; n < 2; ++n) _Pragma("unroll") for (int k = 0; k < 2; ++k) dst[n][k] = *(const LAS bf16x8*)(lds + PG8_SB(b, h) + boff + n * 2048 + k * 1024); } } while (0)
#define PG8_MMA(ai, bj, At, Bt) do { __builtin_amdgcn_s_setprio(1); _Pragma("unroll") for (int m = 0; m < 4; ++m) _Pragma("unroll") for (int n = 0; n < 2; ++n) { \
        if constexpr (FP8) {   \
            asm volatile("v_mfma_scale_f32_16x16x128_f8f6f4 %0, %1, %2, %0, %3, %4 op_sel_hi:[0,0,0]" : "+v"(acc[ai][bj][m][n]) : "v"(Bt##8[n]), "v"(At##8[m]), "v"(sclB_), "v"(sclA_)); \
        } else { _Pragma("unroll") for (int k = 0; k < 2; ++k) acc[ai][bj][m][n] = __builtin_amdgcn_mfma_f32_16x16x32_bf16(Bt[n][k], At[m][k], acc[ai][bj][m][n], 0, 0, 0); } } \
        __builtin_amdgcn_s_setprio(0); } while (0)
#define PG8_WAIT_V(n) asm volatile("s_waitcnt vmcnt(" #n ")" ::: "memory")
#define PG8_WAIT_L(n) asm volatile("s_waitcnt lgkmcnt(" #n ")" ::: "memory")
#define PG8_BAR __builtin_amdgcn_s_barrier()
#define PG8_SCHED __builtin_amdgcn_sched_barrier(0)
    Unit cur, nxt; int ui = 0;
    if (!S.next(0, cur)) return;
    f32x4 acc[2][2][4][2];
#pragma unroll
    for (int a = 0; a < 2; ++a)
#pragma unroll
        for (int b = 0; b < 2; ++b)
#pragma unroll
            for (int m = 0; m < 4; ++m)
#pragma unroll
                for (int n = 0; n < 2; ++n) acc[a][b][m][n] = (f32x4){0.f, 0.f, 0.f, 0.f};
    bf16x8 At[4][2], B0[2][2], B1[2][2];
    v8i32 At8[4], B08[2], B18[2];
    int sclB_ = 0x77777777, sclA_ = 0x7f7f7f7f; asm volatile("" : "+v"(sclB_), "+v"(sclA_));
    const char* cA = cur.Ab; const char* cB = cur.Bb;
    if constexpr (GATHER) {
        if (wid < 4) __builtin_amdgcn_global_load_lds((const unsigned*)(cur.tok + wid * 64 + lane), (LAS unsigned*)(tokl + wid * 64), 4, 0, 0);
        PG8_WAIT_V(0); PG8_BAR;
    }
    PG8_STG(PG8_SB(0, 0), cB, voffB); PG8_STG(PG8_SB(0, 1), cB + hstep, voffB); PG8_STA(PG8_SA(0, 0), cA, 0, 0); PG8_STA(PG8_SA(0, 1), cA, 1, 0);
    if (wr == 1) PG8_BAR;
    PG8_WAIT_V(2); PG8_BAR;
    PG8_STG(PG8_SB(1, 0), cB + kstep, voffB); PG8_STA(PG8_SA(1, 0), cA + kstep, 0, 0); PG8_STG(PG8_SB(1, 1), cB + hstep + kstep, voffB);
    PG8_WAIT_V(6); PG8_BAR;
    for (;;) {
        const bool has_next = S.next(ui + 1, nxt);
        const char* nA = has_next ? nxt.Ab : cA; const char* nB = has_next ? nxt.Bb : cB;
        if constexpr (GATHER) {
            if (has_next && wid < 4) __builtin_amdgcn_global_load_lds((const unsigned*)(nxt.tok + wid * 64 + lane), (LAS unsigned*)(tokl + ((ui + 1) & 1) * 256 + wid * 64), 4, 0, 0);
        }
#pragma unroll 1
        for (int t = 0; t < nt; t += 2) {
            const bool last = (t == nt - 2);
            const char* a1 = cA + (size_t)(t + 1) * kstep;
            const char* a2 = last ? nA : cA + (size_t)(t + 2) * kstep; const char* b2 = last ? nB : cB + (size_t)(t + 2) * kstep;
            const char* a3 = a2 + kstep; const char* b3 = b2 + kstep;
            const int bc_ = ui & 1, bn_ = (last && has_next) ? ((ui + 1) & 1) : (ui & 1);
            PG8_LDB(B0, 0, 0); PG8_LDB(B1, 0, 1); PG8_SCHED; PG8_LDA(At, 0, 0); PG8_STA(PG8_SA(1, 1), a1, 1, bc_);
            PG8_WAIT_V(8); PG8_WAIT_L(0); PG8_BAR; PG8_MMA(0, 0, At, B0); PG8_MMA(0, 1, At, B1); PG8_BAR; PG8_SCHED;
            PG8_LDA(At, 0, 1); PG8_STG(PG8_SB(0, 0), b2, voffB); PG8_STG(PG8_SB(0, 1), b2 + hstep, voffB); PG8_STA(PG8_SA(0, 0), a2, 0, bn_);
            PG8_WAIT_V(8); PG8_WAIT_L(0); PG8_BAR; PG8_MMA(1, 0, At, B0); PG8_MMA(1, 1, At, B1); PG8_BAR; PG8_SCHED;
            PG8_LDB(B0, 1, 0); PG8_LDB(B1, 1, 1); PG8_SCHED; PG8_LDA(At, 1, 0); PG8_STA(PG8_SA(0, 1), a2, 1, bn_);
            PG8_WAIT_V(8); PG8_WAIT_L(0); PG8_BAR; PG8_MMA(0, 0, At, B0); PG8_MMA(0, 1, At, B1); PG8_BAR; PG8_SCHED;
            PG8_LDA(At, 1, 1); PG8_STG(PG8_SB(1, 0), b3, voffB); PG8_STG(PG8_SB(1, 1), b3 + hstep, voffB); PG8_STA(PG8_SA(1, 0), a3, 0, bn_);
            PG8_WAIT_V(8); PG8_WAIT_L(0); PG8_BAR; PG8_MMA(1, 0, At, B0); PG8_MMA(1, 1, At, B1); PG8_BAR; PG8_SCHED;
        }
        if (wr == 0) PG8_BAR;
        if constexpr (FP8) asm volatile("s_nop 15\n\ts_nop 15" ::: "memory");
        E(acc, cur, wr, wc, fr, fq);
        if (!has_next) break;
#pragma unroll
        for (int a = 0; a < 2; ++a)
#pragma unroll
            for (int b = 0; b < 2; ++b)
#pragma unroll
                for (int m = 0; m < 4; ++m)
#pragma unroll
                    for (int n = 0; n < 2; ++n) acc[a][b][m][n] = (f32x4){0.f, 0.f, 0.f, 0.f};
        cur = nxt; cA = nA; cB = nB; ++ui;
        if (wr == 1) PG8_BAR;
    }
    PG8_WAIT_V(0);
    PG8_BAR;
#undef PG8_SA
#undef PG8_SB
#undef PG8_STG
#undef PG8_STA
#undef PG8_LDA
#undef PG8_LDB
#undef PG8_MMA
#undef PG8_WAIT_V
#undef PG8_WAIT_L
#undef PG8_BAR
#undef PG8_SCHED
}

struct StaticOrder {
    int nM, nN, nwg, G, c; const char* A; const char* Bt; size_t tstep;
    DI void init(int M, int N, int K, int G_, int c_, const void* A_, const void* Bt_) { nM = M / BM; nN = N / BM; nwg = nM * nN; G = G_; c = c_; A = (const char*)A_; Bt = (const char*)Bt_; tstep = (size_t)BM * K * 2; }
    DI bool next(int i, Unit& u) const {
        const long L = (long)i * G + c; if (L >= nwg) return false;
        int wgid = (int)L; { const int q = nwg / NXCD, r = nwg % NXCD, xcd = wgid % NXCD, off = wgid / NXCD; wgid = (xcd < r ? xcd * (q + 1) : r * (q + 1) + (xcd - r) * q) + off; }
        const int nig = WGM * nN, gid = wgid / nig, fm = gid * WGM, gsz = (nM - fm) < WGM ? (nM - fm) : WGM;
        u.pm = fm + ((wgid % nig) % gsz); u.pn = (wgid % nig) / gsz; u.aux = 0; u.Ab = A + (size_t)u.pm * tstep; u.Bb = Bt + (size_t)u.pn * tstep; u.tok = nullptr; return true;
    }
};
struct CompressOrder {
    int G, c; const char* KC; const char* PE; const char* W;
    DI bool next(int i, Unit& u) const {
        const int L = i * G + c; if (L >= 132) return false;
        u.pm = L >> 1; u.pn = L & 1; const int kv = u.pm < 32 ? 0 : (u.pm < 64 ? 1 : u.pm - 64); u.aux = kv;
        u.Ab = u.pm < 64 ? KC + (size_t)u.pm * (256 * 1024 * 2) : PE; u.Bb = W + (size_t)kv * (512 * 1024 * 2) + (size_t)u.pn * (256 * 1024 * 2); u.tok = nullptr; return true;
    }
};
struct MoeOrder {
    int G, c, mode; const LAS int* tb; const char* A; const char* W; const int* lists;
    DI bool next(int i, Unit& u) const {
        const int L = i * G + c; const int mt = L >> 2; if (mt >= tb[32]) return false;
        int e = 0;
#pragma unroll 1
        for (int j = 1; j < 32; ++j) e += (tb[j] <= mt) ? 1 : 0;
        u.pm = mt; u.pn = L & 3; u.aux = e;
        if (mode == 0) { u.Ab = A; u.Bb = W + (size_t)e * (1024 * 1024) + (size_t)u.pn * (256 * 1024); u.tok = lists + (size_t)e * ECAP + (size_t)(mt - tb[e]) * 256; }
        else { u.Ab = A + (size_t)mt * (256 * 512); u.Bb = W + (size_t)e * (1024 * 512) + (size_t)u.pn * (256 * 512); u.tok = nullptr; }
        return true;
    }
};

struct EpiBf16 {
    static constexpr bool PERM = true;
    bf16_t* O; int ldc;
    DI void operator()(const f32x4 (&acc)[2][2][4][2], const Unit& u, int wr, int wc, int fr, int fq) const {
        asm volatile("" : "+v"(fr), "+v"(fq));
        const int row0 = u.pm * BM + wr * 64 + fr; const int col0 = u.pn * BM + wc * 32 + 8 * fq;
#pragma unroll
        for (int ai = 0; ai < 2; ++ai)
#pragma unroll
            for (int m = 0; m < 4; ++m) { bf16_t* rowp = O + (size_t)(row0 + ai * HALF + m * 16) * ldc + col0;
#pragma unroll
                for (int bj = 0; bj < 2; ++bj) { const f32x4 v0 = acc[ai][bj][m][0], v1 = acc[ai][bj][m][1];
                    u32x4 w; w.x = pk2(v0[0], v0[1]); w.y = pk2(v0[2], v0[3]); w.z = pk2(v1[0], v1[1]); w.w = pk2(v1[2], v1[3]);
                    *(u32x4*)(rowp + bj * HALF) = w; } }
    }
};
struct EpiInProj {
    static constexpr bool PERM = true;
    unsigned char* ws; const float* g_nq; const float* g_nk; const float* g_dq; const float* g_dk; LAS float* xch;
    DI void operator()(const f32x4 (&acc)[2][2][4][2], const Unit& u, int wr, int wc, int fr, int fq) const {
        const int pn = u.pn, wid = wr * 4 + wc; const int tok0 = u.pm * BM; const int b = tok0 >> 11; int t0 = (tok0 & 2047) + wr * 64 + fr;
        int xo_i = wid * 256 + fr, xp_i = (wid ^ 1) * 256 + fr;
        asm volatile("" : "+v"(t0), "+v"(xo_i), "+v"(xp_i));
        LAS float* xo = xch + xo_i; LAS float* xp = xch + xp_i;
        const float* ropeN = (const float*)(ws + WS_ROPE); const float* ropeD = ropeN + 2048 * 16;
        const int d0 = 32 * (wc & 1) + 8 * fq;
        if (pn <= 4) {
            const bool nrm0 = (pn != 2), nrm1 = (pn < 2);
            if (pn != 2) {
#pragma unroll
                for (int ai = 0; ai < 2; ++ai)
#pragma unroll
                    for (int m = 0; m < 4; ++m)
#pragma unroll
                        for (int bj = 0; bj < 2; ++bj) { const f32x4 a = acc[ai][bj][m][0], c = acc[ai][bj][m][1];
                            float ss = (a[0] * a[0] + a[1] * a[1]) + (a[2] * a[2] + a[3] * a[3]) + (c[0] * c[0] + c[1] * c[1]) + (c[2] * c[2] + c[3] * c[3]);
                            ss += __shfl_xor(ss, 16); ss += __shfl_xor(ss, 32);
                            if (fq == 0) xo[((ai * 4 + m) * 2 + bj) * 16] = ss; }
                asm volatile("s_waitcnt lgkmcnt(0)" ::: "memory"); __builtin_amdgcn_s_barrier(); asm volatile("" ::: "memory");
            }
            const float* gg = pn < 2 ? g_nq : (g_nk + (pn == 3 ? 64 : 128));
            f32x4 g0 = {1.f, 1.f, 1.f, 1.f}, g1 = g0;
            if (pn != 2) { g0 = *(const f32x4*)(gg + d0); g1 = *(const f32x4*)(gg + d0 + 4); }
            const bool ropew = (wc & 1) == 0;
#pragma unroll
            for (int ai = 0; ai < 2; ++ai)
#pragma unroll
                for (int m = 0; m < 4; ++m) {
                    const int t = t0 + ai * HALF + m * 16;
                    f32x4 cs0 = {1.f, 0.f, 1.f, 0.f}, cs1 = cs0, cs2 = cs0, cs3 = cs0;
                    if (pn != 2 && ropew && fq < 2) { const f32x4* rp = (const f32x4*)(ropeN + t * 16); cs0 = rp[0]; cs1 = rp[1]; cs2 = rp[2]; cs3 = rp[3]; }
#pragma unroll
                    for (int bj = 0; bj < 2; ++bj) {
                        const bool donorm = bj == 0 ? nrm0 : nrm1;
                        f32x4 ya = acc[ai][bj][m][0], yb = acc[ai][bj][m][1];
                        u32x4 w0, w1;
                        if (donorm) {
                            const float rstd = rsqrtf((xo[((ai * 4 + m) * 2 + bj) * 16] + xp[((ai * 4 + m) * 2 + bj) * 16]) * (1.f / 64.f) + EPS);
                            ya = ya * rstd * g0; yb = yb * rstd * g1;
                            w0.x = pk2(ya[0], ya[1]); w0.y = pk2(ya[2], ya[3]); w0.z = pk2(yb[0], yb[1]); w0.w = pk2(yb[2], yb[3]);
                            f32x4 ra = ya, rb = yb;
                            if (ropew) {
                                f32x4 pa, pb;
#pragma unroll
                                for (int i = 0; i < 4; ++i) { pa[i] = __shfl_xor(ya[i], 16); pb[i] = __shfl_xor(yb[i], 16); }
                                if (fq == 0) { ra[0] = ya[0] * cs0[0] - pa[0] * cs0[1]; ra[1] = ya[1] * cs0[2] - pa[1] * cs0[3]; ra[2] = ya[2] * cs1[0] - pa[2] * cs1[1]; ra[3] = ya[3] * cs1[2] - pa[3] * cs1[3];
                                               rb[0] = yb[0] * cs2[0] - pb[0] * cs2[1]; rb[1] = yb[1] * cs2[2] - pb[1] * cs2[3]; rb[2] = yb[2] * cs3[0] - pb[2] * cs3[1]; rb[3] = yb[3] * cs3[2] - pb[3] * cs3[3]; }
                                else if (fq == 1) { ra[0] = pa[0] * cs0[1] + ya[0] * cs0[0]; ra[1] = pa[1] * cs0[3] + ya[1] * cs0[2]; ra[2] = pa[2] * cs1[1] + ya[2] * cs1[0]; ra[3] = pa[3] * cs1[3] + ya[3] * cs1[2];
                                                    rb[0] = pb[0] * cs2[1] + yb[0] * cs2[0]; rb[1] = pb[1] * cs2[3] + yb[1] * cs2[2]; rb[2] = pb[2] * cs3[1] + yb[2] * cs3[0]; rb[3] = pb[3] * cs3[3] + yb[3] * cs3[2]; }
                            }
                            w1.x = pk2(ra[0], ra[1]); w1.y = pk2(ra[2], ra[3]); w1.z = pk2(rb[0], rb[1]); w1.w = pk2(rb[2], rb[3]);
                        } else { w0.x = pk2(ya[0], ya[1]); w0.y = pk2(ya[2], ya[3]); w0.z = pk2(yb[0], yb[1]); w0.w = pk2(yb[2], yb[3]); w1 = w0; }
                        const int hq = 2 * bj + (wc >> 1);
                        if (pn < 2) { const size_t off = (((size_t)b * 8 + 4 * pn + hq) * SEQ + t) * 64 + d0;
                            *(u32x4*)((bf16_t*)(ws + WS_QN) + off) = w0; *(u32x4*)((bf16_t*)(ws + WS_QR) + off) = w1; }
                        else { const int six = 2 * (pn - 2) + bj; const size_t base = six == 0 ? WS_KC : six == 1 ? WS_VC : six == 2 ? WS_KS : six == 3 ? WS_VS : six == 4 ? WS_KW : WS_VW;
                            const size_t off = (((size_t)b * 2 + (wc >> 1)) * SEQ + t) * 64 + d0;
                            *(u32x4*)((bf16_t*)(ws + base) + off) = w1; }
                    }
                    asm volatile("" ::: "memory");
                }
        } else if (pn <= 8) {
            const bool isq = pn <= 6; const float* gg = isq ? g_dq : g_dk; bf16_t* dst = (bf16_t*)(ws + (isq ? WS_DQ : WS_DK));
            const f32x4 g0 = *(const f32x4*)(gg + 8 * fq), g1 = *(const f32x4*)(gg + 8 * fq + 4);
#pragma unroll
            for (int ai = 0; ai < 2; ++ai)
#pragma unroll
                for (int m = 0; m < 4; ++m) {
                    const int t = t0 + ai * HALF + m * 16;
                    f32x4 c0 = {1.f, 0.f, 1.f, 0.f}, c1 = c0;
                    if (fq == 0) { const f32x4* rp = (const f32x4*)(ropeD + t * 8); c0 = rp[0]; c1 = rp[1]; }
#pragma unroll
                    for (int bj = 0; bj < 2; ++bj) {
                        f32x4 ya = acc[ai][bj][m][0], yb = acc[ai][bj][m][1];
                        float ss = (ya[0] * ya[0] + ya[1] * ya[1]) + (ya[2] * ya[2] + ya[3] * ya[3]) + (yb[0] * yb[0] + yb[1] * yb[1]) + (yb[2] * yb[2] + yb[3] * yb[3]);
                        ss += __shfl_xor(ss, 16); ss += __shfl_xor(ss, 32);
                        const float rstd = rsqrtf(ss * (1.f / 32.f) + EPS);
                        ya = ya * rstd * g0; yb = yb * rstd * g1;
                        if (fq == 0) { const f32x4 a = ya, bb = yb;
                            ya[0] = a[0] * c0[0] - bb[0] * c0[1]; yb[0] = a[0] * c0[1] + bb[0] * c0[0]; ya[1] = a[1] * c0[2] - bb[1] * c0[3]; yb[1] = a[1] * c0[3] + bb[1] * c0[2];
                            ya[2] = a[2] * c1[0] - bb[2] * c1[1]; yb[2] = a[2] * c1[1] + bb[2] * c1[0]; ya[3] = a[3] * c1[2] - bb[3] * c1[3]; yb[3] = a[3] * c1[3] + bb[3] * c1[2]; }
                        u32x4 w; w.x = pk2(ya[0], ya[1]); w.y = pk2(ya[2], ya[3]); w.z = pk2(yb[0], yb[1]); w.w = pk2(yb[2], yb[3]);
                        const int hd = 4 * ((pn - 5) & 1) + 2 * bj + (wc >> 1);
                        *(u32x4*)(dst + (((size_t)b * 8 + hd) * SEQ + t) * 64 + d0) = w;
                    }
                    asm volatile("" ::: "memory");
                }
        } else if (pn <= 10) {
            bf16_t* dst = (bf16_t*)(ws + WS_DV);
#pragma unroll
            for (int ai = 0; ai < 2; ++ai)
#pragma unroll
                for (int m = 0; m < 4; ++m) { const int t = t0 + ai * HALF + m * 16;
#pragma unroll
                    for (int bj = 0; bj < 2; ++bj) { const f32x4 ya = acc[ai][bj][m][0], yb = acc[ai][bj][m][1];
                        u32x4 w; w.x = pk2(ya[0], ya[1]); w.y = pk2(ya[2], ya[3]); w.z = pk2(yb[0], yb[1]); w.w = pk2(yb[2], yb[3]);
                        const int hd = 4 * (pn - 9) + 2 * bj + (wc >> 1);
                        *(u32x4*)(dst + (((size_t)b * 8 + hd) * SEQ + t) * 64 + d0) = w; }
                    asm volatile("" ::: "memory"); }
        } else {
            if (wc == 0 && fq < 3) {
                float* gt = (float*)(ws + WS_GATES);
#pragma unroll
                for (int ai = 0; ai < 2; ++ai)
#pragma unroll
                    for (int m = 0; m < 4; ++m) { const size_t tok = (size_t)tok0 + wr * 64 + fr + ai * HALF + m * 16; const f32x4 ya = acc[ai][0][m][0], yb = acc[ai][0][m][1]; f32x4 sa, sb;
#pragma unroll
                        for (int i = 0; i < 4; ++i) { sa[i] = 1.f / (1.f + __expf(-ya[i])); sb[i] = 1.f / (1.f + __expf(-yb[i])); }
                        *(f32x4*)(gt + tok * 24 + 8 * fq) = sa; *(f32x4*)(gt + tok * 24 + 8 * fq + 4) = sb; }
            }
        }
    }
};
struct EpiFp8 {
    static constexpr bool PERM = true;
    unsigned char* O; int ldc;
    DI void operator()(const f32x4 (&acc)[2][2][4][2], const Unit& u, int wr, int wc, int fr, int fq) const {
        asm volatile("" : "+v"(fr), "+v"(fq));
        const int row0 = u.pm * BM + wr * 64 + fr; const int col0 = u.pn * BM + wc * 32 + 8 * fq;
#pragma unroll
        for (int ai = 0; ai < 2; ++ai)
#pragma unroll
            for (int m = 0; m < 4; ++m) { unsigned char* rowp = O + (size_t)(row0 + ai * HALF + m * 16) * ldc + col0;
#pragma unroll
                for (int bj = 0; bj < 2; ++bj) { const f32x4 v0 = acc[ai][bj][m][0], v1 = acc[ai][bj][m][1];
                    u32x2 w; w.x = pk4_fp8(v0[0], v0[1], v0[2], v0[3]); w.y = pk4_fp8(v1[0], v1[1], v1[2], v1[3]);
                    *(u32x2*)(rowp + bj * HALF) = w; } }
    }
};
struct EpiSwiglu {
    static constexpr bool PERM = true;
    unsigned char* O;
    DI void operator()(const f32x4 (&acc)[2][2][4][2], const Unit& u, int wr, int wc, int fr, int fq) const {
        asm volatile("" : "+v"(fr), "+v"(fq));
        const int row0 = u.pm * BM + wr * 64 + fr; const int col0 = u.pn * 128 + wc * 16 + 4 * fq;
#pragma unroll
        for (int ai = 0; ai < 2; ++ai)
#pragma unroll
            for (int m = 0; m < 4; ++m) { unsigned char* rowp = O + (size_t)(row0 + ai * HALF + m * 16) * EHID + col0;
#pragma unroll
                for (int bj = 0; bj < 2; ++bj) { const f32x4 g = acc[ai][bj][m][0], up = acc[ai][bj][m][1]; float h[4];
#pragma unroll
                    for (int i = 0; i < 4; ++i) { const float s = fast_rcp(1.f + __expf(-g[i])); h[i] = g[i] * s * up[i]; }
                    *(unsigned*)(rowp + bj * 64) = pk4_fp8(h[0], h[1], h[2], h[3]); } }
    }
};
struct EpiOutProj {
    static constexpr bool PERM = true;
    const float* x; bf16_t* x1b; const float* mod; float* rowss;
    DI void operator()(const f32x4 (&acc)[2][2][4][2], const Unit& u, int wr, int wc, int fr, int fq) const {
        const int col0 = u.pn * BM + wc * 32 + 8 * fq; const int b = (u.pm * BM) / SEQ;
        const float* g1 = mod + (size_t)b * 6144 + 2048 + col0;
        f32x4 gv[2][2];
#pragma unroll
        for (int bj = 0; bj < 2; ++bj)
#pragma unroll
            for (int n = 0; n < 2; ++n) gv[bj][n] = *(const f32x4*)(g1 + bj * HALF + n * 4);
#pragma unroll
        for (int ai = 0; ai < 2; ++ai)
#pragma unroll
            for (int m = 0; m < 4; ++m) { const int r = u.pm * BM + ai * HALF + wr * 64 + m * 16 + fr; const size_t off = (size_t)r * DM + col0; float ss = 0.f;
#pragma unroll
                for (int bj = 0; bj < 2; ++bj) { const f32x4 xa = ldnt4(x + off + bj * HALF), xb = ldnt4(x + off + bj * HALF + 4);
                    const f32x4 oa = xa + gv[bj][0] * acc[ai][bj][m][0], ob = xb + gv[bj][1] * acc[ai][bj][m][1];
                    ss += (oa[0] * oa[0] + oa[1] * oa[1]) + (oa[2] * oa[2] + oa[3] * oa[3]) + (ob[0] * ob[0] + ob[1] * ob[1]) + (ob[2] * ob[2] + ob[3] * ob[3]);
                    u32x4 w; w.x = pk2(oa[0], oa[1]); w.y = pk2(oa[2], oa[3]); w.z = pk2(ob[0], ob[1]); w.w = pk2(ob[2], ob[3]);
                    *(u32x4*)(x1b + off + bj * HALF) = w; }
                ss += __shfl_xor(ss, 16); ss += __shfl_xor(ss, 32);
                if (fq == 0) rowss[(size_t)r * 16 + u.pn * 4 + wc] = ss; }
    }
};
}

struct Frame {
    LAS unsigned char* lds; unsigned char* ws; const float* const* in; float* out;
    int tid, lane, wave, bid, G, gw, NGW;
};

DI int origcol(int n) { return n < 1280 ? n : (n < 2816 ? n + 24 : (n < 2840 ? n - 2816 + 1280 : -1)); }

template <class DRow>
DI void tr_item(const float* src, int src_ld, int sc  , bf16_t* dst, int dst_ld, int k0, LAS float* scr, int lane, DRow drow) {
#pragma unroll 8
    for (int i = 0; i < 32; ++i) { const int kk = 2 * i + (lane >> 5); scr[kk * 33 + (lane & 31)] = sc >= 0 ? src[(size_t)(k0 + kk) * src_ld + sc] : 0.f; }
    asm volatile("s_waitcnt lgkmcnt(0)" ::: "memory");
    const int c = lane & 7;
#pragma unroll
    for (int j = 0; j < 4; ++j) { const int n = (lane >> 3) + 8 * j; const LAS float* s = scr + (8 * c) * 33 + n;
        u32x4 o; o.x = pk2(s[0 * 33], s[1 * 33]); o.y = pk2(s[2 * 33], s[3 * 33]); o.z = pk2(s[4 * 33], s[5 * 33]); o.w = pk2(s[6 * 33], s[7 * 33]);
        *(u32x4*)(dst + (size_t)drow(n) * dst_ld + k0 + 8 * c) = o; }
    asm volatile("s_waitcnt lgkmcnt(0)" ::: "memory");
}

DI void phase0(Frame& F) {
    const float* c_in = F.in[1]; const float* w_ada = F.in[2]; const float* b_ada = F.in[3];
    float* mod = (float*)(F.ws + WS_MOD);
    for (int it = F.bid; it < 96; it += F.G) {
        LAS float* cs = (LAS float*)F.lds;
        for (int idx = F.tid; idx < 32 * 1024; idx += NTHREADS) { const int b = idx >> 10, k = idx & 1023; cs[k * 32 + b] = c_in[idx]; }
        __syncthreads();
        float acc[32];
#pragma unroll
        for (int b = 0; b < 32; ++b) acc[b] = 0.f;
        const int j = it * 64 + F.lane;
#pragma unroll 1
        for (int kg = 0; kg < 4; ++kg) {
            float wv[32];
#pragma unroll
            for (int q = 0; q < 32; ++q) wv[q] = w_ada[(size_t)(F.wave * 128 + kg * 32 + q) * 6144 + j];
#pragma unroll
            for (int q = 0; q < 32; ++q) { const int k = F.wave * 128 + kg * 32 + q; const float w = wv[q];
#pragma unroll
                for (int b4 = 0; b4 < 8; ++b4) { const f32x4 cv = *(const LAS f32x4*)(cs + k * 32 + b4 * 4); acc[b4 * 4 + 0] += cv[0] * w; acc[b4 * 4 + 1] += cv[1] * w; acc[b4 * 4 + 2] += cv[2] * w; acc[b4 * 4 + 3] += cv[3] * w; } }
        }
        __syncthreads();
        LAS float* red = (LAS float*)F.lds;
#pragma unroll
        for (int b = 0; b < 32; ++b) red[(F.wave * 32 + b) * 64 + F.lane] = acc[b];
        __syncthreads();
        for (int o = F.tid; o < 2048; o += NTHREADS) { const int b = o >> 6, l = o & 63; float s = b_ada[it * 64 + l];
#pragma unroll
            for (int w = 0; w < 8; ++w) s += red[(w * 32 + b) * 64 + l];
            mod[(size_t)b * 6144 + it * 64 + l] = s; }
        __syncthreads();
    }
    const int gt = F.bid * NTHREADS + F.tid, NGT = F.G * NTHREADS;
    { float* ropeN = (float*)(F.ws + WS_ROPE); float* ropeD = ropeN + 2048 * 16;
      for (int i = gt; i < 2048 * 12; i += NGT) { const int t = i / 12, j = i % 12; const bool isn = j < 8; const int ii = isn ? j : j - 8;
          const float ex = isn ? (float)(2 * ii) / 16.f : (float)(2 * ii) / 8.f;
          const float inv = exp2f(-ex * 18.931568569324174f);
          const float ang = (float)t * inv;
          const double rev = (double)ang * 0.15915494309189535; const double fr = rev - __builtin_rint(rev); const float rr = (float)(fr * 6.283185307179586);
          const float cs = __cosf(rr), sn = __sinf(rr);
          if (isn) { ropeN[(t * 8 + ii) * 2] = cs; ropeN[(t * 8 + ii) * 2 + 1] = sn; } else { ropeD[(t * 4 + ii) * 2] = cs; ropeD[(t * 4 + ii) * 2 + 1] = sn; } } }
    { bf16_t* whi = (bf16_t*)(F.ws + WS_WR); bf16_t* wlo = whi + 48 * 1024;
      for (int i = gt; i < 48 * 1024; i += NGT) { const int c = i >> 10, k = i & 1023; float w = 0.f;
          if (c < 4) w = F.in[20][k * 4 + c]; else if (c < 36) w = F.in[22][k * 32 + (c - 4)];
          const unsigned short h = f2bf(w); whi[i] = h; wlo[i] = f2bf(w - bf2f(h)); } }
    { bf16_t* pe = (bf16_t*)(F.ws + WS_PE);
      for (int i = gt; i < 256 * 1024; i += NGT) { const int r = i >> 10, k = i & 1023; float v = 0.f; if (r < 4) v = F.in[9][(r >> 1) * 2048 + (r & 1) * 1024 + k]; pe[i] = f2bf(v); } }
    { u32x4* l4 = (u32x4*)(F.ws + WS_LIST); for (int i = gt; i < (int)(NEXP * ECAP / 4); i += NGT) l4[i] = (u32x4){0u, 0u, 0u, 0u};
      unsigned* ctl = (unsigned*)(F.ws + WS_CTL); for (int i = gt; i < 8192; i += NGT) ctl[i] = 0u; }
}

struct TrD { const float* src; int ld; int sc; bf16_t* dst; int dld; int k0; int mode; int n0; int aux; int fp8; };
DI TrD tr_desc(Frame& F, int it, int lane) {
    constexpr int I_IN = 16 * 96, I_OUT = 16 * 32, I_G = 32 * 16 * 16, I_D = 32 * 8 * 32;
    TrD d; int r = it; const int nq = lane & 7;
    if (r < I_IN) { const int kb = r / 96, nb = r % 96; d.n0 = nb * 32; const int n = d.n0 + 4 * nq; d.src = F.in[6]; d.ld = INCOLS; d.sc = origcol(n); d.dst = (bf16_t*)(F.ws + WS_WIN); d.dld = 1024; d.k0 = kb * 64; d.mode = 0; d.aux = 0; d.fp8 = 1; return d; }
    r -= I_IN;
    if (r < I_OUT) { const int kb = r / 32, nb = r % 32; d.n0 = nb * 32; d.src = F.in[19]; d.ld = 1024; d.sc = d.n0 + 4 * nq; d.dst = (bf16_t*)(F.ws + WS_WOUT); d.dld = 1024; d.k0 = kb * 64; d.mode = 0; d.aux = 0; d.fp8 = 0; return d; }
    r -= I_OUT;
    if (r < 2 * I_G) { const int up = r / I_G; r -= up * I_G; const int e = r / 256, q = r % 256, kb = q / 16, nb = q % 16; d.n0 = nb * 32;
        d.src = F.in[24 + up] + (size_t)e * 1024 * 512; d.ld = 512; d.sc = d.n0 + 4 * nq; d.dst = (bf16_t*)(F.ws + WS_WGU + (size_t)e * 1024 * 1024); d.dld = 1024; d.k0 = kb * 64; d.mode = 1; d.aux = up; d.fp8 = 1; return d; }
    r -= 2 * I_G;
    if (r < I_D) { const int e = r / 256, q = r % 256, kb = q / 32, nb = q % 32; d.n0 = nb * 32;
        d.src = F.in[26] + (size_t)e * 512 * 1024; d.ld = 1024; d.sc = d.n0 + 4 * nq; d.dst = (bf16_t*)(F.ws + WS_WD + (size_t)e * 1024 * 512); d.dld = 512; d.k0 = kb * 64; d.mode = 0; d.aux = 0; d.fp8 = 1; return d; }
    r -= I_D;
    { const int kvh = r / 128, q = r % 128, kb = q / 8, nb = q % 8; d.n0 = nb * 32; const int kv = kvh >> 1, half = kvh & 1;
      d.src = F.in[10] + (size_t)kv * 2048 * 256 + (size_t)half * 1024 * 256; d.ld = 256; d.sc = d.n0 + 4 * nq; d.dst = (bf16_t*)(F.ws + WS_WC1) + (size_t)kv * 512 * 1024; d.dld = 1024; d.k0 = kb * 64; d.mode = 2; d.aux = half; d.fp8 = 0; return d; }
}
DI void tr_load(const TrD& d, f32x4 (&v)[8], int lane) {
    const int kk = lane >> 3;
#pragma unroll
    for (int i = 0; i < 8; ++i) v[i] = d.sc >= 0 ? ldnt4(d.src + (size_t)(d.k0 + kk + 8 * i) * d.ld + d.sc) : (f32x4){0.f, 0.f, 0.f, 0.f};
}
DI void tr_finish(const TrD& d, const f32x4 (&v)[8], LAS float* scr, int lane) {
    const int kk = lane >> 3, nq = lane & 7;
#pragma unroll
    for (int i = 0; i < 8; ++i) *(LAS f32x4*)(scr + (kk + 8 * i) * 36 + 4 * nq) = v[i];
    asm volatile("s_waitcnt lgkmcnt(0)" ::: "memory");
    const int c = lane & 7;
#pragma unroll
    for (int j = 0; j < 4; ++j) { const int n = (lane >> 3) + 8 * j; const LAS float* s = scr + (8 * c) * 36 + n;
        const int jn = d.n0 + n; const int row = d.mode == 0 ? jn : (d.mode == 1 ? 8 * (jn >> 2) + (jn & 3) + 4 * d.aux : d.aux * 256 + jn);
        if (d.fp8) { u32x2 o8; o8.x = pk4_fp8(s[0 * 36] * 256.f, s[1 * 36] * 256.f, s[2 * 36] * 256.f, s[3 * 36] * 256.f); o8.y = pk4_fp8(s[4 * 36] * 256.f, s[5 * 36] * 256.f, s[6 * 36] * 256.f, s[7 * 36] * 256.f);
            *(u32x2*)((unsigned char*)d.dst + (size_t)row * d.dld + d.k0 + 8 * c) = o8; }
        else { u32x4 o; o.x = pk2(s[0 * 36], s[1 * 36]); o.y = pk2(s[2 * 36], s[3 * 36]); o.z = pk2(s[4 * 36], s[5 * 36]); o.w = pk2(s[6 * 36], s[7 * 36]);
            *(u32x4*)(d.dst + (size_t)row * d.dld + d.k0 + 8 * c) = o; } }
    asm volatile("s_waitcnt lgkmcnt(0)" ::: "memory");
}
DI void phase0_weights(Frame& F) {
    LAS float* scr = (LAS float*)(F.lds + F.wave * 16384);
    const int lane = F.lane;
    constexpr int NITEMS = 16 * 96 + 16 * 32 + 2 * (32 * 16 * 16) + 32 * 8 * 32 + 4 * 16 * 8;
    int it = F.gw; if (it >= NITEMS) return;
    TrD cur = tr_desc(F, it, lane); f32x4 vc[8]; tr_load(cur, vc, lane);
    for (;;) {
        const int nit = it + F.NGW; const bool more = nit < NITEMS;
        TrD nxt = cur; f32x4 vn[8];
        if (more) { nxt = tr_desc(F, nit, lane); tr_load(nxt, vn, lane); }
        tr_finish(cur, vc, scr, lane);
        if (!more) break;
        cur = nxt; it = nit;
#pragma unroll
        for (int i = 0; i < 8; ++i) vc[i] = vn[i];
    }
}

DI void phase1(Frame& F) {
    const float* x = F.in[0]; const float* g = F.in[4]; const float* mod = (const float*)(F.ws + WS_MOD); unsigned char* h1 = (unsigned char*)(F.ws + WS_H1);
    const int lane = F.lane;
    for (int m0 = F.gw * 32; m0 < TOK; m0 += F.NGW * 32) {
        const int b = m0 >> 11; const float* sh = mod + (size_t)b * 6144; const float* sc = sh + 1024;
        f32x4 A[4], Bv[4];
#pragma unroll
        for (int j = 0; j < 4; ++j) { const int col = 4 * lane + 256 * j; A[j] = *(const f32x4*)(g + col) * (*(const f32x4*)(sc + col) + 1.f); Bv[j] = *(const f32x4*)(sh + col); }
        const f32x4* xr = (const f32x4*)(x + (size_t)m0 * DM) + lane; unsigned* o8 = (unsigned*)(h1 + (size_t)m0 * DM) + lane;
        f32x4 v0[4], v1[4];
#pragma unroll
        for (int j = 0; j < 4; ++j) { v0[j] = __builtin_nontemporal_load(xr + 64 * j); v1[j] = __builtin_nontemporal_load(xr + 256 + 64 * j); }
        for (int i = 0; i < 32; i += 2) {
            f32x4 n0[4], n1[4];
            if (i + 2 < 32) {
#pragma unroll
                for (int j = 0; j < 4; ++j) { n0[j] = __builtin_nontemporal_load(xr + (size_t)(i + 2) * 256 + 64 * j); n1[j] = __builtin_nontemporal_load(xr + (size_t)(i + 3) * 256 + 64 * j); }
            }
            float s0 = 0.f, s1 = 0.f;
#pragma unroll
            for (int j = 0; j < 4; ++j) { s0 += (v0[j][0] * v0[j][0] + v0[j][1] * v0[j][1]) + (v0[j][2] * v0[j][2] + v0[j][3] * v0[j][3]); s1 += (v1[j][0] * v1[j][0] + v1[j][1] * v1[j][1]) + (v1[j][2] * v1[j][2] + v1[j][3] * v1[j][3]); }
#pragma unroll
            for (int o = 1; o < 64; o <<= 1) { s0 += __shfl_xor(s0, o); s1 += __shfl_xor(s1, o); }
            const float r0 = rsqrtf(s0 * (1.f / DM) + EPS), r1 = rsqrtf(s1 * (1.f / DM) + EPS);
#pragma unroll
            for (int j = 0; j < 4; ++j) { const f32x4 y0 = v0[j] * r0 * A[j] + Bv[j], y1 = v1[j] * r1 * A[j] + Bv[j];
                o8[(size_t)i * 256 + 64 * j] = pk4_fp8(y0[0], y0[1], y0[2], y0[3]); o8[(size_t)(i + 1) * 256 + 64 * j] = pk4_fp8(y1[0], y1[1], y1[2], y1[3]); }
#pragma unroll
            for (int j = 0; j < 4; ++j) { v0[j] = n0[j]; v1[j] = n1[j]; }
        }
    }
}

DI void phase3(Frame& F) {
    const bf16_t* proj = (const bf16_t*)(F.ws + WS_PROJ);
    const float* ropeN = (const float*)(F.ws + WS_ROPE); const float* ropeD = ropeN + 2048 * 16;
    const float* g_nq = F.in[7]; const float* g_nk = F.in[8]; const float* g_dq = F.in[12]; const float* g_dk = F.in[13];
    const int lane = F.lane;
    for (int it = F.gw; it < TOK * 6; it += F.NGW) {
        const int m = it / 6, part = it % 6; const int b = m >> 11, t = m & 2047;
        const int c0 = part * 512 + lane * 8;
        const u32x4 raw = *(const u32x4*)(proj + (size_t)m * NPROJ + c0);
        float v[8]; v[0] = bflo(raw.x); v[1] = bfhi(raw.x); v[2] = bflo(raw.y); v[3] = bfhi(raw.y); v[4] = bflo(raw.z); v[5] = bfhi(raw.z); v[6] = bflo(raw.w); v[7] = bfhi(raw.w);
        float ss = 0.f;
#pragma unroll
        for (int i = 0; i < 8; ++i) ss += v[i] * v[i];
        ss += __shfl_xor(ss, 1); ss += __shfl_xor(ss, 2); const float ss32 = ss; ss += __shfl_xor(ss, 4); const float ss64 = ss;
        float pv[8];
#pragma unroll
        for (int i = 0; i < 8; ++i) pv[i] = __shfl_xor(v[i], 1);
        if (c0 < 1280) {
            const bool isq = c0 < 512; int six = 0, gsel = 0, d0;
            if (isq) { d0 = c0 & 63; } else { const int cc = c0 - 512; six = cc >> 7; gsel = (cc >> 6) & 1; d0 = cc & 63; }
            const bool donorm = isq || six == 2 || six == 4;
            float y[8];
            if (donorm) { const float* gg = isq ? g_nq : (g_nk + (six == 2 ? 64 : 128)); const float rstd = rsqrtf(ss64 * (1.f / 64.f) + EPS);
#pragma unroll
                for (int i = 0; i < 8; ++i) { y[i] = v[i] * rstd * gg[d0 + i]; pv[i] = pv[i] * rstd * gg[(d0 ^ 8) + i]; } }
            else {
#pragma unroll
                for (int i = 0; i < 8; ++i) y[i] = v[i]; }
            float yr[8];
#pragma unroll
            for (int i = 0; i < 8; ++i) yr[i] = y[i];
            if (donorm && d0 < 16) {
#pragma unroll
                for (int i = 0; i < 8; ++i) { const float cs = ropeN[(t * 8 + i) * 2], sn = ropeN[(t * 8 + i) * 2 + 1];
                    yr[i] = d0 == 0 ? (y[i] * cs - pv[i] * sn) : (pv[i] * sn + y[i] * cs); }
            }
            u32x4 w0, w1; w0.x = pk2(y[0], y[1]); w0.y = pk2(y[2], y[3]); w0.z = pk2(y[4], y[5]); w0.w = pk2(y[6], y[7]);
            w1.x = pk2(yr[0], yr[1]); w1.y = pk2(yr[2], yr[3]); w1.z = pk2(yr[4], yr[5]); w1.w = pk2(yr[6], yr[7]);
            if (isq) { const int hd = c0 >> 6; const size_t off = (((size_t)b * 8 + hd) * SEQ + t) * 64 + d0;
                *(u32x4*)((bf16_t*)(F.ws + WS_QN) + off) = w0; *(u32x4*)((bf16_t*)(F.ws + WS_QR) + off) = w1; }
            else { const size_t base = six == 0 ? WS_KC : six == 1 ? WS_VC : six == 2 ? WS_KS : six == 3 ? WS_VS : six == 4 ? WS_KW : WS_VW;
                const size_t off = (((size_t)b * 2 + gsel) * SEQ + t) * 64 + d0;
                *(u32x4*)((bf16_t*)(F.ws + base) + off) = donorm ? w1 : w0; }
        } else if (c0 < 2304) {
            const bool isq = c0 < 1792; const int cc = c0 - (isq ? 1280 : 1792); const int hd = cc >> 6, dd = cc & 63, d0 = dd & 31;
            const float* gg = isq ? g_dq : g_dk; const float rstd = rsqrtf(ss32 * (1.f / 32.f) + EPS);
            float y[8];
#pragma unroll
            for (int i = 0; i < 8; ++i) y[i] = v[i] * rstd * gg[d0 + i];
            if (d0 == 0) {
#pragma unroll
                for (int i = 0; i < 4; ++i) { const float cs = ropeD[(t * 4 + i) * 2], sn = ropeD[(t * 4 + i) * 2 + 1]; const float a = y[i], bb = y[i + 4]; y[i] = a * cs - bb * sn; y[i + 4] = a * sn + bb * cs; }
            }
            u32x4 w; w.x = pk2(y[0], y[1]); w.y = pk2(y[2], y[3]); w.z = pk2(y[4], y[5]); w.w = pk2(y[6], y[7]);
            const size_t off = (((size_t)b * 8 + hd) * SEQ + t) * 64 + dd;
            *(u32x4*)((bf16_t*)(F.ws + (isq ? WS_DQ : WS_DK)) + off) = w;
        } else if (c0 < 2816) {
            const int cc = c0 - 2304; const int hd = cc >> 6, dd = cc & 63; const size_t off = (((size_t)b * 8 + hd) * SEQ + t) * 64 + dd;
            *(u32x4*)((bf16_t*)(F.ws + WS_DV) + off) = raw;
        } else if (c0 < 2840) {
            float* gt = (float*)(F.ws + WS_GATES) + (size_t)m * 24 + (c0 - 2816);
#pragma unroll
            for (int i = 0; i < 8; ++i) gt[i] = 1.f / (1.f + __expf(-v[i]));
        }
    }
}

DI void glds16(const void* gsrc, unsigned lds_dst) { unsigned keep;
    asm volatile("s_mov_b32 %0, m0\n\ts_mov_b32 m0, %2\n\ts_nop 0\n\tglobal_load_lds_dwordx4 %1, off\n\ts_mov_b32 m0, %0" : "=&s"(keep) : "v"(gsrc), "s"(lds_dst) : "memory"); }
DI unsigned lds_addr(const LAS void* p) { return (unsigned)(uintptr_t)p; }
struct ALane { int k0; int v0; DI int ko(int ks) const { return k0 ^ (ks << 5); } DI int vo(int db) const { return v0 ^ (db << 6); } };
DI ALane alane_init(int lane) {
    ALane L; const int r = lane & 31, hh = lane >> 5, g = lane >> 4, i = lane & 15;
    L.k0 = r * 128 + ((hh ^ ((r >> 1) & 7)) << 4);
    const int rl = 4 * hh + (i >> 2); const int ch = 2 * (g & 1) + ((i & 3) >> 1);
    L.v0 = rl * 128 + ((ch ^ (((rl >> 1) & 1) << 2)) << 4) + 8 * (i & 1);
    return L;
}
DI s16x4 vtr(const LAS char* p) { typedef short v4i16 __attribute__((ext_vector_type(4))); return __builtin_bit_cast(s16x4, __builtin_amdgcn_ds_read_tr16_b64_v4i16((LAS v4i16*)p)); }
DI bf16x8 vfrag(const LAS char* Vt, const ALane& L, int db, int kb, int s) {
    const LAS char* p = Vt + L.vo(db) + (32 * kb + 16 * s) * 128;
    const s16x4 lo = vtr(p), hi = vtr(p + 8 * 128);
    return __builtin_shufflevector(lo, hi, 0, 1, 2, 3, 4, 5, 6, 7);
}
DI bf16x8 pfrag(const f32x16& p, int s) { u32x4 w; w.x = pk2(p[8 * s + 0], p[8 * s + 1]); w.y = pk2(p[8 * s + 2], p[8 * s + 3]); w.z = pk2(p[8 * s + 4], p[8 * s + 5]); w.w = pk2(p[8 * s + 6], p[8 * s + 7]); return __builtin_bit_cast(bf16x8, w); }
DI u32x4 tile_ld(const bf16_t* g, int tid) { return *(const u32x4*)(g + tid * 8); }
DI void tile_st_k(LAS char* Kt, u32x4 v, int tid) { const int row = tid >> 3, ch = tid & 7; *(LAS u32x4*)(Kt + row * 128 + ((ch ^ ((row >> 1) & 7)) << 4)) = v; }
DI void tile_st_v(LAS char* Vt, u32x4 v, int tid) { const int row = tid >> 3, ch = tid & 7; *(LAS u32x4*)(Vt + row * 128 + ((ch ^ (((row >> 1) & 1) << 2)) << 4)) = v; }

constexpr int MK_NONE = 0, MK_LE = 1, MK_GT = 2;
template <int MASK>
DI void sm16(f32x16& a, float c2, float mcl, int kb, int hh, int th) {
    if constexpr (MASK != MK_NONE) asm volatile("" : "+v"(th));
#pragma unroll
    for (int i = 0; i < 16; ++i) {
        float x = __builtin_fmaf(a[i], c2, -mcl);
        if constexpr (MASK != MK_NONE) { const int kl = 32 * kb + crow(i, hh); const bool ok = MASK == MK_LE ? (kl <= th) : (kl > th); x = ok ? x : -1.0e30f; }
        a[i] = fast_exp2(x);
    }
}
DI float sum16(const f32x16& a) { return ((a[0] + a[1]) + (a[2] + a[3])) + ((a[4] + a[5]) + (a[6] + a[7])) + ((a[8] + a[9]) + (a[10] + a[11])) + ((a[12] + a[13]) + (a[14] + a[15])); }
#define SCHED_FENCE() do { } while (0)
template <int MASK, bool KEEPP>
DI void attn_tile64(const LAS char* Kt, const LAS char* Vt, const ALane& L, const bf16x8 (&qf)[4], f32x16 (&O)[2], float& lsum, float c2, float mcl, int th, int hh, f32x16 (&P)[2]) {
    bf16x8 kf[2][4];
#pragma unroll
    for (int kb = 0; kb < 2; ++kb)
#pragma unroll
        for (int ks = 0; ks < 4; ++ks) kf[kb][ks] = *(const LAS bf16x8*)(Kt + L.ko(ks) + kb * 4096);
    SCHED_FENCE();
    f32x16 a0 = {0.f, 0.f, 0.f, 0.f, 0.f, 0.f, 0.f, 0.f, 0.f, 0.f, 0.f, 0.f, 0.f, 0.f, 0.f, 0.f}, a1 = a0;
#pragma unroll
    for (int ks = 0; ks < 4; ++ks) a0 = MFMA32(kf[0][ks], qf[ks], a0);
#pragma unroll
    for (int ks = 0; ks < 4; ++ks) a1 = MFMA32(kf[1][ks], qf[ks], a1);
    bf16x8 v0[2][2], v1[2][2];
#pragma unroll
    for (int s = 0; s < 2; ++s)
#pragma unroll
        for (int db = 0; db < 2; ++db) v0[s][db] = vfrag(Vt, L, db, 0, s);
    SCHED_FENCE();
    bf16x8 pf[2][2];
    sm16<MASK>(a0, c2, mcl, 0, hh, th); lsum += sum16(a0); pf[0][0] = pfrag(a0, 0); pf[0][1] = pfrag(a0, 1);
    if constexpr (KEEPP) P[0] = a0;
#pragma unroll
    for (int s = 0; s < 2; ++s)
#pragma unroll
        for (int db = 0; db < 2; ++db) v1[s][db] = vfrag(Vt, L, db, 1, s);
    SCHED_FENCE();
    sm16<MASK>(a1, c2, mcl, 1, hh, th); lsum += sum16(a1); pf[1][0] = pfrag(a1, 0); pf[1][1] = pfrag(a1, 1);
    if constexpr (KEEPP) P[1] = a1;
    SCHED_FENCE();
#pragma unroll
    for (int s = 0; s < 2; ++s)
#pragma unroll
        for (int db = 0; db < 2; ++db) O[db] = MFMA32(v0[s][db], pf[0][s], O[db]);
#pragma unroll
    for (int s = 0; s < 2; ++s)
#pragma unroll
        for (int db = 0; db < 2; ++db) O[db] = MFMA32(v1[s][db], pf[1][s], O[db]);
    SCHED_FENCE();
}
template <int MASK>
DI void attn_tile_dm(const LAS char* Kt, const LAS char* Vt, const ALane& L, int ko0, int ko1, const bf16x8 (&qf)[2], f32x16 (&O)[2], float& lsum, float c2, float mc, int th, int hh) {
    const bf16x8 k00 = *(const LAS bf16x8*)(Kt + ko0), k01 = *(const LAS bf16x8*)(Kt + ko1), k10 = *(const LAS bf16x8*)(Kt + ko0 + 4096), k11 = *(const LAS bf16x8*)(Kt + ko1 + 4096);
    SCHED_FENCE();
    f32x16 a0 = {0.f, 0.f, 0.f, 0.f, 0.f, 0.f, 0.f, 0.f, 0.f, 0.f, 0.f, 0.f, 0.f, 0.f, 0.f, 0.f}, a1 = a0;
    a0 = MFMA32(k00, qf[0], a0); a0 = MFMA32(k01, qf[1], a0); a1 = MFMA32(k10, qf[0], a1); a1 = MFMA32(k11, qf[1], a1);
    bf16x8 vf[2][2][2];
#pragma unroll
    for (int kb = 0; kb < 2; ++kb)
#pragma unroll
        for (int s = 0; s < 2; ++s)
#pragma unroll
            for (int db = 0; db < 2; ++db) vf[kb][s][db] = vfrag(Vt, L, db, kb, s);
    SCHED_FENCE();
    bf16x8 pf[2][2];
    sm16<MASK>(a0, c2, mc, 0, hh, th); lsum += sum16(a0); pf[0][0] = pfrag(a0, 0); pf[0][1] = pfrag(a0, 1);
    sm16<MASK>(a1, c2, mc, 1, hh, th); lsum += sum16(a1); pf[1][0] = pfrag(a1, 0); pf[1][1] = pfrag(a1, 1);
    SCHED_FENCE();
#pragma unroll
    for (int kb = 0; kb < 2; ++kb)
#pragma unroll
        for (int s = 0; s < 2; ++s)
#pragma unroll
            for (int db = 0; db < 2; ++db) O[db] = MFMA32(vf[kb][s][db], pf[kb][s], O[db]);
    SCHED_FENCE();
}
#define RING_WAIT(n) asm volatile("s_waitcnt vmcnt(" #n ")" ::: "memory")
template <class PreF, class CompF>
DI void attn_ring(LAS char* lds, const bf16_t* Kg, const bf16_t* Vg, unsigned tiles, int wid, int lane, PreF pre, CompF comp) {
    if (tiles == 0u) return;
    const int p = wid * 64 + lane, row = p >> 3, c = p & 7;
    const unsigned ksrc = (unsigned)(row * 128 + ((c ^ ((row >> 1) & 7)) << 4)), vsrc = (unsigned)(row * 128 + ((c ^ (((row >> 1) & 1) << 2)) << 4));
    LAS char* wb = lds + wid * 1024;
#define RING_ISSUE(j, slot) do { \
        glds16((const char*)(Kg) + (size_t)(j) * 8192 + ksrc, (unsigned)__builtin_amdgcn_readfirstlane((int)(lds_addr(wb) + (unsigned)(slot) * 16384u))); \
        glds16((const char*)(Vg) + (size_t)(j) * 8192 + vsrc, (unsigned)__builtin_amdgcn_readfirstlane((int)(lds_addr(wb) + (unsigned)(slot) * 16384u + 8192u))); } while (0)
    int q0 = __builtin_ctz(tiles); tiles &= tiles - 1u;
    int q1 = -1, q2 = -1;
    if (tiles) { q1 = __builtin_ctz(tiles); tiles &= tiles - 1u; }
    if (tiles) { q2 = __builtin_ctz(tiles); tiles &= tiles - 1u; }
    RING_ISSUE(q0, 0);
    if (q1 >= 0) RING_ISSUE(q1, 1);
    if (q2 >= 0) RING_ISSUE(q2, 2);
    pre();
    int i = 0;
    for (;;) {
        if (q2 >= 0) RING_WAIT(4); else if (q1 >= 0) RING_WAIT(2); else RING_WAIT(0);
        __builtin_amdgcn_s_barrier();
        int q3 = -1;
        if (tiles) { q3 = __builtin_ctz(tiles); tiles &= tiles - 1u; RING_ISSUE(q3, (i + 3) & 3); }
        LAS char* st = lds + (i & 3) * 16384;
        comp(q0, st, st + 8192);
        if (q1 < 0) break;
        q0 = q1; q1 = q2; q2 = q3; ++i;
    }
    asm volatile("s_waitcnt lgkmcnt(0)" ::: "memory");
    __builtin_amdgcn_s_barrier();
#undef RING_ISSUE
}

DI void diff_unit(Frame& F, int b, int hd, int qb, float c2, float mc, float lam) {
    const int tid = F.tid, lane = F.lane, wid = F.wave, r = lane & 31, hh = lane >> 5;
    const int rb = wid >> 1, mp = wid & 1;
    const bf16_t* Q = (const bf16_t*)(F.ws + WS_DQ) + ((size_t)b * 8 + hd) * SEQ * 64;
    const bf16_t* Kg = (const bf16_t*)(F.ws + WS_DK) + ((size_t)b * 8 + hd) * SEQ * 64;
    const bf16_t* Vg = (const bf16_t*)(F.ws + WS_DV) + ((size_t)b * 8 + hd) * SEQ * 64;
    LAS char* lds = (LAS char*)F.lds;
    const ALane L = alane_init(lane);
    const int ko0 = L.ko(2 * mp), ko1 = L.ko(2 * mp + 1);
    const int q0w = qb * 128 + rb * 32; const int qq = q0w + r;
    bf16x8 qf[2];
#pragma unroll
    for (int ks = 0; ks < 2; ++ks) qf[ks] = *(const bf16x8*)(Q + (size_t)qq * 64 + mp * 32 + ks * 16 + hh * 8);
    f32x16 O[2]; float lsum = 0.f;
#pragma unroll
    for (int i = 0; i < 16; ++i) { O[0][i] = 0.f; O[1][i] = 0.f; }
    const int ntile = 2 * qb + 2; const int jmax = 2 * qb + (rb >> 1);
    const unsigned tiles = ntile == 32 ? 0xffffffffu : ((1u << ntile) - 1u);
    attn_ring(lds, Kg, Vg, tiles, wid, lane, [&]() __attribute__((always_inline)) { asm volatile("" : "+v"(qf[0]), "+v"(qf[1])); },
        [&](int j, const LAS char* Kt, const LAS char* Vt) __attribute__((always_inline)) {
        if (j < jmax) attn_tile_dm<MK_NONE>(Kt, Vt, L, ko0, ko1, qf, O, lsum, c2, mc, 0, hh);
        else if (j == jmax) attn_tile_dm<MK_LE>(Kt, Vt, L, ko0, ko1, qf, O, lsum, c2, mc, qq - 64 * j, hh);
    });
    lsum += __shfl_xor(lsum, 32);
    LAS float* xo = (LAS float*)(lds + 65536 + rb * 8192) + lane;
    if (mp == 1) { const float s1 = lam / lsum;
#pragma unroll
        for (int db = 0; db < 2; ++db)
#pragma unroll
            for (int i = 0; i < 16; ++i) xo[(db * 16 + i) * 64] = O[db][i] * s1; }
    __syncthreads();
    if (mp == 0) {
        const float i0 = 1.f / lsum; float ss = 0.f;
#pragma unroll
        for (int db = 0; db < 2; ++db)
#pragma unroll
            for (int i = 0; i < 16; ++i) { const float o = O[db][i] * i0 - xo[(db * 16 + i) * 64]; O[db][i] = o; ss += o * o; }
        ss += __shfl_xor(ss, 32);
        const float rstd = rsqrtf(ss * (1.f / 64.f) + EPS) * 0.8f;
        const float* go = F.in[18];
        bf16_t* orow = (bf16_t*)(F.ws + WS_AO) + ((size_t)b * SEQ + qq) * DM + 512 + hd * 64;
#pragma unroll
        for (int db = 0; db < 2; ++db)
#pragma unroll
            for (int g4 = 0; g4 < 4; ++g4) { const int d = 32 * db + 8 * g4 + 4 * hh; const f32x4 gv = *(const f32x4*)(go + d);
                u32x2 w; w.x = pk2(O[db][4 * g4] * rstd * gv[0], O[db][4 * g4 + 1] * rstd * gv[1]); w.y = pk2(O[db][4 * g4 + 2] * rstd * gv[2], O[db][4 * g4 + 3] * rstd * gv[3]);
                *(u32x2*)(orow + d) = w; }
    }
}

#define NSA_BAR() do { asm volatile("s_waitcnt lgkmcnt(0)" ::: "memory"); __builtin_amdgcn_s_barrier(); asm volatile("" ::: "memory"); } while (0)
DI void nsa_unit(Frame& F, int b, int g, int qb, float c2, float mc) {
    const int lane = F.lane, wid = F.wave, r = lane & 31, hh = lane >> 5;
    const int hd = 4 * g + (wid >> 1); const int tl = 32 * (wid & 1) + r; const int t = 64 * qb + tl;
    LAS char* lds = (LAS char*)F.lds;
    LAS float* impP = (LAS float*)(lds + 65536);
    LAS unsigned* selm = (LAS unsigned*)(lds + LDS_MISC + 5120);
    LAS float* invs = (LAS float*)(selm + 128);
    LAS float* otp = (LAS float*)(lds + 65536 + wid * 8192) + lane;
    LAS float* gpark = (LAS float*)(lds + LDS_MISC + 8192 + wid * 768) + lane;
    const ALane L = alane_init(lane);
    const size_t bg = (size_t)b * 2 + g;
    bf16x8 qf[4];
    { const bf16_t* QN = (const bf16_t*)(F.ws + WS_QN) + (((size_t)b * 8 + hd) * SEQ + t) * 64;
#pragma unroll
      for (int ks = 0; ks < 4; ++ks) qf[ks] = *(const bf16x8*)(QN + ks * 16 + hh * 8);
      const float* gates = (const float*)(F.ws + WS_GATES) + ((size_t)b * SEQ + t) * 24 + hd * 3;
      const float g0_ = gates[0], g1_ = gates[1], g2_ = gates[2]; gpark[0] = g0_; gpark[64] = g1_; gpark[128] = g2_; }
    const char* KcB = (const char*)(F.ws + WS_KCMP) + bg * 16384; const char* VcB = (const char*)(F.ws + WS_VCMP) + bg * 16384;
    const char* KsB = (const char*)(F.ws + WS_KS) + bg * (SEQ * 128); const char* VsB = (const char*)(F.ws + WS_VS) + bg * (SEQ * 128);
    const char* KwB = (const char*)(F.ws + WS_KW) + bg * (SEQ * 128); const char* VwB = (const char*)(F.ws + WS_VW) + bg * (SEQ * 128);
    const int nf = qb == 0 ? 1 : (qb == 1 ? 2 : 3); const int f1 = qb == 1 ? 1 : qb - 1, f2 = qb;
    const unsigned fmask = 1u | (qb >= 1 ? (1u << qb) : 0u) | (qb >= 2 ? (1u << (qb - 1)) : 0u);
    const unsigned allb = qb == 31 ? 0xffffffffu : ((1u << (qb + 1)) - 1u);
    unsigned grest = qb <= 5 ? (allb & ~fmask) : 0u;
    const int jlo = qb >= 4 ? qb - 4 : 0;
    int gph = 0, gi = 0;
    const int p_ = wid * 64 + lane, prow = p_ >> 3, pc = p_ & 7;
    const unsigned ksrc = (unsigned)(prow * 128 + ((pc ^ ((prow >> 1) & 7)) << 4)), vsrc = (unsigned)(prow * 128 + ((pc ^ (((prow >> 1) & 1) << 2)) << 4));
    const unsigned wbase = lds_addr(lds) + (unsigned)wid * 1024u;
#define NSA_GEN(ty, jj) do { ty = -1; jj = 0; \
        if (gph == 0) { ty = 0; jj = gi; if (++gi == 2) { gph = 1; gi = 0; } } \
        else if (gph == 1) { ty = 1; jj = gi == 0 ? 0 : (gi == 1 ? f1 : f2); if (++gi == nf) gph = 2; } \
        else { if (gph == 2) { if (grest) { ty = 1; jj = __builtin_ctz(grest); grest &= grest - 1u; } else { gph = 3; gi = jlo; } } \
               if (gph == 3) { if (gi <= qb) { ty = 2; jj = gi++; } else gph = 4; } } } while (0)
#define NSA_ISSUE(ty, jj, slot) do { const char* kp_ = ty == 0 ? KcB : (ty == 1 ? KsB : KwB); const char* vp_ = ty == 0 ? VcB : (ty == 1 ? VsB : VwB); \
        glds16(kp_ + (size_t)(jj) * 8192 + ksrc, (unsigned)__builtin_amdgcn_readfirstlane((int)(wbase + (unsigned)(slot) * 16384u))); \
        glds16(vp_ + (size_t)(jj) * 8192 + vsrc, (unsigned)__builtin_amdgcn_readfirstlane((int)(wbase + (unsigned)(slot) * 16384u + 8192u))); } while (0)
    int t0, j0, t1, j1, t2, j2;
    NSA_GEN(t0, j0); NSA_GEN(t1, j1); NSA_GEN(t2, j2);
    NSA_ISSUE(t0, j0, 0); NSA_ISSUE(t1, j1, 1); if (t2 >= 0) NSA_ISSUE(t2, j2, 2);
#pragma unroll
    for (int ks = 0; ks < 4; ++ks) asm volatile("" : "+v"(qf[ks]));
    f32x16 O[2]; float lv = 0.f; float carry_in = 0.f; unsigned mym = 0u; bool inB = false;
#pragma unroll
    for (int i = 0; i < 16; ++i) { O[0][i] = 0.f; O[1][i] = 0.f; }
    const int nvalid = t >= 31 ? ((t - 31) >> 4) + 1 : 0;
    for (int n = 0;; ++n) {
        if (t2 >= 0) RING_WAIT(4); else if (t1 >= 0) RING_WAIT(2); else RING_WAIT(0);
        __builtin_amdgcn_s_barrier();
        int t3, j3;
        NSA_GEN(t3, j3);
        if (t3 >= 0) NSA_ISSUE(t3, j3, (n + 3) & 3);
        const LAS char* Kt = lds + (n & 3) * 16384; const LAS char* Vt = Kt + 8192;
        int mode = MK_LE, th = tl; float mcl = mc;
        if (t0 == 0) { th = nvalid - 1 - 64 * j0; }
        else if (t0 == 1) { mcl = ((mym >> j0) & 1u) ? mc : 1.0e30f; mode = j0 < qb ? MK_NONE : MK_LE; }
        else {
            if (inB) {
                float lsum = lv; lsum += __shfl_xor(lsum, 32); const float s1 = gpark[64] / lsum;
#pragma unroll
                for (int db = 0; db < 2; ++db)
#pragma unroll
                    for (int i = 0; i < 16; ++i) { otp[(db * 16 + i) * 64] += O[db][i] * s1; O[db][i] = 0.f; }
                lv = 0.f; inB = false;
            }
            mode = j0 == qb ? MK_LE : (j0 == qb - 4 ? MK_GT : MK_NONE);
        }
        if (t0 != 0) {
            f32x16 Pd[2];
            if (mode == MK_NONE) attn_tile64<MK_NONE, false>(Kt, Vt, L, qf, O, lv, c2, mcl, 0, hh, Pd);
            else if (mode == MK_LE) attn_tile64<MK_LE, false>(Kt, Vt, L, qf, O, lv, c2, mcl, th, hh, Pd);
            else attn_tile64<MK_GT, false>(Kt, Vt, L, qf, O, lv, c2, mcl, th, hh, Pd);
        } else {
            f32x16 P[2];
            attn_tile64<MK_LE, true>(Kt, Vt, L, qf, O, lv, c2, mcl, th, hh, P);
            LAS float* ip = impP + ((wid >> 1) * 64 + tl) * 33;
            float av[8], rc[8];
#pragma unroll
            for (int kb = 0; kb < 2; ++kb)
#pragma unroll
                for (int gq = 0; gq < 4; ++gq) { const int f = 4 * kb + gq; const float p3 = 0.5f * P[kb][4 * gq + 3]; av[f] = P[kb][4 * gq] + P[kb][4 * gq + 1] + P[kb][4 * gq + 2] + p3; rc[f] = __shfl_xor(p3, 32); }
#pragma unroll
            for (int f = 0; f < 8; ++f) { const float carry = hh == 1 ? rc[f] : (f > 0 ? rc[f > 0 ? f - 1 : 0] : carry_in); ip[2 * (8 * j0 + f) + hh] = av[f] + carry; }
            carry_in = rc[7];
            if (j0 == 1) {
                {
                    const bf16_t* QR = (const bf16_t*)(F.ws + WS_QR) + (((size_t)b * 8 + hd) * SEQ + t) * 64;
#pragma unroll
                    for (int ks = 0; ks < 4; ++ks) qf[ks] = *(const bf16x8*)(QR + ks * 16 + hh * 8); }
                float lsum = lv; lsum += __shfl_xor(lsum, 32);
                const float inv = lsum > 0.f ? 1.f / lsum : 0.f;
                if (hh == 0) invs[(wid >> 1) * 64 + tl] = inv;
                const float s0 = gpark[0] * inv;
                lv = 0.f;
                NSA_BAR();
                if (wid == 0) {
                    unsigned m;
                    if (qb <= 5) m = allb;
                    else {
                        m = fmask;
                        float best[3] = {-1.f, -1.f, -1.f}; int bi[3] = {0, 0, 0}; const float iv0 = invs[lane], iv1 = invs[64 + lane], iv2 = invs[128 + lane], iv3 = invs[192 + lane];
                        for (int j = 1; j <= qb - 2; ++j) {
                            const float v = (impP[(0 * 64 + lane) * 33 + j] * iv0 + impP[(1 * 64 + lane) * 33 + j] * iv1) + (impP[(2 * 64 + lane) * 33 + j] * iv2 + impP[(3 * 64 + lane) * 33 + j] * iv3);
                            if (v > best[0]) { best[2] = best[1]; bi[2] = bi[1]; best[1] = best[0]; bi[1] = bi[0]; best[0] = v; bi[0] = j; }
                            else if (v > best[1]) { best[2] = best[1]; bi[2] = bi[1]; best[1] = v; bi[1] = j; }
                            else if (v > best[2]) { best[2] = v; bi[2] = j; }
                        }
                        m |= (1u << bi[0]) | (1u << bi[1]) | (1u << bi[2]);
                    }
                    selm[lane] = m;
                    unsigned u = m;
#pragma unroll
                    for (int o = 1; o < 64; o <<= 1) u |= (unsigned)__shfl_xor((int)u, o);
                    if (lane == 0) selm[64] = u;
                }
                NSA_BAR();
                mym = selm[tl];
                if (qb > 5) grest = (unsigned)__builtin_amdgcn_readfirstlane((int)selm[64]) & ~fmask;
#pragma unroll
                for (int db = 0; db < 2; ++db)
#pragma unroll
                    for (int i = 0; i < 16; ++i) { otp[(db * 16 + i) * 64] = O[db][i] * s0; O[db][i] = 0.f; }
                inB = true;
#pragma unroll
                for (int ks = 0; ks < 4; ++ks) asm volatile("" : "+v"(qf[ks]));
            }
        }
        if (t1 < 0) break;
        t0 = t1; j0 = j1; t1 = t2; j1 = j2; t2 = t3; j2 = j3;
    }
    {
        float lsum = lv; lsum += __shfl_xor(lsum, 32); const float s2 = gpark[128] / lsum;
#pragma unroll
        for (int db = 0; db < 2; ++db)
#pragma unroll
            for (int i = 0; i < 16; ++i) O[db][i] = otp[(db * 16 + i) * 64] + O[db][i] * s2;
    }
    bf16_t* orow = (bf16_t*)(F.ws + WS_AO) + ((size_t)b * SEQ + t) * DM + hd * 64;
#pragma unroll
    for (int db = 0; db < 2; ++db)
#pragma unroll
        for (int g4 = 0; g4 < 4; ++g4) { const int d = 32 * db + 8 * g4 + 4 * hh;
            u32x2 w; w.x = pk2(O[db][4 * g4], O[db][4 * g4 + 1]); w.y = pk2(O[db][4 * g4 + 2], O[db][4 * g4 + 3]);
            *(u32x2*)(orow + d) = w; }
    NSA_BAR();
#undef NSA_GEN
#undef NSA_ISSUE
}

DI float gmax(const float* g, int n, int lane) { float v = lane < n ? fabsf(g[lane]) : 0.f;
#pragma unroll
    for (int o = 1; o < 64; o <<= 1) v = fmaxf(v, __shfl_xor(v, o));
    return v; }

DI int queue_next(Frame& F, unsigned* ctr) {
    LAS int* slot = (LAS int*)(F.lds + LDS_MISC + 4096);
    __syncthreads();
    if (F.tid == 0) *slot = (int)atomicAdd(ctr, 1u);
    __syncthreads();
    return *slot;
}

DI int queue_pass(Frame& F, unsigned nx) {
    LAS int* slot = (LAS int*)(F.lds + LDS_MISC + 4096);
    __syncthreads();
    if (F.tid == 0) *slot = (int)nx;
    __syncthreads();
    return *slot;
}

DI float gelu_tanh(float x) { const float u = 0.7978845608028654f * (x + 0.044715f * x * x * x); const float e = __expf(2.f * u); const float th = 1.f - 2.f / (e + 1.f); return 0.5f * x * (1.f + th); }
DI void phase5(Frame& F) {
    const bf16_t* UL = (const bf16_t*)(F.ws + WS_UL); const float* w2 = F.in[11]; const float* gk0 = F.in[8];
    LAS float* w2s = (LAS float*)F.lds;
    LAS float* hid = (LAS float*)(F.lds + LDS_MISC + 8192 + F.wave * 1024);
    for (int i = F.tid; i < 2 * 256 * 64 / 4; i += NTHREADS) ((LAS f32x4*)w2s)[i] = ((const f32x4*)w2)[i];
    __syncthreads();
    const int lane = F.lane;
    for (int it = F.gw; it < 2 * 64 * 128; it += F.NGW) {
        const int kv = it >> 13, rem = it & 8191, bgi = rem >> 7, c = rem & 127;
        bf16_t* dst = (bf16_t*)(F.ws + (kv ? WS_VCMP : WS_KCMP)) + ((size_t)bgi * 128 + c) * 64;
        if (c == 127) { dst[lane] = 0; continue; }
        const size_t row = (size_t)kv * 8192 + (size_t)bgi * 128 + c;
        const size_t perow = 16384 + (size_t)kv * 256 + (size_t)kv * 2;
        const u32x2 u4 = *(const u32x2*)(UL + row * 512 + 4 * lane), l4 = *(const u32x2*)(UL + (row + 1) * 512 + 256 + 4 * lane);
        const u32x2 pu = *(const u32x2*)(UL + perow * 512 + 4 * lane), pl = *(const u32x2*)(UL + (perow + 1) * 512 + 256 + 4 * lane);
        float h[4];
        h[0] = bflo(u4.x) + bflo(l4.x) + bflo(pu.x) + bflo(pl.x); h[1] = bfhi(u4.x) + bfhi(l4.x) + bfhi(pu.x) + bfhi(pl.x);
        h[2] = bflo(u4.y) + bflo(l4.y) + bflo(pu.y) + bflo(pl.y); h[3] = bfhi(u4.y) + bfhi(l4.y) + bfhi(pu.y) + bfhi(pl.y);
        f32x4 hv;
#pragma unroll
        for (int i = 0; i < 4; ++i) hv[i] = gelu_tanh(h[i]);
        *(LAS f32x4*)(hid + 4 * lane) = hv;
        asm volatile("s_waitcnt lgkmcnt(0)" ::: "memory");
        const LAS float* w = w2s + kv * 256 * 64 + lane; float acc0 = 0.f, acc1 = 0.f;
#pragma unroll 8
        for (int k = 0; k < 256; k += 4) { const f32x4 hh4 = *(const LAS f32x4*)(hid + k);
            acc0 += hh4[0] * w[(k + 0) * 64]; acc1 += hh4[1] * w[(k + 1) * 64]; acc0 += hh4[2] * w[(k + 2) * 64]; acc1 += hh4[3] * w[(k + 3) * 64]; }
        float acc = acc0 + acc1;
        if (kv == 0) { const float ss = wave_sum(acc * acc); acc = acc * rsqrtf(ss * (1.f / 64.f) + EPS) * gk0[lane]; }
        dst[lane] = f2bf(acc);
        asm volatile("s_waitcnt lgkmcnt(0)" ::: "memory");
    }
    __syncthreads();
}

DI void phase8(Frame& F) {
    const bf16_t* x1 = (const bf16_t*)(F.ws + WS_X1B); const float* gf = F.in[5]; const float* mod = (const float*)(F.ws + WS_MOD); const float* rowss = (const float*)(F.ws + WS_ROWSS);
    const char* wsrc = (const char*)(F.ws + WS_WR);
    unsigned char* h2 = (unsigned char*)(F.ws + WS_H2);
    unsigned* cnt = (unsigned*)(F.ws + WS_CTL) + CW_CNT; int* lists = (int*)(F.ws + WS_LIST);
    int* tipos = (int*)(F.ws + WS_TIPOS); int* tie = (int*)(F.ws + WS_TIE); float* tiw = (float*)(F.ws + WS_TIW);
    const float* brg = F.in[21]; const float* bre = F.in[23];
    const int lane = F.lane, wid = F.wave, row = lane & 15, kq = lane >> 4;
    LAS char* wl = (LAS char*)F.lds;
    LAS float* lg = (LAS float*)(F.lds + 98304 + wid * 3072);
    LAS float* A2 = (LAS float*)(F.lds + 122880);
    LAS float* B2 = A2 + 1024;
    LAS unsigned* hist = (LAS unsigned*)(F.lds + LDS_MISC + 8192);
    unsigned wso[6];
#pragma unroll
    for (int i = 0; i < 6; ++i) { const int s = i * 512 + F.tid, part = s / 1536, r = (s >> 5) % 48, cs = s & 31; wso[i] = (unsigned)(part * 98304 + r * 2048 + ((cs ^ (r & 15)) << 4)); }
#define P8_ISSUE(kc, buf) do { _Pragma("unroll") for (int i_ = 0; i_ < 6; ++i_) \
        __builtin_amdgcn_global_load_lds((const unsigned*)(wsrc + (size_t)(kc) * 512 + wso[i_]), (LAS unsigned*)(wl + (buf) * 49152 + i_ * 8192 + wid * 1024), 16, 0, 0); } while (0)
    const int nbatch = TOK / 128;
    for (int bt = F.bid; bt < nbatch; bt += F.G) {
        const int m0 = bt * 128 + wid * 16; const int m = m0 + row; const int b = m0 >> 11;
        P8_ISSUE(0, 0);
        { const float* sh = mod + (size_t)b * 6144 + 3072; const float* sc = sh + 1024;
          for (int k = F.tid; k < 1024; k += NTHREADS) { A2[k] = gf[k] * (sc[k] + 1.f); B2[k] = sh[k]; } }
        if (F.tid < 64) hist[F.tid] = 0u;
        float rs = 0.f; { const f32x4* rp = (const f32x4*)(rowss + (size_t)m * 16);
#pragma unroll
            for (int q = 0; q < 4; ++q) { const f32x4 v = rp[q]; rs += (v[0] + v[1]) + (v[2] + v[3]); } }
        const float rstd = rsqrtf(rs * (1.f / DM) + EPS);
        const bf16_t* xrow = x1 + (size_t)m * DM + 8 * kq; unsigned char* hrow = h2 + (size_t)m * DM + 8 * kq;
        u32x4 xw[4];
#pragma unroll
        for (int u = 0; u < 4; ++u) xw[u] = *(const u32x4*)(xrow + 32 * u);
        f32x4 acc[3] = {{0.f, 0.f, 0.f, 0.f}, {0.f, 0.f, 0.f, 0.f}, {0.f, 0.f, 0.f, 0.f}};
        for (int kc = 0; kc < 4; ++kc) {
            asm volatile("s_waitcnt vmcnt(0)" ::: "memory");
            __syncthreads();
            if (kc + 1 < 4) P8_ISSUE(kc + 1, (kc + 1) & 1);
            const LAS char* wb = wl + (kc & 1) * 49152;
#pragma unroll 1
            for (int g4 = 0; g4 < 2; ++g4) {
                const int gg = kc * 2 + g4;
                u32x4 nw[4];
                if (gg + 1 < 8) {
#pragma unroll
                    for (int u = 0; u < 4; ++u) nw[u] = *(const u32x4*)(xrow + 128 * (gg + 1) + 32 * u);
                }
#pragma unroll
                for (int u = 0; u < 4; ++u) {
                    const int k0 = 128 * gg + 32 * u + 8 * kq;
                    const f32x4 a0 = *(const LAS f32x4*)(A2 + k0), a1 = *(const LAS f32x4*)(A2 + k0 + 4), b0 = *(const LAS f32x4*)(B2 + k0), b1 = *(const LAS f32x4*)(B2 + k0 + 4);
                    const f32x4 xa_ = {bflo(xw[u].x), bfhi(xw[u].x), bflo(xw[u].y), bfhi(xw[u].y)}, xb_ = {bflo(xw[u].z), bfhi(xw[u].z), bflo(xw[u].w), bfhi(xw[u].w)};
                    const f32x4 ya = xa_ * rstd * a0 + b0, yb = xb_ * rstd * a1 + b1;
                    u32x4 hi; hi.x = pk2(ya[0], ya[1]); hi.y = pk2(ya[2], ya[3]); hi.z = pk2(yb[0], yb[1]); hi.w = pk2(yb[2], yb[3]);
                    { u32x2 h8; h8.x = pk4_fp8(ya[0], ya[1], ya[2], ya[3]); h8.y = pk4_fp8(yb[0], yb[1], yb[2], yb[3]); *(u32x2*)(hrow + 128 * gg + 32 * u) = h8; }
                    u32x4 lo; lo.x = pk2(ya[0] - bflo(hi.x), ya[1] - bfhi(hi.x)); lo.y = pk2(ya[2] - bflo(hi.y), ya[3] - bfhi(hi.y)); lo.z = pk2(yb[0] - bflo(hi.z), yb[1] - bfhi(hi.z)); lo.w = pk2(yb[2] - bflo(hi.w), yb[3] - bfhi(hi.w));
                    const bf16x8 ahi = __builtin_bit_cast(bf16x8, hi), alo = __builtin_bit_cast(bf16x8, lo);
                    const int ch = (g4 * 4 + u) * 4 + kq;
#pragma unroll
                    for (int ct = 0; ct < 3; ++ct) { const int r = 16 * ct + row; const int off = r * 512 + ((ch ^ row) << 4);
                        const bf16x8 bh = *(const LAS bf16x8*)(wb + off), bl = *(const LAS bf16x8*)(wb + 24576 + off);
                        acc[ct] = MFMA16(ahi, bh, acc[ct]); acc[ct] = MFMA16(alo, bh, acc[ct]); acc[ct] = MFMA16(ahi, bl, acc[ct]); }
                }
#pragma unroll
                for (int u = 0; u < 4; ++u) xw[u] = nw[u];
            }
        }
#pragma unroll
        for (int ct = 0; ct < 3; ++ct)
#pragma unroll
            for (int i = 0; i < 4; ++i) lg[(kq * 4 + i) * 48 + 16 * ct + row] = acc[ct][i];
        asm volatile("s_waitcnt lgkmcnt(0)" ::: "memory");
        int e0 = 0, e1 = 0; float w0 = 0.f, w1 = 0.f; unsigned lp0 = 0u, lp1 = 0u;
        if (lane < 16) {
            const LAS float* lr = lg + lane * 48;
            float g4v[4]; int grp = 0; float gm = -3.0e38f;
#pragma unroll
            for (int i = 0; i < 4; ++i) { g4v[i] = lr[i] + brg[i]; if (g4v[i] > gm) { gm = g4v[i]; grp = i; } }
            float den = 0.f;
#pragma unroll
            for (int i = 0; i < 4; ++i) den += __expf(g4v[i] - gm);
            const float pg = 1.f / den;
            float v0 = -3.0e38f, v1 = -3.0e38f; int i0 = 0, i1 = 0;
            for (int i = 0; i < 8; ++i) { const float v = lr[4 + grp * 8 + i] + bre[grp * 8 + i];
                if (v > v0) { v1 = v0; i1 = i0; v0 = v; i0 = i; } else if (v > v1) { v1 = v; i1 = i; } }
            const float ex = __expf(v1 - v0); w0 = pg / (1.f + ex); w1 = pg * ex / (1.f + ex);
            e0 = grp * 8 + i0; e1 = grp * 8 + i1;
            lp0 = atomicAdd((unsigned*)&hist[e0], 1u); lp1 = atomicAdd((unsigned*)&hist[e1], 1u);
        }
        __syncthreads();
        if (F.tid < 32) { const unsigned n = hist[F.tid]; hist[32 + F.tid] = n ? atomicAdd(cnt + F.tid, n) : 0u; }
        __syncthreads();
        if (lane < 16) {
            const int tok = m0 + lane; const int p0 = (int)(hist[32 + e0] + lp0), p1 = (int)(hist[32 + e1] + lp1);
            lists[(size_t)e0 * ECAP + p0] = tok; lists[(size_t)e1 * ECAP + p1] = tok;
            tipos[2 * tok] = p0; tipos[2 * tok + 1] = p1; tie[tok] = e0 | (e1 << 8); tiw[2 * tok] = w0; tiw[2 * tok + 1] = w1;
        }
        __syncthreads();
    }
#undef P8_ISSUE
}

DI LAS int* moe_prefix(Frame& F) {
    LAS int* tb = (LAS int*)(F.lds + LDS_MISC);
    __syncthreads();
    if (F.wave == 0) {
        const unsigned* cnt = (const unsigned*)(F.ws + WS_CTL) + CW_CNT; const int l = F.lane;
        int v = l < 32 ? (int)((__hip_atomic_load(cnt + l, __ATOMIC_RELAXED, __HIP_MEMORY_SCOPE_AGENT) + 255u) >> 8) : 0;
#pragma unroll
        for (int o = 1; o < 32; o <<= 1) { const int u = __shfl_up(v, o); if (l >= o) v += u; }
        if (l < 32) tb[l + 1] = v;
        if (l == 0) tb[0] = 0;
    }
    __syncthreads();
    return tb;
}

DI void phase11(Frame& F) {
    LAS int* tb = moe_prefix(F);
    const unsigned char* Y = (const unsigned char*)(F.ws + WS_Y); const float* mod = (const float*)(F.ws + WS_MOD);
    const int* tipos = (const int*)(F.ws + WS_TIPOS); const int* tie = (const int*)(F.ws + WS_TIE); const float* tiw = (const float*)(F.ws + WS_TIW);
    const int lane = F.lane;
    for (int m0 = F.gw * 32; m0 < TOK; m0 += F.NGW * 32) {
        const int b = m0 >> 11; const float* g2 = mod + (size_t)b * 6144 + 5120;
        f32x4 ga[2], gb[2];
#pragma unroll
        for (int j = 0; j < 2; ++j) { ga[j] = *(const f32x4*)(g2 + 8 * lane + 512 * j); gb[j] = *(const f32x4*)(g2 + 8 * lane + 512 * j + 4); }
        int mr0 = 0, mr1 = 0; float mw0 = 0.f, mw1 = 0.f;
        { const int mm = m0 + (lane & 31); const int ee = tie[mm]; mr0 = tb[ee & 255] * 256 + tipos[2 * mm]; mr1 = tb[ee >> 8] * 256 + tipos[2 * mm + 1]; mw0 = tiw[2 * mm]; mw1 = tiw[2 * mm + 1]; }
        float* obase = F.out + (size_t)m0 * DM + 8 * lane; const bf16_t* xbase = (const bf16_t*)(F.ws + WS_X1B) + (size_t)m0 * DM + 8 * lane;
#define P11_LOAD(i, ya, yb, xa, xb) do { const size_t r0_ = (size_t)__shfl(mr0, (i)), r1_ = (size_t)__shfl(mr1, (i)); \
            _Pragma("unroll") for (int j = 0; j < 2; ++j) { ya[j] = __builtin_nontemporal_load((const u32x2*)(Y + r0_ * DM + 8 * lane + 512 * j)); yb[j] = __builtin_nontemporal_load((const u32x2*)(Y + r1_ * DM + 8 * lane + 512 * j)); \
                const u32x4 xw_ = ldntu4(xbase + (size_t)(i) * DM + 512 * j); xa[j] = (f32x4){bflo(xw_.x), bfhi(xw_.x), bflo(xw_.y), bfhi(xw_.y)}; xb[j] = (f32x4){bflo(xw_.z), bfhi(xw_.z), bflo(xw_.w), bfhi(xw_.w)}; } } while (0)
        u32x2 ya0[2], yb0[2], ya1[2], yb1[2]; f32x4 xa0[2], xb0[2], xa1[2], xb1[2];
        P11_LOAD(0, ya0, yb0, xa0, xb0); P11_LOAD(1, ya1, yb1, xa1, xb1);
        for (int i = 0; i < 32; i += 2) {
            u32x2 nya0[2], nyb0[2], nya1[2], nyb1[2]; f32x4 nxa0[2], nxb0[2], nxa1[2], nxb1[2];
            if (i + 2 < 32) { P11_LOAD(i + 2, nya0, nyb0, nxa0, nxb0); P11_LOAD(i + 3, nya1, nyb1, nxa1, nxb1); }
#define P11_ROW(i, ya, yb, xa, xb) do { const float w0 = __shfl(mw0, (i)), w1 = __shfl(mw1, (i)); \
            _Pragma("unroll") for (int j = 0; j < 2; ++j) { f32x4 oa = xa[j], ob = xb[j]; \
                const f32x2 a01 = __builtin_amdgcn_cvt_pk_f32_fp8((int)ya[j].x, false), a23 = __builtin_amdgcn_cvt_pk_f32_fp8((int)ya[j].x, true), a45 = __builtin_amdgcn_cvt_pk_f32_fp8((int)ya[j].y, false), a67 = __builtin_amdgcn_cvt_pk_f32_fp8((int)ya[j].y, true); \
                const f32x2 b01 = __builtin_amdgcn_cvt_pk_f32_fp8((int)yb[j].x, false), b23 = __builtin_amdgcn_cvt_pk_f32_fp8((int)yb[j].x, true), b45 = __builtin_amdgcn_cvt_pk_f32_fp8((int)yb[j].y, false), b67 = __builtin_amdgcn_cvt_pk_f32_fp8((int)yb[j].y, true); \
                oa[0] += ga[j][0] * (w0 * a01[0] + w1 * b01[0]); oa[1] += ga[j][1] * (w0 * a01[1] + w1 * b01[1]); \
                oa[2] += ga[j][2] * (w0 * a23[0] + w1 * b23[0]); oa[3] += ga[j][3] * (w0 * a23[1] + w1 * b23[1]); \
                ob[0] += gb[j][0] * (w0 * a45[0] + w1 * b45[0]); ob[1] += gb[j][1] * (w0 * a45[1] + w1 * b45[1]); \
                ob[2] += gb[j][2] * (w0 * a67[0] + w1 * b67[0]); ob[3] += gb[j][3] * (w0 * a67[1] + w1 * b67[1]); \
                stnt4(obase + (size_t)(i) * DM + 512 * j, oa); stnt4(obase + (size_t)(i) * DM + 512 * j + 4, ob); } } while (0)
            P11_ROW(i, ya0, yb0, xa0, xb0); P11_ROW(i + 1, ya1, yb1, xa1, xb1);
#pragma unroll
            for (int j = 0; j < 2; ++j) { ya0[j] = nya0[j]; yb0[j] = nyb0[j]; xa0[j] = nxa0[j]; xb0[j] = nxb0[j]; ya1[j] = nya1[j]; yb1[j] = nyb1[j]; xa1[j] = nxa1[j]; xb1[j] = nxb1[j]; }
        }
#undef P11_LOAD
#undef P11_ROW
    }
}

constexpr int CW_BAR = 4096;
#define XB_TMO      128
#define XB_XCNT(j)  (256  + 64 * (j))
#define XB_XSUB(j)  (1280 + 64 * (j))
#define XB_XGEN(j)  (2304 + 64 * (j))
#define XB_TOP      3328
#define XB_TOPGEN   3392
#define XB_SPIN_CAP (1u << 22)
DI unsigned xb_ld(unsigned* p)              { return __hip_atomic_load(p, __ATOMIC_RELAXED, __HIP_MEMORY_SCOPE_AGENT); }
DI unsigned xb_add(unsigned* p, unsigned v) { return __hip_atomic_fetch_add(p, v, __ATOMIC_RELAXED, __HIP_MEMORY_SCOPE_AGENT); }
DI unsigned xb_xcc_id() { return (unsigned)__builtin_amdgcn_s_getreg((3 << 11) | 20) & 0xFu; }
#define XB_SPIN(cond, bar) do { unsigned _sp = 0; while (cond) { __builtin_amdgcn_s_sleep(1); \
    if ((++_sp & 255u) == 0u) { if (xb_ld(&(bar)[XB_TMO])) break; if (_sp > XB_SPIN_CAP) { atomicAdd(&(bar)[XB_TMO], 1u); break; } } } } while (0)
struct XcdBarrier { unsigned* bar; unsigned x; volatile LAS unsigned* st; };
DI XcdBarrier xcd_barrier_post(unsigned* bar, volatile LAS unsigned* st, bool leader) {
    XcdBarrier b; b.bar = bar; b.x = xb_xcc_id(); b.st = st;
    if (leader) (void)xb_add(&bar[XB_XCNT(b.x)], 1u);
    return b;
}
DI void xcd_barrier_complete(unsigned* bar, unsigned x, unsigned& nloc, unsigned& nx) {
    const unsigned G = gridDim.x;
    unsigned sum, cnt, mine, sp = 0u;
    for (;;) {
        sum = 0u; cnt = 0u; mine = 0u;
#pragma unroll
        for (unsigned j = 0; j < 16; ++j) { const unsigned c = xb_ld(&bar[XB_XCNT(j)]); sum += c; cnt += (c > 0u) ? 1u : 0u; mine = (j == x) ? c : mine; }
        if (sum == G) break;
        __builtin_amdgcn_s_sleep(1);
        if ((++sp & 255u) == 0u) { if (xb_ld(&bar[XB_TMO])) break; if (sp > XB_SPIN_CAP) { atomicAdd(&bar[XB_TMO], 1u); break; } }
    }
    nloc = mine > 0u ? mine : 1u; nx = cnt > 0u ? cnt : 1u;
}
DI void xcd_barrier(const XcdBarrier& b, bool leader) {
    asm volatile("s_waitcnt vmcnt(0)" ::: "memory");
    __syncthreads();
    if (leader) {
        unsigned* bar = b.bar;
        __builtin_amdgcn_s_waitcnt(0);
        unsigned nloc = b.st[0], nx = b.st[1];
        if (nloc == 0u) { xcd_barrier_complete(bar, b.x, nloc, nx); b.st[0] = nloc; b.st[1] = nx; }
        const unsigned old = xb_add(&bar[XB_XSUB(b.x)], 1u);
        const unsigned gen = old / nloc;
        if (old + 1u == (gen + 1u) * nloc) {
            __builtin_amdgcn_fence(__ATOMIC_RELEASE, "agent");
            asm volatile("s_waitcnt vmcnt(0)" ::: "memory");
            const unsigned og = xb_add(&bar[XB_TOP], 1u);
            const unsigned tg = og / nx;
            if (og + 1u == (tg + 1u) * nx) xb_add(&bar[XB_TOPGEN], 1u);
            else XB_SPIN(xb_ld(&bar[XB_TOPGEN]) == tg, bar);
            __builtin_amdgcn_fence(__ATOMIC_ACQUIRE, "agent");
            xb_add(&bar[XB_XGEN(b.x)], 1u);
            asm volatile("s_waitcnt vmcnt(0)" ::: "memory");
        } else {
            XB_SPIN(xb_ld(&bar[XB_XGEN(b.x)]) == gen, bar);
            __builtin_amdgcn_fence(__ATOMIC_ACQUIRE, "agent");
            asm volatile("s_waitcnt vmcnt(0)" ::: "memory");
        }
    }
    __syncthreads();
}

constexpr int NPHASE = 12;
__global__ void __launch_bounds__(NTHREADS, 2) hymba_fwd(Params p) {
    extern __shared__ __attribute__((aligned(16))) unsigned char lds_raw[];
    __builtin_assume(__builtin_amdgcn_workitem_id_y() == 0); __builtin_assume(__builtin_amdgcn_workitem_id_z() == 0);
    cg::grid_group grid = cg::this_grid();
    Frame F;
    F.lds = (LAS unsigned char*)lds_raw; F.ws = p.ws; F.in = p.in; F.out = p.out;
    F.wave = __builtin_amdgcn_readfirstlane(threadIdx.x >> 6); F.lane = lane_id_fresh(); F.tid = F.wave * 64 + F.lane; F.bid = blockIdx.x; F.G = gridDim.x;
    F.gw = F.bid * NWAVES + F.wave; F.NGW = F.G * NWAVES;
    const int lo = p.ph_lo, hi = p.ph_hi;
#define IN(k) (lo <= (k) && (k) < hi)
#ifdef PROBE_A
    LAS unsigned long long* ts_ = (LAS unsigned long long*)(F.lds + LDS_MISC + 7168);
#define STAMP(k) do { if (F.bid == 0 && F.tid == 0) ts_[k] = __builtin_amdgcn_s_memrealtime(); } while (0)
#else
#define STAMP(k) do { } while (0)
#endif
    STAMP(0);
    volatile LAS unsigned* xst = (volatile LAS unsigned*)(F.lds + LDS_MISC + 4112);
    if (F.tid == 0) { xst[0] = 0u; xst[1] = 0u; }
    __syncthreads();
    XcdBarrier xbar; xbar.bar = (unsigned*)(F.ws + WS_CTL) + CW_BAR; xbar.x = 0; xbar.st = xst;
#define SEAM(k) do { if (IN(k) && IN((k) + 1)) { if ((k) == 0) { grid.sync(); xbar = xcd_barrier_post((unsigned*)(F.ws + WS_CTL) + CW_BAR, xst, F.tid == 0); } else xcd_barrier(xbar, F.tid == 0); } F.lane = lane_id_fresh(); F.tid = F.wave * 64 + F.lane; STAMP((k) + 1); } while (0)
    LAS unsigned char* ring = F.lds; LAS unsigned* tokl = (LAS unsigned*)(F.lds + LDS_MISC + 256);
#ifdef DOUBLE_PHASE
#define NREP(k) ((k) == DOUBLE_PHASE ? 2 : 1)
#define REPSYNC(k, rep) do { if ((k) == DOUBLE_PHASE && (rep) == 0) grid.sync(); } while (0)
#else
#define NREP(k) 1
#define REPSYNC(k, rep) do { } while (0)
#endif

    if (IN(0)) for (int rep = 0; rep < NREP(0); ++rep) { phase0(F); REPSYNC(0, rep); }
    SEAM(0);
    if (IN(1)) for (int rep = 0; rep < NREP(1); ++rep) { phase1(F); phase0_weights(F); REPSYNC(1, rep); }
    SEAM(1);
    if (IN(2)) for (int rep = 0; rep < NREP(2); ++rep) {
        pg8::StaticOrder S; S.init(TOK, NPROJ, DM / 2, F.G, F.bid, F.ws + WS_H1, F.ws + WS_WIN);
        pg8::EpiInProj E{F.ws, F.in[7], F.in[8], F.in[12], F.in[13], (LAS float*)(F.lds + LDS_MISC + 8192)};
        pg8::gemm_phase<pg8::EpiInProj, pg8::StaticOrder, false, true>(ring, tokl, DM / 2, S, E, F.wave, F.lane);
        REPSYNC(2, rep);
    }
    SEAM(2); STAMP(4);
    if (IN(4)) for (int rep = 0; rep < NREP(4); ++rep) {
        { pg8::CompressOrder S{F.G, F.bid, (const char*)(F.ws + WS_KC), (const char*)(F.ws + WS_PE), (const char*)(F.ws + WS_WC1)};
          pg8::EpiBf16 E{(bf16_t*)(F.ws + WS_UL), 512};
          pg8::gemm_phase<pg8::EpiBf16, pg8::CompressOrder, false>(ring, tokl, 1024, S, E, F.wave, F.lane); }
        const float mq = gmax(F.in[12], 32, F.lane), mk = gmax(F.in[13], 32, F.lane);
        const float bound = 5.656854249f * mq * mk * 1.02f; const float c2 = 0.17677669529663687f * 1.4426950408889634f; const float mc = bound * 1.4426950408889634f;
        float s1 = F.lane < 32 ? F.in[14][F.lane] * F.in[15][F.lane] : 0.f, s2 = F.lane < 32 ? F.in[16][F.lane] * F.in[17][F.lane] : 0.f;
        s1 = wave_sum(s1); s2 = wave_sum(s2);
        const float lam = __expf(s1) - __expf(s2) + 0.2f;
        unsigned* ctr = (unsigned*)(F.ws + WS_CTL) + CW_QDIFF + 32 * rep;
        for (int it = queue_next(F, ctr); it < 4096;) { unsigned nx = 0u; if (F.tid == 0) nx = atomicAdd(ctr, 1u);
            const int qb = 15 - (it >> 8), bh = it & 255; diff_unit(F, bh >> 3, bh & 7, qb, c2, mc, lam); it = queue_pass(F, nx); }
        REPSYNC(4, rep);
    }
    SEAM(4);
    if (IN(5)) for (int rep = 0; rep < NREP(5); ++rep) { phase5(F); REPSYNC(5, rep); }
    SEAM(5);
    if (IN(6)) for (int rep = 0; rep < NREP(6); ++rep) {
        const float mq = gmax(F.in[7], 64, F.lane); const float mk = fmaxf(gmax(F.in[8], 64, F.lane), fmaxf(gmax(F.in[8] + 64, 64, F.lane), gmax(F.in[8] + 128, 64, F.lane)));
        const float bound = 8.f * mq * mk * 1.02f; const float c2 = 0.125f * 1.4426950408889634f; const float mc = bound * 1.4426950408889634f;
        unsigned* ctr = (unsigned*)(F.ws + WS_CTL) + CW_QNSA + 32 * rep;
        for (int it = queue_next(F, ctr); it < 2048;) { unsigned nx = 0u; if (F.tid == 0) nx = atomicAdd(ctr, 1u);
            const int qb = 31 - (it >> 6), bg = it & 63; nsa_unit(F, bg >> 1, bg & 1, qb, c2, mc); it = queue_pass(F, nx); }
        REPSYNC(6, rep);
    }
    SEAM(6);
    if (IN(7)) for (int rep = 0; rep < NREP(7); ++rep) {
        pg8::StaticOrder S; S.init(TOK, DM, DM, F.G, F.bid, F.ws + WS_AO, F.ws + WS_WOUT);
        pg8::EpiOutProj E{F.in[0], (bf16_t*)(F.ws + WS_X1B), (const float*)(F.ws + WS_MOD), (float*)(F.ws + WS_ROWSS)};
        pg8::gemm_phase<pg8::EpiOutProj, pg8::StaticOrder, false>(ring, tokl, DM, S, E, F.wave, F.lane);
        REPSYNC(7, rep);
    }
    SEAM(7);
    if (IN(8)) phase8(F);
    SEAM(8);
    if (IN(9)) for (int rep = 0; rep < NREP(9); ++rep) {
        LAS int* tb = moe_prefix(F);
        pg8::MoeOrder S{F.G, F.bid, 0, tb, (const char*)(F.ws + WS_H2), (const char*)(F.ws + WS_WGU), (const int*)(F.ws + WS_LIST)};
        pg8::EpiSwiglu E{(unsigned char*)(F.ws + WS_HH)};
        pg8::gemm_phase<pg8::EpiSwiglu, pg8::MoeOrder, true, true>(ring, tokl, DM / 2, S, E, F.wave, F.lane);
        REPSYNC(9, rep);
    }
    SEAM(9);
    if (IN(10)) for (int rep = 0; rep < NREP(10); ++rep) {
        LAS int* tb = moe_prefix(F);
        pg8::MoeOrder S{F.G, F.bid, 1, tb, (const char*)(F.ws + WS_HH), (const char*)(F.ws + WS_WD), nullptr};
        pg8::EpiFp8 E{(unsigned char*)(F.ws + WS_Y), DM};
        pg8::gemm_phase<pg8::EpiFp8, pg8::MoeOrder, false, true>(ring, tokl, EHID / 2, S, E, F.wave, F.lane);
        REPSYNC(10, rep);
    }
    SEAM(10);
    if (IN(11)) phase11(F);
    grid.sync(); grid.sync(); grid.sync(); grid.sync(); grid.sync(); grid.sync(); grid.sync(); grid.sync();
#ifdef PROBE_A
    grid.sync(); STAMP(12);
    if (F.bid == 0 && F.tid == 0) {
        unsigned long long da = (ts_[PROBE_A + 1] - ts_[PROBE_A]) / 100ull, db = (ts_[PROBE_B + 1] - ts_[PROBE_B]) / 100ull;
        unsigned long long qa = (da + 5ull) / 10ull, qb2 = (db + 5ull) / 10ull; if (qa > 63ull) qa = 63ull; if (qb2 > 63ull) qb2 = 63ull;
        const unsigned long long target = ts_[0] + (6000ull + 16ull + 32ull * qa + 2048ull * qb2) * 100ull;
        while (__builtin_amdgcn_s_memrealtime() < target) __builtin_amdgcn_s_sleep(32);
    }
#endif
#undef IN
#undef SEAM
}

#ifndef MK_LAUNCHES
#define MK_LAUNCHES 1
#endif
extern "C" void kernel_launch(void* const* d_in, const int* in_sizes, int n_in, void* d_out, int out_size, void* d_ws, size_t ws_size, hipStream_t stream) {
    static int grid = 0;
    if (grid == 0) {
        if (n_in != 27 || ws_size < WS_END) { fprintf(stderr, "kernel_launch: unexpected inputs (n_in %d, ws %zu)\n", n_in, ws_size); grid = -1; return; }
        int dev = 0, cus = 0, per_cu = 0;
        hipGetDevice(&dev); hipDeviceGetAttribute(&cus, hipDeviceAttributeMultiprocessorCount, dev);
        hipFuncSetAttribute((const void*)hymba_fwd, hipFuncAttributeMaxDynamicSharedMemorySize, LDS_BYTES);
        hipOccupancyMaxActiveBlocksPerMultiprocessor(&per_cu, (const void*)hymba_fwd, NTHREADS, LDS_BYTES);
        if (per_cu < 1) { fprintf(stderr, "kernel_launch: occupancy query says %d blocks per CU\n", per_cu); per_cu = 1; }
        if (per_cu > 1) per_cu = 1;
        grid = cus * per_cu;
    }
    if (grid < 0) return;
    Params p{};
    for (int i = 0; i < 27; ++i) p.in[i] = (const float*)d_in[i];
    p.out = (float*)d_out; p.ws = (unsigned char*)d_ws;
    const int cuts[13] = {0, 1, 2, 3, 4, 5, 6, 7, 8, 9, 10, 11, 12};
    const int nl = MK_LAUNCHES == 1 ? 1 : NPHASE;
    for (int li = 0; li < nl; ++li) {
        p.ph_lo = nl == 1 ? 0 : cuts[li]; p.ph_hi = nl == 1 ? NPHASE : cuts[li + 1];
        void* args[] = {&p};
        hipError_t e = hipLaunchCooperativeKernel((const void*)hymba_fwd, dim3(grid), dim3(NTHREADS), args, LDS_BYTES, stream);
        if (e != hipSuccess) { fprintf(stderr, "cooperative launch failed: %s (grid %d)\n", hipGetErrorString(e), grid); break; }
    }
}
```

```cpp
#include <hip/hip_runtime.h>
#include <hip/hip_cooperative_groups.h>
#include <cstdint>
#include <cstdio>
namespace cg = cooperative_groups;

#define LAS __attribute__((address_space(3)))
#define DI __device__ __forceinline__
typedef unsigned short bf16_t;
typedef short bf16x8 __attribute__((ext_vector_type(8)));
typedef short s16x4 __attribute__((ext_vector_type(4)));
typedef float f32x2 __attribute__((ext_vector_type(2)));
typedef float f32x4 __attribute__((ext_vector_type(4)));
typedef float f32x16 __attribute__((ext_vector_type(16)));
typedef unsigned u32x2 __attribute__((ext_vector_type(2)));
typedef unsigned u32x4 __attribute__((ext_vector_type(4)));

constexpr int BATCH = 32, SEQ = 2048, DM = 1024, TOK = BATCH * SEQ;
constexpr int NPROJ = 3072;
constexpr int INCOLS = 2840;
constexpr int NEXP = 32, EHID = 512, ECAP = 65536;
constexpr float EPS = 1e-6f;
constexpr int NWAVES = 8, NTHREADS = 512;

constexpr size_t MiB = 1u << 20;
constexpr size_t WS_CTL = 0;
constexpr size_t WS_MOD = 1 * MiB;
constexpr size_t WS_ROPE = 2 * MiB;
constexpr size_t WS_WR = 3 * MiB;
constexpr size_t WS_WIN = 4 * MiB;
constexpr size_t WS_WOUT = 10 * MiB;
constexpr size_t WS_WC1 = 12 * MiB;
constexpr size_t WS_WGU = 16 * MiB;
constexpr size_t WS_WD = 80 * MiB;
constexpr size_t WS_LIST = 112 * MiB;
constexpr size_t WS_TIPOS = 120 * MiB;
constexpr size_t WS_TIE = WS_TIPOS + 512 * 1024;
constexpr size_t WS_TIW = WS_TIE + 256 * 1024;
constexpr size_t WS_ROWSS = 122 * MiB;
constexpr size_t WS_GATES = 126 * MiB;
constexpr size_t WS_KCMP = 132 * MiB;
constexpr size_t WS_VCMP = 133 * MiB;
constexpr size_t WS_UL = 134 * MiB;
constexpr size_t WS_A = 160 * MiB;
constexpr size_t WS_B = 288 * MiB;
constexpr size_t WS_C = 672 * MiB;
constexpr size_t WS_H1 = WS_A, WS_QN = WS_B + 128 * MiB, WS_QR = WS_B + 192 * MiB, WS_H2 = WS_A;
constexpr size_t WS_PROJ = WS_B, WS_AO = WS_B, WS_HH = WS_B, WS_Y = WS_B + 136 * MiB;
constexpr size_t WS_KC = WS_C, WS_VC = WS_C + 16 * MiB, WS_PE = WS_C + 32 * MiB, WS_KS = WS_C + 33 * MiB, WS_VS = WS_C + 49 * MiB,
                 WS_KW = WS_C + 65 * MiB, WS_VW = WS_C + 81 * MiB, WS_DQ = WS_C + 97 * MiB, WS_DK = WS_C + 161 * MiB, WS_DV = WS_C + 225 * MiB;
constexpr size_t WS_X1B = WS_C + 32 * MiB;
constexpr size_t WS_END = WS_C + 289 * MiB;
constexpr int CW_CNT = 0;
constexpr int CW_QDIFF = 64, CW_QNSA = 128;

constexpr int RING_BYTES = 131072;
constexpr int LDS_MISC = RING_BYTES;
constexpr int LDS_BYTES = 147456;

DI unsigned pk2(float lo, float hi) { typedef __bf16 b2 __attribute__((ext_vector_type(2))); f32x2 v = {lo, hi}; b2 b = __builtin_convertvector(v, b2); return __builtin_bit_cast(unsigned, b); }
DI unsigned short f2bf(float f) { return (unsigned short)(pk2(f, 0.f) & 0xffffu); }
DI float bf2f(unsigned short h) { return __uint_as_float((unsigned)h << 16); }
DI float bflo(unsigned w) { return __uint_as_float(w << 16); }
DI float bfhi(unsigned w) { return __uint_as_float(w & 0xffff0000u); }
DI float wave_sum(float v) {
#pragma unroll
    for (int o = 1; o < 64; o <<= 1) v += __shfl_xor(v, o);
    return v;
}
DI float fast_exp2(float x) { return __builtin_amdgcn_exp2f(x); }
DI float fast_rcp(float x) { return __builtin_amdgcn_rcpf(x); }
#define MFMA32(a, b, c) __builtin_amdgcn_mfma_f32_32x32x16_bf16((a), (b), (c), 0, 0, 0)
#define MFMA16(a, b, c) __builtin_amdgcn_mfma_f32_16x16x32_bf16((a), (b), (c), 0, 0, 0)
typedef int v8i32 __attribute__((ext_vector_type(8)));
DI unsigned pk4_fp8(float a, float b, float c, float d) { int w = 0; w = __builtin_amdgcn_cvt_pk_fp8_f32(a, b, w, false); w = __builtin_amdgcn_cvt_pk_fp8_f32(c, d, w, true); return (unsigned)w; }
DI f32x4 ldnt4(const float* p) { return __builtin_nontemporal_load((const f32x4*)p); }
DI u32x4 ldntu4(const void* p) { return __builtin_nontemporal_load((const u32x4*)p); }
DI void stnt4(float* p, f32x4 v) { __builtin_nontemporal_store(v, (f32x4*)p); }
DI int crow(int r, int hi) { return (r & 3) + 8 * (r >> 2) + 4 * hi; }

DI int lane_id_fresh() { int l; asm volatile("v_mbcnt_lo_u32_b32 %0, -1, 0\n\tv_mbcnt_hi_u32_b32 %0, -1, %0" : "=v"(l)); return l; }
DI void glds16s(const void* sbase, unsigned voff, unsigned lds_dst) { unsigned keep;
    asm volatile("s_mov_b32 %0, m0\n\ts_mov_b32 m0, %3\n\ts_nop 0\n\tglobal_load_lds_dwordx4 %1, %2\n\ts_mov_b32 m0, %0" : "=&s"(keep) : "v"(voff), "s"(sbase), "s"(lds_dst) : "memory"); }
struct Params { const float* in[27]; float* out; unsigned char* ws; int ph_lo, ph_hi; };

namespace pg8 {
constexpr int BM = 256, BK = 64, HALF = 128, HTB = HALF * BK * 2, STAGE_BYTES = 8 * HTB, NXCD = 8, WGM = 8;
DI int lds_byte(int r, int c) { const int st = (r >> 4) * 2 + (c >> 5), rr = r & 15, cc = c & 31, ob = rr * 64 + cc * 2; return st * 1024 + (ob ^ (((ob >> 9) & 1) << 5)); }
DI void stage_rc(int b, int& R, int& C) { const int st = b / 1024, sb = b % 1024, swz = sb ^ (((sb >> 9) & 1) << 5); R = (st >> 1) * 16 + swz / 64; C = (st & 1) * 32 + (swz % 64) / 2; }
DI int perm32(int rho) { const int n = rho >> 4, i = rho & 15; return 8 * (i >> 2) + 4 * n + (i & 3); }

struct Unit { int pm, pn, aux; const char* Ab; const char* Bb; const int* tok; };

template <class Epi, class Sched, bool GATHER, bool FP8 = false>
DI void gemm_phase(LAS unsigned char* lds, LAS unsigned* tokl, const int K, const Sched& S, const Epi& E, const int wid, const int lane) {
    const int tid = wid * 64 + lane, wr = wid >> 2, wc = wid & 3, fr = lane & 15, fq = lane >> 4;
    const int nt = K / BK;
    unsigned voffA[2], voffB[2]; int RA[2], CA[2];
#pragma unroll
    for (int i = 0; i < 2; ++i) { int R, C; stage_rc(tid * 16 + i * 8192, R, C); const int Rb = Epi::PERM ? ((R & ~31) + perm32(R & 31)) : R;
        voffA[i] = (unsigned)(R * K + C) * 2u; voffB[i] = (unsigned)(Rb * K + C) * 2u; RA[i] = R; CA[i] = C; }
    const size_t kstep = (size_t)(BK * 2);
    const size_t hstep = (size_t)HALF * K * 2;
    const unsigned ldsw = (unsigned)wid * 1024u; const unsigned ldsb = (unsigned)(uintptr_t)lds;
    const int aoff = lds_byte(wr * 64 + fr, fq * 8), boff = lds_byte(wc * 32 + fr, fq * 8);
#define PG8_SA(b, h) (((b) * 2 + (h)) * HTB)
#define PG8_SB(b, h) ((4 + (b) * 2 + (h)) * HTB)
#define PG8_STG(bufoff, gbase, voff) do { _Pragma("unroll") for (int _i = 0; _i < 2; ++_i) \
        glds16s((const void*)(gbase), (voff)[_i], (unsigned)__builtin_amdgcn_readfirstlane((int)(ldsb + (unsigned)(bufoff) + ldsw + (unsigned)_i * 8192u))); } while (0)
#define PG8_STA(bufoff, gbase, h, bsel) do { if constexpr (GATHER) { unsigned vv_[2];   \
            _Pragma("unroll") for (int _j = 0; _j < 2; ++_j) vv_[_j] = tokl[(bsel) * 256 + (h) * 128 + RA[_j]] * (unsigned)(K * 2) + (unsigned)(CA[_j] * 2); \
            PG8_STG(bufoff, gbase, vv_); } else { PG8_STG(bufoff, (gbase) + (h) * hstep, voffA); } } while (0)
#define PG8_LD8(p_) ({ const u32x4 lo_ = *(const LAS u32x4*)(p_), hi_ = *(const LAS u32x4*)((p_) + 1024); (v8i32){(int)lo_.x, (int)lo_.y, (int)lo_.z, (int)lo_.w, (int)hi_.x, (int)hi_.y, (int)hi_.z, (int)hi_.w}; })
#define PG8_LDA(dst, b, h) do { if constexpr (FP8) { _Pragma("unroll") for (int m = 0; m < 4; ++m) dst##8[m] = PG8_LD8(lds + PG8_SA(b, h) + aoff + m * 2048); } \
        else { _Pragma("unroll") for (int m = 0; m < 4; ++m) _Pragma("unroll") for (int k = 0; k < 2; ++k) dst[m][k] = *(const LAS bf16x8*)(lds + PG8_SA(b, h) + aoff + m * 2048 + k * 1024); } } while (0)
#define PG8_LDB(dst, b, h) do { if constexpr (FP8) { _Pragma("unroll") for (int n = 0; n < 2; ++n) dst##8[n] = PG8_LD8(lds + PG8_SB(b, h) + boff + n * 2048); } \
        else { _Pragma("unroll") for (int n = 0; n < 2; ++n) _Pragma("unroll") for (int k = 0; k < 2; ++k) dst[n][k] = *(const LAS bf16x8*)(lds + PG8_SB(b, h) + boff + n * 2048 + k * 1024); } } while (0)
#define PG8_MMA(ai, bj, At, Bt) do { __builtin_amdgcn_s_setprio(1); _Pragma("unroll") for (int m = 0; m < 4; ++m) _Pragma("unroll") for (int n = 0; n < 2; ++n) { \
        if constexpr (FP8) {   \
            asm volatile("v_mfma_scale_f32_16x16x128_f8f6f4 %0, %1, %2, %0, %3, %4 op_sel_hi:[0,0,0]" : "+v"(acc[ai][bj][m][n]) : "v"(Bt##8[n]), "v"(At##8[m]), "v"(sclB_), "v"(sclA_)); \
        } else { _Pragma("unroll") for (int k = 0; k < 2; ++k) acc[ai][bj][m][n] = __builtin_amdgcn_mfma_f32_16x16x32_bf16(Bt[n][k], At[m][k], acc[ai][bj][m][n], 0, 0, 0); } } \
        __builtin_amdgcn_s_setprio(0); } while (0)
#define PG8_WAIT_V(n) asm volatile("s_waitcnt vmcnt(" #n ")" ::: "memory")
#define PG8_WAIT_L(n) asm volatile("s_waitcnt lgkmcnt(" #n ")" ::: "memory")
#define PG8_BAR __builtin_amdgcn_s_barrier()
#define PG8_SCHED __builtin_amdgcn_sched_barrier(0)
    Unit cur, nxt; int ui = 0;
    if (!S.next(0, cur)) return;
    f32x4 acc[2][2][4][2];
#pragma unroll
    for (int a = 0; a < 2; ++a)
#pragma unroll
        for (int b = 0; b < 2; ++b)
#pragma unroll
            for (int m = 0; m < 4; ++m)
#pragma unroll
                for (int n = 0; n < 2; ++n) acc[a][b][m][n] = (f32x4){0.f, 0.f, 0.f, 0.f};
    bf16x8 At[4][2], B0[2][2], B1[2][2];
    v8i32 At8[4], B08[2], B18[2];
    int sclB_ = 0x77777777, sclA_ = 0x7f7f7f7f; asm volatile("" : "+v"(sclB_), "+v"(sclA_));
    const char* cA = cur.Ab; const char* cB = cur.Bb;
    if constexpr (GATHER) {
        if (wid < 4) __builtin_amdgcn_global_load_lds((const unsigned*)(cur.tok + wid * 64 + lane), (LAS unsigned*)(tokl + wid * 64), 4, 0, 0);
        PG8_WAIT_V(0); PG8_BAR;
    }
    PG8_STG(PG8_SB(0, 0), cB, voffB); PG8_STG(PG8_SB(0, 1), cB + hstep, voffB); PG8_STA(PG8_SA(0, 0), cA, 0, 0); PG8_STA(PG8_SA(0, 1), cA, 1, 0);
    if (wr == 1) PG8_BAR;
    PG8_WAIT_V(2); PG8_BAR;
    PG8_STG(PG8_SB(1, 0), cB + kstep, voffB); PG8_STA(PG8_SA(1, 0), cA + kstep, 0, 0); PG8_STG(PG8_SB(1, 1), cB + hstep + kstep, voffB);
    PG8_WAIT_V(6); PG8_BAR;
    for (;;) {
        const bool has_next = S.next(ui + 1, nxt);
        const char* nA = has_next ? nxt.Ab : cA; const char* nB = has_next ? nxt.Bb : cB;
        if constexpr (GATHER) {
            if (has_next && wid < 4) __builtin_amdgcn_global_load_lds((const unsigned*)(nxt.tok + wid * 64 + lane), (LAS unsigned*)(tokl + ((ui + 1) & 1) * 256 + wid * 64), 4, 0, 0);
        }
#pragma unroll 1
        for (int t = 0; t < nt; t += 2) {
            const bool last = (t == nt - 2);
            const char* a1 = cA + (size_t)(t + 1) * kstep;
            const char* a2 = last ? nA : cA + (size_t)(t + 2) * kstep; const char* b2 = last ? nB : cB + (size_t)(t + 2) * kstep;
            const char* a3 = a2 + kstep; const char* b3 = b2 + kstep;
            const int bc_ = ui & 1, bn_ = (last && has_next) ? ((ui + 1) & 1) : (ui & 1);
            PG8_LDB(B0, 0, 0); PG8_LDB(B1, 0, 1); PG8_SCHED; PG8_LDA(At, 0, 0); PG8_STA(PG8_SA(1, 1), a1, 1, bc_);
            PG8_WAIT_V(8); PG8_WAIT_L(0); PG8_BAR; PG8_MMA(0, 0, At, B0); PG8_MMA(0, 1, At, B1); PG8_BAR; PG8_SCHED;
            PG8_LDA(At, 0, 1); PG8_STG(PG8_SB(0, 0), b2, voffB); PG8_STG(PG8_SB(0, 1), b2 + hstep, voffB); PG8_STA(PG8_SA(0, 0), a2, 0, bn_);
            PG8_WAIT_V(8); PG8_WAIT_L(0); PG8_BAR; PG8_MMA(1, 0, At, B0); PG8_MMA(1, 1, At, B1); PG8_BAR; PG8_SCHED;
            PG8_LDB(B0, 1, 0); PG8_LDB(B1, 1, 1); PG8_SCHED; PG8_LDA(At, 1, 0); PG8_STA(PG8_SA(0, 1), a2, 1, bn_);
            PG8_WAIT_V(8); PG8_WAIT_L(0); PG8_BAR; PG8_MMA(0, 0, At, B0); PG8_MMA(0, 1, At, B1); PG8_BAR; PG8_SCHED;
            PG8_LDA(At, 1, 1); PG8_STG(PG8_SB(1, 0), b3, voffB); PG8_STG(PG8_SB(1, 1), b3 + hstep, voffB); PG8_STA(PG8_SA(1, 0), a3, 0, bn_);
            PG8_WAIT_V(8); PG8_WAIT_L(0); PG8_BAR; PG8_MMA(1, 0, At, B0); PG8_MMA(1, 1, At, B1); PG8_BAR; PG8_SCHED;
        }
        if (wr == 0) PG8_BAR;
        if constexpr (FP8) asm volatile("s_nop 15\n\ts_nop 15" ::: "memory");
        E(acc, cur, wr, wc, fr, fq);
        if (!has_next) break;
#pragma unroll
        for (int a = 0; a < 2; ++a)
#pragma unroll
            for (int b = 0; b < 2; ++b)
#pragma unroll
                for (int m = 0; m < 4; ++m)
#pragma unroll
                    for (int n = 0; n < 2; ++n) acc[a][b][m][n] = (f32x4){0.f, 0.f, 0.f, 0.f};
        cur = nxt; cA = nA; cB = nB; ++ui;
        if (wr == 1) PG8_BAR;
    }
    PG8_WAIT_V(0);
    PG8_BAR;
#undef PG8_SA
#undef PG8_SB
#undef PG8_STG
#undef PG8_STA
#undef PG8_LDA
#undef PG8_LDB
#undef PG8_MMA
#undef PG8_WAIT_V
#undef PG8_WAIT_L
#undef PG8_BAR
#undef PG8_SCHED
}

struct StaticOrder {
    int nM, nN, nwg, G, c; const char* A; const char* Bt; size_t tstep;
    DI void init(int M, int N, int K, int G_, int c_, const void* A_, const void* Bt_) { nM = M / BM; nN = N / BM; nwg = nM * nN; G = G_; c = c_; A = (const char*)A_; Bt = (const char*)Bt_; tstep = (size_t)BM * K * 2; }
    DI bool next(int i, Unit& u) const {
        const long L = (long)i * G + c; if (L >= nwg) return false;
        int wgid = (int)L; { const int q = nwg / NXCD, r = nwg % NXCD, xcd = wgid % NXCD, off = wgid / NXCD; wgid = (xcd < r ? xcd * (q + 1) : r * (q + 1) + (xcd - r) * q) + off; }
        const int nig = WGM * nN, gid = wgid / nig, fm = gid * WGM, gsz = (nM - fm) < WGM ? (nM - fm) : WGM;
        u.pm = fm + ((wgid % nig) % gsz); u.pn = (wgid % nig) / gsz; u.aux = 0; u.Ab = A + (size_t)u.pm * tstep; u.Bb = Bt + (size_t)u.pn * tstep; u.tok = nullptr; return true;
    }
};
struct CompressOrder {
    int G, c; const char* KC; const char* PE; const char* W;
    DI bool next(int i, Unit& u) const {
        const int L = i * G + c; if (L >= 132) return false;
        u.pm = L >> 1; u.pn = L & 1; const int kv = u.pm < 32 ? 0 : (u.pm < 64 ? 1 : u.pm - 64); u.aux = kv;
        u.Ab = u.pm < 64 ? KC + (size_t)u.pm * (256 * 1024 * 2) : PE; u.Bb = W + (size_t)kv * (512 * 1024 * 2) + (size_t)u.pn * (256 * 1024 * 2); u.tok = nullptr; return true;
    }
};
struct MoeOrder {
    int G, c, mode; const LAS int* tb; const char* A; const char* W; const int* lists;
    DI bool next(int i, Unit& u) const {
        const int L = i * G + c; const int mt = L >> 2; if (mt >= tb[32]) return false;
        int e = 0;
#pragma unroll 1
        for (int j = 1; j < 32; ++j) e += (tb[j] <= mt) ? 1 : 0;
        u.pm = mt; u.pn = L & 3; u.aux = e;
        if (mode == 0) { u.Ab = A; u.Bb = W + (size_t)e * (1024 * 1024) + (size_t)u.pn * (256 * 1024); u.tok = lists + (size_t)e * ECAP + (size_t)(mt - tb[e]) * 256; }
        else { u.Ab = A + (size_t)mt * (256 * 512); u.Bb = W + (size_t)e * (1024 * 512) + (size_t)u.pn * (256 * 512); u.tok = nullptr; }
        return true;
    }
};

struct EpiBf16 {
    static constexpr bool PERM = true;
    bf16_t* O; int ldc;
    DI void operator()(const f32x4 (&acc)[2][2][4][2], const Unit& u, int wr, int wc, int fr, int fq) const {
        asm volatile("" : "+v"(fr), "+v"(fq));
        const int row0 = u.pm * BM + wr * 64 + fr; const int col0 = u.pn * BM + wc * 32 + 8 * fq;
#pragma unroll
        for (int ai = 0; ai < 2; ++ai)
#pragma unroll
            for (int m = 0; m < 4; ++m) { bf16_t* rowp = O + (size_t)(row0 + ai * HALF + m * 16) * ldc + col0;
#pragma unroll
                for (int bj = 0; bj < 2; ++bj) { const f32x4 v0 = acc[ai][bj][m][0], v1 = acc[ai][bj][m][1];
                    u32x4 w; w.x = pk2(v0[0], v0[1]); w.y = pk2(v0[2], v0[3]); w.z = pk2(v1[0], v1[1]); w.w = pk2(v1[2], v1[3]);
                    *(u32x4*)(rowp + bj * HALF) = w; } }
    }
};
struct EpiInProj {
    static constexpr bool PERM = true;
    unsigned char* ws; const float* g_nq; const float* g_nk; const float* g_dq; const float* g_dk; LAS float* xch;
    DI void operator()(const f32x4 (&acc)[2][2][4][2], const Unit& u, int wr, int wc, int fr, int fq) const {
        const int pn = u.pn, wid = wr * 4 + wc; const int tok0 = u.pm * BM; const int b = tok0 >> 11; int t0 = (tok0 & 2047) + wr * 64 + fr;
        int xo_i = wid * 256 + fr, xp_i = (wid ^ 1) * 256 + fr;
        asm volatile("" : "+v"(t0), "+v"(xo_i), "+v"(xp_i));
        LAS float* xo = xch + xo_i; LAS float* xp = xch + xp_i;
        const float* ropeN = (const float*)(ws + WS_ROPE); const float* ropeD = ropeN + 2048 * 16;
        const int d0 = 32 * (wc & 1) + 8 * fq;
        if (pn <= 4) {
            const bool nrm0 = (pn != 2), nrm1 = (pn < 2);
            if (pn != 2) {
#pragma unroll
                for (int ai = 0; ai < 2; ++ai)
#pragma unroll
                    for (int m = 0; m < 4; ++m)
#pragma unroll
                        for (int bj = 0; bj < 2; ++bj) { const f32x4 a = acc[ai][bj][m][0], c = acc[ai][bj][m][1];
                            float ss = (a[0] * a[0] + a[1] * a[1]) + (a[2] * a[2] + a[3] * a[3]) + (c[0] * c[0] + c[1] * c[1]) + (c[2] * c[2] + c[3] * c[3]);
                            ss += __shfl_xor(ss, 16); ss += __shfl_xor(ss, 32);
                            if (fq == 0) xo[((ai * 4 + m) * 2 + bj) * 16] = ss; }
                asm volatile("s_waitcnt lgkmcnt(0)" ::: "memory"); __builtin_amdgcn_s_barrier(); asm volatile("" ::: "memory");
            }
            const float* gg = pn < 2 ? g_nq : (g_nk + (pn == 3 ? 64 : 128));
            f32x4 g0 = {1.f, 1.f, 1.f, 1.f}, g1 = g0;
            if (pn != 2) { g0 = *(const f32x4*)(gg + d0); g1 = *(const f32x4*)(gg + d0 + 4); }
            const bool ropew = (wc & 1) == 0;
#pragma unroll
            for (int ai = 0; ai < 2; ++ai)
#pragma unroll
                for (int m = 0; m < 4; ++m) {
                    const int t = t0 + ai * HALF + m * 16;
                    f32x4 cs0 = {1.f, 0.f, 1.f, 0.f}, cs1 = cs0, cs2 = cs0, cs3 = cs0;
                    if (pn != 2 && ropew && fq < 2) { const f32x4* rp = (const f32x4*)(ropeN + t * 16); cs0 = rp[0]; cs1 = rp[1]; cs2 = rp[2]; cs3 = rp[3]; }
#pragma unroll
                    for (int bj = 0; bj < 2; ++bj) {
                        const bool donorm = bj == 0 ? nrm0 : nrm1;
                        f32x4 ya = acc[ai][bj][m][0], yb = acc[ai][bj][m][1];
                        u32x4 w0, w1;
                        if (donorm) {
                            const float rstd = rsqrtf((xo[((ai * 4 + m) * 2 + bj) * 16] + xp[((ai * 4 + m) * 2 + bj) * 16]) * (1.f / 64.f) + EPS);
                            ya = ya * rstd * g0; yb = yb * rstd * g1;
                            w0.x = pk2(ya[0], ya[1]); w0.y = pk2(ya[2], ya[3]); w0.z = pk2(yb[0], yb[1]); w0.w = pk2(yb[2], yb[3]);
                            f32x4 ra = ya, rb = yb;
                            if (ropew) {
                                f32x4 pa, pb;
#pragma unroll
                                for (int i = 0; i < 4; ++i) { pa[i] = __shfl_xor(ya[i], 16); pb[i] = __shfl_xor(yb[i], 16); }
                                if (fq == 0) { ra[0] = ya[0] * cs0[0] - pa[0] * cs0[1]; ra[1] = ya[1] * cs0[2] - pa[1] * cs0[3]; ra[2] = ya[2] * cs1[0] - pa[2] * cs1[1]; ra[3] = ya[3] * cs1[2] - pa[3] * cs1[3];
                                               rb[0] = yb[0] * cs2[0] - pb[0] * cs2[1]; rb[1] = yb[1] * cs2[2] - pb[1] * cs2[3]; rb[2] = yb[2] * cs3[0] - pb[2] * cs3[1]; rb[3] = yb[3] * cs3[2] - pb[3] * cs3[3]; }
                                else if (fq == 1) { ra[0] = pa[0] * cs0[1] + ya[0] * cs0[0]; ra[1] = pa[1] * cs0[3] + ya[1] * cs0[2]; ra[2] = pa[2] * cs1[1] + ya[2] * cs1[0]; ra[3] = pa[3] * cs1[3] + ya[3] * cs1[2];
                                                    rb[0] = pb[0] * cs2[1] + yb[0] * cs2[0]; rb[1] = pb[1] * cs2[3] + yb[1] * cs2[2]; rb[2] = pb[2] * cs3[1] + yb[2] * cs3[0]; rb[3] = pb[3] * cs3[3] + yb[3] * cs3[2]; }
                            }
                            w1.x = pk2(ra[0], ra[1]); w1.y = pk2(ra[2], ra[3]); w1.z = pk2(rb[0], rb[1]); w1.w = pk2(rb[2], rb[3]);
                        } else { w0.x = pk2(ya[0], ya[1]); w0.y = pk2(ya[2], ya[3]); w0.z = pk2(yb[0], yb[1]); w0.w = pk2(yb[2], yb[3]); w1 = w0; }
                        const int hq = 2 * bj + (wc >> 1);
                        if (pn < 2) { const size_t off = (((size_t)b * 8 + 4 * pn + hq) * SEQ + t) * 64 + d0;
                            *(u32x4*)((bf16_t*)(ws + WS_QN) + off) = w0; }
                        else { const int six = 2 * (pn - 2) + bj; const size_t base = six == 0 ? WS_KC : six == 1 ? WS_VC : six == 2 ? WS_KS : six == 3 ? WS_VS : six == 4 ? WS_KW : WS_VW;
                            const size_t off = (((size_t)b * 2 + (wc >> 1)) * SEQ + t) * 64 + d0;
                            *(u32x4*)((bf16_t*)(ws + base) + off) = w1; }
                    }
                    asm volatile("" ::: "memory");
                }
        } else if (pn <= 8) {
            const bool isq = pn <= 6; const float* gg = isq ? g_dq : g_dk; bf16_t* dst = (bf16_t*)(ws + (isq ? WS_DQ : WS_DK));
            const f32x4 g0 = *(const f32x4*)(gg + 8 * fq), g1 = *(const f32x4*)(gg + 8 * fq + 4);
#pragma unroll
            for (int ai = 0; ai < 2; ++ai)
#pragma unroll
                for (int m = 0; m < 4; ++m) {
                    const int t = t0 + ai * HALF + m * 16;
                    f32x4 c0 = {1.f, 0.f, 1.f, 0.f}, c1 = c0;
                    if (fq == 0) { const f32x4* rp = (const f32x4*)(ropeD + t * 8); c0 = rp[0]; c1 = rp[1]; }
#pragma unroll
                    for (int bj = 0; bj < 2; ++bj) {
                        f32x4 ya = acc[ai][bj][m][0], yb = acc[ai][bj][m][1];
                        float ss = (ya[0] * ya[0] + ya[1] * ya[1]) + (ya[2] * ya[2] + ya[3] * ya[3]) + (yb[0] * yb[0] + yb[1] * yb[1]) + (yb[2] * yb[2] + yb[3] * yb[3]);
                        ss += __shfl_xor(ss, 16); ss += __shfl_xor(ss, 32);
                        const float rstd = rsqrtf(ss * (1.f / 32.f) + EPS);
                        ya = ya * rstd * g0; yb = yb * rstd * g1;
                        if (fq == 0) { const f32x4 a = ya, bb = yb;
                            ya[0] = a[0] * c0[0] - bb[0] * c0[1]; yb[0] = a[0] * c0[1] + bb[0] * c0[0]; ya[1] = a[1] * c0[2] - bb[1] * c0[3]; yb[1] = a[1] * c0[3] + bb[1] * c0[2];
                            ya[2] = a[2] * c1[0] - bb[2] * c1[1]; yb[2] = a[2] * c1[1] + bb[2] * c1[0]; ya[3] = a[3] * c1[2] - bb[3] * c1[3]; yb[3] = a[3] * c1[3] + bb[3] * c1[2]; }
                        u32x4 w; w.x = pk2(ya[0], ya[1]); w.y = pk2(ya[2], ya[3]); w.z = pk2(yb[0], yb[1]); w.w = pk2(yb[2], yb[3]);
                        const int hd = 4 * ((pn - 5) & 1) + 2 * bj + (wc >> 1);
                        *(u32x4*)(dst + (((size_t)b * 8 + hd) * SEQ + t) * 64 + d0) = w;
                    }
                    asm volatile("" ::: "memory");
                }
        } else if (pn <= 10) {
            bf16_t* dst = (bf16_t*)(ws + WS_DV);
#pragma unroll
            for (int ai = 0; ai < 2; ++ai)
#pragma unroll
                for (int m = 0; m < 4; ++m) { const int t = t0 + ai * HALF + m * 16;
#pragma unroll
                    for (int bj = 0; bj < 2; ++bj) { const f32x4 ya = acc[ai][bj][m][0], yb = acc[ai][bj][m][1];
                        u32x4 w; w.x = pk2(ya[0], ya[1]); w.y = pk2(ya[2], ya[3]); w.z = pk2(yb[0], yb[1]); w.w = pk2(yb[2], yb[3]);
                        const int hd = 4 * (pn - 9) + 2 * bj + (wc >> 1);
                        *(u32x4*)(dst + (((size_t)b * 8 + hd) * SEQ + t) * 64 + d0) = w; }
                    asm volatile("" ::: "memory"); }
        } else {
            if (wc == 0 && fq < 3) {
                float* gt = (float*)(ws + WS_GATES);
#pragma unroll
                for (int ai = 0; ai < 2; ++ai)
#pragma unroll
                    for (int m = 0; m < 4; ++m) { const size_t tok = (size_t)tok0 + wr * 64 + fr + ai * HALF + m * 16; const f32x4 ya = acc[ai][0][m][0], yb = acc[ai][0][m][1]; f32x4 sa, sb;
#pragma unroll
                        for (int i = 0; i < 4; ++i) { sa[i] = 1.f / (1.f + __expf(-ya[i])); sb[i] = 1.f / (1.f + __expf(-yb[i])); }
                        *(f32x4*)(gt + tok * 24 + 8 * fq) = sa; *(f32x4*)(gt + tok * 24 + 8 * fq + 4) = sb; }
            }
        }
    }
};
struct EpiFp8 {
    static constexpr bool PERM = true;
    unsigned char* O; int ldc;
    DI void operator()(const f32x4 (&acc)[2][2][4][2], const Unit& u, int wr, int wc, int fr, int fq) const {
        asm volatile("" : "+v"(fr), "+v"(fq));
        const int row0 = u.pm * BM + wr * 64 + fr; const int col0 = u.pn * BM + wc * 32 + 8 * fq;
#pragma unroll
        for (int ai = 0; ai < 2; ++ai)
#pragma unroll
            for (int m = 0; m < 4; ++m) { unsigned char* rowp = O + (size_t)(row0 + ai * HALF + m * 16) * ldc + col0;
#pragma unroll
                for (int bj = 0; bj < 2; ++bj) { const f32x4 v0 = acc[ai][bj][m][0], v1 = acc[ai][bj][m][1];
                    u32x2 w; w.x = pk4_fp8(v0[0], v0[1], v0[2], v0[3]); w.y = pk4_fp8(v1[0], v1[1], v1[2], v1[3]);
                    *(u32x2*)(rowp + bj * HALF) = w; } }
    }
};
struct EpiSwiglu {
    static constexpr bool PERM = true;
    unsigned char* O;
    DI void operator()(const f32x4 (&acc)[2][2][4][2], const Unit& u, int wr, int wc, int fr, int fq) const {
        asm volatile("" : "+v"(fr), "+v"(fq));
        const int row0 = u.pm * BM + wr * 64 + fr; const int col0 = u.pn * 128 + wc * 16 + 4 * fq;
#pragma unroll
        for (int ai = 0; ai < 2; ++ai)
#pragma unroll
            for (int m = 0; m < 4; ++m) { unsigned char* rowp = O + (size_t)(row0 + ai * HALF + m * 16) * EHID + col0;
#pragma unroll
                for (int bj = 0; bj < 2; ++bj) { const f32x4 g = acc[ai][bj][m][0], up = acc[ai][bj][m][1]; float h[4];
#pragma unroll
                    for (int i = 0; i < 4; ++i) { const float s = fast_rcp(1.f + __expf(-g[i])); h[i] = g[i] * s * up[i]; }
                    *(unsigned*)(rowp + bj * 64) = pk4_fp8(h[0], h[1], h[2], h[3]); } }
    }
};
struct EpiOutProj {
    static constexpr bool PERM = true;
    const float* x; bf16_t* x1b; const float* mod; float* rowss;
    DI void operator()(const f32x4 (&acc)[2][2][4][2], const Unit& u, int wr, int wc, int fr, int fq) const {
        const int col0 = u.pn * BM + wc * 32 + 8 * fq; const int b = (u.pm * BM) / SEQ;
        const float* g1 = mod + (size_t)b * 6144 + 2048 + col0;
        f32x4 gv[2][2];
#pragma unroll
        for (int bj = 0; bj < 2; ++bj)
#pragma unroll
            for (int n = 0; n < 2; ++n) gv[bj][n] = *(const f32x4*)(g1 + bj * HALF + n * 4);
#pragma unroll
        for (int ai = 0; ai < 2; ++ai)
#pragma unroll
            for (int m = 0; m < 4; ++m) { const int r = u.pm * BM + ai * HALF + wr * 64 + m * 16 + fr; const size_t off = (size_t)r * DM + col0; float ss = 0.f;
#pragma unroll
                for (int bj = 0; bj < 2; ++bj) { const f32x4 xa = ldnt4(x + off + bj * HALF), xb = ldnt4(x + off + bj * HALF + 4);
                    const f32x4 oa = xa + gv[bj][0] * acc[ai][bj][m][0], ob = xb + gv[bj][1] * acc[ai][bj][m][1];
                    ss += (oa[0] * oa[0] + oa[1] * oa[1]) + (oa[2] * oa[2] + oa[3] * oa[3]) + (ob[0] * ob[0] + ob[1] * ob[1]) + (ob[2] * ob[2] + ob[3] * ob[3]);
                    u32x4 w; w.x = pk2(oa[0], oa[1]); w.y = pk2(oa[2], oa[3]); w.z = pk2(ob[0], ob[1]); w.w = pk2(ob[2], ob[3]);
                    *(u32x4*)(x1b + off + bj * HALF) = w; }
                ss += __shfl_xor(ss, 16); ss += __shfl_xor(ss, 32);
                if (fq == 0) rowss[(size_t)r * 16 + u.pn * 4 + wc] = ss; }
    }
};
}

struct Frame {
    LAS unsigned char* lds; unsigned char* ws; const float* const* in; float* out;
    int tid, lane, wave, bid, G, gw, NGW;
};

DI int origcol(int n) { return n < 1280 ? n : (n < 2816 ? n + 24 : (n < 2840 ? n - 2816 + 1280 : -1)); }

template <class DRow>
DI void tr_item(const float* src, int src_ld, int sc  , bf16_t* dst, int dst_ld, int k0, LAS float* scr, int lane, DRow drow) {
#pragma unroll 8
    for (int i = 0; i < 32; ++i) { const int kk = 2 * i + (lane >> 5); scr[kk * 33 + (lane & 31)] = sc >= 0 ? src[(size_t)(k0 + kk) * src_ld + sc] : 0.f; }
    asm volatile("s_waitcnt lgkmcnt(0)" ::: "memory");
    const int c = lane & 7;
#pragma unroll
    for (int j = 0; j < 4; ++j) { const int n = (lane >> 3) + 8 * j; const LAS float* s = scr + (8 * c) * 33 + n;
        u32x4 o; o.x = pk2(s[0 * 33], s[1 * 33]); o.y = pk2(s[2 * 33], s[3 * 33]); o.z = pk2(s[4 * 33], s[5 * 33]); o.w = pk2(s[6 * 33], s[7 * 33]);
        *(u32x4*)(dst + (size_t)drow(n) * dst_ld + k0 + 8 * c) = o; }
    asm volatile("s_waitcnt lgkmcnt(0)" ::: "memory");
}

constexpr int TR_NITEMS = 16 * 96 + 16 * 32 + 2 * (32 * 16 * 16) + 32 * 8 * 32 + 4 * 16 * 8;
constexpr int TR_EARLY = 11264;
DI void phase0_weights(Frame& F, int first, int end, int worker, int nworkers);
DI void phase0(Frame& F) {
    const float* c_in = F.in[1]; const float* w_ada = F.in[2]; const float* b_ada = F.in[3];
    float* mod = (float*)(F.ws + WS_MOD);
    for (int it = F.bid; it < 96; it += F.G) {
        LAS float* cs = (LAS float*)F.lds;
        for (int idx = F.tid; idx < 32 * 1024; idx += NTHREADS) { const int b = idx >> 10, k = idx & 1023; cs[k * 32 + b] = c_in[idx]; }
        __syncthreads();
        float acc[32];
#pragma unroll
        for (int b = 0; b < 32; ++b) acc[b] = 0.f;
        const int j = it * 64 + F.lane;
#pragma unroll 1
        for (int kg = 0; kg < 4; ++kg) {
            float wv[32];
#pragma unroll
            for (int q = 0; q < 32; ++q) wv[q] = w_ada[(size_t)(F.wave * 128 + kg * 32 + q) * 6144 + j];
#pragma unroll
            for (int q = 0; q < 32; ++q) { const int k = F.wave * 128 + kg * 32 + q; const float w = wv[q];
#pragma unroll
                for (int b4 = 0; b4 < 8; ++b4) { const f32x4 cv = *(const LAS f32x4*)(cs + k * 32 + b4 * 4); acc[b4 * 4 + 0] += cv[0] * w; acc[b4 * 4 + 1] += cv[1] * w; acc[b4 * 4 + 2] += cv[2] * w; acc[b4 * 4 + 3] += cv[3] * w; } }
        }
        __syncthreads();
        LAS float* red = (LAS float*)F.lds;
#pragma unroll
        for (int b = 0; b < 32; ++b) red[(F.wave * 32 + b) * 64 + F.lane] = acc[b];
        __syncthreads();
        for (int o = F.tid; o < 2048; o += NTHREADS) { const int b = o >> 6, l = o & 63; float s = b_ada[it * 64 + l];
#pragma unroll
            for (int w = 0; w < 8; ++w) s += red[(w * 32 + b) * 64 + l];
            mod[(size_t)b * 6144 + it * 64 + l] = s; }
        __syncthreads();
    }
    if (F.G > 96) { if (F.bid >= 96) phase0_weights(F, 0, TR_EARLY, (F.bid - 96) * NWAVES + F.wave, (F.G - 96) * NWAVES); phase0_weights(F, TR_EARLY, TR_NITEMS, F.gw, F.NGW); }
    else phase0_weights(F, 0, TR_NITEMS, F.gw, F.NGW);
    const int gt = F.bid * NTHREADS + F.tid, NGT = F.G * NTHREADS;
    { float* ropeN = (float*)(F.ws + WS_ROPE); float* ropeD = ropeN + 2048 * 16;
      for (int i = gt; i < 2048 * 12; i += NGT) { const int t = i / 12, j = i % 12; const bool isn = j < 8; const int ii = isn ? j : j - 8;
          const float ex = isn ? (float)(2 * ii) / 16.f : (float)(2 * ii) / 8.f;
          const float inv = exp2f(-ex * 18.931568569324174f);
          const float ang = (float)t * inv;
          const double rev = (double)ang * 0.15915494309189535; const double fr = rev - __builtin_rint(rev); const float rr = (float)(fr * 6.283185307179586);
          const float cs = __cosf(rr), sn = __sinf(rr);
          if (isn) { ropeN[(t * 8 + ii) * 2] = cs; ropeN[(t * 8 + ii) * 2 + 1] = sn; } else { ropeD[(t * 4 + ii) * 2] = cs; ropeD[(t * 4 + ii) * 2 + 1] = sn; } } }
    { bf16_t* whi = (bf16_t*)(F.ws + WS_WR); bf16_t* wlo = whi + 48 * 1024;
      for (int i = gt; i < 48 * 1024; i += NGT) { const int c = i >> 10, k = i & 1023; float w = 0.f;
          if (c < 4) w = F.in[20][k * 4 + c]; else if (c < 36) w = F.in[22][k * 32 + (c - 4)];
          const unsigned short h = f2bf(w); whi[i] = h; wlo[i] = f2bf(w - bf2f(h)); } }
    { bf16_t* pe = (bf16_t*)(F.ws + WS_PE);
      for (int i = gt; i < 256 * 1024; i += NGT) { const int r = i >> 10, k = i & 1023; float v = 0.f; if (r < 4) v = F.in[9][(r >> 1) * 2048 + (r & 1) * 1024 + k]; pe[i] = f2bf(v); } }
    { u32x4* l4 = (u32x4*)(F.ws + WS_LIST); for (int i = gt; i < (int)(NEXP * ECAP / 4); i += NGT) l4[i] = (u32x4){0u, 0u, 0u, 0u};
      unsigned* ctl = (unsigned*)(F.ws + WS_CTL); for (int i = gt; i < 8192; i += NGT) ctl[i] = 0u; }
}

struct TrD { const float* src; int ld; int sc; bf16_t* dst; int dld; int k0; int mode; int n0; int aux; int fp8; };
DI TrD tr_desc(Frame& F, int it, int lane) {
    constexpr int I_IN = 16 * 96, I_OUT = 16 * 32, I_G = 32 * 16 * 16, I_D = 32 * 8 * 32;
    TrD d; int r = it; const int nq = lane & 7;
    if (r < I_IN) { const int kb = r / 96, nb = r % 96; d.n0 = nb * 32; const int n = d.n0 + 4 * nq; d.src = F.in[6]; d.ld = INCOLS; d.sc = origcol(n); d.dst = (bf16_t*)(F.ws + WS_WIN); d.dld = 1024; d.k0 = kb * 64; d.mode = 0; d.aux = 0; d.fp8 = 1; return d; }
    r -= I_IN;
    if (r < I_OUT) { const int kb = r / 32, nb = r % 32; d.n0 = nb * 32; d.src = F.in[19]; d.ld = 1024; d.sc = d.n0 + 4 * nq; d.dst = (bf16_t*)(F.ws + WS_WOUT); d.dld = 1024; d.k0 = kb * 64; d.mode = 0; d.aux = 0; d.fp8 = 0; return d; }
    r -= I_OUT;
    if (r < 2 * I_G) { const int up = r / I_G; r -= up * I_G; const int e = r / 256, q = r % 256, kb = q / 16, nb = q % 16; d.n0 = nb * 32;
        d.src = F.in[24 + up] + (size_t)e * 1024 * 512; d.ld = 512; d.sc = d.n0 + 4 * nq; d.dst = (bf16_t*)(F.ws + WS_WGU + (size_t)e * 1024 * 1024); d.dld = 1024; d.k0 = kb * 64; d.mode = 1; d.aux = up; d.fp8 = 1; return d; }
    r -= 2 * I_G;
    if (r < I_D) { const int e = r / 256, q = r % 256, kb = q / 32, nb = q % 32; d.n0 = nb * 32;
        d.src = F.in[26] + (size_t)e * 512 * 1024; d.ld = 1024; d.sc = d.n0 + 4 * nq; d.dst = (bf16_t*)(F.ws + WS_WD + (size_t)e * 1024 * 512); d.dld = 512; d.k0 = kb * 64; d.mode = 0; d.aux = 0; d.fp8 = 1; return d; }
    r -= I_D;
    { const int kvh = r / 128, q = r % 128, kb = q / 8, nb = q % 8; d.n0 = nb * 32; const int kv = kvh >> 1, half = kvh & 1;
      d.src = F.in[10] + (size_t)kv * 2048 * 256 + (size_t)half * 1024 * 256; d.ld = 256; d.sc = d.n0 + 4 * nq; d.dst = (bf16_t*)(F.ws + WS_WC1) + (size_t)kv * 512 * 1024; d.dld = 1024; d.k0 = kb * 64; d.mode = 2; d.aux = half; d.fp8 = 0; return d; }
}
DI void tr_load(const TrD& d, f32x4 (&v)[8], int lane) {
    const int kk = lane >> 3;
#pragma unroll
    for (int i = 0; i < 8; ++i) v[i] = d.sc >= 0 ? ldnt4(d.src + (size_t)(d.k0 + kk + 8 * i) * d.ld + d.sc) : (f32x4){0.f, 0.f, 0.f, 0.f};
}
DI void tr_finish(const TrD& d, const f32x4 (&v)[8], LAS float* scr, int lane) {
    const int kk = lane >> 3, nq = lane & 7;
#pragma unroll
    for (int i = 0; i < 8; ++i) *(LAS f32x4*)(scr + (kk + 8 * i) * 36 + 4 * nq) = v[i];
    asm volatile("s_waitcnt lgkmcnt(0)" ::: "memory");
    const int c = lane & 7;
#pragma unroll
    for (int j = 0; j < 4; ++j) { const int n = (lane >> 3) + 8 * j; const LAS float* s = scr + (8 * c) * 36 + n;
        const int jn = d.n0 + n; const int row = d.mode == 0 ? jn : (d.mode == 1 ? 8 * (jn >> 2) + (jn & 3) + 4 * d.aux : d.aux * 256 + jn);
        if (d.fp8) { u32x2 o8; o8.x = pk4_fp8(s[0 * 36] * 256.f, s[1 * 36] * 256.f, s[2 * 36] * 256.f, s[3 * 36] * 256.f); o8.y = pk4_fp8(s[4 * 36] * 256.f, s[5 * 36] * 256.f, s[6 * 36] * 256.f, s[7 * 36] * 256.f);
            *(u32x2*)((unsigned char*)d.dst + (size_t)row * d.dld + d.k0 + 8 * c) = o8; }
        else { u32x4 o; o.x = pk2(s[0 * 36], s[1 * 36]); o.y = pk2(s[2 * 36], s[3 * 36]); o.z = pk2(s[4 * 36], s[5 * 36]); o.w = pk2(s[6 * 36], s[7 * 36]);
            *(u32x4*)(d.dst + (size_t)row * d.dld + d.k0 + 8 * c) = o; } }
    asm volatile("s_waitcnt lgkmcnt(0)" ::: "memory");
}
DI void phase0_weights(Frame& F, int first, int end, int worker, int nworkers) {
    LAS float* scr = (LAS float*)(F.lds + F.wave * 16384);
    const int lane = F.lane;
    int it = first + worker; if (it >= end) return;
    TrD cur = tr_desc(F, it, lane); f32x4 vc[8]; tr_load(cur, vc, lane);
    for (;;) {
        const int nit = it + nworkers; const bool more = nit < end;
        TrD nxt = cur; f32x4 vn[8];
        if (more) { nxt = tr_desc(F, nit, lane); tr_load(nxt, vn, lane); }
        tr_finish(cur, vc, scr, lane);
        if (!more) break;
        cur = nxt; it = nit;
#pragma unroll
        for (int i = 0; i < 8; ++i) vc[i] = vn[i];
    }
}
DI void phase1(Frame& F) {
    const float* x = F.in[0]; const float* g = F.in[4]; const float* mod = (const float*)(F.ws + WS_MOD); unsigned char* h1 = (unsigned char*)(F.ws + WS_H1);
    const int lane = F.lane;
    for (int m0 = F.gw * 32; m0 < TOK; m0 += F.NGW * 32) {
        const int b = m0 >> 11; const float* sh = mod + (size_t)b * 6144; const float* sc = sh + 1024;
        f32x4 A[4], Bv[4];
#pragma unroll
        for (int j = 0; j < 4; ++j) { const int col = 4 * lane + 256 * j; A[j] = *(const f32x4*)(g + col) * (*(const f32x4*)(sc + col) + 1.f); Bv[j] = *(const f32x4*)(sh + col); }
        const f32x4* xr = (const f32x4*)(x + (size_t)m0 * DM) + lane; unsigned* o8 = (unsigned*)(h1 + (size_t)m0 * DM) + lane;
        f32x4 v0[4], v1[4];
#pragma unroll
        for (int j = 0; j < 4; ++j) { v0[j] = __builtin_nontemporal_load(xr + 64 * j); v1[j] = __builtin_nontemporal_load(xr + 256 + 64 * j); }
        for (int i = 0; i < 32; i += 2) {
            f32x4 n0[4], n1[4];
            if (i + 2 < 32) {
#pragma unroll
                for (int j = 0; j < 4; ++j) { n0[j] = __builtin_nontemporal_load(xr + (size_t)(i + 2) * 256 + 64 * j); n1[j] = __builtin_nontemporal_load(xr + (size_t)(i + 3) * 256 + 64 * j); }
            }
            float s0 = 0.f, s1 = 0.f;
#pragma unroll
            for (int j = 0; j < 4; ++j) { s0 += (v0[j][0] * v0[j][0] + v0[j][1] * v0[j][1]) + (v0[j][2] * v0[j][2] + v0[j][3] * v0[j][3]); s1 += (v1[j][0] * v1[j][0] + v1[j][1] * v1[j][1]) + (v1[j][2] * v1[j][2] + v1[j][3] * v1[j][3]); }
#pragma unroll
            for (int o = 1; o < 64; o <<= 1) { s0 += __shfl_xor(s0, o); s1 += __shfl_xor(s1, o); }
            const float r0 = rsqrtf(s0 * (1.f / DM) + EPS), r1 = rsqrtf(s1 * (1.f / DM) + EPS);
#pragma unroll
            for (int j = 0; j < 4; ++j) { const f32x4 y0 = v0[j] * r0 * A[j] + Bv[j], y1 = v1[j] * r1 * A[j] + Bv[j];
                o8[(size_t)i * 256 + 64 * j] = pk4_fp8(y0[0], y0[1], y0[2], y0[3]); o8[(size_t)(i + 1) * 256 + 64 * j] = pk4_fp8(y1[0], y1[1], y1[2], y1[3]); }
#pragma unroll
            for (int j = 0; j < 4; ++j) { v0[j] = n0[j]; v1[j] = n1[j]; }
        }
    }
}

DI void phase3(Frame& F) {
    const bf16_t* proj = (const bf16_t*)(F.ws + WS_PROJ);
    const float* ropeN = (const float*)(F.ws + WS_ROPE); const float* ropeD = ropeN + 2048 * 16;
    const float* g_nq = F.in[7]; const float* g_nk = F.in[8]; const float* g_dq = F.in[12]; const float* g_dk = F.in[13];
    const int lane = F.lane;
    for (int it = F.gw; it < TOK * 6; it += F.NGW) {
        const int m = it / 6, part = it % 6; const int b = m >> 11, t = m & 2047;
        const int c0 = part * 512 + lane * 8;
        const u32x4 raw = *(const u32x4*)(proj + (size_t)m * NPROJ + c0);
        float v[8]; v[0] = bflo(raw.x); v[1] = bfhi(raw.x); v[2] = bflo(raw.y); v[3] = bfhi(raw.y); v[4] = bflo(raw.z); v[5] = bfhi(raw.z); v[6] = bflo(raw.w); v[7] = bfhi(raw.w);
        float ss = 0.f;
#pragma unroll
        for (int i = 0; i < 8; ++i) ss += v[i] * v[i];
        ss += __shfl_xor(ss, 1); ss += __shfl_xor(ss, 2); const float ss32 = ss; ss += __shfl_xor(ss, 4); const float ss64 = ss;
        float pv[8];
#pragma unroll
        for (int i = 0; i < 8; ++i) pv[i] = __shfl_xor(v[i], 1);
        if (c0 < 1280) {
            const bool isq = c0 < 512; int six = 0, gsel = 0, d0;
            if (isq) { d0 = c0 & 63; } else { const int cc = c0 - 512; six = cc >> 7; gsel = (cc >> 6) & 1; d0 = cc & 63; }
            const bool donorm = isq || six == 2 || six == 4;
            float y[8];
            if (donorm) { const float* gg = isq ? g_nq : (g_nk + (six == 2 ? 64 : 128)); const float rstd = rsqrtf(ss64 * (1.f / 64.f) + EPS);
#pragma unroll
                for (int i = 0; i < 8; ++i) { y[i] = v[i] * rstd * gg[d0 + i]; pv[i] = pv[i] * rstd * gg[(d0 ^ 8) + i]; } }
            else {
#pragma unroll
                for (int i = 0; i < 8; ++i) y[i] = v[i]; }
            float yr[8];
#pragma unroll
            for (int i = 0; i < 8; ++i) yr[i] = y[i];
            if (donorm && d0 < 16) {
#pragma unroll
                for (int i = 0; i < 8; ++i) { const float cs = ropeN[(t * 8 + i) * 2], sn = ropeN[(t * 8 + i) * 2 + 1];
                    yr[i] = d0 == 0 ? (y[i] * cs - pv[i] * sn) : (pv[i] * sn + y[i] * cs); }
            }
            u32x4 w0, w1; w0.x = pk2(y[0], y[1]); w0.y = pk2(y[2], y[3]); w0.z = pk2(y[4], y[5]); w0.w = pk2(y[6], y[7]);
            w1.x = pk2(yr[0], yr[1]); w1.y = pk2(yr[2], yr[3]); w1.z = pk2(yr[4], yr[5]); w1.w = pk2(yr[6], yr[7]);
            if (isq) { const int hd = c0 >> 6; const size_t off = (((size_t)b * 8 + hd) * SEQ + t) * 64 + d0;
                *(u32x4*)((bf16_t*)(F.ws + WS_QN) + off) = w0; *(u32x4*)((bf16_t*)(F.ws + WS_QR) + off) = w1; }
            else { const size_t base = six == 0 ? WS_KC : six == 1 ? WS_VC : six == 2 ? WS_KS : six == 3 ? WS_VS : six == 4 ? WS_KW : WS_VW;
                const size_t off = (((size_t)b * 2 + gsel) * SEQ + t) * 64 + d0;
                *(u32x4*)((bf16_t*)(F.ws + base) + off) = donorm ? w1 : w0; }
        } else if (c0 < 2304) {
            const bool isq = c0 < 1792; const int cc = c0 - (isq ? 1280 : 1792); const int hd = cc >> 6, dd = cc & 63, d0 = dd & 31;
            const float* gg = isq ? g_dq : g_dk; const float rstd = rsqrtf(ss32 * (1.f / 32.f) + EPS);
            float y[8];
#pragma unroll
            for (int i = 0; i < 8; ++i) y[i] = v[i] * rstd * gg[d0 + i];
            if (d0 == 0) {
#pragma unroll
                for (int i = 0; i < 4; ++i) { const float cs = ropeD[(t * 4 + i) * 2], sn = ropeD[(t * 4 + i) * 2 + 1]; const float a = y[i], bb = y[i + 4]; y[i] = a * cs - bb * sn; y[i + 4] = a * sn + bb * cs; }
            }
            u32x4 w; w.x = pk2(y[0], y[1]); w.y = pk2(y[2], y[3]); w.z = pk2(y[4], y[5]); w.w = pk2(y[6], y[7]);
            const size_t off = (((size_t)b * 8 + hd) * SEQ + t) * 64 + dd;
            *(u32x4*)((bf16_t*)(F.ws + (isq ? WS_DQ : WS_DK)) + off) = w;
        } else if (c0 < 2816) {
            const int cc = c0 - 2304; const int hd = cc >> 6, dd = cc & 63; const size_t off = (((size_t)b * 8 + hd) * SEQ + t) * 64 + dd;
            *(u32x4*)((bf16_t*)(F.ws + WS_DV) + off) = raw;
        } else if (c0 < 2840) {
            float* gt = (float*)(F.ws + WS_GATES) + (size_t)m * 24 + (c0 - 2816);
#pragma unroll
            for (int i = 0; i < 8; ++i) gt[i] = 1.f / (1.f + __expf(-v[i]));
        }
    }
}

DI void glds16(const void* gsrc, unsigned lds_dst) { unsigned keep;
    asm volatile("s_mov_b32 %0, m0\n\ts_mov_b32 m0, %2\n\ts_nop 0\n\tglobal_load_lds_dwordx4 %1, off\n\ts_mov_b32 m0, %0" : "=&s"(keep) : "v"(gsrc), "s"(lds_dst) : "memory"); }
DI unsigned lds_addr(const LAS void* p) { return (unsigned)(uintptr_t)p; }
struct ALane { int k0; int v0; DI int ko(int ks) const { return k0 ^ (ks << 5); } DI int vo(int db) const { return v0 ^ (db << 6); } };
DI ALane alane_init(int lane) {
    ALane L; const int r = lane & 31, hh = lane >> 5, g = lane >> 4, i = lane & 15;
    L.k0 = r * 128 + ((hh ^ ((r >> 1) & 7)) << 4);
    const int rl = 4 * hh + (i >> 2); const int ch = 2 * (g & 1) + ((i & 3) >> 1);
    L.v0 = rl * 128 + ((ch ^ (((rl >> 1) & 1) << 2)) << 4) + 8 * (i & 1);
    return L;
}
DI s16x4 vtr(const LAS char* p) { typedef short v4i16 __attribute__((ext_vector_type(4))); return __builtin_bit_cast(s16x4, __builtin_amdgcn_ds_read_tr16_b64_v4i16((LAS v4i16*)p)); }
DI bf16x8 vfrag(const LAS char* Vt, const ALane& L, int db, int kb, int s) {
    const LAS char* p = Vt + L.vo(db) + (32 * kb + 16 * s) * 128;
    const s16x4 lo = vtr(p), hi = vtr(p + 8 * 128);
    return __builtin_shufflevector(lo, hi, 0, 1, 2, 3, 4, 5, 6, 7);
}
DI bf16x8 pfrag(const f32x16& p, int s) { u32x4 w; w.x = pk2(p[8 * s + 0], p[8 * s + 1]); w.y = pk2(p[8 * s + 2], p[8 * s + 3]); w.z = pk2(p[8 * s + 4], p[8 * s + 5]); w.w = pk2(p[8 * s + 6], p[8 * s + 7]); return __builtin_bit_cast(bf16x8, w); }
DI u32x4 tile_ld(const bf16_t* g, int tid) { return *(const u32x4*)(g + tid * 8); }
DI void tile_st_k(LAS char* Kt, u32x4 v, int tid) { const int row = tid >> 3, ch = tid & 7; *(LAS u32x4*)(Kt + row * 128 + ((ch ^ ((row >> 1) & 7)) << 4)) = v; }
DI void tile_st_v(LAS char* Vt, u32x4 v, int tid) { const int row = tid >> 3, ch = tid & 7; *(LAS u32x4*)(Vt + row * 128 + ((ch ^ (((row >> 1) & 1) << 2)) << 4)) = v; }

constexpr int MK_NONE = 0, MK_LE = 1, MK_GT = 2;
template <int MASK>
DI void sm16(f32x16& a, float c2, float mcl, int kb, int hh, int th) {
    if constexpr (MASK != MK_NONE) asm volatile("" : "+v"(th));
#pragma unroll
    for (int i = 0; i < 16; ++i) {
        float x = __builtin_fmaf(a[i], c2, -mcl);
        if constexpr (MASK != MK_NONE) { const int kl = 32 * kb + crow(i, hh); const bool ok = MASK == MK_LE ? (kl <= th) : (kl > th); x = ok ? x : -1.0e30f; }
        a[i] = fast_exp2(x);
    }
}
DI float sum16(const f32x16& a) { return ((a[0] + a[1]) + (a[2] + a[3])) + ((a[4] + a[5]) + (a[6] + a[7])) + ((a[8] + a[9]) + (a[10] + a[11])) + ((a[12] + a[13]) + (a[14] + a[15])); }
#define SCHED_FENCE() do { } while (0)
template <int MASK, bool KEEPP>
DI void attn_tile64(const LAS char* Kt, const LAS char* Vt, const ALane& L, const bf16x8 (&qf)[4], f32x16 (&O)[2], float& lsum, float c2, float mcl, int th, int hh, f32x16 (&P)[2]) {
    bf16x8 kf[2][4];
#pragma unroll
    for (int kb = 0; kb < 2; ++kb)
#pragma unroll
        for (int ks = 0; ks < 4; ++ks) kf[kb][ks] = *(const LAS bf16x8*)(Kt + L.ko(ks) + kb * 4096);
    SCHED_FENCE();
    f32x16 a0 = {0.f, 0.f, 0.f, 0.f, 0.f, 0.f, 0.f, 0.f, 0.f, 0.f, 0.f, 0.f, 0.f, 0.f, 0.f, 0.f}, a1 = a0;
#pragma unroll
    for (int ks = 0; ks < 4; ++ks) a0 = MFMA32(kf[0][ks], qf[ks], a0);
#pragma unroll
    for (int ks = 0; ks < 4; ++ks) a1 = MFMA32(kf[1][ks], qf[ks], a1);
    bf16x8 v0[2][2], v1[2][2];
#pragma unroll
    for (int s = 0; s < 2; ++s)
#pragma unroll
        for (int db = 0; db < 2; ++db) v0[s][db] = vfrag(Vt, L, db, 0, s);
    SCHED_FENCE();
    bf16x8 pf[2][2];
    sm16<MASK>(a0, c2, mcl, 0, hh, th); lsum += sum16(a0); pf[0][0] = pfrag(a0, 0); pf[0][1] = pfrag(a0, 1);
    if constexpr (KEEPP) P[0] = a0;
#pragma unroll
    for (int s = 0; s < 2; ++s)
#pragma unroll
        for (int db = 0; db < 2; ++db) v1[s][db] = vfrag(Vt, L, db, 1, s);
    SCHED_FENCE();
    sm16<MASK>(a1, c2, mcl, 1, hh, th); lsum += sum16(a1); pf[1][0] = pfrag(a1, 0); pf[1][1] = pfrag(a1, 1);
    if constexpr (KEEPP) P[1] = a1;
    SCHED_FENCE();
#pragma unroll
    for (int s = 0; s < 2; ++s)
#pragma unroll
        for (int db = 0; db < 2; ++db) O[db] = MFMA32(v0[s][db], pf[0][s], O[db]);
#pragma unroll
    for (int s = 0; s < 2; ++s)
#pragma unroll
        for (int db = 0; db < 2; ++db) O[db] = MFMA32(v1[s][db], pf[1][s], O[db]);
    SCHED_FENCE();
}
template <int MASK>
DI void attn_tile_dm(const LAS char* Kt, const LAS char* Vt, const ALane& L, int ko0, int ko1, const bf16x8 (&qf)[2], f32x16 (&O)[2], float& lsum, float c2, float mc, int th, int hh) {
    const bf16x8 k00 = *(const LAS bf16x8*)(Kt + ko0), k01 = *(const LAS bf16x8*)(Kt + ko1), k10 = *(const LAS bf16x8*)(Kt + ko0 + 4096), k11 = *(const LAS bf16x8*)(Kt + ko1 + 4096);
    SCHED_FENCE();
    f32x16 a0 = {0.f, 0.f, 0.f, 0.f, 0.f, 0.f, 0.f, 0.f, 0.f, 0.f, 0.f, 0.f, 0.f, 0.f, 0.f, 0.f}, a1 = a0;
    a0 = MFMA32(k00, qf[0], a0); a0 = MFMA32(k01, qf[1], a0); a1 = MFMA32(k10, qf[0], a1); a1 = MFMA32(k11, qf[1], a1);
    bf16x8 vf[2][2][2];
#pragma unroll
    for (int kb = 0; kb < 2; ++kb)
#pragma unroll
        for (int s = 0; s < 2; ++s)
#pragma unroll
            for (int db = 0; db < 2; ++db) vf[kb][s][db] = vfrag(Vt, L, db, kb, s);
    SCHED_FENCE();
    bf16x8 pf[2][2];
    sm16<MASK>(a0, c2, mc, 0, hh, th); lsum += sum16(a0); pf[0][0] = pfrag(a0, 0); pf[0][1] = pfrag(a0, 1);
    sm16<MASK>(a1, c2, mc, 1, hh, th); lsum += sum16(a1); pf[1][0] = pfrag(a1, 0); pf[1][1] = pfrag(a1, 1);
    SCHED_FENCE();
#pragma unroll
    for (int kb = 0; kb < 2; ++kb)
#pragma unroll
        for (int s = 0; s < 2; ++s)
#pragma unroll
            for (int db = 0; db < 2; ++db) O[db] = MFMA32(vf[kb][s][db], pf[kb][s], O[db]);
    SCHED_FENCE();
}
#define RING_WAIT(n) asm volatile("s_waitcnt vmcnt(" #n ")" ::: "memory")
template <class PreF, class CompF>
DI void attn_ring(LAS char* lds, const bf16_t* Kg, const bf16_t* Vg, unsigned tiles, int wid, int lane, PreF pre, CompF comp) {
    if (tiles == 0u) return;
    const int p = wid * 64 + lane, row = p >> 3, c = p & 7;
    const unsigned ksrc = (unsigned)(row * 128 + ((c ^ ((row >> 1) & 7)) << 4)), vsrc = (unsigned)(row * 128 + ((c ^ (((row >> 1) & 1) << 2)) << 4));
    LAS char* wb = lds + wid * 1024;
#define RING_ISSUE(j, slot) do { \
        glds16((const char*)(Kg) + (size_t)(j) * 8192 + ksrc, (unsigned)__builtin_amdgcn_readfirstlane((int)(lds_addr(wb) + (unsigned)(slot) * 16384u))); \
        glds16((const char*)(Vg) + (size_t)(j) * 8192 + vsrc, (unsigned)__builtin_amdgcn_readfirstlane((int)(lds_addr(wb) + (unsigned)(slot) * 16384u + 8192u))); } while (0)
    int q0 = __builtin_ctz(tiles); tiles &= tiles - 1u;
    int q1 = -1, q2 = -1;
    if (tiles) { q1 = __builtin_ctz(tiles); tiles &= tiles - 1u; }
    if (tiles) { q2 = __builtin_ctz(tiles); tiles &= tiles - 1u; }
    RING_ISSUE(q0, 0);
    if (q1 >= 0) RING_ISSUE(q1, 1);
    if (q2 >= 0) RING_ISSUE(q2, 2);
    pre();
    int i = 0;
    for (;;) {
        if (q2 >= 0) RING_WAIT(4); else if (q1 >= 0) RING_WAIT(2); else RING_WAIT(0);
        __builtin_amdgcn_s_barrier();
        int q3 = -1;
        if (tiles) { q3 = __builtin_ctz(tiles); tiles &= tiles - 1u; RING_ISSUE(q3, (i + 3) & 3); }
        LAS char* st = lds + (i & 3) * 16384;
        comp(q0, st, st + 8192);
        if (q1 < 0) break;
        q0 = q1; q1 = q2; q2 = q3; ++i;
    }
    asm volatile("s_waitcnt lgkmcnt(0)" ::: "memory");
    __builtin_amdgcn_s_barrier();
#undef RING_ISSUE
}

DI void diff_unit(Frame& F, int b, int hd, int qb, float c2, float mc, float lam) {
    const int tid = F.tid, lane = F.lane, wid = F.wave, r = lane & 31, hh = lane >> 5;
    const int rb = wid >> 1, mp = wid & 1;
    const bf16_t* Q = (const bf16_t*)(F.ws + WS_DQ) + ((size_t)b * 8 + hd) * SEQ * 64;
    const bf16_t* Kg = (const bf16_t*)(F.ws + WS_DK) + ((size_t)b * 8 + hd) * SEQ * 64;
    const bf16_t* Vg = (const bf16_t*)(F.ws + WS_DV) + ((size_t)b * 8 + hd) * SEQ * 64;
    LAS char* lds = (LAS char*)F.lds;
    const ALane L = alane_init(lane);
    const int ko0 = L.ko(2 * mp), ko1 = L.ko(2 * mp + 1);
    const int q0w = qb * 128 + rb * 32; const int qq = q0w + r;
    bf16x8 qf[2];
#pragma unroll
    for (int ks = 0; ks < 2; ++ks) qf[ks] = *(const bf16x8*)(Q + (size_t)qq * 64 + mp * 32 + ks * 16 + hh * 8);
    f32x16 O[2]; float lsum = 0.f;
#pragma unroll
    for (int i = 0; i < 16; ++i) { O[0][i] = 0.f; O[1][i] = 0.f; }
    const int ntile = 2 * qb + 2; const int jmax = 2 * qb + (rb >> 1);
    const unsigned tiles = ntile == 32 ? 0xffffffffu : ((1u << ntile) - 1u);
    attn_ring(lds, Kg, Vg, tiles, wid, lane, [&]() __attribute__((always_inline)) { asm volatile("" : "+v"(qf[0]), "+v"(qf[1])); },
        [&](int j, const LAS char* Kt, const LAS char* Vt) __attribute__((always_inline)) {
        if (j < jmax) attn_tile_dm<MK_NONE>(Kt, Vt, L, ko0, ko1, qf, O, lsum, c2, mc, 0, hh);
        else if (j == jmax) attn_tile_dm<MK_LE>(Kt, Vt, L, ko0, ko1, qf, O, lsum, c2, mc, qq - 64 * j, hh);
    });
    lsum += __shfl_xor(lsum, 32);
    LAS float* xo = (LAS float*)(lds + 65536 + rb * 8192) + lane;
    if (mp == 1) { const float s1 = lam / lsum;
#pragma unroll
        for (int db = 0; db < 2; ++db)
#pragma unroll
            for (int i = 0; i < 16; ++i) xo[(db * 16 + i) * 64] = O[db][i] * s1; }
    __syncthreads();
    if (mp == 0) {
        const float i0 = 1.f / lsum; float ss = 0.f;
#pragma unroll
        for (int db = 0; db < 2; ++db)
#pragma unroll
            for (int i = 0; i < 16; ++i) { const float o = O[db][i] * i0 - xo[(db * 16 + i) * 64]; O[db][i] = o; ss += o * o; }
        ss += __shfl_xor(ss, 32);
        const float rstd = rsqrtf(ss * (1.f / 64.f) + EPS) * 0.8f;
        const float* go = F.in[18];
        bf16_t* orow = (bf16_t*)(F.ws + WS_AO) + ((size_t)b * SEQ + qq) * DM + 512 + hd * 64;
#pragma unroll
        for (int db = 0; db < 2; ++db)
#pragma unroll
            for (int g4 = 0; g4 < 4; ++g4) { const int d = 32 * db + 8 * g4 + 4 * hh; const f32x4 gv = *(const f32x4*)(go + d);
                u32x2 w; w.x = pk2(O[db][4 * g4] * rstd * gv[0], O[db][4 * g4 + 1] * rstd * gv[1]); w.y = pk2(O[db][4 * g4 + 2] * rstd * gv[2], O[db][4 * g4 + 3] * rstd * gv[3]);
                *(u32x2*)(orow + d) = w; }
    }
}

#define NSA_BAR() do { asm volatile("s_waitcnt lgkmcnt(0)" ::: "memory"); __builtin_amdgcn_s_barrier(); asm volatile("" ::: "memory"); } while (0)
DI void nsa_unit(Frame& F, int b, int g, int qb, float c2, float mc) {
    const int lane = F.lane, wid = F.wave, r = lane & 31, hh = lane >> 5;
    const int hd = 4 * g + (wid >> 1); const int tl = 32 * (wid & 1) + r; const int t = 64 * qb + tl;
    LAS char* lds = (LAS char*)F.lds;
    LAS float* impP = (LAS float*)(lds + 65536);
    LAS unsigned* selm = (LAS unsigned*)(lds + LDS_MISC + 5120);
    LAS float* invs = (LAS float*)(selm + 128);
    LAS float* otp = (LAS float*)(lds + 65536 + wid * 8192) + lane;
    LAS float* gpark = (LAS float*)(lds + LDS_MISC + 8192 + wid * 768) + lane;
    const ALane L = alane_init(lane);
    const size_t bg = (size_t)b * 2 + g;
    bf16x8 qf[4];
    { const bf16_t* QN = (const bf16_t*)(F.ws + WS_QN) + (((size_t)b * 8 + hd) * SEQ + t) * 64;
#pragma unroll
      for (int ks = 0; ks < 4; ++ks) qf[ks] = *(const bf16x8*)(QN + ks * 16 + hh * 8);
      const float* gates = (const float*)(F.ws + WS_GATES) + ((size_t)b * SEQ + t) * 24 + hd * 3;
      const float g0_ = gates[0], g1_ = gates[1], g2_ = gates[2]; gpark[0] = g0_; gpark[64] = g1_; gpark[128] = g2_; }
    const char* KcB = (const char*)(F.ws + WS_KCMP) + bg * 16384; const char* VcB = (const char*)(F.ws + WS_VCMP) + bg * 16384;
    const char* KsB = (const char*)(F.ws + WS_KS) + bg * (SEQ * 128); const char* VsB = (const char*)(F.ws + WS_VS) + bg * (SEQ * 128);
    const char* KwB = (const char*)(F.ws + WS_KW) + bg * (SEQ * 128); const char* VwB = (const char*)(F.ws + WS_VW) + bg * (SEQ * 128);
    const int nf = qb == 0 ? 1 : (qb == 1 ? 2 : 3); const int f1 = qb == 1 ? 1 : qb - 1, f2 = qb;
    const unsigned fmask = 1u | (qb >= 1 ? (1u << qb) : 0u) | (qb >= 2 ? (1u << (qb - 1)) : 0u);
    const unsigned allb = qb == 31 ? 0xffffffffu : ((1u << (qb + 1)) - 1u);
    unsigned grest = qb <= 5 ? (allb & ~fmask) : 0u;
    const int jlo = qb >= 4 ? qb - 4 : 0;
    int gph = 0, gi = 0;
    const int p_ = wid * 64 + lane, prow = p_ >> 3, pc = p_ & 7;
    const unsigned ksrc = (unsigned)(prow * 128 + ((pc ^ ((prow >> 1) & 7)) << 4)), vsrc = (unsigned)(prow * 128 + ((pc ^ (((prow >> 1) & 1) << 2)) << 4));
    const unsigned wbase = lds_addr(lds) + (unsigned)wid * 1024u;
#define NSA_GEN(ty, jj) do { ty = -1; jj = 0; \
        if (gph == 0) { ty = 0; jj = gi; if (++gi == 2) { gph = 1; gi = 0; } } \
        else if (gph == 1) { ty = 1; jj = gi == 0 ? 0 : (gi == 1 ? f1 : f2); if (++gi == nf) gph = 2; } \
        else { if (gph == 2) { if (grest) { ty = 1; jj = __builtin_ctz(grest); grest &= grest - 1u; } else { gph = 3; gi = jlo; } } \
               if (gph == 3) { if (gi <= qb) { ty = 2; jj = gi++; } else gph = 4; } } } while (0)
#define NSA_ISSUE(ty, jj, slot) do { const char* kp_ = ty == 0 ? KcB : (ty == 1 ? KsB : KwB); const char* vp_ = ty == 0 ? VcB : (ty == 1 ? VsB : VwB); \
        glds16(kp_ + (size_t)(jj) * 8192 + ksrc, (unsigned)__builtin_amdgcn_readfirstlane((int)(wbase + (unsigned)(slot) * 16384u))); \
        glds16(vp_ + (size_t)(jj) * 8192 + vsrc, (unsigned)__builtin_amdgcn_readfirstlane((int)(wbase + (unsigned)(slot) * 16384u + 8192u))); } while (0)
    int t0, j0, t1, j1, t2, j2;
    NSA_GEN(t0, j0); NSA_GEN(t1, j1); NSA_GEN(t2, j2);
    NSA_ISSUE(t0, j0, 0); NSA_ISSUE(t1, j1, 1); if (t2 >= 0) NSA_ISSUE(t2, j2, 2);
#pragma unroll
    for (int ks = 0; ks < 4; ++ks) asm volatile("" : "+v"(qf[ks]));
    f32x16 O[2]; float lv = 0.f; float carry_in = 0.f; unsigned mym = 0u; bool inB = false;
#pragma unroll
    for (int i = 0; i < 16; ++i) { O[0][i] = 0.f; O[1][i] = 0.f; }
    const int nvalid = t >= 31 ? ((t - 31) >> 4) + 1 : 0;
    for (int n = 0;; ++n) {
        if (t2 >= 0) RING_WAIT(4); else if (t1 >= 0) RING_WAIT(2); else RING_WAIT(0);
        __builtin_amdgcn_s_barrier();
        int t3, j3;
        NSA_GEN(t3, j3);
        if (t3 >= 0) NSA_ISSUE(t3, j3, (n + 3) & 3);
        const LAS char* Kt = lds + (n & 3) * 16384; const LAS char* Vt = Kt + 8192;
        int mode = MK_LE, th = tl; float mcl = mc;
        if (t0 == 0) { th = nvalid - 1 - 64 * j0; }
        else if (t0 == 1) { mcl = ((mym >> j0) & 1u) ? mc : 1.0e30f; mode = j0 < qb ? MK_NONE : MK_LE; }
        else {
            if (inB) {
                float lsum = lv; lsum += __shfl_xor(lsum, 32); const float s1 = gpark[64] / lsum;
#pragma unroll
                for (int db = 0; db < 2; ++db)
#pragma unroll
                    for (int i = 0; i < 16; ++i) { otp[(db * 16 + i) * 64] += O[db][i] * s1; O[db][i] = 0.f; }
                lv = 0.f; inB = false;
            }
            mode = j0 == qb ? MK_LE : (j0 == qb - 4 ? MK_GT : MK_NONE);
        }
        if (t0 != 0) {
            f32x16 Pd[2];
            if (mode == MK_NONE) attn_tile64<MK_NONE, false>(Kt, Vt, L, qf, O, lv, c2, mcl, 0, hh, Pd);
            else if (mode == MK_LE) attn_tile64<MK_LE, false>(Kt, Vt, L, qf, O, lv, c2, mcl, th, hh, Pd);
            else attn_tile64<MK_GT, false>(Kt, Vt, L, qf, O, lv, c2, mcl, th, hh, Pd);
        } else {
            f32x16 P[2];
            attn_tile64<MK_LE, true>(Kt, Vt, L, qf, O, lv, c2, mcl, th, hh, P);
            LAS float* ip = impP + ((wid >> 1) * 64 + tl) * 33;
            float av[8], rc[8];
#pragma unroll
            for (int kb = 0; kb < 2; ++kb)
#pragma unroll
                for (int gq = 0; gq < 4; ++gq) { const int f = 4 * kb + gq; const float p3 = 0.5f * P[kb][4 * gq + 3]; av[f] = P[kb][4 * gq] + P[kb][4 * gq + 1] + P[kb][4 * gq + 2] + p3; rc[f] = __shfl_xor(p3, 32); }
#pragma unroll
            for (int f = 0; f < 8; ++f) { const float carry = hh == 1 ? rc[f] : (f > 0 ? rc[f > 0 ? f - 1 : 0] : carry_in); ip[2 * (8 * j0 + f) + hh] = av[f] + carry; }
            carry_in = rc[7];
            if (j0 == 1) {
                {
                    const f32x4* rp = (const f32x4*)((const float*)(F.ws + WS_ROPE) + t * 16);
                    const f32x4 r0 = rp[0], r1 = rp[1], r2 = rp[2], r3 = rp[3];
                    const u32x4 own = __builtin_bit_cast(u32x4, qf[0]);
                    u32x4 oth; oth.x = (unsigned)__shfl_xor((int)own.x, 32); oth.y = (unsigned)__shfl_xor((int)own.y, 32); oth.z = (unsigned)__shfl_xor((int)own.z, 32); oth.w = (unsigned)__shfl_xor((int)own.w, 32);
                    const float a[8] = {bflo(own.x), bfhi(own.x), bflo(own.y), bfhi(own.y), bflo(own.z), bfhi(own.z), bflo(own.w), bfhi(own.w)};
                    const float p[8] = {bflo(oth.x), bfhi(oth.x), bflo(oth.y), bfhi(oth.y), bflo(oth.z), bfhi(oth.z), bflo(oth.w), bfhi(oth.w)};
                    const float cs[8] = {r0[0], r0[2], r1[0], r1[2], r2[0], r2[2], r3[0], r3[2]}, sn[8] = {r0[1], r0[3], r1[1], r1[3], r2[1], r2[3], r3[1], r3[3]};
                    float o[8];
#pragma unroll
                    for (int i = 0; i < 8; ++i) o[i] = hh == 0 ? (a[i] * cs[i] - p[i] * sn[i]) : (p[i] * sn[i] + a[i] * cs[i]);
                    u32x4 w; w.x = pk2(o[0], o[1]); w.y = pk2(o[2], o[3]); w.z = pk2(o[4], o[5]); w.w = pk2(o[6], o[7]);
                    qf[0] = __builtin_bit_cast(bf16x8, w); }
                float lsum = lv; lsum += __shfl_xor(lsum, 32);
                const float inv = lsum > 0.f ? 1.f / lsum : 0.f;
                if (hh == 0) invs[(wid >> 1) * 64 + tl] = inv;
                const float s0 = gpark[0] * inv;
                lv = 0.f;
                NSA_BAR();
                if (wid == 0) {
                    unsigned m;
                    if (qb <= 5) m = allb;
                    else {
                        m = fmask;
                        float best[3] = {-1.f, -1.f, -1.f}; int bi[3] = {0, 0, 0}; const float iv0 = invs[lane], iv1 = invs[64 + lane], iv2 = invs[128 + lane], iv3 = invs[192 + lane];
                        for (int j = 1; j <= qb - 2; ++j) {
                            const float v = (impP[(0 * 64 + lane) * 33 + j] * iv0 + impP[(1 * 64 + lane) * 33 + j] * iv1) + (impP[(2 * 64 + lane) * 33 + j] * iv2 + impP[(3 * 64 + lane) * 33 + j] * iv3);
                            if (v > best[0]) { best[2] = best[1]; bi[2] = bi[1]; best[1] = best[0]; bi[1] = bi[0]; best[0] = v; bi[0] = j; }
                            else if (v > best[1]) { best[2] = best[1]; bi[2] = bi[1]; best[1] = v; bi[1] = j; }
                            else if (v > best[2]) { best[2] = v; bi[2] = j; }
                        }
                        m |= (1u << bi[0]) | (1u << bi[1]) | (1u << bi[2]);
                    }
                    selm[lane] = m;
                    unsigned u = m;
#pragma unroll
                    for (int o = 1; o < 64; o <<= 1) u |= (unsigned)__shfl_xor((int)u, o);
                    if (lane == 0) selm[64] = u;
                }
                NSA_BAR();
                mym = selm[tl];
                if (qb > 5) grest = (unsigned)__builtin_amdgcn_readfirstlane((int)selm[64]) & ~fmask;
#pragma unroll
                for (int db = 0; db < 2; ++db)
#pragma unroll
                    for (int i = 0; i < 16; ++i) { otp[(db * 16 + i) * 64] = O[db][i] * s0; O[db][i] = 0.f; }
                inB = true;
            }
        }
        if (t1 < 0) break;
        t0 = t1; j0 = j1; t1 = t2; j1 = j2; t2 = t3; j2 = j3;
    }
    {
        float lsum = lv; lsum += __shfl_xor(lsum, 32); const float s2 = gpark[128] / lsum;
#pragma unroll
        for (int db = 0; db < 2; ++db)
#pragma unroll
            for (int i = 0; i < 16; ++i) O[db][i] = otp[(db * 16 + i) * 64] + O[db][i] * s2;
    }
    bf16_t* orow = (bf16_t*)(F.ws + WS_AO) + ((size_t)b * SEQ + t) * DM + hd * 64;
#pragma unroll
    for (int db = 0; db < 2; ++db)
#pragma unroll
        for (int g4 = 0; g4 < 4; ++g4) { const int d = 32 * db + 8 * g4 + 4 * hh;
            u32x2 w; w.x = pk2(O[db][4 * g4], O[db][4 * g4 + 1]); w.y = pk2(O[db][4 * g4 + 2], O[db][4 * g4 + 3]);
            *(u32x2*)(orow + d) = w; }
    NSA_BAR();
#undef NSA_GEN
#undef NSA_ISSUE
}

DI float gmax(const float* g, int n, int lane) { float v = lane < n ? fabsf(g[lane]) : 0.f;
#pragma unroll
    for (int o = 1; o < 64; o <<= 1) v = fmaxf(v, __shfl_xor(v, o));
    return v; }

DI int queue_next(Frame& F, unsigned* ctr) {
    LAS int* slot = (LAS int*)(F.lds + LDS_MISC + 4096);
    __syncthreads();
    if (F.tid == 0) *slot = (int)atomicAdd(ctr, 1u);
    __syncthreads();
    return *slot;
}

DI int queue_pass(Frame& F, unsigned nx) {
    LAS int* slot = (LAS int*)(F.lds + LDS_MISC + 4096);
    __syncthreads();
    if (F.tid == 0) *slot = (int)nx;
    __syncthreads();
    return *slot;
}

DI float gelu_tanh(float x) { const float u = 0.7978845608028654f * (x + 0.044715f * x * x * x); const float e = __expf(2.f * u); const float th = 1.f - 2.f / (e + 1.f); return 0.5f * x * (1.f + th); }
DI void phase5(Frame& F) {
    const bf16_t* UL = (const bf16_t*)(F.ws + WS_UL); const float* w2 = F.in[11]; const float* gk0 = F.in[8];
    LAS float* w2s = (LAS float*)F.lds;
    LAS float* hid = (LAS float*)(F.lds + LDS_MISC + 8192 + F.wave * 1024);
    for (int i = F.tid; i < 2 * 256 * 64 / 4; i += NTHREADS) ((LAS f32x4*)w2s)[i] = ((const f32x4*)w2)[i];
    __syncthreads();
    const int lane = F.lane;
    for (int it0 = F.gw * 8; it0 < 2 * 64 * 128; it0 += F.NGW * 8) {
        const int kv = it0 >> 13, rem0 = it0 & 8191, bgi = rem0 >> 7, c0 = rem0 & 127;
        const size_t perow = 16384 + (size_t)kv * 256 + (size_t)kv * 2;
        const u32x2 pu = *(const u32x2*)(UL + perow * 512 + 4 * lane), pl = *(const u32x2*)(UL + (perow + 1) * 512 + 256 + 4 * lane);
        const size_t row0 = (size_t)kv * 8192 + (size_t)bgi * 128 + c0;
        u32x2 uu[8], ll[8];
#pragma unroll
        for (int q = 0; q < 8; ++q) { const size_t row = row0 + q; const bool ok = c0 + q < 127;
            uu[q] = ok ? *(const u32x2*)(UL + row * 512 + 4 * lane) : (u32x2){0u, 0u}; ll[q] = ok ? *(const u32x2*)(UL + (row + 1) * 512 + 256 + 4 * lane) : (u32x2){0u, 0u}; }
        const LAS float* w = w2s + kv * 256 * 64 + lane;
#pragma unroll 1
        for (int q = 0; q < 8; ++q) {
            const int c = c0 + q;
            bf16_t* dst = (bf16_t*)(F.ws + (kv ? WS_VCMP : WS_KCMP)) + ((size_t)bgi * 128 + c) * 64;
            u32x2 u4 = uu[0], l4 = ll[0];
#pragma unroll
            for (int z = 1; z < 8; ++z) { if (q == z) { u4 = uu[z]; l4 = ll[z]; } }
            if (c == 127) { dst[lane] = 0; continue; }
            float h[4];
            h[0] = bflo(u4.x) + bflo(l4.x) + bflo(pu.x) + bflo(pl.x); h[1] = bfhi(u4.x) + bfhi(l4.x) + bfhi(pu.x) + bfhi(pl.x);
            h[2] = bflo(u4.y) + bflo(l4.y) + bflo(pu.y) + bflo(pl.y); h[3] = bfhi(u4.y) + bfhi(l4.y) + bfhi(pu.y) + bfhi(pl.y);
            f32x4 hv;
#pragma unroll
            for (int i = 0; i < 4; ++i) hv[i] = gelu_tanh(h[i]);
            *(LAS f32x4*)(hid + 4 * lane) = hv;
            asm volatile("s_waitcnt lgkmcnt(0)" ::: "memory");
            float acc0 = 0.f, acc1 = 0.f;
#pragma unroll 8
            for (int k = 0; k < 256; k += 4) { const f32x4 hh4 = *(const LAS f32x4*)(hid + k);
                acc0 += hh4[0] * w[(k + 0) * 64]; acc1 += hh4[1] * w[(k + 1) * 64]; acc0 += hh4[2] * w[(k + 2) * 64]; acc1 += hh4[3] * w[(k + 3) * 64]; }
            float acc = acc0 + acc1;
            if (kv == 0) { const float ss = wave_sum(acc * acc); acc = acc * rsqrtf(ss * (1.f / 64.f) + EPS) * gk0[lane]; }
            dst[lane] = f2bf(acc);
            asm volatile("s_waitcnt lgkmcnt(0)" ::: "memory");
        }
    }
    __syncthreads();
}

DI void phase8(Frame& F) {
    const bf16_t* x1 = (const bf16_t*)(F.ws + WS_X1B); const float* gf = F.in[5]; const float* mod = (const float*)(F.ws + WS_MOD); const float* rowss = (const float*)(F.ws + WS_ROWSS);
    const char* wsrc = (const char*)(F.ws + WS_WR);
    unsigned char* h2 = (unsigned char*)(F.ws + WS_H2);
    unsigned* cnt = (unsigned*)(F.ws + WS_CTL) + CW_CNT; int* lists = (int*)(F.ws + WS_LIST);
    int* tipos = (int*)(F.ws + WS_TIPOS); int* tie = (int*)(F.ws + WS_TIE); float* tiw = (float*)(F.ws + WS_TIW);
    const float* brg = F.in[21]; const float* bre = F.in[23];
    const int lane = F.lane, wid = F.wave, row = lane & 15, kq = lane >> 4;
    LAS char* wl = (LAS char*)F.lds;
    LAS float* lg = (LAS float*)(F.lds + 98304 + wid * 3072);
    LAS float* A2 = (LAS float*)(F.lds + 122880);
    LAS float* B2 = A2 + 1024;
    LAS unsigned* hist = (LAS unsigned*)(F.lds + LDS_MISC + 8192);
    unsigned wso[6];
#pragma unroll
    for (int i = 0; i < 6; ++i) { const int s = i * 512 + F.tid, part = s / 1536, r = (s >> 5) % 48, cs = s & 31; wso[i] = (unsigned)(part * 98304 + r * 2048 + ((cs ^ (r & 15)) << 4)); }
#define P8_ISSUE(kc, buf) do { _Pragma("unroll") for (int i_ = 0; i_ < 6; ++i_) \
        __builtin_amdgcn_global_load_lds((const unsigned*)(wsrc + (size_t)(kc) * 512 + wso[i_]), (LAS unsigned*)(wl + (buf) * 49152 + i_ * 8192 + wid * 1024), 16, 0, 0); } while (0)
    const int nbatch = TOK / 128;
    for (int bt = F.bid; bt < nbatch; bt += F.G) {
        const int m0 = bt * 128 + wid * 16; const int m = m0 + row; const int b = m0 >> 11;
        P8_ISSUE(0, 0);
        { const float* sh = mod + (size_t)b * 6144 + 3072; const float* sc = sh + 1024;
          for (int k = F.tid; k < 1024; k += NTHREADS) { A2[k] = gf[k] * (sc[k] + 1.f); B2[k] = sh[k]; } }
        if (F.tid < 64) hist[F.tid] = 0u;
        float rs = 0.f; { const f32x4* rp = (const f32x4*)(rowss + (size_t)m * 16);
#pragma unroll
            for (int q = 0; q < 4; ++q) { const f32x4 v = rp[q]; rs += (v[0] + v[1]) + (v[2] + v[3]); } }
        const float rstd = rsqrtf(rs * (1.f / DM) + EPS);
        const bf16_t* xrow = x1 + (size_t)m * DM + 8 * kq; unsigned char* hrow = h2 + (size_t)m * DM + 8 * kq;
        u32x4 xw[4];
#pragma unroll
        for (int u = 0; u < 4; ++u) xw[u] = *(const u32x4*)(xrow + 32 * u);
        f32x4 acc[3] = {{0.f, 0.f, 0.f, 0.f}, {0.f, 0.f, 0.f, 0.f}, {0.f, 0.f, 0.f, 0.f}};
        for (int kc = 0; kc < 4; ++kc) {
            asm volatile("s_waitcnt vmcnt(0)" ::: "memory");
            __syncthreads();
            if (kc + 1 < 4) P8_ISSUE(kc + 1, (kc + 1) & 1);
            const LAS char* wb = wl + (kc & 1) * 49152;
#pragma unroll 1
            for (int g4 = 0; g4 < 2; ++g4) {
                const int gg = kc * 2 + g4;
                u32x4 nw[4];
                if (gg + 1 < 8) {
#pragma unroll
                    for (int u = 0; u < 4; ++u) nw[u] = *(const u32x4*)(xrow + 128 * (gg + 1) + 32 * u);
                }
#pragma unroll
                for (int u = 0; u < 4; ++u) {
                    const int k0 = 128 * gg + 32 * u + 8 * kq;
                    const f32x4 a0 = *(const LAS f32x4*)(A2 + k0), a1 = *(const LAS f32x4*)(A2 + k0 + 4), b0 = *(const LAS f32x4*)(B2 + k0), b1 = *(const LAS f32x4*)(B2 + k0 + 4);
                    const f32x4 xa_ = {bflo(xw[u].x), bfhi(xw[u].x), bflo(xw[u].y), bfhi(xw[u].y)}, xb_ = {bflo(xw[u].z), bfhi(xw[u].z), bflo(xw[u].w), bfhi(xw[u].w)};
                    const f32x4 ya = xa_ * rstd * a0 + b0, yb = xb_ * rstd * a1 + b1;
                    u32x4 hi; hi.x = pk2(ya[0], ya[1]); hi.y = pk2(ya[2], ya[3]); hi.z = pk2(yb[0], yb[1]); hi.w = pk2(yb[2], yb[3]);
                    { u32x2 h8; h8.x = pk4_fp8(ya[0], ya[1], ya[2], ya[3]); h8.y = pk4_fp8(yb[0], yb[1], yb[2], yb[3]); *(u32x2*)(hrow + 128 * gg + 32 * u) = h8; }
                    u32x4 lo; lo.x = pk2(ya[0] - bflo(hi.x), ya[1] - bfhi(hi.x)); lo.y = pk2(ya[2] - bflo(hi.y), ya[3] - bfhi(hi.y)); lo.z = pk2(yb[0] - bflo(hi.z), yb[1] - bfhi(hi.z)); lo.w = pk2(yb[2] - bflo(hi.w), yb[3] - bfhi(hi.w));
                    const bf16x8 ahi = __builtin_bit_cast(bf16x8, hi), alo = __builtin_bit_cast(bf16x8, lo);
                    const int ch = (g4 * 4 + u) * 4 + kq;
#pragma unroll
                    for (int ct = 0; ct < 3; ++ct) { const int r = 16 * ct + row; const int off = r * 512 + ((ch ^ row) << 4);
                        const bf16x8 bh = *(const LAS bf16x8*)(wb + off), bl = *(const LAS bf16x8*)(wb + 24576 + off);
                        acc[ct] = MFMA16(ahi, bh, acc[ct]); acc[ct] = MFMA16(alo, bh, acc[ct]); acc[ct] = MFMA16(ahi, bl, acc[ct]); }
                }
#pragma unroll
                for (int u = 0; u < 4; ++u) xw[u] = nw[u];
            }
        }
#pragma unroll
        for (int ct = 0; ct < 3; ++ct)
#pragma unroll
            for (int i = 0; i < 4; ++i) lg[(kq * 4 + i) * 48 + 16 * ct + row] = acc[ct][i];
        asm volatile("s_waitcnt lgkmcnt(0)" ::: "memory");
        int e0 = 0, e1 = 0; float w0 = 0.f, w1 = 0.f; unsigned lp0 = 0u, lp1 = 0u;
        if (lane < 16) {
            const LAS float* lr = lg + lane * 48;
            float g4v[4]; int grp = 0; float gm = -3.0e38f;
#pragma unroll
            for (int i = 0; i < 4; ++i) { g4v[i] = lr[i] + brg[i]; if (g4v[i] > gm) { gm = g4v[i]; grp = i; } }
            float den = 0.f;
#pragma unroll
            for (int i = 0; i < 4; ++i) den += __expf(g4v[i] - gm);
            const float pg = 1.f / den;
            float v0 = -3.0e38f, v1 = -3.0e38f; int i0 = 0, i1 = 0;
            for (int i = 0; i < 8; ++i) { const float v = lr[4 + grp * 8 + i] + bre[grp * 8 + i];
                if (v > v0) { v1 = v0; i1 = i0; v0 = v; i0 = i; } else if (v > v1) { v1 = v; i1 = i; } }
            const float ex = __expf(v1 - v0); w0 = pg / (1.f + ex); w1 = pg * ex / (1.f + ex);
            e0 = grp * 8 + i0; e1 = grp * 8 + i1;
            lp0 = atomicAdd((unsigned*)&hist[e0], 1u); lp1 = atomicAdd((unsigned*)&hist[e1], 1u);
        }
        __syncthreads();
        if (F.tid < 32) { const unsigned n = hist[F.tid]; hist[32 + F.tid] = n ? atomicAdd(cnt + F.tid, n) : 0u; }
        __syncthreads();
        if (lane < 16) {
            const int tok = m0 + lane; const int p0 = (int)(hist[32 + e0] + lp0), p1 = (int)(hist[32 + e1] + lp1);
            lists[(size_t)e0 * ECAP + p0] = tok; lists[(size_t)e1 * ECAP + p1] = tok;
            tipos[2 * tok] = p0; tipos[2 * tok + 1] = p1; tie[tok] = e0 | (e1 << 8); tiw[2 * tok] = w0; tiw[2 * tok + 1] = w1;
        }
        __syncthreads();
    }
#undef P8_ISSUE
}

DI LAS int* moe_prefix(Frame& F) {
    LAS int* tb = (LAS int*)(F.lds + LDS_MISC);
    __syncthreads();
    if (F.wave == 0) {
        const unsigned* cnt = (const unsigned*)(F.ws + WS_CTL) + CW_CNT; const int l = F.lane;
        int v = l < 32 ? (int)((__hip_atomic_load(cnt + l, __ATOMIC_RELAXED, __HIP_MEMORY_SCOPE_AGENT) + 255u) >> 8) : 0;
#pragma unroll
        for (int o = 1; o < 32; o <<= 1) { const int u = __shfl_up(v, o); if (l >= o) v += u; }
        if (l < 32) tb[l + 1] = v;
        if (l == 0) tb[0] = 0;
    }
    __syncthreads();
    return tb;
}

DI void phase11(Frame& F) {
    LAS int* tb = moe_prefix(F);
    const unsigned char* Y = (const unsigned char*)(F.ws + WS_Y); const float* mod = (const float*)(F.ws + WS_MOD);
    const int* tipos = (const int*)(F.ws + WS_TIPOS); const int* tie = (const int*)(F.ws + WS_TIE); const float* tiw = (const float*)(F.ws + WS_TIW);
    const int lane = F.lane;
    for (int m0 = F.gw * 32; m0 < TOK; m0 += F.NGW * 32) {
        const int b = m0 >> 11; const float* g2 = mod + (size_t)b * 6144 + 5120;
        f32x4 ga[2], gb[2];
#pragma unroll
        for (int j = 0; j < 2; ++j) { ga[j] = *(const f32x4*)(g2 + 8 * lane + 512 * j); gb[j] = *(const f32x4*)(g2 + 8 * lane + 512 * j + 4); }
        int mr0 = 0, mr1 = 0; float mw0 = 0.f, mw1 = 0.f;
        { const int mm = m0 + (lane & 31); const int ee = tie[mm]; mr0 = tb[ee & 255] * 256 + tipos[2 * mm]; mr1 = tb[ee >> 8] * 256 + tipos[2 * mm + 1]; mw0 = tiw[2 * mm]; mw1 = tiw[2 * mm + 1]; }
        float* obase = F.out + (size_t)m0 * DM + 8 * lane; const bf16_t* xbase = (const bf16_t*)(F.ws + WS_X1B) + (size_t)m0 * DM + 8 * lane;
#define P11_LOAD(i, ya, yb, xa, xb) do { const size_t r0_ = (size_t)__shfl(mr0, (i)), r1_ = (size_t)__shfl(mr1, (i)); \
            _Pragma("unroll") for (int j = 0; j < 2; ++j) { ya[j] = __builtin_nontemporal_load((const u32x2*)(Y + r0_ * DM + 8 * lane + 512 * j)); yb[j] = __builtin_nontemporal_load((const u32x2*)(Y + r1_ * DM + 8 * lane + 512 * j)); \
                const u32x4 xw_ = ldntu4(xbase + (size_t)(i) * DM + 512 * j); xa[j] = (f32x4){bflo(xw_.x), bfhi(xw_.x), bflo(xw_.y), bfhi(xw_.y)}; xb[j] = (f32x4){bflo(xw_.z), bfhi(xw_.z), bflo(xw_.w), bfhi(xw_.w)}; } } while (0)
        u32x2 ya0[2], yb0[2], ya1[2], yb1[2]; f32x4 xa0[2], xb0[2], xa1[2], xb1[2];
        P11_LOAD(0, ya0, yb0, xa0, xb0); P11_LOAD(1, ya1, yb1, xa1, xb1);
        for (int i = 0; i < 32; i += 2) {
            u32x2 nya0[2], nyb0[2], nya1[2], nyb1[2]; f32x4 nxa0[2], nxb0[2], nxa1[2], nxb1[2];
            if (i + 2 < 32) { P11_LOAD(i + 2, nya0, nyb0, nxa0, nxb0); P11_LOAD(i + 3, nya1, nyb1, nxa1, nxb1); }
#define P11_ROW(i, ya, yb, xa, xb) do { const float w0 = __shfl(mw0, (i)), w1 = __shfl(mw1, (i)); \
            _Pragma("unroll") for (int j = 0; j < 2; ++j) { f32x4 oa = xa[j], ob = xb[j]; \
                const f32x2 a01 = __builtin_amdgcn_cvt_pk_f32_fp8((int)ya[j].x, false), a23 = __builtin_amdgcn_cvt_pk_f32_fp8((int)ya[j].x, true), a45 = __builtin_amdgcn_cvt_pk_f32_fp8((int)ya[j].y, false), a67 = __builtin_amdgcn_cvt_pk_f32_fp8((int)ya[j].y, true); \
                const f32x2 b01 = __builtin_amdgcn_cvt_pk_f32_fp8((int)yb[j].x, false), b23 = __builtin_amdgcn_cvt_pk_f32_fp8((int)yb[j].x, true), b45 = __builtin_amdgcn_cvt_pk_f32_fp8((int)yb[j].y, false), b67 = __builtin_amdgcn_cvt_pk_f32_fp8((int)yb[j].y, true); \
                oa[0] += ga[j][0] * (w0 * a01[0] + w1 * b01[0]); oa[1] += ga[j][1] * (w0 * a01[1] + w1 * b01[1]); \
                oa[2] += ga[j][2] * (w0 * a23[0] + w1 * b23[0]); oa[3] += ga[j][3] * (w0 * a23[1] + w1 * b23[1]); \
                ob[0] += gb[j][0] * (w0 * a45[0] + w1 * b45[0]); ob[1] += gb[j][1] * (w0 * a45[1] + w1 * b45[1]); \
                ob[2] += gb[j][2] * (w0 * a67[0] + w1 * b67[0]); ob[3] += gb[j][3] * (w0 * a67[1] + w1 * b67[1]); \
                stnt4(obase + (size_t)(i) * DM + 512 * j, oa); stnt4(obase + (size_t)(i) * DM + 512 * j + 4, ob); } } while (0)
            P11_ROW(i, ya0, yb0, xa0, xb0); P11_ROW(i + 1, ya1, yb1, xa1, xb1);
#pragma unroll
            for (int j = 0; j < 2; ++j) { ya0[j] = nya0[j]; yb0[j] = nyb0[j]; xa0[j] = nxa0[j]; xb0[j] = nxb0[j]; ya1[j] = nya1[j]; yb1[j] = nyb1[j]; xa1[j] = nxa1[j]; xb1[j] = nxb1[j]; }
        }
#undef P11_LOAD
#undef P11_ROW
    }
}

constexpr int CW_BAR = 4096;
#define XB_TMO      128
#define XB_XCNT(j)  (256  + 64 * (j))
#define XB_XSUB(j)  (1280 + 64 * (j))
#define XB_XGEN(j)  (2304 + 64 * (j))
#define XB_TOP      3328
#define XB_TOPGEN   3392
#define XB_SPIN_CAP (1u << 22)
DI unsigned xb_ld(unsigned* p)              { return __hip_atomic_load(p, __ATOMIC_RELAXED, __HIP_MEMORY_SCOPE_AGENT); }
DI unsigned xb_add(unsigned* p, unsigned v) { return __hip_atomic_fetch_add(p, v, __ATOMIC_RELAXED, __HIP_MEMORY_SCOPE_AGENT); }
DI unsigned xb_xcc_id() { return (unsigned)__builtin_amdgcn_s_getreg((3 << 11) | 20) & 0xFu; }
#define XB_SPIN(cond, bar) do { unsigned _sp = 0; while (cond) { __builtin_amdgcn_s_sleep(1); \
    if ((++_sp & 255u) == 0u) { if (xb_ld(&(bar)[XB_TMO])) break; if (_sp > XB_SPIN_CAP) { atomicAdd(&(bar)[XB_TMO], 1u); break; } } } } while (0)
struct XcdBarrier { unsigned* bar; unsigned x; volatile LAS unsigned* st; };
DI XcdBarrier xcd_barrier_post(unsigned* bar, volatile LAS unsigned* st, bool leader) {
    XcdBarrier b; b.bar = bar; b.x = xb_xcc_id(); b.st = st;
    if (leader) (void)xb_add(&bar[XB_XCNT(b.x)], 1u);
    return b;
}
DI void xcd_barrier_complete(unsigned* bar, unsigned x, unsigned& nloc, unsigned& nx) {
    const unsigned G = gridDim.x;
    unsigned sum, cnt, mine, sp = 0u;
    for (;;) {
        sum = 0u; cnt = 0u; mine = 0u;
#pragma unroll
        for (unsigned j = 0; j < 16; ++j) { const unsigned c = xb_ld(&bar[XB_XCNT(j)]); sum += c; cnt += (c > 0u) ? 1u : 0u; mine = (j == x) ? c : mine; }
        if (sum == G) break;
        __builtin_amdgcn_s_sleep(1);
        if ((++sp & 255u) == 0u) { if (xb_ld(&bar[XB_TMO])) break; if (sp > XB_SPIN_CAP) { atomicAdd(&bar[XB_TMO], 1u); break; } }
    }
    nloc = mine > 0u ? mine : 1u; nx = cnt > 0u ? cnt : 1u;
}
DI void xcd_barrier(const XcdBarrier& b, bool leader) {
    asm volatile("s_waitcnt vmcnt(0)" ::: "memory");
    __syncthreads();
    if (leader) {
        unsigned* bar = b.bar;
        __builtin_amdgcn_s_waitcnt(0);
        unsigned nloc = b.st[0], nx = b.st[1];
        if (nloc == 0u) { xcd_barrier_complete(bar, b.x, nloc, nx); b.st[0] = nloc; b.st[1] = nx; }
        const unsigned old = xb_add(&bar[XB_XSUB(b.x)], 1u);
        const unsigned gen = old / nloc;
        if (old + 1u == (gen + 1u) * nloc) {
            __builtin_amdgcn_fence(__ATOMIC_RELEASE, "agent");
            asm volatile("s_waitcnt vmcnt(0)" ::: "memory");
            const unsigned og = xb_add(&bar[XB_TOP], 1u);
            const unsigned tg = og / nx;
            if (og + 1u == (tg + 1u) * nx) xb_add(&bar[XB_TOPGEN], 1u);
            else XB_SPIN(xb_ld(&bar[XB_TOPGEN]) == tg, bar);
            __builtin_amdgcn_fence(__ATOMIC_ACQUIRE, "agent");
            xb_add(&bar[XB_XGEN(b.x)], 1u);
            asm volatile("s_waitcnt vmcnt(0)" ::: "memory");
        } else {
            XB_SPIN(xb_ld(&bar[XB_XGEN(b.x)]) == gen, bar);
            __builtin_amdgcn_fence(__ATOMIC_ACQUIRE, "agent");
            asm volatile("s_waitcnt vmcnt(0)" ::: "memory");
        }
    }
    __syncthreads();
}

constexpr int NPHASE = 12;
__global__ void __launch_bounds__(NTHREADS, 2) hymba_fwd(Params p) {
    extern __shared__ __attribute__((aligned(16))) unsigned char lds_raw[];
    __builtin_assume(__builtin_amdgcn_workitem_id_y() == 0); __builtin_assume(__builtin_amdgcn_workitem_id_z() == 0);
    cg::grid_group grid = cg::this_grid();
    Frame F;
    F.lds = (LAS unsigned char*)lds_raw; F.ws = p.ws; F.in = p.in; F.out = p.out;
    F.wave = __builtin_amdgcn_readfirstlane(threadIdx.x >> 6); F.lane = lane_id_fresh(); F.tid = F.wave * 64 + F.lane; F.bid = blockIdx.x; F.G = gridDim.x;
    F.gw = F.bid * NWAVES + F.wave; F.NGW = F.G * NWAVES;
    const int lo = p.ph_lo, hi = p.ph_hi;
#define IN(k) (lo <= (k) && (k) < hi)
#ifdef PROBE_A
    LAS unsigned long long* ts_ = (LAS unsigned long long*)(F.lds + LDS_MISC + 7168);
#define STAMP(k) do { if (F.bid == 0 && F.tid == 0) ts_[k] = __builtin_amdgcn_s_memrealtime(); } while (0)
#else
#define STAMP(k) do { } while (0)
#endif
    STAMP(0);
    volatile LAS unsigned* xst = (volatile LAS unsigned*)(F.lds + LDS_MISC + 4112);
    if (F.tid == 0) { xst[0] = 0u; xst[1] = 0u; }
    __syncthreads();
    XcdBarrier xbar; xbar.bar = (unsigned*)(F.ws + WS_CTL) + CW_BAR; xbar.x = 0; xbar.st = xst;
#define SEAM(k) do { if (IN(k) && IN((k) + 1)) { if ((k) == 0) { grid.sync(); xbar = xcd_barrier_post((unsigned*)(F.ws + WS_CTL) + CW_BAR, xst, F.tid == 0); } else xcd_barrier(xbar, F.tid == 0); } F.lane = lane_id_fresh(); F.tid = F.wave * 64 + F.lane; STAMP((k) + 1); } while (0)
    LAS unsigned char* ring = F.lds; LAS unsigned* tokl = (LAS unsigned*)(F.lds + LDS_MISC + 256);
#ifdef DOUBLE_PHASE
#define NREP(k) ((k) == DOUBLE_PHASE ? 2 : 1)
#define REPSYNC(k, rep) do { if ((k) == DOUBLE_PHASE && (rep) == 0) grid.sync(); } while (0)
#else
#define NREP(k) 1
#define REPSYNC(k, rep) do { } while (0)
#endif

    if (IN(0)) for (int rep = 0; rep < NREP(0); ++rep) { phase0(F); REPSYNC(0, rep); }
    SEAM(0);
    if (IN(1)) for (int rep = 0; rep < NREP(1); ++rep) { phase1(F); REPSYNC(1, rep); }
    SEAM(1);
    if (IN(2)) for (int rep = 0; rep < NREP(2); ++rep) {
        pg8::StaticOrder S; S.init(TOK, NPROJ, DM / 2, F.G, F.bid, F.ws + WS_H1, F.ws + WS_WIN);
        pg8::EpiInProj E{F.ws, F.in[7], F.in[8], F.in[12], F.in[13], (LAS float*)(F.lds + LDS_MISC + 8192)};
        pg8::gemm_phase<pg8::EpiInProj, pg8::StaticOrder, false, true>(ring, tokl, DM / 2, S, E, F.wave, F.lane);
        REPSYNC(2, rep);
    }
    SEAM(2); STAMP(4);
    if (IN(4)) for (int rep = 0; rep < NREP(4); ++rep) {
        { pg8::CompressOrder S{F.G, F.bid, (const char*)(F.ws + WS_KC), (const char*)(F.ws + WS_PE), (const char*)(F.ws + WS_WC1)};
          pg8::EpiBf16 E{(bf16_t*)(F.ws + WS_UL), 512};
          pg8::gemm_phase<pg8::EpiBf16, pg8::CompressOrder, false>(ring, tokl, 1024, S, E, F.wave, F.lane); }
        const float mq = gmax(F.in[12], 32, F.lane), mk = gmax(F.in[13], 32, F.lane);
        const float bound = 5.656854249f * mq * mk * 1.02f; const float c2 = 0.17677669529663687f * 1.4426950408889634f; const float mc = bound * 1.4426950408889634f;
        float s1 = F.lane < 32 ? F.in[14][F.lane] * F.in[15][F.lane] : 0.f, s2 = F.lane < 32 ? F.in[16][F.lane] * F.in[17][F.lane] : 0.f;
        s1 = wave_sum(s1); s2 = wave_sum(s2);
        const float lam = __expf(s1) - __expf(s2) + 0.2f;
        unsigned* ctr = (unsigned*)(F.ws + WS_CTL) + CW_QDIFF + 32 * rep;
        for (int it = queue_next(F, ctr); it < 4096;) { unsigned nx = 0u; if (F.tid == 0) nx = atomicAdd(ctr, 1u);
            const int qb = 15 - (it >> 8), bh = it & 255; diff_unit(F, bh >> 3, bh & 7, qb, c2, mc, lam); it = queue_pass(F, nx); }
        REPSYNC(4, rep);
    }
    SEAM(4);
    if (IN(5)) for (int rep = 0; rep < NREP(5); ++rep) { phase5(F); REPSYNC(5, rep); }
    SEAM(5);
    if (IN(6)) for (int rep = 0; rep < NREP(6); ++rep) {
        const float mq = gmax(F.in[7], 64, F.lane); const float mk = fmaxf(gmax(F.in[8], 64, F.lane), fmaxf(gmax(F.in[8] + 64, 64, F.lane), gmax(F.in[8] + 128, 64, F.lane)));
        const float bound = 8.f * mq * mk * 1.02f; const float c2 = 0.125f * 1.4426950408889634f; const float mc = bound * 1.4426950408889634f;
        unsigned* ctr = (unsigned*)(F.ws + WS_CTL) + CW_QNSA + 32 * rep;
        for (int it = queue_next(F, ctr); it < 2048;) { unsigned nx = 0u; if (F.tid == 0) nx = atomicAdd(ctr, 1u);
            const int qb = 31 - (it >> 6), bg = it & 63; nsa_unit(F, bg >> 1, bg & 1, qb, c2, mc); it = queue_pass(F, nx); }
        REPSYNC(6, rep);
    }
    SEAM(6);
    if (IN(7)) for (int rep = 0; rep < NREP(7); ++rep) {
        pg8::StaticOrder S; S.init(TOK, DM, DM, F.G, F.bid, F.ws + WS_AO, F.ws + WS_WOUT);
        pg8::EpiOutProj E{F.in[0], (bf16_t*)(F.ws + WS_X1B), (const float*)(F.ws + WS_MOD), (float*)(F.ws + WS_ROWSS)};
        pg8::gemm_phase<pg8::EpiOutProj, pg8::StaticOrder, false>(ring, tokl, DM, S, E, F.wave, F.lane);
        REPSYNC(7, rep);
    }
    SEAM(7);
    if (IN(8)) phase8(F);
    SEAM(8);
    if (IN(9)) for (int rep = 0; rep < NREP(9); ++rep) {
        LAS int* tb = moe_prefix(F);
        pg8::MoeOrder S{F.G, F.bid, 0, tb, (const char*)(F.ws + WS_H2), (const char*)(F.ws + WS_WGU), (const int*)(F.ws + WS_LIST)};
        pg8::EpiSwiglu E{(unsigned char*)(F.ws + WS_HH)};
        pg8::gemm_phase<pg8::EpiSwiglu, pg8::MoeOrder, true, true>(ring, tokl, DM / 2, S, E, F.wave, F.lane);
        REPSYNC(9, rep);
    }
    SEAM(9);
    if (IN(10)) for (int rep = 0; rep < NREP(10); ++rep) {
        LAS int* tb = moe_prefix(F);
        pg8::MoeOrder S{F.G, F.bid, 1, tb, (const char*)(F.ws + WS_HH), (const char*)(F.ws + WS_WD), nullptr};
        pg8::EpiFp8 E{(unsigned char*)(F.ws + WS_Y), DM};
        pg8::gemm_phase<pg8::EpiFp8, pg8::MoeOrder, false, true>(ring, tokl, EHID / 2, S, E, F.wave, F.lane);
        REPSYNC(10, rep);
    }
    SEAM(10);
    if (IN(11)) phase11(F);
    grid.sync(); grid.sync(); grid.sync(); grid.sync(); grid.sync(); grid.sync(); grid.sync(); grid.sync();
#ifdef PROBE_A
    grid.sync(); STAMP(12);
    if (F.bid == 0 && F.tid == 0) {
        unsigned long long da = (ts_[PROBE_A + 1] - ts_[PROBE_A]) / 100ull, db = (ts_[PROBE_B + 1] - ts_[PROBE_B]) / 100ull;
        unsigned long long qa = (da + 5ull) / 10ull, qb2 = (db + 5ull) / 10ull; if (qa > 63ull) qa = 63ull; if (qb2 > 63ull) qb2 = 63ull;
        const unsigned long long target = ts_[0] + (6000ull + 16ull + 32ull * qa + 2048ull * qb2) * 100ull;
        while (__builtin_amdgcn_s_memrealtime() < target) __builtin_amdgcn_s_sleep(32);
    }
#endif
#undef IN
#undef SEAM
}

#ifndef MK_LAUNCHES
#define MK_LAUNCHES 1
#endif
extern "C" void kernel_launch(void* const* d_in, const int* in_sizes, int n_in, void* d_out, int out_size, void* d_ws, size_t ws_size, hipStream_t stream) {
    static int grid = 0;
    if (grid == 0) {
        if (n_in != 27 || ws_size < WS_END) { fprintf(stderr, "kernel_launch: unexpected inputs (n_in %d, ws %zu)\n", n_in, ws_size); grid = -1; return; }
        int dev = 0, cus = 0, per_cu = 0;
        hipGetDevice(&dev); hipDeviceGetAttribute(&cus, hipDeviceAttributeMultiprocessorCount, dev);
        hipFuncSetAttribute((const void*)hymba_fwd, hipFuncAttributeMaxDynamicSharedMemorySize, LDS_BYTES);
        hipOccupancyMaxActiveBlocksPerMultiprocessor(&per_cu, (const void*)hymba_fwd, NTHREADS, LDS_BYTES);
        if (per_cu < 1) { fprintf(stderr, "kernel_launch: occupancy query says %d blocks per CU\n", per_cu); per_cu = 1; }
        if (per_cu > 1) per_cu = 1;
        grid = cus * per_cu;
    }
    if (grid < 0) return;
    Params p{};
    for (int i = 0; i < 27; ++i) p.in[i] = (const float*)d_in[i];
    p.out = (float*)d_out; p.ws = (unsigned char*)d_ws;
    const int cuts[13] = {0, 1, 2, 3, 4, 5, 6, 7, 8, 9, 10, 11, 12};
    const int nl = MK_LAUNCHES == 1 ? 1 : NPHASE;
    for (int li = 0; li < nl; ++li) {
        p.ph_lo = nl == 1 ? 0 : cuts[li]; p.ph_hi = nl == 1 ? NPHASE : cuts[li + 1];
        void* args[] = {&p};
        hipError_t e = hipLaunchCooperativeKernel((const void*)hymba_fwd, dim3(grid), dim3(NTHREADS), args, LDS_BYTES, stream);
        if (e != hipSuccess) { fprintf(stderr, "cooperative launch failed: %s (grid %d)\n", hipGetErrorString(e), grid); break; }
    }
}
```

```cpp
#include <hip/hip_runtime.h>
#include <hip/hip_cooperative_groups.h>
#include <cstdint>
#include <cstdio>
namespace cg = cooperative_groups;

#define LAS __attribute__((address_space(3)))
#define DI __device__ __forceinline__
typedef unsigned short bf16_t;
typedef short bf16x8 __attribute__((ext_vector_type(8)));
typedef short s16x4 __attribute__((ext_vector_type(4)));
typedef float f32x2 __attribute__((ext_vector_type(2)));
typedef float f32x4 __attribute__((ext_vector_type(4)));
typedef float f32x16 __attribute__((ext_vector_type(16)));
typedef unsigned u32x2 __attribute__((ext_vector_type(2)));
typedef unsigned u32x4 __attribute__((ext_vector_type(4)));

constexpr int BATCH = 32, SEQ = 2048, DM = 1024, TOK = BATCH * SEQ;
constexpr int NPROJ = 3072;
constexpr int INCOLS = 2840;
constexpr int NEXP = 32, EHID = 512, ECAP = 65536;
constexpr float EPS = 1e-6f;
constexpr int NWAVES = 8, NTHREADS = 512;

constexpr size_t MiB = 1u << 20;
constexpr size_t WS_CTL = 0;
constexpr size_t WS_MOD = 1 * MiB;
constexpr size_t WS_ROPE = 2 * MiB;
constexpr size_t WS_WR = 3 * MiB;
constexpr size_t WS_WIN = 4 * MiB;
constexpr size_t WS_WOUT = 10 * MiB;
constexpr size_t WS_WC1 = 12 * MiB;
constexpr size_t WS_WGU = 16 * MiB;
constexpr size_t WS_WD = 80 * MiB;
constexpr size_t WS_LIST = 112 * MiB;
constexpr size_t WS_TIPOS = 120 * MiB;
constexpr size_t WS_TIE = WS_TIPOS + 512 * 1024;
constexpr size_t WS_TIW = WS_TIE + 256 * 1024;
constexpr size_t WS_ROWSS = 122 * MiB;
constexpr size_t WS_GATES = 126 * MiB;
constexpr size_t WS_KCMP = 132 * MiB;
constexpr size_t WS_VCMP = 133 * MiB;
constexpr size_t WS_UL = 134 * MiB;
constexpr size_t WS_A = 160 * MiB;
constexpr size_t WS_B = 288 * MiB;
constexpr size_t WS_C = 672 * MiB;
constexpr size_t WS_H1 = WS_A, WS_QN = WS_B + 128 * MiB, WS_QR = WS_B + 192 * MiB, WS_H2 = WS_A;
constexpr size_t WS_PROJ = WS_B, WS_AO = WS_B, WS_HH = WS_B, WS_Y = WS_B + 136 * MiB;
constexpr size_t WS_KC = WS_C, WS_VC = WS_C + 16 * MiB, WS_PE = WS_C + 32 * MiB, WS_KS = WS_C + 33 * MiB, WS_VS = WS_C + 49 * MiB,
                 WS_KW = WS_C + 65 * MiB, WS_VW = WS_C + 81 * MiB, WS_DQ = WS_C + 97 * MiB, WS_DK = WS_C + 161 * MiB, WS_DV = WS_C + 225 * MiB;
constexpr size_t WS_X1B = WS_C + 32 * MiB;
constexpr size_t WS_END = WS_C + 289 * MiB;
constexpr int CW_CNT = 0;
constexpr int CW_QDIFF = 64, CW_QNSA = 128;

constexpr int RING_BYTES = 131072;
constexpr int LDS_MISC = RING_BYTES;
constexpr int LDS_BYTES = 147456;

DI unsigned pk2(float lo, float hi) { typedef __bf16 b2 __attribute__((ext_vector_type(2))); f32x2 v = {lo, hi}; b2 b = __builtin_convertvector(v, b2); return __builtin_bit_cast(unsigned, b); }
DI unsigned short f2bf(float f) { return (unsigned short)(pk2(f, 0.f) & 0xffffu); }
DI float bf2f(unsigned short h) { return __uint_as_float((unsigned)h << 16); }
DI float bflo(unsigned w) { return __uint_as_float(w << 16); }
DI float bfhi(unsigned w) { return __uint_as_float(w & 0xffff0000u); }
DI float wave_sum(float v) {
#pragma unroll
    for (int o = 1; o < 64; o <<= 1) v += __shfl_xor(v, o);
    return v;
}
DI float fast_exp2(float x) { return __builtin_amdgcn_exp2f(x); }
DI float fast_rcp(float x) { return __builtin_amdgcn_rcpf(x); }
#define MFMA32(a, b, c) __builtin_amdgcn_mfma_f32_32x32x16_bf16((a), (b), (c), 0, 0, 0)
#define MFMA16(a, b, c) __builtin_amdgcn_mfma_f32_16x16x32_bf16((a), (b), (c), 0, 0, 0)
typedef int v8i32 __attribute__((ext_vector_type(8)));
DI unsigned pk4_fp8(float a, float b, float c, float d) { int w = 0; w = __builtin_amdgcn_cvt_pk_fp8_f32(a, b, w, false); w = __builtin_amdgcn_cvt_pk_fp8_f32(c, d, w, true); return (unsigned)w; }
DI f32x4 ldnt4(const float* p) { return __builtin_nontemporal_load((const f32x4*)p); }
DI u32x4 ldntu4(const void* p) { return __builtin_nontemporal_load((const u32x4*)p); }
DI void stnt4(float* p, f32x4 v) { __builtin_nontemporal_store(v, (f32x4*)p); }
DI int crow(int r, int hi) { return (r & 3) + 8 * (r >> 2) + 4 * hi; }

DI int lane_id_fresh() { int l; asm volatile("v_mbcnt_lo_u32_b32 %0, -1, 0\n\tv_mbcnt_hi_u32_b32 %0, -1, %0" : "=v"(l)); return l; }
DI void glds16s(const void* sbase, unsigned voff, unsigned lds_dst) { unsigned keep;
    asm volatile("s_mov_b32 %0, m0\n\ts_mov_b32 m0, %3\n\ts_nop 0\n\tglobal_load_lds_dwordx4 %1, %2\n\ts_mov_b32 m0, %0" : "=&s"(keep) : "v"(voff), "s"(sbase), "s"(lds_dst) : "memory"); }
struct Params { const float* in[27]; float* out; unsigned char* ws; int ph_lo, ph_hi; };

namespace pg8 {
constexpr int BM = 256, BK = 64, HALF = 128, HTB = HALF * BK * 2, STAGE_BYTES = 8 * HTB, NXCD = 8, WGM = 8;
DI int lds_byte(int r, int c) { const int st = (r >> 4) * 2 + (c >> 5), rr = r & 15, cc = c & 31, ob = rr * 64 + cc * 2; return st * 1024 + (ob ^ (((ob >> 9) & 1) << 5)); }
DI void stage_rc(int b, int& R, int& C) { const int st = b / 1024, sb = b % 1024, swz = sb ^ (((sb >> 9) & 1) << 5); R = (st >> 1) * 16 + swz / 64; C = (st & 1) * 32 + (swz % 64) / 2; }
DI int perm32(int rho) { const int n = rho >> 4, i = rho & 15; return 8 * (i >> 2) + 4 * n + (i & 3); }

struct Unit { int pm, pn, aux; const char* Ab; const char* Bb; const int* tok; };

template <class Epi, class Sched, bool GATHER, bool FP8 = false>
DI void gemm_phase(LAS unsigned char* lds, LAS unsigned* tokl, const int K, const Sched& S, const Epi& E, const int wid, const int lane) {
    const int tid = wid * 64 + lane, wr = wid >> 2, wc = wid & 3, fr = lane & 15, fq = lane >> 4;
    const int nt = K / BK;
    unsigned voffA[2], voffB[2]; int RA[2], CA[2];
#pragma unroll
    for (int i = 0; i < 2; ++i) { int R, C; stage_rc(tid * 16 + i * 8192, R, C); const int Rb = Epi::PERM ? ((R & ~31) + perm32(R & 31)) : R;
        voffA[i] = (unsigned)(R * K + C) * 2u; voffB[i] = (unsigned)(Rb * K + C) * 2u; RA[i] = R; CA[i] = C; }
    const size_t kstep = (size_t)(BK * 2);
    const size_t hstep = (size_t)HALF * K * 2;
    const unsigned ldsw = (unsigned)wid * 1024u; const unsigned ldsb = (unsigned)(uintptr_t)lds;
    const int aoff = lds_byte(wr * 64 + fr, fq * 8), boff = lds_byte(wc * 32 + fr, fq * 8);
#define PG8_SA(b, h) (((b) * 2 + (h)) * HTB)
#define PG8_SB(b, h) ((4 + (b) * 2 + (h)) * HTB)
#define PG8_STG(bufoff, gbase, voff) do { _Pragma("unroll") for (int _i = 0; _i < 2; ++_i) \
        glds16s((const void*)(gbase), (voff)[_i], (unsigned)__builtin_amdgcn_readfirstlane((int)(ldsb + (unsigned)(bufoff) + ldsw + (unsigned)_i * 8192u))); } while (0)
#define PG8_STA(bufoff, gbase, h, bsel) do { if constexpr (GATHER) { unsigned vv_[2];   \
            _Pragma("unroll") for (int _j = 0; _j < 2; ++_j) vv_[_j] = tokl[(bsel) * 256 + (h) * 128 + RA[_j]] * (unsigned)(K * 2) + (unsigned)(CA[_j] * 2); \
            PG8_STG(bufoff, gbase, vv_); } else { PG8_STG(bufoff, (gbase) + (h) * hstep, voffA); } } while (0)
#define PG8_LD8(p_) ({ const u32x4 lo_ = *(const LAS u32x4*)(p_), hi_ = *(const LAS u32x4*)((p_) + 1024); (v8i32){(int)lo_.x, (int)lo_.y, (int)lo_.z, (int)lo_.w, (int)hi_.x, (int)hi_.y, (int)hi_.z, (int)hi_.w}; })
#define PG8_LDA(dst, b, h) do { if constexpr (FP8) { _Pragma("unroll") for (int m = 0; m < 4; ++m) dst##8[m] = PG8_LD8(lds + PG8_SA(b, h) + aoff + m * 2048); } \
        else { _Pragma("unroll") for (int m = 0; m < 4; ++m) _Pragma("unroll") for (int k = 0; k < 2; ++k) dst[m][k] = *(const LAS bf16x8*)(lds + PG8_SA(b, h) + aoff + m * 2048 + k * 1024); } } while (0)
#define PG8_LDB(dst, b, h) do { if constexpr (FP8) { _Pragma("unroll") for (int n = 0; n < 2; ++n) dst##8[n] = PG8_LD8(lds + PG8_SB(b, h) + boff + n * 2048); } \
        else { _Pragma("unroll") for (int n = 0; n < 2; ++n) _Pragma("unroll") for (int k = 0; k < 2; ++k) dst[n][k] = *(const LAS bf16x8*)(lds + PG8_SB(b, h) + boff + n * 2048 + k * 1024); } } while (0)
#define PG8_MMA(ai, bj, At, Bt) do { __builtin_amdgcn_s_setprio(1); _Pragma("unroll") for (int m = 0; m < 4; ++m) _Pragma("unroll") for (int n = 0; n < 2; ++n) { \
        if constexpr (FP8) {   \
            asm volatile("v_mfma_scale_f32_16x16x128_f8f6f4 %0, %1, %2, %0, %3, %4 op_sel_hi:[0,0,0]" : "+v"(acc[ai][bj][m][n]) : "v"(Bt##8[n]), "v"(At##8[m]), "v"(sclB_), "v"(sclA_)); \
        } else { _Pragma("unroll") for (int k = 0; k < 2; ++k) acc[ai][bj][m][n] = __builtin_amdgcn_mfma_f32_16x16x32_bf16(Bt[n][k], At[m][k], acc[ai][bj][m][n], 0, 0, 0); } } \
        __builtin_amdgcn_s_setprio(0); } while (0)
#define PG8_WAIT_V(n) asm volatile("s_waitcnt vmcnt(" #n ")" ::: "memory")
#define PG8_WAIT_L(n) asm volatile("s_waitcnt lgkmcnt(" #n ")" ::: "memory")
#define PG8_BAR __builtin_amdgcn_s_barrier()
#define PG8_SCHED __builtin_amdgcn_sched_barrier(0)
    Unit cur, nxt; int ui = 0;
    if (!S.next(0, cur)) return;
    f32x4 acc[2][2][4][2];
#pragma unroll
    for (int a = 0; a < 2; ++a)
#pragma unroll
        for (int b = 0; b < 2; ++b)
#pragma unroll
            for (int m = 0; m < 4; ++m)
#pragma unroll
                for (int n = 0; n < 2; ++n) acc[a][b][m][n] = (f32x4){0.f, 0.f, 0.f, 0.f};
    bf16x8 At[4][2], B0[2][2], B1[2][2];
    v8i32 At8[4], B08[2], B18[2];
    int sclB_ = 0x77777777, sclA_ = 0x7f7f7f7f; asm volatile("" : "+v"(sclB_), "+v"(sclA_));
    const char* cA = cur.Ab; const char* cB = cur.Bb;
    if constexpr (GATHER) {
        if (wid < 4) __builtin_amdgcn_global_load_lds((const unsigned*)(cur.tok + wid * 64 + lane), (LAS unsigned*)(tokl + wid * 64), 4, 0, 0);
        PG8_WAIT_V(0); PG8_BAR;
    }
    PG8_STG(PG8_SB(0, 0), cB, voffB); PG8_STG(PG8_SB(0, 1), cB + hstep, voffB); PG8_STA(PG8_SA(0, 0), cA, 0, 0); PG8_STA(PG8_SA(0, 1), cA, 1, 0);
    if (wr == 1) PG8_BAR;
    PG8_WAIT_V(2); PG8_BAR;
    PG8_STG(PG8_SB(1, 0), cB + kstep, voffB); PG8_STA(PG8_SA(1, 0), cA + kstep, 0, 0); PG8_STG(PG8_SB(1, 1), cB + hstep + kstep, voffB);
    PG8_WAIT_V(6); PG8_BAR;
    for (;;) {
        const bool has_next = S.next(ui + 1, nxt);
        const char* nA = has_next ? nxt.Ab : cA; const char* nB = has_next ? nxt.Bb : cB;
        if constexpr (GATHER) {
            if (has_next && wid < 4) __builtin_amdgcn_global_load_lds((const unsigned*)(nxt.tok + wid * 64 + lane), (LAS unsigned*)(tokl + ((ui + 1) & 1) * 256 + wid * 64), 4, 0, 0);
        }
#pragma unroll 1
        for (int t = 0; t < nt; t += 2) {
            const bool last = (t == nt - 2);
            const char* a1 = cA + (size_t)(t + 1) * kstep;
            const char* a2 = last ? nA : cA + (size_t)(t + 2) * kstep; const char* b2 = last ? nB : cB + (size_t)(t + 2) * kstep;
            const char* a3 = a2 + kstep; const char* b3 = b2 + kstep;
            const int bc_ = ui & 1, bn_ = (last && has_next) ? ((ui + 1) & 1) : (ui & 1);
            PG8_LDB(B0, 0, 0); PG8_LDB(B1, 0, 1); PG8_SCHED; PG8_LDA(At, 0, 0); PG8_STA(PG8_SA(1, 1), a1, 1, bc_);
            PG8_WAIT_V(8); PG8_WAIT_L(0); PG8_BAR; PG8_MMA(0, 0, At, B0); PG8_MMA(0, 1, At, B1); PG8_BAR; PG8_SCHED;
            PG8_LDA(At, 0, 1); PG8_STG(PG8_SB(0, 0), b2, voffB); PG8_STG(PG8_SB(0, 1), b2 + hstep, voffB); PG8_STA(PG8_SA(0, 0), a2, 0, bn_);
            PG8_WAIT_V(8); PG8_WAIT_L(0); PG8_BAR; PG8_MMA(1, 0, At, B0); PG8_MMA(1, 1, At, B1); PG8_BAR; PG8_SCHED;
            PG8_LDB(B0, 1, 0); PG8_LDB(B1, 1, 1); PG8_SCHED; PG8_LDA(At, 1, 0); PG8_STA(PG8_SA(0, 1), a2, 1, bn_);
            PG8_WAIT_V(8); PG8_WAIT_L(0); PG8_BAR; PG8_MMA(0, 0, At, B0); PG8_MMA(0, 1, At, B1); PG8_BAR; PG8_SCHED;
            PG8_LDA(At, 1, 1); PG8_STG(PG8_SB(1, 0), b3, voffB); PG8_STG(PG8_SB(1, 1), b3 + hstep, voffB); PG8_STA(PG8_SA(1, 0), a3, 0, bn_);
            PG8_WAIT_V(8); PG8_WAIT_L(0); PG8_BAR; PG8_MMA(1, 0, At, B0); PG8_MMA(1, 1, At, B1); PG8_BAR; PG8_SCHED;
        }
        if (wr == 0) PG8_BAR;
        if constexpr (FP8) asm volatile("s_nop 15\n\ts_nop 15" ::: "memory");
        E(acc, cur, wr, wc, fr, fq);
        if (!has_next) break;
#pragma unroll
        for (int a = 0; a < 2; ++a)
#pragma unroll
            for (int b = 0; b < 2; ++b)
#pragma unroll
                for (int m = 0; m < 4; ++m)
#pragma unroll
                    for (int n = 0; n < 2; ++n) acc[a][b][m][n] = (f32x4){0.f, 0.f, 0.f, 0.f};
        cur = nxt; cA = nA; cB = nB; ++ui;
        if (wr == 1) PG8_BAR;
    }
    PG8_WAIT_V(0);
    PG8_BAR;
#undef PG8_SA
#undef PG8_SB
#undef PG8_STG
#undef PG8_STA
#undef PG8_LDA
#undef PG8_LDB
#undef PG8_MMA
#undef PG8_WAIT_V
#undef PG8_WAIT_L
#undef PG8_BAR
#undef PG8_SCHED
}

struct StaticOrder {
    int nM, nN, nwg, G, c; const char* A; const char* Bt; size_t tstep;
    DI void init(int M, int N, int K, int G_, int c_, const void* A_, const void* Bt_) { nM = M / BM; nN = N / BM; nwg = nM * nN; G = G_; c = c_; A = (const char*)A_; Bt = (const char*)Bt_; tstep = (size_t)BM * K * 2; }
    DI bool next(int i, Unit& u) const {
        const long L = (long)i * G + c; if (L >= nwg) return false;
        int wgid = (int)L; { const int q = nwg / NXCD, r = nwg % NXCD, xcd = wgid % NXCD, off = wgid / NXCD; wgid = (xcd < r ? xcd * (q + 1) : r * (q + 1) + (xcd - r) * q) + off; }
        const int nig = WGM * nN, gid = wgid / nig, fm = gid * WGM, gsz = (nM - fm) < WGM ? (nM - fm) : WGM;
        u.pm = fm + ((wgid % nig) % gsz); u.pn = (wgid % nig) / gsz; u.aux = 0; u.Ab = A + (size_t)u.pm * tstep; u.Bb = Bt + (size_t)u.pn * tstep; u.tok = nullptr; return true;
    }
};
struct CompressOrder {
    int G, c; const char* KC; const char* PE; const char* W;
    DI bool next(int i, Unit& u) const {
        const int L = i * G + c; if (L >= 132) return false;
        u.pm = L >> 1; u.pn = L & 1; const int kv = u.pm < 32 ? 0 : (u.pm < 64 ? 1 : u.pm - 64); u.aux = kv;
        u.Ab = u.pm < 64 ? KC + (size_t)u.pm * (256 * 1024 * 2) : PE; u.Bb = W + (size_t)kv * (512 * 1024 * 2) + (size_t)u.pn * (256 * 1024 * 2); u.tok = nullptr; return true;
    }
};
struct MoeOrder {
    int G, c, mode; const LAS int* tb; const char* A; const char* W; const int* lists;
    DI bool next(int i, Unit& u) const {
        const int L = i * G + c; const int mt = L >> 2; if (mt >= tb[32]) return false;
        int e = 0;
#pragma unroll 1
        for (int j = 1; j < 32; ++j) e += (tb[j] <= mt) ? 1 : 0;
        u.pm = mt; u.pn = L & 3; u.aux = e;
        if (mode == 0) { u.Ab = A; u.Bb = W + (size_t)e * (1024 * 1024) + (size_t)u.pn * (256 * 1024); u.tok = lists + (size_t)e * ECAP + (size_t)(mt - tb[e]) * 256; }
        else { u.Ab = A + (size_t)mt * (256 * 512); u.Bb = W + (size_t)e * (1024 * 512) + (size_t)u.pn * (256 * 512); u.tok = nullptr; }
        return true;
    }
};

struct EpiBf16 {
    static constexpr bool PERM = true;
    bf16_t* O; int ldc;
    DI void operator()(const f32x4 (&acc)[2][2][4][2], const Unit& u, int wr, int wc, int fr, int fq) const {
        asm volatile("" : "+v"(fr), "+v"(fq));
        const int row0 = u.pm * BM + wr * 64 + fr; const int col0 = u.pn * BM + wc * 32 + 8 * fq;
#pragma unroll
        for (int ai = 0; ai < 2; ++ai)
#pragma unroll
            for (int m = 0; m < 4; ++m) { bf16_t* rowp = O + (size_t)(row0 + ai * HALF + m * 16) * ldc + col0;
#pragma unroll
                for (int bj = 0; bj < 2; ++bj) { const f32x4 v0 = acc[ai][bj][m][0], v1 = acc[ai][bj][m][1];
                    u32x4 w; w.x = pk2(v0[0], v0[1]); w.y = pk2(v0[2], v0[3]); w.z = pk2(v1[0], v1[1]); w.w = pk2(v1[2], v1[3]);
                    *(u32x4*)(rowp + bj * HALF) = w; } }
    }
};
struct EpiInProj {
    static constexpr bool PERM = true;
    unsigned char* ws; const float* g_nq; const float* g_nk; const float* g_dq; const float* g_dk; LAS float* xch;
    DI void operator()(const f32x4 (&acc)[2][2][4][2], const Unit& u, int wr, int wc, int fr, int fq) const {
        const int pn = u.pn, wid = wr * 4 + wc; const int tok0 = u.pm * BM; const int b = tok0 >> 11; int t0 = (tok0 & 2047) + wr * 64 + fr;
        int xo_i = wid * 256 + fr, xp_i = (wid ^ 1) * 256 + fr;
        asm volatile("" : "+v"(t0), "+v"(xo_i), "+v"(xp_i));
        LAS float* xo = xch + xo_i; LAS float* xp = xch + xp_i;
        const float* ropeN = (const float*)(ws + WS_ROPE); const float* ropeD = ropeN + 2048 * 16;
        const int d0 = 32 * (wc & 1) + 8 * fq;
        if (pn <= 4) {
            const bool nrm0 = (pn != 2), nrm1 = (pn < 2);
            if (pn != 2) {
#pragma unroll
                for (int ai = 0; ai < 2; ++ai)
#pragma unroll
                    for (int m = 0; m < 4; ++m)
#pragma unroll
                        for (int bj = 0; bj < 2; ++bj) { const f32x4 a = acc[ai][bj][m][0], c = acc[ai][bj][m][1];
                            float ss = (a[0] * a[0] + a[1] * a[1]) + (a[2] * a[2] + a[3] * a[3]) + (c[0] * c[0] + c[1] * c[1]) + (c[2] * c[2] + c[3] * c[3]);
                            ss += __shfl_xor(ss, 16); ss += __shfl_xor(ss, 32);
                            if (fq == 0) xo[((ai * 4 + m) * 2 + bj) * 16] = ss; }
                asm volatile("s_waitcnt lgkmcnt(0)" ::: "memory"); __builtin_amdgcn_s_barrier(); asm volatile("" ::: "memory");
            }
            const float* gg = pn < 2 ? g_nq : (g_nk + (pn == 3 ? 64 : 128));
            f32x4 g0 = {1.f, 1.f, 1.f, 1.f}, g1 = g0;
            if (pn != 2) { g0 = *(const f32x4*)(gg + d0); g1 = *(const f32x4*)(gg + d0 + 4); }
            const bool ropew = (wc & 1) == 0;
#pragma unroll
            for (int ai = 0; ai < 2; ++ai)
#pragma unroll
                for (int m = 0; m < 4; ++m) {
                    const int t = t0 + ai * HALF + m * 16;
                    f32x4 cs0 = {1.f, 0.f, 1.f, 0.f}, cs1 = cs0, cs2 = cs0, cs3 = cs0;
                    if (pn != 2 && ropew && fq < 2) { const f32x4* rp = (const f32x4*)(ropeN + t * 16); cs0 = rp[0]; cs1 = rp[1]; cs2 = rp[2]; cs3 = rp[3]; }
#pragma unroll
                    for (int bj = 0; bj < 2; ++bj) {
                        const bool donorm = bj == 0 ? nrm0 : nrm1;
                        f32x4 ya = acc[ai][bj][m][0], yb = acc[ai][bj][m][1];
                        u32x4 w0, w1;
                        if (donorm) {
                            const float rstd = rsqrtf((xo[((ai * 4 + m) * 2 + bj) * 16] + xp[((ai * 4 + m) * 2 + bj) * 16]) * (1.f / 64.f) + EPS);
                            ya = ya * rstd * g0; yb = yb * rstd * g1;
                            w0.x = pk2(ya[0], ya[1]); w0.y = pk2(ya[2], ya[3]); w0.z = pk2(yb[0], yb[1]); w0.w = pk2(yb[2], yb[3]);
                            f32x4 ra = ya, rb = yb;
                            if (ropew) {
                                f32x4 pa, pb;
#pragma unroll
                                for (int i = 0; i < 4; ++i) { pa[i] = __shfl_xor(ya[i], 16); pb[i] = __shfl_xor(yb[i], 16); }
                                if (fq == 0) { ra[0] = ya[0] * cs0[0] - pa[0] * cs0[1]; ra[1] = ya[1] * cs0[2] - pa[1] * cs0[3]; ra[2] = ya[2] * cs1[0] - pa[2] * cs1[1]; ra[3] = ya[3] * cs1[2] - pa[3] * cs1[3];
                                               rb[0] = yb[0] * cs2[0] - pb[0] * cs2[1]; rb[1] = yb[1] * cs2[2] - pb[1] * cs2[3]; rb[2] = yb[2] * cs3[0] - pb[2] * cs3[1]; rb[3] = yb[3] * cs3[2] - pb[3] * cs3[3]; }
                                else if (fq == 1) { ra[0] = pa[0] * cs0[1] + ya[0] * cs0[0]; ra[1] = pa[1] * cs0[3] + ya[1] * cs0[2]; ra[2] = pa[2] * cs1[1] + ya[2] * cs1[0]; ra[3] = pa[3] * cs1[3] + ya[3] * cs1[2];
                                                    rb[0] = pb[0] * cs2[1] + yb[0] * cs2[0]; rb[1] = pb[1] * cs2[3] + yb[1] * cs2[2]; rb[2] = pb[2] * cs3[1] + yb[2] * cs3[0]; rb[3] = pb[3] * cs3[3] + yb[3] * cs3[2]; }
                            }
                            w1.x = pk2(ra[0], ra[1]); w1.y = pk2(ra[2], ra[3]); w1.z = pk2(rb[0], rb[1]); w1.w = pk2(rb[2], rb[3]);
                        } else { w0.x = pk2(ya[0], ya[1]); w0.y = pk2(ya[2], ya[3]); w0.z = pk2(yb[0], yb[1]); w0.w = pk2(yb[2], yb[3]); w1 = w0; }
                        const int hq = 2 * bj + (wc >> 1);
                        if (pn < 2) { const size_t off = (((size_t)b * 8 + 4 * pn + hq) * SEQ + t) * 64 + d0;
                            *(u32x4*)((bf16_t*)(ws + WS_QN) + off) = w0; }
                        else { const int six = 2 * (pn - 2) + bj; const size_t base = six == 0 ? WS_KC : six == 1 ? WS_VC : six == 2 ? WS_KS : six == 3 ? WS_VS : six == 4 ? WS_KW : WS_VW;
                            const size_t off = (((size_t)b * 2 + (wc >> 1)) * SEQ + t) * 64 + d0;
                            *(u32x4*)((bf16_t*)(ws + base) + off) = w1; }
                    }
                    asm volatile("" ::: "memory");
                }
        } else if (pn <= 8) {
            const bool isq = pn <= 6; const float* gg = isq ? g_dq : g_dk; bf16_t* dst = (bf16_t*)(ws + (isq ? WS_DQ : WS_DK));
            const f32x4 g0 = *(const f32x4*)(gg + 8 * fq), g1 = *(const f32x4*)(gg + 8 * fq + 4);
#pragma unroll
            for (int ai = 0; ai < 2; ++ai)
#pragma unroll
                for (int m = 0; m < 4; ++m) {
                    const int t = t0 + ai * HALF + m * 16;
                    f32x4 c0 = {1.f, 0.f, 1.f, 0.f}, c1 = c0;
                    if (fq == 0) { const f32x4* rp = (const f32x4*)(ropeD + t * 8); c0 = rp[0]; c1 = rp[1]; }
#pragma unroll
                    for (int bj = 0; bj < 2; ++bj) {
                        f32x4 ya = acc[ai][bj][m][0], yb = acc[ai][bj][m][1];
                        float ss = (ya[0] * ya[0] + ya[1] * ya[1]) + (ya[2] * ya[2] + ya[3] * ya[3]) + (yb[0] * yb[0] + yb[1] * yb[1]) + (yb[2] * yb[2] + yb[3] * yb[3]);
                        ss += __shfl_xor(ss, 16); ss += __shfl_xor(ss, 32);
                        const float rstd = rsqrtf(ss * (1.f / 32.f) + EPS);
                        ya = ya * rstd * g0; yb = yb * rstd * g1;
                        if (fq == 0) { const f32x4 a = ya, bb = yb;
                            ya[0] = a[0] * c0[0] - bb[0] * c0[1]; yb[0] = a[0] * c0[1] + bb[0] * c0[0]; ya[1] = a[1] * c0[2] - bb[1] * c0[3]; yb[1] = a[1] * c0[3] + bb[1] * c0[2];
                            ya[2] = a[2] * c1[0] - bb[2] * c1[1]; yb[2] = a[2] * c1[1] + bb[2] * c1[0]; ya[3] = a[3] * c1[2] - bb[3] * c1[3]; yb[3] = a[3] * c1[3] + bb[3] * c1[2]; }
                        u32x4 w; w.x = pk2(ya[0], ya[1]); w.y = pk2(ya[2], ya[3]); w.z = pk2(yb[0], yb[1]); w.w = pk2(yb[2], yb[3]);
                        const int hd = 4 * ((pn - 5) & 1) + 2 * bj + (wc >> 1);
                        *(u32x4*)(dst + (((size_t)b * 8 + hd) * SEQ + t) * 64 + d0) = w;
                    }
                    asm volatile("" ::: "memory");
                }
        } else if (pn <= 10) {
            bf16_t* dst = (bf16_t*)(ws + WS_DV);
#pragma unroll
            for (int ai = 0; ai < 2; ++ai)
#pragma unroll
                for (int m = 0; m < 4; ++m) { const int t = t0 + ai * HALF + m * 16;
#pragma unroll
                    for (int bj = 0; bj < 2; ++bj) { const f32x4 ya = acc[ai][bj][m][0], yb = acc[ai][bj][m][1];
                        u32x4 w; w.x = pk2(ya[0], ya[1]); w.y = pk2(ya[2], ya[3]); w.z = pk2(yb[0], yb[1]); w.w = pk2(yb[2], yb[3]);
                        const int hd = 4 * (pn - 9) + 2 * bj + (wc >> 1);
                        *(u32x4*)(dst + (((size_t)b * 8 + hd) * SEQ + t) * 64 + d0) = w; }
                    asm volatile("" ::: "memory"); }
        } else {
            if (wc == 0 && fq < 3) {
                float* gt = (float*)(ws + WS_GATES);
#pragma unroll
                for (int ai = 0; ai < 2; ++ai)
#pragma unroll
                    for (int m = 0; m < 4; ++m) { const size_t tok = (size_t)tok0 + wr * 64 + fr + ai * HALF + m * 16; const f32x4 ya = acc[ai][0][m][0], yb = acc[ai][0][m][1]; f32x4 sa, sb;
#pragma unroll
                        for (int i = 0; i < 4; ++i) { sa[i] = 1.f / (1.f + __expf(-ya[i])); sb[i] = 1.f / (1.f + __expf(-yb[i])); }
                        *(f32x4*)(gt + tok * 24 + 8 * fq) = sa; *(f32x4*)(gt + tok * 24 + 8 * fq + 4) = sb; }
            }
        }
    }
};
struct EpiFp8 {
    static constexpr bool PERM = true;
    unsigned char* O; int ldc;
    DI void operator()(const f32x4 (&acc)[2][2][4][2], const Unit& u, int wr, int wc, int fr, int fq) const {
        asm volatile("" : "+v"(fr), "+v"(fq));
        const int row0 = u.pm * BM + wr * 64 + fr; const int col0 = u.pn * BM + wc * 32 + 8 * fq;
#pragma unroll
        for (int ai = 0; ai < 2; ++ai)
#pragma unroll
            for (int m = 0; m < 4; ++m) { unsigned char* rowp = O + (size_t)(row0 + ai * HALF + m * 16) * ldc + col0;
#pragma unroll
                for (int bj = 0; bj < 2; ++bj) { const f32x4 v0 = acc[ai][bj][m][0], v1 = acc[ai][bj][m][1];
                    u32x2 w; w.x = pk4_fp8(v0[0], v0[1], v0[2], v0[3]); w.y = pk4_fp8(v1[0], v1[1], v1[2], v1[3]);
                    *(u32x2*)(rowp + bj * HALF) = w; } }
    }
};
struct EpiSwiglu {
    static constexpr bool PERM = true;
    unsigned char* O;
    DI void operator()(const f32x4 (&acc)[2][2][4][2], const Unit& u, int wr, int wc, int fr, int fq) const {
        asm volatile("" : "+v"(fr), "+v"(fq));
        const int row0 = u.pm * BM + wr * 64 + fr; const int col0 = u.pn * 128 + wc * 16 + 4 * fq;
#pragma unroll
        for (int ai = 0; ai < 2; ++ai)
#pragma unroll
            for (int m = 0; m < 4; ++m) { unsigned char* rowp = O + (size_t)(row0 + ai * HALF + m * 16) * EHID + col0;
#pragma unroll
                for (int bj = 0; bj < 2; ++bj) { const f32x4 g = acc[ai][bj][m][0], up = acc[ai][bj][m][1]; float h[4];
#pragma unroll
                    for (int i = 0; i < 4; ++i) { const float s = fast_rcp(1.f + __expf(-g[i])); h[i] = g[i] * s * up[i]; }
                    *(unsigned*)(rowp + bj * 64) = pk4_fp8(h[0], h[1], h[2], h[3]); } }
    }
};
struct EpiOutProj {
    static constexpr bool PERM = true;
    const float* x; bf16_t* x1b; const float* mod; float* rowss;
    DI void operator()(const f32x4 (&acc)[2][2][4][2], const Unit& u, int wr, int wc, int fr, int fq) const {
        const int col0 = u.pn * BM + wc * 32 + 8 * fq; const int b = (u.pm * BM) / SEQ;
        const float* g1 = mod + (size_t)b * 6144 + 2048 + col0;
        f32x4 gv[2][2];
#pragma unroll
        for (int bj = 0; bj < 2; ++bj)
#pragma unroll
            for (int n = 0; n < 2; ++n) gv[bj][n] = *(const f32x4*)(g1 + bj * HALF + n * 4);
#pragma unroll
        for (int ai = 0; ai < 2; ++ai)
#pragma unroll
            for (int m = 0; m < 4; ++m) { const int r = u.pm * BM + ai * HALF + wr * 64 + m * 16 + fr; const size_t off = (size_t)r * DM + col0; float ss = 0.f;
#pragma unroll
                for (int bj = 0; bj < 2; ++bj) { const f32x4 xa = ldnt4(x + off + bj * HALF), xb = ldnt4(x + off + bj * HALF + 4);
                    const f32x4 oa = xa + gv[bj][0] * acc[ai][bj][m][0], ob = xb + gv[bj][1] * acc[ai][bj][m][1];
                    ss += (oa[0] * oa[0] + oa[1] * oa[1]) + (oa[2] * oa[2] + oa[3] * oa[3]) + (ob[0] * ob[0] + ob[1] * ob[1]) + (ob[2] * ob[2] + ob[3] * ob[3]);
                    u32x4 w; w.x = pk2(oa[0], oa[1]); w.y = pk2(oa[2], oa[3]); w.z = pk2(ob[0], ob[1]); w.w = pk2(ob[2], ob[3]);
                    *(u32x4*)(x1b + off + bj * HALF) = w; }
                ss += __shfl_xor(ss, 16); ss += __shfl_xor(ss, 32);
                if (fq == 0) rowss[(size_t)r * 16 + u.pn * 4 + wc] = ss; }
    }
};
}

struct Frame {
    LAS unsigned char* lds; unsigned char* ws; const float* const* in; float* out;
    int tid, lane, wave, bid, G, gw, NGW;
};

DI int origcol(int n) { return n < 1280 ? n : (n < 2816 ? n + 24 : (n < 2840 ? n - 2816 + 1280 : -1)); }

template <class DRow>
DI void tr_item(const float* src, int src_ld, int sc  , bf16_t* dst, int dst_ld, int k0, LAS float* scr, int lane, DRow drow) {
#pragma unroll 8
    for (int i = 0; i < 32; ++i) { const int kk = 2 * i + (lane >> 5); scr[kk * 33 + (lane & 31)] = sc >= 0 ? src[(size_t)(k0 + kk) * src_ld + sc] : 0.f; }
    asm volatile("s_waitcnt lgkmcnt(0)" ::: "memory");
    const int c = lane & 7;
#pragma unroll
    for (int j = 0; j < 4; ++j) { const int n = (lane >> 3) + 8 * j; const LAS float* s = scr + (8 * c) * 33 + n;
        u32x4 o; o.x = pk2(s[0 * 33], s[1 * 33]); o.y = pk2(s[2 * 33], s[3 * 33]); o.z = pk2(s[4 * 33], s[5 * 33]); o.w = pk2(s[6 * 33], s[7 * 33]);
        *(u32x4*)(dst + (size_t)drow(n) * dst_ld + k0 + 8 * c) = o; }
    asm volatile("s_waitcnt lgkmcnt(0)" ::: "memory");
}

constexpr int TR_NITEMS = 16 * 96 + 16 * 32 + 2 * (32 * 16 * 16) + 32 * 8 * 32 + 4 * 16 * 8;
constexpr int TR_EARLY = 11264;
DI void phase0_weights(Frame& F, int first, int end, int worker, int nworkers);
DI void phase0(Frame& F) {
    const float* c_in = F.in[1]; const float* w_ada = F.in[2]; const float* b_ada = F.in[3];
    float* mod = (float*)(F.ws + WS_MOD);
    for (int it = F.bid; it < 96; it += F.G) {
        LAS float* cs = (LAS float*)F.lds;
        for (int idx = F.tid; idx < 32 * 1024; idx += NTHREADS) { const int b = idx >> 10, k = idx & 1023; cs[k * 32 + b] = c_in[idx]; }
        __syncthreads();
        float acc[32];
#pragma unroll
        for (int b = 0; b < 32; ++b) acc[b] = 0.f;
        const int j = it * 64 + F.lane;
#pragma unroll 1
        for (int kg = 0; kg < 4; ++kg) {
            float wv[32];
#pragma unroll
            for (int q = 0; q < 32; ++q) wv[q] = w_ada[(size_t)(F.wave * 128 + kg * 32 + q) * 6144 + j];
#pragma unroll
            for (int q = 0; q < 32; ++q) { const int k = F.wave * 128 + kg * 32 + q; const float w = wv[q];
#pragma unroll
                for (int b4 = 0; b4 < 8; ++b4) { const f32x4 cv = *(const LAS f32x4*)(cs + k * 32 + b4 * 4); acc[b4 * 4 + 0] += cv[0] * w; acc[b4 * 4 + 1] += cv[1] * w; acc[b4 * 4 + 2] += cv[2] * w; acc[b4 * 4 + 3] += cv[3] * w; } }
        }
        __syncthreads();
        LAS float* red = (LAS float*)F.lds;
#pragma unroll
        for (int b = 0; b < 32; ++b) red[(F.wave * 32 + b) * 64 + F.lane] = acc[b];
        __syncthreads();
        for (int o = F.tid; o < 2048; o += NTHREADS) { const int b = o >> 6, l = o & 63; float s = b_ada[it * 64 + l];
#pragma unroll
            for (int w = 0; w < 8; ++w) s += red[(w * 32 + b) * 64 + l];
            mod[(size_t)b * 6144 + it * 64 + l] = s; }
        __syncthreads();
    }
    if (F.G > 96) { if (F.bid >= 96) phase0_weights(F, 0, TR_EARLY, (F.bid - 96) * NWAVES + F.wave, (F.G - 96) * NWAVES); phase0_weights(F, TR_EARLY, TR_NITEMS, F.gw, F.NGW); }
    else phase0_weights(F, 0, TR_NITEMS, F.gw, F.NGW);
    const int gt = F.bid * NTHREADS + F.tid, NGT = F.G * NTHREADS;
    { float* ropeN = (float*)(F.ws + WS_ROPE); float* ropeD = ropeN + 2048 * 16;
      for (int i = gt; i < 2048 * 12; i += NGT) { const int t = i / 12, j = i % 12; const bool isn = j < 8; const int ii = isn ? j : j - 8;
          const float ex = isn ? (float)(2 * ii) / 16.f : (float)(2 * ii) / 8.f;
          const float inv = exp2f(-ex * 18.931568569324174f);
          const float ang = (float)t * inv;
          const double rev = (double)ang * 0.15915494309189535; const double fr = rev - __builtin_rint(rev); const float rr = (float)(fr * 6.283185307179586);
          const float cs = __cosf(rr), sn = __sinf(rr);
          if (isn) { ropeN[(t * 8 + ii) * 2] = cs; ropeN[(t * 8 + ii) * 2 + 1] = sn; } else { ropeD[(t * 4 + ii) * 2] = cs; ropeD[(t * 4 + ii) * 2 + 1] = sn; } } }
    { bf16_t* whi = (bf16_t*)(F.ws + WS_WR); bf16_t* wlo = whi + 48 * 1024;
      for (int i = gt; i < 48 * 1024; i += NGT) { const int c = i >> 10, k = i & 1023; float w = 0.f;
          if (c < 4) w = F.in[20][k * 4 + c]; else if (c < 36) w = F.in[22][k * 32 + (c - 4)];
          const unsigned short h = f2bf(w); whi[i] = h; wlo[i] = f2bf(w - bf2f(h)); } }
    { bf16_t* pe = (bf16_t*)(F.ws + WS_PE);
      for (int i = gt; i < 256 * 1024; i += NGT) { const int r = i >> 10, k = i & 1023; float v = 0.f; if (r < 4) v = F.in[9][(r >> 1) * 2048 + (r & 1) * 1024 + k]; pe[i] = f2bf(v); } }
    { u32x4* l4 = (u32x4*)(F.ws + WS_LIST); for (int i = gt; i < (int)(NEXP * ECAP / 4); i += NGT) l4[i] = (u32x4){0u, 0u, 0u, 0u};
      unsigned* ctl = (unsigned*)(F.ws + WS_CTL); for (int i = gt; i < 8192; i += NGT) ctl[i] = 0u; }
}

struct TrD { const float* src; int ld; int sc; bf16_t* dst; int dld; int k0; int mode; int n0; int aux; int fp8; };
DI TrD tr_desc(Frame& F, int it, int lane) {
    constexpr int I_IN = 16 * 96, I_OUT = 16 * 32, I_G = 32 * 16 * 16, I_D = 32 * 8 * 32;
    TrD d; int r = it; const int nq = lane & 7;
    if (r < I_IN) { const int kb = r / 96, nb = r % 96; d.n0 = nb * 32; const int n = d.n0 + 4 * nq; d.src = F.in[6]; d.ld = INCOLS; d.sc = origcol(n); d.dst = (bf16_t*)(F.ws + WS_WIN); d.dld = 1024; d.k0 = kb * 64; d.mode = 0; d.aux = 0; d.fp8 = 1; return d; }
    r -= I_IN;
    if (r < I_OUT) { const int kb = r / 32, nb = r % 32; d.n0 = nb * 32; d.src = F.in[19]; d.ld = 1024; d.sc = d.n0 + 4 * nq; d.dst = (bf16_t*)(F.ws + WS_WOUT); d.dld = 1024; d.k0 = kb * 64; d.mode = 0; d.aux = 0; d.fp8 = 0; return d; }
    r -= I_OUT;
    if (r < 2 * I_G) { const int up = r / I_G; r -= up * I_G; const int e = r / 256, q = r % 256, kb = q / 16, nb = q % 16; d.n0 = nb * 32;
        d.src = F.in[24 + up] + (size_t)e * 1024 * 512; d.ld = 512; d.sc = d.n0 + 4 * nq; d.dst = (bf16_t*)(F.ws + WS_WGU + (size_t)e * 1024 * 1024); d.dld = 1024; d.k0 = kb * 64; d.mode = 1; d.aux = up; d.fp8 = 1; return d; }
    r -= 2 * I_G;
    if (r < I_D) { const int e = r / 256, q = r % 256, kb = q / 32, nb = q % 32; d.n0 = nb * 32;
        d.src = F.in[26] + (size_t)e * 512 * 1024; d.ld = 1024; d.sc = d.n0 + 4 * nq; d.dst = (bf16_t*)(F.ws + WS_WD + (size_t)e * 1024 * 512); d.dld = 512; d.k0 = kb * 64; d.mode = 0; d.aux = 0; d.fp8 = 1; return d; }
    r -= I_D;
    { const int kvh = r / 128, q = r % 128, kb = q / 8, nb = q % 8; d.n0 = nb * 32; const int kv = kvh >> 1, half = kvh & 1;
      d.src = F.in[10] + (size_t)kv * 2048 * 256 + (size_t)half * 1024 * 256; d.ld = 256; d.sc = d.n0 + 4 * nq; d.dst = (bf16_t*)(F.ws + WS_WC1) + (size_t)kv * 512 * 1024; d.dld = 1024; d.k0 = kb * 64; d.mode = 2; d.aux = half; d.fp8 = 0; return d; }
}
DI void tr_load(const TrD& d, f32x4 (&v)[8], int lane) {
    const int kk = lane >> 3;
#pragma unroll
    for (int i = 0; i < 8; ++i) v[i] = d.sc >= 0 ? ldnt4(d.src + (size_t)(d.k0 + kk + 8 * i) * d.ld + d.sc) : (f32x4){0.f, 0.f, 0.f, 0.f};
}
DI void tr_finish(const TrD& d, const f32x4 (&v)[8], LAS float* scr, int lane) {
    const int kk = lane >> 3, nq = lane & 7;
#pragma unroll
    for (int i = 0; i < 8; ++i) *(LAS f32x4*)(scr + (kk + 8 * i) * 36 + 4 * nq) = v[i];
    asm volatile("s_waitcnt lgkmcnt(0)" ::: "memory");
    const int c = lane & 7;
#pragma unroll
    for (int j = 0; j < 4; ++j) { const int n = (lane >> 3) + 8 * j; const LAS float* s = scr + (8 * c) * 36 + n;
        const int jn = d.n0 + n; const int row = d.mode == 0 ? jn : (d.mode == 1 ? 8 * (jn >> 2) + (jn & 3) + 4 * d.aux : d.aux * 256 + jn);
        if (d.fp8) { u32x2 o8; o8.x = pk4_fp8(s[0 * 36] * 256.f, s[1 * 36] * 256.f, s[2 * 36] * 256.f, s[3 * 36] * 256.f); o8.y = pk4_fp8(s[4 * 36] * 256.f, s[5 * 36] * 256.f, s[6 * 36] * 256.f, s[7 * 36] * 256.f);
            *(u32x2*)((unsigned char*)d.dst + (size_t)row * d.dld + d.k0 + 8 * c) = o8; }
        else { u32x4 o; o.x = pk2(s[0 * 36], s[1 * 36]); o.y = pk2(s[2 * 36], s[3 * 36]); o.z = pk2(s[4 * 36], s[5 * 36]); o.w = pk2(s[6 * 36], s[7 * 36]);
            *(u32x4*)(d.dst + (size_t)row * d.dld + d.k0 + 8 * c) = o; } }
    asm volatile("s_waitcnt lgkmcnt(0)" ::: "memory");
}
DI void phase0_weights(Frame& F, int first, int end, int worker, int nworkers) {
    LAS float* scr = (LAS float*)(F.lds + F.wave * 16384);
    const int lane = F.lane;
    int it = first + worker; if (it >= end) return;
    TrD cur = tr_desc(F, it, lane); f32x4 vc[8]; tr_load(cur, vc, lane);
    for (;;) {
        const int nit = it + nworkers; const bool more = nit < end;
        TrD nxt = cur; f32x4 vn[8];
        if (more) { nxt = tr_desc(F, nit, lane); tr_load(nxt, vn, lane); }
        tr_finish(cur, vc, scr, lane);
        if (!more) break;
        cur = nxt; it = nit;
#pragma unroll
        for (int i = 0; i < 8; ++i) vc[i] = vn[i];
    }
}
DI void phase1(Frame& F) {
    const float* x = F.in[0]; const float* g = F.in[4]; const float* mod = (const float*)(F.ws + WS_MOD); unsigned char* h1 = (unsigned char*)(F.ws + WS_H1);
    const int lane = F.lane;
    for (int m0 = F.gw * 32; m0 < TOK; m0 += F.NGW * 32) {
        const int b = m0 >> 11; const float* sh = mod + (size_t)b * 6144; const float* sc = sh + 1024;
        f32x4 A[4], Bv[4];
#pragma unroll
        for (int j = 0; j < 4; ++j) { const int col = 4 * lane + 256 * j; A[j] = *(const f32x4*)(g + col) * (*(const f32x4*)(sc + col) + 1.f); Bv[j] = *(const f32x4*)(sh + col); }
        const f32x4* xr = (const f32x4*)(x + (size_t)m0 * DM) + lane; unsigned* o8 = (unsigned*)(h1 + (size_t)m0 * DM) + lane;
        f32x4 v0[4], v1[4];
#pragma unroll
        for (int j = 0; j < 4; ++j) { v0[j] = __builtin_nontemporal_load(xr + 64 * j); v1[j] = __builtin_nontemporal_load(xr + 256 + 64 * j); }
        for (int i = 0; i < 32; i += 2) {
            f32x4 n0[4], n1[4];
            if (i + 2 < 32) {
#pragma unroll
                for (int j = 0; j < 4; ++j) { n0[j] = __builtin_nontemporal_load(xr + (size_t)(i + 2) * 256 + 64 * j); n1[j] = __builtin_nontemporal_load(xr + (size_t)(i + 3) * 256 + 64 * j); }
            }
            float s0 = 0.f, s1 = 0.f;
#pragma unroll
            for (int j = 0; j < 4; ++j) { s0 += (v0[j][0] * v0[j][0] + v0[j][1] * v0[j][1]) + (v0[j][2] * v0[j][2] + v0[j][3] * v0[j][3]); s1 += (v1[j][0] * v1[j][0] + v1[j][1] * v1[j][1]) + (v1[j][2] * v1[j][2] + v1[j][3] * v1[j][3]); }
#pragma unroll
            for (int o = 1; o < 64; o <<= 1) { s0 += __shfl_xor(s0, o); s1 += __shfl_xor(s1, o); }
            const float r0 = rsqrtf(s0 * (1.f / DM) + EPS), r1 = rsqrtf(s1 * (1.f / DM) + EPS);
#pragma unroll
            for (int j = 0; j < 4; ++j) { const f32x4 y0 = v0[j] * r0 * A[j] + Bv[j], y1 = v1[j] * r1 * A[j] + Bv[j];
                o8[(size_t)i * 256 + 64 * j] = pk4_fp8(y0[0], y0[1], y0[2], y0[3]); o8[(size_t)(i + 1) * 256 + 64 * j] = pk4_fp8(y1[0], y1[1], y1[2], y1[3]); }
#pragma unroll
            for (int j = 0; j < 4; ++j) { v0[j] = n0[j]; v1[j] = n1[j]; }
        }
    }
}

DI void phase3(Frame& F) {
    const bf16_t* proj = (const bf16_t*)(F.ws + WS_PROJ);
    const float* ropeN = (const float*)(F.ws + WS_ROPE); const float* ropeD = ropeN + 2048 * 16;
    const float* g_nq = F.in[7]; const float* g_nk = F.in[8]; const float* g_dq = F.in[12]; const float* g_dk = F.in[13];
    const int lane = F.lane;
    for (int it = F.gw; it < TOK * 6; it += F.NGW) {
        const int m = it / 6, part = it % 6; const int b = m >> 11, t = m & 2047;
        const int c0 = part * 512 + lane * 8;
        const u32x4 raw = *(const u32x4*)(proj + (size_t)m * NPROJ + c0);
        float v[8]; v[0] = bflo(raw.x); v[1] = bfhi(raw.x); v[2] = bflo(raw.y); v[3] = bfhi(raw.y); v[4] = bflo(raw.z); v[5] = bfhi(raw.z); v[6] = bflo(raw.w); v[7] = bfhi(raw.w);
        float ss = 0.f;
#pragma unroll
        for (int i = 0; i < 8; ++i) ss += v[i] * v[i];
        ss += __shfl_xor(ss, 1); ss += __shfl_xor(ss, 2); const float ss32 = ss; ss += __shfl_xor(ss, 4); const float ss64 = ss;
        float pv[8];
#pragma unroll
        for (int i = 0; i < 8; ++i) pv[i] = __shfl_xor(v[i], 1);
        if (c0 < 1280) {
            const bool isq = c0 < 512; int six = 0, gsel = 0, d0;
            if (isq) { d0 = c0 & 63; } else { const int cc = c0 - 512; six = cc >> 7; gsel = (cc >> 6) & 1; d0 = cc & 63; }
            const bool donorm = isq || six == 2 || six == 4;
            float y[8];
            if (donorm) { const float* gg = isq ? g_nq : (g_nk + (six == 2 ? 64 : 128)); const float rstd = rsqrtf(ss64 * (1.f / 64.f) + EPS);
#pragma unroll
                for (int i = 0; i < 8; ++i) { y[i] = v[i] * rstd * gg[d0 + i]; pv[i] = pv[i] * rstd * gg[(d0 ^ 8) + i]; } }
            else {
#pragma unroll
                for (int i = 0; i < 8; ++i) y[i] = v[i]; }
            float yr[8];
#pragma unroll
            for (int i = 0; i < 8; ++i) yr[i] = y[i];
            if (donorm && d0 < 16) {
#pragma unroll
                for (int i = 0; i < 8; ++i) { const float cs = ropeN[(t * 8 + i) * 2], sn = ropeN[(t * 8 + i) * 2 + 1];
                    yr[i] = d0 == 0 ? (y[i] * cs - pv[i] * sn) : (pv[i] * sn + y[i] * cs); }
            }
            u32x4 w0, w1; w0.x = pk2(y[0], y[1]); w0.y = pk2(y[2], y[3]); w0.z = pk2(y[4], y[5]); w0.w = pk2(y[6], y[7]);
            w1.x = pk2(yr[0], yr[1]); w1.y = pk2(yr[2], yr[3]); w1.z = pk2(yr[4], yr[5]); w1.w = pk2(yr[6], yr[7]);
            if (isq) { const int hd = c0 >> 6; const size_t off = (((size_t)b * 8 + hd) * SEQ + t) * 64 + d0;
                *(u32x4*)((bf16_t*)(F.ws + WS_QN) + off) = w0; *(u32x4*)((bf16_t*)(F.ws + WS_QR) + off) = w1; }
            else { const size_t base = six == 0 ? WS_KC : six == 1 ? WS_VC : six == 2 ? WS_KS : six == 3 ? WS_VS : six == 4 ? WS_KW : WS_VW;
                const size_t off = (((size_t)b * 2 + gsel) * SEQ + t) * 64 + d0;
                *(u32x4*)((bf16_t*)(F.ws + base) + off) = donorm ? w1 : w0; }
        } else if (c0 < 2304) {
            const bool isq = c0 < 1792; const int cc = c0 - (isq ? 1280 : 1792); const int hd = cc >> 6, dd = cc & 63, d0 = dd & 31;
            const float* gg = isq ? g_dq : g_dk; const float rstd = rsqrtf(ss32 * (1.f / 32.f) + EPS);
            float y[8];
#pragma unroll
            for (int i = 0; i < 8; ++i) y[i] = v[i] * rstd * gg[d0 + i];
            if (d0 == 0) {
#pragma unroll
                for (int i = 0; i < 4; ++i) { const float cs = ropeD[(t * 4 + i) * 2], sn = ropeD[(t * 4 + i) * 2 + 1]; const float a = y[i], bb = y[i + 4]; y[i] = a * cs - bb * sn; y[i + 4] = a * sn + bb * cs; }
            }
            u32x4 w; w.x = pk2(y[0], y[1]); w.y = pk2(y[2], y[3]); w.z = pk2(y[4], y[5]); w.w = pk2(y[6], y[7]);
            const size_t off = (((size_t)b * 8 + hd) * SEQ + t) * 64 + dd;
            *(u32x4*)((bf16_t*)(F.ws + (isq ? WS_DQ : WS_DK)) + off) = w;
        } else if (c0 < 2816) {
            const int cc = c0 - 2304; const int hd = cc >> 6, dd = cc & 63; const size_t off = (((size_t)b * 8 + hd) * SEQ + t) * 64 + dd;
            *(u32x4*)((bf16_t*)(F.ws + WS_DV) + off) = raw;
        } else if (c0 < 2840) {
            float* gt = (float*)(F.ws + WS_GATES) + (size_t)m * 24 + (c0 - 2816);
#pragma unroll
            for (int i = 0; i < 8; ++i) gt[i] = 1.f / (1.f + __expf(-v[i]));
        }
    }
}

DI void glds16(const void* gsrc, unsigned lds_dst) { unsigned keep;
    asm volatile("s_mov_b32 %0, m0\n\ts_mov_b32 m0, %2\n\ts_nop 0\n\tglobal_load_lds_dwordx4 %1, off\n\ts_mov_b32 m0, %0" : "=&s"(keep) : "v"(gsrc), "s"(lds_dst) : "memory"); }
DI unsigned lds_addr(const LAS void* p) { return (unsigned)(uintptr_t)p; }
DI void store_row64(bf16_t* row, u32x2 (&o2)[8], int hh) {
#pragma unroll
    for (int k = 0; k < 8; k += 2) { u32x2 a = o2[k], b = o2[k + 1];
        auto r0 = __builtin_amdgcn_permlane32_swap(a.x, b.x, false, false); a.x = r0[0]; b.x = r0[1];
        auto r1 = __builtin_amdgcn_permlane32_swap(a.y, b.y, false, false); a.y = r1[0]; b.y = r1[1];
        u32x4 w; w.x = a.x; w.y = a.y; w.z = b.x; w.w = b.y;
        *(u32x4*)(row + 8 * k + (hh ? 8 : 0)) = w; }
}
struct ALane { int k0; int v0; DI int ko(int ks) const { return k0 ^ (ks << 5); } DI int vo(int db) const { return v0 ^ (db << 6); } };
DI ALane alane_init(int lane) {
    ALane L; const int r = lane & 31, hh = lane >> 5, g = lane >> 4, i = lane & 15;
    L.k0 = r * 128 + ((hh ^ ((r >> 1) & 7)) << 4);
    const int rl = 4 * hh + (i >> 2); const int ch = 2 * (g & 1) + ((i & 3) >> 1);
    L.v0 = rl * 128 + ((ch ^ (((rl >> 1) & 1) << 2)) << 4) + 8 * (i & 1);
    return L;
}
DI s16x4 vtr(const LAS char* p) { typedef short v4i16 __attribute__((ext_vector_type(4))); return __builtin_bit_cast(s16x4, __builtin_amdgcn_ds_read_tr16_b64_v4i16((LAS v4i16*)p)); }
DI bf16x8 vfrag(const LAS char* Vt, const ALane& L, int db, int kb, int s) {
    const LAS char* p = Vt + L.vo(db) + (32 * kb + 16 * s) * 128;
    const s16x4 lo = vtr(p), hi = vtr(p + 8 * 128);
    return __builtin_shufflevector(lo, hi, 0, 1, 2, 3, 4, 5, 6, 7);
}
DI bf16x8 pfrag(const f32x16& p, int s) { u32x4 w; w.x = pk2(p[8 * s + 0], p[8 * s + 1]); w.y = pk2(p[8 * s + 2], p[8 * s + 3]); w.z = pk2(p[8 * s + 4], p[8 * s + 5]); w.w = pk2(p[8 * s + 6], p[8 * s + 7]); return __builtin_bit_cast(bf16x8, w); }
DI u32x4 tile_ld(const bf16_t* g, int tid) { return *(const u32x4*)(g + tid * 8); }
DI void tile_st_k(LAS char* Kt, u32x4 v, int tid) { const int row = tid >> 3, ch = tid & 7; *(LAS u32x4*)(Kt + row * 128 + ((ch ^ ((row >> 1) & 7)) << 4)) = v; }
DI void tile_st_v(LAS char* Vt, u32x4 v, int tid) { const int row = tid >> 3, ch = tid & 7; *(LAS u32x4*)(Vt + row * 128 + ((ch ^ (((row >> 1) & 1) << 2)) << 4)) = v; }

constexpr int MK_NONE = 0, MK_LE = 1, MK_GT = 2;
template <int MASK>
DI void sm16(f32x16& a, float c2, float mcl, int kb, int hh, int th) {
    if constexpr (MASK != MK_NONE) asm volatile("" : "+v"(th));
#pragma unroll
    for (int i = 0; i < 16; ++i) {
        float x = __builtin_fmaf(a[i], c2, -mcl);
        if constexpr (MASK != MK_NONE) { const int kl = 32 * kb + crow(i, hh); const bool ok = MASK == MK_LE ? (kl <= th) : (kl > th); x = ok ? x : -1.0e30f; }
        a[i] = fast_exp2(x);
    }
}
DI float sum16(const f32x16& a) { return ((a[0] + a[1]) + (a[2] + a[3])) + ((a[4] + a[5]) + (a[6] + a[7])) + ((a[8] + a[9]) + (a[10] + a[11])) + ((a[12] + a[13]) + (a[14] + a[15])); }
#define SCHED_FENCE() do { } while (0)
template <int MASK, bool KEEPP>
DI void attn_tile64(const LAS char* Kt, const LAS char* Vt, const ALane& L, const bf16x8 (&qf)[4], f32x16 (&O)[2], float& lsum, float c2, float mcl, int th, int hh, f32x16 (&P)[2]) {
    bf16x8 kf[2][4];
#pragma unroll
    for (int kb = 0; kb < 2; ++kb)
#pragma unroll
        for (int ks = 0; ks < 4; ++ks) kf[kb][ks] = *(const LAS bf16x8*)(Kt + L.ko(ks) + kb * 4096);
    SCHED_FENCE();
    f32x16 a0 = {0.f, 0.f, 0.f, 0.f, 0.f, 0.f, 0.f, 0.f, 0.f, 0.f, 0.f, 0.f, 0.f, 0.f, 0.f, 0.f}, a1 = a0;
#pragma unroll
    for (int ks = 0; ks < 4; ++ks) a0 = MFMA32(kf[0][ks], qf[ks], a0);
#pragma unroll
    for (int ks = 0; ks < 4; ++ks) a1 = MFMA32(kf[1][ks], qf[ks], a1);
    bf16x8 v0[2][2], v1[2][2];
#pragma unroll
    for (int s = 0; s < 2; ++s)
#pragma unroll
        for (int db = 0; db < 2; ++db) v0[s][db] = vfrag(Vt, L, db, 0, s);
    SCHED_FENCE();
    bf16x8 pf[2][2];
    sm16<MASK>(a0, c2, mcl, 0, hh, th); lsum += sum16(a0); pf[0][0] = pfrag(a0, 0); pf[0][1] = pfrag(a0, 1);
    if constexpr (KEEPP) P[0] = a0;
#pragma unroll
    for (int s = 0; s < 2; ++s)
#pragma unroll
        for (int db = 0; db < 2; ++db) v1[s][db] = vfrag(Vt, L, db, 1, s);
    SCHED_FENCE();
    sm16<MASK>(a1, c2, mcl, 1, hh, th); lsum += sum16(a1); pf[1][0] = pfrag(a1, 0); pf[1][1] = pfrag(a1, 1);
    if constexpr (KEEPP) P[1] = a1;
    SCHED_FENCE();
#pragma unroll
    for (int s = 0; s < 2; ++s)
#pragma unroll
        for (int db = 0; db < 2; ++db) O[db] = MFMA32(v0[s][db], pf[0][s], O[db]);
#pragma unroll
    for (int s = 0; s < 2; ++s)
#pragma unroll
        for (int db = 0; db < 2; ++db) O[db] = MFMA32(v1[s][db], pf[1][s], O[db]);
    SCHED_FENCE();
}
template <int MASK>
DI void ex16(f32x16& a, int kb, int hh, int th) {
    if constexpr (MASK != MK_NONE) asm volatile("" : "+v"(th));
#pragma unroll
    for (int i = 0; i < 16; ++i) {
        float x = a[i];
        if constexpr (MASK != MK_NONE) { const int kl = 32 * kb + crow(i, hh); const bool ok = MASK == MK_LE ? (kl <= th) : (kl > th); x = ok ? x : -1.0e30f; }
        a[i] = fast_exp2(x);
    }
}
template <int MASK>
DI void attn_tile_dm(const LAS char* Kt, const LAS char* Vt, const ALane& L, int ko0, int ko1, const bf16x8 (&qf)[2], f32x16 (&O)[2], f32x16& Ls, const f32x16& negm, const bf16x8& ones, int th, int hh) {
    bf16x8 pf[2][2];
#pragma unroll
    for (int kb = 0; kb < 2; ++kb) {
        const bf16x8 k0 = *(const LAS bf16x8*)(Kt + ko0 + kb * 4096), k1 = *(const LAS bf16x8*)(Kt + ko1 + kb * 4096);
        f32x16 acc = MFMA32(k0, qf[0], negm); acc = MFMA32(k1, qf[1], acc);
        ex16<MASK>(acc, kb, hh, th);
        Ls[0] += sum16(acc);
        pf[kb][0] = pfrag(acc, 0); pf[kb][1] = pfrag(acc, 1);
    }
#pragma unroll
    for (int kb = 0; kb < 2; ++kb)
#pragma unroll
        for (int s = 0; s < 2; ++s)
#pragma unroll
            for (int db = 0; db < 2; ++db) O[db] = MFMA32(vfrag(Vt, L, db, kb, s), pf[kb][s], O[db]);
}
#define RING_WAIT(n) asm volatile("s_waitcnt vmcnt(" #n ")" ::: "memory")
template <class PreF, class CompF>
DI void attn_ring(LAS char* lds, const bf16_t* Kg, const bf16_t* Vg, unsigned tiles, int wid, int lane, PreF pre, CompF comp) {
    if (tiles == 0u) return;
    const int p = wid * 64 + lane, row = p >> 3, c = p & 7;
    const unsigned ksrc = (unsigned)(row * 128 + ((c ^ ((row >> 1) & 7)) << 4)), vsrc = (unsigned)(row * 128 + ((c ^ (((row >> 1) & 1) << 2)) << 4));
    LAS char* wb = lds + wid * 1024;
#define RING_ISSUE(j, slot) do { \
        glds16((const char*)(Kg) + (size_t)(j) * 8192 + ksrc, (unsigned)__builtin_amdgcn_readfirstlane((int)(lds_addr(wb) + (unsigned)(slot) * 16384u))); \
        glds16((const char*)(Vg) + (size_t)(j) * 8192 + vsrc, (unsigned)__builtin_amdgcn_readfirstlane((int)(lds_addr(wb) + (unsigned)(slot) * 16384u + 8192u))); } while (0)
    int q0 = __builtin_ctz(tiles); tiles &= tiles - 1u;
    int q1 = -1, q2 = -1;
    if (tiles) { q1 = __builtin_ctz(tiles); tiles &= tiles - 1u; }
    if (tiles) { q2 = __builtin_ctz(tiles); tiles &= tiles - 1u; }
    RING_ISSUE(q0, 0);
    if (q1 >= 0) RING_ISSUE(q1, 1);
    if (q2 >= 0) RING_ISSUE(q2, 2);
    pre();
    int i = 0;
    for (;;) {
        if (q2 >= 0) RING_WAIT(4); else if (q1 >= 0) RING_WAIT(2); else RING_WAIT(0);
        __builtin_amdgcn_s_barrier();
        int q3 = -1;
        if (tiles) { q3 = __builtin_ctz(tiles); tiles &= tiles - 1u; RING_ISSUE(q3, (i + 3) & 3); }
        LAS char* st = lds + (i & 3) * 16384;
        comp(q0, st, st + 8192);
        if (q1 < 0) break;
        q0 = q1; q1 = q2; q2 = q3; ++i;
    }
    asm volatile("s_waitcnt lgkmcnt(0)" ::: "memory");
    __builtin_amdgcn_s_barrier();
#undef RING_ISSUE
}

DI void diff_unit(Frame& F, int b, int hd, int qb, float c2, float mc, float lam) {
    const int tid = F.tid, lane = F.lane, wid = F.wave, r = lane & 31, hh = lane >> 5;
    const int rb = wid >> 1, mp = wid & 1;
    const bf16_t* Q = (const bf16_t*)(F.ws + WS_DQ) + ((size_t)b * 8 + hd) * SEQ * 64;
    const bf16_t* Kg = (const bf16_t*)(F.ws + WS_DK) + ((size_t)b * 8 + hd) * SEQ * 64;
    const bf16_t* Vg = (const bf16_t*)(F.ws + WS_DV) + ((size_t)b * 8 + hd) * SEQ * 64;
    LAS char* lds = (LAS char*)F.lds;
    const ALane L = alane_init(lane);
    const int ko0 = L.ko(2 * mp), ko1 = L.ko(2 * mp + 1);
    const int q0w = qb * 128 + rb * 32; const int qq = q0w + r;
    bf16x8 qf[2];
#pragma unroll
    for (int ks = 0; ks < 2; ++ks) { const u32x4 w = *(const u32x4*)(Q + (size_t)qq * 64 + mp * 32 + ks * 16 + hh * 8);
        u32x4 s; s.x = pk2(bflo(w.x) * c2, bfhi(w.x) * c2); s.y = pk2(bflo(w.y) * c2, bfhi(w.y) * c2); s.z = pk2(bflo(w.z) * c2, bfhi(w.z) * c2); s.w = pk2(bflo(w.w) * c2, bfhi(w.w) * c2);
        qf[ks] = __builtin_bit_cast(bf16x8, s); }
    f32x16 O[2], Ls, negm; bf16x8 ones;
#pragma unroll
    for (int i = 0; i < 16; ++i) { O[0][i] = 0.f; O[1][i] = 0.f; Ls[i] = 0.f; negm[i] = -mc; }
#pragma unroll
    for (int i = 0; i < 8; ++i) ones[i] = (short)0x3f80;
    asm volatile("" : "+v"(negm), "+v"(ones));
    const int ntile = 2 * qb + 2; const int jmax = 2 * qb + (rb >> 1);
    const unsigned tiles = ntile == 32 ? 0xffffffffu : ((1u << ntile) - 1u);
    attn_ring(lds, Kg, Vg, tiles, wid, lane, [&]() __attribute__((always_inline)) { asm volatile("" : "+v"(qf[0]), "+v"(qf[1])); },
        [&](int j, const LAS char* Kt, const LAS char* Vt) __attribute__((always_inline)) {
        if (j < jmax) attn_tile_dm<MK_NONE>(Kt, Vt, L, ko0, ko1, qf, O, Ls, negm, ones, 0, hh);
        else if (j == jmax) attn_tile_dm<MK_LE>(Kt, Vt, L, ko0, ko1, qf, O, Ls, negm, ones, qq - 64 * j, hh);
    });
    float lsum = Ls[0]; lsum += __shfl_xor(lsum, 32);
    LAS float* xo = (LAS float*)(lds + 65536 + rb * 8192) + lane;
    if (mp == 1) { const float s1 = lam / lsum;
#pragma unroll
        for (int db = 0; db < 2; ++db)
#pragma unroll
            for (int i = 0; i < 16; ++i) xo[(db * 16 + i) * 64] = O[db][i] * s1; }
    __syncthreads();
    if (mp == 0) {
        const float i0 = 1.f / lsum; float ss = 0.f;
#pragma unroll
        for (int db = 0; db < 2; ++db)
#pragma unroll
            for (int i = 0; i < 16; ++i) { const float o = O[db][i] * i0 - xo[(db * 16 + i) * 64]; O[db][i] = o; ss += o * o; }
        ss += __shfl_xor(ss, 32);
        const float rstd = rsqrtf(ss * (1.f / 64.f) + EPS) * 0.8f;
        const float* go = F.in[18];
        bf16_t* orow = (bf16_t*)(F.ws + WS_AO) + ((size_t)b * SEQ + qq) * DM + 512 + hd * 64;
        u32x2 o2[8];
#pragma unroll
        for (int db = 0; db < 2; ++db)
#pragma unroll
            for (int g4 = 0; g4 < 4; ++g4) { const int d = 32 * db + 8 * g4 + 4 * hh; const f32x4 gv = *(const f32x4*)(go + d);
                o2[4 * db + g4].x = pk2(O[db][4 * g4] * rstd * gv[0], O[db][4 * g4 + 1] * rstd * gv[1]); o2[4 * db + g4].y = pk2(O[db][4 * g4 + 2] * rstd * gv[2], O[db][4 * g4 + 3] * rstd * gv[3]); }
        store_row64(orow, o2, hh);
    }
}

#define NSA_BAR() do { asm volatile("s_waitcnt lgkmcnt(0)" ::: "memory"); __builtin_amdgcn_s_barrier(); asm volatile("" ::: "memory"); } while (0)
DI void nsa_unit(Frame& F, int b, int g, int qb, float c2, float mc) {
    const int lane = F.lane, wid = F.wave, r = lane & 31, hh = lane >> 5;
    const int hd = 4 * g + (wid >> 1); const int tl = 32 * (wid & 1) + r; const int t = 64 * qb + tl;
    LAS char* lds = (LAS char*)F.lds;
    LAS float* impP = (LAS float*)(lds + 65536);
    LAS unsigned* selm = (LAS unsigned*)(lds + LDS_MISC + 5120);
    LAS float* invs = (LAS float*)(selm + 128);
    LAS float* otp = (LAS float*)(lds + 65536 + wid * 8192) + lane;
    LAS float* gpark = (LAS float*)(lds + LDS_MISC + 8192 + wid * 768) + lane;
    const ALane L = alane_init(lane);
    const size_t bg = (size_t)b * 2 + g;
    bf16x8 qf[4];
    { const bf16_t* QN = (const bf16_t*)(F.ws + WS_QN) + (((size_t)b * 8 + hd) * SEQ + t) * 64;
#pragma unroll
      for (int ks = 0; ks < 4; ++ks) qf[ks] = *(const bf16x8*)(QN + ks * 16 + hh * 8);
      const float* gates = (const float*)(F.ws + WS_GATES) + ((size_t)b * SEQ + t) * 24 + hd * 3;
      const float g0_ = gates[0], g1_ = gates[1], g2_ = gates[2]; gpark[0] = g0_; gpark[64] = g1_; gpark[128] = g2_; }
    const char* KcB = (const char*)(F.ws + WS_KCMP) + bg * 16384; const char* VcB = (const char*)(F.ws + WS_VCMP) + bg * 16384;
    const char* KsB = (const char*)(F.ws + WS_KS) + bg * (SEQ * 128); const char* VsB = (const char*)(F.ws + WS_VS) + bg * (SEQ * 128);
    const char* KwB = (const char*)(F.ws + WS_KW) + bg * (SEQ * 128); const char* VwB = (const char*)(F.ws + WS_VW) + bg * (SEQ * 128);
    const int nf = qb == 0 ? 1 : (qb == 1 ? 2 : 3); const int f1 = qb == 1 ? 1 : qb - 1, f2 = qb;
    const unsigned fmask = 1u | (qb >= 1 ? (1u << qb) : 0u) | (qb >= 2 ? (1u << (qb - 1)) : 0u);
    const unsigned allb = qb == 31 ? 0xffffffffu : ((1u << (qb + 1)) - 1u);
    unsigned grest = qb <= 5 ? (allb & ~fmask) : 0u;
    const int jlo = qb >= 4 ? qb - 4 : 0;
    int gph = 0, gi = 0;
    const int p_ = wid * 64 + lane, prow = p_ >> 3, pc = p_ & 7;
    const unsigned ksrc = (unsigned)(prow * 128 + ((pc ^ ((prow >> 1) & 7)) << 4)), vsrc = (unsigned)(prow * 128 + ((pc ^ (((prow >> 1) & 1) << 2)) << 4));
    const unsigned wbase = lds_addr(lds) + (unsigned)wid * 1024u;
#define NSA_GEN(ty, jj) do { ty = -1; jj = 0; \
        if (gph == 0) { ty = 0; jj = gi; if (++gi == 2) { gph = 1; gi = 0; } } \
        else if (gph == 1) { ty = 1; jj = gi == 0 ? 0 : (gi == 1 ? f1 : f2); if (++gi == nf) gph = 2; } \
        else { if (gph == 2) { if (grest) { ty = 1; jj = __builtin_ctz(grest); grest &= grest - 1u; } else { gph = 3; gi = jlo; } } \
               if (gph == 3) { if (gi <= qb) { ty = 2; jj = gi++; } else gph = 4; } } } while (0)
#define NSA_ISSUE(ty, jj, slot) do { const char* kp_ = ty == 0 ? KcB : (ty == 1 ? KsB : KwB); const char* vp_ = ty == 0 ? VcB : (ty == 1 ? VsB : VwB); \
        glds16(kp_ + (size_t)(jj) * 8192 + ksrc, (unsigned)__builtin_amdgcn_readfirstlane((int)(wbase + (unsigned)(slot) * 16384u))); \
        glds16(vp_ + (size_t)(jj) * 8192 + vsrc, (unsigned)__builtin_amdgcn_readfirstlane((int)(wbase + (unsigned)(slot) * 16384u + 8192u))); } while (0)
    int t0, j0, t1, j1, t2, j2;
    NSA_GEN(t0, j0); NSA_GEN(t1, j1); NSA_GEN(t2, j2);
    NSA_ISSUE(t0, j0, 0); NSA_ISSUE(t1, j1, 1); if (t2 >= 0) NSA_ISSUE(t2, j2, 2);
#pragma unroll
    for (int ks = 0; ks < 4; ++ks) asm volatile("" : "+v"(qf[ks]));
    f32x16 O[2]; float lv = 0.f; float carry_in = 0.f; unsigned mym = 0u; bool inB = false;
#pragma unroll
    for (int i = 0; i < 16; ++i) { O[0][i] = 0.f; O[1][i] = 0.f; }
    const int nvalid = t >= 31 ? ((t - 31) >> 4) + 1 : 0;
    for (int n = 0;; ++n) {
        if (t2 >= 0) RING_WAIT(4); else if (t1 >= 0) RING_WAIT(2); else RING_WAIT(0);
        __builtin_amdgcn_s_barrier();
        int t3, j3;
        NSA_GEN(t3, j3);
        if (t3 >= 0) NSA_ISSUE(t3, j3, (n + 3) & 3);
        const LAS char* Kt = lds + (n & 3) * 16384; const LAS char* Vt = Kt + 8192;
        int mode = MK_LE, th = tl; float mcl = mc;
        if (t0 == 0) { th = nvalid - 1 - 64 * j0; }
        else if (t0 == 1) { mcl = ((mym >> j0) & 1u) ? mc : 1.0e30f; mode = j0 < qb ? MK_NONE : MK_LE; }
        else {
            if (inB) {
                float lsum = lv; lsum += __shfl_xor(lsum, 32); const float s1 = gpark[64] / lsum;
#pragma unroll
                for (int db = 0; db < 2; ++db)
#pragma unroll
                    for (int i = 0; i < 16; ++i) { otp[(db * 16 + i) * 64] += O[db][i] * s1; O[db][i] = 0.f; }
                lv = 0.f; inB = false;
            }
            mode = j0 == qb ? MK_LE : (j0 == qb - 4 ? MK_GT : MK_NONE);
        }
        if (t0 != 0) {
            f32x16 Pd[2];
            if (mode == MK_NONE) attn_tile64<MK_NONE, false>(Kt, Vt, L, qf, O, lv, c2, mcl, 0, hh, Pd);
            else if (mode == MK_LE) attn_tile64<MK_LE, false>(Kt, Vt, L, qf, O, lv, c2, mcl, th, hh, Pd);
            else attn_tile64<MK_GT, false>(Kt, Vt, L, qf, O, lv, c2, mcl, th, hh, Pd);
        } else {
            f32x16 P[2];
            attn_tile64<MK_LE, true>(Kt, Vt, L, qf, O, lv, c2, mcl, th, hh, P);
            LAS float* ip = impP + ((wid >> 1) * 64 + tl) * 33;
            float av[8], rc[8];
#pragma unroll
            for (int kb = 0; kb < 2; ++kb)
#pragma unroll
                for (int gq = 0; gq < 4; ++gq) { const int f = 4 * kb + gq; const float p3 = 0.5f * P[kb][4 * gq + 3]; av[f] = P[kb][4 * gq] + P[kb][4 * gq + 1] + P[kb][4 * gq + 2] + p3; rc[f] = __shfl_xor(p3, 32); }
#pragma unroll
            for (int f = 0; f < 8; ++f) { const float carry = hh == 1 ? rc[f] : (f > 0 ? rc[f > 0 ? f - 1 : 0] : carry_in); ip[2 * (8 * j0 + f) + hh] = av[f] + carry; }
            carry_in = rc[7];
            if (j0 == 1) {
                {
                    const f32x4* rp = (const f32x4*)((const float*)(F.ws + WS_ROPE) + t * 16);
                    const f32x4 r0 = rp[0], r1 = rp[1], r2 = rp[2], r3 = rp[3];
                    const u32x4 own = __builtin_bit_cast(u32x4, qf[0]);
                    u32x4 oth; oth.x = (unsigned)__shfl_xor((int)own.x, 32); oth.y = (unsigned)__shfl_xor((int)own.y, 32); oth.z = (unsigned)__shfl_xor((int)own.z, 32); oth.w = (unsigned)__shfl_xor((int)own.w, 32);
                    const float a[8] = {bflo(own.x), bfhi(own.x), bflo(own.y), bfhi(own.y), bflo(own.z), bfhi(own.z), bflo(own.w), bfhi(own.w)};
                    const float p[8] = {bflo(oth.x), bfhi(oth.x), bflo(oth.y), bfhi(oth.y), bflo(oth.z), bfhi(oth.z), bflo(oth.w), bfhi(oth.w)};
                    const float cs[8] = {r0[0], r0[2], r1[0], r1[2], r2[0], r2[2], r3[0], r3[2]}, sn[8] = {r0[1], r0[3], r1[1], r1[3], r2[1], r2[3], r3[1], r3[3]};
                    float o[8];
#pragma unroll
                    for (int i = 0; i < 8; ++i) o[i] = hh == 0 ? (a[i] * cs[i] - p[i] * sn[i]) : (p[i] * sn[i] + a[i] * cs[i]);
                    u32x4 w; w.x = pk2(o[0], o[1]); w.y = pk2(o[2], o[3]); w.z = pk2(o[4], o[5]); w.w = pk2(o[6], o[7]);
                    qf[0] = __builtin_bit_cast(bf16x8, w); }
                float lsum = lv; lsum += __shfl_xor(lsum, 32);
                const float inv = lsum > 0.f ? 1.f / lsum : 0.f;
                if (hh == 0) invs[(wid >> 1) * 64 + tl] = inv;
                const float s0 = gpark[0] * inv;
                lv = 0.f;
                NSA_BAR();
                if (wid == 0) {
                    unsigned m;
                    if (qb <= 5) m = allb;
                    else {
                        m = fmask;
                        float best[3] = {-1.f, -1.f, -1.f}; int bi[3] = {0, 0, 0}; const float iv0 = invs[lane], iv1 = invs[64 + lane], iv2 = invs[128 + lane], iv3 = invs[192 + lane];
                        for (int j = 1; j <= qb - 2; ++j) {
                            const float v = (impP[(0 * 64 + lane) * 33 + j] * iv0 + impP[(1 * 64 + lane) * 33 + j] * iv1) + (impP[(2 * 64 + lane) * 33 + j] * iv2 + impP[(3 * 64 + lane) * 33 + j] * iv3);
                            if (v > best[0]) { best[2] = best[1]; bi[2] = bi[1]; best[1] = best[0]; bi[1] = bi[0]; best[0] = v; bi[0] = j; }
                            else if (v > best[1]) { best[2] = best[1]; bi[2] = bi[1]; best[1] = v; bi[1] = j; }
                            else if (v > best[2]) { best[2] = v; bi[2] = j; }
                        }
                        m |= (1u << bi[0]) | (1u << bi[1]) | (1u << bi[2]);
                    }
                    selm[lane] = m;
                    unsigned u = m;
#pragma unroll
                    for (int o = 1; o < 64; o <<= 1) u |= (unsigned)__shfl_xor((int)u, o);
                    if (lane == 0) selm[64] = u;
                }
                NSA_BAR();
                mym = selm[tl];
                if (qb > 5) grest = (unsigned)__builtin_amdgcn_readfirstlane((int)selm[64]) & ~fmask;
#pragma unroll
                for (int db = 0; db < 2; ++db)
#pragma unroll
                    for (int i = 0; i < 16; ++i) { otp[(db * 16 + i) * 64] = O[db][i] * s0; O[db][i] = 0.f; }
                inB = true;
            }
        }
        if (t1 < 0) break;
        t0 = t1; j0 = j1; t1 = t2; j1 = j2; t2 = t3; j2 = j3;
    }
    {
        float lsum = lv; lsum += __shfl_xor(lsum, 32); const float s2 = gpark[128] / lsum;
#pragma unroll
        for (int db = 0; db < 2; ++db)
#pragma unroll
            for (int i = 0; i < 16; ++i) O[db][i] = otp[(db * 16 + i) * 64] + O[db][i] * s2;
    }
    bf16_t* orow = (bf16_t*)(F.ws + WS_AO) + ((size_t)b * SEQ + t) * DM + hd * 64;
    { u32x2 o2[8];
#pragma unroll
      for (int db = 0; db < 2; ++db)
#pragma unroll
          for (int g4 = 0; g4 < 4; ++g4) { o2[4 * db + g4].x = pk2(O[db][4 * g4], O[db][4 * g4 + 1]); o2[4 * db + g4].y = pk2(O[db][4 * g4 + 2], O[db][4 * g4 + 3]); }
      store_row64(orow, o2, hh); }
    NSA_BAR();
#undef NSA_GEN
#undef NSA_ISSUE
}

DI float gmax(const float* g, int n, int lane) { float v = lane < n ? fabsf(g[lane]) : 0.f;
#pragma unroll
    for (int o = 1; o < 64; o <<= 1) v = fmaxf(v, __shfl_xor(v, o));
    return v; }

DI int queue_next(Frame& F, unsigned* ctr) {
    LAS int* slot = (LAS int*)(F.lds + LDS_MISC + 4096);
    __syncthreads();
    if (F.tid == 0) *slot = (int)atomicAdd(ctr, 1u);
    __syncthreads();
    return *slot;
}

DI int queue_pass(Frame& F, unsigned nx) {
    LAS int* slot = (LAS int*)(F.lds + LDS_MISC + 4096);
    __syncthreads();
    if (F.tid == 0) *slot = (int)nx;
    __syncthreads();
    return *slot;
}

DI float gelu_tanh(float x) { const float u = 0.7978845608028654f * (x + 0.044715f * x * x * x); const float e = __expf(2.f * u); const float th = 1.f - 2.f / (e + 1.f); return 0.5f * x * (1.f + th); }
DI void phase5(Frame& F) {
    const bf16_t* UL = (const bf16_t*)(F.ws + WS_UL); const float* w2 = F.in[11]; const float* gk0 = F.in[8];
    LAS float* w2s = (LAS float*)F.lds;
    LAS float* hid = (LAS float*)(F.lds + LDS_MISC + 8192 + F.wave * 1024);
    for (int i = F.tid; i < 2 * 256 * 64 / 4; i += NTHREADS) ((LAS f32x4*)w2s)[i] = ((const f32x4*)w2)[i];
    __syncthreads();
    const int lane = F.lane;
    for (int it0 = F.gw * 8; it0 < 2 * 64 * 128; it0 += F.NGW * 8) {
        const int kv = it0 >> 13, rem0 = it0 & 8191, bgi = rem0 >> 7, c0 = rem0 & 127;
        const size_t perow = 16384 + (size_t)kv * 256 + (size_t)kv * 2;
        const u32x2 pu = *(const u32x2*)(UL + perow * 512 + 4 * lane), pl = *(const u32x2*)(UL + (perow + 1) * 512 + 256 + 4 * lane);
        const size_t row0 = (size_t)kv * 8192 + (size_t)bgi * 128 + c0;
        u32x2 uu[8], ll[8];
#pragma unroll
        for (int q = 0; q < 8; ++q) { const size_t row = row0 + q; const bool ok = c0 + q < 127;
            uu[q] = ok ? *(const u32x2*)(UL + row * 512 + 4 * lane) : (u32x2){0u, 0u}; ll[q] = ok ? *(const u32x2*)(UL + (row + 1) * 512 + 256 + 4 * lane) : (u32x2){0u, 0u}; }
        const LAS float* w = w2s + kv * 256 * 64 + lane;
#pragma unroll 1
        for (int q = 0; q < 8; ++q) {
            const int c = c0 + q;
            bf16_t* dst = (bf16_t*)(F.ws + (kv ? WS_VCMP : WS_KCMP)) + ((size_t)bgi * 128 + c) * 64;
            u32x2 u4 = uu[0], l4 = ll[0];
#pragma unroll
            for (int z = 1; z < 8; ++z) { if (q == z) { u4 = uu[z]; l4 = ll[z]; } }
            if (c == 127) { dst[lane] = 0; continue; }
            float h[4];
            h[0] = bflo(u4.x) + bflo(l4.x) + bflo(pu.x) + bflo(pl.x); h[1] = bfhi(u4.x) + bfhi(l4.x) + bfhi(pu.x) + bfhi(pl.x);
            h[2] = bflo(u4.y) + bflo(l4.y) + bflo(pu.y) + bflo(pl.y); h[3] = bfhi(u4.y) + bfhi(l4.y) + bfhi(pu.y) + bfhi(pl.y);
            f32x4 hv;
#pragma unroll
            for (int i = 0; i < 4; ++i) hv[i] = gelu_tanh(h[i]);
            *(LAS f32x4*)(hid + 4 * lane) = hv;
            asm volatile("s_waitcnt lgkmcnt(0)" ::: "memory");
            float acc0 = 0.f, acc1 = 0.f;
#pragma unroll 8
            for (int k = 0; k < 256; k += 4) { const f32x4 hh4 = *(const LAS f32x4*)(hid + k);
                acc0 += hh4[0] * w[(k + 0) * 64]; acc1 += hh4[1] * w[(k + 1) * 64]; acc0 += hh4[2] * w[(k + 2) * 64]; acc1 += hh4[3] * w[(k + 3) * 64]; }
            float acc = acc0 + acc1;
            if (kv == 0) { const float ss = wave_sum(acc * acc); acc = acc * rsqrtf(ss * (1.f / 64.f) + EPS) * gk0[lane]; }
            dst[lane] = f2bf(acc);
            asm volatile("s_waitcnt lgkmcnt(0)" ::: "memory");
        }
    }
    __syncthreads();
}

DI void phase8(Frame& F) {
    const bf16_t* x1 = (const bf16_t*)(F.ws + WS_X1B); const float* gf = F.in[5]; const float* mod = (const float*)(F.ws + WS_MOD); const float* rowss = (const float*)(F.ws + WS_ROWSS);
    const char* wsrc = (const char*)(F.ws + WS_WR);
    unsigned char* h2 = (unsigned char*)(F.ws + WS_H2);
    unsigned* cnt = (unsigned*)(F.ws + WS_CTL) + CW_CNT; int* lists = (int*)(F.ws + WS_LIST);
    int* tipos = (int*)(F.ws + WS_TIPOS); int* tie = (int*)(F.ws + WS_TIE); float* tiw = (float*)(F.ws + WS_TIW);
    const float* brg = F.in[21]; const float* bre = F.in[23];
    const int lane = F.lane, wid = F.wave, row = lane & 15, kq = lane >> 4;
    LAS char* wl = (LAS char*)F.lds;
    LAS float* lg = (LAS float*)(F.lds + 98304 + wid * 3072);
    LAS float* A2 = (LAS float*)(F.lds + 122880);
    LAS float* B2 = A2 + 1024;
    LAS unsigned* hist = (LAS unsigned*)(F.lds + LDS_MISC + 8192);
    unsigned wso[6];
#pragma unroll
    for (int i = 0; i < 6; ++i) { const int s = i * 512 + F.tid, part = s / 1536, r = (s >> 5) % 48, cs = s & 31; wso[i] = (unsigned)(part * 98304 + r * 2048 + ((cs ^ (r & 15)) << 4)); }
#define P8_ISSUE(kc, buf) do { _Pragma("unroll") for (int i_ = 0; i_ < 6; ++i_) \
        __builtin_amdgcn_global_load_lds((const unsigned*)(wsrc + (size_t)(kc) * 512 + wso[i_]), (LAS unsigned*)(wl + (buf) * 49152 + i_ * 8192 + wid * 1024), 16, 0, 0); } while (0)
    const int nbatch = TOK / 128;
    for (int bt = F.bid; bt < nbatch; bt += F.G) {
        const int m0 = bt * 128 + wid * 16; const int m = m0 + row; const int b = m0 >> 11;
        P8_ISSUE(0, 0);
        { const float* sh = mod + (size_t)b * 6144 + 3072; const float* sc = sh + 1024;
          for (int k = F.tid; k < 1024; k += NTHREADS) { A2[k] = gf[k] * (sc[k] + 1.f); B2[k] = sh[k]; } }
        if (F.tid < 64) hist[F.tid] = 0u;
        float rs = 0.f; { const f32x4* rp = (const f32x4*)(rowss + (size_t)m * 16);
#pragma unroll
            for (int q = 0; q < 4; ++q) { const f32x4 v = rp[q]; rs += (v[0] + v[1]) + (v[2] + v[3]); } }
        const float rstd = rsqrtf(rs * (1.f / DM) + EPS);
        const bf16_t* xrow = x1 + (size_t)m * DM + 8 * kq; unsigned char* hrow = h2 + (size_t)m * DM + 8 * kq;
        u32x4 xw[4];
#pragma unroll
        for (int u = 0; u < 4; ++u) xw[u] = *(const u32x4*)(xrow + 32 * u);
        f32x4 acc[3] = {{0.f, 0.f, 0.f, 0.f}, {0.f, 0.f, 0.f, 0.f}, {0.f, 0.f, 0.f, 0.f}};
        for (int kc = 0; kc < 4; ++kc) {
            asm volatile("s_waitcnt vmcnt(0)" ::: "memory");
            __syncthreads();
            if (kc + 1 < 4) P8_ISSUE(kc + 1, (kc + 1) & 1);
            const LAS char* wb = wl + (kc & 1) * 49152;
#pragma unroll 1
            for (int g4 = 0; g4 < 2; ++g4) {
                const int gg = kc * 2 + g4;
                u32x4 nw[4];
                if (gg + 1 < 8) {
#pragma unroll
                    for (int u = 0; u < 4; ++u) nw[u] = *(const u32x4*)(xrow + 128 * (gg + 1) + 32 * u);
                }
#pragma unroll
                for (int u = 0; u < 4; ++u) {
                    const int k0 = 128 * gg + 32 * u + 8 * kq;
                    const f32x4 a0 = *(const LAS f32x4*)(A2 + k0), a1 = *(const LAS f32x4*)(A2 + k0 + 4), b0 = *(const LAS f32x4*)(B2 + k0), b1 = *(const LAS f32x4*)(B2 + k0 + 4);
                    const f32x4 xa_ = {bflo(xw[u].x), bfhi(xw[u].x), bflo(xw[u].y), bfhi(xw[u].y)}, xb_ = {bflo(xw[u].z), bfhi(xw[u].z), bflo(xw[u].w), bfhi(xw[u].w)};
                    const f32x4 ya = xa_ * rstd * a0 + b0, yb = xb_ * rstd * a1 + b1;
                    u32x4 hi; hi.x = pk2(ya[0], ya[1]); hi.y = pk2(ya[2], ya[3]); hi.z = pk2(yb[0], yb[1]); hi.w = pk2(yb[2], yb[3]);
                    { u32x2 h8; h8.x = pk4_fp8(ya[0], ya[1], ya[2], ya[3]); h8.y = pk4_fp8(yb[0], yb[1], yb[2], yb[3]); *(u32x2*)(hrow + 128 * gg + 32 * u) = h8; }
                    u32x4 lo; lo.x = pk2(ya[0] - bflo(hi.x), ya[1] - bfhi(hi.x)); lo.y = pk2(ya[2] - bflo(hi.y), ya[3] - bfhi(hi.y)); lo.z = pk2(yb[0] - bflo(hi.z), yb[1] - bfhi(hi.z)); lo.w = pk2(yb[2] - bflo(hi.w), yb[3] - bfhi(hi.w));
                    const bf16x8 ahi = __builtin_bit_cast(bf16x8, hi), alo = __builtin_bit_cast(bf16x8, lo);
                    const int ch = (g4 * 4 + u) * 4 + kq;
#pragma unroll
                    for (int ct = 0; ct < 3; ++ct) { const int r = 16 * ct + row; const int off = r * 512 + ((ch ^ row) << 4);
                        const bf16x8 bh = *(const LAS bf16x8*)(wb + off), bl = *(const LAS bf16x8*)(wb + 24576 + off);
                        acc[ct] = MFMA16(ahi, bh, acc[ct]); acc[ct] = MFMA16(alo, bh, acc[ct]); acc[ct] = MFMA16(ahi, bl, acc[ct]); }
                }
#pragma unroll
                for (int u = 0; u < 4; ++u) xw[u] = nw[u];
            }
        }
#pragma unroll
        for (int ct = 0; ct < 3; ++ct)
#pragma unroll
            for (int i = 0; i < 4; ++i) lg[(kq * 4 + i) * 48 + 16 * ct + row] = acc[ct][i];
        asm volatile("s_waitcnt lgkmcnt(0)" ::: "memory");
        int e0 = 0, e1 = 0; float w0 = 0.f, w1 = 0.f; unsigned lp0 = 0u, lp1 = 0u;
        if (lane < 16) {
            const LAS float* lr = lg + lane * 48;
            float g4v[4]; int grp = 0; float gm = -3.0e38f;
#pragma unroll
            for (int i = 0; i < 4; ++i) { g4v[i] = lr[i] + brg[i]; if (g4v[i] > gm) { gm = g4v[i]; grp = i; } }
            float den = 0.f;
#pragma unroll
            for (int i = 0; i < 4; ++i) den += __expf(g4v[i] - gm);
            const float pg = 1.f / den;
            float v0 = -3.0e38f, v1 = -3.0e38f; int i0 = 0, i1 = 0;
            for (int i = 0; i < 8; ++i) { const float v = lr[4 + grp * 8 + i] + bre[grp * 8 + i];
                if (v > v0) { v1 = v0; i1 = i0; v0 = v; i0 = i; } else if (v > v1) { v1 = v; i1 = i; } }
            const float ex = __expf(v1 - v0); w0 = pg / (1.f + ex); w1 = pg * ex / (1.f + ex);
            e0 = grp * 8 + i0; e1 = grp * 8 + i1;
            lp0 = atomicAdd((unsigned*)&hist[e0], 1u); lp1 = atomicAdd((unsigned*)&hist[e1], 1u);
        }
        __syncthreads();
        if (F.tid < 32) { const unsigned n = hist[F.tid]; hist[32 + F.tid] = n ? atomicAdd(cnt + F.tid, n) : 0u; }
        __syncthreads();
        if (lane < 16) {
            const int tok = m0 + lane; const int p0 = (int)(hist[32 + e0] + lp0), p1 = (int)(hist[32 + e1] + lp1);
            lists[(size_t)e0 * ECAP + p0] = tok; lists[(size_t)e1 * ECAP + p1] = tok;
            tipos[2 * tok] = p0; tipos[2 * tok + 1] = p1; tie[tok] = e0 | (e1 << 8); tiw[2 * tok] = w0; tiw[2 * tok + 1] = w1;
        }
        __syncthreads();
    }
#undef P8_ISSUE
}

DI LAS int* moe_prefix(Frame& F) {
    LAS int* tb = (LAS int*)(F.lds + LDS_MISC);
    __syncthreads();
    if (F.wave == 0) {
        const unsigned* cnt = (const unsigned*)(F.ws + WS_CTL) + CW_CNT; const int l = F.lane;
        int v = l < 32 ? (int)((__hip_atomic_load(cnt + l, __ATOMIC_RELAXED, __HIP_MEMORY_SCOPE_AGENT) + 255u) >> 8) : 0;
#pragma unroll
        for (int o = 1; o < 32; o <<= 1) { const int u = __shfl_up(v, o); if (l >= o) v += u; }
        if (l < 32) tb[l + 1] = v;
        if (l == 0) tb[0] = 0;
    }
    __syncthreads();
    return tb;
}

DI void phase11(Frame& F) {
    LAS int* tb = moe_prefix(F);
    const unsigned char* Y = (const unsigned char*)(F.ws + WS_Y); const float* mod = (const float*)(F.ws + WS_MOD);
    const int* tipos = (const int*)(F.ws + WS_TIPOS); const int* tie = (const int*)(F.ws + WS_TIE); const float* tiw = (const float*)(F.ws + WS_TIW);
    const int lane = F.lane;
    for (int m0 = F.gw * 32; m0 < TOK; m0 += F.NGW * 32) {
        const int b = m0 >> 11; const float* g2 = mod + (size_t)b * 6144 + 5120;
        f32x4 ga[2], gb[2];
#pragma unroll
        for (int j = 0; j < 2; ++j) { ga[j] = *(const f32x4*)(g2 + 8 * lane + 512 * j); gb[j] = *(const f32x4*)(g2 + 8 * lane + 512 * j + 4); }
        int mr0 = 0, mr1 = 0; float mw0 = 0.f, mw1 = 0.f;
        { const int mm = m0 + (lane & 31); const int ee = tie[mm]; mr0 = tb[ee & 255] * 256 + tipos[2 * mm]; mr1 = tb[ee >> 8] * 256 + tipos[2 * mm + 1]; mw0 = tiw[2 * mm]; mw1 = tiw[2 * mm + 1]; }
        float* obase = F.out + (size_t)m0 * DM + 8 * lane; const bf16_t* xbase = (const bf16_t*)(F.ws + WS_X1B) + (size_t)m0 * DM + 8 * lane;
#define P11_LOAD(i, ya, yb, xa, xb) do { const size_t r0_ = (size_t)__shfl(mr0, (i)), r1_ = (size_t)__shfl(mr1, (i)); \
            _Pragma("unroll") for (int j = 0; j < 2; ++j) { ya[j] = __builtin_nontemporal_load((const u32x2*)(Y + r0_ * DM + 8 * lane + 512 * j)); yb[j] = __builtin_nontemporal_load((const u32x2*)(Y + r1_ * DM + 8 * lane + 512 * j)); \
                const u32x4 xw_ = ldntu4(xbase + (size_t)(i) * DM + 512 * j); xa[j] = (f32x4){bflo(xw_.x), bfhi(xw_.x), bflo(xw_.y), bfhi(xw_.y)}; xb[j] = (f32x4){bflo(xw_.z), bfhi(xw_.z), bflo(xw_.w), bfhi(xw_.w)}; } } while (0)
        u32x2 ya0[2], yb0[2], ya1[2], yb1[2]; f32x4 xa0[2], xb0[2], xa1[2], xb1[2];
        P11_LOAD(0, ya0, yb0, xa0, xb0); P11_LOAD(1, ya1, yb1, xa1, xb1);
        for (int i = 0; i < 32; i += 2) {
            u32x2 nya0[2], nyb0[2], nya1[2], nyb1[2]; f32x4 nxa0[2], nxb0[2], nxa1[2], nxb1[2];
            if (i + 2 < 32) { P11_LOAD(i + 2, nya0, nyb0, nxa0, nxb0); P11_LOAD(i + 3, nya1, nyb1, nxa1, nxb1); }
#define P11_ROW(i, ya, yb, xa, xb) do { const float w0 = __shfl(mw0, (i)), w1 = __shfl(mw1, (i)); \
            _Pragma("unroll") for (int j = 0; j < 2; ++j) { f32x4 oa = xa[j], ob = xb[j]; \
                const f32x2 a01 = __builtin_amdgcn_cvt_pk_f32_fp8((int)ya[j].x, false), a23 = __builtin_amdgcn_cvt_pk_f32_fp8((int)ya[j].x, true), a45 = __builtin_amdgcn_cvt_pk_f32_fp8((int)ya[j].y, false), a67 = __builtin_amdgcn_cvt_pk_f32_fp8((int)ya[j].y, true); \
                const f32x2 b01 = __builtin_amdgcn_cvt_pk_f32_fp8((int)yb[j].x, false), b23 = __builtin_amdgcn_cvt_pk_f32_fp8((int)yb[j].x, true), b45 = __builtin_amdgcn_cvt_pk_f32_fp8((int)yb[j].y, false), b67 = __builtin_amdgcn_cvt_pk_f32_fp8((int)yb[j].y, true); \
                oa[0] += ga[j][0] * (w0 * a01[0] + w1 * b01[0]); oa[1] += ga[j][1] * (w0 * a01[1] + w1 * b01[1]); \
                oa[2] += ga[j][2] * (w0 * a23[0] + w1 * b23[0]); oa[3] += ga[j][3] * (w0 * a23[1] + w1 * b23[1]); \
                ob[0] += gb[j][0] * (w0 * a45[0] + w1 * b45[0]); ob[1] += gb[j][1] * (w0 * a45[1] + w1 * b45[1]); \
                ob[2] += gb[j][2] * (w0 * a67[0] + w1 * b67[0]); ob[3] += gb[j][3] * (w0 * a67[1] + w1 * b67[1]); \
                stnt4(obase + (size_t)(i) * DM + 512 * j, oa); stnt4(obase + (size_t)(i) * DM + 512 * j + 4, ob); } } while (0)
            P11_ROW(i, ya0, yb0, xa0, xb0); P11_ROW(i + 1, ya1, yb1, xa1, xb1);
#pragma unroll
            for (int j = 0; j < 2; ++j) { ya0[j] = nya0[j]; yb0[j] = nyb0[j]; xa0[j] = nxa0[j]; xb0[j] = nxb0[j]; ya1[j] = nya1[j]; yb1[j] = nyb1[j]; xa1[j] = nxa1[j]; xb1[j] = nxb1[j]; }
        }
#undef P11_LOAD
#undef P11_ROW
    }
}

constexpr int CW_BAR = 4096;
#define XB_TMO      128
#define XB_XCNT(j)  (256  + 64 * (j))
#define XB_XSUB(j)  (1280 + 64 * (j))
#define XB_XGEN(j)  (2304 + 64 * (j))
#define XB_TOP      3328
#define XB_TOPGEN   3392
#define XB_SPIN_CAP (1u << 22)
DI unsigned xb_ld(unsigned* p)              { return __hip_atomic_load(p, __ATOMIC_RELAXED, __HIP_MEMORY_SCOPE_AGENT); }
DI unsigned xb_add(unsigned* p, unsigned v) { return __hip_atomic_fetch_add(p, v, __ATOMIC_RELAXED, __HIP_MEMORY_SCOPE_AGENT); }
DI unsigned xb_xcc_id() { return (unsigned)__builtin_amdgcn_s_getreg((3 << 11) | 20) & 0xFu; }
#define XB_SPIN(cond, bar) do { unsigned _sp = 0; while (cond) { __builtin_amdgcn_s_sleep(1); \
    if ((++_sp & 255u) == 0u) { if (xb_ld(&(bar)[XB_TMO])) break; if (_sp > XB_SPIN_CAP) { atomicAdd(&(bar)[XB_TMO], 1u); break; } } } } while (0)
struct XcdBarrier { unsigned* bar; unsigned x; volatile LAS unsigned* st; };
DI XcdBarrier xcd_barrier_post(unsigned* bar, volatile LAS unsigned* st, bool leader) {
    XcdBarrier b; b.bar = bar; b.x = xb_xcc_id(); b.st = st;
    if (leader) (void)xb_add(&bar[XB_XCNT(b.x)], 1u);
    return b;
}
DI void xcd_barrier_complete(unsigned* bar, unsigned x, unsigned& nloc, unsigned& nx) {
    const unsigned G = gridDim.x;
    unsigned sum, cnt, mine, sp = 0u;
    for (;;) {
        sum = 0u; cnt = 0u; mine = 0u;
#pragma unroll
        for (unsigned j = 0; j < 16; ++j) { const unsigned c = xb_ld(&bar[XB_XCNT(j)]); sum += c; cnt += (c > 0u) ? 1u : 0u; mine = (j == x) ? c : mine; }
        if (sum == G) break;
        __builtin_amdgcn_s_sleep(1);
        if ((++sp & 255u) == 0u) { if (xb_ld(&bar[XB_TMO])) break; if (sp > XB_SPIN_CAP) { atomicAdd(&bar[XB_TMO], 1u); break; } }
    }
    nloc = mine > 0u ? mine : 1u; nx = cnt > 0u ? cnt : 1u;
}
DI void xcd_barrier(const XcdBarrier& b, bool leader) {
    asm volatile("s_waitcnt vmcnt(0)" ::: "memory");
    __syncthreads();
    if (leader) {
        unsigned* bar = b.bar;
        __builtin_amdgcn_s_waitcnt(0);
        unsigned nloc = b.st[0], nx = b.st[1];
        if (nloc == 0u) { xcd_barrier_complete(bar, b.x, nloc, nx); b.st[0] = nloc; b.st[1] = nx; }
        const unsigned old = xb_add(&bar[XB_XSUB(b.x)], 1u);
        const unsigned gen = old / nloc;
        if (old + 1u == (gen + 1u) * nloc) {
            __builtin_amdgcn_fence(__ATOMIC_RELEASE, "agent");
            asm volatile("s_waitcnt vmcnt(0)" ::: "memory");
            const unsigned og = xb_add(&bar[XB_TOP], 1u);
            const unsigned tg = og / nx;
            if (og + 1u == (tg + 1u) * nx) xb_add(&bar[XB_TOPGEN], 1u);
            else XB_SPIN(xb_ld(&bar[XB_TOPGEN]) == tg, bar);
            __builtin_amdgcn_fence(__ATOMIC_ACQUIRE, "agent");
            xb_add(&bar[XB_XGEN(b.x)], 1u);
            asm volatile("s_waitcnt vmcnt(0)" ::: "memory");
        } else {
            XB_SPIN(xb_ld(&bar[XB_XGEN(b.x)]) == gen, bar);
            __builtin_amdgcn_fence(__ATOMIC_ACQUIRE, "agent");
            asm volatile("s_waitcnt vmcnt(0)" ::: "memory");
        }
    }
    __syncthreads();
}

constexpr int NPHASE = 12;
__global__ void __launch_bounds__(NTHREADS, 2) hymba_fwd(Params p) {
    extern __shared__ __attribute__((aligned(16))) unsigned char lds_raw[];
    __builtin_assume(__builtin_amdgcn_workitem_id_y() == 0); __builtin_assume(__builtin_amdgcn_workitem_id_z() == 0);
    cg::grid_group grid = cg::this_grid();
    Frame F;
    F.lds = (LAS unsigned char*)lds_raw; F.ws = p.ws; F.in = p.in; F.out = p.out;
    F.wave = __builtin_amdgcn_readfirstlane(threadIdx.x >> 6); F.lane = lane_id_fresh(); F.tid = F.wave * 64 + F.lane; F.bid = blockIdx.x; F.G = gridDim.x;
    F.gw = F.bid * NWAVES + F.wave; F.NGW = F.G * NWAVES;
    const int lo = p.ph_lo, hi = p.ph_hi;
#define IN(k) (lo <= (k) && (k) < hi)
#ifdef PROBE_A
    LAS unsigned long long* ts_ = (LAS unsigned long long*)(F.lds + LDS_MISC + 7168);
#define STAMP(k) do { if (F.bid == 0 && F.tid == 0) ts_[k] = __builtin_amdgcn_s_memrealtime(); } while (0)
#else
#define STAMP(k) do { } while (0)
#endif
    STAMP(0);
    volatile LAS unsigned* xst = (volatile LAS unsigned*)(F.lds + LDS_MISC + 4112);
    if (F.tid == 0) { xst[0] = 0u; xst[1] = 0u; }
    __syncthreads();
    XcdBarrier xbar; xbar.bar = (unsigned*)(F.ws + WS_CTL) + CW_BAR; xbar.x = 0; xbar.st = xst;
#define SEAM(k) do { if (IN(k) && IN((k) + 1)) { if ((k) == 0) { grid.sync(); xbar = xcd_barrier_post((unsigned*)(F.ws + WS_CTL) + CW_BAR, xst, F.tid == 0); } else xcd_barrier(xbar, F.tid == 0); } F.lane = lane_id_fresh(); F.tid = F.wave * 64 + F.lane; STAMP((k) + 1); } while (0)
    LAS unsigned char* ring = F.lds; LAS unsigned* tokl = (LAS unsigned*)(F.lds + LDS_MISC + 256);
#ifdef DOUBLE_PHASE
#define NREP(k) ((k) == DOUBLE_PHASE ? 2 : 1)
#define REPSYNC(k, rep) do { if ((k) == DOUBLE_PHASE && (rep) == 0) grid.sync(); } while (0)
#else
#define NREP(k) 1
#define REPSYNC(k, rep) do { } while (0)
#endif

    if (IN(0)) for (int rep = 0; rep < NREP(0); ++rep) { phase0(F); REPSYNC(0, rep); }
    SEAM(0);
    if (IN(1)) for (int rep = 0; rep < NREP(1); ++rep) { phase1(F); REPSYNC(1, rep); }
    SEAM(1);
    if (IN(2)) for (int rep = 0; rep < NREP(2); ++rep) {
        pg8::StaticOrder S; S.init(TOK, NPROJ, DM / 2, F.G, F.bid, F.ws + WS_H1, F.ws + WS_WIN);
        pg8::EpiInProj E{F.ws, F.in[7], F.in[8], F.in[12], F.in[13], (LAS float*)(F.lds + LDS_MISC + 8192)};
        pg8::gemm_phase<pg8::EpiInProj, pg8::StaticOrder, false, true>(ring, tokl, DM / 2, S, E, F.wave, F.lane);
        REPSYNC(2, rep);
    }
    SEAM(2); STAMP(4);
    if (IN(4)) for (int rep = 0; rep < NREP(4); ++rep) {
        { pg8::CompressOrder S{F.G, F.bid, (const char*)(F.ws + WS_KC), (const char*)(F.ws + WS_PE), (const char*)(F.ws + WS_WC1)};
          pg8::EpiBf16 E{(bf16_t*)(F.ws + WS_UL), 512};
          pg8::gemm_phase<pg8::EpiBf16, pg8::CompressOrder, false>(ring, tokl, 1024, S, E, F.wave, F.lane); }
        const float mq = gmax(F.in[12], 32, F.lane), mk = gmax(F.in[13], 32, F.lane);
        const float bound = 5.656854249f * mq * mk * 1.02f; const float c2 = 0.17677669529663687f * 1.4426950408889634f; const float mc = bound * 1.4426950408889634f;
        float s1 = F.lane < 32 ? F.in[14][F.lane] * F.in[15][F.lane] : 0.f, s2 = F.lane < 32 ? F.in[16][F.lane] * F.in[17][F.lane] : 0.f;
        s1 = wave_sum(s1); s2 = wave_sum(s2);
        const float lam = __expf(s1) - __expf(s2) + 0.2f;
        unsigned* ctr = (unsigned*)(F.ws + WS_CTL) + CW_QDIFF + 32 * rep;
        for (int it = queue_next(F, ctr); it < 4096;) { unsigned nx = 0u; if (F.tid == 0) nx = atomicAdd(ctr, 1u);
            const int qb = 15 - (it >> 8), bh = it & 255; diff_unit(F, bh >> 3, bh & 7, qb, c2, mc, lam); it = queue_pass(F, nx); }
        REPSYNC(4, rep);
    }
    SEAM(4);
    if (IN(5)) for (int rep = 0; rep < NREP(5); ++rep) { phase5(F); REPSYNC(5, rep); }
    SEAM(5);
    if (IN(6)) for (int rep = 0; rep < NREP(6); ++rep) {
        const float mq = gmax(F.in[7], 64, F.lane); const float mk = fmaxf(gmax(F.in[8], 64, F.lane), fmaxf(gmax(F.in[8] + 64, 64, F.lane), gmax(F.in[8] + 128, 64, F.lane)));
        const float bound = 8.f * mq * mk * 1.02f; const float c2 = 0.125f * 1.4426950408889634f; const float mc = bound * 1.4426950408889634f;
        unsigned* ctr = (unsigned*)(F.ws + WS_CTL) + CW_QNSA + 32 * rep;
        for (int it = queue_next(F, ctr); it < 2048;) { unsigned nx = 0u; if (F.tid == 0) nx = atomicAdd(ctr, 1u);
            const int qb = 31 - (it >> 6), bg = it & 63; nsa_unit(F, bg >> 1, bg & 1, qb, c2, mc); it = queue_pass(F, nx); }
        REPSYNC(6, rep);
    }
    SEAM(6);
    if (IN(7)) for (int rep = 0; rep < NREP(7); ++rep) {
        pg8::StaticOrder S; S.init(TOK, DM, DM, F.G, F.bid, F.ws + WS_AO, F.ws + WS_WOUT);
        pg8::EpiOutProj E{F.in[0], (bf16_t*)(F.ws + WS_X1B), (const float*)(F.ws + WS_MOD), (float*)(F.ws + WS_ROWSS)};
        pg8::gemm_phase<pg8::EpiOutProj, pg8::StaticOrder, false>(ring, tokl, DM, S, E, F.wave, F.lane);
        REPSYNC(7, rep);
    }
    SEAM(7);
    if (IN(8)) phase8(F);
    SEAM(8);
    if (IN(9)) for (int rep = 0; rep < NREP(9); ++rep) {
        LAS int* tb = moe_prefix(F);
        pg8::MoeOrder S{F.G, F.bid, 0, tb, (const char*)(F.ws + WS_H2), (const char*)(F.ws + WS_WGU), (const int*)(F.ws + WS_LIST)};
        pg8::EpiSwiglu E{(unsigned char*)(F.ws + WS_HH)};
        pg8::gemm_phase<pg8::EpiSwiglu, pg8::MoeOrder, true, true>(ring, tokl, DM / 2, S, E, F.wave, F.lane);
        REPSYNC(9, rep);
    }
    SEAM(9);
    if (IN(10)) for (int rep = 0; rep < NREP(10); ++rep) {
        LAS int* tb = moe_prefix(F);
        pg8::MoeOrder S{F.G, F.bid, 1, tb, (const char*)(F.ws + WS_HH), (const char*)(F.ws + WS_WD), nullptr};
        pg8::EpiFp8 E{(unsigned char*)(F.ws + WS_Y), DM};
        pg8::gemm_phase<pg8::EpiFp8, pg8::MoeOrder, false, true>(ring, tokl, EHID / 2, S, E, F.wave, F.lane);
        REPSYNC(10, rep);
    }
    SEAM(10);
    if (IN(11)) phase11(F);
    grid.sync(); grid.sync(); grid.sync(); grid.sync(); grid.sync(); grid.sync(); grid.sync(); grid.sync();
#ifdef PROBE_A
    grid.sync(); STAMP(12);
    if (F.bid == 0 && F.tid == 0) {
        unsigned long long da = (ts_[PROBE_A + 1] - ts_[PROBE_A]) / 100ull, db = (ts_[PROBE_B + 1] - ts_[PROBE_B]) / 100ull;
        unsigned long long qa = (da + 5ull) / 10ull, qb2 = (db + 5ull) / 10ull; if (qa > 63ull) qa = 63ull; if (qb2 > 63ull) qb2 = 63ull;
        const unsigned long long target = ts_[0] + (6000ull + 16ull + 32ull * qa + 2048ull * qb2) * 100ull;
        while (__builtin_amdgcn_s_memrealtime() < target) __builtin_amdgcn_s_sleep(32);
    }
#endif
#undef IN
#undef SEAM
}

#ifndef MK_LAUNCHES
#define MK_LAUNCHES 1
#endif
extern "C" void kernel_launch(void* const* d_in, const int* in_sizes, int n_in, void* d_out, int out_size, void* d_ws, size_t ws_size, hipStream_t stream) {
    static int grid = 0;
    if (grid == 0) {
        if (n_in != 27 || ws_size < WS_END) { fprintf(stderr, "kernel_launch: unexpected inputs (n_in %d, ws %zu)\n", n_in, ws_size); grid = -1; return; }
        int dev = 0, cus = 0, per_cu = 0;
        hipGetDevice(&dev); hipDeviceGetAttribute(&cus, hipDeviceAttributeMultiprocessorCount, dev);
        hipFuncSetAttribute((const void*)hymba_fwd, hipFuncAttributeMaxDynamicSharedMemorySize, LDS_BYTES);
        hipOccupancyMaxActiveBlocksPerMultiprocessor(&per_cu, (const void*)hymba_fwd, NTHREADS, LDS_BYTES);
        if (per_cu < 1) { fprintf(stderr, "kernel_launch: occupancy query says %d blocks per CU\n", per_cu); per_cu = 1; }
        if (per_cu > 1) per_cu = 1;
        grid = cus * per_cu;
    }
    if (grid < 0) return;
    Params p{};
    for (int i = 0; i < 27; ++i) p.in[i] = (const float*)d_in[i];
    p.out = (float*)d_out; p.ws = (unsigned char*)d_ws;
    const int cuts[13] = {0, 1, 2, 3, 4, 5, 6, 7, 8, 9, 10, 11, 12};
    const int nl = MK_LAUNCHES == 1 ? 1 : NPHASE;
    for (int li = 0; li < nl; ++li) {
        p.ph_lo = nl == 1 ? 0 : cuts[li]; p.ph_hi = nl == 1 ? NPHASE : cuts[li + 1];
        void* args[] = {&p};
        hipError_t e = hipLaunchCooperativeKernel((const void*)hymba_fwd, dim3(grid), dim3(NTHREADS), args, LDS_BYTES, stream);
        if (e != hipSuccess) { fprintf(stderr, "cooperative launch failed: %s (grid %d)\n", hipGetErrorString(e), grid); break; }
    }
}
```

```cpp
#include <hip/hip_runtime.h>
#include <hip/hip_cooperative_groups.h>
#include <cstdint>
#include <cstdio>
namespace cg = cooperative_groups;

#define LAS __attribute__((address_space(3)))
#define DI __device__ __forceinline__
typedef unsigned short bf16_t;
typedef short bf16x8 __attribute__((ext_vector_type(8)));
typedef short s16x4 __attribute__((ext_vector_type(4)));
typedef float f32x2 __attribute__((ext_vector_type(2)));
typedef float f32x4 __attribute__((ext_vector_type(4)));
typedef float f32x16 __attribute__((ext_vector_type(16)));
typedef unsigned u32x2 __attribute__((ext_vector_type(2)));
typedef unsigned u32x4 __attribute__((ext_vector_type(4)));

constexpr int BATCH = 32, SEQ = 2048, DM = 1024, TOK = BATCH * SEQ;
constexpr int NPROJ = 3072;
constexpr int INCOLS = 2840;
constexpr int NEXP = 32, EHID = 512, ECAP = 65536;
constexpr float EPS = 1e-6f;
constexpr int NWAVES = 8, NTHREADS = 512;

constexpr size_t MiB = 1u << 20;
constexpr size_t WS_CTL = 0;
constexpr size_t WS_MOD = 1 * MiB;
constexpr size_t WS_ROPE = 2 * MiB;
constexpr size_t WS_W2T = 2 * MiB + 512 * 1024;
constexpr size_t WS_WR = 3 * MiB;
constexpr size_t WS_WIN = 4 * MiB;
constexpr size_t WS_WOUT = 10 * MiB;
constexpr size_t WS_WC1 = 12 * MiB;
constexpr size_t WS_WGU = 16 * MiB;
constexpr size_t WS_WD = 80 * MiB;
constexpr size_t WS_LIST = 112 * MiB;
constexpr size_t WS_TIPOS = 120 * MiB;
constexpr size_t WS_TIE = WS_TIPOS + 512 * 1024;
constexpr size_t WS_TIW = WS_TIE + 256 * 1024;
constexpr size_t WS_ROWSS = 122 * MiB;
constexpr size_t WS_GATES = 126 * MiB;
constexpr size_t WS_KCMP = 132 * MiB;
constexpr size_t WS_VCMP = 133 * MiB;
constexpr size_t WS_UL = 134 * MiB;
constexpr size_t WS_A = 160 * MiB;
constexpr size_t WS_B = 288 * MiB;
constexpr size_t WS_C = 672 * MiB;
constexpr size_t WS_H1 = WS_A, WS_QN = WS_B + 128 * MiB, WS_QR = WS_B + 192 * MiB, WS_H2 = WS_A;
constexpr size_t WS_PROJ = WS_B, WS_AO = WS_B, WS_HH = WS_B, WS_Y = WS_B + 136 * MiB;
constexpr size_t WS_KC = WS_C, WS_VC = WS_C + 16 * MiB, WS_PE = WS_C + 32 * MiB, WS_KS = WS_C + 33 * MiB, WS_VS = WS_C + 49 * MiB,
                 WS_KW = WS_C + 65 * MiB, WS_VW = WS_C + 81 * MiB, WS_DQ = WS_C + 97 * MiB, WS_DK = WS_C + 161 * MiB, WS_DV = WS_C + 225 * MiB;
constexpr size_t WS_X1B = WS_C + 32 * MiB;
constexpr size_t WS_END = WS_C + 289 * MiB;
constexpr int CW_CNT = 0;
constexpr int CW_QDIFF = 64, CW_QNSA = 128;
constexpr int CW_ADA = 4096 + 3520;
constexpr int CW_XID = 4096 + 3840;
constexpr int CW_XA = 1024, CW_XB2 = 2048;
constexpr int CW_GDONE = 192, CW_P5DONE = 224;

constexpr int RING_BYTES = 131072;
constexpr int LDS_MISC = RING_BYTES;
constexpr int LDS_BYTES = 147456;

DI unsigned pk2(float lo, float hi) { typedef __bf16 b2 __attribute__((ext_vector_type(2))); f32x2 v = {lo, hi}; b2 b = __builtin_convertvector(v, b2); return __builtin_bit_cast(unsigned, b); }
DI unsigned short f2bf(float f) { return (unsigned short)(pk2(f, 0.f) & 0xffffu); }
DI float bf2f(unsigned short h) { return __uint_as_float((unsigned)h << 16); }
DI float bflo(unsigned w) { return __uint_as_float(w << 16); }
DI float bfhi(unsigned w) { return __uint_as_float(w & 0xffff0000u); }
template <int CTRL> DI float dppf(float v) { return __builtin_bit_cast(float, __builtin_amdgcn_update_dpp(0, __builtin_bit_cast(int, v), CTRL, 0xf, 0xf, true)); }
DI void swap16(float& a, float& b) { asm("s_nop 1\n\tv_permlane16_swap_b32 %0, %1" : "+v"(a), "+v"(b)); }
DI void swap32(float& a, float& b) { asm("s_nop 1\n\tv_permlane32_swap_b32 %0, %1" : "+v"(a), "+v"(b)); }
DI float xadd16(float v) { float a = v, b = v; swap16(a, b); return a + b; }
DI float xadd32(float v) { float a = v, b = v; swap32(a, b); return a + b; }
DI float xmax16(float v) { float a = v, b = v; swap16(a, b); return fmaxf(a, b); }
DI float xmax32(float v) { float a = v, b = v; swap32(a, b); return fmaxf(a, b); }
DI float swz16(float v) { return __int_as_float(__builtin_amdgcn_ds_swizzle(__float_as_int(v), 0x401F)); }
DI float xchg16(float v, bool oddrow) { float a = v, b = v; swap16(a, b); return oddrow ? a : b; }
DI float xchg32(float v, bool hi) { float a = v, b = v; swap32(a, b); return hi ? a : b; }
DI float wave_sum(float v) {
    v += dppf<0xB1>(v); v += dppf<0x4E>(v); v += dppf<0x141>(v); v += dppf<0x140>(v); return xadd32(xadd16(v));
}
DI float wave_max(float v) {
    v = fmaxf(v, dppf<0xB1>(v)); v = fmaxf(v, dppf<0x4E>(v)); v = fmaxf(v, dppf<0x141>(v)); v = fmaxf(v, dppf<0x140>(v)); return xmax32(xmax16(v));
}
DI float fast_exp2(float x) { return __builtin_amdgcn_exp2f(x); }
DI float fast_rcp(float x) { return __builtin_amdgcn_rcpf(x); }
#define MFMA32(a, b, c) __builtin_amdgcn_mfma_f32_32x32x16_bf16((a), (b), (c), 0, 0, 0)
#define MFMA16(a, b, c) __builtin_amdgcn_mfma_f32_16x16x32_bf16((a), (b), (c), 0, 0, 0)
typedef int v8i32 __attribute__((ext_vector_type(8)));
DI unsigned pk4_fp8(float a, float b, float c, float d) { int w = 0; w = __builtin_amdgcn_cvt_pk_fp8_f32(a, b, w, false); w = __builtin_amdgcn_cvt_pk_fp8_f32(c, d, w, true); return (unsigned)w; }
DI f32x4 ldnt4(const float* p) { return __builtin_nontemporal_load((const f32x4*)p); }
DI u32x4 ldntu4(const void* p) { return __builtin_nontemporal_load((const u32x4*)p); }
DI void stnt4(float* p, f32x4 v) { __builtin_nontemporal_store(v, (f32x4*)p); }
DI int crow(int r, int hi) { return (r & 3) + 8 * (r >> 2) + 4 * hi; }

DI int lane_id_fresh() { int l; asm volatile("v_mbcnt_lo_u32_b32 %0, -1, 0\n\tv_mbcnt_hi_u32_b32 %0, -1, %0" : "=v"(l)); return l; }
DI void glds16s(const void* sbase, unsigned voff, unsigned lds_dst) { unsigned keep;
    asm volatile("s_mov_b32 %0, m0\n\ts_mov_b32 m0, %3\n\ts_nop 0\n\tglobal_load_lds_dwordx4 %1, %2\n\ts_mov_b32 m0, %0" : "=&s"(keep) : "v"(voff), "s"(sbase), "s"(lds_dst) : "memory"); }
struct Params { const float* in[27]; float* out; unsigned char* ws; int ph_lo, ph_hi; };

namespace pg8 {
constexpr int BM = 256, BK = 64, HALF = 128, HTB = HALF * BK * 2, STAGE_BYTES = 8 * HTB, NXCD = 8, WGM = 8;
DI int lds_byte(int r, int c) { const int st = (r >> 4) * 2 + (c >> 5), rr = r & 15, cc = c & 31, ob = rr * 64 + cc * 2; return st * 1024 + (ob ^ (((ob >> 9) & 1) << 5)); }
DI void stage_rc(int b, int& R, int& C) { const int st = b / 1024, sb = b % 1024, swz = sb ^ (((sb >> 9) & 1) << 5); R = (st >> 1) * 16 + swz / 64; C = (st & 1) * 32 + (swz % 64) / 2; }
DI int perm32(int rho) { const int n = rho >> 4, i = rho & 15; return 8 * (i >> 2) + 4 * n + (i & 3); }

struct Unit { int pm, pn, aux; const char* Ab; const char* Bb; const int* tok; };

template <class Epi, class Sched, bool GATHER, bool FP8 = false>
DI void gemm_phase(LAS unsigned char* lds, LAS unsigned* tokl, const int K, const Sched& S, const Epi& E, const int wid, const int lane) {
    const int tid = wid * 64 + lane, wr = wid >> 2, wc = wid & 3, fr = lane & 15, fq = lane >> 4;
    const int nt = K / BK;
    unsigned voffA[2], voffB[2]; int RA[2], CA[2];
#pragma unroll
    for (int i = 0; i < 2; ++i) { int R, C; stage_rc(tid * 16 + i * 8192, R, C); const int Rb = Epi::PERM ? ((R & ~31) + perm32(R & 31)) : R;
        voffA[i] = (unsigned)(R * K + C) * 2u; voffB[i] = (unsigned)(Rb * K + C) * 2u; RA[i] = R; CA[i] = C; }
    const size_t kstep = (size_t)(BK * 2);
    const size_t hstep = (size_t)HALF * K * 2;
    const unsigned ldsw = (unsigned)wid * 1024u; const unsigned ldsb = (unsigned)(uintptr_t)lds;
    const int aoff = lds_byte(wr * 64 + fr, fq * 8), boff = lds_byte(wc * 32 + fr, fq * 8);
    const unsigned pfv = (unsigned)(wid * 32) * 4096u + (unsigned)lane * 16u, pfl = ldsb + (unsigned)(LDS_MISC + 8192) + ldsw;
#define PG8_SA(b, h) (((b) * 2 + (h)) * HTB)
#define PG8_SB(b, h) ((4 + (b) * 2 + (h)) * HTB)
#define PG8_STG(bufoff, gbase, voff) do { _Pragma("unroll") for (int _i = 0; _i < 2; ++_i) \
        glds16s((const void*)(gbase), (voff)[_i], (unsigned)__builtin_amdgcn_readfirstlane((int)(ldsb + (unsigned)(bufoff) + ldsw + (unsigned)_i * 8192u))); } while (0)
#define PG8_STA(bufoff, gbase, h, bsel) do { if constexpr (GATHER) { unsigned vv_[2];   \
            _Pragma("unroll") for (int _j = 0; _j < 2; ++_j) vv_[_j] = tokl[(bsel) * 256 + (h) * 128 + RA[_j]] * (unsigned)(K * 2) + (unsigned)(CA[_j] * 2); \
            PG8_STG(bufoff, gbase, vv_); } else { PG8_STG(bufoff, (gbase) + (h) * hstep, voffA); } } while (0)
#define PG8_LD8(p_) ({ const u32x4 lo_ = *(const LAS u32x4*)(p_), hi_ = *(const LAS u32x4*)((p_) + 1024); (v8i32){(int)lo_.x, (int)lo_.y, (int)lo_.z, (int)lo_.w, (int)hi_.x, (int)hi_.y, (int)hi_.z, (int)hi_.w}; })
#define PG8_LDA(dst, b, h) do { if constexpr (FP8) { _Pragma("unroll") for (int m = 0; m < 4; ++m) dst##8[m] = PG8_LD8(lds + PG8_SA(b, h) + aoff + m * 2048); } \
        else { _Pragma("unroll") for (int m = 0; m < 4; ++m) _Pragma("unroll") for (int k = 0; k < 2; ++k) dst[m][k] = *(const LAS bf16x8*)(lds + PG8_SA(b, h) + aoff + m * 2048 + k * 1024); } } while (0)
#define PG8_LDB(dst, b, h) do { if constexpr (FP8) { _Pragma("unroll") for (int n = 0; n < 2; ++n) dst##8[n] = PG8_LD8(lds + PG8_SB(b, h) + boff + n * 2048); } \
        else { _Pragma("unroll") for (int n = 0; n < 2; ++n) _Pragma("unroll") for (int k = 0; k < 2; ++k) dst[n][k] = *(const LAS bf16x8*)(lds + PG8_SB(b, h) + boff + n * 2048 + k * 1024); } } while (0)
#define PG8_MMA(ai, bj, At, Bt) do { __builtin_amdgcn_s_setprio(1); _Pragma("unroll") for (int m = 0; m < 4; ++m) _Pragma("unroll") for (int n = 0; n < 2; ++n) { \
        if constexpr (FP8) {   \
            asm volatile("v_mfma_scale_f32_16x16x128_f8f6f4 %0, %1, %2, %0, %3, %4 op_sel_hi:[0,0,0]" : "+v"(acc[ai][bj][m][n]) : "v"(Bt##8[n]), "v"(At##8[m]), "v"(sclB_), "v"(sclA_)); \
        } else { _Pragma("unroll") for (int k = 0; k < 2; ++k) acc[ai][bj][m][n] = __builtin_amdgcn_mfma_f32_16x16x32_bf16(Bt[n][k], At[m][k], acc[ai][bj][m][n], 0, 0, 0); } } \
        __builtin_amdgcn_s_setprio(0); } while (0)
#define PG8_WAIT_V(n) asm volatile("s_waitcnt vmcnt(" #n ")" ::: "memory")
#define PG8_PF(j) do { if constexpr (Epi::PF) glds16s((const void*)(pfb + (size_t)(j) * 4096), pfv, (unsigned)__builtin_amdgcn_readfirstlane((int)pfl)); } while (0)
#define PG8_WAIT_M do { if constexpr (Epi::PF) PG8_WAIT_V(10); else PG8_WAIT_V(8); } while (0)
#define PG8_WAIT_L(n) asm volatile("s_waitcnt lgkmcnt(" #n ")" ::: "memory")
#define PG8_BAR __builtin_amdgcn_s_barrier()
#define PG8_SCHED __builtin_amdgcn_sched_barrier(0)
    Unit cur, nxt; int ui = 0;
    if (!S.next(0, cur)) return;
    f32x4 acc[2][2][4][2];
#pragma unroll
    for (int a = 0; a < 2; ++a)
#pragma unroll
        for (int b = 0; b < 2; ++b)
#pragma unroll
            for (int m = 0; m < 4; ++m)
#pragma unroll
                for (int n = 0; n < 2; ++n) acc[a][b][m][n] = (f32x4){0.f, 0.f, 0.f, 0.f};
    bf16x8 At[4][2], B0[2][2], B1[2][2];
    v8i32 At8[4], B08[2], B18[2];
    int sclB_ = 0x77777777, sclA_ = 0x7f7f7f7f; asm volatile("" : "+v"(sclB_), "+v"(sclA_));
    const char* cA = cur.Ab; const char* cB = cur.Bb;
    const char* pfb = nullptr; if constexpr (Epi::PF) pfb = E.pf_base(cur);
    if constexpr (GATHER) {
        if (wid < 4) __builtin_amdgcn_global_load_lds((const unsigned*)(cur.tok + wid * 64 + lane), (LAS unsigned*)(tokl + wid * 64), 4, 0, 0);
        PG8_WAIT_V(0); PG8_BAR;
    }
    PG8_STG(PG8_SB(0, 0), cB, voffB); PG8_STG(PG8_SB(0, 1), cB + hstep, voffB); PG8_STA(PG8_SA(0, 0), cA, 0, 0); PG8_STA(PG8_SA(0, 1), cA, 1, 0);
    if (wr == 1) PG8_BAR;
    PG8_WAIT_V(2); PG8_BAR;
    PG8_STG(PG8_SB(1, 0), cB + kstep, voffB); PG8_STA(PG8_SA(1, 0), cA + kstep, 0, 0); PG8_STG(PG8_SB(1, 1), cB + hstep + kstep, voffB);
    PG8_WAIT_V(6); PG8_BAR;
    PG8_PF(0);
    for (;;) {
        const bool has_next = S.next(ui + 1, nxt);
        const char* nA = has_next ? nxt.Ab : cA; const char* nB = has_next ? nxt.Bb : cB;
        if constexpr (GATHER) {
            if (has_next && wid < 4) __builtin_amdgcn_global_load_lds((const unsigned*)(nxt.tok + wid * 64 + lane), (LAS unsigned*)(tokl + ((ui + 1) & 1) * 256 + wid * 64), 4, 0, 0);
        }
#pragma unroll 1
        for (int t = 0; t < nt; t += 2) {
            const bool last = (t == nt - 2);
            const char* a1 = cA + (size_t)(t + 1) * kstep;
            const char* a2 = last ? nA : cA + (size_t)(t + 2) * kstep; const char* b2 = last ? nB : cB + (size_t)(t + 2) * kstep;
            const char* a3 = a2 + kstep; const char* b3 = b2 + kstep;
            const int bc_ = ui & 1, bn_ = (last && has_next) ? ((ui + 1) & 1) : (ui & 1);
            PG8_LDB(B0, 0, 0); PG8_LDB(B1, 0, 1); PG8_SCHED; PG8_LDA(At, 0, 0); PG8_STA(PG8_SA(1, 1), a1, 1, bc_); PG8_PF(2 * t);
            PG8_WAIT_M; PG8_WAIT_L(0); PG8_BAR; PG8_MMA(0, 0, At, B0); PG8_MMA(0, 1, At, B1); PG8_BAR; PG8_SCHED;
            PG8_LDA(At, 0, 1); PG8_STG(PG8_SB(0, 0), b2, voffB); PG8_STG(PG8_SB(0, 1), b2 + hstep, voffB); PG8_STA(PG8_SA(0, 0), a2, 0, bn_); PG8_PF(2 * t + 1);
            PG8_WAIT_M; PG8_WAIT_L(0); PG8_BAR; PG8_MMA(1, 0, At, B0); PG8_MMA(1, 1, At, B1); PG8_BAR; PG8_SCHED;
            PG8_LDB(B0, 1, 0); PG8_LDB(B1, 1, 1); PG8_SCHED; PG8_LDA(At, 1, 0); PG8_STA(PG8_SA(0, 1), a2, 1, bn_); PG8_PF(2 * t + 2);
            PG8_WAIT_M; PG8_WAIT_L(0); PG8_BAR; PG8_MMA(0, 0, At, B0); PG8_MMA(0, 1, At, B1); PG8_BAR; PG8_SCHED;
            PG8_LDA(At, 1, 1); PG8_STG(PG8_SB(1, 0), b3, voffB); PG8_STG(PG8_SB(1, 1), b3 + hstep, voffB); PG8_STA(PG8_SA(1, 0), a3, 0, bn_); PG8_PF(2 * t + 3);
            PG8_WAIT_M; PG8_WAIT_L(0); PG8_BAR; PG8_MMA(1, 0, At, B0); PG8_MMA(1, 1, At, B1); PG8_BAR; PG8_SCHED;
        }
        if (wr == 0) PG8_BAR;
        if constexpr (FP8) asm volatile("s_nop 15\n\ts_nop 15" ::: "memory");
        E(acc, cur, wr, wc, fr, fq);
        if (!has_next) break;
#pragma unroll
        for (int a = 0; a < 2; ++a)
#pragma unroll
            for (int b = 0; b < 2; ++b)
#pragma unroll
                for (int m = 0; m < 4; ++m)
#pragma unroll
                    for (int n = 0; n < 2; ++n) acc[a][b][m][n] = (f32x4){0.f, 0.f, 0.f, 0.f};
        cur = nxt; cA = nA; cB = nB; ++ui;
        if constexpr (Epi::PF) pfb = E.pf_base(cur);
        if (wr == 1) PG8_BAR;
    }
    PG8_WAIT_V(0);
    PG8_BAR;
#undef PG8_SA
#undef PG8_SB
#undef PG8_STG
#undef PG8_STA
#undef PG8_LDA
#undef PG8_LDB
#undef PG8_MMA
#undef PG8_WAIT_V
#undef PG8_PF
#undef PG8_WAIT_M
#undef PG8_WAIT_L
#undef PG8_BAR
#undef PG8_SCHED
}

struct StaticOrder {
    int nM, nN, nwg, G, c; const char* A; const char* Bt; size_t tstep;
    DI void init(int M, int N, int K, int G_, int c_, const void* A_, const void* Bt_) { nM = M / BM; nN = N / BM; nwg = nM * nN; G = G_; c = c_; A = (const char*)A_; Bt = (const char*)Bt_; tstep = (size_t)BM * K * 2; }
    DI bool next(int i, Unit& u) const {
        const long L = (long)i * G + c; if (L >= nwg) return false;
        int wgid = (int)L; { const int q = nwg / NXCD, r = nwg % NXCD, xcd = wgid % NXCD, off = wgid / NXCD; wgid = (xcd < r ? xcd * (q + 1) : r * (q + 1) + (xcd - r) * q) + off; }
        const int nig = WGM * nN, gid = wgid / nig, fm = gid * WGM, gsz = (nM - fm) < WGM ? (nM - fm) : WGM;
        u.pm = fm + ((wgid % nig) % gsz); u.pn = (wgid % nig) / gsz; u.aux = 0; u.Ab = A + (size_t)u.pm * tstep; u.Bb = Bt + (size_t)u.pn * tstep; u.tok = nullptr; return true;
    }
};
struct CompressOrder {
    int G, c; const char* KC; const char* PE; const char* W;
    DI bool next(int i, Unit& u) const {
        const int L = i * G + c; if (L >= 132) return false;
        u.pm = L >> 1; u.pn = L & 1; const int kv = u.pm < 32 ? 0 : (u.pm < 64 ? 1 : u.pm - 64); u.aux = kv;
        u.Ab = u.pm < 64 ? KC + (size_t)u.pm * (256 * 1024 * 2) : PE; u.Bb = W + (size_t)kv * (512 * 1024 * 2) + (size_t)u.pn * (256 * 1024 * 2); u.tok = nullptr; return true;
    }
};
struct MoeOrder {
    int G, c, mode; const LAS int* tb; const char* A; const char* W; const int* lists;
    DI bool next(int i, Unit& u) const {
        int mt, pn_;
        if ((G & 31) == 0) { const int x = c & 7, y = c >> 3, mtpr = G >> 5; const int R = (tb[32] + 7) >> 3;
            mt = x * R + i * mtpr + (y >> 2); pn_ = y & 3; if (mt >= (x + 1) * R) return false; }
        else { const int L = i * G + c; mt = L >> 2; pn_ = L & 3; }
        if (mt >= tb[32]) return false;
        int e = -1;
#pragma unroll
        for (int q = 0; q < 8; ++q) { const u32x4 t = *(const LAS u32x4*)(tb + 4 * q); e += ((int)t.x <= mt ? 1 : 0) + ((int)t.y <= mt ? 1 : 0) + ((int)t.z <= mt ? 1 : 0) + ((int)t.w <= mt ? 1 : 0); }
        e = __builtin_amdgcn_readfirstlane(e);
        u.pm = mt; u.pn = pn_; u.aux = e;
        if (mode == 0) { u.Ab = A; u.Bb = W + (size_t)e * (1024 * 1024) + (size_t)u.pn * (256 * 1024); u.tok = lists + (size_t)e * ECAP + (size_t)(mt - tb[e]) * 256; }
        else { u.Ab = A + (size_t)mt * (256 * 512); u.Bb = W + (size_t)e * (1024 * 512) + (size_t)u.pn * (256 * 512); u.tok = nullptr; }
        return true;
    }
};

struct EpiBf16 {
    static constexpr bool PERM = true; static constexpr bool PF = false;
    bf16_t* O; int ldc;
    DI void operator()(const f32x4 (&acc)[2][2][4][2], const Unit& u, int wr, int wc, int fr, int fq) const {
        asm volatile("" : "+v"(fr), "+v"(fq));
        const int row0 = u.pm * BM + wr * 64 + fr; const int col0 = u.pn * BM + wc * 32 + 8 * fq;
#pragma unroll
        for (int ai = 0; ai < 2; ++ai)
#pragma unroll
            for (int m = 0; m < 4; ++m) { bf16_t* rowp = O + (size_t)(row0 + ai * HALF + m * 16) * ldc + col0;
#pragma unroll
                for (int bj = 0; bj < 2; ++bj) { const f32x4 v0 = acc[ai][bj][m][0], v1 = acc[ai][bj][m][1];
                    u32x4 w; w.x = pk2(v0[0], v0[1]); w.y = pk2(v0[2], v0[3]); w.z = pk2(v1[0], v1[1]); w.w = pk2(v1[2], v1[3]);
                    *(u32x4*)(rowp + bj * HALF) = w; } }
    }
};
struct EpiInProj {
    static constexpr bool PERM = true; static constexpr bool PF = false;
    unsigned char* ws; const float* g_nq; const float* g_nk; const float* g_dq; const float* g_dk; LAS float* xch;
    DI void operator()(const f32x4 (&acc)[2][2][4][2], const Unit& u, int wr, int wc, int fr, int fq) const {
        const int pn = u.pn, wid = wr * 4 + wc; const int tok0 = u.pm * BM; const int b = tok0 >> 11; int t0 = (tok0 & 2047) + wr * 64 + fr;
        int xo_i = wid * 256 + fr, xp_i = (wid ^ 1) * 256 + fr;
        asm volatile("" : "+v"(t0), "+v"(xo_i), "+v"(xp_i));
        LAS float* xo = xch + xo_i; LAS float* xp = xch + xp_i;
        const float* ropeN = (const float*)(ws + WS_ROPE); const float* ropeD = ropeN + 2048 * 16;
        const int d0 = 32 * (wc & 1) + 8 * fq;
        if (pn <= 4) {
            const bool nrm0 = (pn != 2), nrm1 = (pn < 2);
            if (pn != 2) {
#pragma unroll
                for (int ai = 0; ai < 2; ++ai)
#pragma unroll
                    for (int m = 0; m < 4; ++m)
#pragma unroll
                        for (int bj = 0; bj < 2; ++bj) { const f32x4 a = acc[ai][bj][m][0], c = acc[ai][bj][m][1];
                            float ss = (a[0] * a[0] + a[1] * a[1]) + (a[2] * a[2] + a[3] * a[3]) + (c[0] * c[0] + c[1] * c[1]) + (c[2] * c[2] + c[3] * c[3]);
                            ss = xadd16(ss); ss = xadd32(ss);
                            if (fq == 0) xo[((ai * 4 + m) * 2 + bj) * 16] = ss; }
                asm volatile("s_waitcnt lgkmcnt(0)" ::: "memory"); __builtin_amdgcn_s_barrier(); asm volatile("" ::: "memory");
            }
            const float* gg = pn < 2 ? g_nq : (g_nk + (pn == 3 ? 64 : 128));
            f32x4 g0 = {1.f, 1.f, 1.f, 1.f}, g1 = g0;
            if (pn != 2) { g0 = *(const f32x4*)(gg + d0); g1 = *(const f32x4*)(gg + d0 + 4); }
            const bool ropew = (wc & 1) == 0;
#pragma unroll
            for (int ai = 0; ai < 2; ++ai)
#pragma unroll
                for (int m = 0; m < 4; ++m) {
                    const int t = t0 + ai * HALF + m * 16;
                    const bool dorope = ropew && pn >= 3;
                    f32x4 cs0 = {1.f, 0.f, 1.f, 0.f}, cs1 = cs0, cs2 = cs0, cs3 = cs0;
                    if (dorope && fq < 2) { const f32x4* rp = (const f32x4*)(ropeN + (fq == 0 ? 65536 : 0) + t * 16); cs0 = rp[0]; cs1 = rp[1]; cs2 = rp[2]; cs3 = rp[3]; }
#pragma unroll
                    for (int bj = 0; bj < 2; ++bj) {
                        const bool donorm = bj == 0 ? nrm0 : nrm1;
                        f32x4 ya = acc[ai][bj][m][0], yb = acc[ai][bj][m][1];
                        u32x4 w0, w1;
                        if (donorm) {
                            const float rstd = rsqrtf((xo[((ai * 4 + m) * 2 + bj) * 16] + xp[((ai * 4 + m) * 2 + bj) * 16]) * (1.f / 64.f) + EPS);
                            ya = ya * rstd * g0; yb = yb * rstd * g1;
                            w0.x = pk2(ya[0], ya[1]); w0.y = pk2(ya[2], ya[3]); w0.z = pk2(yb[0], yb[1]); w0.w = pk2(yb[2], yb[3]);
                            if (dorope) {
                                f32x4 pa, pb, ra, rb;
#pragma unroll
                                for (int i = 0; i < 4; ++i) { pa[i] = swz16(ya[i]); pb[i] = swz16(yb[i]); }
                                ra[0] = ya[0] * cs0[0] + pa[0] * cs0[1]; ra[1] = ya[1] * cs0[2] + pa[1] * cs0[3]; ra[2] = ya[2] * cs1[0] + pa[2] * cs1[1]; ra[3] = ya[3] * cs1[2] + pa[3] * cs1[3];
                                rb[0] = yb[0] * cs2[0] + pb[0] * cs2[1]; rb[1] = yb[1] * cs2[2] + pb[1] * cs2[3]; rb[2] = yb[2] * cs3[0] + pb[2] * cs3[1]; rb[3] = yb[3] * cs3[2] + pb[3] * cs3[3];
                                w1.x = pk2(ra[0], ra[1]); w1.y = pk2(ra[2], ra[3]); w1.z = pk2(rb[0], rb[1]); w1.w = pk2(rb[2], rb[3]);
                            } else w1 = w0;
                        } else { w0.x = pk2(ya[0], ya[1]); w0.y = pk2(ya[2], ya[3]); w0.z = pk2(yb[0], yb[1]); w0.w = pk2(yb[2], yb[3]); w1 = w0; }
                        const int hq = 2 * bj + (wc >> 1);
                        if (pn < 2) { const size_t off = (((size_t)b * 8 + 4 * pn + hq) * SEQ + t) * 64 + d0;
                            *(u32x4*)((bf16_t*)(ws + WS_QN) + off) = w0; }
                        else { const int six = 2 * (pn - 2) + bj; const size_t base = six == 0 ? WS_KC : six == 1 ? WS_VC : six == 2 ? WS_KS : six == 3 ? WS_VS : six == 4 ? WS_KW : WS_VW;
                            const size_t off = (((size_t)b * 2 + (wc >> 1)) * SEQ + t) * 64 + d0;
                            *(u32x4*)((bf16_t*)(ws + base) + off) = w1; }
                    }
                    asm volatile("" ::: "memory");
                }
        } else if (pn <= 8) {
            const bool isq = pn <= 6; const float* gg = isq ? g_dq : g_dk; bf16_t* dst = (bf16_t*)(ws + (isq ? WS_DQ : WS_DK));
            const f32x4 g0 = *(const f32x4*)(gg + 8 * fq), g1 = *(const f32x4*)(gg + 8 * fq + 4);
#pragma unroll
            for (int ai = 0; ai < 2; ++ai)
#pragma unroll
                for (int m = 0; m < 4; ++m) {
                    const int t = t0 + ai * HALF + m * 16;
                    f32x4 c0 = {1.f, 0.f, 1.f, 0.f}, c1 = c0;
                    if (fq == 0) { const f32x4* rp = (const f32x4*)(ropeD + t * 8); c0 = rp[0]; c1 = rp[1]; }
#pragma unroll
                    for (int bj = 0; bj < 2; ++bj) {
                        f32x4 ya = acc[ai][bj][m][0], yb = acc[ai][bj][m][1];
                        float ss = (ya[0] * ya[0] + ya[1] * ya[1]) + (ya[2] * ya[2] + ya[3] * ya[3]) + (yb[0] * yb[0] + yb[1] * yb[1]) + (yb[2] * yb[2] + yb[3] * yb[3]);
                        ss = xadd16(ss); ss = xadd32(ss);
                        const float rstd = rsqrtf(ss * (1.f / 32.f) + EPS);
                        ya = ya * rstd * g0; yb = yb * rstd * g1;
                        if (fq == 0) { const f32x4 a = ya, bb = yb;
                            ya[0] = a[0] * c0[0] - bb[0] * c0[1]; yb[0] = a[0] * c0[1] + bb[0] * c0[0]; ya[1] = a[1] * c0[2] - bb[1] * c0[3]; yb[1] = a[1] * c0[3] + bb[1] * c0[2];
                            ya[2] = a[2] * c1[0] - bb[2] * c1[1]; yb[2] = a[2] * c1[1] + bb[2] * c1[0]; ya[3] = a[3] * c1[2] - bb[3] * c1[3]; yb[3] = a[3] * c1[3] + bb[3] * c1[2]; }
                        u32x4 w; w.x = pk2(ya[0], ya[1]); w.y = pk2(ya[2], ya[3]); w.z = pk2(yb[0], yb[1]); w.w = pk2(yb[2], yb[3]);
                        const int hd = 4 * ((pn - 5) & 1) + 2 * bj + (wc >> 1);
                        *(u32x4*)(dst + (((size_t)b * 8 + hd) * SEQ + t) * 64 + d0) = w;
                    }
                    asm volatile("" ::: "memory");
                }
        } else if (pn <= 10) {
            bf16_t* dst = (bf16_t*)(ws + WS_DV);
#pragma unroll
            for (int ai = 0; ai < 2; ++ai)
#pragma unroll
                for (int m = 0; m < 4; ++m) { const int t = t0 + ai * HALF + m * 16;
#pragma unroll
                    for (int bj = 0; bj < 2; ++bj) { const f32x4 ya = acc[ai][bj][m][0], yb = acc[ai][bj][m][1];
                        u32x4 w; w.x = pk2(ya[0], ya[1]); w.y = pk2(ya[2], ya[3]); w.z = pk2(yb[0], yb[1]); w.w = pk2(yb[2], yb[3]);
                        const int hd = 4 * (pn - 9) + 2 * bj + (wc >> 1);
                        *(u32x4*)(dst + (((size_t)b * 8 + hd) * SEQ + t) * 64 + d0) = w; }
                    asm volatile("" ::: "memory"); }
        } else {
            if (wc == 0 && fq < 3) {
                float* gt = (float*)(ws + WS_GATES);
#pragma unroll
                for (int ai = 0; ai < 2; ++ai)
#pragma unroll
                    for (int m = 0; m < 4; ++m) { const size_t tok = (size_t)tok0 + wr * 64 + fr + ai * HALF + m * 16; const f32x4 ya = acc[ai][0][m][0], yb = acc[ai][0][m][1]; f32x4 sa, sb;
#pragma unroll
                        for (int i = 0; i < 4; ++i) { sa[i] = fast_rcp(1.f + __expf(-ya[i])); sb[i] = fast_rcp(1.f + __expf(-yb[i])); }
                        *(f32x4*)(gt + tok * 24 + 8 * fq) = sa; *(f32x4*)(gt + tok * 24 + 8 * fq + 4) = sb; }
            }
        }
    }
};
struct EpiFp8 {
    static constexpr bool PERM = true; static constexpr bool PF = false;
    unsigned char* O; int ldc;
    DI void operator()(const f32x4 (&acc)[2][2][4][2], const Unit& u, int wr, int wc, int fr, int fq) const {
        asm volatile("" : "+v"(fr), "+v"(fq));
        const int row0 = u.pm * BM + wr * 64 + fr; const int col0 = u.pn * BM + wc * 32 + 8 * fq;
#pragma unroll
        for (int ai = 0; ai < 2; ++ai)
#pragma unroll
            for (int m = 0; m < 4; ++m) { unsigned char* rowp = O + (size_t)(row0 + ai * HALF + m * 16) * ldc + col0;
#pragma unroll
                for (int bj = 0; bj < 2; ++bj) { const f32x4 v0 = acc[ai][bj][m][0], v1 = acc[ai][bj][m][1];
                    u32x2 w; w.x = pk4_fp8(v0[0], v0[1], v0[2], v0[3]); w.y = pk4_fp8(v1[0], v1[1], v1[2], v1[3]);
                    *(u32x2*)(rowp + bj * HALF) = w; } }
    }
};
struct EpiSwiglu {
    static constexpr bool PERM = true; static constexpr bool PF = false;
    unsigned char* O;
    DI void operator()(const f32x4 (&acc)[2][2][4][2], const Unit& u, int wr, int wc, int fr, int fq) const {
        asm volatile("" : "+v"(fr), "+v"(fq));
        const int row0 = u.pm * BM + wr * 64 + fr; const int col0 = u.pn * 128 + wc * 16 + 4 * fq;
#pragma unroll
        for (int ai = 0; ai < 2; ++ai)
#pragma unroll
            for (int m = 0; m < 4; ++m) { unsigned char* rowp = O + (size_t)(row0 + ai * HALF + m * 16) * EHID + col0;
#pragma unroll
                for (int bj = 0; bj < 2; ++bj) { const f32x4 g = acc[ai][bj][m][0], up = acc[ai][bj][m][1]; float h[4];
#pragma unroll
                    for (int i = 0; i < 4; ++i) { const float s = fast_rcp(1.f + __expf(-g[i])); h[i] = g[i] * s * up[i]; }
                    *(unsigned*)(rowp + bj * 64) = pk4_fp8(h[0], h[1], h[2], h[3]); } }
    }
};
struct EpiOutProj {
    static constexpr bool PERM = true; static constexpr bool PF = false;
    DI const char* pf_base(const Unit& u) const { return (const char*)(x + (size_t)u.pm * BM * DM + u.pn * BM); }
    const float* x; bf16_t* x1b; const float* mod; float* rowss;
    DI void operator()(const f32x4 (&acc)[2][2][4][2], const Unit& u, int wr, int wc, int fr, int fq) const {
        const int col0 = u.pn * BM + wc * 32 + 8 * fq; const int b = (u.pm * BM) / SEQ;
        const float* g1 = mod + (size_t)b * 6144 + 2048 + col0;
        f32x4 gv[2][2];
#pragma unroll
        for (int bj = 0; bj < 2; ++bj)
#pragma unroll
            for (int n = 0; n < 2; ++n) gv[bj][n] = *(const f32x4*)(g1 + bj * HALF + n * 4);
        f32x4 xa_[2][2], xb_[2][2], na_[2][2], nb_[2][2];
#define OP_LOAD(q, A_, B_) do { _Pragma("unroll") for (int m2 = 0; m2 < 2; ++m2) _Pragma("unroll") for (int bj = 0; bj < 2; ++bj) { \
            const size_t off_ = (size_t)(u.pm * BM + ((q) >> 1) * HALF + wr * 64 + (2 * ((q) & 1) + m2) * 16 + fr) * DM + col0; A_[m2][bj] = ldnt4(x + off_ + bj * HALF); B_[m2][bj] = ldnt4(x + off_ + bj * HALF + 4); } } while (0)
        OP_LOAD(0, xa_, xb_);
#pragma unroll
        for (int q = 0; q < 4; ++q) {
            if (q < 3) OP_LOAD(q + 1, na_, nb_);
            const int ai = q >> 1;
#pragma unroll
            for (int m2 = 0; m2 < 2; ++m2) { const int m = 2 * (q & 1) + m2; const int r = u.pm * BM + ai * HALF + wr * 64 + m * 16 + fr; const size_t off = (size_t)r * DM + col0; float ss = 0.f;
#pragma unroll
                for (int bj = 0; bj < 2; ++bj) { const f32x4 xa = xa_[m2][bj], xb = xb_[m2][bj];
                    const f32x4 oa = xa + gv[bj][0] * acc[ai][bj][m][0], ob = xb + gv[bj][1] * acc[ai][bj][m][1];
                    ss += (oa[0] * oa[0] + oa[1] * oa[1]) + (oa[2] * oa[2] + oa[3] * oa[3]) + (ob[0] * ob[0] + ob[1] * ob[1]) + (ob[2] * ob[2] + ob[3] * ob[3]);
                    u32x4 w; w.x = pk2(oa[0], oa[1]); w.y = pk2(oa[2], oa[3]); w.z = pk2(ob[0], ob[1]); w.w = pk2(ob[2], ob[3]);
                    *(u32x4*)(x1b + off + bj * HALF) = w; }
                ss = xadd16(ss); ss = xadd32(ss);
                if (fq == 0) rowss[(size_t)r * 16 + u.pn * 4 + wc] = ss; }
            if (q < 3) {
#pragma unroll
                for (int m2 = 0; m2 < 2; ++m2)
#pragma unroll
                    for (int bj = 0; bj < 2; ++bj) { xa_[m2][bj] = na_[m2][bj]; xb_[m2][bj] = nb_[m2][bj]; }
            }
        }
#undef OP_LOAD
    }
};
}

struct Frame {
    LAS unsigned char* lds; unsigned char* ws; const float* const* in; float* out;
    int tid, lane, wave, bid, G, gw, NGW;
};

DI int origcol(int n) { return n < 1280 ? n : (n < 2816 ? n + 24 : (n < 2840 ? n - 2816 + 1280 : -1)); }

template <class DRow>
DI void tr_item(const float* src, int src_ld, int sc  , bf16_t* dst, int dst_ld, int k0, LAS float* scr, int lane, DRow drow) {
#pragma unroll 8
    for (int i = 0; i < 32; ++i) { const int kk = 2 * i + (lane >> 5); scr[kk * 33 + (lane & 31)] = sc >= 0 ? src[(size_t)(k0 + kk) * src_ld + sc] : 0.f; }
    asm volatile("s_waitcnt lgkmcnt(0)" ::: "memory");
    const int c = lane & 7;
#pragma unroll
    for (int j = 0; j < 4; ++j) { const int n = (lane >> 3) + 8 * j; const LAS float* s = scr + (8 * c) * 33 + n;
        u32x4 o; o.x = pk2(s[0 * 33], s[1 * 33]); o.y = pk2(s[2 * 33], s[3 * 33]); o.z = pk2(s[4 * 33], s[5 * 33]); o.w = pk2(s[6 * 33], s[7 * 33]);
        *(u32x4*)(dst + (size_t)drow(n) * dst_ld + k0 + 8 * c) = o; }
    asm volatile("s_waitcnt lgkmcnt(0)" ::: "memory");
}

constexpr int TR_NITEMS = 16 * 96 + 16 * 32 + 2 * (32 * 16 * 16) + 32 * 8 * 32 + 4 * 16 * 8;
constexpr int TR_EARLY = 11264;
DI void phase0_weights(Frame& F, int first, int end, int worker, int nworkers);
DI void phase0(Frame& F) {
    const float* c_in = F.in[1]; const float* w_ada = F.in[2]; const float* b_ada = F.in[3];
    float* mod = (float*)(F.ws + WS_MOD);
    for (int it = F.bid; it < 96; it += F.G) {
        LAS float* cs = (LAS float*)F.lds;
        for (int idx = F.tid; idx < 32 * 1024; idx += NTHREADS) { const int b = idx >> 10, k = idx & 1023; cs[k * 32 + (b ^ (k & 31))] = c_in[idx]; }
        __syncthreads();
        float acc[32];
#pragma unroll
        for (int b = 0; b < 32; ++b) acc[b] = 0.f;
        const int j = it * 64 + F.lane;
#pragma unroll 1
        for (int kg = 0; kg < 2; ++kg) {
            float wv[64];
#pragma unroll
            for (int q = 0; q < 64; ++q) wv[q] = w_ada[(size_t)(F.wave * 128 + kg * 64 + q) * 6144 + j];
#pragma unroll
            for (int q = 0; q < 64; ++q) { const int k = F.wave * 128 + kg * 64 + q; const float w = wv[q];
#pragma unroll
                for (int b4 = 0; b4 < 8; ++b4) { const f32x4 cv = *(const LAS f32x4*)(cs + k * 32 + ((b4 * 4) ^ (q & 28)));
                    acc[b4 * 4 + 0] += cv[0 ^ (q & 3)] * w; acc[b4 * 4 + 1] += cv[1 ^ (q & 3)] * w; acc[b4 * 4 + 2] += cv[2 ^ (q & 3)] * w; acc[b4 * 4 + 3] += cv[3 ^ (q & 3)] * w; } }
        }
        __syncthreads();
        LAS float* red = (LAS float*)F.lds;
#pragma unroll
        for (int b = 0; b < 32; ++b) red[(F.wave * 32 + b) * 64 + F.lane] = acc[b];
        __syncthreads();
        for (int o = F.tid; o < 2048; o += NTHREADS) { const int b = o >> 6, l = o & 63; float s = b_ada[it * 64 + l];
#pragma unroll
            for (int w = 0; w < 8; ++w) s += red[(w * 32 + b) * 64 + l];
            mod[(size_t)b * 6144 + it * 64 + l] = s; }
        asm volatile("s_waitcnt vmcnt(0)" ::: "memory");
        __syncthreads();
        if (it < 32 && F.tid == 0) { __builtin_amdgcn_fence(__ATOMIC_RELEASE, "agent"); __hip_atomic_fetch_add((unsigned*)(F.ws + WS_CTL) + CW_ADA, 1u, __ATOMIC_RELAXED, __HIP_MEMORY_SCOPE_AGENT); }
    }
    if (F.G > 96) { if (F.bid >= 96) phase0_weights(F, 0, TR_EARLY, (F.bid - 96) * NWAVES + F.wave, (F.G - 96) * NWAVES); phase0_weights(F, TR_EARLY, TR_NITEMS, F.gw, F.NGW); }
    else phase0_weights(F, 0, TR_NITEMS, F.gw, F.NGW);
    const int gt = F.bid * NTHREADS + F.tid, NGT = F.G * NTHREADS;
    { float* ropeN = (float*)(F.ws + WS_ROPE); float* ropeD = ropeN + 2048 * 16;
      for (int i = gt; i < 2048 * 12; i += NGT) { const int t = i / 12, j = i % 12; const bool isn = j < 8; const int ii = isn ? j : j - 8;
          const float ex = isn ? (float)(2 * ii) / 16.f : (float)(2 * ii) / 8.f;
          const float inv = exp2f(-ex * 18.931568569324174f);
          const float ang = (float)t * inv;
          const double rev = (double)ang * 0.15915494309189535; const double fr = rev - __builtin_rint(rev); const float rr = (float)(fr * 6.283185307179586);
          const float cs = __cosf(rr), sn = __sinf(rr);
          if (isn) { ropeN[(t * 8 + ii) * 2] = cs; ropeN[(t * 8 + ii) * 2 + 1] = sn; ropeN[65536 + (t * 8 + ii) * 2] = cs; ropeN[65536 + (t * 8 + ii) * 2 + 1] = -sn; }
          else { ropeD[(t * 4 + ii) * 2] = cs; ropeD[(t * 4 + ii) * 2 + 1] = sn; } } }
    { bf16_t* whi = (bf16_t*)(F.ws + WS_WR); bf16_t* wlo = whi + 48 * 1024;
      for (int i = gt; i < 48 * 1024; i += NGT) { const int c = i >> 10, k = i & 1023; float w = 0.f;
          if (c < 4) w = F.in[20][k * 4 + c]; else if (c < 36) w = F.in[22][k * 32 + (c - 4)];
          const unsigned short h = f2bf(w); whi[i] = h; wlo[i] = f2bf(w - bf2f(h)); } }
    { bf16_t* w2t = (bf16_t*)(F.ws + WS_W2T);
      for (int i = gt; i < 2 * 64 * 264; i += NGT) { const int k = i % 264, n = (i / 264) & 63, kv = i / (264 * 64); w2t[i] = k < 256 ? f2bf(F.in[11][((size_t)kv * 256 + k) * 64 + n]) : (bf16_t)0; } }
    { bf16_t* pe = (bf16_t*)(F.ws + WS_PE);
      for (int i = gt; i < 256 * 1024; i += NGT) { const int r = i >> 10, k = i & 1023; float v = 0.f; if (r < 4) v = F.in[9][(r >> 1) * 2048 + (r & 1) * 1024 + k]; pe[i] = f2bf(v); } }
    { u32x4* l4 = (u32x4*)(F.ws + WS_LIST); for (int i = gt; i < (int)(NEXP * ECAP / 4); i += NGT) l4[i] = (u32x4){0u, 0u, 0u, 0u};
      unsigned* ctl = (unsigned*)(F.ws + WS_CTL); for (int i = gt; i < 4096; i += NGT) ctl[i] = 0u; }
}

struct TrD { const float* src; int ld; int sc; bf16_t* dst; int dld; int k0; int mode; int n0; int aux; int fp8; };
DI TrD tr_desc(Frame& F, int it, int lane) {
    constexpr int I_IN = 16 * 96, I_OUT = 16 * 32, I_G = 32 * 16 * 16, I_D = 32 * 8 * 32;
    TrD d; int r = it; const int nq = lane & 7;
    if (r < I_IN) { const int kb = r / 96, nb = r % 96; d.n0 = nb * 32; const int n = d.n0 + 4 * nq; d.src = F.in[6]; d.ld = INCOLS; d.sc = origcol(n); d.dst = (bf16_t*)(F.ws + WS_WIN); d.dld = 1024; d.k0 = kb * 64; d.mode = 0; d.aux = 0; d.fp8 = 1; return d; }
    r -= I_IN;
    if (r < I_OUT) { const int kb = r / 32, nb = r % 32; d.n0 = nb * 32; d.src = F.in[19]; d.ld = 1024; d.sc = d.n0 + 4 * nq; d.dst = (bf16_t*)(F.ws + WS_WOUT); d.dld = 1024; d.k0 = kb * 64; d.mode = 0; d.aux = 0; d.fp8 = 0; return d; }
    r -= I_OUT;
    if (r < 2 * I_G) { const int up = r / I_G; r -= up * I_G; const int e = r / 256, q = r % 256, kb = q / 16, nb = q % 16; d.n0 = nb * 32;
        d.src = F.in[24 + up] + (size_t)e * 1024 * 512; d.ld = 512; d.sc = d.n0 + 4 * nq; d.dst = (bf16_t*)(F.ws + WS_WGU + (size_t)e * 1024 * 1024); d.dld = 1024; d.k0 = kb * 64; d.mode = 1; d.aux = up; d.fp8 = 1; return d; }
    r -= 2 * I_G;
    if (r < I_D) { const int e = r / 256, q = r % 256, kb = q / 32, nb = q % 32; d.n0 = nb * 32;
        d.src = F.in[26] + (size_t)e * 512 * 1024; d.ld = 1024; d.sc = d.n0 + 4 * nq; d.dst = (bf16_t*)(F.ws + WS_WD + (size_t)e * 1024 * 512); d.dld = 512; d.k0 = kb * 64; d.mode = 0; d.aux = 0; d.fp8 = 1; return d; }
    r -= I_D;
    { const int kvh = r / 128, q = r % 128, kb = q / 8, nb = q % 8; d.n0 = nb * 32; const int kv = kvh >> 1, half = kvh & 1;
      d.src = F.in[10] + (size_t)kv * 2048 * 256 + (size_t)half * 1024 * 256; d.ld = 256; d.sc = d.n0 + 4 * nq; d.dst = (bf16_t*)(F.ws + WS_WC1) + (size_t)kv * 512 * 1024; d.dld = 1024; d.k0 = kb * 64; d.mode = 2; d.aux = half; d.fp8 = 0; return d; }
}
DI void tr_load(const TrD& d, f32x4 (&v)[8], int lane) {
    const int kk = lane >> 3;
#pragma unroll
    for (int i = 0; i < 8; ++i) v[i] = d.sc >= 0 ? ldnt4(d.src + (size_t)(d.k0 + kk + 8 * i) * d.ld + d.sc) : (f32x4){0.f, 0.f, 0.f, 0.f};
}
DI void tr_finish(const TrD& d, const f32x4 (&v)[8], LAS float* scr, int lane) {
    const int kk = lane >> 3, nq = lane & 7;
#pragma unroll
    for (int i = 0; i < 8; ++i) *(LAS f32x4*)(scr + (kk + 8 * i) * 36 + ((4 * nq) ^ (4 * i))) = v[i];
    asm volatile("s_waitcnt lgkmcnt(0)" ::: "memory");
    const int c = lane & 7;
#pragma unroll
    for (int j = 0; j < 4; ++j) { const int n = (lane >> 3) + 8 * j; const LAS float* s = scr + (8 * c) * 36 + (n ^ (4 * c));
        const int jn = d.n0 + n; const int row = d.mode == 0 ? jn : (d.mode == 1 ? 8 * (jn >> 2) + (jn & 3) + 4 * d.aux : d.aux * 256 + jn);
        if (d.fp8) { u32x2 o8; o8.x = pk4_fp8(s[0 * 36] * 256.f, s[1 * 36] * 256.f, s[2 * 36] * 256.f, s[3 * 36] * 256.f); o8.y = pk4_fp8(s[4 * 36] * 256.f, s[5 * 36] * 256.f, s[6 * 36] * 256.f, s[7 * 36] * 256.f);
            *(u32x2*)((unsigned char*)d.dst + (size_t)row * d.dld + d.k0 + 8 * c) = o8; }
        else { u32x4 o; o.x = pk2(s[0 * 36], s[1 * 36]); o.y = pk2(s[2 * 36], s[3 * 36]); o.z = pk2(s[4 * 36], s[5 * 36]); o.w = pk2(s[6 * 36], s[7 * 36]);
            *(u32x4*)(d.dst + (size_t)row * d.dld + d.k0 + 8 * c) = o; } }
    asm volatile("s_waitcnt lgkmcnt(0)" ::: "memory");
}
DI void phase0_weights(Frame& F, int first, int end, int worker, int nworkers) {
    LAS float* scr = (LAS float*)(F.lds + F.wave * 16384);
    const int lane = F.lane;
    int it = first + worker; if (it >= end) return;
    TrD cur = tr_desc(F, it, lane); f32x4 vc[8]; tr_load(cur, vc, lane);
    for (;;) {
        const int nit = it + nworkers; const bool more = nit < end;
        TrD nxt = cur; f32x4 vn[8];
        if (more) { nxt = tr_desc(F, nit, lane); tr_load(nxt, vn, lane); }
        tr_finish(cur, vc, scr, lane);
        if (!more) break;
        cur = nxt; it = nit;
#pragma unroll
        for (int i = 0; i < 8; ++i) vc[i] = vn[i];
    }
}
#ifndef STAG2
#define STAG2 0
#endif
DI void stagger(const Frame& F, int ticks) {
    if (ticks > 0 && ((F.bid >> 3) & 1)) { const unsigned long long t0 = __builtin_amdgcn_s_memrealtime(); while ((long long)(__builtin_amdgcn_s_memrealtime() - t0) < (long long)ticks) __builtin_amdgcn_s_sleep(16); }
}
DI void phase1(Frame& F) {
    const float* x = F.in[0]; const float* g = F.in[4]; const float* mod = (const float*)(F.ws + WS_MOD); unsigned char* h1 = (unsigned char*)(F.ws + WS_H1);
    const int lane = F.lane;
    for (int m0 = F.gw * 32; m0 < TOK; m0 += F.NGW * 32) {
        const int b = m0 >> 11; const float* sh = mod + (size_t)b * 6144; const float* sc = sh + 1024;
        f32x4 A[4], Bv[4];
#pragma unroll
        for (int j = 0; j < 4; ++j) { const int col = 4 * lane + 256 * j; A[j] = *(const f32x4*)(g + col) * (*(const f32x4*)(sc + col) + 1.f); Bv[j] = *(const f32x4*)(sh + col); }
        const f32x4* xr = (const f32x4*)(x + (size_t)m0 * DM) + lane; unsigned* o8 = (unsigned*)(h1 + (size_t)m0 * DM) + lane;
        f32x4 v0[4], v1[4];
#pragma unroll
        for (int j = 0; j < 4; ++j) { v0[j] = __builtin_nontemporal_load(xr + 64 * j); v1[j] = __builtin_nontemporal_load(xr + 256 + 64 * j); }
        for (int i = 0; i < 32; i += 2) {
            f32x4 n0[4], n1[4];
            if (i + 2 < 32) {
#pragma unroll
                for (int j = 0; j < 4; ++j) { n0[j] = __builtin_nontemporal_load(xr + (size_t)(i + 2) * 256 + 64 * j); n1[j] = __builtin_nontemporal_load(xr + (size_t)(i + 3) * 256 + 64 * j); }
            }
            float s0 = 0.f, s1 = 0.f;
#pragma unroll
            for (int j = 0; j < 4; ++j) { s0 += (v0[j][0] * v0[j][0] + v0[j][1] * v0[j][1]) + (v0[j][2] * v0[j][2] + v0[j][3] * v0[j][3]); s1 += (v1[j][0] * v1[j][0] + v1[j][1] * v1[j][1]) + (v1[j][2] * v1[j][2] + v1[j][3] * v1[j][3]); }
            s0 = wave_sum(s0); s1 = wave_sum(s1);
            const float r0 = rsqrtf(s0 * (1.f / DM) + EPS), r1 = rsqrtf(s1 * (1.f / DM) + EPS);
#pragma unroll
            for (int j = 0; j < 4; ++j) { const f32x4 y0 = v0[j] * r0 * A[j] + Bv[j], y1 = v1[j] * r1 * A[j] + Bv[j];
                o8[(size_t)i * 256 + 64 * j] = pk4_fp8(y0[0], y0[1], y0[2], y0[3]); o8[(size_t)(i + 1) * 256 + 64 * j] = pk4_fp8(y1[0], y1[1], y1[2], y1[3]); }
#pragma unroll
            for (int j = 0; j < 4; ++j) { v0[j] = n0[j]; v1[j] = n1[j]; }
        }
    }
}

DI void phase3(Frame& F) {
    const bf16_t* proj = (const bf16_t*)(F.ws + WS_PROJ);
    const float* ropeN = (const float*)(F.ws + WS_ROPE); const float* ropeD = ropeN + 2048 * 16;
    const float* g_nq = F.in[7]; const float* g_nk = F.in[8]; const float* g_dq = F.in[12]; const float* g_dk = F.in[13];
    const int lane = F.lane;
    for (int it = F.gw; it < TOK * 6; it += F.NGW) {
        const int m = it / 6, part = it % 6; const int b = m >> 11, t = m & 2047;
        const int c0 = part * 512 + lane * 8;
        const u32x4 raw = *(const u32x4*)(proj + (size_t)m * NPROJ + c0);
        float v[8]; v[0] = bflo(raw.x); v[1] = bfhi(raw.x); v[2] = bflo(raw.y); v[3] = bfhi(raw.y); v[4] = bflo(raw.z); v[5] = bfhi(raw.z); v[6] = bflo(raw.w); v[7] = bfhi(raw.w);
        float ss = 0.f;
#pragma unroll
        for (int i = 0; i < 8; ++i) ss += v[i] * v[i];
        ss += __shfl_xor(ss, 1); ss += __shfl_xor(ss, 2); const float ss32 = ss; ss += __shfl_xor(ss, 4); const float ss64 = ss;
        float pv[8];
#pragma unroll
        for (int i = 0; i < 8; ++i) pv[i] = __shfl_xor(v[i], 1);
        if (c0 < 1280) {
            const bool isq = c0 < 512; int six = 0, gsel = 0, d0;
            if (isq) { d0 = c0 & 63; } else { const int cc = c0 - 512; six = cc >> 7; gsel = (cc >> 6) & 1; d0 = cc & 63; }
            const bool donorm = isq || six == 2 || six == 4;
            float y[8];
            if (donorm) { const float* gg = isq ? g_nq : (g_nk + (six == 2 ? 64 : 128)); const float rstd = rsqrtf(ss64 * (1.f / 64.f) + EPS);
#pragma unroll
                for (int i = 0; i < 8; ++i) { y[i] = v[i] * rstd * gg[d0 + i]; pv[i] = pv[i] * rstd * gg[(d0 ^ 8) + i]; } }
            else {
#pragma unroll
                for (int i = 0; i < 8; ++i) y[i] = v[i]; }
            float yr[8];
#pragma unroll
            for (int i = 0; i < 8; ++i) yr[i] = y[i];
            if (donorm && d0 < 16) {
#pragma unroll
                for (int i = 0; i < 8; ++i) { const float cs = ropeN[(t * 8 + i) * 2], sn = ropeN[(t * 8 + i) * 2 + 1];
                    yr[i] = d0 == 0 ? (y[i] * cs - pv[i] * sn) : (pv[i] * sn + y[i] * cs); }
            }
            u32x4 w0, w1; w0.x = pk2(y[0], y[1]); w0.y = pk2(y[2], y[3]); w0.z = pk2(y[4], y[5]); w0.w = pk2(y[6], y[7]);
            w1.x = pk2(yr[0], yr[1]); w1.y = pk2(yr[2], yr[3]); w1.z = pk2(yr[4], yr[5]); w1.w = pk2(yr[6], yr[7]);
            if (isq) { const int hd = c0 >> 6; const size_t off = (((size_t)b * 8 + hd) * SEQ + t) * 64 + d0;
                *(u32x4*)((bf16_t*)(F.ws + WS_QN) + off) = w0; *(u32x4*)((bf16_t*)(F.ws + WS_QR) + off) = w1; }
            else { const size_t base = six == 0 ? WS_KC : six == 1 ? WS_VC : six == 2 ? WS_KS : six == 3 ? WS_VS : six == 4 ? WS_KW : WS_VW;
                const size_t off = (((size_t)b * 2 + gsel) * SEQ + t) * 64 + d0;
                *(u32x4*)((bf16_t*)(F.ws + base) + off) = donorm ? w1 : w0; }
        } else if (c0 < 2304) {
            const bool isq = c0 < 1792; const int cc = c0 - (isq ? 1280 : 1792); const int hd = cc >> 6, dd = cc & 63, d0 = dd & 31;
            const float* gg = isq ? g_dq : g_dk; const float rstd = rsqrtf(ss32 * (1.f / 32.f) + EPS);
            float y[8];
#pragma unroll
            for (int i = 0; i < 8; ++i) y[i] = v[i] * rstd * gg[d0 + i];
            if (d0 == 0) {
#pragma unroll
                for (int i = 0; i < 4; ++i) { const float cs = ropeD[(t * 4 + i) * 2], sn = ropeD[(t * 4 + i) * 2 + 1]; const float a = y[i], bb = y[i + 4]; y[i] = a * cs - bb * sn; y[i + 4] = a * sn + bb * cs; }
            }
            u32x4 w; w.x = pk2(y[0], y[1]); w.y = pk2(y[2], y[3]); w.z = pk2(y[4], y[5]); w.w = pk2(y[6], y[7]);
            const size_t off = (((size_t)b * 8 + hd) * SEQ + t) * 64 + dd;
            *(u32x4*)((bf16_t*)(F.ws + (isq ? WS_DQ : WS_DK)) + off) = w;
        } else if (c0 < 2816) {
            const int cc = c0 - 2304; const int hd = cc >> 6, dd = cc & 63; const size_t off = (((size_t)b * 8 + hd) * SEQ + t) * 64 + dd;
            *(u32x4*)((bf16_t*)(F.ws + WS_DV) + off) = raw;
        } else if (c0 < 2840) {
            float* gt = (float*)(F.ws + WS_GATES) + (size_t)m * 24 + (c0 - 2816);
#pragma unroll
            for (int i = 0; i < 8; ++i) gt[i] = 1.f / (1.f + __expf(-v[i]));
        }
    }
}

DI void glds16(const void* gsrc, unsigned lds_dst) { unsigned keep;
    asm volatile("s_mov_b32 %0, m0\n\ts_mov_b32 m0, %2\n\ts_nop 0\n\tglobal_load_lds_dwordx4 %1, off\n\ts_mov_b32 m0, %0" : "=&s"(keep) : "v"(gsrc), "s"(lds_dst) : "memory"); }
DI unsigned lds_addr(const LAS void* p) { return (unsigned)(uintptr_t)p; }
DI void store_row64(bf16_t* row, u32x2 (&o2)[8], int hh) {
#pragma unroll
    for (int k = 0; k < 8; k += 2) { u32x2 a = o2[k], b = o2[k + 1];
        auto r0 = __builtin_amdgcn_permlane32_swap(a.x, b.x, false, false); a.x = r0[0]; b.x = r0[1];
        auto r1 = __builtin_amdgcn_permlane32_swap(a.y, b.y, false, false); a.y = r1[0]; b.y = r1[1];
        u32x4 w; w.x = a.x; w.y = a.y; w.z = b.x; w.w = b.y;
        *(u32x4*)(row + 8 * k + (hh ? 8 : 0)) = w; }
}
struct ALane { int k0; int v0; DI int ko(int ks) const { return k0 ^ (ks << 5); } DI int vo(int db) const { return v0 ^ (db << 6); } };
DI ALane alane_init(int lane) {
    ALane L; const int r = lane & 31, hh = lane >> 5, g = lane >> 4, i = lane & 15;
    L.k0 = r * 128 + ((hh ^ ((r >> 1) & 7)) << 4);
    const int rl = 4 * hh + (i >> 2); const int ch = 2 * (g & 1) + ((i & 3) >> 1);
    L.v0 = rl * 128 + ((ch ^ (((rl >> 1) & 1) << 2)) << 4) + 8 * (i & 1);
    return L;
}
DI s16x4 vtr(const LAS char* p) { typedef short v4i16 __attribute__((ext_vector_type(4))); return __builtin_bit_cast(s16x4, __builtin_amdgcn_ds_read_tr16_b64_v4i16((LAS v4i16*)p)); }
DI bf16x8 vfrag(const LAS char* Vt, const ALane& L, int db, int kb, int s) {
    const LAS char* p = Vt + L.vo(db) + (32 * kb + 16 * s) * 128;
    const s16x4 lo = vtr(p), hi = vtr(p + 8 * 128);
    return __builtin_shufflevector(lo, hi, 0, 1, 2, 3, 4, 5, 6, 7);
}
DI bf16x8 pfrag(const f32x16& p, int s) { u32x4 w; w.x = pk2(p[8 * s + 0], p[8 * s + 1]); w.y = pk2(p[8 * s + 2], p[8 * s + 3]); w.z = pk2(p[8 * s + 4], p[8 * s + 5]); w.w = pk2(p[8 * s + 6], p[8 * s + 7]); return __builtin_bit_cast(bf16x8, w); }
DI u32x4 tile_ld(const bf16_t* g, int tid) { return *(const u32x4*)(g + tid * 8); }
DI void tile_st_k(LAS char* Kt, u32x4 v, int tid) { const int row = tid >> 3, ch = tid & 7; *(LAS u32x4*)(Kt + row * 128 + ((ch ^ ((row >> 1) & 7)) << 4)) = v; }
DI void tile_st_v(LAS char* Vt, u32x4 v, int tid) { const int row = tid >> 3, ch = tid & 7; *(LAS u32x4*)(Vt + row * 128 + ((ch ^ (((row >> 1) & 1) << 2)) << 4)) = v; }

constexpr int MK_NONE = 0, MK_LE = 1, MK_GT = 2;
template <int MASK>
DI void sm16(f32x16& a, float c2, float mcl, int kb, int hh, int th) {
    if constexpr (MASK != MK_NONE) asm volatile("" : "+v"(th));
#pragma unroll
    for (int i = 0; i < 16; ++i) {
        float x = __builtin_fmaf(a[i], c2, -mcl);
        if constexpr (MASK != MK_NONE) { const int kl = 32 * kb + crow(i, hh); const bool ok = MASK == MK_LE ? (kl <= th) : (kl > th); x = ok ? x : -1.0e30f; }
        a[i] = fast_exp2(x);
    }
}
DI float sum16(const f32x16& a) { return ((a[0] + a[1]) + (a[2] + a[3])) + ((a[4] + a[5]) + (a[6] + a[7])) + ((a[8] + a[9]) + (a[10] + a[11])) + ((a[12] + a[13]) + (a[14] + a[15])); }
#define SCHED_FENCE() do { } while (0)
template <int MASK, bool KEEPP>
DI void attn_tile64(const LAS char* Kt, const LAS char* Vt, const ALane& L, const bf16x8 (&qf)[4], f32x16 (&O)[2], float& lsum, float c2, float mcl, int th, int hh, f32x16 (&P)[2]) {
    bf16x8 kf[2][4];
#pragma unroll
    for (int kb = 0; kb < 2; ++kb)
#pragma unroll
        for (int ks = 0; ks < 4; ++ks) kf[kb][ks] = *(const LAS bf16x8*)(Kt + L.ko(ks) + kb * 4096);
    SCHED_FENCE();
    f32x16 a0 = {0.f, 0.f, 0.f, 0.f, 0.f, 0.f, 0.f, 0.f, 0.f, 0.f, 0.f, 0.f, 0.f, 0.f, 0.f, 0.f}, a1 = a0;
#pragma unroll
    for (int ks = 0; ks < 4; ++ks) a0 = MFMA32(kf[0][ks], qf[ks], a0);
#pragma unroll
    for (int ks = 0; ks < 4; ++ks) a1 = MFMA32(kf[1][ks], qf[ks], a1);
    bf16x8 v0[2][2], v1[2][2];
#pragma unroll
    for (int s = 0; s < 2; ++s)
#pragma unroll
        for (int db = 0; db < 2; ++db) v0[s][db] = vfrag(Vt, L, db, 0, s);
    SCHED_FENCE();
    bf16x8 pf[2][2];
    sm16<MASK>(a0, c2, mcl, 0, hh, th); lsum += sum16(a0); pf[0][0] = pfrag(a0, 0); pf[0][1] = pfrag(a0, 1);
    if constexpr (KEEPP) P[0] = a0;
#pragma unroll
    for (int s = 0; s < 2; ++s)
#pragma unroll
        for (int db = 0; db < 2; ++db) v1[s][db] = vfrag(Vt, L, db, 1, s);
    SCHED_FENCE();
    sm16<MASK>(a1, c2, mcl, 1, hh, th); lsum += sum16(a1); pf[1][0] = pfrag(a1, 0); pf[1][1] = pfrag(a1, 1);
    if constexpr (KEEPP) P[1] = a1;
    SCHED_FENCE();
#pragma unroll
    for (int s = 0; s < 2; ++s)
#pragma unroll
        for (int db = 0; db < 2; ++db) O[db] = MFMA32(v0[s][db], pf[0][s], O[db]);
#pragma unroll
    for (int s = 0; s < 2; ++s)
#pragma unroll
        for (int db = 0; db < 2; ++db) O[db] = MFMA32(v1[s][db], pf[1][s], O[db]);
    SCHED_FENCE();
}
template <int MASK>
DI void ex16(f32x16& a, int kb, int hh, int th) {
    if constexpr (MASK != MK_NONE) asm volatile("" : "+v"(th));
#pragma unroll
    for (int i = 0; i < 16; ++i) {
        float x = a[i];
        if constexpr (MASK != MK_NONE) { const int kl = 32 * kb + crow(i, hh); const bool ok = MASK == MK_LE ? (kl <= th) : (kl > th); x = ok ? x : -1.0e30f; }
        a[i] = fast_exp2(x);
    }
}
template <int MASK>
DI void attn_tile_dm(const LAS char* Kt, const LAS char* Vt, const ALane& L, int ko0, int ko1, const bf16x8 (&qf)[2], f32x16 (&O)[2], f32x16& Ls, const f32x16& negm, const bf16x8& ones, int th, int hh) {
    bf16x8 pf[2][2];
#pragma unroll
    for (int kb = 0; kb < 2; ++kb) {
        const bf16x8 k0 = *(const LAS bf16x8*)(Kt + ko0 + kb * 4096), k1 = *(const LAS bf16x8*)(Kt + ko1 + kb * 4096);
        f32x16 acc = MFMA32(k0, qf[0], negm); acc = MFMA32(k1, qf[1], acc);
        ex16<MASK>(acc, kb, hh, th);
        Ls[0] += sum16(acc);
        pf[kb][0] = pfrag(acc, 0); pf[kb][1] = pfrag(acc, 1);
    }
#pragma unroll
    for (int kb = 0; kb < 2; ++kb)
#pragma unroll
        for (int s = 0; s < 2; ++s)
#pragma unroll
            for (int db = 0; db < 2; ++db) O[db] = MFMA32(vfrag(Vt, L, db, kb, s), pf[kb][s], O[db]);
}
#define RING_WAIT(n) asm volatile("s_waitcnt vmcnt(" #n ")" ::: "memory")
template <class PreF, class CompF>
DI void attn_ring(LAS char* lds, const bf16_t* Kg, const bf16_t* Vg, unsigned tiles, int wid, int lane, PreF pre, CompF comp) {
    if (tiles == 0u) return;
    const int p = wid * 64 + lane, row = p >> 3, c = p & 7;
    const unsigned ksrc = (unsigned)(row * 128 + ((c ^ ((row >> 1) & 7)) << 4)), vsrc = (unsigned)(row * 128 + ((c ^ (((row >> 1) & 1) << 2)) << 4));
    LAS char* wb = lds + wid * 1024;
#define RING_ISSUE(j, slot) do { \
        glds16((const char*)(Kg) + (size_t)(j) * 8192 + ksrc, (unsigned)__builtin_amdgcn_readfirstlane((int)(lds_addr(wb) + (unsigned)(slot) * 16384u))); \
        glds16((const char*)(Vg) + (size_t)(j) * 8192 + vsrc, (unsigned)__builtin_amdgcn_readfirstlane((int)(lds_addr(wb) + (unsigned)(slot) * 16384u + 8192u))); } while (0)
    int q0 = __builtin_ctz(tiles); tiles &= tiles - 1u;
    int q1 = -1, q2 = -1;
    if (tiles) { q1 = __builtin_ctz(tiles); tiles &= tiles - 1u; }
    if (tiles) { q2 = __builtin_ctz(tiles); tiles &= tiles - 1u; }
    RING_ISSUE(q0, 0);
    if (q1 >= 0) RING_ISSUE(q1, 1);
    if (q2 >= 0) RING_ISSUE(q2, 2);
    pre();
    int i = 0;
    for (;;) {
        if (q2 >= 0) RING_WAIT(4); else if (q1 >= 0) RING_WAIT(2); else RING_WAIT(0);
        __builtin_amdgcn_s_barrier();
        int q3 = -1;
        if (tiles) { q3 = __builtin_ctz(tiles); tiles &= tiles - 1u; RING_ISSUE(q3, (i + 3) & 3); }
        LAS char* st = lds + (i & 3) * 16384;
        comp(q0, st, st + 8192);
        if (q1 < 0) break;
        q0 = q1; q1 = q2; q2 = q3; ++i;
    }
    asm volatile("s_waitcnt lgkmcnt(0)" ::: "memory");
    __builtin_amdgcn_s_barrier();
#undef RING_ISSUE
}

DI void ring2_issue(LAS char* lds, const bf16_t* Kg, const bf16_t* Vg, int P, int slot, int wid, int lane) {
    const int p = wid * 64 + lane, row = p >> 3, c = p & 7;
    const unsigned ksrc = (unsigned)(row * 128 + ((c ^ ((row >> 1) & 7)) << 4)), vsrc = (unsigned)(row * 128 + ((c ^ (((row >> 1) & 1) << 2)) << 4));
    const unsigned d_ = (unsigned)__builtin_amdgcn_readfirstlane((int)(lds_addr(lds + wid * 1024) + (unsigned)slot * 32768u));
    const char* kp_ = (const char*)Kg + (size_t)P * 16384; const char* vp_ = (const char*)Vg + (size_t)P * 16384;
    glds16(kp_ + ksrc, d_); glds16(vp_ + vsrc, d_ + 8192u); glds16(kp_ + 8192 + ksrc, d_ + 16384u); glds16(vp_ + 8192 + vsrc, d_ + 24576u);
}
template <class PreF, class CompF, class FinF>
DI void attn_ring2(LAS char* lds, const bf16_t* Kg, const bf16_t* Vg, int np, int wid, int lane, bool preissued, PreF pre, CompF comp, FinF fin) {
    if (!preissued) { ring2_issue(lds, Kg, Vg, 0, 0, wid, lane); if (np > 1) ring2_issue(lds, Kg, Vg, 1, 1, wid, lane); }
    pre();
    int s = 0;
    for (int i = 0; i < np; ++i) {
        if (i + 1 < np) RING_WAIT(4); else RING_WAIT(0);
        __builtin_amdgcn_s_barrier();
        const int s2 = s == 0 ? 2 : s - 1;
        if (i + 2 < np) ring2_issue(lds, Kg, Vg, i + 2, s2, wid, lane);
        comp(i, lds + s * 32768);
        s = s == 2 ? 0 : s + 1;
    }
    fin();
    asm volatile("s_waitcnt lgkmcnt(0)" ::: "memory");
    __builtin_amdgcn_s_barrier();
    asm volatile("" ::: "memory");
}

DI int diff_unit(Frame& F, int b, int hd, int qb, float c2, float mc, float lam, unsigned nx, bool preissued) {
    const int tid = F.tid, lane = F.lane, wid = F.wave, r = lane & 31, hh = lane >> 5;
    const int rb = wid >> 1, mp = wid & 1;
    const bf16_t* Q = (const bf16_t*)(F.ws + WS_DQ) + ((size_t)b * 8 + hd) * SEQ * 64;
    const bf16_t* Kg = (const bf16_t*)(F.ws + WS_DK) + ((size_t)b * 8 + hd) * SEQ * 64;
    const bf16_t* Vg = (const bf16_t*)(F.ws + WS_DV) + ((size_t)b * 8 + hd) * SEQ * 64;
    LAS char* lds = (LAS char*)F.lds;
    const ALane L = alane_init(lane);
    const int ko0 = L.ko(2 * mp), ko1 = L.ko(2 * mp + 1);
    const int q0w = qb * 128 + rb * 32; const int qq = q0w + r;
    bf16x8 qf[2];
#pragma unroll
    for (int ks = 0; ks < 2; ++ks) { const u32x4 w = *(const u32x4*)(Q + (size_t)qq * 64 + mp * 32 + ks * 16 + hh * 8);
        u32x4 s; s.x = pk2(bflo(w.x) * c2, bfhi(w.x) * c2); s.y = pk2(bflo(w.y) * c2, bfhi(w.y) * c2); s.z = pk2(bflo(w.z) * c2, bfhi(w.z) * c2); s.w = pk2(bflo(w.w) * c2, bfhi(w.w) * c2);
        qf[ks] = __builtin_bit_cast(bf16x8, s); }
    f32x16 O[2], Ls, negm; bf16x8 ones;
#pragma unroll
    for (int i = 0; i < 16; ++i) { O[0][i] = 0.f; O[1][i] = 0.f; Ls[i] = 0.f; negm[i] = -mc; }
#pragma unroll
    for (int i = 0; i < 8; ++i) ones[i] = (short)0x3f80;
    asm volatile("" : "+v"(negm), "+v"(ones));
    const int jmax = 2 * qb + (rb >> 1);
    attn_ring2(lds, Kg, Vg, qb + 1, wid, lane, preissued, [&]() __attribute__((always_inline)) { asm volatile("" : "+v"(qf[0]), "+v"(qf[1])); },
        [&](int P, const LAS char* st) __attribute__((always_inline)) {
        if (P < qb) { attn_tile_dm<MK_NONE>(st, st + 8192, L, ko0, ko1, qf, O, Ls, negm, ones, 0, hh); attn_tile_dm<MK_NONE>(st + 16384, st + 24576, L, ko0, ko1, qf, O, Ls, negm, ones, 0, hh); }
        else if (rb < 2) attn_tile_dm<MK_LE>(st, st + 8192, L, ko0, ko1, qf, O, Ls, negm, ones, qq - 64 * jmax, hh);
        else { attn_tile_dm<MK_NONE>(st, st + 8192, L, ko0, ko1, qf, O, Ls, negm, ones, 0, hh); attn_tile_dm<MK_LE>(st + 16384, st + 24576, L, ko0, ko1, qf, O, Ls, negm, ones, qq - 64 * jmax, hh); }
    }, [&]() __attribute__((always_inline)) { if (tid == 0) *(LAS int*)(lds + LDS_MISC + 4096) = (int)nx; });
    const int nxt = __builtin_amdgcn_readfirstlane(*(const LAS int*)(lds + LDS_MISC + 4096));
    if (nxt < 4096) { const int qbn = 15 - (nxt & 15), bhn = nxt >> 4;
        const bf16_t* Kn = (const bf16_t*)(F.ws + WS_DK) + (size_t)bhn * SEQ * 64; const bf16_t* Vn = (const bf16_t*)(F.ws + WS_DV) + (size_t)bhn * SEQ * 64;
        ring2_issue(lds, Kn, Vn, 0, 0, wid, lane); if (qbn > 0) ring2_issue(lds, Kn, Vn, 1, 1, wid, lane); }
    float lsum = Ls[0]; lsum = xadd32(lsum);
    LAS float* xo = (LAS float*)(lds + 98304 + rb * 8192) + lane;
    if (mp == 1) { const float s1 = lam / lsum;
#pragma unroll
        for (int db = 0; db < 2; ++db)
#pragma unroll
            for (int i = 0; i < 16; ++i) xo[(db * 16 + i) * 64] = O[db][i] * s1; }
    asm volatile("s_waitcnt lgkmcnt(0)" ::: "memory"); __builtin_amdgcn_s_barrier(); asm volatile("" ::: "memory");
    if (mp == 0) {
        const float i0 = 1.f / lsum; float ss = 0.f;
#pragma unroll
        for (int db = 0; db < 2; ++db)
#pragma unroll
            for (int i = 0; i < 16; ++i) { const float o = O[db][i] * i0 - xo[(db * 16 + i) * 64]; O[db][i] = o; ss += o * o; }
        ss = xadd32(ss);
        const float rstd = rsqrtf(ss * (1.f / 64.f) + EPS) * 0.8f;
        const LAS float* go = (const LAS float*)(lds + LDS_MISC + 5120);
        bf16_t* orow = (bf16_t*)(F.ws + WS_AO) + ((size_t)b * SEQ + qq) * DM + 512 + hd * 64;
        u32x2 o2[8];
#pragma unroll
        for (int db = 0; db < 2; ++db)
#pragma unroll
            for (int g4 = 0; g4 < 4; ++g4) { const int d = 32 * db + 8 * g4 + 4 * hh; const f32x4 gv = *(const LAS f32x4*)(go + d);
                o2[4 * db + g4].x = pk2(O[db][4 * g4] * rstd * gv[0], O[db][4 * g4 + 1] * rstd * gv[1]); o2[4 * db + g4].y = pk2(O[db][4 * g4 + 2] * rstd * gv[2], O[db][4 * g4 + 3] * rstd * gv[3]); }
        store_row64(orow, o2, hh);
    }
    return nxt;
}

#define NSA_BAR() do { asm volatile("s_waitcnt lgkmcnt(0)" ::: "memory"); __builtin_amdgcn_s_barrier(); asm volatile("" ::: "memory"); } while (0)
DI int nsa_unit(Frame& F, int b, int g, int qb, float c2, float mc, unsigned nx, bool preissued) {
    const int lane = F.lane, wid = F.wave, r = lane & 31, hh = lane >> 5;
    const int hd = 4 * g + (wid >> 1); const int tl = 32 * (wid & 1) + r; const int t = 64 * qb + tl;
    LAS char* lds = (LAS char*)F.lds;
    LAS float* impP = (LAS float*)(lds + 65536);
    LAS unsigned* selm = (LAS unsigned*)(lds + LDS_MISC + 5120);
    LAS float* invs = (LAS float*)(selm + 128);
    LAS float* otp = (LAS float*)(lds + 65536 + wid * 8192) + lane;
    LAS float* gpark = (LAS float*)(lds + LDS_MISC + 8192 + wid * 768) + lane;
    const ALane L = alane_init(lane);
    const size_t bg = (size_t)b * 2 + g;
    bf16x8 qf[4];
    { const bf16_t* QN = (const bf16_t*)(F.ws + WS_QN) + (((size_t)b * 8 + hd) * SEQ + t) * 64;
#pragma unroll
      for (int ks = 0; ks < 4; ++ks) qf[ks] = *(const bf16x8*)(QN + ks * 16 + hh * 8);
      const float* gates = (const float*)(F.ws + WS_GATES) + ((size_t)b * SEQ + t) * 24 + hd * 3;
      const float g0_ = gates[0], g1_ = gates[1], g2_ = gates[2]; gpark[0] = g0_; gpark[64] = g1_; gpark[128] = g2_; }
    const char* KcB = (const char*)(F.ws + WS_KCMP) + bg * 16384; const char* VcB = (const char*)(F.ws + WS_VCMP) + bg * 16384;
    const char* KsB = (const char*)(F.ws + WS_KS) + bg * (SEQ * 128); const char* VsB = (const char*)(F.ws + WS_VS) + bg * (SEQ * 128);
    const char* KwB = (const char*)(F.ws + WS_KW) + bg * (SEQ * 128); const char* VwB = (const char*)(F.ws + WS_VW) + bg * (SEQ * 128);
    const int nf = qb == 0 ? 1 : (qb == 1 ? 2 : 3); const int f1 = qb == 1 ? 1 : qb - 1, f2 = qb;
    const unsigned fmask = 1u | (qb >= 1 ? (1u << qb) : 0u) | (qb >= 2 ? (1u << (qb - 1)) : 0u);
    const unsigned allb = qb == 31 ? 0xffffffffu : ((1u << (qb + 1)) - 1u);
    unsigned grest = qb <= 5 ? (allb & ~fmask) : 0u;
    const int jlo = qb >= 4 ? qb - 4 : 0;
    int gph = 0, gi = 0;
    const int p_ = wid * 64 + lane, prow = p_ >> 3, pc = p_ & 7;
    const unsigned ksrc = (unsigned)(prow * 128 + ((pc ^ ((prow >> 1) & 7)) << 4)), vsrc = (unsigned)(prow * 128 + ((pc ^ (((prow >> 1) & 1) << 2)) << 4));
    const unsigned wbase = lds_addr(lds) + (unsigned)wid * 1024u;
#define NSA_GEN(ty, jj) do { ty = -1; jj = 0; \
        if (gph == 0) { ty = 0; jj = gi; if (++gi == 2) { gph = 1; gi = 0; } } \
        else if (gph == 1) { ty = 1; jj = gi == 0 ? 0 : (gi == 1 ? f1 : f2); if (++gi == nf) gph = 2; } \
        else { if (gph == 2) { if (grest) { ty = 1; jj = __builtin_ctz(grest); grest &= grest - 1u; } else { gph = 3; gi = jlo; } } \
               if (gph == 3) { if (gi <= qb) { ty = 2; jj = gi++; } else gph = 4; } } } while (0)
#define NSA_ISSUE(ty, jj, slot) do { const char* kp_ = ty == 0 ? KcB : (ty == 1 ? KsB : KwB); const char* vp_ = ty == 0 ? VcB : (ty == 1 ? VsB : VwB); \
        glds16(kp_ + (size_t)(jj) * 8192 + ksrc, (unsigned)__builtin_amdgcn_readfirstlane((int)(wbase + (unsigned)(slot) * 16384u))); \
        glds16(vp_ + (size_t)(jj) * 8192 + vsrc, (unsigned)__builtin_amdgcn_readfirstlane((int)(wbase + (unsigned)(slot) * 16384u + 8192u))); } while (0)
    int t0, j0, t1, j1, t2, j2;
    NSA_GEN(t0, j0); NSA_GEN(t1, j1); NSA_GEN(t2, j2);
    if (!preissued) { NSA_ISSUE(t0, j0, 0); NSA_ISSUE(t1, j1, 1); if (t2 >= 0) NSA_ISSUE(t2, j2, 2); }
#pragma unroll
    for (int ks = 0; ks < 4; ++ks) asm volatile("" : "+v"(qf[ks]));
    f32x16 O[2]; float lv = 0.f; float carry_in = 0.f; unsigned mym = 0u; bool inB = false;
#pragma unroll
    for (int i = 0; i < 16; ++i) { O[0][i] = 0.f; O[1][i] = 0.f; }
    const int nvalid = t >= 31 ? ((t - 31) >> 4) + 1 : 0;
    for (int n = 0;; ++n) {
        if (t2 >= 0) RING_WAIT(4); else if (t1 >= 0) RING_WAIT(2); else RING_WAIT(0);
        __builtin_amdgcn_s_barrier();
        int t3, j3;
        NSA_GEN(t3, j3);
        if (t3 >= 0) NSA_ISSUE(t3, j3, (n + 3) & 3);
        const LAS char* Kt = lds + (n & 3) * 16384; const LAS char* Vt = Kt + 8192;
        int mode = MK_LE, th = tl; float mcl = mc;
        if (t0 == 0) { th = nvalid - 1 - 64 * j0; }
        else if (t0 == 1) { mcl = ((mym >> j0) & 1u) ? mc : 1.0e30f; mode = j0 < qb ? MK_NONE : MK_LE; }
        else {
            if (inB) {
                float lsum = lv; lsum = xadd32(lsum); const float s1 = gpark[64] / lsum;
#pragma unroll
                for (int db = 0; db < 2; ++db)
#pragma unroll
                    for (int i = 0; i < 16; ++i) { otp[(db * 16 + i) * 64] += O[db][i] * s1; O[db][i] = 0.f; }
                lv = 0.f; inB = false;
            }
            mode = j0 == qb ? MK_LE : (j0 == qb - 4 ? MK_GT : MK_NONE);
        }
        if (t0 != 0) {
            f32x16 Pd[2];
            if (mode == MK_NONE) attn_tile64<MK_NONE, false>(Kt, Vt, L, qf, O, lv, c2, mcl, 0, hh, Pd);
            else if (mode == MK_LE) attn_tile64<MK_LE, false>(Kt, Vt, L, qf, O, lv, c2, mcl, th, hh, Pd);
            else attn_tile64<MK_GT, false>(Kt, Vt, L, qf, O, lv, c2, mcl, th, hh, Pd);
        } else {
            f32x16 P[2];
            attn_tile64<MK_LE, true>(Kt, Vt, L, qf, O, lv, c2, mcl, th, hh, P);
            LAS float* ip = impP + ((wid >> 1) * 64 + tl) * 33;
            float av[8], rc[8];
#pragma unroll
            for (int kb = 0; kb < 2; ++kb)
#pragma unroll
                for (int gq = 0; gq < 4; ++gq) { const int f = 4 * kb + gq; const float p3 = 0.5f * P[kb][4 * gq + 3]; av[f] = P[kb][4 * gq] + P[kb][4 * gq + 1] + P[kb][4 * gq + 2] + p3; rc[f] = xchg32(p3, hh == 1); }
#pragma unroll
            for (int f = 0; f < 8; ++f) { const float carry = hh == 1 ? rc[f] : (f > 0 ? rc[f > 0 ? f - 1 : 0] : carry_in); ip[2 * (8 * j0 + f) + hh] = av[f] + carry; }
            carry_in = rc[7];
            if (j0 == 1) {
                {
                    const f32x4* rp = (const f32x4*)((const float*)(F.ws + WS_ROPE) + t * 16);
                    const f32x4 r0 = rp[0], r1 = rp[1], r2 = rp[2], r3 = rp[3];
                    const u32x4 own = __builtin_bit_cast(u32x4, qf[0]);
                    u32x4 oth; oth.x = (unsigned)__shfl_xor((int)own.x, 32); oth.y = (unsigned)__shfl_xor((int)own.y, 32); oth.z = (unsigned)__shfl_xor((int)own.z, 32); oth.w = (unsigned)__shfl_xor((int)own.w, 32);
                    const float a[8] = {bflo(own.x), bfhi(own.x), bflo(own.y), bfhi(own.y), bflo(own.z), bfhi(own.z), bflo(own.w), bfhi(own.w)};
                    const float p[8] = {bflo(oth.x), bfhi(oth.x), bflo(oth.y), bfhi(oth.y), bflo(oth.z), bfhi(oth.z), bflo(oth.w), bfhi(oth.w)};
                    const float cs[8] = {r0[0], r0[2], r1[0], r1[2], r2[0], r2[2], r3[0], r3[2]}, sn[8] = {r0[1], r0[3], r1[1], r1[3], r2[1], r2[3], r3[1], r3[3]};
                    float o[8];
#pragma unroll
                    for (int i = 0; i < 8; ++i) o[i] = hh == 0 ? (a[i] * cs[i] - p[i] * sn[i]) : (p[i] * sn[i] + a[i] * cs[i]);
                    u32x4 w; w.x = pk2(o[0], o[1]); w.y = pk2(o[2], o[3]); w.z = pk2(o[4], o[5]); w.w = pk2(o[6], o[7]);
                    qf[0] = __builtin_bit_cast(bf16x8, w); }
                float lsum = lv; lsum = xadd32(lsum);
                const float inv = lsum > 0.f ? 1.f / lsum : 0.f;
                if (hh == 0) invs[(wid >> 1) * 64 + tl] = inv;
                const float s0 = gpark[0] * inv;
                lv = 0.f;
                NSA_BAR();
                if (wid == 0) {
                    unsigned m;
                    if (qb <= 5) m = allb;
                    else {
                        m = fmask;
                        float best[3] = {-1.f, -1.f, -1.f}; int bi[3] = {0, 0, 0}; const float iv0 = invs[lane], iv1 = invs[64 + lane], iv2 = invs[128 + lane], iv3 = invs[192 + lane];
                        for (int j = 1; j <= qb - 2; ++j) {
                            const float v = (impP[(0 * 64 + lane) * 33 + j] * iv0 + impP[(1 * 64 + lane) * 33 + j] * iv1) + (impP[(2 * 64 + lane) * 33 + j] * iv2 + impP[(3 * 64 + lane) * 33 + j] * iv3);
                            if (v > best[0]) { best[2] = best[1]; bi[2] = bi[1]; best[1] = best[0]; bi[1] = bi[0]; best[0] = v; bi[0] = j; }
                            else if (v > best[1]) { best[2] = best[1]; bi[2] = bi[1]; best[1] = v; bi[1] = j; }
                            else if (v > best[2]) { best[2] = v; bi[2] = j; }
                        }
                        m |= (1u << bi[0]) | (1u << bi[1]) | (1u << bi[2]);
                    }
                    selm[lane] = m;
                    unsigned u = m;
#pragma unroll
                    for (int o = 1; o < 64; o <<= 1) u |= (unsigned)__shfl_xor((int)u, o);
                    if (lane == 0) selm[64] = u;
                }
                NSA_BAR();
                mym = selm[tl];
                if (qb > 5) grest = (unsigned)__builtin_amdgcn_readfirstlane((int)selm[64]) & ~fmask;
#pragma unroll
                for (int db = 0; db < 2; ++db)
#pragma unroll
                    for (int i = 0; i < 16; ++i) { otp[(db * 16 + i) * 64] = O[db][i] * s0; O[db][i] = 0.f; }
                inB = true;
            }
        }
        if (t1 < 0) break;
        t0 = t1; j0 = j1; t1 = t2; j1 = j2; t2 = t3; j2 = j3;
    }
    {
        float lsum = lv; lsum = xadd32(lsum); const float s2 = gpark[128] / lsum;
#pragma unroll
        for (int db = 0; db < 2; ++db)
#pragma unroll
            for (int i = 0; i < 16; ++i) O[db][i] = otp[(db * 16 + i) * 64] + O[db][i] * s2;
    }
    bf16_t* orow = (bf16_t*)(F.ws + WS_AO) + ((size_t)b * SEQ + t) * DM + hd * 64;
    { u32x2 o2[8];
#pragma unroll
      for (int db = 0; db < 2; ++db)
#pragma unroll
          for (int g4 = 0; g4 < 4; ++g4) { o2[4 * db + g4].x = pk2(O[db][4 * g4], O[db][4 * g4 + 1]); o2[4 * db + g4].y = pk2(O[db][4 * g4 + 2], O[db][4 * g4 + 3]); }
      store_row64(orow, o2, hh); }
    if (F.tid == 0) *(LAS int*)(lds + LDS_MISC + 4096) = (int)nx;
    NSA_BAR();
    const int nxt = __builtin_amdgcn_readfirstlane(*(const LAS int*)(lds + LDS_MISC + 4096));
    if (nxt < 2048) { const size_t bgn = (size_t)(nxt & 63);
        const char* kc_ = (const char*)(F.ws + WS_KCMP) + bgn * 16384; const char* vc_ = (const char*)(F.ws + WS_VCMP) + bgn * 16384;
        const char* ks_ = (const char*)(F.ws + WS_KS) + bgn * (SEQ * 128); const char* vs_ = (const char*)(F.ws + WS_VS) + bgn * (SEQ * 128);
        glds16(kc_ + ksrc, (unsigned)__builtin_amdgcn_readfirstlane((int)(wbase))); glds16(vc_ + vsrc, (unsigned)__builtin_amdgcn_readfirstlane((int)(wbase + 8192u)));
        glds16(kc_ + 8192 + ksrc, (unsigned)__builtin_amdgcn_readfirstlane((int)(wbase + 16384u))); glds16(vc_ + 8192 + vsrc, (unsigned)__builtin_amdgcn_readfirstlane((int)(wbase + 16384u + 8192u)));
        glds16(ks_ + ksrc, (unsigned)__builtin_amdgcn_readfirstlane((int)(wbase + 32768u))); glds16(vs_ + vsrc, (unsigned)__builtin_amdgcn_readfirstlane((int)(wbase + 32768u + 8192u))); }
#undef NSA_GEN
#undef NSA_ISSUE
    return nxt;
}

DI float gmax(const float* g, int n, int lane) { float v = lane < n ? fabsf(g[lane]) : 0.f;
#pragma unroll
    for (int o = 1; o < 64; o <<= 1) v = fmaxf(v, __shfl_xor(v, o));
    return v; }

DI int queue_next(Frame& F, unsigned* ctr) {
    LAS int* slot = (LAS int*)(F.lds + LDS_MISC + 4096);
    __syncthreads();
    if (F.tid == 0) *slot = (int)atomicAdd(ctr, 1u);
    __syncthreads();
    return *slot;
}

DI int queue_pass(Frame& F, unsigned nx) {
    LAS int* slot = (LAS int*)(F.lds + LDS_MISC + 4096);
    asm volatile("s_waitcnt lgkmcnt(0)" ::: "memory"); __builtin_amdgcn_s_barrier(); asm volatile("" ::: "memory");
    if (F.tid == 0) *slot = (int)nx;
    asm volatile("s_waitcnt lgkmcnt(0)" ::: "memory"); __builtin_amdgcn_s_barrier(); asm volatile("" ::: "memory");
    return *slot;
}

DI float gelu_tanh(float x) { const float u = 0.7978845608028654f * (x + 0.044715f * x * x * x); const float e = __expf(2.f * u); const float th = 1.f - 2.f / (e + 1.f); return 0.5f * x * (1.f + th); }
DI void phase5(Frame& F) {
    const bf16_t* UL = (const bf16_t*)(F.ws + WS_UL); const float* gk0 = F.in[8];
    LAS unsigned short* w2t = (LAS unsigned short*)F.lds;
    for (int i = F.tid; i < 2 * 64 * 264 * 2 / 16; i += NTHREADS) ((LAS u32x4*)w2t)[i] = ((const u32x4*)(F.ws + WS_W2T))[i];
    LAS float* pes = (LAS float*)(F.lds + 69632);
    { const int kv = F.tid >> 8, k = F.tid & 255; const size_t perow = 16384 + (size_t)kv * 256 + (size_t)kv * 2;
      pes[F.tid] = bf2f(UL[perow * 512 + k]) + bf2f(UL[(perow + 1) * 512 + 256 + k]); }
    __syncthreads();
    const int lane = F.lane, r = lane & 31, hh = lane >> 5;
    const int ngb = F.G < 132 ? F.G : 132;
    for (int grp = F.bid + ngb * F.wave; grp < 512; grp += ngb * NWAVES) {
        const int kv = grp >> 8, bgi = (grp & 255) >> 2, c = (grp & 3) * 32 + r;
        const bool ok = c < 127;
        const size_t row = (size_t)kv * 8192 + (size_t)bgi * 128 + c;
        const bf16_t* up = UL + row * 512 + 8 * hh; const bf16_t* lp = UL + (row + 1) * 512 + 256 + 8 * hh;
        const LAS float* pe = pes + kv * 256 + 8 * hh;
        const LAS unsigned short* wa = w2t + (kv * 64 + r) * 264 + 8 * hh;
        u32x4 uu[16], ll[16];
#pragma unroll
        for (int ks = 0; ks < 16; ++ks) { const u32x4 z4 = {0u, 0u, 0u, 0u}; uu[ks] = ok ? *(const u32x4*)(up + 16 * ks) : z4; ll[ks] = ok ? *(const u32x4*)(lp + 16 * ks) : z4; }
        f32x16 acc[2];
#pragma unroll
        for (int i = 0; i < 16; ++i) { acc[0][i] = 0.f; acc[1][i] = 0.f; }
#pragma unroll
        for (int ks = 0; ks < 16; ++ks) {
            const u32x4 u4 = uu[ks], l4 = ll[ks]; const f32x4 p0 = *(const LAS f32x4*)(pe + 16 * ks), p1 = *(const LAS f32x4*)(pe + 16 * ks + 4);
            u32x4 hw;
            hw.x = pk2(gelu_tanh(bflo(u4.x) + bflo(l4.x) + p0[0]), gelu_tanh(bfhi(u4.x) + bfhi(l4.x) + p0[1]));
            hw.y = pk2(gelu_tanh(bflo(u4.y) + bflo(l4.y) + p0[2]), gelu_tanh(bfhi(u4.y) + bfhi(l4.y) + p0[3]));
            hw.z = pk2(gelu_tanh(bflo(u4.z) + bflo(l4.z) + p1[0]), gelu_tanh(bfhi(u4.z) + bfhi(l4.z) + p1[1]));
            hw.w = pk2(gelu_tanh(bflo(u4.w) + bflo(l4.w) + p1[2]), gelu_tanh(bfhi(u4.w) + bfhi(l4.w) + p1[3]));
            const bf16x8 hf = __builtin_bit_cast(bf16x8, hw);
#pragma unroll
            for (int db = 0; db < 2; ++db) acc[db] = MFMA32(*(const LAS bf16x8*)(wa + db * 32 * 264 + 16 * ks), hf, acc[db]);
        }
        float sc = 1.f;
        if (kv == 0) { float ss = 0.f;
#pragma unroll
            for (int db = 0; db < 2; ++db)
#pragma unroll
                for (int i = 0; i < 16; ++i) ss += acc[db][i] * acc[db][i];
            ss = xadd32(ss); sc = rsqrtf(ss * (1.f / 64.f) + EPS); }
        if (!ok) sc = 0.f;
        u32x2 o2[8];
#pragma unroll
        for (int db = 0; db < 2; ++db)
#pragma unroll
            for (int g4 = 0; g4 < 4; ++g4) { f32x4 gv = {1.f, 1.f, 1.f, 1.f}; if (kv == 0) gv = *(const f32x4*)(gk0 + 32 * db + 8 * g4 + 4 * hh);
                o2[4 * db + g4].x = pk2(acc[db][4 * g4] * sc * gv[0], acc[db][4 * g4 + 1] * sc * gv[1]); o2[4 * db + g4].y = pk2(acc[db][4 * g4 + 2] * sc * gv[2], acc[db][4 * g4 + 3] * sc * gv[3]); }
        store_row64((bf16_t*)(F.ws + (kv ? WS_VCMP : WS_KCMP)) + ((size_t)bgi * 128 + c) * 64, o2, hh);
    }
    __syncthreads();
}

DI void phase8(Frame& F) {
    const bf16_t* x1 = (const bf16_t*)(F.ws + WS_X1B); const float* gf = F.in[5]; const float* mod = (const float*)(F.ws + WS_MOD); const float* rowss = (const float*)(F.ws + WS_ROWSS);
    const char* wsrc = (const char*)(F.ws + WS_WR);
    unsigned char* h2 = (unsigned char*)(F.ws + WS_H2);
    unsigned* cnt = (unsigned*)(F.ws + WS_CTL) + CW_CNT; int* lists = (int*)(F.ws + WS_LIST);
    int* tipos = (int*)(F.ws + WS_TIPOS); int* tie = (int*)(F.ws + WS_TIE); float* tiw = (float*)(F.ws + WS_TIW);
    const float* brg = F.in[21]; const float* bre = F.in[23];
    const int lane = F.lane, wid = F.wave, row = lane & 15, kq = lane >> 4;
    LAS char* wl = (LAS char*)F.lds;
    LAS float* lg = (LAS float*)(F.lds + 98304 + wid * 3072);
    LAS float* A2 = (LAS float*)(F.lds + 122880);
    LAS float* B2 = A2 + 1024;
    LAS unsigned* hist = (LAS unsigned*)(F.lds + LDS_MISC + 8192);
    unsigned wso[6];
#pragma unroll
    for (int i = 0; i < 6; ++i) { const int s = i * 512 + F.tid, part = s / 1536, r = (s >> 5) % 48, cs = s & 31; wso[i] = (unsigned)(part * 98304 + r * 2048 + ((cs ^ (r & 15)) << 4)); }
#define P8_ISSUE(kc, buf) do { _Pragma("unroll") for (int i_ = 0; i_ < 6; ++i_) \
        __builtin_amdgcn_global_load_lds((const unsigned*)(wsrc + (size_t)(kc) * 512 + wso[i_]), (LAS unsigned*)(wl + (buf) * 49152 + i_ * 8192 + wid * 1024), 16, 0, 0); } while (0)
    const int nbatch = TOK / 128;
    for (int bt = F.bid; bt < nbatch; bt += F.G) {
        const int m0 = bt * 128 + wid * 16; const int m = m0 + row; const int b = m0 >> 11;
        P8_ISSUE(0, 0);
        { const float* sh = mod + (size_t)b * 6144 + 3072; const float* sc = sh + 1024;
          for (int k = F.tid; k < 1024; k += NTHREADS) { A2[k] = gf[k] * (sc[k] + 1.f); B2[k] = sh[k]; } }
        if (F.tid < 64) hist[F.tid] = 0u;
        float rs = 0.f; { const f32x4* rp = (const f32x4*)(rowss + (size_t)m * 16);
#pragma unroll
            for (int q = 0; q < 4; ++q) { const f32x4 v = rp[q]; rs += (v[0] + v[1]) + (v[2] + v[3]); } }
        const float rstd = rsqrtf(rs * (1.f / DM) + EPS);
        const bf16_t* xrow = x1 + (size_t)m * DM + 8 * kq; unsigned char* hrow = h2 + (size_t)m * DM + 8 * kq;
        u32x4 xw[4];
#pragma unroll
        for (int u = 0; u < 4; ++u) xw[u] = *(const u32x4*)(xrow + 32 * u);
        f32x4 acc[3] = {{0.f, 0.f, 0.f, 0.f}, {0.f, 0.f, 0.f, 0.f}, {0.f, 0.f, 0.f, 0.f}};
        for (int kc = 0; kc < 4; ++kc) {
            asm volatile("s_waitcnt vmcnt(0)" ::: "memory");
            __syncthreads();
            if (kc + 1 < 4) P8_ISSUE(kc + 1, (kc + 1) & 1);
            const LAS char* wb = wl + (kc & 1) * 49152;
#pragma unroll 1
            for (int g4 = 0; g4 < 2; ++g4) {
                const int gg = kc * 2 + g4;
                u32x4 nw[4];
                if (gg + 1 < 8) {
#pragma unroll
                    for (int u = 0; u < 4; ++u) nw[u] = *(const u32x4*)(xrow + 128 * (gg + 1) + 32 * u);
                }
#pragma unroll
                for (int u = 0; u < 4; ++u) {
                    const int k0 = 128 * gg + 32 * u + 8 * kq;
                    const f32x4 a0 = *(const LAS f32x4*)(A2 + k0), a1 = *(const LAS f32x4*)(A2 + k0 + 4), b0 = *(const LAS f32x4*)(B2 + k0), b1 = *(const LAS f32x4*)(B2 + k0 + 4);
                    const f32x4 xa_ = {bflo(xw[u].x), bfhi(xw[u].x), bflo(xw[u].y), bfhi(xw[u].y)}, xb_ = {bflo(xw[u].z), bfhi(xw[u].z), bflo(xw[u].w), bfhi(xw[u].w)};
                    const f32x4 ya = xa_ * rstd * a0 + b0, yb = xb_ * rstd * a1 + b1;
                    u32x4 hi; hi.x = pk2(ya[0], ya[1]); hi.y = pk2(ya[2], ya[3]); hi.z = pk2(yb[0], yb[1]); hi.w = pk2(yb[2], yb[3]);
                    { u32x2 h8; h8.x = pk4_fp8(ya[0], ya[1], ya[2], ya[3]); h8.y = pk4_fp8(yb[0], yb[1], yb[2], yb[3]); *(u32x2*)(hrow + 128 * gg + 32 * u) = h8; }
                    u32x4 lo; lo.x = pk2(ya[0] - bflo(hi.x), ya[1] - bfhi(hi.x)); lo.y = pk2(ya[2] - bflo(hi.y), ya[3] - bfhi(hi.y)); lo.z = pk2(yb[0] - bflo(hi.z), yb[1] - bfhi(hi.z)); lo.w = pk2(yb[2] - bflo(hi.w), yb[3] - bfhi(hi.w));
                    const bf16x8 ahi = __builtin_bit_cast(bf16x8, hi), alo = __builtin_bit_cast(bf16x8, lo);
                    const int ch = (g4 * 4 + u) * 4 + kq;
#pragma unroll
                    for (int ct = 0; ct < 3; ++ct) { const int r = 16 * ct + row; const int off = r * 512 + ((ch ^ row) << 4);
                        const bf16x8 bh = *(const LAS bf16x8*)(wb + off), bl = *(const LAS bf16x8*)(wb + 24576 + off);
                        acc[ct] = MFMA16(ahi, bh, acc[ct]); acc[ct] = MFMA16(alo, bh, acc[ct]); acc[ct] = MFMA16(ahi, bl, acc[ct]); }
                }
#pragma unroll
                for (int u = 0; u < 4; ++u) xw[u] = nw[u];
            }
        }
#pragma unroll
        for (int ct = 0; ct < 3; ++ct)
#pragma unroll
            for (int i = 0; i < 4; ++i) lg[(kq * 4 + i) * 48 + 16 * ct + row] = acc[ct][i];
        asm volatile("s_waitcnt lgkmcnt(0)" ::: "memory");
        int e0 = 0, e1 = 0; float w0 = 0.f, w1 = 0.f; unsigned lp0 = 0u, lp1 = 0u;
        if (lane < 16) {
            const LAS float* lr = lg + lane * 48;
            float g4v[4]; int grp = 0; float gm = -3.0e38f;
#pragma unroll
            for (int i = 0; i < 4; ++i) { g4v[i] = lr[i] + brg[i]; if (g4v[i] > gm) { gm = g4v[i]; grp = i; } }
            float den = 0.f;
#pragma unroll
            for (int i = 0; i < 4; ++i) den += __expf(g4v[i] - gm);
            const float pg = 1.f / den;
            float v0 = -3.0e38f, v1 = -3.0e38f; int i0 = 0, i1 = 0;
            for (int i = 0; i < 8; ++i) { const float v = lr[4 + grp * 8 + i] + bre[grp * 8 + i];
                if (v > v0) { v1 = v0; i1 = i0; v0 = v; i0 = i; } else if (v > v1) { v1 = v; i1 = i; } }
            const float ex = __expf(v1 - v0); w0 = pg / (1.f + ex); w1 = pg * ex / (1.f + ex);
            e0 = grp * 8 + i0; e1 = grp * 8 + i1;
            lp0 = atomicAdd((unsigned*)&hist[e0], 1u); lp1 = atomicAdd((unsigned*)&hist[e1], 1u);
        }
        __syncthreads();
        if (F.tid < 32) { const unsigned n = hist[F.tid]; hist[32 + F.tid] = n ? atomicAdd(cnt + F.tid, n) : 0u; }
        __syncthreads();
        if (lane < 16) {
            const int tok = m0 + lane; const int p0 = (int)(hist[32 + e0] + lp0), p1 = (int)(hist[32 + e1] + lp1);
            lists[(size_t)e0 * ECAP + p0] = tok; lists[(size_t)e1 * ECAP + p1] = tok;
            tipos[2 * tok] = p0; tipos[2 * tok + 1] = p1; tie[tok] = e0 | (e1 << 8); tiw[2 * tok] = w0; tiw[2 * tok + 1] = w1;
        }
        __syncthreads();
    }
#undef P8_ISSUE
}

DI LAS int* moe_prefix(Frame& F) {
    LAS int* tb = (LAS int*)(F.lds + LDS_MISC);
    __syncthreads();
    if (F.wave == 0) {
        const unsigned* cnt = (const unsigned*)(F.ws + WS_CTL) + CW_CNT; const int l = F.lane;
        int v = l < 32 ? (int)((__hip_atomic_load(cnt + l, __ATOMIC_RELAXED, __HIP_MEMORY_SCOPE_AGENT) + 255u) >> 8) : 0;
#pragma unroll
        for (int o = 1; o < 32; o <<= 1) { const int u = __shfl_up(v, o); if (l >= o) v += u; }
        if (l < 32) tb[l + 1] = v;
        if (l == 0) tb[0] = 0;
    }
    __syncthreads();
    return tb;
}

DI void phase11(Frame& F) {
    LAS int* tb = moe_prefix(F);
    const unsigned char* Y = (const unsigned char*)(F.ws + WS_Y); const float* mod = (const float*)(F.ws + WS_MOD);
    const int* tipos = (const int*)(F.ws + WS_TIPOS); const int* tie = (const int*)(F.ws + WS_TIE); const float* tiw = (const float*)(F.ws + WS_TIW);
    const int lane = F.lane;
    for (int m0 = F.gw * 32; m0 < TOK; m0 += F.NGW * 32) {
        const int b = m0 >> 11; const float* g2 = mod + (size_t)b * 6144 + 5120;
        f32x4 ga[2], gb[2];
#pragma unroll
        for (int j = 0; j < 2; ++j) { ga[j] = *(const f32x4*)(g2 + 8 * lane + 512 * j); gb[j] = *(const f32x4*)(g2 + 8 * lane + 512 * j + 4); }
        int mr0 = 0, mr1 = 0; float mw0 = 0.f, mw1 = 0.f;
        { const int mm = m0 + (lane & 31); const int ee = tie[mm]; mr0 = tb[ee & 255] * 256 + tipos[2 * mm]; mr1 = tb[ee >> 8] * 256 + tipos[2 * mm + 1]; mw0 = tiw[2 * mm]; mw1 = tiw[2 * mm + 1]; }
        float* obase = F.out + (size_t)m0 * DM + 8 * lane; const bf16_t* xbase = (const bf16_t*)(F.ws + WS_X1B) + (size_t)m0 * DM + 8 * lane;
#define P11_LOAD(i, ya, yb, xa, xb) do { const size_t r0_ = (size_t)__shfl(mr0, (i)), r1_ = (size_t)__shfl(mr1, (i)); \
            _Pragma("unroll") for (int j = 0; j < 2; ++j) { ya[j] = __builtin_nontemporal_load((const u32x2*)(Y + r0_ * DM + 8 * lane + 512 * j)); yb[j] = __builtin_nontemporal_load((const u32x2*)(Y + r1_ * DM + 8 * lane + 512 * j)); \
                const u32x4 xw_ = ldntu4(xbase + (size_t)(i) * DM + 512 * j); xa[j] = (f32x4){bflo(xw_.x), bfhi(xw_.x), bflo(xw_.y), bfhi(xw_.y)}; xb[j] = (f32x4){bflo(xw_.z), bfhi(xw_.z), bflo(xw_.w), bfhi(xw_.w)}; } } while (0)
        u32x2 ya0[2], yb0[2], ya1[2], yb1[2]; f32x4 xa0[2], xb0[2], xa1[2], xb1[2];
        P11_LOAD(0, ya0, yb0, xa0, xb0); P11_LOAD(1, ya1, yb1, xa1, xb1);
        for (int i = 0; i < 32; i += 2) {
            u32x2 nya0[2], nyb0[2], nya1[2], nyb1[2]; f32x4 nxa0[2], nxb0[2], nxa1[2], nxb1[2];
            if (i + 2 < 32) { P11_LOAD(i + 2, nya0, nyb0, nxa0, nxb0); P11_LOAD(i + 3, nya1, nyb1, nxa1, nxb1); }
#define P11_ROW(i, ya, yb, xa, xb) do { const float w0 = __shfl(mw0, (i)), w1 = __shfl(mw1, (i)); \
            _Pragma("unroll") for (int j = 0; j < 2; ++j) { f32x4 oa = xa[j], ob = xb[j]; \
                const f32x2 a01 = __builtin_amdgcn_cvt_pk_f32_fp8((int)ya[j].x, false), a23 = __builtin_amdgcn_cvt_pk_f32_fp8((int)ya[j].x, true), a45 = __builtin_amdgcn_cvt_pk_f32_fp8((int)ya[j].y, false), a67 = __builtin_amdgcn_cvt_pk_f32_fp8((int)ya[j].y, true); \
                const f32x2 b01 = __builtin_amdgcn_cvt_pk_f32_fp8((int)yb[j].x, false), b23 = __builtin_amdgcn_cvt_pk_f32_fp8((int)yb[j].x, true), b45 = __builtin_amdgcn_cvt_pk_f32_fp8((int)yb[j].y, false), b67 = __builtin_amdgcn_cvt_pk_f32_fp8((int)yb[j].y, true); \
                oa[0] += ga[j][0] * (w0 * a01[0] + w1 * b01[0]); oa[1] += ga[j][1] * (w0 * a01[1] + w1 * b01[1]); \
                oa[2] += ga[j][2] * (w0 * a23[0] + w1 * b23[0]); oa[3] += ga[j][3] * (w0 * a23[1] + w1 * b23[1]); \
                ob[0] += gb[j][0] * (w0 * a45[0] + w1 * b45[0]); ob[1] += gb[j][1] * (w0 * a45[1] + w1 * b45[1]); \
                ob[2] += gb[j][2] * (w0 * a67[0] + w1 * b67[0]); ob[3] += gb[j][3] * (w0 * a67[1] + w1 * b67[1]); \
                stnt4(obase + (size_t)(i) * DM + 512 * j, oa); stnt4(obase + (size_t)(i) * DM + 512 * j + 4, ob); } } while (0)
            P11_ROW(i, ya0, yb0, xa0, xb0); P11_ROW(i + 1, ya1, yb1, xa1, xb1);
#pragma unroll
            for (int j = 0; j < 2; ++j) { ya0[j] = nya0[j]; yb0[j] = nyb0[j]; xa0[j] = nxa0[j]; xb0[j] = nxb0[j]; ya1[j] = nya1[j]; yb1[j] = nyb1[j]; xa1[j] = nxa1[j]; xb1[j] = nxb1[j]; }
        }
#undef P11_LOAD
#undef P11_ROW
    }
}

constexpr int CW_BAR = 4096;
#define XB_TMO      128
#define XB_XCNT(j)  (256  + 64 * (j))
#define XB_XSUB(j)  (1280 + 64 * (j))
#define XB_XGEN(j)  (2304 + 64 * (j))
#define XB_TOP      3328
#define XB_TOPGEN   3392
#define XB_SPIN_CAP (1u << 22)
DI unsigned xb_ld(unsigned* p)              { return __hip_atomic_load(p, __ATOMIC_RELAXED, __HIP_MEMORY_SCOPE_AGENT); }
DI unsigned xb_add(unsigned* p, unsigned v) { return __hip_atomic_fetch_add(p, v, __ATOMIC_RELAXED, __HIP_MEMORY_SCOPE_AGENT); }
DI unsigned xb_xcc_id() { return (unsigned)__builtin_amdgcn_s_getreg((3 << 11) | 20) & 0xFu; }
#define XB_SPIN(cond, bar) do { unsigned _sp = 0; while (cond) { __builtin_amdgcn_s_sleep(1); \
    if ((++_sp & 255u) == 0u) { if (xb_ld(&(bar)[XB_TMO])) break; if (_sp > XB_SPIN_CAP) { atomicAdd(&(bar)[XB_TMO], 1u); break; } } } } while (0)
struct XcdBarrier { unsigned* bar; unsigned x; volatile LAS unsigned* st; };
DI XcdBarrier xcd_barrier_post(unsigned* bar, volatile LAS unsigned* st, bool leader) {
    XcdBarrier b; b.bar = bar; b.x = xb_xcc_id(); b.st = st;
    if (leader) (void)xb_add(&bar[XB_XCNT(b.x)], 1u);
    return b;
}
DI void xcd_barrier_complete(unsigned* bar, unsigned x, unsigned& nloc, unsigned& nx) {
    const unsigned G = gridDim.x;
    unsigned sum, cnt, mine, sp = 0u;
    for (;;) {
        sum = 0u; cnt = 0u; mine = 0u;
#pragma unroll
        for (unsigned j = 0; j < 16; ++j) { const unsigned c = xb_ld(&bar[XB_XCNT(j)]); sum += c; cnt += (c > 0u) ? 1u : 0u; mine = (j == x) ? c : mine; }
        if (sum == G) break;
        __builtin_amdgcn_s_sleep(1);
        if ((++sp & 255u) == 0u) { if (xb_ld(&bar[XB_TMO])) break; if (sp > XB_SPIN_CAP) { atomicAdd(&bar[XB_TMO], 1u); break; } }
    }
    nloc = mine > 0u ? mine : 1u; nx = cnt > 0u ? cnt : 1u;
}
DI void xcd_barrier(const XcdBarrier& b, bool leader) {
    asm volatile("s_waitcnt vmcnt(0)" ::: "memory");
    __syncthreads();
    if (leader) {
        unsigned* bar = b.bar;
        __builtin_amdgcn_s_waitcnt(0);
        unsigned nloc = b.st[0], nx = b.st[1];
        if (nloc == 0u) { xcd_barrier_complete(bar, b.x, nloc, nx); b.st[0] = nloc; b.st[1] = nx; }
        const unsigned old = xb_add(&bar[XB_XSUB(b.x)], 1u);
        const unsigned gen = old / nloc;
        if (old + 1u == (gen + 1u) * nloc) {
            __builtin_amdgcn_fence(__ATOMIC_RELEASE, "agent");
            asm volatile("s_waitcnt vmcnt(0)" ::: "memory");
            const unsigned og = xb_add(&bar[XB_TOP], 1u);
            const unsigned tg = og / nx;
            if (og + 1u == (tg + 1u) * nx) xb_add(&bar[XB_TOPGEN], 1u);
            else XB_SPIN(xb_ld(&bar[XB_TOPGEN]) == tg, bar);
            xb_add(&bar[XB_XGEN(b.x)], 1u);
            __builtin_amdgcn_fence(__ATOMIC_ACQUIRE, "agent");
            asm volatile("s_waitcnt vmcnt(0)" ::: "memory");
        } else {
            XB_SPIN(xb_ld(&bar[XB_XGEN(b.x)]) == gen, bar);
            __builtin_amdgcn_fence(__ATOMIC_ACQUIRE, "agent");
            asm volatile("s_waitcnt vmcnt(0)" ::: "memory");
        }
    }
    __syncthreads();
}

constexpr int NPHASE = 12;
__global__ void __launch_bounds__(NTHREADS, 2) hymba_fwd(Params p) {
    extern __shared__ __attribute__((aligned(16))) unsigned char lds_raw[];
    __builtin_assume(__builtin_amdgcn_workitem_id_y() == 0); __builtin_assume(__builtin_amdgcn_workitem_id_z() == 0);
    cg::grid_group grid = cg::this_grid();
    Frame F;
    F.lds = (LAS unsigned char*)lds_raw; F.ws = p.ws; F.in = p.in; F.out = p.out;
    F.wave = __builtin_amdgcn_readfirstlane(threadIdx.x >> 6); F.lane = lane_id_fresh(); F.tid = F.wave * 64 + F.lane; F.bid = blockIdx.x; F.G = gridDim.x;
    F.gw = F.bid * NWAVES + F.wave; F.NGW = F.G * NWAVES;
    const int lo = p.ph_lo, hi = p.ph_hi;
#define IN(k) (lo <= (k) && (k) < hi)
#ifdef PROBE_A
    LAS unsigned long long* ts_ = (LAS unsigned long long*)(F.lds + LDS_MISC + 7168);
#define STAMP(k) do { if (F.bid == 0 && F.tid == 0) ts_[k] = __builtin_amdgcn_s_memrealtime(); } while (0)
#else
#define STAMP(k) do { } while (0)
#endif
    STAMP(0);
    volatile LAS unsigned* xst = (volatile LAS unsigned*)(F.lds + LDS_MISC + 4112);
    if (F.tid == 0) { xst[0] = 0u; xst[1] = 0u; }
    __syncthreads();
    XcdBarrier xbar = xcd_barrier_post((unsigned*)(F.ws + WS_CTL) + CW_BAR, xst, F.tid == 0);
    if (F.tid == 0) __hip_atomic_store((unsigned*)(F.ws + WS_CTL) + CW_XID + F.bid, xb_xcc_id() + 1u, __ATOMIC_RELAXED, __HIP_MEMORY_SCOPE_AGENT);
#define SEAM(k) do { if (IN(k) && IN((k) + 1)) { xcd_barrier(xbar, F.tid == 0); } F.lane = lane_id_fresh(); F.tid = F.wave * 64 + F.lane; STAMP((k) + 1); } while (0)
    LAS unsigned char* ring = F.lds; LAS unsigned* tokl = (LAS unsigned*)(F.lds + LDS_MISC + 256);
#ifdef DOUBLE_PHASE
#define NREP(k) ((k) == DOUBLE_PHASE ? 2 : 1)
#define REPSYNC(k, rep) do { if ((k) == DOUBLE_PHASE && (rep) == 0) grid.sync(); } while (0)
#else
#define NREP(k) 1
#define REPSYNC(k, rep) do { } while (0)
#endif

    if (IN(0)) for (int rep = 0; rep < NREP(0); ++rep) { phase0(F); REPSYNC(0, rep); }
    if (IN(0) && IN(1)) {
        if (F.tid == 0) { unsigned* a = (unsigned*)(F.ws + WS_CTL) + CW_ADA; while (__hip_atomic_load(a, __ATOMIC_RELAXED, __HIP_MEMORY_SCOPE_AGENT) < 32u) __builtin_amdgcn_s_sleep(8); }
        __syncthreads(); __builtin_amdgcn_fence(__ATOMIC_ACQUIRE, "agent");
    }
    F.lane = lane_id_fresh(); F.tid = F.wave * 64 + F.lane; STAMP(1);
    if (IN(1)) for (int rep = 0; rep < NREP(1); ++rep) { phase1(F); REPSYNC(1, rep); }
    SEAM(1);
    if (IN(2)) for (int rep = 0; rep < NREP(2); ++rep) {
        pg8::StaticOrder S; S.init(TOK, NPROJ, DM / 2, F.G, F.bid, F.ws + WS_H1, F.ws + WS_WIN);
        stagger(F, STAG2);
        pg8::EpiInProj E{F.ws, F.in[7], F.in[8], F.in[12], F.in[13], (LAS float*)(F.lds + LDS_MISC + 8192)};
        pg8::gemm_phase<pg8::EpiInProj, pg8::StaticOrder, false, true>(ring, tokl, DM / 2, S, E, F.wave, F.lane);
        REPSYNC(2, rep);
    }
    SEAM(2); STAMP(4);
    if (IN(4)) for (int rep = 0; rep < NREP(4); ++rep) {
        { pg8::CompressOrder S{F.G, F.bid, (const char*)(F.ws + WS_KC), (const char*)(F.ws + WS_PE), (const char*)(F.ws + WS_WC1)};
          pg8::EpiBf16 E{(bf16_t*)(F.ws + WS_UL), 512};
          pg8::gemm_phase<pg8::EpiBf16, pg8::CompressOrder, false>(ring, tokl, 1024, S, E, F.wave, F.lane); }
        { unsigned* ctl = (unsigned*)(F.ws + WS_CTL); const int ngb = F.G < 132 ? F.G : 132;
          if (F.bid < ngb) {
              const int mine = (132 - F.bid + F.G - 1) / F.G;
              const unsigned myx = xb_xcc_id(); unsigned nxb = 0u;
#pragma unroll
              for (int q = 0; q < 3; ++q) { const int j = F.lane + 64 * q; const bool m = j < ngb && xb_ld(ctl + CW_XID + (j < ngb ? j : 0)) == myx + 1u; nxb += (unsigned)__popcll(__ballot(m)); }
              __syncthreads();
              if (F.tid == 0) { const unsigned old = xb_add(ctl + CW_XA + 16 * myx, ((unsigned)mine << 16) | 1u);
                  if ((old & 0xffffu) + 1u == nxb) { __builtin_amdgcn_fence(__ATOMIC_RELEASE, "agent"); asm volatile("s_waitcnt vmcnt(0)" ::: "memory"); xb_add(ctl + CW_GDONE, (old >> 16) + (unsigned)mine); }
                  while (__hip_atomic_load(ctl + CW_GDONE, __ATOMIC_RELAXED, __HIP_MEMORY_SCOPE_AGENT) < 132u) __builtin_amdgcn_s_sleep(8); }
              __syncthreads(); __builtin_amdgcn_fence(__ATOMIC_ACQUIRE, "agent");
              phase5(F);
              asm volatile("s_waitcnt vmcnt(0)" ::: "memory"); __syncthreads();
              if (F.tid == 0) { const unsigned old = xb_add(ctl + CW_XB2 + 16 * myx, 1u);
                  if (old + 1u == nxb) { __builtin_amdgcn_fence(__ATOMIC_RELEASE, "agent"); asm volatile("s_waitcnt vmcnt(0)" ::: "memory"); xb_add(ctl + CW_P5DONE, nxb); } }
          } }
        const float mq = gmax(F.in[12], 32, F.lane), mk = gmax(F.in[13], 32, F.lane);
        const float bound = 5.656854249f * mq * mk * 1.02f; const float c2 = 0.17677669529663687f * 1.4426950408889634f; const float mc = bound * 1.4426950408889634f;
        float s1 = F.lane < 32 ? F.in[14][F.lane] * F.in[15][F.lane] : 0.f, s2 = F.lane < 32 ? F.in[16][F.lane] * F.in[17][F.lane] : 0.f;
        s1 = wave_sum(s1); s2 = wave_sum(s2);
        const float lam = __expf(s1) - __expf(s2) + 0.2f;
        unsigned* ctr = (unsigned*)(F.ws + WS_CTL) + CW_QDIFF + 32 * rep;
        if (F.tid < 64) ((LAS float*)(F.lds + LDS_MISC + 5120))[F.tid] = F.in[18][F.tid];
        __syncthreads();
        if (F.wave >= 4) __builtin_amdgcn_s_setprio(1);
        { bool pre = false;
          const int xcc = (int)xb_xcc_id() & 7;
          unsigned* cen = (unsigned*)(F.ws + WS_CTL) + CW_BAR;
          auto draw = [&]() { for (int k = 0; k < 8; ++k) { const int q = (xcc + k) & 7;
                  if (k > 0 && (xb_ld(cen + XB_XCNT(q)) + xb_ld(cen + XB_XCNT(q + 8))) != 0u) continue;
                  const int l = (int)atomicAdd(ctr + q, 1u); if (l < 512) return (((l >> 4) * 8 + q) << 4) + (l & 15); } return 4096; };
          int it; { LAS int* slot = (LAS int*)(F.lds + LDS_MISC + 4096); __syncthreads(); if (F.tid == 0) *slot = draw(); __syncthreads(); it = *slot; }
          for (; it < 4096;) { unsigned nx = 0u; if (F.tid == 0) nx = (unsigned)draw();
            const int qb = 15 - (it & 15), bh = it >> 4; const int nxt = diff_unit(F, bh >> 3, bh & 7, qb, c2, mc, lam, nx, pre); pre = nxt < 4096; it = nxt; } }
        __builtin_amdgcn_s_setprio(0);
        REPSYNC(4, rep);
    }
    { unsigned* ctl = (unsigned*)(F.ws + WS_CTL); const unsigned ngb = (unsigned)(F.G < 132 ? F.G : 132);
      if (F.tid == 0) { while (__hip_atomic_load(ctl + CW_P5DONE, __ATOMIC_RELAXED, __HIP_MEMORY_SCOPE_AGENT) < ngb) __builtin_amdgcn_s_sleep(8); }
      __syncthreads(); __builtin_amdgcn_fence(__ATOMIC_ACQUIRE, "agent"); }
    F.lane = lane_id_fresh(); F.tid = F.wave * 64 + F.lane;
    if (IN(6)) for (int rep = 0; rep < NREP(6); ++rep) {
        const float mq = gmax(F.in[7], 64, F.lane); const float mk = fmaxf(gmax(F.in[8], 64, F.lane), fmaxf(gmax(F.in[8] + 64, 64, F.lane), gmax(F.in[8] + 128, 64, F.lane)));
        const float bound = 8.f * mq * mk * 1.02f; const float c2 = 0.125f * 1.4426950408889634f; const float mc = bound * 1.4426950408889634f;
        unsigned* ctr = (unsigned*)(F.ws + WS_CTL) + CW_QNSA + 32 * rep;
        if (F.wave >= 4) __builtin_amdgcn_s_setprio(1);
        { bool pre = false;
          for (int it = queue_next(F, ctr); it < 2048;) { unsigned nx = 0u; if (F.tid == 0) nx = atomicAdd(ctr, 1u);
            const int qb = 31 - (it >> 6), bg = it & 63; const int nxt = nsa_unit(F, bg >> 1, bg & 1, qb, c2, mc, nx, pre); pre = nxt < 2048; it = nxt; } }
        __builtin_amdgcn_s_setprio(0);
        REPSYNC(6, rep);
    }
    SEAM(6);
    if (IN(7)) for (int rep = 0; rep < NREP(7); ++rep) {
        pg8::StaticOrder S; S.init(TOK, DM, DM, F.G, F.bid, F.ws + WS_AO, F.ws + WS_WOUT);
        pg8::EpiOutProj E{F.in[0], (bf16_t*)(F.ws + WS_X1B), (const float*)(F.ws + WS_MOD), (float*)(F.ws + WS_ROWSS)};
        pg8::gemm_phase<pg8::EpiOutProj, pg8::StaticOrder, false>(ring, tokl, DM, S, E, F.wave, F.lane);
        REPSYNC(7, rep);
    }
    SEAM(7);
    if (IN(8)) phase8(F);
    SEAM(8);
    if (IN(9)) for (int rep = 0; rep < NREP(9); ++rep) {
        LAS int* tb = moe_prefix(F);
        pg8::MoeOrder S{F.G, F.bid, 0, tb, (const char*)(F.ws + WS_H2), (const char*)(F.ws + WS_WGU), (const int*)(F.ws + WS_LIST)};
        pg8::EpiSwiglu E{(unsigned char*)(F.ws + WS_HH)};
        pg8::gemm_phase<pg8::EpiSwiglu, pg8::MoeOrder, true, true>(ring, tokl, DM / 2, S, E, F.wave, F.lane);
        REPSYNC(9, rep);
    }
    SEAM(9);
    if (IN(10)) for (int rep = 0; rep < NREP(10); ++rep) {
        LAS int* tb = moe_prefix(F);
        pg8::MoeOrder S{F.G, F.bid, 1, tb, (const char*)(F.ws + WS_HH), (const char*)(F.ws + WS_WD), nullptr};
        pg8::EpiFp8 E{(unsigned char*)(F.ws + WS_Y), DM};
        pg8::gemm_phase<pg8::EpiFp8, pg8::MoeOrder, false, true>(ring, tokl, EHID / 2, S, E, F.wave, F.lane);
        REPSYNC(10, rep);
    }
    SEAM(10);
    if (IN(11)) phase11(F);
    if (p.ph_hi > 100) { grid.sync(); grid.sync(); grid.sync(); grid.sync(); grid.sync(); grid.sync(); grid.sync(); grid.sync(); }
#ifdef PROBE_A
    grid.sync(); STAMP(12);
    if (F.bid == 0 && F.tid == 0) {
        unsigned long long da = (ts_[PROBE_A + 1] - ts_[PROBE_A]) / 100ull, db = (ts_[PROBE_B + 1] - ts_[PROBE_B]) / 100ull;
        unsigned long long qa = (da + 5ull) / 10ull, qb2 = (db + 5ull) / 10ull; if (qa > 63ull) qa = 63ull; if (qb2 > 63ull) qb2 = 63ull;
        const unsigned long long target = ts_[0] + (6000ull + 16ull + 32ull * qa + 2048ull * qb2) * 100ull;
        while (__builtin_amdgcn_s_memrealtime() < target) __builtin_amdgcn_s_sleep(32);
    }
#endif
#undef IN
#undef SEAM
}

#ifndef MK_LAUNCHES
#define MK_LAUNCHES 1
#endif
extern "C" void kernel_launch(void* const* d_in, const int* in_sizes, int n_in, void* d_out, int out_size, void* d_ws, size_t ws_size, hipStream_t stream) {
    static int grid = 0;
    if (grid == 0) {
        if (n_in != 27 || ws_size < WS_END) { fprintf(stderr, "kernel_launch: unexpected inputs (n_in %d, ws %zu)\n", n_in, ws_size); grid = -1; return; }
        int dev = 0, cus = 0, per_cu = 0;
        hipGetDevice(&dev); hipDeviceGetAttribute(&cus, hipDeviceAttributeMultiprocessorCount, dev);
        hipFuncSetAttribute((const void*)hymba_fwd, hipFuncAttributeMaxDynamicSharedMemorySize, LDS_BYTES);
        hipOccupancyMaxActiveBlocksPerMultiprocessor(&per_cu, (const void*)hymba_fwd, NTHREADS, LDS_BYTES);
        if (per_cu < 1) { fprintf(stderr, "kernel_launch: occupancy query says %d blocks per CU\n", per_cu); per_cu = 1; }
        if (per_cu > 1) per_cu = 1;
        grid = cus * per_cu;
    }
    if (grid < 0) return;
    Params p{};
    for (int i = 0; i < 27; ++i) p.in[i] = (const float*)d_in[i];
    p.out = (float*)d_out; p.ws = (unsigned char*)d_ws;
    const int cuts[13] = {0, 1, 2, 3, 4, 5, 6, 7, 8, 9, 10, 11, 12};
    const int nl = MK_LAUNCHES == 1 ? 1 : NPHASE;
    hipMemsetAsync((unsigned char*)d_ws + WS_CTL + (size_t)4096 * 4, 0, (size_t)4096 * 4, stream);
    for (int li = 0; li < nl; ++li) {
        p.ph_lo = nl == 1 ? 0 : cuts[li]; p.ph_hi = nl == 1 ? NPHASE : cuts[li + 1];
        void* args[] = {&p};
        hipError_t e = hipLaunchCooperativeKernel((const void*)hymba_fwd, dim3(grid), dim3(NTHREADS), args, LDS_BYTES, stream);
        if (e != hipSuccess) { fprintf(stderr, "cooperative launch failed: %s (grid %d)\n", hipGetErrorString(e), grid); break; }
    }
}
```
